# Optimizing an MI355X kernel written in HIP

```python
import math
import jax, jax.numpy as jnp
from jax import lax
import numpy as np

D_MODEL = 2048
BATCH = 8
SEQ = 2048
DEPTH = 1

MEM_LEN = 256
EPS = 1e-6

ATTN_HEADS = 16
ATTN_KV_HEADS = 2
ATTN_HEAD_DIM = 64
ATTN_WIDTH = ATTN_HEADS * ATTN_HEAD_DIM
KV_WIDTH = ATTN_KV_HEADS * ATTN_HEAD_DIM
WINDOW = 128
BLOCK = 128

REL_BUCKETS = 32
REL_MAX_DIST = 128

SSM_GROUP_CH = 16
SSM_GROUPS = 32
SSM_STATE = 64
SSM_WIDTH = SSM_GROUPS * SSM_GROUP_CH

XATTN_HEADS = 4
XATTN_HEAD_DIM = 128
XATTN_WIDTH = XATTN_HEADS * XATTN_HEAD_DIM

MIX_WIDTH = ATTN_WIDTH + SSM_WIDTH + XATTN_WIDTH
IN_COLS = ATTN_WIDTH + 2 * KV_WIDTH + SSM_WIDTH + XATTN_WIDTH

N_EXPERT_GROUPS = 8
EXPERTS_PER_GROUP = 8
N_EXPERTS = N_EXPERT_GROUPS * EXPERTS_PER_GROUP
TOP_K_INNER = 2
D_EXPERT = 512
MOE_BLOCK = 128

kernel_name = "hymba_swa_s5_xattn_hmoe"


def rms_norm(x, g):
    xf = x.astype(jnp.float32)
    y = xf * lax.rsqrt(jnp.mean(xf * xf, axis=-1, keepdims=True) + EPS)
    return (y * g.astype(jnp.float32)).astype(x.dtype)


def t5_bucket(delta):
    n = jnp.maximum(delta, 0)
    max_exact = REL_BUCKETS // 2
    nf = jnp.maximum(n, 1).astype(jnp.float32)
    large = max_exact + (jnp.log(nf / max_exact) / math.log(REL_MAX_DIST / max_exact)
                         * (REL_BUCKETS - max_exact)).astype(jnp.int32)
    large = jnp.minimum(large, REL_BUCKETS - 1)
    return jnp.where(n < max_exact, n, large)


def sliding_window_attention(q, k, v, sinks, rel_bias):
    B, S = q.shape[0], q.shape[1]
    nb = S // BLOCK
    G = ATTN_HEADS // ATTN_KV_HEADS
    f32 = jnp.float32
    qb = q.astype(f32).reshape(B, nb, BLOCK, ATTN_KV_HEADS, G, ATTN_HEAD_DIM)

    def banded(t):
        tp = jnp.pad(t, ((0, 0), (BLOCK, 0), (0, 0), (0, 0)))
        tb = tp.reshape(B, nb + 1, BLOCK, ATTN_KV_HEADS, ATTN_HEAD_DIM)
        return jnp.concatenate([tb[:, :-1], tb[:, 1:]], axis=2)

    kc = banded(k).astype(f32)
    vc = banded(v)
    logits = jnp.einsum('bnqhgd,bnkhd->bnhgqk', qb, kc) / math.sqrt(ATTN_HEAD_DIM)

    qi = jnp.arange(BLOCK, dtype=jnp.int32)[:, None]
    ki = jnp.arange(2 * BLOCK, dtype=jnp.int32)[None, :]
    delta = BLOCK + qi - ki
    in_window = (delta >= 0) & (delta < WINDOW)
    blk = jnp.arange(nb, dtype=jnp.int32)[:, None, None]
    valid = in_window[None] & ((ki >= BLOCK)[None] | (blk > 0))

    bias = rel_bias.astype(f32)[t5_bucket(delta)]
    bias = jnp.transpose(bias, (2, 0, 1)).reshape(ATTN_KV_HEADS, G, BLOCK, 2 * BLOCK)
    logits = logits + bias[None, None]
    logits = jnp.where(valid[None, :, None, None], logits, jnp.float32(-1e30))

    sink = jnp.broadcast_to(sinks.astype(f32).reshape(ATTN_KV_HEADS, G, 1, 1),
                            logits.shape[:-1] + (1,))
    probs = jax.nn.softmax(jnp.concatenate([logits, sink], axis=-1), axis=-1)[..., :-1]
    out = jnp.einsum('bnhgqk,bnkhd->bnqhgd', probs.astype(v.dtype), vc)
    return out.reshape(B, S, ATTN_WIDTH)


def s5_layer(u, lam_re, lam_im, log_dt, b_re, b_im, c_re, c_im, d_skip, w_glu):
    B, S, _ = u.shape
    f32 = jnp.float32
    uf = u.astype(f32).reshape(B, S, SSM_GROUPS, SSM_GROUP_CH)
    lr, li = lam_re.astype(f32), lam_im.astype(f32)
    dt = jnp.exp(log_dt.astype(f32))[:, None]
    mag = jnp.exp(lr * dt)
    a_re, a_im = mag * jnp.cos(li * dt), mag * jnp.sin(li * dt)
    den = lr * lr + li * li
    nr, ni = a_re - 1.0, a_im
    coef_re = (nr * lr + ni * li) / den
    coef_im = (ni * lr - nr * li) / den
    br, bi = b_re.astype(f32), b_im.astype(f32)
    bbar_re = coef_re[..., None] * br - coef_im[..., None] * bi
    bbar_im = coef_re[..., None] * bi + coef_im[..., None] * br
    bu_re = jnp.einsum('bsgc,gnc->bsgn', uf, bbar_re)
    bu_im = jnp.einsum('bsgc,gnc->bsgn', uf, bbar_im)
    ar = jnp.broadcast_to(a_re, bu_re.shape)
    ai = jnp.broadcast_to(a_im, bu_re.shape)

    def combine(left, right):
        a1r, a1i, b1r, b1i = left
        a2r, a2i, b2r, b2i = right
        return (a2r * a1r - a2i * a1i,
                a2r * a1i + a2i * a1r,
                a2r * b1r - a2i * b1i + b2r,
                a2r * b1i + a2i * b1r + b2i)

    _, _, xr, xi = lax.associative_scan(combine, (ar, ai, bu_re, bu_im), axis=1)
    y = (jnp.einsum('gcn,bsgn->bsgc', c_re.astype(f32), xr)
         - jnp.einsum('gcn,bsgn->bsgc', c_im.astype(f32), xi)
         + d_skip.astype(f32).reshape(SSM_GROUPS, SSM_GROUP_CH) * uf)
    y = jax.nn.gelu(y.reshape(B, S, SSM_WIDTH))
    y = y * jax.nn.sigmoid(y @ w_glu.astype(f32))
    return y.astype(u.dtype)


def memory_cross_attention(qx, mem, mem_norm, w_mem_kv, xq_norm, xk_norm):
    B, S, _ = qx.shape
    M = mem.shape[1]
    kv = rms_norm(mem, mem_norm) @ w_mem_kv
    km, vm = jnp.split(kv, 2, axis=-1)
    q = rms_norm(qx.reshape(B, S, XATTN_HEADS, XATTN_HEAD_DIM), xq_norm).astype(jnp.float32)
    km = rms_norm(km.reshape(B, M, XATTN_HEADS, XATTN_HEAD_DIM), xk_norm).astype(jnp.float32)
    vm = vm.reshape(B, M, XATTN_HEADS, XATTN_HEAD_DIM)
    logits = jnp.einsum('bshd,bmhd->bhsm', q, km) / math.sqrt(XATTN_HEAD_DIM)
    probs = jax.nn.softmax(logits, axis=-1)
    out = jnp.einsum('bhsm,bmhd->bshd', probs.astype(vm.dtype), vm)
    return out.reshape(B, S, XATTN_WIDTH)


def hierarchical_moe(h, w_router_group, w_router_expert, w_gate, w_up, w_down):
    B, S, D = h.shape
    T = B * S
    f32 = jnp.float32
    xt = h.reshape(T, D)
    g_logits = (xt @ w_router_group).astype(f32)
    g_prob = jax.nn.softmax(g_logits, axis=-1)
    g_idx = jnp.argmax(g_logits, axis=-1)
    g_gate = jnp.take_along_axis(g_prob, g_idx[:, None], axis=-1)
    e_logits = (xt @ w_router_expert).astype(f32).reshape(T, N_EXPERT_GROUPS, EXPERTS_PER_GROUP)
    e_logits = jnp.take_along_axis(e_logits, g_idx[:, None, None], axis=1)[:, 0]
    top_val, top_idx = lax.top_k(e_logits, TOP_K_INNER)
    weights = g_gate * jax.nn.softmax(top_val, axis=-1)
    expert_ids = g_idx[:, None] * EXPERTS_PER_GROUP + top_idx

    A = T * TOP_K_INNER
    flat_e = expert_ids.reshape(A).astype(jnp.int32)
    flat_tok = jnp.repeat(jnp.arange(T, dtype=jnp.int32), TOP_K_INNER)
    flat_w = weights.reshape(A)
    order = jnp.argsort(flat_e)
    sorted_e = flat_e[order]
    sorted_tok = flat_tok[order]
    counts = jnp.bincount(flat_e, length=N_EXPERTS)
    starts = jnp.cumsum(counts) - counts
    padded = ((counts + MOE_BLOCK - 1) // MOE_BLOCK) * MOE_BLOCK
    pends = jnp.cumsum(padded)
    pstarts = pends - padded
    dest = pstarts[sorted_e] + (jnp.arange(A, dtype=jnp.int32) - starts[sorted_e])
    P = A + N_EXPERTS * MOE_BLOCK
    n_blocks = P // MOE_BLOCK
    buf = jnp.zeros((P, D), xt.dtype).at[dest].set(xt[sorted_tok])
    blk_start = jnp.arange(n_blocks, dtype=jnp.int32) * MOE_BLOCK
    blk_expert = jnp.minimum(jnp.searchsorted(pends, blk_start, side='right'), N_EXPERTS - 1)

    def expert_block(args):
        xb, e = args
        return (jax.nn.silu(xb @ w_gate[e]) * (xb @ w_up[e])) @ w_down[e]

    yb = lax.map(expert_block, (buf.reshape(n_blocks, MOE_BLOCK, D), blk_expert))
    ys = yb.reshape(P, D)[dest]
    contrib = ys.astype(f32) * flat_w[order][:, None]
    out = jax.ops.segment_sum(contrib, sorted_tok, num_segments=T)
    return out.reshape(B, S, D).astype(h.dtype)


def setup_inputs(seed: int = 0) -> dict:
    key = jax.random.key(seed)
    ks = jax.random.split(key, 32)
    f32 = jnp.float32
    L = DEPTH

    def nrm(k, shape, scale):
        return jax.random.normal(k, shape, f32) * scale

    def gain(k, shape):
        return 1.0 + 0.05 * jax.random.normal(k, shape, f32)

    n_idx = jnp.arange(SSM_STATE, dtype=f32)
    gn = (L, SSM_GROUPS, SSM_STATE)
    return {
        "x": nrm(ks[0], (BATCH, SEQ, D_MODEL), 1.0),
        "mem": nrm(ks[1], (BATCH, MEM_LEN, D_MODEL), 1.0),
        "norm_mix": gain(ks[2], (L, D_MODEL)),
        "w_in": nrm(ks[3], (L, D_MODEL, IN_COLS), D_MODEL ** -0.5),
        "q_norm": gain(ks[4], (L, ATTN_HEAD_DIM)),
        "k_norm": gain(ks[5], (L, ATTN_HEAD_DIM)),
        "attn_sinks": nrm(ks[6], (L, ATTN_HEADS), 0.5),
        "rel_bias": nrm(ks[7], (REL_BUCKETS, ATTN_HEADS), 0.2),
        "ssm_lambda_re": -0.5 + nrm(ks[8], gn, 0.01),
        "ssm_lambda_im": math.pi * n_idx + nrm(ks[9], gn, 0.01),
        "ssm_log_dt": jax.random.uniform(ks[10], (L, SSM_GROUPS), f32,
                                         minval=math.log(1e-3), maxval=math.log(1e-1)),
        "ssm_b_re": nrm(ks[11], (L, SSM_GROUPS, SSM_STATE, SSM_GROUP_CH), (2 * SSM_GROUP_CH) ** -0.5),
        "ssm_b_im": nrm(ks[12], (L, SSM_GROUPS, SSM_STATE, SSM_GROUP_CH), (2 * SSM_GROUP_CH) ** -0.5),
        "ssm_c_re": nrm(ks[13], (L, SSM_GROUPS, SSM_GROUP_CH, SSM_STATE), (2 * SSM_STATE) ** -0.5),
        "ssm_c_im": nrm(ks[14], (L, SSM_GROUPS, SSM_GROUP_CH, SSM_STATE), (2 * SSM_STATE) ** -0.5),
        "ssm_d": nrm(ks[15], (L, SSM_WIDTH), 1.0),
        "ssm_w_glu": nrm(ks[16], (L, SSM_WIDTH, SSM_WIDTH), SSM_WIDTH ** -0.5),
        "mem_norm": gain(ks[17], (L, D_MODEL)),
        "w_mem_kv": nrm(ks[18], (L, D_MODEL, 2 * XATTN_WIDTH), D_MODEL ** -0.5),
        "xq_norm": gain(ks[19], (L, XATTN_HEAD_DIM)),
        "xk_norm": gain(ks[20], (L, XATTN_HEAD_DIM)),
        "out_norm_attn": gain(ks[21], (L, ATTN_WIDTH)),
        "out_norm_ssm": gain(ks[22], (L, SSM_WIDTH)),
        "out_norm_xattn": gain(ks[23], (L, XATTN_WIDTH)),
        "w_o": nrm(ks[24], (L, MIX_WIDTH, D_MODEL), MIX_WIDTH ** -0.5),
        "norm_ffn": gain(ks[25], (L, D_MODEL)),
        "w_router_group": nrm(ks[26], (L, D_MODEL, N_EXPERT_GROUPS), D_MODEL ** -0.5),
        "w_router_expert": nrm(ks[27], (L, D_MODEL, N_EXPERTS), D_MODEL ** -0.5),
        "w_gate": nrm(ks[28], (L, N_EXPERTS, D_MODEL, D_EXPERT), D_MODEL ** -0.5),
        "w_up": nrm(ks[29], (L, N_EXPERTS, D_MODEL, D_EXPERT), D_MODEL ** -0.5),
        "w_down": nrm(ks[30], (L, N_EXPERTS, D_EXPERT, D_MODEL), D_EXPERT ** -0.5),
    }


def reference(x, mem, norm_mix, w_in, q_norm, k_norm, attn_sinks, rel_bias,
              ssm_lambda_re, ssm_lambda_im, ssm_log_dt, ssm_b_re, ssm_b_im,
              ssm_c_re, ssm_c_im, ssm_d, ssm_w_glu, mem_norm, w_mem_kv,
              xq_norm, xk_norm, out_norm_attn, out_norm_ssm, out_norm_xattn, w_o,
              norm_ffn, w_router_group, w_router_expert, w_gate, w_up, w_down):
    B, S, _ = x.shape
    splits = [ATTN_WIDTH, ATTN_WIDTH + KV_WIDTH, ATTN_WIDTH + 2 * KV_WIDTH,
              ATTN_WIDTH + 2 * KV_WIDTH + SSM_WIDTH]
    for l in range(DEPTH):
        h = rms_norm(x, norm_mix[l])
        proj = h @ w_in[l]
        q, k, v, u, qx = jnp.split(proj, splits, axis=-1)

        q = rms_norm(q.reshape(B, S, ATTN_HEADS, ATTN_HEAD_DIM), q_norm[l])
        k = rms_norm(k.reshape(B, S, ATTN_KV_HEADS, ATTN_HEAD_DIM), k_norm[l])
        v = v.reshape(B, S, ATTN_KV_HEADS, ATTN_HEAD_DIM)
        y_attn = sliding_window_attention(q, k, v, attn_sinks[l], rel_bias)

        y_ssm = s5_layer(u, ssm_lambda_re[l], ssm_lambda_im[l], ssm_log_dt[l],
                         ssm_b_re[l], ssm_b_im[l], ssm_c_re[l], ssm_c_im[l],
                         ssm_d[l], ssm_w_glu[l])

        y_x = memory_cross_attention(qx, mem, mem_norm[l], w_mem_kv[l], xq_norm[l], xk_norm[l])

        mix = jnp.concatenate([rms_norm(y_attn, out_norm_attn[l]),
                               rms_norm(y_ssm, out_norm_ssm[l]),
                               rms_norm(y_x, out_norm_xattn[l])], axis=-1)
        x = x + mix @ w_o[l]

        h2 = rms_norm(x, norm_ffn[l])
        x = x + hierarchical_moe(h2, w_router_group[l], w_router_expert[l],
                                 w_gate[l], w_up[l], w_down[l])
    return x
```

```cpp
#include <hip/hip_runtime.h>
#include <cstdio>
#include <cstdint>

#ifndef MK_PER_PHASE
#define MK_PER_PHASE 0
#endif

#define GAS __attribute__((address_space(1)))
#define LAS __attribute__((address_space(3)))
typedef unsigned short bf16;
typedef unsigned v4u __attribute__((ext_vector_type(4)));
typedef unsigned v2u __attribute__((ext_vector_type(2)));
typedef float f32x4 __attribute__((ext_vector_type(4)));
typedef float f32x16 __attribute__((ext_vector_type(16)));
typedef short bf16x8 __attribute__((ext_vector_type(8)));
typedef short bf16x4 __attribute__((ext_vector_type(4)));

constexpr int T = 16384, D = 2048, SEQ = 2048, NB = 8, INC = 2304, MEML = 256;
constexpr int NPH = 15;
constexpr float EPS = 1e-6f;
constexpr int NEXP = 64, DEXP = 512, LCAP = 16384;
constexpr int S5L = 32, S5K = 640;

constexpr size_t MiB = 1u << 20;
constexpr size_t WS_CTL = 0, CTL_ZERO_BYTES = 1 * MiB;
constexpr size_t WS_WIN = 2 * MiB, WS_WO = 11 * MiB, WS_WMKV = 19 * MiB, WS_WGLU = 23 * MiB;
constexpr size_t WS_MQ = 24 * MiB, WS_SP = 44 * MiB, WS_UA = 52 * MiB, WS_SL = 72 * MiB, WS_AL = 88 * MiB, WS_WR = 89 * MiB;
constexpr size_t WS_XN = 96 * MiB;
constexpr size_t WS_MEMN = 160 * MiB, WS_MEMKV = 168 * MiB;
constexpr size_t WS_PROJ = 176 * MiB;
constexpr size_t WS_MIX = 248 * MiB;
constexpr size_t WS_Y2 = 176 * MiB;
constexpr size_t WS_G = 312 * MiB;
constexpr size_t WS_LOG = 328 * MiB;
constexpr size_t WS_LIST = 344 * MiB;
constexpr size_t WS_WTS = 348 * MiB;
constexpr size_t WS_XS = 352 * MiB;
constexpr size_t WS_ACT = 544 * MiB;
constexpr size_t WS_WGU = 592 * MiB;
constexpr size_t WS_WD = 848 * MiB;
constexpr size_t WS_END = 976 * MiB;
constexpr int CW_CNT = 1024;
constexpr int CW_BAR = 4096;

constexpr int RING_BYTES = 131072;
constexpr int TAB_OFF = 139264;
constexpr int XBW_OFF = TAB_OFF + 2048;
constexpr int LDS_BYTES = 147456;

#define LDS_WAIT() asm volatile("s_waitcnt lgkmcnt(0)" ::: "memory")
#define VM_WAIT() asm volatile("s_waitcnt vmcnt(0)" ::: "memory")
__device__ __forceinline__ unsigned f2bf(float f) { unsigned u = __builtin_bit_cast(unsigned, f); return (u + 0x7fffu + ((u >> 16) & 1u)) >> 16; }
__device__ __forceinline__ unsigned pk2(float lo, float hi) { unsigned r; asm volatile("v_cvt_pk_bf16_f32 %0, %1, %2" : "=v"(r) : "v"(lo), "v"(hi)); return r; }
__device__ __forceinline__ float bflo(unsigned w) { return __builtin_bit_cast(float, w << 16); }
__device__ __forceinline__ float bfhi(unsigned w) { return __builtin_bit_cast(float, w & 0xffff0000u); }
__device__ __forceinline__ float wave_sum(float v) {
#pragma unroll
    for (int o = 1; o < 64; o <<= 1) v += __shfl_xor(v, o);
    return v;
}
__device__ __forceinline__ float fast_exp(float x) { return __builtin_amdgcn_exp2f(x * 1.44269504089f); }
__device__ __forceinline__ float sigmoidf_(float x) { return __builtin_amdgcn_rcpf(1.0f + fast_exp(-x)); }
__device__ __forceinline__ float gelu_tanh(float x) { const float z = 1.5957691216f * (x + 0.044715f * x * x * x); return x * sigmoidf_(z); }

#define XB_TMO      128
#define XB_XCNT(j)  (256  + 64 * (j))
#define XB_XSUB(j)  (1280 + 64 * (j))
#define XB_XGEN(j)  (2304 + 64 * (j))
#define XB_TOP      3328
#define XB_TOPGEN   3392
#define XCD_BAR_WORDS 3456
#define XB_SPIN_CAP (1u << 18)
__device__ __forceinline__ unsigned xb_ld(unsigned* p)              { return __hip_atomic_load(p, __ATOMIC_RELAXED, __HIP_MEMORY_SCOPE_AGENT); }
__device__ __forceinline__ unsigned xb_add(unsigned* p, unsigned v) { return __hip_atomic_fetch_add(p, v, __ATOMIC_RELAXED, __HIP_MEMORY_SCOPE_AGENT); }
__device__ __forceinline__ unsigned xb_xcc_id() { return (unsigned)__builtin_amdgcn_s_getreg((3 << 11) | 20) & 0xFu; }
#define XB_SPIN(cond, bar) do { unsigned _sp = 0; while (cond) { __builtin_amdgcn_s_sleep(1); \
    if ((++_sp & 255u) == 0u) { if (xb_ld(&(bar)[XB_TMO])) break; if (_sp > XB_SPIN_CAP) { atomicAdd(&(bar)[XB_TMO], 1u); break; } } } } while (0)
struct XcdBarrier { unsigned* bar; unsigned x; volatile LAS unsigned* st; };
__device__ __forceinline__ XcdBarrier xcd_barrier_post(unsigned* bar, volatile LAS unsigned* st) {
    XcdBarrier b; b.bar = bar; b.x = xb_xcc_id(); b.st = st;
    if (threadIdx.x == 0) (void)xb_add(&bar[XB_XCNT(b.x)], 1u);
    return b;
}
__device__ __forceinline__ void xcd_barrier_complete(unsigned* bar, unsigned x, unsigned& nloc, unsigned& nx) {
    const unsigned G = gridDim.x * gridDim.y * gridDim.z;
    unsigned sum, cnt, mine, sp = 0u;
    for (;;) {
        sum = 0u; cnt = 0u; mine = 0u;
#pragma unroll
        for (unsigned j = 0; j < 16; ++j) { const unsigned c = xb_ld(&bar[XB_XCNT(j)]); sum += c; cnt += (c > 0u) ? 1u : 0u; mine = (j == x) ? c : mine; }
        if (sum == G) break;
        __builtin_amdgcn_s_sleep(1);
        if ((++sp & 255u) == 0u) { if (xb_ld(&bar[XB_TMO])) break; if (sp > XB_SPIN_CAP) { atomicAdd(&bar[XB_TMO], 1u); break; } }
    }
    nloc = mine > 0u ? mine : 1u; nx = cnt > 0u ? cnt : 1u;
}
__device__ __forceinline__ void xcd_barrier(const XcdBarrier& b) {
    asm volatile("s_waitcnt vmcnt(0)" ::: "memory");
    __syncthreads();
    if (threadIdx.x == 0) {
        unsigned* bar = b.bar;
        __builtin_amdgcn_s_waitcnt(0);
        unsigned nloc = b.st[0], nx = b.st[1];
        if (nloc == 0u) { xcd_barrier_complete(bar, b.x, nloc, nx); b.st[0] = nloc; b.st[1] = nx; }
        const unsigned old = xb_add(&bar[XB_XSUB(b.x)], 1u);
        const unsigned gen = old / nloc;
        if (old + 1u == (gen + 1u) * nloc) {
            __builtin_amdgcn_fence(__ATOMIC_RELEASE, "agent");
            asm volatile("s_waitcnt vmcnt(0)" ::: "memory");
            const unsigned og = xb_add(&bar[XB_TOP], 1u);
            const unsigned tg = og / nx;
            if (og + 1u == (tg + 1u) * nx) xb_add(&bar[XB_TOPGEN], 1u);
            else XB_SPIN(xb_ld(&bar[XB_TOPGEN]) == tg, bar);
            __builtin_amdgcn_fence(__ATOMIC_ACQUIRE, "agent");
            xb_add(&bar[XB_XGEN(b.x)], 1u);
            asm volatile("s_waitcnt vmcnt(0)" ::: "memory");
        } else {
            XB_SPIN(xb_ld(&bar[XB_XGEN(b.x)]) == gen, bar);
            __builtin_amdgcn_fence(__ATOMIC_ACQUIRE, "agent");
            asm volatile("s_waitcnt vmcnt(0)" ::: "memory");
        }
    }
    __syncthreads();
}

namespace pg8 {
constexpr int BM = 256, BK = 64, HALF = 128, HTB = HALF * BK * 2, STAGE_BYTES = 8 * HTB, NXCD = 8, WGM = 8;
__host__ __device__ __forceinline__ int lds_byte(int r, int c) { const int st = (r >> 4) * 2 + (c >> 5), rr = r & 15, cc = c & 31, ob = rr * 64 + cc * 2; return st * 1024 + (ob ^ (((ob >> 9) & 1) << 5)); }
__host__ __device__ __forceinline__ void stage_rc(int b, int& R, int& C) { const int st = b / 1024, sb = b % 1024, swz = sb ^ (((sb >> 9) & 1) << 5); R = (st >> 1) * 16 + swz / 64; C = (st & 1) * 32 + (swz % 64) / 2; }
__host__ __device__ __forceinline__ int perm32(int rho) { const int n = rho >> 4, i = rho & 15; return 8 * (i >> 2) + 4 * n + (i & 3); }

struct Unit { const char* a; const char* b; int r0, c0, aux; };
struct Gemm { int lda, ldb, K; };

struct DenseOrder {
    const char* A; const char* Bt; int lda, ldb, nM, nN, nwg, G, c;
    __device__ void init(const void* A_, const void* Bt_, int lda_, int ldb_, int M, int N, int G_, int c_) { A = (const char*)A_; Bt = (const char*)Bt_; lda = lda_; ldb = ldb_; nM = M / BM; nN = N / BM; nwg = nM * nN; G = G_; c = c_; }
    __device__ bool next(int i, Unit& u) const {
        const long L = (long)i * G + c; if (L >= nwg) return false;
        int wgid = (int)L; { const int q = nwg / NXCD, r = nwg % NXCD, xcd = wgid % NXCD, off = wgid / NXCD; wgid = (xcd < r ? xcd * (q + 1) : r * (q + 1) + (xcd - r) * q) + off; }
        const int nig = WGM * nN, gid = wgid / nig, fm = gid * WGM, gsz = (nM - fm) < WGM ? (nM - fm) : WGM;
        const int pm = fm + ((wgid % nig) % gsz), pn = (wgid % nig) / gsz;
        u.a = A + (size_t)pm * BM * lda * 2; u.b = Bt + (size_t)pn * BM * ldb * 2; u.r0 = pm * BM; u.c0 = pn * BM; u.aux = 0; return true;
    }
};
struct GroupOrder {
    const char* A; const char* Bt; int lda, ldb, nN, ngrp, G, c;
    __device__ bool next(int i, Unit& u) const {
        const int L = i * G + c; if (L >= ngrp * 2 * nN) return false;
        const int g = L / (2 * nN), q = L % (2 * nN), pn = q >> 1, pm = q & 1;
        u.a = A + ((size_t)g * 512 + pm * BM) * lda * 2; u.b = Bt + ((size_t)g * nN + pn) * BM * ldb * 2; u.r0 = pm * BM; u.c0 = pn * BM; u.aux = g; return true;
    }
};
struct MoeOrder {
    const char* A; const char* Bt; const LAS int* ts; int lda, ldb, nct, brows, G, c; bool rel;
    __device__ bool next(int i, Unit& u) const {
        const int L = i * G + c; const int lane = threadIdx.x & 63;
        if (L >= ts[64] * nct) return false;
        const int lo = ts[lane] * nct, hi = ts[lane + 1] * nct;
        const unsigned long long m = __ballot(lo <= L && L < hi);
        const int e = __builtin_amdgcn_readfirstlane((int)__builtin_ctzll(m));
        const int tse = ts[e], ne = ts[e + 1] - tse, q = L - tse * nct, ct = q / ne, rt = q % ne;
        u.a = A + (size_t)(tse + rt) * BM * lda * 2; u.b = Bt + ((size_t)e * brows + (size_t)ct * BM) * ldb * 2;
        u.r0 = rel ? rt * BM : (tse + rt) * BM; u.c0 = ct; u.aux = e; return true;
    }
};

#define EPI_ROWS_COLS() const int rowb = wr * 64 + fr; (void)rowb;

template <class Epi, class Sched, bool ALIGN_EPI = true, bool SP2 = true>
__device__ __forceinline__ void gemm_phase(LAS unsigned char* lds, const Gemm g, const Sched& S, const Epi& E) {
    const int tid = threadIdx.x, wid = __builtin_amdgcn_readfirstlane(tid >> 6), lane = tid & 63, wr = wid >> 2, wc = wid & 3, fr = lane & 15, fq = lane >> 4;
    const int K = g.K, nt = K / BK;
    unsigned voffA[2], voffB[2];
#pragma unroll
    for (int i = 0; i < 2; ++i) { int R, C; stage_rc(tid * 16 + i * 8192, R, C); const int Rb = Epi::PERM ? ((R & ~31) + perm32(R & 31)) : R;
        voffA[i] = (unsigned)(R * g.lda + C) * 2u; voffB[i] = (unsigned)(Rb * g.ldb + C) * 2u; }
    const size_t kstep = (size_t)(BK * 2);
    const size_t hstepA = (size_t)HALF * g.lda * 2, hstepB = (size_t)HALF * g.ldb * 2;
    const unsigned ldsw = (unsigned)wid * 1024u;
    const int aoff = lds_byte(wr * 64 + fr, fq * 8), boff = lds_byte(wc * 32 + fr, fq * 8);
#define PG8_SA(b, h) (((b) * 2 + (h)) * HTB)
#define PG8_SB(b, h) ((4 + (b) * 2 + (h)) * HTB)
#define PG8_STAGE(bufoff, gbase, voff) do { _Pragma("unroll") for (int _i = 0; _i < 2; ++_i) \
        __builtin_amdgcn_global_load_lds((const unsigned*)((const char*)(gbase) + (voff)[_i]), (LAS unsigned*)(lds + (bufoff) + ldsw + _i * 8192), 16, 0, 0); } while (0)
#define PG8_LDA(dst, b, h) do { _Pragma("unroll") for (int m = 0; m < 4; ++m) _Pragma("unroll") for (int k = 0; k < 2; ++k) dst[m][k] = *(const LAS bf16x8*)(lds + PG8_SA(b, h) + aoff + m * 2048 + k * 1024); } while (0)
#define PG8_LDB(dst, b, h) do { _Pragma("unroll") for (int n = 0; n < 2; ++n) _Pragma("unroll") for (int k = 0; k < 2; ++k) dst[n][k] = *(const LAS bf16x8*)(lds + PG8_SB(b, h) + boff + n * 2048 + k * 1024); } while (0)
#define PG8_MMA(ai, bj, At, Bt) do { __builtin_amdgcn_s_setprio(1); _Pragma("unroll") for (int m = 0; m < 4; ++m) _Pragma("unroll") for (int n = 0; n < 2; ++n) _Pragma("unroll") for (int k = 0; k < 2; ++k) \
        acc[ai][bj][m][n] = __builtin_amdgcn_mfma_f32_16x16x32_bf16(Bt[n][k], At[m][k], acc[ai][bj][m][n], 0, 0, 0); __builtin_amdgcn_s_setprio(0); } while (0)
#define PG8_WAIT_V(n) asm volatile("s_waitcnt vmcnt(" #n ")" ::: "memory")
#define PG8_WAIT_L(n) asm volatile("s_waitcnt lgkmcnt(" #n ")" ::: "memory")
#define PG8_BAR __builtin_amdgcn_s_barrier()
#define PG8_SCHED __builtin_amdgcn_sched_barrier(0)
    Unit cur, nxt; int ui = 0;
    if (!S.next(0, cur)) return;
    f32x4 acc[2][2][4][2];
#pragma unroll
    for (int a = 0; a < 2; ++a)
#pragma unroll
        for (int b = 0; b < 2; ++b)
#pragma unroll
            for (int m = 0; m < 4; ++m)
#pragma unroll
                for (int n = 0; n < 2; ++n) acc[a][b][m][n] = (f32x4){0.f, 0.f, 0.f, 0.f};
    bf16x8 At[4][2], B0[2][2], B1[2][2];
    const char* cA = cur.a; const char* cB = cur.b;
    if constexpr (SP2) {
        PG8_STAGE(PG8_SB(0, 0), cB, voffB); PG8_STAGE(PG8_SB(0, 1), cB + hstepB, voffB); PG8_STAGE(PG8_SA(0, 0), cA, voffA); PG8_STAGE(PG8_SA(0, 1), cA + hstepA, voffA);
        if (wr == 1) PG8_BAR;
        PG8_WAIT_V(2); PG8_BAR;
        PG8_STAGE(PG8_SB(1, 0), cB + kstep, voffB); PG8_STAGE(PG8_SA(1, 0), cA + kstep, voffA); PG8_STAGE(PG8_SB(1, 1), cB + hstepB + kstep, voffB);
        PG8_WAIT_V(6); PG8_BAR;
    } else {
        PG8_STAGE(PG8_SB(0, 0), cB, voffB); PG8_STAGE(PG8_SA(0, 0), cA, voffA); PG8_STAGE(PG8_SB(0, 1), cB + hstepB, voffB); PG8_STAGE(PG8_SA(0, 1), cA + hstepA, voffA);
        if (wr == 1) PG8_BAR;
        PG8_WAIT_V(4); PG8_BAR;
        PG8_STAGE(PG8_SB(1, 0), cB + kstep, voffB); PG8_STAGE(PG8_SA(1, 0), cA + kstep, voffA); PG8_STAGE(PG8_SB(1, 1), cB + hstepB + kstep, voffB);
        PG8_WAIT_V(6); PG8_BAR;
    }
    for (;;) {
        const bool has_next = S.next(ui + 1, nxt);
        const char* nA = has_next ? nxt.a : cA; const char* nB = has_next ? nxt.b : cB;
        for (int t = 0; t < nt; t += 2) {
            const bool last = (t == nt - 2);
            const char* a1 = cA + (size_t)(t + 1) * kstep;
            const char* a2 = last ? nA : cA + (size_t)(t + 2) * kstep; const char* b2 = last ? nB : cB + (size_t)(t + 2) * kstep;
            const char* a3 = a2 + kstep; const char* b3 = b2 + kstep;
            if constexpr (SP2) {
            PG8_LDB(B0, 0, 0); PG8_LDB(B1, 0, 1); PG8_SCHED; PG8_LDA(At, 0, 0); PG8_STAGE(PG8_SA(1, 1), a1 + hstepA, voffA);
            PG8_WAIT_V(8); PG8_WAIT_L(0); PG8_BAR; PG8_MMA(0, 0, At, B0); PG8_MMA(0, 1, At, B1); PG8_BAR; PG8_SCHED;
            PG8_LDA(At, 0, 1); PG8_STAGE(PG8_SB(0, 0), b2, voffB); PG8_STAGE(PG8_SB(0, 1), b2 + hstepB, voffB); PG8_STAGE(PG8_SA(0, 0), a2, voffA);
            PG8_WAIT_V(8); PG8_WAIT_L(0); PG8_BAR; PG8_MMA(1, 0, At, B0); PG8_MMA(1, 1, At, B1); PG8_BAR; PG8_SCHED;
            PG8_LDB(B0, 1, 0); PG8_LDB(B1, 1, 1); PG8_SCHED; PG8_LDA(At, 1, 0); PG8_STAGE(PG8_SA(0, 1), a2 + hstepA, voffA);
            PG8_WAIT_V(8); PG8_WAIT_L(0); PG8_BAR; PG8_MMA(0, 0, At, B0); PG8_MMA(0, 1, At, B1); PG8_BAR; PG8_SCHED;
            PG8_LDA(At, 1, 1); PG8_STAGE(PG8_SB(1, 0), b3, voffB); PG8_STAGE(PG8_SB(1, 1), b3 + hstepB, voffB); PG8_STAGE(PG8_SA(1, 0), a3, voffA);
            PG8_WAIT_V(8); PG8_WAIT_L(0); PG8_BAR; PG8_MMA(1, 0, At, B0); PG8_MMA(1, 1, At, B1); PG8_BAR; PG8_SCHED;
            } else {
            PG8_LDB(B0, 0, 0); PG8_SCHED; PG8_LDA(At, 0, 0); PG8_STAGE(PG8_SA(1, 1), a1 + hstepA, voffA);
            PG8_WAIT_L(8); PG8_BAR; PG8_WAIT_L(0); PG8_MMA(0, 0, At, B0); PG8_BAR; PG8_SCHED;
            PG8_LDB(B1, 0, 1); PG8_STAGE(PG8_SB(0, 0), b2, voffB);
            PG8_BAR; PG8_WAIT_L(0); PG8_MMA(0, 1, At, B1); PG8_BAR;
            PG8_LDA(At, 0, 1); PG8_STAGE(PG8_SA(0, 0), a2, voffA);
            PG8_BAR; PG8_WAIT_L(0); PG8_MMA(1, 0, At, B0); PG8_BAR; PG8_SCHED;
            PG8_STAGE(PG8_SB(0, 1), b2 + hstepB, voffB);
            PG8_WAIT_V(6); PG8_BAR; PG8_MMA(1, 1, At, B1); PG8_BAR;
            PG8_LDB(B0, 1, 0); PG8_SCHED; PG8_LDA(At, 1, 0); PG8_STAGE(PG8_SA(0, 1), a2 + hstepA, voffA);
            PG8_WAIT_L(8); PG8_BAR; PG8_WAIT_L(0); PG8_MMA(0, 0, At, B0); PG8_BAR; PG8_SCHED;
            PG8_LDB(B1, 1, 1); PG8_STAGE(PG8_SB(1, 0), b3, voffB);
            PG8_BAR; PG8_WAIT_L(0); PG8_MMA(0, 1, At, B1); PG8_BAR;
            PG8_LDA(At, 1, 1); PG8_STAGE(PG8_SA(1, 0), a3, voffA);
            PG8_BAR; PG8_WAIT_L(0); PG8_MMA(1, 0, At, B0); PG8_BAR; PG8_SCHED;
            PG8_STAGE(PG8_SB(1, 1), b3 + hstepB, voffB);
            PG8_WAIT_V(6); PG8_BAR; PG8_MMA(1, 1, At, B1); PG8_BAR;
            }
        }
        if constexpr (ALIGN_EPI) { if (wr == 0) PG8_BAR; }
        E(acc, cur, wr, wc, fr, fq);
        if (!has_next) break;
#pragma unroll
        for (int a = 0; a < 2; ++a)
#pragma unroll
            for (int b = 0; b < 2; ++b)
#pragma unroll
                for (int m = 0; m < 4; ++m)
#pragma unroll
                    for (int n = 0; n < 2; ++n) acc[a][b][m][n] = (f32x4){0.f, 0.f, 0.f, 0.f};
        cur = nxt; cA = nA; cB = nB; ++ui;
        if constexpr (ALIGN_EPI) { if (wr == 1) PG8_BAR; }
    }
    PG8_WAIT_V(0);
    if constexpr (!ALIGN_EPI) { if (wr == 0) PG8_BAR; }
    PG8_BAR;
#undef PG8_SA
#undef PG8_SB
#undef PG8_STAGE
#undef PG8_LDA
#undef PG8_LDB
#undef PG8_MMA
#undef PG8_WAIT_V
#undef PG8_WAIT_L
#undef PG8_BAR
#undef PG8_SCHED
}

typedef const f32x4 (&AccRef)[2][2][4][2];
__device__ __forceinline__ v4u pack8(const f32x4 a, const f32x4 b) { v4u w; w.x = pk2(a[0], a[1]); w.y = pk2(a[2], a[3]); w.z = pk2(b[0], b[1]); w.w = pk2(b[2], b[3]); return w; }

struct EpiProj {
    static constexpr bool PERM = true;
    bf16* PROJ; bf16* UA;
    __device__ __forceinline__ void operator()(AccRef acc, const Unit& u, int wr, int wc, int fr, int fq) const {
        const int row0 = u.r0 + wr * 64 + fr, colb = u.c0 + wc * 32 + 8 * fq;
        const bool isu = (u.c0 == 1280 || u.c0 == 1536);
#pragma unroll
        for (int ai = 0; ai < 2; ++ai)
#pragma unroll
            for (int m = 0; m < 4; ++m) { const int row = row0 + ai * HALF + m * 16;
#pragma unroll
                for (int bj = 0; bj < 2; ++bj) { const int col = colb + bj * HALF; const v4u w = pack8(acc[ai][bj][m][0], acc[ai][bj][m][1]);
                    if (!isu) *(v4u*)(PROJ + (size_t)row * INC + col) = w;
                    else { const int cc = col - 1280, g = cc >> 4, c0 = cc & 15; *(v4u*)(UA + ((size_t)(g * 512 + (row >> 5)) * S5K + (row & 31) * 16 + c0)) = w; } } }
    }
};
struct EpiBf16 {
    static constexpr bool PERM = true;
    bf16* O; int ldc;
    __device__ __forceinline__ void operator()(AccRef acc, const Unit& u, int wr, int wc, int fr, int fq) const {
        const int row0 = u.r0 + wr * 64 + fr, colb = u.c0 + wc * 32 + 8 * fq;
#pragma unroll
        for (int ai = 0; ai < 2; ++ai)
#pragma unroll
            for (int m = 0; m < 4; ++m) { bf16* rowp = O + (size_t)(row0 + ai * HALF + m * 16) * ldc + colb;
#pragma unroll
                for (int bj = 0; bj < 2; ++bj) *(v4u*)(rowp + bj * HALF) = pack8(acc[ai][bj][m][0], acc[ai][bj][m][1]); }
    }
};
struct EpiF32 {
    static constexpr bool PERM = false;
    float* C; int ldc; size_t gstride;
    __device__ __forceinline__ void operator()(AccRef acc, const Unit& u, int wr, int wc, int fr, int fq) const {
        const int row0 = u.r0 + wr * 64 + fr, col0 = u.c0 + wc * 32 + 4 * fq; float* base = C + (size_t)u.aux * gstride;
#pragma unroll
        for (int ai = 0; ai < 2; ++ai)
#pragma unroll
            for (int m = 0; m < 4; ++m) { float* rowp = base + (size_t)(row0 + ai * HALF + m * 16) * ldc + col0;
#pragma unroll
                for (int bj = 0; bj < 2; ++bj)
#pragma unroll
                    for (int n = 0; n < 2; ++n) *(f32x4*)(rowp + bj * HALF + n * 16) = acc[ai][bj][m][n]; }
    }
};
struct EpiS5Y {
    static constexpr bool PERM = true;
    const bf16* UA; const float* dsk; bf16* Gm;
    __device__ __forceinline__ void operator()(AccRef acc, const Unit& u, int wr, int wc, int fr, int fq) const {
        const int row0 = u.r0 + wr * 64 + fr, colb = u.c0 + wc * 32 + 8 * fq, g = u.aux;
#pragma unroll
        for (int ai = 0; ai < 2; ++ai)
#pragma unroll
            for (int m = 0; m < 4; ++m) { const int row = row0 + ai * HALF + m * 16;
#pragma unroll
                for (int bj = 0; bj < 2; ++bj) { const int col = colb + bj * HALF, i = col >> 4, c0 = col & 15;
                    const v4u uw = *(const v4u*)(UA + ((size_t)(g * 512 + row) * S5K + col));
                    const f32x4 d0 = *(const f32x4*)(dsk + g * 16 + c0), d1 = *(const f32x4*)(dsk + g * 16 + c0 + 4);
                    const f32x4 a0 = acc[ai][bj][m][0], a1 = acc[ai][bj][m][1];
                    f32x4 y0, y1;
                    y0[0] = gelu_tanh(a0[0] + d0[0] * bflo(uw.x)); y0[1] = gelu_tanh(a0[1] + d0[1] * bfhi(uw.x)); y0[2] = gelu_tanh(a0[2] + d0[2] * bflo(uw.y)); y0[3] = gelu_tanh(a0[3] + d0[3] * bfhi(uw.y));
                    y1[0] = gelu_tanh(a1[0] + d1[0] * bflo(uw.z)); y1[1] = gelu_tanh(a1[1] + d1[1] * bfhi(uw.z)); y1[2] = gelu_tanh(a1[2] + d1[2] * bflo(uw.w)); y1[3] = gelu_tanh(a1[3] + d1[3] * bfhi(uw.w));
                    *(v4u*)(Gm + ((size_t)row * 32 + i) * 512 + g * 16 + c0) = pack8(y0, y1); } }
    }
};
struct EpiGlu {
    static constexpr bool PERM = true;
    const bf16* Gm; bf16* MIX;
    __device__ __forceinline__ void operator()(AccRef acc, const Unit& u, int wr, int wc, int fr, int fq) const {
        const int row0 = u.r0 + wr * 64 + fr, colb = u.c0 + wc * 32 + 8 * fq;
#pragma unroll
        for (int ai = 0; ai < 2; ++ai)
#pragma unroll
            for (int m = 0; m < 4; ++m) { const int row = row0 + ai * HALF + m * 16;
#pragma unroll
                for (int bj = 0; bj < 2; ++bj) { const int col = colb + bj * HALF;
                    const v4u gw = *(const v4u*)(Gm + (size_t)row * 512 + col);
                    const f32x4 a0 = acc[ai][bj][m][0], a1 = acc[ai][bj][m][1];
                    f32x4 y0, y1;
                    y0[0] = bflo(gw.x) * sigmoidf_(a0[0]); y0[1] = bfhi(gw.x) * sigmoidf_(a0[1]); y0[2] = bflo(gw.y) * sigmoidf_(a0[2]); y0[3] = bfhi(gw.y) * sigmoidf_(a0[3]);
                    y1[0] = bflo(gw.z) * sigmoidf_(a1[0]); y1[1] = bfhi(gw.z) * sigmoidf_(a1[1]); y1[2] = bflo(gw.w) * sigmoidf_(a1[2]); y1[3] = bfhi(gw.w) * sigmoidf_(a1[3]);
                    *(v4u*)(MIX + (size_t)row * D + 1024 + col) = pack8(y0, y1); } }
    }
};
struct EpiWo {
    static constexpr bool PERM = false;
    const float* X; float* O;
    __device__ __forceinline__ void operator()(AccRef acc, const Unit& u, int wr, int wc, int fr, int fq) const {
        const int row0 = u.r0 + wr * 64 + fr, col0 = u.c0 + wc * 32 + 4 * fq;
#pragma unroll
        for (int ai = 0; ai < 2; ++ai)
#pragma unroll
            for (int m = 0; m < 4; ++m) { const size_t off = (size_t)(row0 + ai * HALF + m * 16) * D + col0;
#pragma unroll
                for (int bj = 0; bj < 2; ++bj)
#pragma unroll
                    for (int n = 0; n < 2; ++n) *(f32x4*)(O + off + bj * HALF + n * 16) = *(const f32x4*)(X + off + bj * HALF + n * 16) + acc[ai][bj][m][n]; }
    }
};
struct EpiGU {
    static constexpr bool PERM = true;
    bf16* ACT;
    __device__ __forceinline__ void operator()(AccRef acc, const Unit& u, int wr, int wc, int fr, int fq) const {
        const int row0 = u.r0 + wr * 64 + fr, colb = u.c0 * 128 + wc * 32 + 8 * fq;
#pragma unroll
        for (int ai = 0; ai < 2; ++ai)
#pragma unroll
            for (int m = 0; m < 4; ++m) { const int row = row0 + ai * HALF + m * 16;
                f32x4 y0, y1;
#pragma unroll
                for (int j = 0; j < 4; ++j) { const float g0 = acc[ai][0][m][0][j], g1 = acc[ai][0][m][1][j];
                    y0[j] = g0 * sigmoidf_(g0) * acc[ai][1][m][0][j]; y1[j] = g1 * sigmoidf_(g1) * acc[ai][1][m][1][j]; }
                *(v4u*)(ACT + (size_t)row * DEXP + colb) = pack8(y0, y1); }
    }
};
struct EpiDown {
    static constexpr bool PERM = true;
    const int* list; const float* wts; const LAS int* cnt; bf16* Y2;
    __device__ __forceinline__ void operator()(AccRef acc, const Unit& u, int wr, int wc, int fr, int fq) const {
        const int e = u.aux, n = cnt[e], row0 = u.r0 + wr * 64 + fr, colb = u.c0 * 256 + wc * 32 + 8 * fq;
#pragma unroll
        for (int ai = 0; ai < 2; ++ai)
#pragma unroll
            for (int m = 0; m < 4; ++m) { const int r = row0 + ai * HALF + m * 16;
                if (r < n) { const int ent = list[(size_t)e * LCAP + r]; const float w = wts[ent]; bf16* rowp = Y2 + (size_t)ent * D + colb;
#pragma unroll
                    for (int bj = 0; bj < 2; ++bj) *(v4u*)(rowp + bj * HALF) = pack8(acc[ai][bj][m][0] * w, acc[ai][bj][m][1] * w); } }
    }
};
}

struct Frame {
    LAS unsigned char* lds;
    unsigned* ctl;
    int tid, lane, wave, vcu, G;
    const float* in[31]; float* out; unsigned char* ws;
};
enum { I_X = 0, I_MEM, I_NORM_MIX, I_W_IN, I_Q_NORM, I_K_NORM, I_SINKS, I_REL_BIAS, I_LAM_RE, I_LAM_IM, I_LOG_DT, I_B_RE, I_B_IM, I_C_RE, I_C_IM, I_SSM_D, I_W_GLU,
       I_MEM_NORM, I_W_MEM_KV, I_XQ_NORM, I_XK_NORM, I_ON_ATTN, I_ON_SSM, I_ON_X, I_W_O, I_NORM_FFN, I_WR_G, I_WR_E, I_W_GATE, I_W_UP, I_W_DOWN };

__device__ __forceinline__ void tr_item(const float* W, int ldw, bf16* WT, int ldt, int k0, int n0, int drow0, LAS float* scr, int lane) {
#pragma unroll 8
    for (int i = 0; i < 32; ++i) { const int kk = 2 * i + (lane >> 5); scr[kk * 33 + (lane & 31)] = W[(size_t)(k0 + kk) * ldw + n0 + (lane & 31)]; }
    LDS_WAIT(); asm volatile("" ::: "memory");
    const int c = lane & 7;
#pragma unroll
    for (int j = 0; j < 4; ++j) { const int n = (lane >> 3) + 8 * j; const LAS float* s = scr + (8 * c) * 33 + n;
        v4u o; o.x = pk2(s[0 * 33], s[1 * 33]); o.y = pk2(s[2 * 33], s[3 * 33]); o.z = pk2(s[4 * 33], s[5 * 33]); o.w = pk2(s[6 * 33], s[7 * 33]);
        *(v4u*)(WT + (size_t)(drow0 + n) * ldt + k0 + 8 * c) = o; }
    LDS_WAIT(); asm volatile("" ::: "memory");
}
__device__ __forceinline__ void rms_row_to_bf16(const float* xrow, const float* gain, bf16* orow, int lane) {
    const f32x4* xr = (const f32x4*)xrow + lane; const f32x4* gr = (const f32x4*)gain + lane;
    f32x4 v[8]; float s = 0.f;
#pragma unroll
    for (int j = 0; j < 8; ++j) { v[j] = xr[64 * j]; s += (v[j].x * v[j].x + v[j].y * v[j].y) + (v[j].z * v[j].z + v[j].w * v[j].w); }
    const float rstd = 1.0f / sqrtf(wave_sum(s) * (1.f / 2048.f) + EPS);
    v2u* o8 = (v2u*)orow + lane;
#pragma unroll
    for (int j = 0; j < 8; ++j) { const f32x4 g = gr[64 * j]; v2u w; w.x = pk2(v[j].x * rstd * g.x, v[j].y * rstd * g.y); w.y = pk2(v[j].z * rstd * g.z, v[j].w * rstd * g.w); o8[64 * j] = w; }
}

__device__ __forceinline__ void s5_tables(Frame& F, int g) {
    LAS float* ap = (LAS float*)F.lds;
    LAS float* Bb = ap + 33 * 64 * 2;
    LAS float* Cc = Bb + 64 * 16 * 2;
    LAS float* Km = Cc + 16 * 64 * 2;
    const float dt = expf(F.in[I_LOG_DT][g]);
    const float* lre = F.in[I_LAM_RE] + g * 64; const float* lim = F.in[I_LAM_IM] + g * 64;
    for (int idx = F.tid; idx < 33 * 64; idx += 512) { const int tau = idx >> 6, n = idx & 63; const float lr = lre[n], li = lim[n];
        const float mag = expf((float)tau * (lr * dt)), ang = (float)tau * (li * dt); ap[idx * 2] = mag * cosf(ang); ap[idx * 2 + 1] = mag * sinf(ang); }
    __syncthreads();
    for (int idx = F.tid; idx < 64 * 16; idx += 512) { const int n = idx >> 4; const float lr = lre[n], li = lim[n];
        const float nr = ap[(64 + n) * 2] - 1.0f, ni = ap[(64 + n) * 2 + 1], den = lr * lr + li * li;
        const float cr = (nr * lr + ni * li) / den, ci = (ni * lr - nr * li) / den;
        const float br = F.in[I_B_RE][(size_t)g * 1024 + idx], bi = F.in[I_B_IM][(size_t)g * 1024 + idx];
        Bb[idx * 2] = cr * br - ci * bi; Bb[idx * 2 + 1] = cr * bi + ci * br; }
    for (int idx = F.tid; idx < 16 * 64; idx += 512) { Cc[idx * 2] = F.in[I_C_RE][(size_t)g * 1024 + idx]; Cc[idx * 2 + 1] = F.in[I_C_IM][(size_t)g * 1024 + idx]; }
    __syncthreads();
    for (int idx = F.tid; idx < 32 * 256; idx += 512) { const int tau = idx >> 8, c = (idx >> 4) & 15, c2 = idx & 15; float s = 0.f;
        for (int n = 0; n < 64; ++n) { const float ar = ap[(tau * 64 + n) * 2], ai = ap[(tau * 64 + n) * 2 + 1], cr = Cc[(c * 64 + n) * 2], ci = Cc[(c * 64 + n) * 2 + 1];
            const float er = cr * ar - ci * ai, ei = cr * ai + ci * ar; s += er * Bb[(n * 16 + c2) * 2] - ei * Bb[(n * 16 + c2) * 2 + 1]; }
        Km[idx] = s; }
    __syncthreads();
    bf16* MQ = (bf16*)(F.ws + WS_MQ) + (size_t)g * 512 * S5K;
    for (int idx = F.tid; idx < 512 * 80; idx += 512) { const int row = idx / 80, ch = idx % 80, i = row >> 4, c = row & 15, k0 = ch * 8; float v[8];
        if (k0 < 512) { const int s = k0 >> 4, c20 = k0 & 15, tau = i - s;
#pragma unroll
            for (int j = 0; j < 8; ++j) v[j] = tau >= 0 ? Km[(tau * 16 + c) * 16 + c20 + j] : 0.f;
        } else { const int kk = k0 - 512, ri = kk >> 6, n0 = kk & 63;
#pragma unroll
            for (int j = 0; j < 8; ++j) { const int n = n0 + j; const float ar = ap[((i + 1) * 64 + n) * 2], ai = ap[((i + 1) * 64 + n) * 2 + 1], cr = Cc[(c * 64 + n) * 2], ci = Cc[(c * 64 + n) * 2 + 1];
                v[j] = ri == 0 ? (cr * ar - ci * ai) : -(cr * ai + ci * ar); } }
        v4u o; o.x = pk2(v[0], v[1]); o.y = pk2(v[2], v[3]); o.z = pk2(v[4], v[5]); o.w = pk2(v[6], v[7]);
        *(v4u*)(MQ + (size_t)row * S5K + k0) = o; }
    bf16* SP = (bf16*)(F.ws + WS_SP) + (size_t)g * 256 * 512;
    for (int idx = F.tid; idx < 256 * 64; idx += 512) { const int row = idx >> 6, k0 = (idx & 63) * 8; float v[8];
        if (row < 128) { const int ri = row >> 6, n = row & 63, s = k0 >> 4, c20 = k0 & 15; const float ar = ap[((31 - s) * 64 + n) * 2], ai = ap[((31 - s) * 64 + n) * 2 + 1];
#pragma unroll
            for (int j = 0; j < 8; ++j) { const float br = Bb[(n * 16 + c20 + j) * 2], bi = Bb[(n * 16 + c20 + j) * 2 + 1]; v[j] = ri == 0 ? (ar * br - ai * bi) : (ar * bi + ai * br); }
        } else {
#pragma unroll
            for (int j = 0; j < 8; ++j) v[j] = 0.f; }
        v4u o; o.x = pk2(v[0], v[1]); o.y = pk2(v[2], v[3]); o.z = pk2(v[4], v[5]); o.w = pk2(v[6], v[7]);
        *(v4u*)(SP + (size_t)row * 512 + k0) = o; }
    float* AL = (float*)(F.ws + WS_AL) + g * 128;
    if (F.tid < 64) { AL[F.tid * 2] = ap[(32 * 64 + F.tid) * 2]; AL[F.tid * 2 + 1] = ap[(32 * 64 + F.tid) * 2 + 1]; }
    __syncthreads();
}

__device__ __forceinline__ void p0_prologue(Frame& F) {
    if (F.vcu < 32) s5_tables(F, F.vcu);
    LAS float* scr = (LAS float*)(F.lds + F.wave * 16384);
    const int gw = F.vcu * 8 + F.wave, NGW = F.G * 8;
    bf16* WinT = (bf16*)(F.ws + WS_WIN); bf16* WoT = (bf16*)(F.ws + WS_WO); bf16* WmkvT = (bf16*)(F.ws + WS_WMKV); bf16* WgluT = (bf16*)(F.ws + WS_WGLU);
    bf16* WguT = (bf16*)(F.ws + WS_WGU); bf16* WdT = (bf16*)(F.ws + WS_WD);
    constexpr int I_IN = 32 * 72, I_O = 32 * 64, I_MKV = 32 * 32, I_GLU = 8 * 16, I_E = 512;
    constexpr int NITEMS = I_IN + I_O + I_MKV + I_GLU + 3 * 64 * I_E;
    for (int it = gw; it < NITEMS; it += NGW) {
        int r = it;
        if (r < I_IN) { const int kb = r / 72, nb = r % 72; tr_item(F.in[I_W_IN], INC, WinT, D, kb * 64, nb * 32, nb * 32, scr, F.lane); continue; } r -= I_IN;
        if (r < I_O) { const int kb = r / 64, nb = r % 64; tr_item(F.in[I_W_O], D, WoT, D, kb * 64, nb * 32, nb * 32, scr, F.lane); continue; } r -= I_O;
        if (r < I_MKV) { const int kb = r / 32, nb = r % 32; tr_item(F.in[I_W_MEM_KV], 1024, WmkvT, D, kb * 64, nb * 32, nb * 32, scr, F.lane); continue; } r -= I_MKV;
        if (r < I_GLU) { const int kb = r / 16, nb = r % 16; tr_item(F.in[I_W_GLU], 512, WgluT, 512, kb * 64, nb * 32, nb * 32, scr, F.lane); continue; } r -= I_GLU;
        const int which = r / (64 * I_E), rr = r % (64 * I_E), e = rr / I_E, q = rr % I_E;
        if (which < 2) { const int kb = q / 16, nb = q % 16, n0 = nb * 32;
            tr_item(F.in[which == 0 ? I_W_GATE : I_W_UP] + (size_t)e * D * DEXP, DEXP, WguT + (size_t)e * 1024 * D, D, kb * 64, n0, (n0 >> 7) * 256 + which * 128 + (n0 & 127), scr, F.lane);
        } else { const int kb = q / 64, nb = q % 64;
            tr_item(F.in[I_W_DOWN] + (size_t)e * DEXP * D, D, WdT + (size_t)e * D * DEXP, DEXP, kb * 64, nb * 32, nb * 32, scr, F.lane); }
    }
    { bf16* WrT = (bf16*)(F.ws + WS_WR); const int gt = F.vcu * 512 + F.tid, NT = F.G * 512;
      for (int idx = gt; idx < 256 * 2048; idx += NT) { const int n = idx >> 11, k = idx & 2047; float v = 0.f;
          if (n < 8) v = F.in[I_WR_G][k * 8 + n]; else if (n < 72) v = F.in[I_WR_E][k * 64 + (n - 8)];
          WrT[idx] = (bf16)f2bf(v); } }
    bf16* XN = (bf16*)(F.ws + WS_XN); bf16* MEMN = (bf16*)(F.ws + WS_MEMN);
    for (int m = gw; m < T; m += NGW) rms_row_to_bf16(F.in[I_X] + (size_t)m * D, F.in[I_NORM_MIX], XN + (size_t)m * D, F.lane);
    for (int m = gw; m < NB * MEML; m += NGW) rms_row_to_bf16(F.in[I_MEM] + (size_t)m * D, F.in[I_MEM_NORM], MEMN + (size_t)m * D, F.lane);
}

constexpr int SWA_KS = 72, SWA_VS = 264;
constexpr int SWA_KOFF = 0, SWA_VOFF = 256 * SWA_KS * 2, SWA_BOFF = SWA_VOFF + 64 * SWA_VS * 2;
__device__ __forceinline__ int t5_bucket(int n) { if (n < 16) return n; const int v = 16 + (int)(logf((float)n * (1.0f / 16.0f)) / logf(8.0f) * 16.0f); return v < 31 ? v : 31; }
__device__ __forceinline__ void swa_unit(Frame& F, int unit) {
    const int b = unit >> 5, kvh = (unit >> 4) & 1, nb = unit & 15;
    const bf16* PROJ = (const bf16*)(F.ws + WS_PROJ); bf16* MIX = (bf16*)(F.ws + WS_MIX);
    LAS bf16* Ks = (LAS bf16*)(F.lds + SWA_KOFF); LAS bf16* Vt = (LAS bf16*)(F.lds + SWA_VOFF); LAS float* bt = (LAS float*)(F.lds + SWA_BOFF);
    __syncthreads();
    {
        const int key = F.tid >> 1, half = F.tid & 1, s = (nb - 1) * 128 + key;
        v4u kw[4], vw[4];
        if (s >= 0) { const bf16* rp = PROJ + (size_t)(b * SEQ + s) * INC + 1024 + kvh * 64 + half * 32;
#pragma unroll
            for (int j = 0; j < 4; ++j) { kw[j] = *(const v4u*)(rp + j * 8); vw[j] = *(const v4u*)(rp + 128 + j * 8); }
        } else {
#pragma unroll
            for (int j = 0; j < 4; ++j) { kw[j] = (v4u){0u, 0u, 0u, 0u}; vw[j] = (v4u){0u, 0u, 0u, 0u}; } }
        float kf[32]; float ss = 0.f;
#pragma unroll
        for (int j = 0; j < 4; ++j) { kf[j * 8 + 0] = bflo(kw[j].x); kf[j * 8 + 1] = bfhi(kw[j].x); kf[j * 8 + 2] = bflo(kw[j].y); kf[j * 8 + 3] = bfhi(kw[j].y);
            kf[j * 8 + 4] = bflo(kw[j].z); kf[j * 8 + 5] = bfhi(kw[j].z); kf[j * 8 + 6] = bflo(kw[j].w); kf[j * 8 + 7] = bfhi(kw[j].w); }
#pragma unroll
        for (int j = 0; j < 32; ++j) ss += kf[j] * kf[j];
        ss += __shfl_xor(ss, 1);
        const float rstd = 1.0f / sqrtf(ss * (1.f / 64.f) + EPS);
        const float* kn = F.in[I_K_NORM] + half * 32;
#pragma unroll
        for (int j = 0; j < 4; ++j) { v4u o; o.x = pk2(kf[j * 8 + 0] * rstd * kn[j * 8 + 0], kf[j * 8 + 1] * rstd * kn[j * 8 + 1]); o.y = pk2(kf[j * 8 + 2] * rstd * kn[j * 8 + 2], kf[j * 8 + 3] * rstd * kn[j * 8 + 3]);
            o.z = pk2(kf[j * 8 + 4] * rstd * kn[j * 8 + 4], kf[j * 8 + 5] * rstd * kn[j * 8 + 5]); o.w = pk2(kf[j * 8 + 6] * rstd * kn[j * 8 + 6], kf[j * 8 + 7] * rstd * kn[j * 8 + 7]);
            *(LAS v4u*)(Ks + key * SWA_KS + half * 32 + j * 8) = o; }
#pragma unroll
        for (int j = 0; j < 4; ++j) { const unsigned w4[4] = {vw[j].x, vw[j].y, vw[j].z, vw[j].w};
#pragma unroll
            for (int q = 0; q < 4; ++q) { const int d = half * 32 + j * 8 + q * 2; Vt[d * SWA_VS + key] = (bf16)(w4[q] & 0xffffu); Vt[(d + 1) * SWA_VS + key] = (bf16)(w4[q] >> 16); } }
        for (int idx = F.tid; idx < 8 * 128; idx += 512) { const int w = idx >> 7, dl = idx & 127; bt[idx] = F.in[I_REL_BIAS][t5_bucket(dl) * 16 + kvh * 8 + w]; }
    }
    __syncthreads();
    const int w = F.wave, h = kvh * 8 + w, ql = F.lane & 31, hh = F.lane >> 5;
    const float sink = F.in[I_SINKS][h];
    const float* qn = F.in[I_Q_NORM];
    for (int r = 0; r < 4; ++r) {
        const int qi = 32 * r + ql; const size_t t = (size_t)b * SEQ + nb * 128 + qi;
        bf16x8 qf[4];
        {   const bf16* qp = PROJ + t * INC + h * 64 + 8 * hh; v4u qw[4]; float qv[32]; float ss = 0.f;
#pragma unroll
            for (int ks = 0; ks < 4; ++ks) qw[ks] = *(const v4u*)(qp + ks * 16);
#pragma unroll
            for (int ks = 0; ks < 4; ++ks) { qv[ks * 8 + 0] = bflo(qw[ks].x); qv[ks * 8 + 1] = bfhi(qw[ks].x); qv[ks * 8 + 2] = bflo(qw[ks].y); qv[ks * 8 + 3] = bfhi(qw[ks].y);
                qv[ks * 8 + 4] = bflo(qw[ks].z); qv[ks * 8 + 5] = bfhi(qw[ks].z); qv[ks * 8 + 6] = bflo(qw[ks].w); qv[ks * 8 + 7] = bfhi(qw[ks].w); }
#pragma unroll
            for (int j = 0; j < 32; ++j) ss += qv[j] * qv[j];
            ss += __shfl_xor(ss, 32);
            const float sc = 0.125f / sqrtf(ss * (1.f / 64.f) + EPS);
#pragma unroll
            for (int ks = 0; ks < 4; ++ks) { const float* g = qn + ks * 16 + 8 * hh; v4u o;
                o.x = pk2(qv[ks * 8 + 0] * sc * g[0], qv[ks * 8 + 1] * sc * g[1]); o.y = pk2(qv[ks * 8 + 2] * sc * g[2], qv[ks * 8 + 3] * sc * g[3]);
                o.z = pk2(qv[ks * 8 + 4] * sc * g[4], qv[ks * 8 + 5] * sc * g[5]); o.w = pk2(qv[ks * 8 + 6] * sc * g[6], qv[ks * 8 + 7] * sc * g[7]);
                qf[ks] = __builtin_bit_cast(bf16x8, o); } }
        f32x16 s[5];
#pragma unroll
        for (int kt = 0; kt < 5; ++kt) { f32x16 a = {0.f, 0.f, 0.f, 0.f, 0.f, 0.f, 0.f, 0.f, 0.f, 0.f, 0.f, 0.f, 0.f, 0.f, 0.f, 0.f};
#pragma unroll
            for (int ks = 0; ks < 4; ++ks) { const bf16x8 kfrag = *(const LAS bf16x8*)(Ks + (32 * (r + kt) + ql) * SWA_KS + ks * 16 + 8 * hh);
                a = __builtin_amdgcn_mfma_f32_32x32x16_bf16(kfrag, qf[ks], a, 0, 0, 0); }
            s[kt] = a; }
        float mx = sink;
#pragma unroll
        for (int kt = 0; kt < 5; ++kt)
#pragma unroll
            for (int rg = 0; rg < 16; ++rg) { const int ki = 32 * (r + kt) + (rg & 3) + 8 * (rg >> 2) + 4 * hh, dl = 128 + qi - ki;
                const bool ok = (dl >= 0) && (dl < 128) && (ki >= 128 || nb > 0);
                const float v = ok ? s[kt][rg] + bt[w * 128 + (dl & 127)] : -1e30f; s[kt][rg] = v; mx = fmaxf(mx, v); }
        mx = fmaxf(mx, __shfl_xor(mx, 32));
        float l = 0.f;
#pragma unroll
        for (int kt = 0; kt < 5; ++kt)
#pragma unroll
            for (int rg = 0; rg < 16; ++rg) { const float p = fast_exp(s[kt][rg] - mx); s[kt][rg] = p; l += p; }
        l += __shfl_xor(l, 32);
        l += fast_exp(sink - mx);
        f32x16 o[2];
#pragma unroll
        for (int dt = 0; dt < 2; ++dt) o[dt] = (f32x16){0.f, 0.f, 0.f, 0.f, 0.f, 0.f, 0.f, 0.f, 0.f, 0.f, 0.f, 0.f, 0.f, 0.f, 0.f, 0.f};
#pragma unroll
        for (int kt = 0; kt < 5; ++kt)
#pragma unroll
            for (int st = 0; st < 2; ++st) { v4u pw; pw.x = pk2(s[kt][8 * st + 0], s[kt][8 * st + 1]); pw.y = pk2(s[kt][8 * st + 2], s[kt][8 * st + 3]); pw.z = pk2(s[kt][8 * st + 4], s[kt][8 * st + 5]); pw.w = pk2(s[kt][8 * st + 6], s[kt][8 * st + 7]);
                const bf16x8 pf = __builtin_bit_cast(bf16x8, pw);
#pragma unroll
                for (int dt = 0; dt < 2; ++dt) { const LAS bf16* vp = Vt + (dt * 32 + ql) * SWA_VS + 32 * (r + kt) + 16 * st + 4 * hh;
                    const v2u lo = *(const LAS v2u*)vp, hi = *(const LAS v2u*)(vp + 8); v4u vv; vv.x = lo.x; vv.y = lo.y; vv.z = hi.x; vv.w = hi.y;
                    o[dt] = __builtin_amdgcn_mfma_f32_32x32x16_bf16(__builtin_bit_cast(bf16x8, vv), pf, o[dt], 0, 0, 0); } }
        const float inv = 1.0f / l;
        bf16* op = MIX + t * D + h * 64 + 4 * hh;
#pragma unroll
        for (int dt = 0; dt < 2; ++dt)
#pragma unroll
            for (int q4 = 0; q4 < 4; ++q4) { v2u ow; ow.x = pk2(o[dt][q4 * 4 + 0] * inv, o[dt][q4 * 4 + 1] * inv); ow.y = pk2(o[dt][q4 * 4 + 2] * inv, o[dt][q4 * 4 + 3] * inv);
                *(v2u*)(op + dt * 32 + q4 * 8) = ow; }
    }
}

constexpr int XA_KS = 136, XA_VS = 264;
constexpr int XA_KOFF = 0, XA_VOFF = 256 * XA_KS * 2;
__device__ __forceinline__ void xattn_unit(Frame& F, int unit) {
    const int b = unit >> 5, hx = (unit >> 3) & 3, qb = unit & 7;
    const bf16* PROJ = (const bf16*)(F.ws + WS_PROJ); const bf16* MKV = (const bf16*)(F.ws + WS_MEMKV); bf16* MIX = (bf16*)(F.ws + WS_MIX);
    LAS bf16* Ks = (LAS bf16*)(F.lds + XA_KOFF); LAS bf16* Vt = (LAS bf16*)(F.lds + XA_VOFF);
    __syncthreads();
    {   const int key = F.tid >> 1, half = F.tid & 1; const bf16* rp = MKV + (size_t)(b * MEML + key) * 1024 + hx * 128 + half * 64;
        float ss = 0.f; v4u kw[8];
#pragma unroll
        for (int j = 0; j < 8; ++j) { kw[j] = *(const v4u*)(rp + j * 8);
            const float a0 = bflo(kw[j].x), a1 = bfhi(kw[j].x), a2 = bflo(kw[j].y), a3 = bfhi(kw[j].y), a4 = bflo(kw[j].z), a5 = bfhi(kw[j].z), a6 = bflo(kw[j].w), a7 = bfhi(kw[j].w);
            ss += (a0 * a0 + a1 * a1) + (a2 * a2 + a3 * a3) + (a4 * a4 + a5 * a5) + (a6 * a6 + a7 * a7); }
        ss += __shfl_xor(ss, 1);
        const float rstd = 1.0f / sqrtf(ss * (1.f / 128.f) + EPS);
        const float* kn = F.in[I_XK_NORM] + half * 64;
#pragma unroll
        for (int j = 0; j < 8; ++j) { v4u o; const float* g = kn + j * 8;
            o.x = pk2(bflo(kw[j].x) * rstd * g[0], bfhi(kw[j].x) * rstd * g[1]); o.y = pk2(bflo(kw[j].y) * rstd * g[2], bfhi(kw[j].y) * rstd * g[3]);
            o.z = pk2(bflo(kw[j].z) * rstd * g[4], bfhi(kw[j].z) * rstd * g[5]); o.w = pk2(bflo(kw[j].w) * rstd * g[6], bfhi(kw[j].w) * rstd * g[7]);
            *(LAS v4u*)(Ks + key * XA_KS + half * 64 + j * 8) = o; }
#pragma unroll
        for (int j = 0; j < 8; ++j) { const v4u vw = *(const v4u*)(rp + 512 + j * 8); const unsigned w4[4] = {vw.x, vw.y, vw.z, vw.w};
#pragma unroll
            for (int q = 0; q < 4; ++q) { const int d = half * 64 + j * 8 + q * 2; Vt[d * XA_VS + key] = (bf16)(w4[q] & 0xffffu); Vt[(d + 1) * XA_VS + key] = (bf16)(w4[q] >> 16); } }
    }
    __syncthreads();
    const int ql = F.lane & 31, hh = F.lane >> 5;
    const size_t t = (size_t)b * SEQ + qb * 256 + F.wave * 32 + ql;
    bf16x8 qf[8];
    {   const bf16* qp = PROJ + t * INC + 1792 + hx * 128 + 8 * hh; v4u qw[8]; float ss = 0.f;
#pragma unroll
        for (int ks = 0; ks < 8; ++ks) { qw[ks] = *(const v4u*)(qp + ks * 16);
            const float a0 = bflo(qw[ks].x), a1 = bfhi(qw[ks].x), a2 = bflo(qw[ks].y), a3 = bfhi(qw[ks].y), a4 = bflo(qw[ks].z), a5 = bfhi(qw[ks].z), a6 = bflo(qw[ks].w), a7 = bfhi(qw[ks].w);
            ss += (a0 * a0 + a1 * a1) + (a2 * a2 + a3 * a3) + (a4 * a4 + a5 * a5) + (a6 * a6 + a7 * a7); }
        ss += __shfl_xor(ss, 32);
        const float sc = 0.08838834764831845f / sqrtf(ss * (1.f / 128.f) + EPS);
        const float* qn = F.in[I_XQ_NORM] + 8 * hh;
#pragma unroll
        for (int ks = 0; ks < 8; ++ks) { const float* g = qn + ks * 16; v4u o;
            o.x = pk2(bflo(qw[ks].x) * sc * g[0], bfhi(qw[ks].x) * sc * g[1]); o.y = pk2(bflo(qw[ks].y) * sc * g[2], bfhi(qw[ks].y) * sc * g[3]);
            o.z = pk2(bflo(qw[ks].z) * sc * g[4], bfhi(qw[ks].z) * sc * g[5]); o.w = pk2(bflo(qw[ks].w) * sc * g[6], bfhi(qw[ks].w) * sc * g[7]);
            qf[ks] = __builtin_bit_cast(bf16x8, o); } }
    f32x16 o[4];
#pragma unroll
    for (int dt = 0; dt < 4; ++dt) o[dt] = (f32x16){0.f, 0.f, 0.f, 0.f, 0.f, 0.f, 0.f, 0.f, 0.f, 0.f, 0.f, 0.f, 0.f, 0.f, 0.f, 0.f};
    float mrun = -1e30f, lrun = 0.f;
    for (int kb = 0; kb < 4; ++kb) {
        f32x16 s[2];
#pragma unroll
        for (int kt = 0; kt < 2; ++kt) { f32x16 a = {0.f, 0.f, 0.f, 0.f, 0.f, 0.f, 0.f, 0.f, 0.f, 0.f, 0.f, 0.f, 0.f, 0.f, 0.f, 0.f};
#pragma unroll
            for (int ks = 0; ks < 8; ++ks) { const bf16x8 kfrag = *(const LAS bf16x8*)(Ks + (64 * kb + 32 * kt + ql) * XA_KS + ks * 16 + 8 * hh);
                a = __builtin_amdgcn_mfma_f32_32x32x16_bf16(kfrag, qf[ks], a, 0, 0, 0); }
            s[kt] = a; }
        float mx = mrun;
#pragma unroll
        for (int kt = 0; kt < 2; ++kt)
#pragma unroll
            for (int rg = 0; rg < 16; ++rg) mx = fmaxf(mx, s[kt][rg]);
        mx = fmaxf(mx, __shfl_xor(mx, 32));
        const float alpha = fast_exp(mrun - mx); mrun = mx;
        float ls = 0.f;
#pragma unroll
        for (int kt = 0; kt < 2; ++kt)
#pragma unroll
            for (int rg = 0; rg < 16; ++rg) { const float p = fast_exp(s[kt][rg] - mx); s[kt][rg] = p; ls += p; }
        lrun = lrun * alpha + ls;
#pragma unroll
        for (int dt = 0; dt < 4; ++dt)
#pragma unroll
            for (int rg = 0; rg < 16; ++rg) o[dt][rg] *= alpha;
#pragma unroll
        for (int kt = 0; kt < 2; ++kt)
#pragma unroll
            for (int st = 0; st < 2; ++st) { v4u pw; pw.x = pk2(s[kt][8 * st + 0], s[kt][8 * st + 1]); pw.y = pk2(s[kt][8 * st + 2], s[kt][8 * st + 3]); pw.z = pk2(s[kt][8 * st + 4], s[kt][8 * st + 5]); pw.w = pk2(s[kt][8 * st + 6], s[kt][8 * st + 7]);
                const bf16x8 pf = __builtin_bit_cast(bf16x8, pw);
#pragma unroll
                for (int dt = 0; dt < 4; ++dt) { const LAS bf16* vp = Vt + (dt * 32 + ql) * XA_VS + 64 * kb + 32 * kt + 16 * st + 4 * hh;
                    const v2u lo = *(const LAS v2u*)vp, hi = *(const LAS v2u*)(vp + 8); v4u vv; vv.x = lo.x; vv.y = lo.y; vv.z = hi.x; vv.w = hi.y;
                    o[dt] = __builtin_amdgcn_mfma_f32_32x32x16_bf16(__builtin_bit_cast(bf16x8, vv), pf, o[dt], 0, 0, 0); } }
    }
    lrun += __shfl_xor(lrun, 32);
    const float inv = 1.0f / lrun;
    bf16* op = MIX + t * D + 1536 + hx * 128 + 4 * hh;
#pragma unroll
    for (int dt = 0; dt < 4; ++dt)
#pragma unroll
        for (int q4 = 0; q4 < 4; ++q4) { v2u ow; ow.x = pk2(o[dt][q4 * 4 + 0] * inv, o[dt][q4 * 4 + 1] * inv); ow.y = pk2(o[dt][q4 * 4 + 2] * inv, o[dt][q4 * 4 + 3] * inv);
            *(v2u*)(op + dt * 32 + q4 * 8) = ow; }
}

__device__ __forceinline__ void moe_tables(Frame& F) {
    LAS int* cnt = (LAS int*)(F.lds + TAB_OFF); LAS int* ts = cnt + 64;
    __syncthreads();
    if (F.tid < 64) { const int c = (int)__hip_atomic_load(F.ctl + CW_CNT + F.tid, __ATOMIC_RELAXED, __HIP_MEMORY_SCOPE_AGENT); const int nt = (c + 255) >> 8; int inc = nt;
#pragma unroll
        for (int o = 1; o < 64; o <<= 1) { const int v = __shfl_up(inc, o); if (F.tid >= o) inc += v; }
        cnt[F.tid] = c; ts[F.tid + 1] = inc; if (F.tid == 0) ts[0] = 0; }
    __syncthreads();
}

struct Args { const float* in[31]; float* out; unsigned char* ws; int ph_lo, ph_hi; };
__global__ void __launch_bounds__(512, 2) hymba_fwd(Args args) {
    extern __shared__ __attribute__((aligned(16))) unsigned char lds_raw[];
    Frame F;
    F.lds = (LAS unsigned char*)lds_raw;
    F.tid = threadIdx.x; F.lane = F.tid & 63; F.wave = __builtin_amdgcn_readfirstlane(F.tid >> 6);
    F.G = gridDim.x; { const int bx = blockIdx.x; F.vcu = (F.G % 8 == 0) ? (bx % 8) * (F.G / 8) + bx / 8 : bx; }
#pragma unroll
    for (int i = 0; i < 31; ++i) F.in[i] = args.in[i];
    F.out = args.out; F.ws = args.ws; F.ctl = (unsigned*)(args.ws + WS_CTL);
    const int lo = args.ph_lo, hi = args.ph_hi;
#if !MK_PER_PHASE
    if (F.tid < 4) ((LAS unsigned*)(F.lds + XBW_OFF))[F.tid] = 0u;
    __syncthreads();
    XcdBarrier bar = xcd_barrier_post(F.ctl + CW_BAR, (volatile LAS unsigned*)(F.lds + XBW_OFF));
#define GRID_BAR() xcd_barrier(bar)
#else
#define GRID_BAR() do {} while (0)
#endif
#define IN(k) (lo <= (k) && (k) < hi)
#define SEAM(k) do { if (IN(k) && IN((k) + 1)) GRID_BAR(); } while (0)
    const int gw = F.vcu * 8 + F.wave, NGW = F.G * 8;
    bf16* const XN = (bf16*)(F.ws + WS_XN); bf16* const PROJ = (bf16*)(F.ws + WS_PROJ); bf16* const MIX = (bf16*)(F.ws + WS_MIX);
    bf16* const UA = (bf16*)(F.ws + WS_UA); bf16* const Gm = (bf16*)(F.ws + WS_G);

    if (IN(0)) { p0_prologue(F); }
    SEAM(0);
    if (IN(1)) {
        { pg8::Gemm g{D, D, D}; pg8::DenseOrder S; S.init(XN, F.ws + WS_WIN, D, D, T, INC, F.G, (int)blockIdx.x);
          pg8::EpiProj E{PROJ, UA}; pg8::gemm_phase<pg8::EpiProj, pg8::DenseOrder>(F.lds, g, S, E); }
        { pg8::Gemm g{D, D, D}; pg8::DenseOrder S; S.init(F.ws + WS_MEMN, F.ws + WS_WMKV, D, D, NB * MEML, 1024, F.G, F.G - 1 - (int)blockIdx.x);
          pg8::EpiBf16 E{(bf16*)(F.ws + WS_MEMKV), 1024}; pg8::gemm_phase<pg8::EpiBf16, pg8::DenseOrder>(F.lds, g, S, E); }
    }
    SEAM(1);
    if (IN(2)) {
        for (int u = F.vcu; u < 256; u += F.G) swa_unit(F, u);
        __syncthreads();
        { pg8::Gemm g{S5K, 512, 512}; pg8::GroupOrder S{(const char*)UA, (const char*)(F.ws + WS_SP), S5K, 512, 1, 32, F.G, F.G - 1 - F.vcu};
          pg8::EpiF32 E{(float*)(F.ws + WS_SL), 256, (size_t)512 * 256}; pg8::gemm_phase<pg8::EpiF32, pg8::GroupOrder>(F.lds, g, S, E); }
    }
    SEAM(2);
    if (IN(3)) {
        if (F.wave == 0) {
            const float* SL = (const float*)(F.ws + WS_SL); const float* AL = (const float*)(F.ws + WS_AL);
            for (int p = F.vcu; p < 256; p += F.G) { const int b = p >> 5, g = p & 31, n = F.lane;
                const float ar = AL[(g * 64 + n) * 2], ai = AL[(g * 64 + n) * 2 + 1]; float xr = 0.f, xi = 0.f;
                for (int j0 = 0; j0 < 64; j0 += 8) { float sr[8], si[8];
#pragma unroll
                    for (int j = 0; j < 8; ++j) { const float* sp = SL + ((size_t)(g * 512 + b * 64 + j0 + j)) * 256; sr[j] = sp[n]; si[j] = sp[64 + n]; }
#pragma unroll
                    for (int j = 0; j < 8; ++j) { bf16* up = UA + ((size_t)(g * 512 + b * 64 + j0 + j)) * S5K + 512; up[n] = (bf16)f2bf(xr); up[64 + n] = (bf16)f2bf(xi);
                        const float nr = ar * xr - ai * xi + sr[j], ni = ar * xi + ai * xr + si[j]; xr = nr; xi = ni; } } }
        }
        for (int u = F.vcu; u < 256; u += F.G) xattn_unit(F, u);
        __syncthreads();
    }
    SEAM(3);
    if (IN(4)) {
        pg8::Gemm g{S5K, S5K, S5K}; pg8::GroupOrder S{(const char*)UA, (const char*)(F.ws + WS_MQ), S5K, S5K, 2, 32, F.G, F.vcu};
        pg8::EpiS5Y E{UA, F.in[I_SSM_D], Gm}; pg8::gemm_phase<pg8::EpiS5Y, pg8::GroupOrder>(F.lds, g, S, E);
    }
    SEAM(4);
    if (IN(5)) {
        pg8::Gemm g{512, 512, 512}; pg8::DenseOrder S; S.init(Gm, F.ws + WS_WGLU, 512, 512, T, 512, F.G, (int)blockIdx.x);
        pg8::EpiGlu E{Gm, MIX}; pg8::gemm_phase<pg8::EpiGlu, pg8::DenseOrder>(F.lds, g, S, E);
    }
    SEAM(5);
    if (IN(6)) {
        for (int m = gw; m < T; m += NGW) { v4u* rp = (v4u*)(MIX + (size_t)m * D) + F.lane; v4u w[4]; float ss[4];
#pragma unroll
            for (int j = 0; j < 4; ++j) { w[j] = rp[64 * j];
                const float a0 = bflo(w[j].x), a1 = bfhi(w[j].x), a2 = bflo(w[j].y), a3 = bfhi(w[j].y), a4 = bflo(w[j].z), a5 = bfhi(w[j].z), a6 = bflo(w[j].w), a7 = bfhi(w[j].w);
                ss[j] = (a0 * a0 + a1 * a1) + (a2 * a2 + a3 * a3) + (a4 * a4 + a5 * a5) + (a6 * a6 + a7 * a7); }
            const float sa = wave_sum(ss[0] + ss[1]), sb = wave_sum(ss[2]), sc = wave_sum(ss[3]);
            const float ra = 1.0f / sqrtf(sa * (1.f / 1024.f) + EPS), rb = 1.0f / sqrtf(sb * (1.f / 512.f) + EPS), rc = 1.0f / sqrtf(sc * (1.f / 512.f) + EPS);
#pragma unroll
            for (int j = 0; j < 4; ++j) { const float rs = j < 2 ? ra : (j == 2 ? rb : rc);
                const float* g = (j < 2 ? F.in[I_ON_ATTN] + j * 512 : (j == 2 ? F.in[I_ON_SSM] : F.in[I_ON_X])) + F.lane * 8; v4u o;
                o.x = pk2(bflo(w[j].x) * rs * g[0], bfhi(w[j].x) * rs * g[1]); o.y = pk2(bflo(w[j].y) * rs * g[2], bfhi(w[j].y) * rs * g[3]);
                o.z = pk2(bflo(w[j].z) * rs * g[4], bfhi(w[j].z) * rs * g[5]); o.w = pk2(bflo(w[j].w) * rs * g[6], bfhi(w[j].w) * rs * g[7]);
                rp[64 * j] = o; } }
    }
    SEAM(6);
    if (IN(7)) {
        pg8::Gemm g{D, D, D}; pg8::DenseOrder S; S.init(MIX, F.ws + WS_WO, D, D, T, D, F.G, (int)blockIdx.x);
        pg8::EpiWo E{F.in[I_X], F.out}; pg8::gemm_phase<pg8::EpiWo, pg8::DenseOrder>(F.lds, g, S, E);
    }
    SEAM(7);
    if (IN(8)) {
        for (int m = gw; m < T; m += NGW) rms_row_to_bf16(F.out + (size_t)m * D, F.in[I_NORM_FFN], XN + (size_t)m * D, F.lane);
    }
    SEAM(8);
    if (IN(9)) {
        pg8::Gemm g{D, D, D}; pg8::DenseOrder S; S.init(XN, F.ws + WS_WR, D, D, T, 256, F.G, (int)blockIdx.x);
        pg8::EpiF32 E{(float*)(F.ws + WS_LOG), 256, 0}; pg8::gemm_phase<pg8::EpiF32, pg8::DenseOrder>(F.lds, g, S, E);
    }
    SEAM(9);
    if (IN(10)) {
        const float* LG = (const float*)(F.ws + WS_LOG); int* list = (int*)(F.ws + WS_LIST); float* wts = (float*)(F.ws + WS_WTS);
        for (int t = F.vcu * 512 + F.tid; t < T; t += F.G * 512) { const float* lp = LG + (size_t)t * 256;
            const f32x4 g0 = *(const f32x4*)lp, g1 = *(const f32x4*)(lp + 4); const float gl[8] = {g0[0], g0[1], g0[2], g0[3], g1[0], g1[1], g1[2], g1[3]};
            int gi = 0; float gm = gl[0];
#pragma unroll
            for (int j = 1; j < 8; ++j) if (gl[j] > gm) { gm = gl[j]; gi = j; }
            float gs = 0.f;
#pragma unroll
            for (int j = 0; j < 8; ++j) gs += expf(gl[j] - gm);
            const float gate = 1.0f / gs;
            const f32x4 e0 = *(const f32x4*)(lp + 8 + gi * 8), e1 = *(const f32x4*)(lp + 12 + gi * 8); const float el[8] = {e0[0], e0[1], e0[2], e0[3], e1[0], e1[1], e1[2], e1[3]};
            int i1 = 0; float v1 = el[0];
#pragma unroll
            for (int j = 1; j < 8; ++j) if (el[j] > v1) { v1 = el[j]; i1 = j; }
            int i2 = -1; float v2 = -3.0e38f;
#pragma unroll
            for (int j = 0; j < 8; ++j) if (j != i1 && el[j] > v2) { v2 = el[j]; i2 = j; }
            const float ex = expf(v2 - v1), w1 = gate / (1.0f + ex), w2 = gate * ex / (1.0f + ex);
            const int ea = gi * 8 + i1, eb = gi * 8 + i2;
            const int sa = (int)atomicAdd(F.ctl + CW_CNT + ea, 1u), sb = (int)atomicAdd(F.ctl + CW_CNT + eb, 1u);
            list[(size_t)ea * LCAP + sa] = t * 2; list[(size_t)eb * LCAP + sb] = t * 2 + 1;
            wts[t * 2] = w1; wts[t * 2 + 1] = w2; }
    }
    SEAM(10);
    if (IN(11)) {
        moe_tables(F);
        const LAS int* cnt = (const LAS int*)(F.lds + TAB_OFF); const LAS int* ts = cnt + 64; const int* list = (const int*)(F.ws + WS_LIST); bf16* XS = (bf16*)(F.ws + WS_XS);
        const int nrows = ts[64] * 256;
        for (int p = gw; p < nrows; p += NGW) { const int tile = p >> 8; const int lo_ = ts[F.lane], hi_ = ts[F.lane + 1];
            const int e = __builtin_amdgcn_readfirstlane((int)__builtin_ctzll(__ballot(lo_ <= tile && tile < hi_)));
            const int r = p - ts[e] * 256; v4u* dst = (v4u*)(XS + (size_t)p * D) + F.lane;
            if (r < cnt[e]) { const int ent = list[(size_t)e * LCAP + r]; const v4u* src = (const v4u*)(XN + (size_t)(ent >> 1) * D) + F.lane;
#pragma unroll
                for (int j = 0; j < 4; ++j) dst[64 * j] = src[64 * j];
            } else {
#pragma unroll
                for (int j = 0; j < 4; ++j) dst[64 * j] = (v4u){0u, 0u, 0u, 0u}; } }
    }
    SEAM(11);
    if (IN(12)) {
        moe_tables(F);
        pg8::Gemm g{D, D, D}; pg8::MoeOrder S{(const char*)(F.ws + WS_XS), (const char*)(F.ws + WS_WGU), (const LAS int*)(F.lds + TAB_OFF) + 64, D, D, 4, 1024, F.G, F.vcu, false};
        pg8::EpiGU E{(bf16*)(F.ws + WS_ACT)}; pg8::gemm_phase<pg8::EpiGU, pg8::MoeOrder>(F.lds, g, S, E);
    }
    SEAM(12);
    if (IN(13)) {
        moe_tables(F);
        pg8::Gemm g{DEXP, DEXP, DEXP}; pg8::MoeOrder S{(const char*)(F.ws + WS_ACT), (const char*)(F.ws + WS_WD), (const LAS int*)(F.lds + TAB_OFF) + 64, DEXP, DEXP, 8, 2048, F.G, F.vcu, true};
        pg8::EpiDown E{(const int*)(F.ws + WS_LIST), (const float*)(F.ws + WS_WTS), (const LAS int*)(F.lds + TAB_OFF), (bf16*)(F.ws + WS_Y2)};
        pg8::gemm_phase<pg8::EpiDown, pg8::MoeOrder>(F.lds, g, S, E);
    }
    SEAM(13);
    if (IN(14)) {
        const bf16* Y2 = (const bf16*)(F.ws + WS_Y2);
        for (int m = gw; m < T; m += NGW) { f32x4* op = (f32x4*)(F.out + (size_t)m * D) + F.lane * 2; const v4u* ya = (const v4u*)(Y2 + (size_t)m * 2 * D) + F.lane; const v4u* yb = ya + 256;
#pragma unroll
            for (int j = 0; j < 4; ++j) { const v4u a = ya[64 * j], c = yb[64 * j]; f32x4 x0 = op[128 * j], x1 = op[128 * j + 1];
                x0[0] += bflo(a.x) + bflo(c.x); x0[1] += bfhi(a.x) + bfhi(c.x); x0[2] += bflo(a.y) + bflo(c.y); x0[3] += bfhi(a.y) + bfhi(c.y);
                x1[0] += bflo(a.z) + bflo(c.z); x1[1] += bfhi(a.z) + bfhi(c.z); x1[2] += bflo(a.w) + bflo(c.w); x1[3] += bfhi(a.w) + bfhi(c.w);
                op[128 * j] = x0; op[128 * j + 1] = x1; } }
    }
#undef IN
#undef SEAM
}

extern "C" void kernel_launch(void* const* d_in, const int* in_sizes, int n_in, void* d_out, int out_size, void* d_ws, size_t ws_size, hipStream_t stream) {
    static int grid = 0;
    if (grid == 0) {
        if (n_in != 31 || out_size != T * D || ws_size < WS_END) { fprintf(stderr, "kernel_launch: unexpected shapes (n_in %d out %d ws %zu)\n", n_in, out_size, ws_size); grid = -1; return; }
        int dev = 0, cus = 0, per_cu = 0;
        if (hipGetDevice(&dev) != hipSuccess || hipDeviceGetAttribute(&cus, hipDeviceAttributeMultiprocessorCount, dev) != hipSuccess) { grid = -1; return; }
        if (hipFuncSetAttribute((const void*)hymba_fwd, hipFuncAttributeMaxDynamicSharedMemorySize, LDS_BYTES) != hipSuccess) { fprintf(stderr, "kernel_launch: hipFuncSetAttribute failed\n"); grid = -1; return; }
        if (hipOccupancyMaxActiveBlocksPerMultiprocessor(&per_cu, (const void*)hymba_fwd, 512, LDS_BYTES) != hipSuccess || per_cu < 1) fprintf(stderr, "kernel_launch: occupancy query reports %d\n", per_cu);
        (void)hipGetLastError();
        grid = cus;
    }
    if (grid < 0) return;
    (void)hipMemsetAsync((char*)d_ws + WS_CTL, 0, CTL_ZERO_BYTES, stream);
    Args a{};
    for (int i = 0; i < 31; ++i) a.in[i] = (const float*)d_in[i];
    a.out = (float*)d_out; a.ws = (unsigned char*)d_ws;
#if MK_PER_PHASE
    for (int p = 0; p < NPH; ++p) { a.ph_lo = p; a.ph_hi = p + 1; hipLaunchKernelGGL(hymba_fwd, dim3(grid), dim3(512), LDS_BYTES, stream, a); }
#else
    a.ph_lo = 0; a.ph_hi = NPH; hipLaunchKernelGGL(hymba_fwd, dim3(grid), dim3(512), LDS_BYTES, stream, a);
#endif
}
```

```cpp
#include <hip/hip_runtime.h>
#include <cstdio>
#include <cstdint>

#ifndef PROBE_REP_MASK
#define PROBE_REP_MASK 0
#endif
#ifndef MK_PER_PHASE
#define MK_PER_PHASE 0
#endif

#define GAS __attribute__((address_space(1)))
#define LAS __attribute__((address_space(3)))
typedef unsigned short bf16;
typedef unsigned v4u __attribute__((ext_vector_type(4)));
typedef unsigned v2u __attribute__((ext_vector_type(2)));
typedef float f32x4 __attribute__((ext_vector_type(4)));
typedef float f32x16 __attribute__((ext_vector_type(16)));
typedef short bf16x8 __attribute__((ext_vector_type(8)));
typedef short bf16x4 __attribute__((ext_vector_type(4)));

constexpr int T = 16384, D = 2048, SEQ = 2048, NB = 8, INC = 2304, MEML = 256;
constexpr int NPH = 13;
constexpr float EPS = 1e-6f;
constexpr int NEXP = 64, DEXP = 512, LCAP = 16384;
constexpr int S5L = 32, S5K = 640;

constexpr size_t MiB = 1u << 20;
constexpr size_t WS_CTL = 0, CTL_ZERO_BYTES = 1 * MiB;
constexpr size_t WS_WIN = 2 * MiB, WS_WO = 11 * MiB, WS_WMKV = 19 * MiB, WS_WGLU = 23 * MiB;
constexpr size_t WS_MQ = 24 * MiB, WS_SP = 44 * MiB, WS_UA = 52 * MiB, WS_SL = 72 * MiB, WS_AL = 88 * MiB, WS_WR = 89 * MiB;
constexpr size_t WS_XN = 96 * MiB;
constexpr size_t WS_MEMN = 160 * MiB, WS_MEMKV = 168 * MiB;
constexpr size_t WS_PROJ = 176 * MiB;
constexpr size_t WS_MIX = 248 * MiB;
constexpr size_t WS_Y2 = 176 * MiB;
constexpr size_t WS_G = 312 * MiB;
constexpr size_t WS_LOG = 328 * MiB;
constexpr size_t WS_LIST = 344 * MiB;
constexpr size_t WS_WTS = 348 * MiB;
constexpr size_t WS_LP = 352 * MiB;
constexpr size_t WS_PART = 376 * MiB;
constexpr size_t WS_RSTD = 379 * MiB;
constexpr size_t WS_ACT = 544 * MiB;
constexpr size_t WS_WGU = 592 * MiB;
constexpr size_t WS_WD = 848 * MiB;
constexpr size_t WS_END = 976 * MiB;
constexpr int CW_CNT = 1024;
constexpr int CW_BAR = 4096;

constexpr int RING_BYTES = 131072;
constexpr int TAB_OFF = 139264;
constexpr int XBW_OFF = TAB_OFF + 2048;
constexpr int LDS_BYTES = 147456;

#define LDS_WAIT() asm volatile("s_waitcnt lgkmcnt(0)" ::: "memory")
#define VM_WAIT() asm volatile("s_waitcnt vmcnt(0)" ::: "memory")
__device__ __forceinline__ unsigned f2bf(float f) { unsigned u = __builtin_bit_cast(unsigned, f); return (u + 0x7fffu + ((u >> 16) & 1u)) >> 16; }
__device__ __forceinline__ unsigned pk2(float lo, float hi) { unsigned r; asm volatile("v_cvt_pk_bf16_f32 %0, %1, %2" : "=v"(r) : "v"(lo), "v"(hi)); return r; }
__device__ __forceinline__ float bflo(unsigned w) { return __builtin_bit_cast(float, w << 16); }
__device__ __forceinline__ float bfhi(unsigned w) { return __builtin_bit_cast(float, w & 0xffff0000u); }
__device__ __forceinline__ float wave_sum(float v) {
#pragma unroll
    for (int o = 1; o < 64; o <<= 1) v += __shfl_xor(v, o);
    return v;
}
__device__ __forceinline__ float fast_exp(float x) { return __builtin_amdgcn_exp2f(x * 1.44269504089f); }
__device__ __forceinline__ float sigmoidf_(float x) { return __builtin_amdgcn_rcpf(1.0f + fast_exp(-x)); }
__device__ __forceinline__ float gelu_tanh(float x) { const float z = 1.5957691216f * (x + 0.044715f * x * x * x); return x * sigmoidf_(z); }

#define XB_TMO      128
#define XB_XCNT(j)  (256  + 64 * (j))
#define XB_XSUB(j)  (1280 + 64 * (j))
#define XB_XGEN(j)  (2304 + 64 * (j))
#define XB_TOP      3328
#define XB_TOPGEN   3392
#define XCD_BAR_WORDS 3456
#define XB_SPIN_CAP (1u << 18)
__device__ __forceinline__ unsigned xb_ld(unsigned* p)              { return __hip_atomic_load(p, __ATOMIC_RELAXED, __HIP_MEMORY_SCOPE_AGENT); }
__device__ __forceinline__ unsigned xb_add(unsigned* p, unsigned v) { return __hip_atomic_fetch_add(p, v, __ATOMIC_RELAXED, __HIP_MEMORY_SCOPE_AGENT); }
__device__ __forceinline__ unsigned xb_xcc_id() { return (unsigned)__builtin_amdgcn_s_getreg((3 << 11) | 20) & 0xFu; }
#define XB_SPIN(cond, bar) do { unsigned _sp = 0; while (cond) { __builtin_amdgcn_s_sleep(1); \
    if ((++_sp & 255u) == 0u) { if (xb_ld(&(bar)[XB_TMO])) break; if (_sp > XB_SPIN_CAP) { atomicAdd(&(bar)[XB_TMO], 1u); break; } } } } while (0)
struct XcdBarrier { unsigned* bar; unsigned x; volatile LAS unsigned* st; };
__device__ __forceinline__ XcdBarrier xcd_barrier_post(unsigned* bar, volatile LAS unsigned* st) {
    XcdBarrier b; b.bar = bar; b.x = xb_xcc_id(); b.st = st;
    if (threadIdx.x == 0) (void)xb_add(&bar[XB_XCNT(b.x)], 1u);
    return b;
}
__device__ __forceinline__ void xcd_barrier_complete(unsigned* bar, unsigned x, unsigned& nloc, unsigned& nx) {
    const unsigned G = gridDim.x * gridDim.y * gridDim.z;
    unsigned sum, cnt, mine, sp = 0u;
    for (;;) {
        sum = 0u; cnt = 0u; mine = 0u;
#pragma unroll
        for (unsigned j = 0; j < 16; ++j) { const unsigned c = xb_ld(&bar[XB_XCNT(j)]); sum += c; cnt += (c > 0u) ? 1u : 0u; mine = (j == x) ? c : mine; }
        if (sum == G) break;
        __builtin_amdgcn_s_sleep(1);
        if ((++sp & 255u) == 0u) { if (xb_ld(&bar[XB_TMO])) break; if (sp > XB_SPIN_CAP) { atomicAdd(&bar[XB_TMO], 1u); break; } }
    }
    nloc = mine > 0u ? mine : 1u; nx = cnt > 0u ? cnt : 1u;
}
__device__ __forceinline__ void xcd_barrier(const XcdBarrier& b) {
    asm volatile("s_waitcnt vmcnt(0)" ::: "memory");
    __syncthreads();
    if (threadIdx.x == 0) {
        unsigned* bar = b.bar;
        __builtin_amdgcn_s_waitcnt(0);
        unsigned nloc = b.st[0], nx = b.st[1];
        if (nloc == 0u) { xcd_barrier_complete(bar, b.x, nloc, nx); b.st[0] = nloc; b.st[1] = nx; }
        const unsigned old = xb_add(&bar[XB_XSUB(b.x)], 1u);
        const unsigned gen = old / nloc;
        if (old + 1u == (gen + 1u) * nloc) {
            __builtin_amdgcn_fence(__ATOMIC_RELEASE, "agent");
            asm volatile("s_waitcnt vmcnt(0)" ::: "memory");
            const unsigned og = xb_add(&bar[XB_TOP], 1u);
            const unsigned tg = og / nx;
            if (og + 1u == (tg + 1u) * nx) xb_add(&bar[XB_TOPGEN], 1u);
            else XB_SPIN(xb_ld(&bar[XB_TOPGEN]) == tg, bar);
            __builtin_amdgcn_fence(__ATOMIC_ACQUIRE, "agent");
            xb_add(&bar[XB_XGEN(b.x)], 1u);
            asm volatile("s_waitcnt vmcnt(0)" ::: "memory");
        } else {
            XB_SPIN(xb_ld(&bar[XB_XGEN(b.x)]) == gen, bar);
            __builtin_amdgcn_fence(__ATOMIC_ACQUIRE, "agent");
            asm volatile("s_waitcnt vmcnt(0)" ::: "memory");
        }
    }
    __syncthreads();
}

namespace pg8 {
constexpr int BM = 256, BK = 64, HALF = 128, HTB = HALF * BK * 2, STAGE_BYTES = 8 * HTB, NXCD = 8, WGM = 8;
__host__ __device__ __forceinline__ int lds_byte(int r, int c) { const int st = (r >> 4) * 2 + (c >> 5), rr = r & 15, cc = c & 31, ob = rr * 64 + cc * 2; return st * 1024 + (ob ^ (((ob >> 9) & 1) << 5)); }
__host__ __device__ __forceinline__ void stage_rc(int b, int& R, int& C) { const int st = b / 1024, sb = b % 1024, swz = sb ^ (((sb >> 9) & 1) << 5); R = (st >> 1) * 16 + swz / 64; C = (st & 1) * 32 + (swz % 64) / 2; }
__host__ __device__ __forceinline__ int perm32(int rho) { const int n = rho >> 4, i = rho & 15; return 8 * (i >> 2) + 4 * n + (i & 3); }

struct Unit { const char* a; const char* b; int r0, c0, aux, r1; };
struct Gemm { int lda, ldb, K; };

struct DenseOrder {
    const char* A; const char* Bt; int lda, ldb, nM, nN, nwg, G, c;
    __device__ void init(const void* A_, const void* Bt_, int lda_, int ldb_, int M, int N, int G_, int c_) { A = (const char*)A_; Bt = (const char*)Bt_; lda = lda_; ldb = ldb_; nM = M / BM; nN = N / BM; nwg = nM * nN; G = G_; c = c_; }
    __device__ bool next(int i, Unit& u) const {
        const long L = (long)i * G + c; if (L >= nwg) return false;
        int wgid = (int)L; { const int q = nwg / NXCD, r = nwg % NXCD, xcd = wgid % NXCD, off = wgid / NXCD; wgid = (xcd < r ? xcd * (q + 1) : r * (q + 1) + (xcd - r) * q) + off; }
        const int nig = WGM * nN, gid = wgid / nig, fm = gid * WGM, gsz = (nM - fm) < WGM ? (nM - fm) : WGM;
        const int pm = fm + ((wgid % nig) % gsz), pn = (wgid % nig) / gsz;
        u.a = A + (size_t)pm * BM * lda * 2; u.b = Bt + (size_t)pn * BM * ldb * 2; u.r0 = pm * BM; u.c0 = pn * BM; u.aux = 0; u.r1 = 0; return true;
    }
    __device__ __forceinline__ unsigned arow(const Unit&, int) const { return 0u; }
};
struct GroupOrder {
    const char* A; const char* Bt; int lda, ldb, nN, ngrp, G, c;
    __device__ bool next(int i, Unit& u) const {
        const int L = i * G + c; if (L >= ngrp * 2 * nN) return false;
        const int g = L / (2 * nN), q = L % (2 * nN), pn = q >> 1, pm = q & 1;
        u.a = A + ((size_t)g * 512 + pm * BM) * lda * 2; u.b = Bt + ((size_t)g * nN + pn) * BM * ldb * 2; u.r0 = pm * BM; u.c0 = pn * BM; u.aux = g; u.r1 = 0; return true;
    }
    __device__ __forceinline__ unsigned arow(const Unit&, int) const { return 0u; }
};
struct MoeOrder {
    const char* A; const char* Bt; const LAS int* cnt; const LAS int* ts; const int* list; int lda, ldb, nct, brows, G, c; bool gather;
    __device__ bool next(int i, Unit& u) const {
        const int L = i * G + c; const int lane = threadIdx.x & 63;
        if (L >= ts[64] * nct) return false;
        const int lo = ts[lane] * nct, hi = ts[lane + 1] * nct;
        const unsigned long long m = __ballot(lo <= L && L < hi);
        const int e = __builtin_amdgcn_readfirstlane((int)__builtin_ctzll(m));
        const int tse = ts[e], ne = ts[e + 1] - tse, q = L - tse * nct, ct = q / ne, rt = q % ne;
        u.a = gather ? A : A + (size_t)(tse + rt) * BM * lda * 2; u.b = Bt + ((size_t)e * brows + (size_t)ct * BM) * ldb * 2;
        u.r0 = (tse + rt) * BM; u.r1 = rt * BM; u.c0 = ct; u.aux = e; return true;
    }
    __device__ __forceinline__ unsigned arow(const Unit& u, int r) const {
        const int n = cnt[u.aux]; int rr = u.r1 + r; rr = rr < n ? rr : n - 1;
        return (unsigned)(list[(size_t)u.aux * LCAP + rr] >> 1) * (unsigned)(lda * 2);
    }
};

#define EPI_ROWS_COLS() const int rowb = wr * 64 + fr; (void)rowb;

template <class Epi, class Sched, bool GATHER = false>
__device__ __forceinline__ void gemm_phase(LAS unsigned char* lds, const Gemm g, const Sched& S, const Epi& E) {
    const int tid = threadIdx.x, wid = __builtin_amdgcn_readfirstlane(tid >> 6), lane = tid & 63, wr = wid >> 2, wc = wid & 3, fr = lane & 15, fq = lane >> 4;
    const int K = g.K, nt = K / BK;
    unsigned voffB[2]; int Ra[2], Ca[2];
#pragma unroll
    for (int i = 0; i < 2; ++i) { int R, C; stage_rc(tid * 16 + i * 8192, R, C); const int Rb = Epi::PERM ? ((R & ~31) + perm32(R & 31)) : R;
        Ra[i] = R; Ca[i] = C; voffB[i] = (unsigned)(Rb * g.ldb + C) * 2u; }
    const size_t kstep = (size_t)(BK * 2);
    const size_t hstepB = (size_t)HALF * g.ldb * 2;
    const unsigned ldsw = (unsigned)wid * 1024u;
    const int aoff = lds_byte(wr * 64 + fr, fq * 8), boff = lds_byte(wc * 32 + fr, fq * 8);
#define PG8_SA(b, h) (((b) * 2 + (h)) * HTB)
#define PG8_SB(b, h) ((4 + (b) * 2 + (h)) * HTB)
#define PG8_STAGE(bufoff, gbase, voff) do { _Pragma("unroll") for (int _i = 0; _i < 2; ++_i) \
        __builtin_amdgcn_global_load_lds((const unsigned*)((const char*)(gbase) + (voff)[_i]), (LAS unsigned*)(lds + (bufoff) + ldsw + _i * 8192), 16, 0, 0); } while (0)
#define PG8_STAGEA(bufoff, gbase, o0, o1) do { \
        __builtin_amdgcn_global_load_lds((const unsigned*)((const char*)(gbase) + (o0)), (LAS unsigned*)(lds + (bufoff) + ldsw), 16, 0, 0); \
        __builtin_amdgcn_global_load_lds((const unsigned*)((const char*)(gbase) + (o1)), (LAS unsigned*)(lds + (bufoff) + ldsw + 8192), 16, 0, 0); } while (0)
#define PG8_LDA(dst, b, h) do { _Pragma("unroll") for (int m = 0; m < 4; ++m) _Pragma("unroll") for (int k = 0; k < 2; ++k) dst[m][k] = *(const LAS bf16x8*)(lds + PG8_SA(b, h) + aoff + m * 2048 + k * 1024); } while (0)
#define PG8_LDB(dst, b, h) do { _Pragma("unroll") for (int n = 0; n < 2; ++n) _Pragma("unroll") for (int k = 0; k < 2; ++k) dst[n][k] = *(const LAS bf16x8*)(lds + PG8_SB(b, h) + boff + n * 2048 + k * 1024); } while (0)
#define PG8_MMA(ai, bj, At, Bt) do { __builtin_amdgcn_s_setprio(1); _Pragma("unroll") for (int m = 0; m < 4; ++m) _Pragma("unroll") for (int n = 0; n < 2; ++n) _Pragma("unroll") for (int k = 0; k < 2; ++k) \
        acc[ai][bj][m][n] = __builtin_amdgcn_mfma_f32_16x16x32_bf16(Bt[n][k], At[m][k], acc[ai][bj][m][n], 0, 0, 0); __builtin_amdgcn_s_setprio(0); } while (0)
#define PG8_WAIT_V(n) asm volatile("s_waitcnt vmcnt(" #n ")" ::: "memory")
#define PG8_WAIT_L(n) asm volatile("s_waitcnt lgkmcnt(" #n ")" ::: "memory")
#define PG8_BAR __builtin_amdgcn_s_barrier()
#define PG8_SCHED __builtin_amdgcn_sched_barrier(0)
    Unit cur, nxt; int ui = 0;
    if (!S.next(0, cur)) return;
    f32x4 acc[2][2][4][2];
#pragma unroll
    for (int a = 0; a < 2; ++a)
#pragma unroll
        for (int b = 0; b < 2; ++b)
#pragma unroll
            for (int m = 0; m < 4; ++m)
#pragma unroll
                for (int n = 0; n < 2; ++n) acc[a][b][m][n] = (f32x4){0.f, 0.f, 0.f, 0.f};
    bf16x8 At[4][2], B0[2][2], B1[2][2];
    const char* cA = cur.a; const char* cB = cur.b;
    unsigned c00, c01, c10, c11, n00, n01, n10, n11;
    if constexpr (GATHER) {
        c00 = S.arow(cur, Ra[0]) + Ca[0] * 2u; c01 = S.arow(cur, Ra[1]) + Ca[1] * 2u; c10 = S.arow(cur, HALF + Ra[0]) + Ca[0] * 2u; c11 = S.arow(cur, HALF + Ra[1]) + Ca[1] * 2u;
        asm volatile("s_waitcnt vmcnt(0)" : "+v"(c00), "+v"(c01), "+v"(c10), "+v"(c11) :: "memory");
    } else {
        c00 = (unsigned)(Ra[0] * g.lda + Ca[0]) * 2u; c01 = (unsigned)(Ra[1] * g.lda + Ca[1]) * 2u; c10 = c00 + (unsigned)(HALF * g.lda * 2); c11 = c01 + (unsigned)(HALF * g.lda * 2);
    }
    n00 = c00; n01 = c01; n10 = c10; n11 = c11;
    PG8_STAGE(PG8_SB(0, 0), cB, voffB); PG8_STAGE(PG8_SB(0, 1), cB + hstepB, voffB); PG8_STAGEA(PG8_SA(0, 0), cA, c00, c01); PG8_STAGEA(PG8_SA(0, 1), cA, c10, c11);
    if (wr == 1) PG8_BAR;
    PG8_WAIT_V(2); PG8_BAR;
    PG8_STAGE(PG8_SB(1, 0), cB + kstep, voffB); PG8_STAGEA(PG8_SA(1, 0), cA + kstep, c00, c01); PG8_STAGE(PG8_SB(1, 1), cB + hstepB + kstep, voffB);
    PG8_WAIT_V(6); PG8_BAR;
    for (;;) {
        const bool has_next = S.next(ui + 1, nxt);
        const char* nA = has_next ? nxt.a : cA; const char* nB = has_next ? nxt.b : cB;
        if constexpr (GATHER) {
            if (has_next) { n00 = S.arow(nxt, Ra[0]) + Ca[0] * 2u; n01 = S.arow(nxt, Ra[1]) + Ca[1] * 2u; n10 = S.arow(nxt, HALF + Ra[0]) + Ca[0] * 2u; n11 = S.arow(nxt, HALF + Ra[1]) + Ca[1] * 2u; }
            else { n00 = c00; n01 = c01; n10 = c10; n11 = c11; }
            asm volatile("s_waitcnt vmcnt(0)" : "+v"(n00), "+v"(n01), "+v"(n10), "+v"(n11) :: "memory");
        }
        for (int t = 0; t < nt; t += 2) {
            const bool last = (t == nt - 2);
            const char* a1 = cA + (size_t)(t + 1) * kstep;
            const char* a2 = last ? nA : cA + (size_t)(t + 2) * kstep; const char* b2 = last ? nB : cB + (size_t)(t + 2) * kstep;
            const char* a3 = a2 + kstep; const char* b3 = b2 + kstep;
            const unsigned x00 = (GATHER && last) ? n00 : c00, x01 = (GATHER && last) ? n01 : c01, x10 = (GATHER && last) ? n10 : c10, x11 = (GATHER && last) ? n11 : c11;
            PG8_LDB(B0, 0, 0); PG8_LDB(B1, 0, 1); PG8_SCHED; PG8_LDA(At, 0, 0); PG8_STAGEA(PG8_SA(1, 1), a1, c10, c11);
            PG8_WAIT_V(8); PG8_WAIT_L(0); PG8_BAR; PG8_MMA(0, 0, At, B0); PG8_MMA(0, 1, At, B1); PG8_BAR; PG8_SCHED;
            PG8_LDA(At, 0, 1); PG8_STAGE(PG8_SB(0, 0), b2, voffB); PG8_STAGE(PG8_SB(0, 1), b2 + hstepB, voffB); PG8_STAGEA(PG8_SA(0, 0), a2, x00, x01);
            PG8_WAIT_V(8); PG8_WAIT_L(0); PG8_BAR; PG8_MMA(1, 0, At, B0); PG8_MMA(1, 1, At, B1); PG8_BAR; PG8_SCHED;
            PG8_LDB(B0, 1, 0); PG8_LDB(B1, 1, 1); PG8_SCHED; PG8_LDA(At, 1, 0); PG8_STAGEA(PG8_SA(0, 1), a2, x10, x11);
            PG8_WAIT_V(8); PG8_WAIT_L(0); PG8_BAR; PG8_MMA(0, 0, At, B0); PG8_MMA(0, 1, At, B1); PG8_BAR; PG8_SCHED;
            PG8_LDA(At, 1, 1); PG8_STAGE(PG8_SB(1, 0), b3, voffB); PG8_STAGE(PG8_SB(1, 1), b3 + hstepB, voffB); PG8_STAGEA(PG8_SA(1, 0), a3, x00, x01);
            PG8_WAIT_V(8); PG8_WAIT_L(0); PG8_BAR; PG8_MMA(1, 0, At, B0); PG8_MMA(1, 1, At, B1); PG8_BAR; PG8_SCHED;
        }
        if (wr == 0) PG8_BAR;
        E(acc, cur, wr, wc, fr, fq);
        if (!has_next) break;
#pragma unroll
        for (int a = 0; a < 2; ++a)
#pragma unroll
            for (int b = 0; b < 2; ++b)
#pragma unroll
                for (int m = 0; m < 4; ++m)
#pragma unroll
                    for (int n = 0; n < 2; ++n) acc[a][b][m][n] = (f32x4){0.f, 0.f, 0.f, 0.f};
        cur = nxt; cA = nA; cB = nB; ++ui;
        c00 = n00; c01 = n01; c10 = n10; c11 = n11;
        if (wr == 1) PG8_BAR;
    }
    PG8_WAIT_V(0);
    PG8_BAR;
#undef PG8_SA
#undef PG8_SB
#undef PG8_STAGE
#undef PG8_STAGEA
#undef PG8_LDA
#undef PG8_LDB
#undef PG8_MMA
#undef PG8_WAIT_V
#undef PG8_WAIT_L
#undef PG8_BAR
#undef PG8_SCHED
}

typedef const f32x4 (&AccRef)[2][2][4][2];
__device__ __forceinline__ v4u pack8(const f32x4 a, const f32x4 b) { v4u w; w.x = pk2(a[0], a[1]); w.y = pk2(a[2], a[3]); w.z = pk2(b[0], b[1]); w.w = pk2(b[2], b[3]); return w; }

struct EpiProj {
    static constexpr bool PERM = true;
    bf16* PROJ; bf16* UA;
    __device__ __forceinline__ void operator()(AccRef acc, const Unit& u, int wr, int wc, int fr, int fq) const {
        const int row0 = u.r0 + wr * 64 + fr, colb = u.c0 + wc * 32 + 8 * fq;
        const bool isu = (u.c0 == 1280 || u.c0 == 1536);
#pragma unroll
        for (int ai = 0; ai < 2; ++ai)
#pragma unroll
            for (int m = 0; m < 4; ++m) { const int row = row0 + ai * HALF + m * 16;
#pragma unroll
                for (int bj = 0; bj < 2; ++bj) { const int col = colb + bj * HALF; const v4u w = pack8(acc[ai][bj][m][0], acc[ai][bj][m][1]);
                    if (!isu) *(v4u*)(PROJ + (size_t)row * INC + col) = w;
                    else { const int cc = col - 1280, g = cc >> 4, c0 = cc & 15; *(v4u*)(UA + ((size_t)(g * 512 + (row >> 5)) * S5K + (row & 31) * 16 + c0)) = w; } } }
    }
};
struct EpiBf16 {
    static constexpr bool PERM = true;
    bf16* O; int ldc;
    __device__ __forceinline__ void operator()(AccRef acc, const Unit& u, int wr, int wc, int fr, int fq) const {
        const int row0 = u.r0 + wr * 64 + fr, colb = u.c0 + wc * 32 + 8 * fq;
#pragma unroll
        for (int ai = 0; ai < 2; ++ai)
#pragma unroll
            for (int m = 0; m < 4; ++m) { bf16* rowp = O + (size_t)(row0 + ai * HALF + m * 16) * ldc + colb;
#pragma unroll
                for (int bj = 0; bj < 2; ++bj) *(v4u*)(rowp + bj * HALF) = pack8(acc[ai][bj][m][0], acc[ai][bj][m][1]); }
    }
};
struct EpiF32 {
    static constexpr bool PERM = false;
    float* C; int ldc; size_t gstride;
    __device__ __forceinline__ void operator()(AccRef acc, const Unit& u, int wr, int wc, int fr, int fq) const {
        const int row0 = u.r0 + wr * 64 + fr, col0 = u.c0 + wc * 32 + 4 * fq; float* base = C + (size_t)u.aux * gstride;
#pragma unroll
        for (int ai = 0; ai < 2; ++ai)
#pragma unroll
            for (int m = 0; m < 4; ++m) { float* rowp = base + (size_t)(row0 + ai * HALF + m * 16) * ldc + col0;
#pragma unroll
                for (int bj = 0; bj < 2; ++bj)
#pragma unroll
                    for (int n = 0; n < 2; ++n) *(f32x4*)(rowp + bj * HALF + n * 16) = acc[ai][bj][m][n]; }
    }
};
struct EpiS5Y {
    static constexpr bool PERM = true;
    const bf16* UA; const float* dsk; bf16* Gm;
    __device__ __forceinline__ void operator()(AccRef acc, const Unit& u, int wr, int wc, int fr, int fq) const {
        const int row0 = u.r0 + wr * 64 + fr, colb = u.c0 + wc * 32 + 8 * fq, g = u.aux;
#pragma unroll
        for (int ai = 0; ai < 2; ++ai)
#pragma unroll
            for (int m = 0; m < 4; ++m) { const int row = row0 + ai * HALF + m * 16;
#pragma unroll
                for (int bj = 0; bj < 2; ++bj) { const int col = colb + bj * HALF, i = col >> 4, c0 = col & 15;
                    const v4u uw = *(const v4u*)(UA + ((size_t)(g * 512 + row) * S5K + col));
                    const f32x4 d0 = *(const f32x4*)(dsk + g * 16 + c0), d1 = *(const f32x4*)(dsk + g * 16 + c0 + 4);
                    const f32x4 a0 = acc[ai][bj][m][0], a1 = acc[ai][bj][m][1];
                    f32x4 y0, y1;
                    y0[0] = gelu_tanh(a0[0] + d0[0] * bflo(uw.x)); y0[1] = gelu_tanh(a0[1] + d0[1] * bfhi(uw.x)); y0[2] = gelu_tanh(a0[2] + d0[2] * bflo(uw.y)); y0[3] = gelu_tanh(a0[3] + d0[3] * bfhi(uw.y));
                    y1[0] = gelu_tanh(a1[0] + d1[0] * bflo(uw.z)); y1[1] = gelu_tanh(a1[1] + d1[1] * bfhi(uw.z)); y1[2] = gelu_tanh(a1[2] + d1[2] * bflo(uw.w)); y1[3] = gelu_tanh(a1[3] + d1[3] * bfhi(uw.w));
                    *(v4u*)(Gm + ((size_t)row * 32 + i) * 512 + g * 16 + c0) = pack8(y0, y1); } }
    }
};
struct EpiGlu {
    static constexpr bool PERM = true;
    const bf16* Gm; bf16* MIX;
    __device__ __forceinline__ void operator()(AccRef acc, const Unit& u, int wr, int wc, int fr, int fq) const {
        const int row0 = u.r0 + wr * 64 + fr, colb = u.c0 + wc * 32 + 8 * fq;
#pragma unroll
        for (int ai = 0; ai < 2; ++ai)
#pragma unroll
            for (int m = 0; m < 4; ++m) { const int row = row0 + ai * HALF + m * 16;
#pragma unroll
                for (int bj = 0; bj < 2; ++bj) { const int col = colb + bj * HALF;
                    const v4u gw = *(const v4u*)(Gm + (size_t)row * 512 + col);
                    const f32x4 a0 = acc[ai][bj][m][0], a1 = acc[ai][bj][m][1];
                    f32x4 y0, y1;
                    y0[0] = bflo(gw.x) * sigmoidf_(a0[0]); y0[1] = bfhi(gw.x) * sigmoidf_(a0[1]); y0[2] = bflo(gw.y) * sigmoidf_(a0[2]); y0[3] = bfhi(gw.y) * sigmoidf_(a0[3]);
                    y1[0] = bflo(gw.z) * sigmoidf_(a1[0]); y1[1] = bfhi(gw.z) * sigmoidf_(a1[1]); y1[2] = bflo(gw.w) * sigmoidf_(a1[2]); y1[3] = bfhi(gw.w) * sigmoidf_(a1[3]);
                    *(v4u*)(MIX + (size_t)row * D + 1024 + col) = pack8(y0, y1); } }
    }
};
struct EpiWo {
    static constexpr bool PERM = false;
    const float* X; bf16* X1B; float* part;
    __device__ __forceinline__ void operator()(AccRef acc, const Unit& u, int wr, int wc, int fr, int fq) const {
        const int row0 = u.r0 + wr * 64 + fr, col0 = u.c0 + wc * 32 + 4 * fq;
#pragma unroll
        for (int ai = 0; ai < 2; ++ai) {
            f32x4 xv[4][2][2];
#pragma unroll
            for (int m = 0; m < 4; ++m)
#pragma unroll
                for (int bj = 0; bj < 2; ++bj)
#pragma unroll
                    for (int n = 0; n < 2; ++n) xv[m][bj][n] = __builtin_nontemporal_load((const f32x4*)(X + (size_t)(row0 + ai * HALF + m * 16) * D + col0 + bj * HALF + n * 16));
#pragma unroll
            for (int m = 0; m < 4; ++m) { const int row = row0 + ai * HALF + m * 16; const size_t off = (size_t)row * D + col0; float ss = 0.f;
#pragma unroll
                for (int bj = 0; bj < 2; ++bj)
#pragma unroll
                    for (int n = 0; n < 2; ++n) { const f32x4 v = xv[m][bj][n] + acc[ai][bj][m][n];
                        ss += (v[0] * v[0] + v[1] * v[1]) + (v[2] * v[2] + v[3] * v[3]);
                        v2u w; w.x = pk2(v[0], v[1]); w.y = pk2(v[2], v[3]); *(v2u*)(X1B + off + bj * HALF + n * 16) = w; }
                ss += __shfl_xor(ss, 16); ss += __shfl_xor(ss, 32);
                if (fq == 0) part[(size_t)row * 32 + (u.c0 >> 8) * 4 + wc] = ss; }
            asm volatile("" ::: "memory");
        }
    }
};
struct EpiLogit {
    static constexpr bool PERM = false;
    float* LP;
    __device__ __forceinline__ void operator()(AccRef acc, const Unit& u, int wr, int wc, int fr, int fq) const {
        const int row0 = u.r0 + wr * 64 + fr, col0 = wc * 32 + 4 * fq; float* base = LP + (size_t)u.aux * T * 80;
#pragma unroll
        for (int ai = 0; ai < 2; ++ai)
#pragma unroll
            for (int m = 0; m < 4; ++m) { float* rowp = base + (size_t)(row0 + ai * HALF + m * 16) * 80 + col0;
#pragma unroll
                for (int n = 0; n < 2; ++n) if (col0 + n * 16 < 80) *(f32x4*)(rowp + n * 16) = acc[ai][0][m][n]; }
    }
};
struct EpiGU {
    static constexpr bool PERM = true;
    const int* list; const float* rstd; const LAS int* cnt; bf16* ACT;
    __device__ __forceinline__ void operator()(AccRef acc, const Unit& u, int wr, int wc, int fr, int fq) const {
        const int e = u.aux, nreal = cnt[e], rb = wr * 64 + fr, colb = u.c0 * 128 + wc * 32 + 8 * fq;
#pragma unroll
        for (int ai = 0; ai < 2; ++ai)
#pragma unroll
            for (int m = 0; m < 4; ++m) { const int r = rb + ai * HALF + m * 16; int rr = u.r1 + r; rr = rr < nreal ? rr : nreal - 1;
                const float rs = rstd[list[(size_t)e * LCAP + rr] >> 1];
                f32x4 y0, y1;
#pragma unroll
                for (int j = 0; j < 4; ++j) { const float g0 = acc[ai][0][m][0][j] * rs, g1 = acc[ai][0][m][1][j] * rs;
                    y0[j] = g0 * sigmoidf_(g0) * (acc[ai][1][m][0][j] * rs); y1[j] = g1 * sigmoidf_(g1) * (acc[ai][1][m][1][j] * rs); }
                *(v4u*)(ACT + (size_t)(u.r0 + r) * DEXP + colb) = pack8(y0, y1); }
    }
};
struct EpiDown {
    static constexpr bool PERM = true;
    const int* list; const float* wts; const LAS int* cnt; bf16* Y2;
    __device__ __forceinline__ void operator()(AccRef acc, const Unit& u, int wr, int wc, int fr, int fq) const {
        const int e = u.aux, n = cnt[e], row0 = u.r1 + wr * 64 + fr, colb = u.c0 * 256 + wc * 32 + 8 * fq;
#pragma unroll
        for (int ai = 0; ai < 2; ++ai)
#pragma unroll
            for (int m = 0; m < 4; ++m) { const int r = row0 + ai * HALF + m * 16;
                if (r < n) { const int ent = list[(size_t)e * LCAP + r]; const float w = wts[ent]; bf16* rowp = Y2 + (size_t)ent * D + colb;
#pragma unroll
                    for (int bj = 0; bj < 2; ++bj) *(v4u*)(rowp + bj * HALF) = pack8(acc[ai][bj][m][0] * w, acc[ai][bj][m][1] * w); } }
    }
};
struct KSplitOrder {
    const char* A; const char* Bt; int lda, ldb, K, nM, nks, G, c;
    __device__ bool next(int i, Unit& u) const {
        const int L = i * G + c; if (L >= nM * nks) return false;
        const int pm = L / nks, ks = L % nks;
        u.a = A + ((size_t)pm * BM * lda + (size_t)ks * K) * 2; u.b = Bt + (size_t)ks * BM * ldb * 2; u.r0 = pm * BM; u.c0 = 0; u.aux = ks; u.r1 = 0; return true;
    }
    __device__ __forceinline__ unsigned arow(const Unit&, int) const { return 0u; }
};
}

struct Frame {
    LAS unsigned char* lds;
    unsigned* ctl;
    int tid, lane, wave, vcu, G;
    const float* in[31]; float* out; unsigned char* ws;
};
enum { I_X = 0, I_MEM, I_NORM_MIX, I_W_IN, I_Q_NORM, I_K_NORM, I_SINKS, I_REL_BIAS, I_LAM_RE, I_LAM_IM, I_LOG_DT, I_B_RE, I_B_IM, I_C_RE, I_C_IM, I_SSM_D, I_W_GLU,
       I_MEM_NORM, I_W_MEM_KV, I_XQ_NORM, I_XK_NORM, I_ON_ATTN, I_ON_SSM, I_ON_X, I_W_O, I_NORM_FFN, I_WR_G, I_WR_E, I_W_GATE, I_W_UP, I_W_DOWN };

struct TrItem { const float* W; bf16* WT; const float* ks; int ldw, ldt, k0, n0, drow0; };
__device__ __forceinline__ void tr_load(const TrItem& it, f32x4 (&v)[8], int lane) {
    const int kc = lane & 7, nq = lane >> 3; const float* src = it.W + (size_t)(it.k0 + kc * 8) * it.ldw + it.n0 + nq * 4;
#pragma unroll
    for (int j = 0; j < 8; ++j) v[j] = __builtin_nontemporal_load((const f32x4*)(src + (size_t)j * it.ldw));
}
__device__ __forceinline__ void tr_store(const TrItem& it, f32x4 (&v)[8], int lane) {
    const int kc = lane & 7, nq = lane >> 3;
    if (it.ks) { const f32x4 s0 = *(const f32x4*)(it.ks + it.k0 + kc * 8), s1 = *(const f32x4*)(it.ks + it.k0 + kc * 8 + 4);
#pragma unroll
        for (int j = 0; j < 4; ++j) { v[j] = v[j] * s0[j]; v[4 + j] = v[4 + j] * s1[j]; } }
#pragma unroll
    for (int i = 0; i < 4; ++i) { v4u o; o.x = pk2(v[0][i], v[1][i]); o.y = pk2(v[2][i], v[3][i]); o.z = pk2(v[4][i], v[5][i]); o.w = pk2(v[6][i], v[7][i]);
        *(v4u*)(it.WT + (size_t)(it.drow0 + nq * 4 + i) * it.ldt + it.k0 + kc * 8) = o; }
}
__device__ __forceinline__ void rms_row_to_bf16(const float* xrow, const float* gain, bf16* orow, int lane) {
    const f32x4* xr = (const f32x4*)xrow + lane; const f32x4* gr = (const f32x4*)gain + lane;
    f32x4 v[8]; float s = 0.f;
#pragma unroll
    for (int j = 0; j < 8; ++j) { v[j] = xr[64 * j]; s += (v[j].x * v[j].x + v[j].y * v[j].y) + (v[j].z * v[j].z + v[j].w * v[j].w); }
    const float rstd = 1.0f / sqrtf(wave_sum(s) * (1.f / 2048.f) + EPS);
    v2u* o8 = (v2u*)orow + lane;
#pragma unroll
    for (int j = 0; j < 8; ++j) { const f32x4 g = gr[64 * j]; v2u w; w.x = pk2(v[j].x * rstd * g.x, v[j].y * rstd * g.y); w.y = pk2(v[j].z * rstd * g.z, v[j].w * rstd * g.w); o8[64 * j] = w; }
}

__device__ __forceinline__ void s5_tables(Frame& F, int g) {
    LAS float* ap = (LAS float*)F.lds;
    LAS float* Bb = ap + 33 * 64 * 2;
    LAS float* Cc = Bb + 64 * 16 * 2;
    LAS float* Km = Cc + 16 * 64 * 2;
    const float dt = expf(F.in[I_LOG_DT][g]);
    const float* lre = F.in[I_LAM_RE] + g * 64; const float* lim = F.in[I_LAM_IM] + g * 64;
    for (int idx = F.tid; idx < 33 * 64; idx += 512) { const int tau = idx >> 6, n = idx & 63; const float lr = lre[n], li = lim[n];
        const float mag = expf((float)tau * (lr * dt)), ang = (float)tau * (li * dt); ap[idx * 2] = mag * cosf(ang); ap[idx * 2 + 1] = mag * sinf(ang); }
    __syncthreads();
    for (int idx = F.tid; idx < 64 * 16; idx += 512) { const int n = idx >> 4; const float lr = lre[n], li = lim[n];
        const float nr = ap[(64 + n) * 2] - 1.0f, ni = ap[(64 + n) * 2 + 1], den = lr * lr + li * li;
        const float cr = (nr * lr + ni * li) / den, ci = (ni * lr - nr * li) / den;
        const float br = F.in[I_B_RE][(size_t)g * 1024 + idx], bi = F.in[I_B_IM][(size_t)g * 1024 + idx];
        Bb[idx * 2] = cr * br - ci * bi; Bb[idx * 2 + 1] = cr * bi + ci * br; }
    for (int idx = F.tid; idx < 16 * 64; idx += 512) { Cc[idx * 2] = F.in[I_C_RE][(size_t)g * 1024 + idx]; Cc[idx * 2 + 1] = F.in[I_C_IM][(size_t)g * 1024 + idx]; }
    __syncthreads();
    for (int idx = F.tid; idx < 32 * 256; idx += 512) { const int tau = idx >> 8, c = (idx >> 4) & 15, c2 = idx & 15; float s = 0.f;
        for (int n = 0; n < 64; ++n) { const float ar = ap[(tau * 64 + n) * 2], ai = ap[(tau * 64 + n) * 2 + 1], cr = Cc[(c * 64 + n) * 2], ci = Cc[(c * 64 + n) * 2 + 1];
            const float er = cr * ar - ci * ai, ei = cr * ai + ci * ar; s += er * Bb[(n * 16 + c2) * 2] - ei * Bb[(n * 16 + c2) * 2 + 1]; }
        Km[idx] = s; }
    __syncthreads();
    bf16* MQ = (bf16*)(F.ws + WS_MQ) + (size_t)g * 512 * S5K;
    for (int idx = F.tid; idx < 512 * 80; idx += 512) { const int row = idx / 80, ch = idx % 80, i = row >> 4, c = row & 15, k0 = ch * 8; float v[8];
        if (k0 < 512) { const int s = k0 >> 4, c20 = k0 & 15, tau = i - s;
#pragma unroll
            for (int j = 0; j < 8; ++j) v[j] = tau >= 0 ? Km[(tau * 16 + c) * 16 + c20 + j] : 0.f;
        } else { const int kk = k0 - 512, ri = kk >> 6, n0 = kk & 63;
#pragma unroll
            for (int j = 0; j < 8; ++j) { const int n = n0 + j; const float ar = ap[((i + 1) * 64 + n) * 2], ai = ap[((i + 1) * 64 + n) * 2 + 1], cr = Cc[(c * 64 + n) * 2], ci = Cc[(c * 64 + n) * 2 + 1];
                v[j] = ri == 0 ? (cr * ar - ci * ai) : -(cr * ai + ci * ar); } }
        v4u o; o.x = pk2(v[0], v[1]); o.y = pk2(v[2], v[3]); o.z = pk2(v[4], v[5]); o.w = pk2(v[6], v[7]);
        *(v4u*)(MQ + (size_t)row * S5K + k0) = o; }
    bf16* SP = (bf16*)(F.ws + WS_SP) + (size_t)g * 256 * 512;
    for (int idx = F.tid; idx < 256 * 64; idx += 512) { const int row = idx >> 6, k0 = (idx & 63) * 8; float v[8];
        if (row < 128) { const int ri = row >> 6, n = row & 63, s = k0 >> 4, c20 = k0 & 15; const float ar = ap[((31 - s) * 64 + n) * 2], ai = ap[((31 - s) * 64 + n) * 2 + 1];
#pragma unroll
            for (int j = 0; j < 8; ++j) { const float br = Bb[(n * 16 + c20 + j) * 2], bi = Bb[(n * 16 + c20 + j) * 2 + 1]; v[j] = ri == 0 ? (ar * br - ai * bi) : (ar * bi + ai * br); }
        } else {
#pragma unroll
            for (int j = 0; j < 8; ++j) v[j] = 0.f; }
        v4u o; o.x = pk2(v[0], v[1]); o.y = pk2(v[2], v[3]); o.z = pk2(v[4], v[5]); o.w = pk2(v[6], v[7]);
        *(v4u*)(SP + (size_t)row * 512 + k0) = o; }
    float* AL = (float*)(F.ws + WS_AL) + g * 128;
    if (F.tid < 64) { AL[F.tid * 2] = ap[(32 * 64 + F.tid) * 2]; AL[F.tid * 2 + 1] = ap[(32 * 64 + F.tid) * 2 + 1]; }
    __syncthreads();
}

__device__ __forceinline__ void p0_prologue(Frame& F) {
    if (F.vcu < 32) s5_tables(F, F.vcu);
    const int gw = F.vcu * 8 + F.wave, NGW = F.G * 8;
    bf16* WinT = (bf16*)(F.ws + WS_WIN); bf16* WoT = (bf16*)(F.ws + WS_WO); bf16* WmkvT = (bf16*)(F.ws + WS_WMKV); bf16* WgluT = (bf16*)(F.ws + WS_WGLU);
    bf16* WguT = (bf16*)(F.ws + WS_WGU); bf16* WdT = (bf16*)(F.ws + WS_WD);
    const float* nf = F.in[I_NORM_FFN];
    constexpr int I_IN = 32 * 72, I_O = 32 * 64, I_MKV = 32 * 32, I_GLU = 8 * 16, I_E = 512;
    constexpr int NITEMS = I_IN + I_O + I_MKV + I_GLU + 3 * 64 * I_E;
    auto decode = [&](int it) -> TrItem {
        int r = it;
        if (r < I_IN) { const int kb = r / 72, nb = r % 72; return TrItem{F.in[I_W_IN], WinT, nullptr, INC, D, kb * 64, nb * 32, nb * 32}; } r -= I_IN;
        if (r < I_O) { const int kb = r / 64, nb = r % 64; return TrItem{F.in[I_W_O], WoT, nullptr, D, D, kb * 64, nb * 32, nb * 32}; } r -= I_O;
        if (r < I_MKV) { const int kb = r / 32, nb = r % 32; return TrItem{F.in[I_W_MEM_KV], WmkvT, nullptr, 1024, D, kb * 64, nb * 32, nb * 32}; } r -= I_MKV;
        if (r < I_GLU) { const int kb = r / 16, nb = r % 16; return TrItem{F.in[I_W_GLU], WgluT, nullptr, 512, 512, kb * 64, nb * 32, nb * 32}; } r -= I_GLU;
        const int which = r / (64 * I_E), rr = r % (64 * I_E), e = rr / I_E, q = rr % I_E;
        if (which < 2) { const int kb = q / 16, nb = q % 16, n0 = nb * 32;
            return TrItem{F.in[which == 0 ? I_W_GATE : I_W_UP] + (size_t)e * D * DEXP, WguT + (size_t)e * 1024 * D, nf, DEXP, D, kb * 64, n0, (n0 >> 7) * 256 + which * 128 + (n0 & 127)}; }
        const int kb = q / 64, nb = q % 64;
        return TrItem{F.in[I_W_DOWN] + (size_t)e * DEXP * D, WdT + (size_t)e * D * DEXP, nullptr, D, DEXP, kb * 64, nb * 32, nb * 32};
    };
    {
        f32x4 va[8], vb[8]; int it = gw; TrItem ia, ib;
        if (it < NITEMS) { ia = decode(it); tr_load(ia, va, F.lane); }
        while (it < NITEMS) {
            const int it2 = it + NGW; if (it2 < NITEMS) { ib = decode(it2); tr_load(ib, vb, F.lane); }
            tr_store(ia, va, F.lane);
            if (it2 >= NITEMS) break;
            const int it3 = it2 + NGW; if (it3 < NITEMS) { ia = decode(it3); tr_load(ia, va, F.lane); }
            tr_store(ib, vb, F.lane);
            it = it3;
        }
    }
    { bf16* WrT = (bf16*)(F.ws + WS_WR); const int gt = F.vcu * 512 + F.tid, NT = F.G * 512;
      for (int idx = gt; idx < 4 * 256 * 512; idx += NT) { const int ks = idx >> 17, n = (idx >> 9) & 255, k = ks * 512 + (idx & 511); float v = 0.f;
          if (n < 8) v = F.in[I_WR_G][k * 8 + n] * nf[k]; else if (n < 72) v = F.in[I_WR_E][k * 64 + (n - 8)] * nf[k];
          WrT[idx] = (bf16)f2bf(v); } }
    bf16* XN = (bf16*)(F.ws + WS_XN); bf16* MEMN = (bf16*)(F.ws + WS_MEMN);
    for (int m = gw; m < T; m += NGW) rms_row_to_bf16(F.in[I_X] + (size_t)m * D, F.in[I_NORM_MIX], XN + (size_t)m * D, F.lane);
    for (int m = gw; m < NB * MEML; m += NGW) rms_row_to_bf16(F.in[I_MEM] + (size_t)m * D, F.in[I_MEM_NORM], MEMN + (size_t)m * D, F.lane);
}

constexpr int SWA_KS = 72, SWA_VS = 264;
constexpr int SWA_KOFF = 0, SWA_VOFF = 256 * SWA_KS * 2, SWA_BOFF = SWA_VOFF + 64 * SWA_VS * 2;
__device__ __forceinline__ int t5_bucket(int n) { if (n < 16) return n; const int v = 16 + (int)(logf((float)n * (1.0f / 16.0f)) / logf(8.0f) * 16.0f); return v < 31 ? v : 31; }
__device__ __forceinline__ void swa_unit(Frame& F, int unit) {
    const int b = unit >> 5, kvh = (unit >> 4) & 1, nb = unit & 15;
    const bf16* PROJ = (const bf16*)(F.ws + WS_PROJ); bf16* MIX = (bf16*)(F.ws + WS_MIX);
    LAS bf16* Ks = (LAS bf16*)(F.lds + SWA_KOFF); LAS bf16* Vt = (LAS bf16*)(F.lds + SWA_VOFF); LAS float* bt = (LAS float*)(F.lds + SWA_BOFF);
    __syncthreads();
    {
        const int key = F.tid >> 1, half = F.tid & 1, s = (nb - 1) * 128 + key;
        v4u kw[4], vw[4];
        if (s >= 0) { const bf16* rp = PROJ + (size_t)(b * SEQ + s) * INC + 1024 + kvh * 64 + half * 32;
#pragma unroll
            for (int j = 0; j < 4; ++j) { kw[j] = *(const v4u*)(rp + j * 8); vw[j] = *(const v4u*)(rp + 128 + j * 8); }
        } else {
#pragma unroll
            for (int j = 0; j < 4; ++j) { kw[j] = (v4u){0u, 0u, 0u, 0u}; vw[j] = (v4u){0u, 0u, 0u, 0u}; } }
        float kf[32]; float ss = 0.f;
#pragma unroll
        for (int j = 0; j < 4; ++j) { kf[j * 8 + 0] = bflo(kw[j].x); kf[j * 8 + 1] = bfhi(kw[j].x); kf[j * 8 + 2] = bflo(kw[j].y); kf[j * 8 + 3] = bfhi(kw[j].y);
            kf[j * 8 + 4] = bflo(kw[j].z); kf[j * 8 + 5] = bfhi(kw[j].z); kf[j * 8 + 6] = bflo(kw[j].w); kf[j * 8 + 7] = bfhi(kw[j].w); }
#pragma unroll
        for (int j = 0; j < 32; ++j) ss += kf[j] * kf[j];
        ss += __shfl_xor(ss, 1);
        const float rstd = 1.0f / sqrtf(ss * (1.f / 64.f) + EPS);
        const float* kn = F.in[I_K_NORM] + half * 32;
#pragma unroll
        for (int j = 0; j < 4; ++j) { v4u o; o.x = pk2(kf[j * 8 + 0] * rstd * kn[j * 8 + 0], kf[j * 8 + 1] * rstd * kn[j * 8 + 1]); o.y = pk2(kf[j * 8 + 2] * rstd * kn[j * 8 + 2], kf[j * 8 + 3] * rstd * kn[j * 8 + 3]);
            o.z = pk2(kf[j * 8 + 4] * rstd * kn[j * 8 + 4], kf[j * 8 + 5] * rstd * kn[j * 8 + 5]); o.w = pk2(kf[j * 8 + 6] * rstd * kn[j * 8 + 6], kf[j * 8 + 7] * rstd * kn[j * 8 + 7]);
            *(LAS v4u*)(Ks + key * SWA_KS + half * 32 + j * 8) = o; }
#pragma unroll
        for (int j = 0; j < 4; ++j) { const unsigned w4[4] = {vw[j].x, vw[j].y, vw[j].z, vw[j].w};
#pragma unroll
            for (int q = 0; q < 4; ++q) { const int d = half * 32 + j * 8 + q * 2; Vt[d * SWA_VS + key] = (bf16)(w4[q] & 0xffffu); Vt[(d + 1) * SWA_VS + key] = (bf16)(w4[q] >> 16); } }
        for (int idx = F.tid; idx < 8 * 128; idx += 512) { const int w = idx >> 7, dl = idx & 127; bt[idx] = F.in[I_REL_BIAS][t5_bucket(dl) * 16 + kvh * 8 + w]; }
    }
    __syncthreads();
    const int w = F.wave, h = kvh * 8 + w, ql = F.lane & 31, hh = F.lane >> 5;
    const float sink = F.in[I_SINKS][h];
    const float* qn = F.in[I_Q_NORM];
    for (int r = 0; r < 4; ++r) {
        const int qi = 32 * r + ql; const size_t t = (size_t)b * SEQ + nb * 128 + qi;
        bf16x8 qf[4];
        {   const bf16* qp = PROJ + t * INC + h * 64 + 8 * hh; v4u qw[4]; float qv[32]; float ss = 0.f;
#pragma unroll
            for (int ks = 0; ks < 4; ++ks) qw[ks] = *(const v4u*)(qp + ks * 16);
#pragma unroll
            for (int ks = 0; ks < 4; ++ks) { qv[ks * 8 + 0] = bflo(qw[ks].x); qv[ks * 8 + 1] = bfhi(qw[ks].x); qv[ks * 8 + 2] = bflo(qw[ks].y); qv[ks * 8 + 3] = bfhi(qw[ks].y);
                qv[ks * 8 + 4] = bflo(qw[ks].z); qv[ks * 8 + 5] = bfhi(qw[ks].z); qv[ks * 8 + 6] = bflo(qw[ks].w); qv[ks * 8 + 7] = bfhi(qw[ks].w); }
#pragma unroll
            for (int j = 0; j < 32; ++j) ss += qv[j] * qv[j];
            ss += __shfl_xor(ss, 32);
            const float sc = 0.125f / sqrtf(ss * (1.f / 64.f) + EPS);
#pragma unroll
            for (int ks = 0; ks < 4; ++ks) { const float* g = qn + ks * 16 + 8 * hh; v4u o;
                o.x = pk2(qv[ks * 8 + 0] * sc * g[0], qv[ks * 8 + 1] * sc * g[1]); o.y = pk2(qv[ks * 8 + 2] * sc * g[2], qv[ks * 8 + 3] * sc * g[3]);
                o.z = pk2(qv[ks * 8 + 4] * sc * g[4], qv[ks * 8 + 5] * sc * g[5]); o.w = pk2(qv[ks * 8 + 6] * sc * g[6], qv[ks * 8 + 7] * sc * g[7]);
                qf[ks] = __builtin_bit_cast(bf16x8, o); } }
        f32x16 s[5];
        const int qh = ql - 4 * hh; const LAS float* pb = bt + w * 128 + qh;
        float mx = sink;
#pragma unroll
        for (int kt = 0; kt < 5; ++kt) {
            const bool live = (nb > 0) || (r + kt >= 4);
            f32x16 a = {0.f, 0.f, 0.f, 0.f, 0.f, 0.f, 0.f, 0.f, 0.f, 0.f, 0.f, 0.f, 0.f, 0.f, 0.f, 0.f};
            if (live) {
#pragma unroll
                for (int ks = 0; ks < 4; ++ks) { const bf16x8 kfrag = *(const LAS bf16x8*)(Ks + (32 * (r + kt) + ql) * SWA_KS + ks * 16 + 8 * hh);
                    a = __builtin_amdgcn_mfma_f32_32x32x16_bf16(kfrag, qf[ks], a, 0, 0, 0); }
#pragma unroll
                for (int rg = 0; rg < 16; ++rg) { const int rowc = (rg & 3) + 8 * (rg >> 2);
                    float v = a[rg] + pb[128 - 32 * kt - rowc];
                    if (kt == 0) v = (rowc > qh) ? v : -1e30f;
                    if (kt == 4) v = (rowc <= qh) ? v : -1e30f;
                    a[rg] = v; mx = fmaxf(mx, v); }
            } else {
#pragma unroll
                for (int rg = 0; rg < 16; ++rg) a[rg] = -1e30f;
            }
            s[kt] = a; }
        mx = fmaxf(mx, __shfl_xor(mx, 32));
        float l = 0.f;
#pragma unroll
        for (int kt = 0; kt < 5; ++kt)
#pragma unroll
            for (int rg = 0; rg < 16; ++rg) { const float p = fast_exp(s[kt][rg] - mx); s[kt][rg] = p; l += p; }
        l += __shfl_xor(l, 32);
        l += fast_exp(sink - mx);
        f32x16 o[2];
#pragma unroll
        for (int dt = 0; dt < 2; ++dt) o[dt] = (f32x16){0.f, 0.f, 0.f, 0.f, 0.f, 0.f, 0.f, 0.f, 0.f, 0.f, 0.f, 0.f, 0.f, 0.f, 0.f, 0.f};
#pragma unroll
        for (int kt = 0; kt < 5; ++kt)
#pragma unroll
            for (int st = 0; st < 2; ++st) { v4u pw; pw.x = pk2(s[kt][8 * st + 0], s[kt][8 * st + 1]); pw.y = pk2(s[kt][8 * st + 2], s[kt][8 * st + 3]); pw.z = pk2(s[kt][8 * st + 4], s[kt][8 * st + 5]); pw.w = pk2(s[kt][8 * st + 6], s[kt][8 * st + 7]);
                const bf16x8 pf = __builtin_bit_cast(bf16x8, pw);
#pragma unroll
                for (int dt = 0; dt < 2; ++dt) { const LAS bf16* vp = Vt + (dt * 32 + ql) * SWA_VS + 32 * (r + kt) + 16 * st + 4 * hh;
                    const v2u lo = *(const LAS v2u*)vp, hi = *(const LAS v2u*)(vp + 8); v4u vv; vv.x = lo.x; vv.y = lo.y; vv.z = hi.x; vv.w = hi.y;
                    o[dt] = __builtin_amdgcn_mfma_f32_32x32x16_bf16(__builtin_bit_cast(bf16x8, vv), pf, o[dt], 0, 0, 0); } }
        const float inv = 1.0f / l;
        bf16* op = MIX + t * D + h * 64 + 4 * hh;
#pragma unroll
        for (int dt = 0; dt < 2; ++dt)
#pragma unroll
            for (int q4 = 0; q4 < 4; ++q4) { v2u ow; ow.x = pk2(o[dt][q4 * 4 + 0] * inv, o[dt][q4 * 4 + 1] * inv); ow.y = pk2(o[dt][q4 * 4 + 2] * inv, o[dt][q4 * 4 + 3] * inv);
                *(v2u*)(op + dt * 32 + q4 * 8) = ow; }
    }
}

constexpr int XA_KS = 136, XA_VS = 264;
constexpr int XA_KOFF = 0, XA_VOFF = 256 * XA_KS * 2;
__device__ __forceinline__ void xattn_unit(Frame& F, int unit) {
    const int b = unit >> 5, hx = (unit >> 3) & 3, qb = unit & 7;
    const bf16* PROJ = (const bf16*)(F.ws + WS_PROJ); const bf16* MKV = (const bf16*)(F.ws + WS_MEMKV); bf16* MIX = (bf16*)(F.ws + WS_MIX);
    LAS bf16* Ks = (LAS bf16*)(F.lds + XA_KOFF); LAS bf16* Vt = (LAS bf16*)(F.lds + XA_VOFF);
    __syncthreads();
    {   const int key = F.tid >> 1, half = F.tid & 1; const bf16* rp = MKV + (size_t)(b * MEML + key) * 1024 + hx * 128 + half * 64;
        float ss = 0.f; v4u kw[8];
#pragma unroll
        for (int j = 0; j < 8; ++j) { kw[j] = *(const v4u*)(rp + j * 8);
            const float a0 = bflo(kw[j].x), a1 = bfhi(kw[j].x), a2 = bflo(kw[j].y), a3 = bfhi(kw[j].y), a4 = bflo(kw[j].z), a5 = bfhi(kw[j].z), a6 = bflo(kw[j].w), a7 = bfhi(kw[j].w);
            ss += (a0 * a0 + a1 * a1) + (a2 * a2 + a3 * a3) + (a4 * a4 + a5 * a5) + (a6 * a6 + a7 * a7); }
        ss += __shfl_xor(ss, 1);
        const float rstd = 1.0f / sqrtf(ss * (1.f / 128.f) + EPS);
        const float* kn = F.in[I_XK_NORM] + half * 64;
#pragma unroll
        for (int j = 0; j < 8; ++j) { v4u o; const float* g = kn + j * 8;
            o.x = pk2(bflo(kw[j].x) * rstd * g[0], bfhi(kw[j].x) * rstd * g[1]); o.y = pk2(bflo(kw[j].y) * rstd * g[2], bfhi(kw[j].y) * rstd * g[3]);
            o.z = pk2(bflo(kw[j].z) * rstd * g[4], bfhi(kw[j].z) * rstd * g[5]); o.w = pk2(bflo(kw[j].w) * rstd * g[6], bfhi(kw[j].w) * rstd * g[7]);
            *(LAS v4u*)(Ks + key * XA_KS + half * 64 + j * 8) = o; }
#pragma unroll
        for (int j = 0; j < 8; ++j) { const v4u vw = *(const v4u*)(rp + 512 + j * 8); const unsigned w4[4] = {vw.x, vw.y, vw.z, vw.w};
#pragma unroll
            for (int q = 0; q < 4; ++q) { const int d = half * 64 + j * 8 + q * 2; Vt[d * XA_VS + key] = (bf16)(w4[q] & 0xffffu); Vt[(d + 1) * XA_VS + key] = (bf16)(w4[q] >> 16); } }
    }
    __syncthreads();
    const int ql = F.lane & 31, hh = F.lane >> 5;
    const size_t t = (size_t)b * SEQ + qb * 256 + F.wave * 32 + ql;
    bf16x8 qf[8];
    {   const bf16* qp = PROJ + t * INC + 1792 + hx * 128 + 8 * hh; v4u qw[8]; float ss = 0.f;
#pragma unroll
        for (int ks = 0; ks < 8; ++ks) { qw[ks] = *(const v4u*)(qp + ks * 16);
            const float a0 = bflo(qw[ks].x), a1 = bfhi(qw[ks].x), a2 = bflo(qw[ks].y), a3 = bfhi(qw[ks].y), a4 = bflo(qw[ks].z), a5 = bfhi(qw[ks].z), a6 = bflo(qw[ks].w), a7 = bfhi(qw[ks].w);
            ss += (a0 * a0 + a1 * a1) + (a2 * a2 + a3 * a3) + (a4 * a4 + a5 * a5) + (a6 * a6 + a7 * a7); }
        ss += __shfl_xor(ss, 32);
        const float sc = 0.08838834764831845f / sqrtf(ss * (1.f / 128.f) + EPS);
        const float* qn = F.in[I_XQ_NORM] + 8 * hh;
#pragma unroll
        for (int ks = 0; ks < 8; ++ks) { const float* g = qn + ks * 16; v4u o;
            o.x = pk2(bflo(qw[ks].x) * sc * g[0], bfhi(qw[ks].x) * sc * g[1]); o.y = pk2(bflo(qw[ks].y) * sc * g[2], bfhi(qw[ks].y) * sc * g[3]);
            o.z = pk2(bflo(qw[ks].z) * sc * g[4], bfhi(qw[ks].z) * sc * g[5]); o.w = pk2(bflo(qw[ks].w) * sc * g[6], bfhi(qw[ks].w) * sc * g[7]);
            qf[ks] = __builtin_bit_cast(bf16x8, o); } }
    f32x16 o[4];
#pragma unroll
    for (int dt = 0; dt < 4; ++dt) o[dt] = (f32x16){0.f, 0.f, 0.f, 0.f, 0.f, 0.f, 0.f, 0.f, 0.f, 0.f, 0.f, 0.f, 0.f, 0.f, 0.f, 0.f};
    float mrun = -1e30f, lrun = 0.f;
    for (int kb = 0; kb < 4; ++kb) {
        f32x16 s[2];
#pragma unroll
        for (int kt = 0; kt < 2; ++kt) { f32x16 a = {0.f, 0.f, 0.f, 0.f, 0.f, 0.f, 0.f, 0.f, 0.f, 0.f, 0.f, 0.f, 0.f, 0.f, 0.f, 0.f};
#pragma unroll
            for (int ks = 0; ks < 8; ++ks) { const bf16x8 kfrag = *(const LAS bf16x8*)(Ks + (64 * kb + 32 * kt + ql) * XA_KS + ks * 16 + 8 * hh);
                a = __builtin_amdgcn_mfma_f32_32x32x16_bf16(kfrag, qf[ks], a, 0, 0, 0); }
            s[kt] = a; }
        float mx = mrun;
#pragma unroll
        for (int kt = 0; kt < 2; ++kt)
#pragma unroll
            for (int rg = 0; rg < 16; ++rg) mx = fmaxf(mx, s[kt][rg]);
        mx = fmaxf(mx, __shfl_xor(mx, 32));
        const float alpha = fast_exp(mrun - mx); mrun = mx;
        float ls = 0.f;
#pragma unroll
        for (int kt = 0; kt < 2; ++kt)
#pragma unroll
            for (int rg = 0; rg < 16; ++rg) { const float p = fast_exp(s[kt][rg] - mx); s[kt][rg] = p; ls += p; }
        lrun = lrun * alpha + ls;
#pragma unroll
        for (int dt = 0; dt < 4; ++dt)
#pragma unroll
            for (int rg = 0; rg < 16; ++rg) o[dt][rg] *= alpha;
#pragma unroll
        for (int kt = 0; kt < 2; ++kt)
#pragma unroll
            for (int st = 0; st < 2; ++st) { v4u pw; pw.x = pk2(s[kt][8 * st + 0], s[kt][8 * st + 1]); pw.y = pk2(s[kt][8 * st + 2], s[kt][8 * st + 3]); pw.z = pk2(s[kt][8 * st + 4], s[kt][8 * st + 5]); pw.w = pk2(s[kt][8 * st + 6], s[kt][8 * st + 7]);
                const bf16x8 pf = __builtin_bit_cast(bf16x8, pw);
#pragma unroll
                for (int dt = 0; dt < 4; ++dt) { const LAS bf16* vp = Vt + (dt * 32 + ql) * XA_VS + 64 * kb + 32 * kt + 16 * st + 4 * hh;
                    const v2u lo = *(const LAS v2u*)vp, hi = *(const LAS v2u*)(vp + 8); v4u vv; vv.x = lo.x; vv.y = lo.y; vv.z = hi.x; vv.w = hi.y;
                    o[dt] = __builtin_amdgcn_mfma_f32_32x32x16_bf16(__builtin_bit_cast(bf16x8, vv), pf, o[dt], 0, 0, 0); } }
    }
    lrun += __shfl_xor(lrun, 32);
    const float inv = 1.0f / lrun;
    bf16* op = MIX + t * D + 1536 + hx * 128 + 4 * hh;
#pragma unroll
    for (int dt = 0; dt < 4; ++dt)
#pragma unroll
        for (int q4 = 0; q4 < 4; ++q4) { v2u ow; ow.x = pk2(o[dt][q4 * 4 + 0] * inv, o[dt][q4 * 4 + 1] * inv); ow.y = pk2(o[dt][q4 * 4 + 2] * inv, o[dt][q4 * 4 + 3] * inv);
            *(v2u*)(op + dt * 32 + q4 * 8) = ow; }
}

__device__ __forceinline__ void moe_tables(Frame& F) {
    LAS int* cnt = (LAS int*)(F.lds + TAB_OFF); LAS int* ts = cnt + 64;
    __syncthreads();
    if (F.tid < 64) { const int c = (int)__hip_atomic_load(F.ctl + CW_CNT + F.tid, __ATOMIC_RELAXED, __HIP_MEMORY_SCOPE_AGENT); const int nt = (c + 255) >> 8; int inc = nt;
#pragma unroll
        for (int o = 1; o < 64; o <<= 1) { const int v = __shfl_up(inc, o); if (F.tid >= o) inc += v; }
        cnt[F.tid] = c; ts[F.tid + 1] = inc; if (F.tid == 0) ts[0] = 0; }
    __syncthreads();
}

struct Args { const float* in[31]; float* out; unsigned char* ws; int ph_lo, ph_hi; };
__global__ void __launch_bounds__(512, 2) hymba_fwd(Args args) {
    extern __shared__ __attribute__((aligned(16))) unsigned char lds_raw[];
    Frame F;
    F.lds = (LAS unsigned char*)lds_raw;
    F.tid = threadIdx.x; F.lane = F.tid & 63; F.wave = __builtin_amdgcn_readfirstlane(F.tid >> 6);
    F.G = gridDim.x; { const int bx = blockIdx.x; F.vcu = (F.G % 8 == 0) ? (bx % 8) * (F.G / 8) + bx / 8 : bx; }
#pragma unroll
    for (int i = 0; i < 31; ++i) F.in[i] = args.in[i];
    F.out = args.out; F.ws = args.ws; F.ctl = (unsigned*)(args.ws + WS_CTL);
    const int lo = args.ph_lo, hi = args.ph_hi;
#if !MK_PER_PHASE
    if (F.tid < 4) ((LAS unsigned*)(F.lds + XBW_OFF))[F.tid] = 0u;
    __syncthreads();
    XcdBarrier bar = xcd_barrier_post(F.ctl + CW_BAR, (volatile LAS unsigned*)(F.lds + XBW_OFF));
#define GRID_BAR() xcd_barrier(bar)
#else
#define GRID_BAR() do {} while (0)
#endif
#define IN(k) (lo <= (k) && (k) < hi)
#define SEAM(k) do { if (IN(k) && IN((k) + 1)) GRID_BAR(); } while (0)
    const int gw = F.vcu * 8 + F.wave, NGW = F.G * 8;
    bf16* const XN = (bf16*)(F.ws + WS_XN); bf16* const PROJ = (bf16*)(F.ws + WS_PROJ); bf16* const MIX = (bf16*)(F.ws + WS_MIX);
    bf16* const UA = (bf16*)(F.ws + WS_UA); bf16* const Gm = (bf16*)(F.ws + WS_G);

    if (IN(0)) { p0_prologue(F); }
    SEAM(0);
    if (IN(1)) {
        { pg8::Gemm g{D, D, D}; pg8::DenseOrder S; S.init(XN, F.ws + WS_WIN, D, D, T, INC, F.G, (int)blockIdx.x);
          pg8::EpiProj E{PROJ, UA}; pg8::gemm_phase<pg8::EpiProj, pg8::DenseOrder>(F.lds, g, S, E); }
        { pg8::Gemm g{D, D, D}; pg8::DenseOrder S; S.init(F.ws + WS_MEMN, F.ws + WS_WMKV, D, D, NB * MEML, 1024, F.G, F.G - 1 - (int)blockIdx.x);
          pg8::EpiBf16 E{(bf16*)(F.ws + WS_MEMKV), 1024}; pg8::gemm_phase<pg8::EpiBf16, pg8::DenseOrder>(F.lds, g, S, E); }
    }
    SEAM(1);
    if (IN(2)) {
        for (int u = F.vcu; u < 256; u += F.G) swa_unit(F, u);
        __syncthreads();
        { pg8::Gemm g{S5K, 512, 512}; pg8::GroupOrder S{(const char*)UA, (const char*)(F.ws + WS_SP), S5K, 512, 1, 32, F.G, F.G - 1 - F.vcu};
          pg8::EpiF32 E{(float*)(F.ws + WS_SL), 256, (size_t)512 * 256}; pg8::gemm_phase<pg8::EpiF32, pg8::GroupOrder>(F.lds, g, S, E); }
    }
    SEAM(2);
    if (IN(3)) {
        if (F.wave == 0) {
            const float* SL = (const float*)(F.ws + WS_SL); const float* AL = (const float*)(F.ws + WS_AL);
            for (int p = F.vcu; p < 256; p += F.G) { const int b = p >> 5, g = p & 31, n = F.lane;
                const float ar = AL[(g * 64 + n) * 2], ai = AL[(g * 64 + n) * 2 + 1]; float xr = 0.f, xi = 0.f;
                for (int j0 = 0; j0 < 64; j0 += 8) { float sr[8], si[8];
#pragma unroll
                    for (int j = 0; j < 8; ++j) { const float* sp = SL + ((size_t)(g * 512 + b * 64 + j0 + j)) * 256; sr[j] = sp[n]; si[j] = sp[64 + n]; }
#pragma unroll
                    for (int j = 0; j < 8; ++j) { bf16* up = UA + ((size_t)(g * 512 + b * 64 + j0 + j)) * S5K + 512; up[n] = (bf16)f2bf(xr); up[64 + n] = (bf16)f2bf(xi);
                        const float nr = ar * xr - ai * xi + sr[j], ni = ar * xi + ai * xr + si[j]; xr = nr; xi = ni; } } }
        }
        for (int u = F.vcu; u < 256; u += F.G) xattn_unit(F, u);
        __syncthreads();
    }
    SEAM(3);
    if (IN(4)) {
        pg8::Gemm g{S5K, S5K, S5K}; pg8::GroupOrder S{(const char*)UA, (const char*)(F.ws + WS_MQ), S5K, S5K, 2, 32, F.G, F.vcu};
        pg8::EpiS5Y E{UA, F.in[I_SSM_D], Gm}; pg8::gemm_phase<pg8::EpiS5Y, pg8::GroupOrder>(F.lds, g, S, E);
    }
    SEAM(4);
    if (IN(5)) {
        pg8::Gemm g{512, 512, 512}; pg8::DenseOrder S; S.init(Gm, F.ws + WS_WGLU, 512, 512, T, 512, F.G, (int)blockIdx.x);
        pg8::EpiGlu E{Gm, MIX}; pg8::gemm_phase<pg8::EpiGlu, pg8::DenseOrder>(F.lds, g, S, E);
    }
    SEAM(5);
    if (IN(6)) {
        for (int m = gw; m < T; m += NGW) { v4u* rp = (v4u*)(MIX + (size_t)m * D) + F.lane; v4u w[4]; float ss[4];
#pragma unroll
            for (int j = 0; j < 4; ++j) { w[j] = rp[64 * j];
                const float a0 = bflo(w[j].x), a1 = bfhi(w[j].x), a2 = bflo(w[j].y), a3 = bfhi(w[j].y), a4 = bflo(w[j].z), a5 = bfhi(w[j].z), a6 = bflo(w[j].w), a7 = bfhi(w[j].w);
                ss[j] = (a0 * a0 + a1 * a1) + (a2 * a2 + a3 * a3) + (a4 * a4 + a5 * a5) + (a6 * a6 + a7 * a7); }
            const float sa = wave_sum(ss[0] + ss[1]), sb = wave_sum(ss[2]), sc = wave_sum(ss[3]);
            const float ra = 1.0f / sqrtf(sa * (1.f / 1024.f) + EPS), rb = 1.0f / sqrtf(sb * (1.f / 512.f) + EPS), rc = 1.0f / sqrtf(sc * (1.f / 512.f) + EPS);
#pragma unroll
            for (int j = 0; j < 4; ++j) { const float rs = j < 2 ? ra : (j == 2 ? rb : rc);
                const float* g = (j < 2 ? F.in[I_ON_ATTN] + j * 512 : (j == 2 ? F.in[I_ON_SSM] : F.in[I_ON_X])) + F.lane * 8; v4u o;
                o.x = pk2(bflo(w[j].x) * rs * g[0], bfhi(w[j].x) * rs * g[1]); o.y = pk2(bflo(w[j].y) * rs * g[2], bfhi(w[j].y) * rs * g[3]);
                o.z = pk2(bflo(w[j].z) * rs * g[4], bfhi(w[j].z) * rs * g[5]); o.w = pk2(bflo(w[j].w) * rs * g[6], bfhi(w[j].w) * rs * g[7]);
                rp[64 * j] = o; } }
    }
    SEAM(6);
    if (IN(7)) {
        pg8::Gemm g{D, D, D}; pg8::DenseOrder S; S.init(MIX, F.ws + WS_WO, D, D, T, D, F.G, (int)blockIdx.x);
        pg8::EpiWo E{F.in[I_X], XN, (float*)(F.ws + WS_PART)}; pg8::gemm_phase<pg8::EpiWo, pg8::DenseOrder>(F.lds, g, S, E);
    }
    SEAM(7);
    if (IN(8)) {
        pg8::Gemm g{D, 512, 512}; pg8::KSplitOrder S{(const char*)XN, (const char*)(F.ws + WS_WR), D, 512, 512, T / 256, 4, F.G, F.vcu};
        pg8::EpiLogit E{(float*)(F.ws + WS_LP)}; pg8::gemm_phase<pg8::EpiLogit, pg8::KSplitOrder>(F.lds, g, S, E);
    }
    SEAM(8);
    if (IN(9)) {
        LAS int* hist = (LAS int*)F.lds; LAS int* gbase = hist + 64;
        const float* LP = (const float*)(F.ws + WS_LP); const float* part = (const float*)(F.ws + WS_PART); float* rstdv = (float*)(F.ws + WS_RSTD);
        int* list = (int*)(F.ws + WS_LIST); float* wts = (float*)(F.ws + WS_WTS);
        const int per = (T + F.G - 1) / F.G, tbeg = F.vcu * per, tend = (tbeg + per) < T ? (tbeg + per) : T;
        for (int base = tbeg; base < tend; base += 512) {
            __syncthreads();
            if (F.tid < 64) hist[F.tid] = 0;
            __syncthreads();
            const int t = base + F.tid; const bool act = t < tend; int ea = 0, eb = 0, la = 0, lb = 0; float w1 = 0.f, w2 = 0.f;
            if (act) {
                const f32x4* pp = (const f32x4*)(part + (size_t)t * 32); float ss = 0.f;
#pragma unroll
                for (int j = 0; j < 8; ++j) { const f32x4 v = pp[j]; ss += (v[0] + v[1]) + (v[2] + v[3]); }
                const float rs = 1.0f / sqrtf(ss * (1.f / 2048.f) + EPS); rstdv[t] = rs;
                const float* l0 = LP + (size_t)t * 80; const float* l1 = l0 + (size_t)T * 80; const float* l2 = l1 + (size_t)T * 80; const float* l3 = l2 + (size_t)T * 80;
                float gl[8];
#pragma unroll
                for (int j = 0; j < 8; j += 4) { const f32x4 a = *(const f32x4*)(l0 + j), b = *(const f32x4*)(l1 + j), c = *(const f32x4*)(l2 + j), d = *(const f32x4*)(l3 + j);
#pragma unroll
                    for (int q = 0; q < 4; ++q) gl[j + q] = rs * (((a[q] + b[q]) + c[q]) + d[q]); }
                int gi = 0; float gm = gl[0];
#pragma unroll
                for (int j = 1; j < 8; ++j) if (gl[j] > gm) { gm = gl[j]; gi = j; }
                float gs = 0.f;
#pragma unroll
                for (int j = 0; j < 8; ++j) gs += expf(gl[j] - gm);
                const float gate = 1.0f / gs;
                float el[8];
#pragma unroll
                for (int j = 0; j < 8; j += 4) { const int o = 8 + gi * 8 + j; const f32x4 a = *(const f32x4*)(l0 + o), b = *(const f32x4*)(l1 + o), c = *(const f32x4*)(l2 + o), d = *(const f32x4*)(l3 + o);
#pragma unroll
                    for (int q = 0; q < 4; ++q) el[j + q] = rs * (((a[q] + b[q]) + c[q]) + d[q]); }
                int i1 = 0; float v1 = el[0];
#pragma unroll
                for (int j = 1; j < 8; ++j) if (el[j] > v1) { v1 = el[j]; i1 = j; }
                int i2 = -1; float v2 = -3.0e38f;
#pragma unroll
                for (int j = 0; j < 8; ++j) if (j != i1 && el[j] > v2) { v2 = el[j]; i2 = j; }
                const float ex = expf(v2 - v1); w1 = gate / (1.0f + ex); w2 = gate * ex / (1.0f + ex);
                ea = gi * 8 + i1; eb = gi * 8 + i2;
                la = __hip_atomic_fetch_add(hist + ea, 1, __ATOMIC_RELAXED, __HIP_MEMORY_SCOPE_WORKGROUP); lb = __hip_atomic_fetch_add(hist + eb, 1, __ATOMIC_RELAXED, __HIP_MEMORY_SCOPE_WORKGROUP);
            }
            __syncthreads();
            if (F.tid < 64) { const int hcount = hist[F.tid]; gbase[F.tid] = hcount ? (int)atomicAdd(F.ctl + CW_CNT + F.tid, (unsigned)hcount) : 0; }
            __syncthreads();
            if (act) { list[(size_t)ea * LCAP + gbase[ea] + la] = t * 2; list[(size_t)eb * LCAP + gbase[eb] + lb] = t * 2 + 1; wts[t * 2] = w1; wts[t * 2 + 1] = w2; }
        }
        __syncthreads();
    }
    SEAM(9);
    if (IN(10)) {
        moe_tables(F);
        const LAS int* cnt = (const LAS int*)(F.lds + TAB_OFF); const int* list = (const int*)(F.ws + WS_LIST);
        pg8::Gemm g{D, D, D}; pg8::MoeOrder S{(const char*)XN, (const char*)(F.ws + WS_WGU), cnt, cnt + 64, list, D, D, 4, 1024, F.G, F.vcu, true};
        pg8::EpiGU E{list, (const float*)(F.ws + WS_RSTD), cnt, (bf16*)(F.ws + WS_ACT)}; pg8::gemm_phase<pg8::EpiGU, pg8::MoeOrder, true>(F.lds, g, S, E);
    }
    SEAM(10);
    if (IN(11)) {
        moe_tables(F);
        const LAS int* cnt = (const LAS int*)(F.lds + TAB_OFF); const int* list = (const int*)(F.ws + WS_LIST);
        pg8::Gemm g{DEXP, DEXP, DEXP}; pg8::MoeOrder S{(const char*)(F.ws + WS_ACT), (const char*)(F.ws + WS_WD), cnt, cnt + 64, list, DEXP, DEXP, 8, 2048, F.G, F.vcu, false};
        pg8::EpiDown E{list, (const float*)(F.ws + WS_WTS), cnt, (bf16*)(F.ws + WS_Y2)};
        pg8::gemm_phase<pg8::EpiDown, pg8::MoeOrder>(F.lds, g, S, E);
    }
    SEAM(11);
    if (IN(12)) {
        const bf16* Y2 = (const bf16*)(F.ws + WS_Y2);
        for (int m = gw; m < T; m += NGW) { f32x4* op = (f32x4*)(F.out + (size_t)m * D) + F.lane * 2; const v4u* xb = (const v4u*)(XN + (size_t)m * D) + F.lane;
            const v4u* ya = (const v4u*)(Y2 + (size_t)m * 2 * D) + F.lane; const v4u* yb = ya + 256;
            v4u xw[4], aw[4], cw[4];
#pragma unroll
            for (int j = 0; j < 4; ++j) { xw[j] = __builtin_nontemporal_load(xb + 64 * j); aw[j] = __builtin_nontemporal_load(ya + 64 * j); cw[j] = __builtin_nontemporal_load(yb + 64 * j); }
#pragma unroll
            for (int j = 0; j < 4; ++j) { const v4u x = xw[j], a = aw[j], c = cw[j]; f32x4 x0, x1;
                x0[0] = bflo(x.x) + (bflo(a.x) + bflo(c.x)); x0[1] = bfhi(x.x) + (bfhi(a.x) + bfhi(c.x)); x0[2] = bflo(x.y) + (bflo(a.y) + bflo(c.y)); x0[3] = bfhi(x.y) + (bfhi(a.y) + bfhi(c.y));
                x1[0] = bflo(x.z) + (bflo(a.z) + bflo(c.z)); x1[1] = bfhi(x.z) + (bfhi(a.z) + bfhi(c.z)); x1[2] = bflo(x.w) + (bflo(a.w) + bflo(c.w)); x1[3] = bfhi(x.w) + (bfhi(a.w) + bfhi(c.w));
                __builtin_nontemporal_store(x0, op + 128 * j); __builtin_nontemporal_store(x1, op + 128 * j + 1); } }
    }
#undef IN
#undef SEAM
}

extern "C" void kernel_launch(void* const* d_in, const int* in_sizes, int n_in, void* d_out, int out_size, void* d_ws, size_t ws_size, hipStream_t stream) {
    static int grid = 0;
    if (grid == 0) {
        if (n_in != 31 || out_size != T * D || ws_size < WS_END) { fprintf(stderr, "kernel_launch: unexpected shapes (n_in %d out %d ws %zu)\n", n_in, out_size, ws_size); grid = -1; return; }
        int dev = 0, cus = 0, per_cu = 0;
        if (hipGetDevice(&dev) != hipSuccess || hipDeviceGetAttribute(&cus, hipDeviceAttributeMultiprocessorCount, dev) != hipSuccess) { grid = -1; return; }
        if (hipFuncSetAttribute((const void*)hymba_fwd, hipFuncAttributeMaxDynamicSharedMemorySize, LDS_BYTES) != hipSuccess) { fprintf(stderr, "kernel_launch: hipFuncSetAttribute failed\n"); grid = -1; return; }
        if (hipOccupancyMaxActiveBlocksPerMultiprocessor(&per_cu, (const void*)hymba_fwd, 512, LDS_BYTES) != hipSuccess || per_cu < 1) fprintf(stderr, "kernel_launch: occupancy query reports %d\n", per_cu);
        (void)hipGetLastError();
        grid = cus;
    }
    if (grid < 0) return;
    (void)hipMemsetAsync((char*)d_ws + WS_CTL, 0, CTL_ZERO_BYTES, stream);
    Args a{};
    for (int i = 0; i < 31; ++i) a.in[i] = (const float*)d_in[i];
    a.out = (float*)d_out; a.ws = (unsigned char*)d_ws;
#if MK_PER_PHASE
    for (int p = 0; p < NPH; ++p) { const int reps = ((PROBE_REP_MASK >> p) & 1) ? 2 : 1;
        for (int q = 0; q < reps; ++q) { a.ph_lo = p; a.ph_hi = p + 1; hipLaunchKernelGGL(hymba_fwd, dim3(grid), dim3(512), LDS_BYTES, stream, a); } }
#else
    a.ph_lo = 0; a.ph_hi = NPH; hipLaunchKernelGGL(hymba_fwd, dim3(grid), dim3(512), LDS_BYTES, stream, a);
#endif
}
```

```cpp
#include <hip/hip_runtime.h>
#include <cstdio>
#include <cstdint>

#ifndef PROBE_REP_MASK
#define PROBE_REP_MASK 0
#endif
#ifndef MK_PER_PHASE
#define MK_PER_PHASE 0
#endif

#define GAS __attribute__((address_space(1)))
#define LAS __attribute__((address_space(3)))
typedef unsigned short bf16;
typedef unsigned v4u __attribute__((ext_vector_type(4)));
typedef unsigned v2u __attribute__((ext_vector_type(2)));
typedef float f32x4 __attribute__((ext_vector_type(4)));
typedef float f32x16 __attribute__((ext_vector_type(16)));
typedef short bf16x8 __attribute__((ext_vector_type(8)));
typedef short bf16x4 __attribute__((ext_vector_type(4)));

constexpr int T = 16384, D = 2048, SEQ = 2048, NB = 8, INC = 2304, MEML = 256;
constexpr int NPH = 14;
constexpr float EPS = 1e-6f;
constexpr int NEXP = 64, DEXP = 512, LCAP = 16384;
constexpr int S5L = 32, S5K = 640;

constexpr size_t MiB = 1u << 20;
constexpr size_t WS_CTL = 0, CTL_ZERO_BYTES = 1 * MiB;
constexpr size_t WS_WIN = 2 * MiB, WS_WO = 11 * MiB, WS_WMKV = 19 * MiB, WS_WGLU = 23 * MiB;
constexpr size_t WS_MQ = 24 * MiB, WS_SP = 44 * MiB, WS_UA = 52 * MiB, WS_SL = 72 * MiB, WS_AL = 88 * MiB, WS_WR = 89 * MiB;
constexpr size_t WS_XN = 96 * MiB;
constexpr size_t WS_MEMN = 160 * MiB, WS_MEMKV = 168 * MiB;
constexpr size_t WS_PROJ = 176 * MiB;
constexpr size_t WS_MIX = 248 * MiB;
constexpr size_t WS_Y2 = 176 * MiB;
constexpr size_t WS_G = 312 * MiB;
constexpr size_t WS_LOG = 328 * MiB;
constexpr size_t WS_LIST = 344 * MiB;
constexpr size_t WS_WTS = 348 * MiB;
constexpr size_t WS_LP = 352 * MiB;
constexpr size_t WS_PART = 376 * MiB;
constexpr size_t WS_RSTD = 379 * MiB;
constexpr size_t WS_HIST = 380 * MiB;
constexpr size_t WS_TOKE = 381 * MiB;
constexpr size_t WS_ACT = 544 * MiB;
constexpr size_t WS_WGU = 592 * MiB;
constexpr size_t WS_WD = 848 * MiB;
constexpr size_t WS_END = 976 * MiB;
constexpr int CW_CNT = 1024;
constexpr int CW_BAR = 4096;
constexpr int CW_QUEUE = 2048;

constexpr int RING_BYTES = 131072;
constexpr int TAB_OFF = 139264;
constexpr int XBW_OFF = TAB_OFF + 2048;
constexpr int LDS_BYTES = 147456;

#define LDS_WAIT() asm volatile("s_waitcnt lgkmcnt(0)" ::: "memory")
#define VM_WAIT() asm volatile("s_waitcnt vmcnt(0)" ::: "memory")
__device__ __forceinline__ unsigned f2bf(float f) { unsigned u = __builtin_bit_cast(unsigned, f); return (u + 0x7fffu + ((u >> 16) & 1u)) >> 16; }
__device__ __forceinline__ unsigned pk2(float lo, float hi) { unsigned r; asm volatile("v_cvt_pk_bf16_f32 %0, %1, %2" : "=v"(r) : "v"(lo), "v"(hi)); return r; }
__device__ __forceinline__ float bflo(unsigned w) { return __builtin_bit_cast(float, w << 16); }
__device__ __forceinline__ float bfhi(unsigned w) { return __builtin_bit_cast(float, w & 0xffff0000u); }
__device__ __forceinline__ float wave_sum(float v) {
#pragma unroll
    for (int o = 1; o < 64; o <<= 1) v += __shfl_xor(v, o);
    return v;
}
__device__ __forceinline__ float fast_exp(float x) { return __builtin_amdgcn_exp2f(x * 1.44269504089f); }
__device__ __forceinline__ float sigmoidf_(float x) { return __builtin_amdgcn_rcpf(1.0f + fast_exp(-x)); }
__device__ __forceinline__ float gelu_tanh(float x) { const float z = 1.5957691216f * (x + 0.044715f * x * x * x); return x * sigmoidf_(z); }

#define XB_TMO      128
#define XB_XCNT(j)  (256  + 64 * (j))
#define XB_XSUB(j)  (1280 + 64 * (j))
#define XB_XGEN(j)  (2304 + 64 * (j))
#define XB_TOP      3328
#define XB_TOPGEN   3392
#define XCD_BAR_WORDS 3456
#define XB_SPIN_CAP (1u << 18)
__device__ __forceinline__ unsigned xb_ld(unsigned* p)              { return __hip_atomic_load(p, __ATOMIC_RELAXED, __HIP_MEMORY_SCOPE_AGENT); }
__device__ __forceinline__ unsigned xb_add(unsigned* p, unsigned v) { return __hip_atomic_fetch_add(p, v, __ATOMIC_RELAXED, __HIP_MEMORY_SCOPE_AGENT); }
__device__ __forceinline__ unsigned xb_xcc_id() { return (unsigned)__builtin_amdgcn_s_getreg((3 << 11) | 20) & 0xFu; }
#define XB_SPIN(cond, bar) do { unsigned _sp = 0; while (cond) { __builtin_amdgcn_s_sleep(1); \
    if ((++_sp & 255u) == 0u) { if (xb_ld(&(bar)[XB_TMO])) break; if (_sp > XB_SPIN_CAP) { atomicAdd(&(bar)[XB_TMO], 1u); break; } } } } while (0)
struct XcdBarrier { unsigned* bar; unsigned x; volatile LAS unsigned* st; };
__device__ __forceinline__ XcdBarrier xcd_barrier_post(unsigned* bar, volatile LAS unsigned* st) {
    XcdBarrier b; b.bar = bar; b.x = xb_xcc_id(); b.st = st;
    if (threadIdx.x == 0) (void)xb_add(&bar[XB_XCNT(b.x)], 1u);
    return b;
}
__device__ __forceinline__ void xcd_barrier_complete(unsigned* bar, unsigned x, unsigned& nloc, unsigned& nx) {
    const unsigned G = gridDim.x * gridDim.y * gridDim.z;
    unsigned sum, cnt, mine, sp = 0u;
    for (;;) {
        sum = 0u; cnt = 0u; mine = 0u;
#pragma unroll
        for (unsigned j = 0; j < 16; ++j) { const unsigned c = xb_ld(&bar[XB_XCNT(j)]); sum += c; cnt += (c > 0u) ? 1u : 0u; mine = (j == x) ? c : mine; }
        if (sum == G) break;
        __builtin_amdgcn_s_sleep(1);
        if ((++sp & 255u) == 0u) { if (xb_ld(&bar[XB_TMO])) break; if (sp > XB_SPIN_CAP) { atomicAdd(&bar[XB_TMO], 1u); break; } }
    }
    nloc = mine > 0u ? mine : 1u; nx = cnt > 0u ? cnt : 1u;
}
__device__ __forceinline__ void xcd_barrier(const XcdBarrier& b) {
    asm volatile("s_waitcnt vmcnt(0)" ::: "memory");
    __syncthreads();
    if (threadIdx.x == 0) {
        unsigned* bar = b.bar;
        __builtin_amdgcn_s_waitcnt(0);
        unsigned nloc = b.st[0], nx = b.st[1];
        if (nloc == 0u) { xcd_barrier_complete(bar, b.x, nloc, nx); b.st[0] = nloc; b.st[1] = nx; }
        const unsigned old = xb_add(&bar[XB_XSUB(b.x)], 1u);
        const unsigned gen = old / nloc;
        if (old + 1u == (gen + 1u) * nloc) {
            __builtin_amdgcn_fence(__ATOMIC_RELEASE, "agent");
            asm volatile("s_waitcnt vmcnt(0)" ::: "memory");
            const unsigned og = xb_add(&bar[XB_TOP], 1u);
            const unsigned tg = og / nx;
            if (og + 1u == (tg + 1u) * nx) xb_add(&bar[XB_TOPGEN], 1u);
            else XB_SPIN(xb_ld(&bar[XB_TOPGEN]) == tg, bar);
            __builtin_amdgcn_fence(__ATOMIC_ACQUIRE, "agent");
            xb_add(&bar[XB_XGEN(b.x)], 1u);
            asm volatile("s_waitcnt vmcnt(0)" ::: "memory");
        } else {
            XB_SPIN(xb_ld(&bar[XB_XGEN(b.x)]) == gen, bar);
            __builtin_amdgcn_fence(__ATOMIC_ACQUIRE, "agent");
            asm volatile("s_waitcnt vmcnt(0)" ::: "memory");
        }
    }
    __syncthreads();
}

namespace pg8 {
constexpr int BM = 256, BK = 64, HALF = 128, HTB = HALF * BK * 2, STAGE_BYTES = 8 * HTB, NXCD = 8, WGM = 8;
__host__ __device__ __forceinline__ int lds_byte(int r, int c) { const int st = (r >> 4) * 2 + (c >> 5), rr = r & 15, cc = c & 31, ob = rr * 64 + cc * 2; return st * 1024 + (ob ^ (((ob >> 9) & 1) << 5)); }
__host__ __device__ __forceinline__ void stage_rc(int b, int& R, int& C) { const int st = b / 1024, sb = b % 1024, swz = sb ^ (((sb >> 9) & 1) << 5); R = (st >> 1) * 16 + swz / 64; C = (st & 1) * 32 + (swz % 64) / 2; }
__host__ __device__ __forceinline__ int perm32(int rho) { const int n = rho >> 4, i = rho & 15; return 8 * (i >> 2) + 4 * n + (i & 3); }

struct Unit { const char* a; const char* b; int r0, c0, aux, r1; };
struct Gemm { int lda, ldb, K; };

struct DenseOrder {
    const char* A; const char* Bt; int lda, ldb, nM, nN, nwg, G, c;
    __device__ void init(const void* A_, const void* Bt_, int lda_, int ldb_, int M, int N, int G_, int c_) { A = (const char*)A_; Bt = (const char*)Bt_; lda = lda_; ldb = ldb_; nM = M / BM; nN = N / BM; nwg = nM * nN; G = G_; c = c_; }
    __device__ bool next(int i, Unit& u) const {
        const long L = (long)i * G + c; if (L >= nwg) return false;
        int wgid = (int)L; { const int q = nwg / NXCD, r = nwg % NXCD, xcd = wgid % NXCD, off = wgid / NXCD; wgid = (xcd < r ? xcd * (q + 1) : r * (q + 1) + (xcd - r) * q) + off; }
        const int nig = WGM * nN, gid = wgid / nig, fm = gid * WGM, gsz = (nM - fm) < WGM ? (nM - fm) : WGM;
        const int pm = fm + ((wgid % nig) % gsz), pn = (wgid % nig) / gsz;
        u.a = A + (size_t)pm * BM * lda * 2; u.b = Bt + (size_t)pn * BM * ldb * 2; u.r0 = pm * BM; u.c0 = pn * BM; u.aux = 0; u.r1 = 0; return true;
    }
    __device__ __forceinline__ unsigned arow(const Unit&, int) const { return 0u; }
};
struct GroupOrder {
    const char* A; const char* Bt; int lda, ldb, nN, ngrp, G, c;
    __device__ bool next(int i, Unit& u) const {
        const int L = i * G + c; if (L >= ngrp * 2 * nN) return false;
        const int g = L / (2 * nN), q = L % (2 * nN), pn = q >> 1, pm = q & 1;
        u.a = A + ((size_t)g * 512 + pm * BM) * lda * 2; u.b = Bt + ((size_t)g * nN + pn) * BM * ldb * 2; u.r0 = pm * BM; u.c0 = pn * BM; u.aux = g; u.r1 = 0; return true;
    }
    __device__ __forceinline__ unsigned arow(const Unit&, int) const { return 0u; }
};
struct MoeOrder {
    const char* A; const char* Bt; const LAS int* cnt; const LAS int* ts; const int* list; int lda, ldb, nct, brows, G, c; bool gather;
    __device__ bool next(int i, Unit& u) const {
        const int L = i * G + c; const int lane = threadIdx.x & 63;
        if (L >= ts[64] * nct) return false;
        const int lo = ts[lane] * nct, hi = ts[lane + 1] * nct;
        const unsigned long long m = __ballot(lo <= L && L < hi);
        const int e = __builtin_amdgcn_readfirstlane((int)__builtin_ctzll(m));
        const int tse = ts[e], ne = ts[e + 1] - tse, q = L - tse * nct, ct = q / ne, rt = q % ne;
        u.a = gather ? A : A + (size_t)(tse + rt) * BM * lda * 2; u.b = Bt + ((size_t)e * brows + (size_t)ct * BM) * ldb * 2;
        u.r0 = (tse + rt) * BM; u.r1 = rt * BM; u.c0 = ct; u.aux = e; return true;
    }
    __device__ __forceinline__ unsigned arow(const Unit& u, int r) const {
        const int n = cnt[u.aux]; int rr = u.r1 + r; rr = rr < n ? rr : n - 1;
        return (unsigned)(list[(size_t)u.aux * LCAP + rr] >> 1) * (unsigned)(lda * 2);
    }
};

#define EPI_ROWS_COLS() const int rowb = wr * 64 + fr; (void)rowb;

template <class Epi, class Sched, bool GATHER = false>
__device__ __forceinline__ void gemm_phase(LAS unsigned char* lds, const Gemm g, const Sched& S, const Epi& E) {
    const int tid = threadIdx.x, wid = __builtin_amdgcn_readfirstlane(tid >> 6), lane = tid & 63, wr = wid >> 2, wc = wid & 3, fr = lane & 15, fq = lane >> 4;
    const int K = g.K, nt = K / BK;
    unsigned voffB[2]; int Ra[2], Ca[2];
#pragma unroll
    for (int i = 0; i < 2; ++i) { int R, C; stage_rc(tid * 16 + i * 8192, R, C); const int Rb = Epi::PERM ? ((R & ~31) + perm32(R & 31)) : R;
        Ra[i] = R; Ca[i] = C; voffB[i] = (unsigned)(Rb * g.ldb + C) * 2u; }
    const size_t kstep = (size_t)(BK * 2);
    const size_t hstepB = (size_t)HALF * g.ldb * 2;
    const unsigned ldsw = (unsigned)wid * 1024u;
    const int aoff = lds_byte(wr * 64 + fr, fq * 8), boff = lds_byte(wc * 32 + fr, fq * 8);
#define PG8_SA(b, h) (((b) * 2 + (h)) * HTB)
#define PG8_SB(b, h) ((4 + (b) * 2 + (h)) * HTB)
#define PG8_STAGE(bufoff, gbase, voff) do { _Pragma("unroll") for (int _i = 0; _i < 2; ++_i) \
        __builtin_amdgcn_global_load_lds((const unsigned*)((const char*)(gbase) + (voff)[_i]), (LAS unsigned*)(lds + (bufoff) + ldsw + _i * 8192), 16, 0, 0); } while (0)
#define PG8_STAGEA(bufoff, gbase, o0, o1) do { \
        __builtin_amdgcn_global_load_lds((const unsigned*)((const char*)(gbase) + (o0)), (LAS unsigned*)(lds + (bufoff) + ldsw), 16, 0, 0); \
        __builtin_amdgcn_global_load_lds((const unsigned*)((const char*)(gbase) + (o1)), (LAS unsigned*)(lds + (bufoff) + ldsw + 8192), 16, 0, 0); } while (0)
#define PG8_LDA(dst, b, h) do { _Pragma("unroll") for (int m = 0; m < 4; ++m) _Pragma("unroll") for (int k = 0; k < 2; ++k) dst[m][k] = *(const LAS bf16x8*)(lds + PG8_SA(b, h) + aoff + m * 2048 + k * 1024); } while (0)
#define PG8_LDB(dst, b, h) do { _Pragma("unroll") for (int n = 0; n < 2; ++n) _Pragma("unroll") for (int k = 0; k < 2; ++k) dst[n][k] = *(const LAS bf16x8*)(lds + PG8_SB(b, h) + boff + n * 2048 + k * 1024); } while (0)
#define PG8_MMA(ai, bj, At, Bt) do { __builtin_amdgcn_s_setprio(1); _Pragma("unroll") for (int m = 0; m < 4; ++m) _Pragma("unroll") for (int n = 0; n < 2; ++n) _Pragma("unroll") for (int k = 0; k < 2; ++k) \
        acc[ai][bj][m][n] = __builtin_amdgcn_mfma_f32_16x16x32_bf16(Bt[n][k], At[m][k], acc[ai][bj][m][n], 0, 0, 0); __builtin_amdgcn_s_setprio(0); } while (0)
#define PG8_WAIT_V(n) asm volatile("s_waitcnt vmcnt(" #n ")" ::: "memory")
#define PG8_WAIT_L(n) asm volatile("s_waitcnt lgkmcnt(" #n ")" ::: "memory")
#define PG8_BAR __builtin_amdgcn_s_barrier()
#define PG8_SCHED __builtin_amdgcn_sched_barrier(0)
    Unit cur, nxt; int ui = 0;
    if (!S.next(0, cur)) return;
    f32x4 acc[2][2][4][2];
#pragma unroll
    for (int a = 0; a < 2; ++a)
#pragma unroll
        for (int b = 0; b < 2; ++b)
#pragma unroll
            for (int m = 0; m < 4; ++m)
#pragma unroll
                for (int n = 0; n < 2; ++n) acc[a][b][m][n] = (f32x4){0.f, 0.f, 0.f, 0.f};
    bf16x8 At[4][2], B0[2][2], B1[2][2];
    const char* cA = cur.a; const char* cB = cur.b;
    unsigned c00, c01, c10, c11, n00, n01, n10, n11;
    if constexpr (GATHER) {
        c00 = S.arow(cur, Ra[0]) + Ca[0] * 2u; c01 = S.arow(cur, Ra[1]) + Ca[1] * 2u; c10 = S.arow(cur, HALF + Ra[0]) + Ca[0] * 2u; c11 = S.arow(cur, HALF + Ra[1]) + Ca[1] * 2u;
        asm volatile("s_waitcnt vmcnt(0)" : "+v"(c00), "+v"(c01), "+v"(c10), "+v"(c11) :: "memory");
    } else {
        c00 = (unsigned)(Ra[0] * g.lda + Ca[0]) * 2u; c01 = (unsigned)(Ra[1] * g.lda + Ca[1]) * 2u; c10 = c00 + (unsigned)(HALF * g.lda * 2); c11 = c01 + (unsigned)(HALF * g.lda * 2);
    }
    n00 = c00; n01 = c01; n10 = c10; n11 = c11;
    PG8_STAGE(PG8_SB(0, 0), cB, voffB); PG8_STAGE(PG8_SB(0, 1), cB + hstepB, voffB); PG8_STAGEA(PG8_SA(0, 0), cA, c00, c01); PG8_STAGEA(PG8_SA(0, 1), cA, c10, c11);
    if (wr == 1) PG8_BAR;
    PG8_WAIT_V(2); PG8_BAR;
    PG8_STAGE(PG8_SB(1, 0), cB + kstep, voffB); PG8_STAGEA(PG8_SA(1, 0), cA + kstep, c00, c01); PG8_STAGE(PG8_SB(1, 1), cB + hstepB + kstep, voffB);
    PG8_WAIT_V(6); PG8_BAR;
    for (;;) {
        const bool has_next = S.next(ui + 1, nxt);
        const char* nA = has_next ? nxt.a : cA; const char* nB = has_next ? nxt.b : cB;
        if constexpr (GATHER) {
            if (has_next) { n00 = S.arow(nxt, Ra[0]) + Ca[0] * 2u; n01 = S.arow(nxt, Ra[1]) + Ca[1] * 2u; n10 = S.arow(nxt, HALF + Ra[0]) + Ca[0] * 2u; n11 = S.arow(nxt, HALF + Ra[1]) + Ca[1] * 2u; }
            else { n00 = c00; n01 = c01; n10 = c10; n11 = c11; }
            asm volatile("s_waitcnt vmcnt(0)" : "+v"(n00), "+v"(n01), "+v"(n10), "+v"(n11) :: "memory");
        }
        for (int t = 0; t < nt; t += 2) {
            const bool last = (t == nt - 2);
            const char* a1 = cA + (size_t)(t + 1) * kstep;
            const char* a2 = last ? nA : cA + (size_t)(t + 2) * kstep; const char* b2 = last ? nB : cB + (size_t)(t + 2) * kstep;
            const char* a3 = a2 + kstep; const char* b3 = b2 + kstep;
            const unsigned x00 = (GATHER && last) ? n00 : c00, x01 = (GATHER && last) ? n01 : c01, x10 = (GATHER && last) ? n10 : c10, x11 = (GATHER && last) ? n11 : c11;
            PG8_LDB(B0, 0, 0); PG8_LDB(B1, 0, 1); PG8_SCHED; PG8_LDA(At, 0, 0); PG8_STAGEA(PG8_SA(1, 1), a1, c10, c11);
            PG8_WAIT_V(8); PG8_WAIT_L(0); PG8_BAR; PG8_MMA(0, 0, At, B0); PG8_MMA(0, 1, At, B1); PG8_BAR; PG8_SCHED;
            PG8_LDA(At, 0, 1); PG8_STAGE(PG8_SB(0, 0), b2, voffB); PG8_STAGE(PG8_SB(0, 1), b2 + hstepB, voffB); PG8_STAGEA(PG8_SA(0, 0), a2, x00, x01);
            PG8_WAIT_V(8); PG8_WAIT_L(0); PG8_BAR; PG8_MMA(1, 0, At, B0); PG8_MMA(1, 1, At, B1); PG8_BAR; PG8_SCHED;
            PG8_LDB(B0, 1, 0); PG8_LDB(B1, 1, 1); PG8_SCHED; PG8_LDA(At, 1, 0); PG8_STAGEA(PG8_SA(0, 1), a2, x10, x11);
            PG8_WAIT_V(8); PG8_WAIT_L(0); PG8_BAR; PG8_MMA(0, 0, At, B0); PG8_MMA(0, 1, At, B1); PG8_BAR; PG8_SCHED;
            PG8_LDA(At, 1, 1); PG8_STAGE(PG8_SB(1, 0), b3, voffB); PG8_STAGE(PG8_SB(1, 1), b3 + hstepB, voffB); PG8_STAGEA(PG8_SA(1, 0), a3, x00, x01);
            PG8_WAIT_V(8); PG8_WAIT_L(0); PG8_BAR; PG8_MMA(1, 0, At, B0); PG8_MMA(1, 1, At, B1); PG8_BAR; PG8_SCHED;
        }
        if (wr == 0) PG8_BAR;
        E(acc, cur, wr, wc, fr, fq);
        if (!has_next) break;
#pragma unroll
        for (int a = 0; a < 2; ++a)
#pragma unroll
            for (int b = 0; b < 2; ++b)
#pragma unroll
                for (int m = 0; m < 4; ++m)
#pragma unroll
                    for (int n = 0; n < 2; ++n) acc[a][b][m][n] = (f32x4){0.f, 0.f, 0.f, 0.f};
        cur = nxt; cA = nA; cB = nB; ++ui;
        c00 = n00; c01 = n01; c10 = n10; c11 = n11;
        if (wr == 1) PG8_BAR;
    }
    PG8_WAIT_V(0);
    PG8_BAR;
#undef PG8_SA
#undef PG8_SB
#undef PG8_STAGE
#undef PG8_STAGEA
#undef PG8_LDA
#undef PG8_LDB
#undef PG8_MMA
#undef PG8_WAIT_V
#undef PG8_WAIT_L
#undef PG8_BAR
#undef PG8_SCHED
}

typedef const f32x4 (&AccRef)[2][2][4][2];
__device__ __forceinline__ v4u pack8(const f32x4 a, const f32x4 b) { v4u w; w.x = pk2(a[0], a[1]); w.y = pk2(a[2], a[3]); w.z = pk2(b[0], b[1]); w.w = pk2(b[2], b[3]); return w; }

struct EpiProj {
    static constexpr bool PERM = true;
    bf16* PROJ; bf16* UA;
    __device__ __forceinline__ void operator()(AccRef acc, const Unit& u, int wr, int wc, int fr, int fq) const {
        const int row0 = u.r0 + wr * 64 + fr, colb = u.c0 + wc * 32 + 8 * fq;
        const bool isu = (u.c0 == 1280 || u.c0 == 1536);
#pragma unroll
        for (int ai = 0; ai < 2; ++ai)
#pragma unroll
            for (int m = 0; m < 4; ++m) { const int row = row0 + ai * HALF + m * 16;
#pragma unroll
                for (int bj = 0; bj < 2; ++bj) { const int col = colb + bj * HALF; const v4u w = pack8(acc[ai][bj][m][0], acc[ai][bj][m][1]);
                    if (!isu) *(v4u*)(PROJ + (size_t)row * INC + col) = w;
                    else { const int cc = col - 1280, g = cc >> 4, c0 = cc & 15; *(v4u*)(UA + ((size_t)(g * 512 + (row >> 5)) * S5K + (row & 31) * 16 + c0)) = w; } } }
    }
};
struct EpiBf16 {
    static constexpr bool PERM = true;
    bf16* O; int ldc;
    __device__ __forceinline__ void operator()(AccRef acc, const Unit& u, int wr, int wc, int fr, int fq) const {
        const int row0 = u.r0 + wr * 64 + fr, colb = u.c0 + wc * 32 + 8 * fq;
#pragma unroll
        for (int ai = 0; ai < 2; ++ai)
#pragma unroll
            for (int m = 0; m < 4; ++m) { bf16* rowp = O + (size_t)(row0 + ai * HALF + m * 16) * ldc + colb;
#pragma unroll
                for (int bj = 0; bj < 2; ++bj) *(v4u*)(rowp + bj * HALF) = pack8(acc[ai][bj][m][0], acc[ai][bj][m][1]); }
    }
};
struct EpiF32 {
    static constexpr bool PERM = false;
    float* C; int ldc; size_t gstride;
    __device__ __forceinline__ void operator()(AccRef acc, const Unit& u, int wr, int wc, int fr, int fq) const {
        const int row0 = u.r0 + wr * 64 + fr, col0 = u.c0 + wc * 32 + 4 * fq; float* base = C + (size_t)u.aux * gstride;
#pragma unroll
        for (int ai = 0; ai < 2; ++ai)
#pragma unroll
            for (int m = 0; m < 4; ++m) { float* rowp = base + (size_t)(row0 + ai * HALF + m * 16) * ldc + col0;
#pragma unroll
                for (int bj = 0; bj < 2; ++bj)
#pragma unroll
                    for (int n = 0; n < 2; ++n) *(f32x4*)(rowp + bj * HALF + n * 16) = acc[ai][bj][m][n]; }
    }
};
struct EpiS5Y {
    static constexpr bool PERM = true;
    const bf16* UA; const float* dsk; bf16* Gm;
    __device__ __forceinline__ void operator()(AccRef acc, const Unit& u, int wr, int wc, int fr, int fq) const {
        const int row0 = u.r0 + wr * 64 + fr, colb = u.c0 + wc * 32 + 8 * fq, g = u.aux;
#pragma unroll
        for (int ai = 0; ai < 2; ++ai)
#pragma unroll
            for (int m = 0; m < 4; ++m) { const int row = row0 + ai * HALF + m * 16;
#pragma unroll
                for (int bj = 0; bj < 2; ++bj) { const int col = colb + bj * HALF, i = col >> 4, c0 = col & 15;
                    const v4u uw = *(const v4u*)(UA + ((size_t)(g * 512 + row) * S5K + col));
                    const f32x4 d0 = *(const f32x4*)(dsk + g * 16 + c0), d1 = *(const f32x4*)(dsk + g * 16 + c0 + 4);
                    const f32x4 a0 = acc[ai][bj][m][0], a1 = acc[ai][bj][m][1];
                    f32x4 y0, y1;
                    y0[0] = gelu_tanh(a0[0] + d0[0] * bflo(uw.x)); y0[1] = gelu_tanh(a0[1] + d0[1] * bfhi(uw.x)); y0[2] = gelu_tanh(a0[2] + d0[2] * bflo(uw.y)); y0[3] = gelu_tanh(a0[3] + d0[3] * bfhi(uw.y));
                    y1[0] = gelu_tanh(a1[0] + d1[0] * bflo(uw.z)); y1[1] = gelu_tanh(a1[1] + d1[1] * bfhi(uw.z)); y1[2] = gelu_tanh(a1[2] + d1[2] * bflo(uw.w)); y1[3] = gelu_tanh(a1[3] + d1[3] * bfhi(uw.w));
                    *(v4u*)(Gm + ((size_t)row * 32 + i) * 512 + g * 16 + c0) = pack8(y0, y1); } }
    }
};
struct EpiGlu {
    static constexpr bool PERM = true;
    const bf16* Gm; bf16* MIX;
    __device__ __forceinline__ void operator()(AccRef acc, const Unit& u, int wr, int wc, int fr, int fq) const {
        const int row0 = u.r0 + wr * 64 + fr, colb = u.c0 + wc * 32 + 8 * fq;
#pragma unroll
        for (int ai = 0; ai < 2; ++ai)
#pragma unroll
            for (int m = 0; m < 4; ++m) { const int row = row0 + ai * HALF + m * 16;
#pragma unroll
                for (int bj = 0; bj < 2; ++bj) { const int col = colb + bj * HALF;
                    const v4u gw = *(const v4u*)(Gm + (size_t)row * 512 + col);
                    const f32x4 a0 = acc[ai][bj][m][0], a1 = acc[ai][bj][m][1];
                    f32x4 y0, y1;
                    y0[0] = bflo(gw.x) * sigmoidf_(a0[0]); y0[1] = bfhi(gw.x) * sigmoidf_(a0[1]); y0[2] = bflo(gw.y) * sigmoidf_(a0[2]); y0[3] = bfhi(gw.y) * sigmoidf_(a0[3]);
                    y1[0] = bflo(gw.z) * sigmoidf_(a1[0]); y1[1] = bfhi(gw.z) * sigmoidf_(a1[1]); y1[2] = bflo(gw.w) * sigmoidf_(a1[2]); y1[3] = bfhi(gw.w) * sigmoidf_(a1[3]);
                    *(v4u*)(MIX + (size_t)row * D + 1024 + col) = pack8(y0, y1); } }
    }
};
struct EpiWo {
    static constexpr bool PERM = false;
    const float* X; bf16* X1B; float* part;
    __device__ __forceinline__ void operator()(AccRef acc, const Unit& u, int wr, int wc, int fr, int fq) const {
        const int row0 = u.r0 + wr * 64 + fr, col0 = u.c0 + wc * 32 + 4 * fq;
#pragma unroll
        for (int ai = 0; ai < 2; ++ai) {
            f32x4 xv[4][2][2];
#pragma unroll
            for (int m = 0; m < 4; ++m)
#pragma unroll
                for (int bj = 0; bj < 2; ++bj)
#pragma unroll
                    for (int n = 0; n < 2; ++n) xv[m][bj][n] = __builtin_nontemporal_load((const f32x4*)(X + (size_t)(row0 + ai * HALF + m * 16) * D + col0 + bj * HALF + n * 16));
#pragma unroll
            for (int m = 0; m < 4; ++m) { const int row = row0 + ai * HALF + m * 16; const size_t off = (size_t)row * D + col0; float ss = 0.f;
#pragma unroll
                for (int bj = 0; bj < 2; ++bj)
#pragma unroll
                    for (int n = 0; n < 2; ++n) { const f32x4 v = xv[m][bj][n] + acc[ai][bj][m][n];
                        ss += (v[0] * v[0] + v[1] * v[1]) + (v[2] * v[2] + v[3] * v[3]);
                        v2u w; w.x = pk2(v[0], v[1]); w.y = pk2(v[2], v[3]); *(v2u*)(X1B + off + bj * HALF + n * 16) = w; }
                ss += __shfl_xor(ss, 16); ss += __shfl_xor(ss, 32);
                if (fq == 0) part[(size_t)row * 32 + (u.c0 >> 8) * 4 + wc] = ss; }
            asm volatile("" ::: "memory");
        }
    }
};
struct EpiLogit {
    static constexpr bool PERM = false;
    float* LP;
    __device__ __forceinline__ void operator()(AccRef acc, const Unit& u, int wr, int wc, int fr, int fq) const {
        const int row0 = u.r0 + wr * 64 + fr, col0 = wc * 32 + 4 * fq; float* base = LP + (size_t)u.aux * T * 80;
#pragma unroll
        for (int ai = 0; ai < 2; ++ai)
#pragma unroll
            for (int m = 0; m < 4; ++m) { float* rowp = base + (size_t)(row0 + ai * HALF + m * 16) * 80 + col0;
#pragma unroll
                for (int n = 0; n < 2; ++n) if (col0 + n * 16 < 80) *(f32x4*)(rowp + n * 16) = acc[ai][0][m][n]; }
    }
};
struct EpiGU {
    static constexpr bool PERM = true;
    const int* list; const float* rstd; const LAS int* cnt; bf16* ACT;
    __device__ __forceinline__ void operator()(AccRef acc, const Unit& u, int wr, int wc, int fr, int fq) const {
        const int e = u.aux, nreal = cnt[e], rb = wr * 64 + fr, colb = u.c0 * 128 + wc * 32 + 8 * fq;
#pragma unroll
        for (int ai = 0; ai < 2; ++ai)
#pragma unroll
            for (int m = 0; m < 4; ++m) { const int r = rb + ai * HALF + m * 16; int rr = u.r1 + r; rr = rr < nreal ? rr : nreal - 1;
                const float rs = rstd[list[(size_t)e * LCAP + rr] >> 1];
                f32x4 y0, y1;
#pragma unroll
                for (int j = 0; j < 4; ++j) { const float g0 = acc[ai][0][m][0][j] * rs, g1 = acc[ai][0][m][1][j] * rs;
                    y0[j] = g0 * sigmoidf_(g0) * (acc[ai][1][m][0][j] * rs); y1[j] = g1 * sigmoidf_(g1) * (acc[ai][1][m][1][j] * rs); }
                *(v4u*)(ACT + (size_t)(u.r0 + r) * DEXP + colb) = pack8(y0, y1); }
    }
};
struct EpiDown {
    static constexpr bool PERM = true;
    const int* list; const float* wts; const LAS int* cnt; bf16* Y2;
    __device__ __forceinline__ void operator()(AccRef acc, const Unit& u, int wr, int wc, int fr, int fq) const {
        const int e = u.aux, n = cnt[e], row0 = u.r1 + wr * 64 + fr, colb = u.c0 * 256 + wc * 32 + 8 * fq;
#pragma unroll
        for (int ai = 0; ai < 2; ++ai)
#pragma unroll
            for (int m = 0; m < 4; ++m) { const int r = row0 + ai * HALF + m * 16;
                if (r < n) { const int ent = list[(size_t)e * LCAP + r]; const float w = wts[ent]; bf16* rowp = Y2 + (size_t)ent * D + colb;
#pragma unroll
                    for (int bj = 0; bj < 2; ++bj) *(v4u*)(rowp + bj * HALF) = pack8(acc[ai][bj][m][0] * w, acc[ai][bj][m][1] * w); } }
    }
};
struct KSplitOrder {
    const char* A; const char* Bt; int lda, ldb, K, nM, nks, G, c;
    __device__ bool next(int i, Unit& u) const {
        const int L = i * G + c; if (L >= nM * nks) return false;
        const int pm = L / nks, ks = L % nks;
        u.a = A + ((size_t)pm * BM * lda + (size_t)ks * K) * 2; u.b = Bt + (size_t)ks * BM * ldb * 2; u.r0 = pm * BM; u.c0 = 0; u.aux = ks; u.r1 = 0; return true;
    }
    __device__ __forceinline__ unsigned arow(const Unit&, int) const { return 0u; }
};
}

struct Frame {
    LAS unsigned char* lds;
    unsigned* ctl;
    int tid, lane, wave, vcu, G;
    const float* in[31]; float* out; unsigned char* ws;
};
enum { I_X = 0, I_MEM, I_NORM_MIX, I_W_IN, I_Q_NORM, I_K_NORM, I_SINKS, I_REL_BIAS, I_LAM_RE, I_LAM_IM, I_LOG_DT, I_B_RE, I_B_IM, I_C_RE, I_C_IM, I_SSM_D, I_W_GLU,
       I_MEM_NORM, I_W_MEM_KV, I_XQ_NORM, I_XK_NORM, I_ON_ATTN, I_ON_SSM, I_ON_X, I_W_O, I_NORM_FFN, I_WR_G, I_WR_E, I_W_GATE, I_W_UP, I_W_DOWN };

struct TrItem { const float* W; bf16* WT; const float* ks; int ldw, ldt, k0, n0, drow0; };
__device__ __forceinline__ void tr_load(const TrItem& it, f32x4 (&v)[8], int lane) {
    const int kc = lane & 7, nq = lane >> 3; const float* src = it.W + (size_t)(it.k0 + kc * 8) * it.ldw + it.n0 + nq * 4;
#pragma unroll
    for (int j = 0; j < 8; ++j) v[j] = __builtin_nontemporal_load((const f32x4*)(src + (size_t)j * it.ldw));
}
__device__ __forceinline__ void tr_store(const TrItem& it, f32x4 (&v)[8], int lane) {
    const int kc = lane & 7, nq = lane >> 3;
    if (it.ks) { const f32x4 s0 = *(const f32x4*)(it.ks + it.k0 + kc * 8), s1 = *(const f32x4*)(it.ks + it.k0 + kc * 8 + 4);
#pragma unroll
        for (int j = 0; j < 4; ++j) { v[j] = v[j] * s0[j]; v[4 + j] = v[4 + j] * s1[j]; } }
#pragma unroll
    for (int i = 0; i < 4; ++i) { v4u o; o.x = pk2(v[0][i], v[1][i]); o.y = pk2(v[2][i], v[3][i]); o.z = pk2(v[4][i], v[5][i]); o.w = pk2(v[6][i], v[7][i]);
        *(v4u*)(it.WT + (size_t)(it.drow0 + nq * 4 + i) * it.ldt + it.k0 + kc * 8) = o; }
}
__device__ __forceinline__ void rms_row_to_bf16(const float* xrow, const float* gain, bf16* orow, int lane) {
    const f32x4* xr = (const f32x4*)xrow + lane; const f32x4* gr = (const f32x4*)gain + lane;
    f32x4 v[8]; float s = 0.f;
#pragma unroll
    for (int j = 0; j < 8; ++j) { v[j] = xr[64 * j]; s += (v[j].x * v[j].x + v[j].y * v[j].y) + (v[j].z * v[j].z + v[j].w * v[j].w); }
    const float rstd = 1.0f / sqrtf(wave_sum(s) * (1.f / 2048.f) + EPS);
    v2u* o8 = (v2u*)orow + lane;
#pragma unroll
    for (int j = 0; j < 8; ++j) { const f32x4 g = gr[64 * j]; v2u w; w.x = pk2(v[j].x * rstd * g.x, v[j].y * rstd * g.y); w.y = pk2(v[j].z * rstd * g.z, v[j].w * rstd * g.w); o8[64 * j] = w; }
}

__device__ __forceinline__ void s5_tables(Frame& F, int g) {
    LAS float* ap = (LAS float*)F.lds;
    LAS float* Bb = ap + 33 * 64 * 2;
    LAS float* Cc = Bb + 64 * 16 * 2;
    LAS float* Km = Cc + 16 * 64 * 2;
    const float dt = expf(F.in[I_LOG_DT][g]);
    const float* lre = F.in[I_LAM_RE] + g * 64; const float* lim = F.in[I_LAM_IM] + g * 64;
    for (int idx = F.tid; idx < 33 * 64; idx += 512) { const int tau = idx >> 6, n = idx & 63; const float lr = lre[n], li = lim[n];
        const float mag = expf((float)tau * (lr * dt)), ang = (float)tau * (li * dt); ap[idx * 2] = mag * cosf(ang); ap[idx * 2 + 1] = mag * sinf(ang); }
    __syncthreads();
    for (int idx = F.tid; idx < 64 * 16; idx += 512) { const int n = idx >> 4; const float lr = lre[n], li = lim[n];
        const float nr = ap[(64 + n) * 2] - 1.0f, ni = ap[(64 + n) * 2 + 1], den = lr * lr + li * li;
        const float cr = (nr * lr + ni * li) / den, ci = (ni * lr - nr * li) / den;
        const float br = F.in[I_B_RE][(size_t)g * 1024 + idx], bi = F.in[I_B_IM][(size_t)g * 1024 + idx];
        Bb[idx * 2] = cr * br - ci * bi; Bb[idx * 2 + 1] = cr * bi + ci * br; }
    for (int idx = F.tid; idx < 16 * 64; idx += 512) { Cc[idx * 2] = F.in[I_C_RE][(size_t)g * 1024 + idx]; Cc[idx * 2 + 1] = F.in[I_C_IM][(size_t)g * 1024 + idx]; }
    __syncthreads();
    for (int idx = F.tid; idx < 32 * 256; idx += 512) { const int tau = idx >> 8, c = (idx >> 4) & 15, c2 = idx & 15; float s = 0.f;
        for (int n = 0; n < 64; ++n) { const float ar = ap[(tau * 64 + n) * 2], ai = ap[(tau * 64 + n) * 2 + 1], cr = Cc[(c * 64 + n) * 2], ci = Cc[(c * 64 + n) * 2 + 1];
            const float er = cr * ar - ci * ai, ei = cr * ai + ci * ar; s += er * Bb[(n * 16 + c2) * 2] - ei * Bb[(n * 16 + c2) * 2 + 1]; }
        Km[idx] = s; }
    __syncthreads();
    bf16* MQ = (bf16*)(F.ws + WS_MQ) + (size_t)g * 512 * S5K;
    for (int idx = F.tid; idx < 512 * 80; idx += 512) { const int row = idx / 80, ch = idx % 80, i = row >> 4, c = row & 15, k0 = ch * 8; float v[8];
        if (k0 < 512) { const int s = k0 >> 4, c20 = k0 & 15, tau = i - s;
#pragma unroll
            for (int j = 0; j < 8; ++j) v[j] = tau >= 0 ? Km[(tau * 16 + c) * 16 + c20 + j] : 0.f;
        } else { const int kk = k0 - 512, ri = kk >> 6, n0 = kk & 63;
#pragma unroll
            for (int j = 0; j < 8; ++j) { const int n = n0 + j; const float ar = ap[((i + 1) * 64 + n) * 2], ai = ap[((i + 1) * 64 + n) * 2 + 1], cr = Cc[(c * 64 + n) * 2], ci = Cc[(c * 64 + n) * 2 + 1];
                v[j] = ri == 0 ? (cr * ar - ci * ai) : -(cr * ai + ci * ar); } }
        v4u o; o.x = pk2(v[0], v[1]); o.y = pk2(v[2], v[3]); o.z = pk2(v[4], v[5]); o.w = pk2(v[6], v[7]);
        *(v4u*)(MQ + (size_t)row * S5K + k0) = o; }
    bf16* SP = (bf16*)(F.ws + WS_SP) + (size_t)g * 256 * 512;
    for (int idx = F.tid; idx < 256 * 64; idx += 512) { const int row = idx >> 6, k0 = (idx & 63) * 8; float v[8];
        if (row < 128) { const int ri = row >> 6, n = row & 63, s = k0 >> 4, c20 = k0 & 15; const float ar = ap[((31 - s) * 64 + n) * 2], ai = ap[((31 - s) * 64 + n) * 2 + 1];
#pragma unroll
            for (int j = 0; j < 8; ++j) { const float br = Bb[(n * 16 + c20 + j) * 2], bi = Bb[(n * 16 + c20 + j) * 2 + 1]; v[j] = ri == 0 ? (ar * br - ai * bi) : (ar * bi + ai * br); }
        } else {
#pragma unroll
            for (int j = 0; j < 8; ++j) v[j] = 0.f; }
        v4u o; o.x = pk2(v[0], v[1]); o.y = pk2(v[2], v[3]); o.z = pk2(v[4], v[5]); o.w = pk2(v[6], v[7]);
        *(v4u*)(SP + (size_t)row * 512 + k0) = o; }
    float* AL = (float*)(F.ws + WS_AL) + g * 128;
    if (F.tid < 64) { AL[F.tid * 2] = ap[(32 * 64 + F.tid) * 2]; AL[F.tid * 2 + 1] = ap[(32 * 64 + F.tid) * 2 + 1]; }
    __syncthreads();
}

struct BigTile { const float* src; bf16* dst; const float* ks; int ldw, ldt; };
constexpr int BT_GU = 64 * 2 * 64, BT_D = 64 * 64, BT_N = BT_GU + BT_D, BT_PITCH = 260;
__device__ __forceinline__ BigTile bt_decode(const Frame& F, bf16* WguT, bf16* WdT, const float* nf, int ti) {
    BigTile t;
    const unsigned long long pg = (unsigned long long)F.in[I_W_GATE], pu = (unsigned long long)F.in[I_W_UP], pd = (unsigned long long)F.in[I_W_DOWN];
    if (ti < BT_GU) { const int e = ti >> 7, r = ti & 127, which = r >> 6, kb = (r >> 2) & 15, nb = r & 3;
        const unsigned long long p = pg + ((pu - pg) & (0ull - (unsigned long long)which));
        t.src = (const float*)p + (size_t)e * D * DEXP + (size_t)kb * 128 * DEXP + nb * 128; t.dst = WguT + ((size_t)e * 1024 + nb * 256 + which * 128) * D + kb * 128; t.ks = nf + kb * 128; t.ldw = DEXP; t.ldt = D; }
    else { const int t2 = ti - BT_GU, e = t2 >> 6, r = t2 & 63, kb = r >> 4, nb = r & 15;
        t.src = (const float*)pd + (size_t)e * DEXP * D + (size_t)kb * 128 * D + nb * 128; t.dst = WdT + ((size_t)e * D + nb * 128) * DEXP + kb * 128; t.ks = nullptr; t.ldw = D; t.ldt = DEXP; }
    return t;
}
#define BT_LOAD(t, v, kv) do { const unsigned _lo = (unsigned)(rl * (t).ldw + cq * 4); \
    _Pragma("unroll") for (int _p = 0; _p < 8; ++_p) kv[_p] = (t).ks ? (t).ks[_p * 16 + rl] : 1.0f; \
    _Pragma("unroll") for (int _p = 0; _p < 8; ++_p) v[_p] = __builtin_nontemporal_load((const f32x4*)((t).src + (size_t)_p * 16 * (t).ldw + _lo)); } while (0)
#define BT_STORE(t, v, kv) do { \
    _Pragma("unroll") for (int _p = 0; _p < 8; ++_p) { const int _r = _p * 16 + rl; const f32x4 _x = v[_p] * kv[_p]; \
        const unsigned _w0 = pk2(_x[0], _x[1]), _w1 = pk2(_x[2], _x[3]); LAS bf16* _q = (LAS bf16*)(img + (cq * 4) * BT_PITCH + _r * 2); \
        _q[0] = (bf16)(_w0 & 0xffffu); _q[BT_PITCH / 2] = (bf16)(_w0 >> 16); _q[2 * (BT_PITCH / 2)] = (bf16)(_w1 & 0xffffu); _q[3 * (BT_PITCH / 2)] = (bf16)(_w1 >> 16); } \
    __syncthreads(); \
    { const unsigned _so = (unsigned)((rl * 2 + (cq >> 4)) * (t).ldt + (cq & 15) * 8); \
    _Pragma("unroll") for (int _q4 = 0; _q4 < 4; ++_q4) { const int _n = _q4 * 32 + rl * 2 + (cq >> 4); const LAS unsigned* _rp = (const LAS unsigned*)(img + _n * BT_PITCH + (cq & 15) * 16); \
        v4u _o; _o.x = _rp[0]; _o.y = _rp[1]; _o.z = _rp[2]; _o.w = _rp[3]; *(v4u*)((t).dst + (size_t)_q4 * 32 * (t).ldt + _so) = _o; } } \
    __syncthreads(); } while (0)
__device__ __forceinline__ void bigtile_convert(Frame& F, bf16* WguT, bf16* WdT, const float* nf) {
    const int rl = F.tid >> 5, cq = F.tid & 31; LAS unsigned char* img = F.lds; LAS int* qn = (LAS int*)(F.lds + TAB_OFF + 1024);
    f32x4 va[8], vb[8]; float ka[8], kb[8];
    __syncthreads();
    if (F.tid == 0) { qn[0] = (int)atomicAdd(F.ctl + CW_QUEUE, 1u); qn[1] = (int)atomicAdd(F.ctl + CW_QUEUE, 1u); }
    __syncthreads();
    int i0 = __builtin_amdgcn_readfirstlane(qn[0]), i1 = __builtin_amdgcn_readfirstlane(qn[1]);
    __syncthreads();
    { const BigTile t0 = bt_decode(F, WguT, WdT, nf, i0 < BT_N ? i0 : BT_N - 1); BT_LOAD(t0, va, ka); }
    while (i0 < BT_N) {
        const BigTile ta = bt_decode(F, WguT, WdT, nf, i0);
        const BigTile tb = bt_decode(F, WguT, WdT, nf, i1 < BT_N ? i1 : BT_N - 1);
        BT_LOAD(tb, vb, kb);
        if (F.tid == 0) qn[0] = (int)atomicAdd(F.ctl + CW_QUEUE, 1u);
        BT_STORE(ta, va, ka);
        const int i2 = __builtin_amdgcn_readfirstlane(qn[0]);
        if (i1 >= BT_N) break;
        const BigTile tc = bt_decode(F, WguT, WdT, nf, i2 < BT_N ? i2 : BT_N - 1);
        BT_LOAD(tc, va, ka);
        if (F.tid == 0) qn[1] = (int)atomicAdd(F.ctl + CW_QUEUE, 1u);
        BT_STORE(tb, vb, kb);
        const int i3 = __builtin_amdgcn_readfirstlane(qn[1]);
        i0 = i2; i1 = i3;
    }
    __syncthreads();
}
__device__ __forceinline__ void p0_prologue(Frame& F) {
    if (F.vcu < 32) s5_tables(F, F.vcu);
    const int gw = F.vcu * 8 + F.wave, NGW = F.G * 8;
    bf16* WinT = (bf16*)(F.ws + WS_WIN); bf16* WoT = (bf16*)(F.ws + WS_WO); bf16* WmkvT = (bf16*)(F.ws + WS_WMKV); bf16* WgluT = (bf16*)(F.ws + WS_WGLU);
    bf16* WguT = (bf16*)(F.ws + WS_WGU); bf16* WdT = (bf16*)(F.ws + WS_WD);
    const float* nf = F.in[I_NORM_FFN];
    constexpr int I_IN = 32 * 72, I_O = 32 * 64, I_MKV = 32 * 32, I_GLU = 8 * 16;
    constexpr int NITEMS = I_IN + I_O + I_MKV + I_GLU;
    auto decode = [&](int it) -> TrItem {
        int r = it;
        if (r < I_IN) { const int kb = r / 72, nb = r % 72; return TrItem{F.in[I_W_IN], WinT, nullptr, INC, D, kb * 64, nb * 32, nb * 32}; } r -= I_IN;
        if (r < I_O) { const int kb = r / 64, nb = r % 64; return TrItem{F.in[I_W_O], WoT, nullptr, D, D, kb * 64, nb * 32, nb * 32}; } r -= I_O;
        if (r < I_MKV) { const int kb = r / 32, nb = r % 32; return TrItem{F.in[I_W_MEM_KV], WmkvT, nullptr, 1024, D, kb * 64, nb * 32, nb * 32}; } r -= I_MKV;
        const int kb = r / 16, nb = r % 16; return TrItem{F.in[I_W_GLU], WgluT, nullptr, 512, 512, kb * 64, nb * 32, nb * 32};
    };
    {
        f32x4 va[8], vb[8]; int it = gw; TrItem ia, ib;
        if (it < NITEMS) { ia = decode(it); tr_load(ia, va, F.lane); }
        while (it < NITEMS) {
            const int it2 = it + NGW; if (it2 < NITEMS) { ib = decode(it2); tr_load(ib, vb, F.lane); }
            tr_store(ia, va, F.lane);
            if (it2 >= NITEMS) break;
            const int it3 = it2 + NGW; if (it3 < NITEMS) { ia = decode(it3); tr_load(ia, va, F.lane); }
            tr_store(ib, vb, F.lane);
            it = it3;
        }
    }
    { bf16* WrT = (bf16*)(F.ws + WS_WR); const int gt = F.vcu * 512 + F.tid, NT = F.G * 512;
      for (int idx = gt; idx < 4 * 256 * 512; idx += NT) { const int ks = idx >> 17, n = (idx >> 9) & 255, k = ks * 512 + (idx & 511); float v = 0.f;
          if (n < 8) v = F.in[I_WR_G][k * 8 + n] * nf[k]; else if (n < 72) v = F.in[I_WR_E][k * 64 + (n - 8)] * nf[k];
          WrT[idx] = (bf16)f2bf(v); } }
    bf16* XN = (bf16*)(F.ws + WS_XN); bf16* MEMN = (bf16*)(F.ws + WS_MEMN);
    for (int m = gw; m < T; m += NGW) rms_row_to_bf16(F.in[I_X] + (size_t)m * D, F.in[I_NORM_MIX], XN + (size_t)m * D, F.lane);
    for (int m = gw; m < NB * MEML; m += NGW) rms_row_to_bf16(F.in[I_MEM] + (size_t)m * D, F.in[I_MEM_NORM], MEMN + (size_t)m * D, F.lane);
    bigtile_convert(F, WguT, WdT, nf);
}

constexpr int SWA_KS = 72, SWA_VS = 264;
constexpr int SWA_KOFF = 0, SWA_VOFF = 256 * SWA_KS * 2, SWA_BOFF = SWA_VOFF + 64 * SWA_VS * 2;
__device__ __forceinline__ int t5_bucket(int n) { if (n < 16) return n; const int v = 16 + (int)(logf((float)n * (1.0f / 16.0f)) / logf(8.0f) * 16.0f); return v < 31 ? v : 31; }
__device__ __forceinline__ void swa_unit(Frame& F, int unit) {
    const int b = unit >> 5, kvh = (unit >> 4) & 1, nb = unit & 15;
    const bf16* PROJ = (const bf16*)(F.ws + WS_PROJ); bf16* MIX = (bf16*)(F.ws + WS_MIX);
    LAS bf16* Ks = (LAS bf16*)(F.lds + SWA_KOFF); LAS bf16* Vt = (LAS bf16*)(F.lds + SWA_VOFF); LAS float* bt = (LAS float*)(F.lds + SWA_BOFF);
    __syncthreads();
    {
        const int key = F.tid >> 1, half = F.tid & 1, s = (nb - 1) * 128 + key;
        v4u kw[4], vw[4];
        if (s >= 0) { const bf16* rp = PROJ + (size_t)(b * SEQ + s) * INC + 1024 + kvh * 64 + half * 32;
#pragma unroll
            for (int j = 0; j < 4; ++j) { kw[j] = *(const v4u*)(rp + j * 8); vw[j] = *(const v4u*)(rp + 128 + j * 8); }
        } else {
#pragma unroll
            for (int j = 0; j < 4; ++j) { kw[j] = (v4u){0u, 0u, 0u, 0u}; vw[j] = (v4u){0u, 0u, 0u, 0u}; } }
        float kf[32]; float ss = 0.f;
#pragma unroll
        for (int j = 0; j < 4; ++j) { kf[j * 8 + 0] = bflo(kw[j].x); kf[j * 8 + 1] = bfhi(kw[j].x); kf[j * 8 + 2] = bflo(kw[j].y); kf[j * 8 + 3] = bfhi(kw[j].y);
            kf[j * 8 + 4] = bflo(kw[j].z); kf[j * 8 + 5] = bfhi(kw[j].z); kf[j * 8 + 6] = bflo(kw[j].w); kf[j * 8 + 7] = bfhi(kw[j].w); }
#pragma unroll
        for (int j = 0; j < 32; ++j) ss += kf[j] * kf[j];
        ss += __shfl_xor(ss, 1);
        const float rstd = 1.0f / sqrtf(ss * (1.f / 64.f) + EPS);
        const float* kn = F.in[I_K_NORM] + half * 32;
#pragma unroll
        for (int j = 0; j < 4; ++j) { v4u o; o.x = pk2(kf[j * 8 + 0] * rstd * kn[j * 8 + 0], kf[j * 8 + 1] * rstd * kn[j * 8 + 1]); o.y = pk2(kf[j * 8 + 2] * rstd * kn[j * 8 + 2], kf[j * 8 + 3] * rstd * kn[j * 8 + 3]);
            o.z = pk2(kf[j * 8 + 4] * rstd * kn[j * 8 + 4], kf[j * 8 + 5] * rstd * kn[j * 8 + 5]); o.w = pk2(kf[j * 8 + 6] * rstd * kn[j * 8 + 6], kf[j * 8 + 7] * rstd * kn[j * 8 + 7]);
            *(LAS v4u*)(Ks + key * SWA_KS + half * 32 + j * 8) = o; }
#pragma unroll
        for (int j = 0; j < 4; ++j) { const unsigned w4[4] = {vw[j].x, vw[j].y, vw[j].z, vw[j].w};
#pragma unroll
            for (int q = 0; q < 4; ++q) { const int d = half * 32 + j * 8 + q * 2; Vt[d * SWA_VS + key] = (bf16)(w4[q] & 0xffffu); Vt[(d + 1) * SWA_VS + key] = (bf16)(w4[q] >> 16); } }
        for (int idx = F.tid; idx < 8 * 128; idx += 512) { const int w = idx >> 7, dl = idx & 127; bt[idx] = F.in[I_REL_BIAS][t5_bucket(dl) * 16 + kvh * 8 + w]; }
    }
    __syncthreads();
    const int w = F.wave, h = kvh * 8 + w, ql = F.lane & 31, hh = F.lane >> 5;
    const float sink = F.in[I_SINKS][h];
    const float* qn = F.in[I_Q_NORM];
    for (int r = 0; r < 4; ++r) {
        const int qi = 32 * r + ql; const size_t t = (size_t)b * SEQ + nb * 128 + qi;
        bf16x8 qf[4];
        {   const bf16* qp = PROJ + t * INC + h * 64 + 8 * hh; v4u qw[4]; float qv[32]; float ss = 0.f;
#pragma unroll
            for (int ks = 0; ks < 4; ++ks) qw[ks] = *(const v4u*)(qp + ks * 16);
#pragma unroll
            for (int ks = 0; ks < 4; ++ks) { qv[ks * 8 + 0] = bflo(qw[ks].x); qv[ks * 8 + 1] = bfhi(qw[ks].x); qv[ks * 8 + 2] = bflo(qw[ks].y); qv[ks * 8 + 3] = bfhi(qw[ks].y);
                qv[ks * 8 + 4] = bflo(qw[ks].z); qv[ks * 8 + 5] = bfhi(qw[ks].z); qv[ks * 8 + 6] = bflo(qw[ks].w); qv[ks * 8 + 7] = bfhi(qw[ks].w); }
#pragma unroll
            for (int j = 0; j < 32; ++j) ss += qv[j] * qv[j];
            ss += __shfl_xor(ss, 32);
            const float sc = 0.125f / sqrtf(ss * (1.f / 64.f) + EPS);
#pragma unroll
            for (int ks = 0; ks < 4; ++ks) { const float* g = qn + ks * 16 + 8 * hh; v4u o;
                o.x = pk2(qv[ks * 8 + 0] * sc * g[0], qv[ks * 8 + 1] * sc * g[1]); o.y = pk2(qv[ks * 8 + 2] * sc * g[2], qv[ks * 8 + 3] * sc * g[3]);
                o.z = pk2(qv[ks * 8 + 4] * sc * g[4], qv[ks * 8 + 5] * sc * g[5]); o.w = pk2(qv[ks * 8 + 6] * sc * g[6], qv[ks * 8 + 7] * sc * g[7]);
                qf[ks] = __builtin_bit_cast(bf16x8, o); } }
        f32x16 s[5];
        const int qh = ql - 4 * hh; const LAS float* pb = bt + w * 128 + qh;
        float mx = sink;
#pragma unroll
        for (int kt = 0; kt < 5; ++kt) {
            const bool live = (nb > 0) || (r + kt >= 4);
            f32x16 a = {0.f, 0.f, 0.f, 0.f, 0.f, 0.f, 0.f, 0.f, 0.f, 0.f, 0.f, 0.f, 0.f, 0.f, 0.f, 0.f};
            if (live) {
#pragma unroll
                for (int ks = 0; ks < 4; ++ks) { const bf16x8 kfrag = *(const LAS bf16x8*)(Ks + (32 * (r + kt) + ql) * SWA_KS + ks * 16 + 8 * hh);
                    a = __builtin_amdgcn_mfma_f32_32x32x16_bf16(kfrag, qf[ks], a, 0, 0, 0); }
#pragma unroll
                for (int rg = 0; rg < 16; ++rg) { const int rowc = (rg & 3) + 8 * (rg >> 2);
                    float v = a[rg] + pb[128 - 32 * kt - rowc];
                    if (kt == 0) v = (rowc > qh) ? v : -1e30f;
                    if (kt == 4) v = (rowc <= qh) ? v : -1e30f;
                    a[rg] = v; mx = fmaxf(mx, v); }
            } else {
#pragma unroll
                for (int rg = 0; rg < 16; ++rg) a[rg] = -1e30f;
            }
            s[kt] = a; }
        mx = fmaxf(mx, __shfl_xor(mx, 32));
        float l = 0.f;
#pragma unroll
        for (int kt = 0; kt < 5; ++kt)
#pragma unroll
            for (int rg = 0; rg < 16; ++rg) { const float p = fast_exp(s[kt][rg] - mx); s[kt][rg] = p; l += p; }
        l += __shfl_xor(l, 32);
        l += fast_exp(sink - mx);
        f32x16 o[2];
#pragma unroll
        for (int dt = 0; dt < 2; ++dt) o[dt] = (f32x16){0.f, 0.f, 0.f, 0.f, 0.f, 0.f, 0.f, 0.f, 0.f, 0.f, 0.f, 0.f, 0.f, 0.f, 0.f, 0.f};
#pragma unroll
        for (int kt = 0; kt < 5; ++kt)
#pragma unroll
            for (int st = 0; st < 2; ++st) { v4u pw; pw.x = pk2(s[kt][8 * st + 0], s[kt][8 * st + 1]); pw.y = pk2(s[kt][8 * st + 2], s[kt][8 * st + 3]); pw.z = pk2(s[kt][8 * st + 4], s[kt][8 * st + 5]); pw.w = pk2(s[kt][8 * st + 6], s[kt][8 * st + 7]);
                const bf16x8 pf = __builtin_bit_cast(bf16x8, pw);
#pragma unroll
                for (int dt = 0; dt < 2; ++dt) { const LAS bf16* vp = Vt + (dt * 32 + ql) * SWA_VS + 32 * (r + kt) + 16 * st + 4 * hh;
                    const v2u lo = *(const LAS v2u*)vp, hi = *(const LAS v2u*)(vp + 8); v4u vv; vv.x = lo.x; vv.y = lo.y; vv.z = hi.x; vv.w = hi.y;
                    o[dt] = __builtin_amdgcn_mfma_f32_32x32x16_bf16(__builtin_bit_cast(bf16x8, vv), pf, o[dt], 0, 0, 0); } }
        const float inv = 1.0f / l;
        bf16* op = MIX + t * D + h * 64 + 4 * hh;
#pragma unroll
        for (int dt = 0; dt < 2; ++dt)
#pragma unroll
            for (int q4 = 0; q4 < 4; ++q4) { v2u ow; ow.x = pk2(o[dt][q4 * 4 + 0] * inv, o[dt][q4 * 4 + 1] * inv); ow.y = pk2(o[dt][q4 * 4 + 2] * inv, o[dt][q4 * 4 + 3] * inv);
                *(v2u*)(op + dt * 32 + q4 * 8) = ow; }
    }
}

constexpr int XA_KS = 136, XA_VS = 264;
constexpr int XA_KOFF = 0, XA_VOFF = 256 * XA_KS * 2;
__device__ __forceinline__ void xattn_unit(Frame& F, int unit) {
    const int b = unit >> 5, hx = (unit >> 3) & 3, qb = unit & 7;
    const bf16* PROJ = (const bf16*)(F.ws + WS_PROJ); const bf16* MKV = (const bf16*)(F.ws + WS_MEMKV); bf16* MIX = (bf16*)(F.ws + WS_MIX);
    LAS bf16* Ks = (LAS bf16*)(F.lds + XA_KOFF); LAS bf16* Vt = (LAS bf16*)(F.lds + XA_VOFF);
    __syncthreads();
    {   const int key = F.tid >> 1, half = F.tid & 1; const bf16* rp = MKV + (size_t)(b * MEML + key) * 1024 + hx * 128 + half * 64;
        float ss = 0.f; v4u kw[8];
#pragma unroll
        for (int j = 0; j < 8; ++j) { kw[j] = *(const v4u*)(rp + j * 8);
            const float a0 = bflo(kw[j].x), a1 = bfhi(kw[j].x), a2 = bflo(kw[j].y), a3 = bfhi(kw[j].y), a4 = bflo(kw[j].z), a5 = bfhi(kw[j].z), a6 = bflo(kw[j].w), a7 = bfhi(kw[j].w);
            ss += (a0 * a0 + a1 * a1) + (a2 * a2 + a3 * a3) + (a4 * a4 + a5 * a5) + (a6 * a6 + a7 * a7); }
        ss += __shfl_xor(ss, 1);
        const float rstd = 1.0f / sqrtf(ss * (1.f / 128.f) + EPS);
        const float* kn = F.in[I_XK_NORM] + half * 64;
#pragma unroll
        for (int j = 0; j < 8; ++j) { v4u o; const float* g = kn + j * 8;
            o.x = pk2(bflo(kw[j].x) * rstd * g[0], bfhi(kw[j].x) * rstd * g[1]); o.y = pk2(bflo(kw[j].y) * rstd * g[2], bfhi(kw[j].y) * rstd * g[3]);
            o.z = pk2(bflo(kw[j].z) * rstd * g[4], bfhi(kw[j].z) * rstd * g[5]); o.w = pk2(bflo(kw[j].w) * rstd * g[6], bfhi(kw[j].w) * rstd * g[7]);
            *(LAS v4u*)(Ks + key * XA_KS + half * 64 + j * 8) = o; }
#pragma unroll
        for (int j = 0; j < 8; ++j) { const v4u vw = *(const v4u*)(rp + 512 + j * 8); const unsigned w4[4] = {vw.x, vw.y, vw.z, vw.w};
#pragma unroll
            for (int q = 0; q < 4; ++q) { const int d = half * 64 + j * 8 + q * 2; Vt[d * XA_VS + key] = (bf16)(w4[q] & 0xffffu); Vt[(d + 1) * XA_VS + key] = (bf16)(w4[q] >> 16); } }
    }
    __syncthreads();
    const int ql = F.lane & 31, hh = F.lane >> 5;
    const size_t t = (size_t)b * SEQ + qb * 256 + F.wave * 32 + ql;
    bf16x8 qf[8];
    {   const bf16* qp = PROJ + t * INC + 1792 + hx * 128 + 8 * hh; v4u qw[8]; float ss = 0.f;
#pragma unroll
        for (int ks = 0; ks < 8; ++ks) { qw[ks] = *(const v4u*)(qp + ks * 16);
            const float a0 = bflo(qw[ks].x), a1 = bfhi(qw[ks].x), a2 = bflo(qw[ks].y), a3 = bfhi(qw[ks].y), a4 = bflo(qw[ks].z), a5 = bfhi(qw[ks].z), a6 = bflo(qw[ks].w), a7 = bfhi(qw[ks].w);
            ss += (a0 * a0 + a1 * a1) + (a2 * a2 + a3 * a3) + (a4 * a4 + a5 * a5) + (a6 * a6 + a7 * a7); }
        ss += __shfl_xor(ss, 32);
        const float sc = 0.08838834764831845f / sqrtf(ss * (1.f / 128.f) + EPS);
        const float* qn = F.in[I_XQ_NORM] + 8 * hh;
#pragma unroll
        for (int ks = 0; ks < 8; ++ks) { const float* g = qn + ks * 16; v4u o;
            o.x = pk2(bflo(qw[ks].x) * sc * g[0], bfhi(qw[ks].x) * sc * g[1]); o.y = pk2(bflo(qw[ks].y) * sc * g[2], bfhi(qw[ks].y) * sc * g[3]);
            o.z = pk2(bflo(qw[ks].z) * sc * g[4], bfhi(qw[ks].z) * sc * g[5]); o.w = pk2(bflo(qw[ks].w) * sc * g[6], bfhi(qw[ks].w) * sc * g[7]);
            qf[ks] = __builtin_bit_cast(bf16x8, o); } }
    f32x16 o[4];
#pragma unroll
    for (int dt = 0; dt < 4; ++dt) o[dt] = (f32x16){0.f, 0.f, 0.f, 0.f, 0.f, 0.f, 0.f, 0.f, 0.f, 0.f, 0.f, 0.f, 0.f, 0.f, 0.f, 0.f};
    float mrun = -1e30f, lrun = 0.f;
    for (int kb = 0; kb < 4; ++kb) {
        f32x16 s[2];
#pragma unroll
        for (int kt = 0; kt < 2; ++kt) { f32x16 a = {0.f, 0.f, 0.f, 0.f, 0.f, 0.f, 0.f, 0.f, 0.f, 0.f, 0.f, 0.f, 0.f, 0.f, 0.f, 0.f};
#pragma unroll
            for (int ks = 0; ks < 8; ++ks) { const bf16x8 kfrag = *(const LAS bf16x8*)(Ks + (64 * kb + 32 * kt + ql) * XA_KS + ks * 16 + 8 * hh);
                a = __builtin_amdgcn_mfma_f32_32x32x16_bf16(kfrag, qf[ks], a, 0, 0, 0); }
            s[kt] = a; }
        float mx = mrun;
#pragma unroll
        for (int kt = 0; kt < 2; ++kt)
#pragma unroll
            for (int rg = 0; rg < 16; ++rg) mx = fmaxf(mx, s[kt][rg]);
        mx = fmaxf(mx, __shfl_xor(mx, 32));
        const float alpha = fast_exp(mrun - mx); mrun = mx;
        float ls = 0.f;
#pragma unroll
        for (int kt = 0; kt < 2; ++kt)
#pragma unroll
            for (int rg = 0; rg < 16; ++rg) { const float p = fast_exp(s[kt][rg] - mx); s[kt][rg] = p; ls += p; }
        lrun = lrun * alpha + ls;
#pragma unroll
        for (int dt = 0; dt < 4; ++dt)
#pragma unroll
            for (int rg = 0; rg < 16; ++rg) o[dt][rg] *= alpha;
#pragma unroll
        for (int kt = 0; kt < 2; ++kt)
#pragma unroll
            for (int st = 0; st < 2; ++st) { v4u pw; pw.x = pk2(s[kt][8 * st + 0], s[kt][8 * st + 1]); pw.y = pk2(s[kt][8 * st + 2], s[kt][8 * st + 3]); pw.z = pk2(s[kt][8 * st + 4], s[kt][8 * st + 5]); pw.w = pk2(s[kt][8 * st + 6], s[kt][8 * st + 7]);
                const bf16x8 pf = __builtin_bit_cast(bf16x8, pw);
#pragma unroll
                for (int dt = 0; dt < 4; ++dt) { const LAS bf16* vp = Vt + (dt * 32 + ql) * XA_VS + 64 * kb + 32 * kt + 16 * st + 4 * hh;
                    const v2u lo = *(const LAS v2u*)vp, hi = *(const LAS v2u*)(vp + 8); v4u vv; vv.x = lo.x; vv.y = lo.y; vv.z = hi.x; vv.w = hi.y;
                    o[dt] = __builtin_amdgcn_mfma_f32_32x32x16_bf16(__builtin_bit_cast(bf16x8, vv), pf, o[dt], 0, 0, 0); } }
    }
    lrun += __shfl_xor(lrun, 32);
    const float inv = 1.0f / lrun;
    bf16* op = MIX + t * D + 1536 + hx * 128 + 4 * hh;
#pragma unroll
    for (int dt = 0; dt < 4; ++dt)
#pragma unroll
        for (int q4 = 0; q4 < 4; ++q4) { v2u ow; ow.x = pk2(o[dt][q4 * 4 + 0] * inv, o[dt][q4 * 4 + 1] * inv); ow.y = pk2(o[dt][q4 * 4 + 2] * inv, o[dt][q4 * 4 + 3] * inv);
            *(v2u*)(op + dt * 32 + q4 * 8) = ow; }
}

__device__ __forceinline__ void moe_tables(Frame& F) {
    LAS int* cnt = (LAS int*)(F.lds + TAB_OFF); LAS int* ts = cnt + 64;
    __syncthreads();
    if (F.tid < 64) { const int c = (int)__hip_atomic_load(F.ctl + CW_CNT + F.tid, __ATOMIC_RELAXED, __HIP_MEMORY_SCOPE_AGENT); const int nt = (c + 255) >> 8; int inc = nt;
#pragma unroll
        for (int o = 1; o < 64; o <<= 1) { const int v = __shfl_up(inc, o); if (F.tid >= o) inc += v; }
        cnt[F.tid] = c; ts[F.tid + 1] = inc; if (F.tid == 0) ts[0] = 0; }
    __syncthreads();
}

struct Args { const float* in[31]; float* out; unsigned char* ws; int ph_lo, ph_hi; };
__global__ void __launch_bounds__(512, 2) hymba_fwd(Args args) {
    extern __shared__ __attribute__((aligned(16))) unsigned char lds_raw[];
    Frame F;
    F.lds = (LAS unsigned char*)lds_raw;
    F.tid = threadIdx.x; F.lane = F.tid & 63; F.wave = __builtin_amdgcn_readfirstlane(F.tid >> 6);
    F.G = gridDim.x; { const int bx = blockIdx.x; F.vcu = (F.G % 8 == 0) ? (bx % 8) * (F.G / 8) + bx / 8 : bx; }
#pragma unroll
    for (int i = 0; i < 31; ++i) F.in[i] = args.in[i];
    F.out = args.out; F.ws = args.ws; F.ctl = (unsigned*)(args.ws + WS_CTL);
    const int lo = args.ph_lo, hi = args.ph_hi;
#if !MK_PER_PHASE
    if (F.tid < 4) ((LAS unsigned*)(F.lds + XBW_OFF))[F.tid] = 0u;
    __syncthreads();
    XcdBarrier bar = xcd_barrier_post(F.ctl + CW_BAR, (volatile LAS unsigned*)(F.lds + XBW_OFF));
#define GRID_BAR() xcd_barrier(bar)
#else
#define GRID_BAR() do {} while (0)
#endif
#define IN(k) (lo <= (k) && (k) < hi)
#define SEAM(k) do { if (IN(k) && IN((k) + 1)) GRID_BAR(); } while (0)
    const int gw = F.vcu * 8 + F.wave, NGW = F.G * 8;
    bf16* const XN = (bf16*)(F.ws + WS_XN); bf16* const PROJ = (bf16*)(F.ws + WS_PROJ); bf16* const MIX = (bf16*)(F.ws + WS_MIX);
    bf16* const UA = (bf16*)(F.ws + WS_UA); bf16* const Gm = (bf16*)(F.ws + WS_G);

    if (IN(0)) { p0_prologue(F); }
    SEAM(0);
    if (IN(1)) {
        { pg8::Gemm g{D, D, D}; pg8::DenseOrder S; S.init(XN, F.ws + WS_WIN, D, D, T, INC, F.G, (int)blockIdx.x);
          pg8::EpiProj E{PROJ, UA}; pg8::gemm_phase<pg8::EpiProj, pg8::DenseOrder>(F.lds, g, S, E); }
        { pg8::Gemm g{D, D, D}; pg8::DenseOrder S; S.init(F.ws + WS_MEMN, F.ws + WS_WMKV, D, D, NB * MEML, 1024, F.G, F.G - 1 - (int)blockIdx.x);
          pg8::EpiBf16 E{(bf16*)(F.ws + WS_MEMKV), 1024}; pg8::gemm_phase<pg8::EpiBf16, pg8::DenseOrder>(F.lds, g, S, E); }
    }
    SEAM(1);
    if (IN(2)) {
        for (int u = F.vcu; u < 256; u += F.G) swa_unit(F, u);
        __syncthreads();
        { pg8::Gemm g{S5K, 512, 512}; pg8::GroupOrder S{(const char*)UA, (const char*)(F.ws + WS_SP), S5K, 512, 1, 32, F.G, F.G - 1 - F.vcu};
          pg8::EpiF32 E{(float*)(F.ws + WS_SL), 256, (size_t)512 * 256}; pg8::gemm_phase<pg8::EpiF32, pg8::GroupOrder>(F.lds, g, S, E); }
    }
    SEAM(2);
    if (IN(3)) {
        if (F.wave == 0) {
            const float* SL = (const float*)(F.ws + WS_SL); const float* AL = (const float*)(F.ws + WS_AL);
            for (int p = F.vcu; p < 256; p += F.G) { const int b = p >> 5, g = p & 31, n = F.lane;
                const float ar = AL[(g * 64 + n) * 2], ai = AL[(g * 64 + n) * 2 + 1]; float xr = 0.f, xi = 0.f;
                for (int j0 = 0; j0 < 64; j0 += 8) { float sr[8], si[8];
#pragma unroll
                    for (int j = 0; j < 8; ++j) { const float* sp = SL + ((size_t)(g * 512 + b * 64 + j0 + j)) * 256; sr[j] = sp[n]; si[j] = sp[64 + n]; }
#pragma unroll
                    for (int j = 0; j < 8; ++j) { bf16* up = UA + ((size_t)(g * 512 + b * 64 + j0 + j)) * S5K + 512; up[n] = (bf16)f2bf(xr); up[64 + n] = (bf16)f2bf(xi);
                        const float nr = ar * xr - ai * xi + sr[j], ni = ar * xi + ai * xr + si[j]; xr = nr; xi = ni; } } }
        }
        for (int u = F.vcu; u < 256; u += F.G) xattn_unit(F, u);
        __syncthreads();
    }
    SEAM(3);
    if (IN(4)) {
        pg8::Gemm g{S5K, S5K, S5K}; pg8::GroupOrder S{(const char*)UA, (const char*)(F.ws + WS_MQ), S5K, S5K, 2, 32, F.G, F.vcu};
        pg8::EpiS5Y E{UA, F.in[I_SSM_D], Gm}; pg8::gemm_phase<pg8::EpiS5Y, pg8::GroupOrder>(F.lds, g, S, E);
    }
    SEAM(4);
    if (IN(5)) {
        pg8::Gemm g{512, 512, 512}; pg8::DenseOrder S; S.init(Gm, F.ws + WS_WGLU, 512, 512, T, 512, F.G, (int)blockIdx.x);
        pg8::EpiGlu E{Gm, MIX}; pg8::gemm_phase<pg8::EpiGlu, pg8::DenseOrder>(F.lds, g, S, E);
    }
    SEAM(5);
    if (IN(6)) {
        for (int m = gw; m < T; m += NGW) { v4u* rp = (v4u*)(MIX + (size_t)m * D) + F.lane; v4u w[4]; float ss[4];
#pragma unroll
            for (int j = 0; j < 4; ++j) { w[j] = rp[64 * j];
                const float a0 = bflo(w[j].x), a1 = bfhi(w[j].x), a2 = bflo(w[j].y), a3 = bfhi(w[j].y), a4 = bflo(w[j].z), a5 = bfhi(w[j].z), a6 = bflo(w[j].w), a7 = bfhi(w[j].w);
                ss[j] = (a0 * a0 + a1 * a1) + (a2 * a2 + a3 * a3) + (a4 * a4 + a5 * a5) + (a6 * a6 + a7 * a7); }
            const float sa = wave_sum(ss[0] + ss[1]), sb = wave_sum(ss[2]), sc = wave_sum(ss[3]);
            const float ra = 1.0f / sqrtf(sa * (1.f / 1024.f) + EPS), rb = 1.0f / sqrtf(sb * (1.f / 512.f) + EPS), rc = 1.0f / sqrtf(sc * (1.f / 512.f) + EPS);
#pragma unroll
            for (int j = 0; j < 4; ++j) { const float rs = j < 2 ? ra : (j == 2 ? rb : rc);
                const float* g = (j < 2 ? F.in[I_ON_ATTN] + j * 512 : (j == 2 ? F.in[I_ON_SSM] : F.in[I_ON_X])) + F.lane * 8; v4u o;
                o.x = pk2(bflo(w[j].x) * rs * g[0], bfhi(w[j].x) * rs * g[1]); o.y = pk2(bflo(w[j].y) * rs * g[2], bfhi(w[j].y) * rs * g[3]);
                o.z = pk2(bflo(w[j].z) * rs * g[4], bfhi(w[j].z) * rs * g[5]); o.w = pk2(bflo(w[j].w) * rs * g[6], bfhi(w[j].w) * rs * g[7]);
                rp[64 * j] = o; } }
    }
    SEAM(6);
    if (IN(7)) {
        pg8::Gemm g{D, D, D}; pg8::DenseOrder S; S.init(MIX, F.ws + WS_WO, D, D, T, D, F.G, (int)blockIdx.x);
        pg8::EpiWo E{F.in[I_X], XN, (float*)(F.ws + WS_PART)}; pg8::gemm_phase<pg8::EpiWo, pg8::DenseOrder>(F.lds, g, S, E);
    }
    SEAM(7);
    if (IN(8)) {
        pg8::Gemm g{D, 512, 512}; pg8::KSplitOrder S{(const char*)XN, (const char*)(F.ws + WS_WR), D, 512, 512, T / 256, 4, F.G, F.vcu};
        pg8::EpiLogit E{(float*)(F.ws + WS_LP)}; pg8::gemm_phase<pg8::EpiLogit, pg8::KSplitOrder>(F.lds, g, S, E);
    }
    SEAM(8);
    const int rt_per = (T + F.G - 1) / F.G, rt_beg = F.vcu * rt_per, rt_end = (rt_beg + rt_per) < T ? (rt_beg + rt_per) : T;
    if (IN(9)) {
        LAS int* hist = (LAS int*)F.lds;
        const float* LP = (const float*)(F.ws + WS_LP); const float* part = (const float*)(F.ws + WS_PART); float* rstdv = (float*)(F.ws + WS_RSTD);
        int* toke = (int*)(F.ws + WS_TOKE); float* wts = (float*)(F.ws + WS_WTS); int* HIST = (int*)(F.ws + WS_HIST);
        __syncthreads();
        if (F.tid < 64) hist[F.tid] = 0;
        __syncthreads();
        for (int t = rt_beg + F.tid; t < rt_end; t += 512) {
            const f32x4* pp = (const f32x4*)(part + (size_t)t * 32); float ss = 0.f;
#pragma unroll
            for (int j = 0; j < 8; ++j) { const f32x4 v = pp[j]; ss += (v[0] + v[1]) + (v[2] + v[3]); }
            const float rs = 1.0f / sqrtf(ss * (1.f / 2048.f) + EPS); rstdv[t] = rs;
            const float* l0 = LP + (size_t)t * 80; const float* l1 = l0 + (size_t)T * 80; const float* l2 = l1 + (size_t)T * 80; const float* l3 = l2 + (size_t)T * 80;
            float gl[8];
#pragma unroll
            for (int j = 0; j < 8; j += 4) { const f32x4 a = *(const f32x4*)(l0 + j), b = *(const f32x4*)(l1 + j), c = *(const f32x4*)(l2 + j), d = *(const f32x4*)(l3 + j);
#pragma unroll
                for (int q = 0; q < 4; ++q) gl[j + q] = rs * (((a[q] + b[q]) + c[q]) + d[q]); }
            int gi = 0; float gm = gl[0];
#pragma unroll
            for (int j = 1; j < 8; ++j) if (gl[j] > gm) { gm = gl[j]; gi = j; }
            float gs = 0.f;
#pragma unroll
            for (int j = 0; j < 8; ++j) gs += expf(gl[j] - gm);
            const float gate = 1.0f / gs;
            float el[8];
#pragma unroll
            for (int j = 0; j < 8; j += 4) { const int o = 8 + gi * 8 + j; const f32x4 a = *(const f32x4*)(l0 + o), b = *(const f32x4*)(l1 + o), c = *(const f32x4*)(l2 + o), d = *(const f32x4*)(l3 + o);
#pragma unroll
                for (int q = 0; q < 4; ++q) el[j + q] = rs * (((a[q] + b[q]) + c[q]) + d[q]); }
            int i1 = 0; float v1 = el[0];
#pragma unroll
            for (int j = 1; j < 8; ++j) if (el[j] > v1) { v1 = el[j]; i1 = j; }
            int i2 = -1; float v2 = -3.0e38f;
#pragma unroll
            for (int j = 0; j < 8; ++j) if (j != i1 && el[j] > v2) { v2 = el[j]; i2 = j; }
            const float ex = expf(v2 - v1);
            const int ea = gi * 8 + i1, eb = gi * 8 + i2;
            const int la = __hip_atomic_fetch_add(hist + ea, 1, __ATOMIC_RELAXED, __HIP_MEMORY_SCOPE_WORKGROUP), lb = __hip_atomic_fetch_add(hist + eb, 1, __ATOMIC_RELAXED, __HIP_MEMORY_SCOPE_WORKGROUP);
            toke[t * 2] = (ea << 16) | la; toke[t * 2 + 1] = (eb << 16) | lb; wts[t * 2] = gate / (1.0f + ex); wts[t * 2 + 1] = gate * ex / (1.0f + ex);
        }
        __syncthreads();
        if (F.tid < 64) HIST[F.vcu * 64 + F.tid] = hist[F.tid];
        __syncthreads();
    }
    SEAM(9);
    if (IN(10)) {
        LAS int* pb = (LAS int*)F.lds; LAS int* pt = pb + 512; LAS int* base = pt + 512;
        const int* HIST = (const int*)(F.ws + WS_HIST); const int* toke = (const int*)(F.ws + WS_TOKE); int* list = (int*)(F.ws + WS_LIST);
        __syncthreads();
        { const int e = F.tid & 63, p8 = F.tid >> 6; int sb = 0, st = 0;
          for (int w = p8; w < F.G; w += 8) { const int h = HIST[w * 64 + e]; st += h; sb += (w < F.vcu) ? h : 0; }
          pb[F.tid] = sb; pt[F.tid] = st; }
        __syncthreads();
        if (F.tid < 64) { int sb = 0, st = 0;
#pragma unroll
            for (int j = 0; j < 8; ++j) { sb += pb[j * 64 + F.tid]; st += pt[j * 64 + F.tid]; }
            base[F.tid] = sb; F.ctl[CW_CNT + F.tid] = (unsigned)st; }
        __syncthreads();
        for (int t = rt_beg + F.tid; t < rt_end; t += 512) {
#pragma unroll
            for (int k = 0; k < 2; ++k) { const int v = toke[t * 2 + k], e = v >> 16, sl = v & 0xffff; list[(size_t)e * LCAP + base[e] + sl] = t * 2 + k; } }
        __syncthreads();
    }
    SEAM(10);
    if (IN(11)) {
        moe_tables(F);
        const LAS int* cnt = (const LAS int*)(F.lds + TAB_OFF); const int* list = (const int*)(F.ws + WS_LIST);
        pg8::Gemm g{D, D, D}; pg8::MoeOrder S{(const char*)XN, (const char*)(F.ws + WS_WGU), cnt, cnt + 64, list, D, D, 4, 1024, F.G, F.vcu, true};
        pg8::EpiGU E{list, (const float*)(F.ws + WS_RSTD), cnt, (bf16*)(F.ws + WS_ACT)}; pg8::gemm_phase<pg8::EpiGU, pg8::MoeOrder, true>(F.lds, g, S, E);
    }
    SEAM(11);
    if (IN(12)) {
        moe_tables(F);
        const LAS int* cnt = (const LAS int*)(F.lds + TAB_OFF); const int* list = (const int*)(F.ws + WS_LIST);
        pg8::Gemm g{DEXP, DEXP, DEXP}; pg8::MoeOrder S{(const char*)(F.ws + WS_ACT), (const char*)(F.ws + WS_WD), cnt, cnt + 64, list, DEXP, DEXP, 8, 2048, F.G, F.vcu, false};
        pg8::EpiDown E{list, (const float*)(F.ws + WS_WTS), cnt, (bf16*)(F.ws + WS_Y2)};
        pg8::gemm_phase<pg8::EpiDown, pg8::MoeOrder>(F.lds, g, S, E);
    }
    SEAM(12);
    if (IN(13)) {
        const bf16* Y2 = (const bf16*)(F.ws + WS_Y2);
        for (int m = gw; m < T; m += NGW) { f32x4* op = (f32x4*)(F.out + (size_t)m * D) + F.lane * 2; const v4u* xb = (const v4u*)(XN + (size_t)m * D) + F.lane;
            const v4u* ya = (const v4u*)(Y2 + (size_t)m * 2 * D) + F.lane; const v4u* yb = ya + 256;
            v4u xw[4], aw[4], cw[4];
#pragma unroll
            for (int j = 0; j < 4; ++j) { xw[j] = __builtin_nontemporal_load(xb + 64 * j); aw[j] = __builtin_nontemporal_load(ya + 64 * j); cw[j] = __builtin_nontemporal_load(yb + 64 * j); }
#pragma unroll
            for (int j = 0; j < 4; ++j) { const v4u x = xw[j], a = aw[j], c = cw[j]; f32x4 x0, x1;
                x0[0] = bflo(x.x) + (bflo(a.x) + bflo(c.x)); x0[1] = bfhi(x.x) + (bfhi(a.x) + bfhi(c.x)); x0[2] = bflo(x.y) + (bflo(a.y) + bflo(c.y)); x0[3] = bfhi(x.y) + (bfhi(a.y) + bfhi(c.y));
                x1[0] = bflo(x.z) + (bflo(a.z) + bflo(c.z)); x1[1] = bfhi(x.z) + (bfhi(a.z) + bfhi(c.z)); x1[2] = bflo(x.w) + (bflo(a.w) + bflo(c.w)); x1[3] = bfhi(x.w) + (bfhi(a.w) + bfhi(c.w));
                __builtin_nontemporal_store(x0, op + 128 * j); __builtin_nontemporal_store(x1, op + 128 * j + 1); } }
    }
#undef IN
#undef SEAM
}

extern "C" void kernel_launch(void* const* d_in, const int* in_sizes, int n_in, void* d_out, int out_size, void* d_ws, size_t ws_size, hipStream_t stream) {
    static int grid = 0;
    if (grid == 0) {
        if (n_in != 31 || out_size != T * D || ws_size < WS_END) { fprintf(stderr, "kernel_launch: unexpected shapes (n_in %d out %d ws %zu)\n", n_in, out_size, ws_size); grid = -1; return; }
        int dev = 0, cus = 0, per_cu = 0;
        if (hipGetDevice(&dev) != hipSuccess || hipDeviceGetAttribute(&cus, hipDeviceAttributeMultiprocessorCount, dev) != hipSuccess) { grid = -1; return; }
        if (hipFuncSetAttribute((const void*)hymba_fwd, hipFuncAttributeMaxDynamicSharedMemorySize, LDS_BYTES) != hipSuccess) { fprintf(stderr, "kernel_launch: hipFuncSetAttribute failed\n"); grid = -1; return; }
        if (hipOccupancyMaxActiveBlocksPerMultiprocessor(&per_cu, (const void*)hymba_fwd, 512, LDS_BYTES) != hipSuccess || per_cu < 1) fprintf(stderr, "kernel_launch: occupancy query reports %d\n", per_cu);
        (void)hipGetLastError();
        grid = cus;
    }
    if (grid < 0) return;
    (void)hipMemsetAsync((char*)d_ws + WS_CTL, 0, CTL_ZERO_BYTES, stream);
    Args a{};
    for (int i = 0; i < 31; ++i) a.in[i] = (const float*)d_in[i];
    a.out = (float*)d_out; a.ws = (unsigned char*)d_ws;
#if MK_PER_PHASE
    for (int p = 0; p < NPH; ++p) { const int reps = ((PROBE_REP_MASK >> p) & 1) ? 2 : 1;
        for (int q = 0; q < reps; ++q) { a.ph_lo = p; a.ph_hi = p + 1; hipLaunchKernelGGL(hymba_fwd, dim3(grid), dim3(512), LDS_BYTES, stream, a); } }
#else
    a.ph_lo = 0; a.ph_hi = NPH; hipLaunchKernelGGL(hymba_fwd, dim3(grid), dim3(512), LDS_BYTES, stream, a);
#endif
}
```

```cpp
#include <hip/hip_runtime.h>
#include <cstdio>
#include <cstdint>

#ifndef PROBE_REP_MASK
#define PROBE_REP_MASK 0
#endif
#ifndef PB0
#define PB0 40
#endif
#ifndef PB0_S5
#define PB0_S5 28
#endif
#ifndef PB0_D
#define PB0_D 0
#endif
#ifndef PB1
#define PB1 0
#endif
#ifndef PB2
#define PB2 0
#endif
#ifndef PB4
#define PB4 0
#endif
#ifndef PB5
#define PB5 0
#endif
#ifndef PB11
#define PB11 0
#endif
#ifndef MK_PER_PHASE
#define MK_PER_PHASE 0
#endif

#define GAS __attribute__((address_space(1)))
#define LAS __attribute__((address_space(3)))
typedef unsigned short bf16;
typedef unsigned v4u __attribute__((ext_vector_type(4)));
typedef unsigned v2u __attribute__((ext_vector_type(2)));
typedef float f32x4 __attribute__((ext_vector_type(4)));
typedef float f32x16 __attribute__((ext_vector_type(16)));
typedef short bf16x8 __attribute__((ext_vector_type(8)));
typedef short bf16x4 __attribute__((ext_vector_type(4)));

constexpr int T = 16384, D = 2048, SEQ = 2048, NB = 8, INC = 2304, MEML = 256;
constexpr int NPH = 14;
constexpr float EPS = 1e-6f;
constexpr int NEXP = 64, DEXP = 512, LCAP = 16384;
constexpr int S5L = 32, S5K = 640;

constexpr size_t MiB = 1u << 20;
constexpr size_t WS_CTL = 0, CTL_ZERO_BYTES = 1 * MiB;
constexpr size_t WS_WIN = 2 * MiB, WS_WO = 11 * MiB, WS_WMKV = 19 * MiB, WS_WGLU = 23 * MiB;
constexpr size_t WS_MQ = 24 * MiB, WS_SP = 44 * MiB, WS_UA = 52 * MiB, WS_SL = 72 * MiB, WS_AL = 88 * MiB, WS_WR = 89 * MiB;
constexpr size_t WS_XN = 96 * MiB;
constexpr size_t WS_MEMN = 160 * MiB, WS_MEMKV = 168 * MiB;
constexpr size_t WS_PROJ = 176 * MiB;
constexpr size_t WS_MIX = 248 * MiB;
constexpr size_t WS_Y2 = 176 * MiB;
constexpr size_t WS_G = 312 * MiB;
constexpr size_t WS_LOG = 328 * MiB;
constexpr size_t WS_LIST = 344 * MiB;
constexpr size_t WS_WTS = 348 * MiB;
constexpr size_t WS_LP = 352 * MiB;
constexpr size_t WS_PART = 376 * MiB;
constexpr size_t WS_RSTD = 379 * MiB;
constexpr size_t WS_HIST = 380 * MiB;
constexpr size_t WS_TOKE = 381 * MiB;
constexpr size_t WS_ACT = 544 * MiB;
constexpr size_t WS_WGU = 592 * MiB;
constexpr size_t WS_WD = 848 * MiB;
constexpr size_t WS_END = 976 * MiB;
constexpr int CW_CNT = 1024;
constexpr int CW_BAR = 4096;
constexpr int CW_QGU = 2048, CW_QD = 2112;

constexpr int RING_BYTES = 131072;
constexpr int TAB_OFF = 139264;
constexpr int XBW_OFF = TAB_OFF + 2048;
constexpr int LDS_BYTES = 147456;

#define LDS_WAIT() asm volatile("s_waitcnt lgkmcnt(0)" ::: "memory")
#define VM_WAIT() asm volatile("s_waitcnt vmcnt(0)" ::: "memory")
__device__ __forceinline__ unsigned f2bf(float f) { unsigned u = __builtin_bit_cast(unsigned, f); return (u + 0x7fffu + ((u >> 16) & 1u)) >> 16; }
__device__ __forceinline__ unsigned pk2(float lo, float hi) { unsigned r; asm volatile("v_cvt_pk_bf16_f32 %0, %1, %2" : "=v"(r) : "v"(lo), "v"(hi)); return r; }
__device__ __forceinline__ float bflo(unsigned w) { return __builtin_bit_cast(float, w << 16); }
__device__ __forceinline__ float bfhi(unsigned w) { return __builtin_bit_cast(float, w & 0xffff0000u); }
__device__ __forceinline__ float wave_sum(float v) {
#pragma unroll
    for (int o = 1; o < 64; o <<= 1) v += __shfl_xor(v, o);
    return v;
}
__device__ __forceinline__ float fast_exp(float x) { return __builtin_amdgcn_exp2f(x * 1.44269504089f); }
__device__ __forceinline__ float sigmoidf_(float x) { return __builtin_amdgcn_rcpf(1.0f + fast_exp(-x)); }
__device__ __forceinline__ float gelu_tanh(float x) { const float z = 1.5957691216f * (x + 0.044715f * x * x * x); return x * sigmoidf_(z); }

#define XB_TMO      128
#define XB_XCNT(j)  (256  + 64 * (j))
#define XB_XSUB(j)  (1280 + 64 * (j))
#define XB_XGEN(j)  (2304 + 64 * (j))
#define XB_TOP      3328
#define XB_TOPGEN   3392
#define XCD_BAR_WORDS 3456
#define XB_SPIN_CAP (1u << 18)
__device__ __forceinline__ unsigned xb_ld(unsigned* p)              { return __hip_atomic_load(p, __ATOMIC_RELAXED, __HIP_MEMORY_SCOPE_AGENT); }
__device__ __forceinline__ unsigned xb_add(unsigned* p, unsigned v) { return __hip_atomic_fetch_add(p, v, __ATOMIC_RELAXED, __HIP_MEMORY_SCOPE_AGENT); }
__device__ __forceinline__ unsigned xb_xcc_id() { return (unsigned)__builtin_amdgcn_s_getreg((3 << 11) | 20) & 0xFu; }
#define XB_SPIN(cond, bar) do { unsigned _sp = 0; while (cond) { __builtin_amdgcn_s_sleep(1); \
    if ((++_sp & 255u) == 0u) { if (xb_ld(&(bar)[XB_TMO])) break; if (_sp > XB_SPIN_CAP) { atomicAdd(&(bar)[XB_TMO], 1u); break; } } } } while (0)
struct XcdBarrier { unsigned* bar; unsigned x; volatile LAS unsigned* st; };
__device__ __forceinline__ XcdBarrier xcd_barrier_post(unsigned* bar, volatile LAS unsigned* st) {
    XcdBarrier b; b.bar = bar; b.x = xb_xcc_id(); b.st = st;
    if (threadIdx.x == 0) (void)xb_add(&bar[XB_XCNT(b.x)], 1u);
    return b;
}
__device__ __forceinline__ void xcd_barrier_complete(unsigned* bar, unsigned x, unsigned& nloc, unsigned& nx) {
    const unsigned G = gridDim.x * gridDim.y * gridDim.z;
    unsigned sum, cnt, mine, sp = 0u;
    for (;;) {
        sum = 0u; cnt = 0u; mine = 0u;
#pragma unroll
        for (unsigned j = 0; j < 16; ++j) { const unsigned c = xb_ld(&bar[XB_XCNT(j)]); sum += c; cnt += (c > 0u) ? 1u : 0u; mine = (j == x) ? c : mine; }
        if (sum == G) break;
        __builtin_amdgcn_s_sleep(1);
        if ((++sp & 255u) == 0u) { if (xb_ld(&bar[XB_TMO])) break; if (sp > XB_SPIN_CAP) { atomicAdd(&bar[XB_TMO], 1u); break; } }
    }
    nloc = mine > 0u ? mine : 1u; nx = cnt > 0u ? cnt : 1u;
}
__device__ __forceinline__ void xcd_barrier(const XcdBarrier& b) {
    asm volatile("s_waitcnt vmcnt(0)" ::: "memory");
    __syncthreads();
    if (threadIdx.x == 0) {
        unsigned* bar = b.bar;
        __builtin_amdgcn_s_waitcnt(0);
        unsigned nloc = b.st[0], nx = b.st[1];
        if (nloc == 0u) { xcd_barrier_complete(bar, b.x, nloc, nx); b.st[0] = nloc; b.st[1] = nx; }
        const unsigned old = xb_add(&bar[XB_XSUB(b.x)], 1u);
        const unsigned gen = old / nloc;
        if (old + 1u == (gen + 1u) * nloc) {
            __builtin_amdgcn_fence(__ATOMIC_RELEASE, "agent");
            asm volatile("s_waitcnt vmcnt(0)" ::: "memory");
            const unsigned og = xb_add(&bar[XB_TOP], 1u);
            const unsigned tg = og / nx;
            if (og + 1u == (tg + 1u) * nx) xb_add(&bar[XB_TOPGEN], 1u);
            else XB_SPIN(xb_ld(&bar[XB_TOPGEN]) == tg, bar);
            __builtin_amdgcn_fence(__ATOMIC_ACQUIRE, "agent");
            xb_add(&bar[XB_XGEN(b.x)], 1u);
            asm volatile("s_waitcnt vmcnt(0)" ::: "memory");
        } else {
            XB_SPIN(xb_ld(&bar[XB_XGEN(b.x)]) == gen, bar);
            __builtin_amdgcn_fence(__ATOMIC_ACQUIRE, "agent");
            asm volatile("s_waitcnt vmcnt(0)" ::: "memory");
        }
    }
    __syncthreads();
}

namespace pg8 {
constexpr int BM = 256, BK = 64, HALF = 128, HTB = HALF * BK * 2, STAGE_BYTES = 8 * HTB, NXCD = 8, WGM = 8;
__host__ __device__ __forceinline__ int lds_byte(int r, int c) { const int st = (r >> 4) * 2 + (c >> 5), rr = r & 15, cc = c & 31, ob = rr * 64 + cc * 2; return st * 1024 + (ob ^ (((ob >> 9) & 1) << 5)); }
__host__ __device__ __forceinline__ void stage_rc(int b, int& R, int& C) { const int st = b / 1024, sb = b % 1024, swz = sb ^ (((sb >> 9) & 1) << 5); R = (st >> 1) * 16 + swz / 64; C = (st & 1) * 32 + (swz % 64) / 2; }
__host__ __device__ __forceinline__ int perm32(int rho) { const int n = rho >> 4, i = rho & 15; return 8 * (i >> 2) + 4 * n + (i & 3); }

struct Unit { const char* a; const char* b; int r0, c0, aux, r1; };
struct Gemm { int lda, ldb, K; };

struct DenseOrder {
    const char* A; const char* Bt; int lda, ldb, nM, nN, nwg, G, c;
    __device__ void init(const void* A_, const void* Bt_, int lda_, int ldb_, int M, int N, int G_, int c_) { A = (const char*)A_; Bt = (const char*)Bt_; lda = lda_; ldb = ldb_; nM = M / BM; nN = N / BM; nwg = nM * nN; G = G_; c = c_; }
    __device__ bool next(int i, Unit& u) const {
        const long L = (long)i * G + c; if (L >= nwg) return false;
        int wgid = (int)L; { const int q = nwg / NXCD, r = nwg % NXCD, xcd = wgid % NXCD, off = wgid / NXCD; wgid = (xcd < r ? xcd * (q + 1) : r * (q + 1) + (xcd - r) * q) + off; }
        const int nig = WGM * nN, gid = wgid / nig, fm = gid * WGM, gsz = (nM - fm) < WGM ? (nM - fm) : WGM;
        const int pm = fm + ((wgid % nig) % gsz), pn = (wgid % nig) / gsz;
        u.a = A + (size_t)pm * BM * lda * 2; u.b = Bt + (size_t)pn * BM * ldb * 2; u.r0 = pm * BM; u.c0 = pn * BM; u.aux = 0; u.r1 = 0; return true;
    }
    __device__ __forceinline__ unsigned arow(const Unit&, int) const { return 0u; }
};
struct GroupOrder {
    const char* A; const char* Bt; int lda, ldb, nN, ngrp, G, c;
    __device__ bool next(int i, Unit& u) const {
        const int L = i * G + c; if (L >= ngrp * 2 * nN) return false;
        const int g = L / (2 * nN), q = L % (2 * nN), pn = q >> 1, pm = q & 1;
        u.a = A + ((size_t)g * 512 + pm * BM) * lda * 2; u.b = Bt + ((size_t)g * nN + pn) * BM * ldb * 2; u.r0 = pm * BM; u.c0 = pn * BM; u.aux = g; u.r1 = 0; return true;
    }
    __device__ __forceinline__ unsigned arow(const Unit&, int) const { return 0u; }
};
struct MoeOrder {
    const char* A; const char* Bt; const LAS int* cnt; const LAS int* ts; const int* list; int lda, ldb, nct, brows, G, c; bool gather;
    __device__ bool next(int i, Unit& u) const {
        const int L = i * G + c; const int lane = threadIdx.x & 63;
        if (L >= ts[64] * nct) return false;
        const int lo = ts[lane] * nct, hi = ts[lane + 1] * nct;
        const unsigned long long m = __ballot(lo <= L && L < hi);
        const int e = __builtin_amdgcn_readfirstlane((int)__builtin_ctzll(m));
        const int tse = ts[e], ne = ts[e + 1] - tse, q = L - tse * nct, ct = q / ne, rt = q % ne;
        u.a = gather ? A : A + (size_t)(tse + rt) * BM * lda * 2; u.b = Bt + ((size_t)e * brows + (size_t)ct * BM) * ldb * 2;
        u.r0 = (tse + rt) * BM; u.r1 = rt * BM; u.c0 = ct; u.aux = e; return true;
    }
    __device__ __forceinline__ unsigned arow(const Unit& u, int r) const {
        const int n = cnt[u.aux]; int rr = u.r1 + r; rr = rr < n ? rr : n - 1;
        return (unsigned)(list[(size_t)u.aux * LCAP + rr] >> 1) * (unsigned)(lda * 2);
    }
};

#define EPI_ROWS_COLS() const int rowb = wr * 64 + fr; (void)rowb;

template <class Epi, class Sched, bool GATHER = false>
__device__ __forceinline__ void gemm_phase(LAS unsigned char* lds, const Gemm g, const Sched& S, const Epi& E) {
    const int tid = threadIdx.x, wid = __builtin_amdgcn_readfirstlane(tid >> 6), lane = tid & 63, wr = wid >> 2, wc = wid & 3, fr = lane & 15, fq = lane >> 4;
    const int K = g.K, nt = K / BK;
    unsigned voffB[2]; int Ra[2], Ca[2];
#pragma unroll
    for (int i = 0; i < 2; ++i) { int R, C; stage_rc(tid * 16 + i * 8192, R, C); const int Rb = Epi::PERM ? ((R & ~31) + perm32(R & 31)) : R;
        Ra[i] = R; Ca[i] = C; voffB[i] = (unsigned)(Rb * g.ldb + C) * 2u; }
    const size_t kstep = (size_t)(BK * 2);
    const size_t hstepB = (size_t)HALF * g.ldb * 2;
    const unsigned ldsw = (unsigned)wid * 1024u;
    const int aoff = lds_byte(wr * 64 + fr, fq * 8), boff = lds_byte(wc * 32 + fr, fq * 8);
#define PG8_SA(b, h) (((b) * 2 + (h)) * HTB)
#define PG8_SB(b, h) ((4 + (b) * 2 + (h)) * HTB)
#define PG8_STAGE(bufoff, gbase, voff) do { _Pragma("unroll") for (int _i = 0; _i < 2; ++_i) \
        __builtin_amdgcn_global_load_lds((const unsigned*)((const char*)(gbase) + (voff)[_i]), (LAS unsigned*)(lds + (bufoff) + ldsw + _i * 8192), 16, 0, 0); } while (0)
#define PG8_STAGEA(bufoff, gbase, o0, o1) do { \
        __builtin_amdgcn_global_load_lds((const unsigned*)((const char*)(gbase) + (o0)), (LAS unsigned*)(lds + (bufoff) + ldsw), 16, 0, 0); \
        __builtin_amdgcn_global_load_lds((const unsigned*)((const char*)(gbase) + (o1)), (LAS unsigned*)(lds + (bufoff) + ldsw + 8192), 16, 0, 0); } while (0)
#define PG8_LDA(dst, b, h) do { _Pragma("unroll") for (int m = 0; m < 4; ++m) _Pragma("unroll") for (int k = 0; k < 2; ++k) dst[m][k] = *(const LAS bf16x8*)(lds + PG8_SA(b, h) + aoff + m * 2048 + k * 1024); } while (0)
#define PG8_LDB(dst, b, h) do { _Pragma("unroll") for (int n = 0; n < 2; ++n) _Pragma("unroll") for (int k = 0; k < 2; ++k) dst[n][k] = *(const LAS bf16x8*)(lds + PG8_SB(b, h) + boff + n * 2048 + k * 1024); } while (0)
#define PG8_MMA(ai, bj, At, Bt) do { __builtin_amdgcn_s_setprio(1); _Pragma("unroll") for (int m = 0; m < 4; ++m) _Pragma("unroll") for (int n = 0; n < 2; ++n) _Pragma("unroll") for (int k = 0; k < 2; ++k) \
        acc[ai][bj][m][n] = __builtin_amdgcn_mfma_f32_16x16x32_bf16(Bt[n][k], At[m][k], acc[ai][bj][m][n], 0, 0, 0); __builtin_amdgcn_s_setprio(0); } while (0)
#define PG8_WAIT_V(n) asm volatile("s_waitcnt vmcnt(" #n ")" ::: "memory")
#define PG8_WAIT_L(n) asm volatile("s_waitcnt lgkmcnt(" #n ")" ::: "memory")
#define PG8_BAR __builtin_amdgcn_s_barrier()
#define PG8_SCHED __builtin_amdgcn_sched_barrier(0)
    Unit cur, nxt; int ui = 0;
    if (!S.next(0, cur)) return;
    f32x4 acc[2][2][4][2];
#pragma unroll
    for (int a = 0; a < 2; ++a)
#pragma unroll
        for (int b = 0; b < 2; ++b)
#pragma unroll
            for (int m = 0; m < 4; ++m)
#pragma unroll
                for (int n = 0; n < 2; ++n) acc[a][b][m][n] = (f32x4){0.f, 0.f, 0.f, 0.f};
    bf16x8 At[4][2], B0[2][2], B1[2][2];
    const char* cA = cur.a; const char* cB = cur.b;
    unsigned c00, c01, c10, c11, n00, n01, n10, n11;
    if constexpr (GATHER) {
        c00 = S.arow(cur, Ra[0]) + Ca[0] * 2u; c01 = S.arow(cur, Ra[1]) + Ca[1] * 2u; c10 = S.arow(cur, HALF + Ra[0]) + Ca[0] * 2u; c11 = S.arow(cur, HALF + Ra[1]) + Ca[1] * 2u;
        asm volatile("s_waitcnt vmcnt(0)" : "+v"(c00), "+v"(c01), "+v"(c10), "+v"(c11) :: "memory");
    } else {
        c00 = (unsigned)(Ra[0] * g.lda + Ca[0]) * 2u; c01 = (unsigned)(Ra[1] * g.lda + Ca[1]) * 2u; c10 = c00 + (unsigned)(HALF * g.lda * 2); c11 = c01 + (unsigned)(HALF * g.lda * 2);
    }
    n00 = c00; n01 = c01; n10 = c10; n11 = c11;
    PG8_STAGE(PG8_SB(0, 0), cB, voffB); PG8_STAGE(PG8_SB(0, 1), cB + hstepB, voffB); PG8_STAGEA(PG8_SA(0, 0), cA, c00, c01); PG8_STAGEA(PG8_SA(0, 1), cA, c10, c11);
    if (wr == 1) PG8_BAR;
    PG8_WAIT_V(2); PG8_BAR;
    PG8_STAGE(PG8_SB(1, 0), cB + kstep, voffB); PG8_STAGEA(PG8_SA(1, 0), cA + kstep, c00, c01); PG8_STAGE(PG8_SB(1, 1), cB + hstepB + kstep, voffB);
    PG8_WAIT_V(6); PG8_BAR;
    for (;;) {
        const bool has_next = S.next(ui + 1, nxt);
        const char* nA = has_next ? nxt.a : cA; const char* nB = has_next ? nxt.b : cB;
        if constexpr (GATHER) {
            if (has_next) { n00 = S.arow(nxt, Ra[0]) + Ca[0] * 2u; n01 = S.arow(nxt, Ra[1]) + Ca[1] * 2u; n10 = S.arow(nxt, HALF + Ra[0]) + Ca[0] * 2u; n11 = S.arow(nxt, HALF + Ra[1]) + Ca[1] * 2u; }
            else { n00 = c00; n01 = c01; n10 = c10; n11 = c11; }
            asm volatile("s_waitcnt vmcnt(0)" : "+v"(n00), "+v"(n01), "+v"(n10), "+v"(n11) :: "memory");
        }
        for (int t = 0; t < nt; t += 2) {
            const bool last = (t == nt - 2);
            const char* a1 = cA + (size_t)(t + 1) * kstep;
            const char* a2 = last ? nA : cA + (size_t)(t + 2) * kstep; const char* b2 = last ? nB : cB + (size_t)(t + 2) * kstep;
            const char* a3 = a2 + kstep; const char* b3 = b2 + kstep;
            const unsigned x00 = (GATHER && last) ? n00 : c00, x01 = (GATHER && last) ? n01 : c01, x10 = (GATHER && last) ? n10 : c10, x11 = (GATHER && last) ? n11 : c11;
            PG8_LDB(B0, 0, 0); PG8_LDB(B1, 0, 1); PG8_SCHED; PG8_LDA(At, 0, 0); PG8_STAGEA(PG8_SA(1, 1), a1, c10, c11);
            PG8_WAIT_V(8); PG8_WAIT_L(0); PG8_BAR; PG8_MMA(0, 0, At, B0); PG8_MMA(0, 1, At, B1); PG8_BAR; PG8_SCHED;
            PG8_LDA(At, 0, 1); PG8_STAGE(PG8_SB(0, 0), b2, voffB); PG8_STAGE(PG8_SB(0, 1), b2 + hstepB, voffB); PG8_STAGEA(PG8_SA(0, 0), a2, x00, x01);
            PG8_WAIT_V(8); PG8_WAIT_L(0); PG8_BAR; PG8_MMA(1, 0, At, B0); PG8_MMA(1, 1, At, B1); PG8_BAR; PG8_SCHED;
            PG8_LDB(B0, 1, 0); PG8_LDB(B1, 1, 1); PG8_SCHED; PG8_LDA(At, 1, 0); PG8_STAGEA(PG8_SA(0, 1), a2, x10, x11);
            PG8_WAIT_V(8); PG8_WAIT_L(0); PG8_BAR; PG8_MMA(0, 0, At, B0); PG8_MMA(0, 1, At, B1); PG8_BAR; PG8_SCHED;
            PG8_LDA(At, 1, 1); PG8_STAGE(PG8_SB(1, 0), b3, voffB); PG8_STAGE(PG8_SB(1, 1), b3 + hstepB, voffB); PG8_STAGEA(PG8_SA(1, 0), a3, x00, x01);
            PG8_WAIT_V(8); PG8_WAIT_L(0); PG8_BAR; PG8_MMA(1, 0, At, B0); PG8_MMA(1, 1, At, B1); PG8_BAR; PG8_SCHED;
        }
        if (wr == 0) PG8_BAR;
        E(acc, cur, wr, wc, fr, fq);
        if (!has_next) break;
#pragma unroll
        for (int a = 0; a < 2; ++a)
#pragma unroll
            for (int b = 0; b < 2; ++b)
#pragma unroll
                for (int m = 0; m < 4; ++m)
#pragma unroll
                    for (int n = 0; n < 2; ++n) acc[a][b][m][n] = (f32x4){0.f, 0.f, 0.f, 0.f};
        cur = nxt; cA = nA; cB = nB; ++ui;
        c00 = n00; c01 = n01; c10 = n10; c11 = n11;
        if (wr == 1) PG8_BAR;
    }
    PG8_WAIT_V(0);
    PG8_BAR;
#undef PG8_SA
#undef PG8_SB
#undef PG8_STAGE
#undef PG8_STAGEA
#undef PG8_LDA
#undef PG8_LDB
#undef PG8_MMA
#undef PG8_WAIT_V
#undef PG8_WAIT_L
#undef PG8_BAR
#undef PG8_SCHED
}

typedef const f32x4 (&AccRef)[2][2][4][2];
__device__ __forceinline__ v4u pack8(const f32x4 a, const f32x4 b) { v4u w; w.x = pk2(a[0], a[1]); w.y = pk2(a[2], a[3]); w.z = pk2(b[0], b[1]); w.w = pk2(b[2], b[3]); return w; }

struct EpiProj {
    static constexpr bool PERM = true;
    bf16* PROJ; bf16* UA;
    __device__ __forceinline__ void operator()(AccRef acc, const Unit& u, int wr, int wc, int fr, int fq) const {
        const int row0 = u.r0 + wr * 64 + fr, colb = u.c0 + wc * 32 + 8 * fq;
        const bool isu = (u.c0 == 1280 || u.c0 == 1536);
#pragma unroll
        for (int ai = 0; ai < 2; ++ai)
#pragma unroll
            for (int m = 0; m < 4; ++m) { const int row = row0 + ai * HALF + m * 16;
#pragma unroll
                for (int bj = 0; bj < 2; ++bj) { const int col = colb + bj * HALF; const v4u w = pack8(acc[ai][bj][m][0], acc[ai][bj][m][1]);
                    if (!isu) *(v4u*)(PROJ + (size_t)row * INC + col) = w;
                    else { const int cc = col - 1280, g = cc >> 4, c0 = cc & 15; *(v4u*)(UA + ((size_t)(g * 512 + (row >> 5)) * S5K + (row & 31) * 16 + c0)) = w; } } }
    }
};
struct EpiBf16 {
    static constexpr bool PERM = true;
    bf16* O; int ldc;
    __device__ __forceinline__ void operator()(AccRef acc, const Unit& u, int wr, int wc, int fr, int fq) const {
        const int row0 = u.r0 + wr * 64 + fr, colb = u.c0 + wc * 32 + 8 * fq;
#pragma unroll
        for (int ai = 0; ai < 2; ++ai)
#pragma unroll
            for (int m = 0; m < 4; ++m) { bf16* rowp = O + (size_t)(row0 + ai * HALF + m * 16) * ldc + colb;
#pragma unroll
                for (int bj = 0; bj < 2; ++bj) *(v4u*)(rowp + bj * HALF) = pack8(acc[ai][bj][m][0], acc[ai][bj][m][1]); }
    }
};
struct EpiF32 {
    static constexpr bool PERM = false;
    float* C; int ldc; size_t gstride;
    __device__ __forceinline__ void operator()(AccRef acc, const Unit& u, int wr, int wc, int fr, int fq) const {
        const int row0 = u.r0 + wr * 64 + fr, col0 = u.c0 + wc * 32 + 4 * fq; float* base = C + (size_t)u.aux * gstride;
#pragma unroll
        for (int ai = 0; ai < 2; ++ai)
#pragma unroll
            for (int m = 0; m < 4; ++m) { float* rowp = base + (size_t)(row0 + ai * HALF + m * 16) * ldc + col0;
#pragma unroll
                for (int bj = 0; bj < 2; ++bj)
#pragma unroll
                    for (int n = 0; n < 2; ++n) *(f32x4*)(rowp + bj * HALF + n * 16) = acc[ai][bj][m][n]; }
    }
};
struct EpiS5Y {
    static constexpr bool PERM = true;
    const bf16* UA; const float* dsk; bf16* Gm;
    __device__ __forceinline__ void operator()(AccRef acc, const Unit& u, int wr, int wc, int fr, int fq) const {
        const int row0 = u.r0 + wr * 64 + fr, colb = u.c0 + wc * 32 + 8 * fq, g = u.aux;
#pragma unroll
        for (int ai = 0; ai < 2; ++ai)
#pragma unroll
            for (int m = 0; m < 4; ++m) { const int row = row0 + ai * HALF + m * 16;
#pragma unroll
                for (int bj = 0; bj < 2; ++bj) { const int col = colb + bj * HALF, i = col >> 4, c0 = col & 15;
                    const v4u uw = *(const v4u*)(UA + ((size_t)(g * 512 + row) * S5K + col));
                    const f32x4 d0 = *(const f32x4*)(dsk + g * 16 + c0), d1 = *(const f32x4*)(dsk + g * 16 + c0 + 4);
                    const f32x4 a0 = acc[ai][bj][m][0], a1 = acc[ai][bj][m][1];
                    f32x4 y0, y1;
                    y0[0] = gelu_tanh(a0[0] + d0[0] * bflo(uw.x)); y0[1] = gelu_tanh(a0[1] + d0[1] * bfhi(uw.x)); y0[2] = gelu_tanh(a0[2] + d0[2] * bflo(uw.y)); y0[3] = gelu_tanh(a0[3] + d0[3] * bfhi(uw.y));
                    y1[0] = gelu_tanh(a1[0] + d1[0] * bflo(uw.z)); y1[1] = gelu_tanh(a1[1] + d1[1] * bfhi(uw.z)); y1[2] = gelu_tanh(a1[2] + d1[2] * bflo(uw.w)); y1[3] = gelu_tanh(a1[3] + d1[3] * bfhi(uw.w));
                    *(v4u*)(Gm + ((size_t)row * 32 + i) * 512 + g * 16 + c0) = pack8(y0, y1); } }
    }
};
struct EpiGlu {
    static constexpr bool PERM = true;
    const bf16* Gm; bf16* MIX;
    __device__ __forceinline__ void operator()(AccRef acc, const Unit& u, int wr, int wc, int fr, int fq) const {
        const int row0 = u.r0 + wr * 64 + fr, colb = u.c0 + wc * 32 + 8 * fq;
#pragma unroll
        for (int ai = 0; ai < 2; ++ai)
#pragma unroll
            for (int m = 0; m < 4; ++m) { const int row = row0 + ai * HALF + m * 16;
#pragma unroll
                for (int bj = 0; bj < 2; ++bj) { const int col = colb + bj * HALF;
                    const v4u gw = *(const v4u*)(Gm + (size_t)row * 512 + col);
                    const f32x4 a0 = acc[ai][bj][m][0], a1 = acc[ai][bj][m][1];
                    f32x4 y0, y1;
                    y0[0] = bflo(gw.x) * sigmoidf_(a0[0]); y0[1] = bfhi(gw.x) * sigmoidf_(a0[1]); y0[2] = bflo(gw.y) * sigmoidf_(a0[2]); y0[3] = bfhi(gw.y) * sigmoidf_(a0[3]);
                    y1[0] = bflo(gw.z) * sigmoidf_(a1[0]); y1[1] = bfhi(gw.z) * sigmoidf_(a1[1]); y1[2] = bflo(gw.w) * sigmoidf_(a1[2]); y1[3] = bfhi(gw.w) * sigmoidf_(a1[3]);
                    *(v4u*)(MIX + (size_t)row * D + 1024 + col) = pack8(y0, y1); } }
    }
};
struct EpiWo {
    static constexpr bool PERM = false;
    const float* X; bf16* X1B; float* part;
    __device__ __forceinline__ void operator()(AccRef acc, const Unit& u, int wr, int wc, int fr, int fq) const {
        const int row0 = u.r0 + wr * 64 + fr, col0 = u.c0 + wc * 32 + 4 * fq;
#pragma unroll
        for (int ai = 0; ai < 2; ++ai) {
            f32x4 xv[4][2][2];
#pragma unroll
            for (int m = 0; m < 4; ++m)
#pragma unroll
                for (int bj = 0; bj < 2; ++bj)
#pragma unroll
                    for (int n = 0; n < 2; ++n) xv[m][bj][n] = __builtin_nontemporal_load((const f32x4*)(X + (size_t)(row0 + ai * HALF + m * 16) * D + col0 + bj * HALF + n * 16));
#pragma unroll
            for (int m = 0; m < 4; ++m) { const int row = row0 + ai * HALF + m * 16; const size_t off = (size_t)row * D + col0; float ss = 0.f;
#pragma unroll
                for (int bj = 0; bj < 2; ++bj)
#pragma unroll
                    for (int n = 0; n < 2; ++n) { const f32x4 v = xv[m][bj][n] + acc[ai][bj][m][n];
                        ss += (v[0] * v[0] + v[1] * v[1]) + (v[2] * v[2] + v[3] * v[3]);
                        v2u w; w.x = pk2(v[0], v[1]); w.y = pk2(v[2], v[3]); *(v2u*)(X1B + off + bj * HALF + n * 16) = w; }
                ss += __shfl_xor(ss, 16); ss += __shfl_xor(ss, 32);
                if (fq == 0) part[(size_t)row * 32 + (u.c0 >> 8) * 4 + wc] = ss; }
            asm volatile("" ::: "memory");
        }
    }
};
struct EpiLogit {
    static constexpr bool PERM = false;
    float* LP;
    __device__ __forceinline__ void operator()(AccRef acc, const Unit& u, int wr, int wc, int fr, int fq) const {
        const int row0 = u.r0 + wr * 64 + fr, col0 = wc * 32 + 4 * fq; float* base = LP + (size_t)u.aux * T * 80;
#pragma unroll
        for (int ai = 0; ai < 2; ++ai)
#pragma unroll
            for (int m = 0; m < 4; ++m) { float* rowp = base + (size_t)(row0 + ai * HALF + m * 16) * 80 + col0;
#pragma unroll
                for (int n = 0; n < 2; ++n) if (col0 + n * 16 < 80) *(f32x4*)(rowp + n * 16) = acc[ai][0][m][n]; }
    }
};
struct EpiGU {
    static constexpr bool PERM = true;
    const int* list; const float* rstd; const LAS int* cnt; bf16* ACT;
    __device__ __forceinline__ void operator()(AccRef acc, const Unit& u, int wr, int wc, int fr, int fq) const {
        const int e = u.aux, nreal = cnt[e], rb = wr * 64 + fr, colb = u.c0 * 128 + wc * 32 + 8 * fq;
#pragma unroll
        for (int ai = 0; ai < 2; ++ai)
#pragma unroll
            for (int m = 0; m < 4; ++m) { const int r = rb + ai * HALF + m * 16; int rr = u.r1 + r; rr = rr < nreal ? rr : nreal - 1;
                const float rs = rstd[list[(size_t)e * LCAP + rr] >> 1];
                f32x4 y0, y1;
#pragma unroll
                for (int j = 0; j < 4; ++j) { const float g0 = acc[ai][0][m][0][j] * rs, g1 = acc[ai][0][m][1][j] * rs;
                    y0[j] = g0 * sigmoidf_(g0) * (acc[ai][1][m][0][j] * rs); y1[j] = g1 * sigmoidf_(g1) * (acc[ai][1][m][1][j] * rs); }
                *(v4u*)(ACT + (size_t)(u.r0 + r) * DEXP + colb) = pack8(y0, y1); }
    }
};
struct EpiDown {
    static constexpr bool PERM = true;
    const int* list; const float* wts; const LAS int* cnt; bf16* Y2;
    __device__ __forceinline__ void operator()(AccRef acc, const Unit& u, int wr, int wc, int fr, int fq) const {
        const int e = u.aux, n = cnt[e], row0 = u.r1 + wr * 64 + fr, colb = u.c0 * 256 + wc * 32 + 8 * fq;
#pragma unroll
        for (int ai = 0; ai < 2; ++ai)
#pragma unroll
            for (int m = 0; m < 4; ++m) { const int r = row0 + ai * HALF + m * 16;
                if (r < n) { const int ent = list[(size_t)e * LCAP + r]; const float w = wts[ent]; bf16* rowp = Y2 + (size_t)ent * D + colb;
#pragma unroll
                    for (int bj = 0; bj < 2; ++bj) *(v4u*)(rowp + bj * HALF) = pack8(acc[ai][bj][m][0] * w, acc[ai][bj][m][1] * w); } }
    }
};
struct KSplitOrder {
    const char* A; const char* Bt; int lda, ldb, K, nM, nks, G, c;
    __device__ bool next(int i, Unit& u) const {
        const int L = i * G + c; if (L >= nM * nks) return false;
        const int pm = L / nks, ks = L % nks;
        u.a = A + ((size_t)pm * BM * lda + (size_t)ks * K) * 2; u.b = Bt + (size_t)ks * BM * ldb * 2; u.r0 = pm * BM; u.c0 = 0; u.aux = ks; u.r1 = 0; return true;
    }
    __device__ __forceinline__ unsigned arow(const Unit&, int) const { return 0u; }
};
}

struct Frame {
    LAS unsigned char* lds;
    unsigned* ctl;
    int tid, lane, wave, vcu, G;
    const float* in[31]; float* out; unsigned char* ws;
};
enum { I_X = 0, I_MEM, I_NORM_MIX, I_W_IN, I_Q_NORM, I_K_NORM, I_SINKS, I_REL_BIAS, I_LAM_RE, I_LAM_IM, I_LOG_DT, I_B_RE, I_B_IM, I_C_RE, I_C_IM, I_SSM_D, I_W_GLU,
       I_MEM_NORM, I_W_MEM_KV, I_XQ_NORM, I_XK_NORM, I_ON_ATTN, I_ON_SSM, I_ON_X, I_W_O, I_NORM_FFN, I_WR_G, I_WR_E, I_W_GATE, I_W_UP, I_W_DOWN };

struct TrItem { const float* W; bf16* WT; const float* ks; int ldw, ldt, k0, n0, drow0; };
__device__ __forceinline__ void tr_load(const TrItem& it, f32x4 (&v)[8], int lane) {
    const int kc = lane & 7, nq = lane >> 3; const float* src = it.W + (size_t)(it.k0 + kc * 8) * it.ldw + it.n0 + nq * 4;
#pragma unroll
    for (int j = 0; j < 8; ++j) v[j] = __builtin_nontemporal_load((const f32x4*)(src + (size_t)j * it.ldw));
}
__device__ __forceinline__ void tr_store(const TrItem& it, f32x4 (&v)[8], int lane) {
    const int kc = lane & 7, nq = lane >> 3;
    if (it.ks) { const f32x4 s0 = *(const f32x4*)(it.ks + it.k0 + kc * 8), s1 = *(const f32x4*)(it.ks + it.k0 + kc * 8 + 4);
#pragma unroll
        for (int j = 0; j < 4; ++j) { v[j] = v[j] * s0[j]; v[4 + j] = v[4 + j] * s1[j]; } }
#pragma unroll
    for (int i = 0; i < 4; ++i) { v4u o; o.x = pk2(v[0][i], v[1][i]); o.y = pk2(v[2][i], v[3][i]); o.z = pk2(v[4][i], v[5][i]); o.w = pk2(v[6][i], v[7][i]);
        *(v4u*)(it.WT + (size_t)(it.drow0 + nq * 4 + i) * it.ldt + it.k0 + kc * 8) = o; }
}
__device__ __forceinline__ void rms_row_to_bf16(const float* xrow, const float* gain, bf16* orow, int lane) {
    const f32x4* xr = (const f32x4*)xrow + lane; const f32x4* gr = (const f32x4*)gain + lane;
    f32x4 v[8]; float s = 0.f;
#pragma unroll
    for (int j = 0; j < 8; ++j) { v[j] = xr[64 * j]; s += (v[j].x * v[j].x + v[j].y * v[j].y) + (v[j].z * v[j].z + v[j].w * v[j].w); }
    const float rstd = 1.0f / sqrtf(wave_sum(s) * (1.f / 2048.f) + EPS);
    v2u* o8 = (v2u*)orow + lane;
#pragma unroll
    for (int j = 0; j < 8; ++j) { const f32x4 g = gr[64 * j]; v2u w; w.x = pk2(v[j].x * rstd * g.x, v[j].y * rstd * g.y); w.y = pk2(v[j].z * rstd * g.z, v[j].w * rstd * g.w); o8[64 * j] = w; }
}

__device__ __forceinline__ void s5_tables(Frame& F, int g) {
    LAS float* ap = (LAS float*)F.lds;
    LAS float* Bb = ap + 33 * 64 * 2;
    LAS float* Cc = Bb + 64 * 16 * 2;
    LAS float* Km = Cc + 16 * 64 * 2;
    const float dt = expf(F.in[I_LOG_DT][g]);
    const float* lre = F.in[I_LAM_RE] + g * 64; const float* lim = F.in[I_LAM_IM] + g * 64;
    for (int idx = F.tid; idx < 33 * 64; idx += 512) { const int tau = idx >> 6, n = idx & 63; const float lr = lre[n], li = lim[n];
        const float mag = expf((float)tau * (lr * dt)), ang = (float)tau * (li * dt); ap[idx * 2] = mag * cosf(ang); ap[idx * 2 + 1] = mag * sinf(ang); }
    __syncthreads();
    for (int idx = F.tid; idx < 64 * 16; idx += 512) { const int n = idx >> 4; const float lr = lre[n], li = lim[n];
        const float nr = ap[(64 + n) * 2] - 1.0f, ni = ap[(64 + n) * 2 + 1], den = lr * lr + li * li;
        const float cr = (nr * lr + ni * li) / den, ci = (ni * lr - nr * li) / den;
        const float br = F.in[I_B_RE][(size_t)g * 1024 + idx], bi = F.in[I_B_IM][(size_t)g * 1024 + idx];
        Bb[idx * 2] = cr * br - ci * bi; Bb[idx * 2 + 1] = cr * bi + ci * br; }
    for (int idx = F.tid; idx < 16 * 64; idx += 512) { Cc[idx * 2] = F.in[I_C_RE][(size_t)g * 1024 + idx]; Cc[idx * 2 + 1] = F.in[I_C_IM][(size_t)g * 1024 + idx]; }
    __syncthreads();
    for (int idx = F.tid; idx < 32 * 256; idx += 512) { const int tau = idx >> 8, c = (idx >> 4) & 15, c2 = idx & 15; float s = 0.f;
        for (int n = 0; n < 64; ++n) { const float ar = ap[(tau * 64 + n) * 2], ai = ap[(tau * 64 + n) * 2 + 1], cr = Cc[(c * 64 + n) * 2], ci = Cc[(c * 64 + n) * 2 + 1];
            const float er = cr * ar - ci * ai, ei = cr * ai + ci * ar; s += er * Bb[(n * 16 + c2) * 2] - ei * Bb[(n * 16 + c2) * 2 + 1]; }
        Km[idx] = s; }
    __syncthreads();
    bf16* MQ = (bf16*)(F.ws + WS_MQ) + (size_t)g * 512 * S5K;
    for (int idx = F.tid; idx < 512 * 80; idx += 512) { const int row = idx / 80, ch = idx % 80, i = row >> 4, c = row & 15, k0 = ch * 8; float v[8];
        if (k0 < 512) { const int s = k0 >> 4, c20 = k0 & 15, tau = i - s;
#pragma unroll
            for (int j = 0; j < 8; ++j) v[j] = tau >= 0 ? Km[(tau * 16 + c) * 16 + c20 + j] : 0.f;
        } else { const int kk = k0 - 512, ri = kk >> 6, n0 = kk & 63;
#pragma unroll
            for (int j = 0; j < 8; ++j) { const int n = n0 + j; const float ar = ap[((i + 1) * 64 + n) * 2], ai = ap[((i + 1) * 64 + n) * 2 + 1], cr = Cc[(c * 64 + n) * 2], ci = Cc[(c * 64 + n) * 2 + 1];
                v[j] = ri == 0 ? (cr * ar - ci * ai) : -(cr * ai + ci * ar); } }
        v4u o; o.x = pk2(v[0], v[1]); o.y = pk2(v[2], v[3]); o.z = pk2(v[4], v[5]); o.w = pk2(v[6], v[7]);
        *(v4u*)(MQ + (size_t)row * S5K + k0) = o; }
    bf16* SP = (bf16*)(F.ws + WS_SP) + (size_t)g * 256 * 512;
    for (int idx = F.tid; idx < 256 * 64; idx += 512) { const int row = idx >> 6, k0 = (idx & 63) * 8; float v[8];
        if (row < 128) { const int ri = row >> 6, n = row & 63, s = k0 >> 4, c20 = k0 & 15; const float ar = ap[((31 - s) * 64 + n) * 2], ai = ap[((31 - s) * 64 + n) * 2 + 1];
#pragma unroll
            for (int j = 0; j < 8; ++j) { const float br = Bb[(n * 16 + c20 + j) * 2], bi = Bb[(n * 16 + c20 + j) * 2 + 1]; v[j] = ri == 0 ? (ar * br - ai * bi) : (ar * bi + ai * br); }
        } else {
#pragma unroll
            for (int j = 0; j < 8; ++j) v[j] = 0.f; }
        v4u o; o.x = pk2(v[0], v[1]); o.y = pk2(v[2], v[3]); o.z = pk2(v[4], v[5]); o.w = pk2(v[6], v[7]);
        *(v4u*)(SP + (size_t)row * 512 + k0) = o; }
    float* AL = (float*)(F.ws + WS_AL) + g * 128;
    if (F.tid < 64) { AL[F.tid * 2] = ap[(32 * 64 + F.tid) * 2]; AL[F.tid * 2 + 1] = ap[(32 * 64 + F.tid) * 2 + 1]; }
    __syncthreads();
}

struct BigTile { const float* src; bf16* dst; const float* ks; int ldw, ldt; };
constexpr int BT_GU = 64 * 2 * 64, BT_D = 64 * 64, BT_N = BT_GU + BT_D, BT_PITCH = 260;
__device__ __forceinline__ BigTile bt_decode(const Frame& F, bf16* WguT, bf16* WdT, const float* nf, int ti) {
    BigTile t;
    const unsigned long long pg = (unsigned long long)F.in[I_W_GATE], pu = (unsigned long long)F.in[I_W_UP], pd = (unsigned long long)F.in[I_W_DOWN];
    if (ti < BT_GU) { const int e = ti >> 7, r = ti & 127, which = r >> 6, kb = (r >> 2) & 15, nb = r & 3;
        const unsigned long long p = pg + ((pu - pg) & (0ull - (unsigned long long)which));
        t.src = (const float*)p + (size_t)e * D * DEXP + (size_t)kb * 128 * DEXP + nb * 128; t.dst = WguT + ((size_t)e * 1024 + nb * 256 + which * 128) * D + kb * 128; t.ks = nf + kb * 128; t.ldw = DEXP; t.ldt = D; }
    else { const int t2 = ti - BT_GU, e = t2 >> 6, r = t2 & 63, kb = r >> 4, nb = r & 15;
        t.src = (const float*)pd + (size_t)e * DEXP * D + (size_t)kb * 128 * D + nb * 128; t.dst = WdT + ((size_t)e * D + nb * 128) * DEXP + kb * 128; t.ks = nullptr; t.ldw = D; t.ldt = DEXP; }
    return t;
}
#define BT_LOAD(t, v, kv) do { const unsigned _lo = (unsigned)(rl * (t).ldw + cq * 4); \
    _Pragma("unroll") for (int _p = 0; _p < 8; ++_p) kv[_p] = (t).ks ? (t).ks[_p * 16 + rl] : 1.0f; \
    _Pragma("unroll") for (int _p = 0; _p < 8; ++_p) v[_p] = __builtin_nontemporal_load((const f32x4*)((t).src + (size_t)_p * 16 * (t).ldw + _lo)); } while (0)
#define BT_STORE(t, v, kv) do { \
    _Pragma("unroll") for (int _p = 0; _p < 8; ++_p) { const int _r = _p * 16 + rl; const f32x4 _x = v[_p] * kv[_p]; \
        const unsigned _w0 = pk2(_x[0], _x[1]), _w1 = pk2(_x[2], _x[3]); LAS bf16* _q = (LAS bf16*)(img + (cq * 4) * BT_PITCH + _r * 2); \
        _q[0] = (bf16)(_w0 & 0xffffu); _q[BT_PITCH / 2] = (bf16)(_w0 >> 16); _q[2 * (BT_PITCH / 2)] = (bf16)(_w1 & 0xffffu); _q[3 * (BT_PITCH / 2)] = (bf16)(_w1 >> 16); } \
    __syncthreads(); \
    { const unsigned _so = (unsigned)((rl * 2 + (cq >> 4)) * (t).ldt + (cq & 15) * 8); \
    _Pragma("unroll") for (int _q4 = 0; _q4 < 4; ++_q4) { const int _n = _q4 * 32 + rl * 2 + (cq >> 4); const LAS unsigned* _rp = (const LAS unsigned*)(img + _n * BT_PITCH + (cq & 15) * 16); \
        v4u _o; _o.x = _rp[0]; _o.y = _rp[1]; _o.z = _rp[2]; _o.w = _rp[3]; *(v4u*)((t).dst + (size_t)_q4 * 32 * (t).ldt + _so) = _o; } } \
    __syncthreads(); } while (0)
__device__ __forceinline__ void bg_convert(Frame& F, int qword, int base, int ntiles, int budget) {
    if (budget <= 0) return;
    bf16* WguT = (bf16*)(F.ws + WS_WGU); bf16* WdT = (bf16*)(F.ws + WS_WD); const float* nf = F.in[I_NORM_FFN];
    const int rl = F.tid >> 5, cq = F.tid & 31; LAS unsigned char* img = F.lds; LAS int* qn = (LAS int*)(F.lds + TAB_OFF + 1024);
    f32x4 va[8], vb[8]; float ka[8], kb[8];
    int nfetch = 0;
#define BG_FETCH(slot) do { if (nfetch < budget) { if (F.tid == 0) qn[slot] = (int)atomicAdd(F.ctl + qword, 1u); } else if (F.tid == 0) qn[slot] = 0x7fffffff; ++nfetch; } while (0)
    __syncthreads();
    BG_FETCH(0); BG_FETCH(1);
    __syncthreads();
    int i0 = __builtin_amdgcn_readfirstlane(qn[0]), i1 = __builtin_amdgcn_readfirstlane(qn[1]);
    __syncthreads();
    if (i0 < ntiles) { const BigTile t0 = bt_decode(F, WguT, WdT, nf, base + i0); BT_LOAD(t0, va, ka); }
    while (i0 < ntiles) {
        const BigTile ta = bt_decode(F, WguT, WdT, nf, base + i0);
        const BigTile tb = bt_decode(F, WguT, WdT, nf, base + (i1 < ntiles ? i1 : i0));
        BT_LOAD(tb, vb, kb);
        if (i1 >= ntiles) budget = 0;
        BG_FETCH(0);
        BT_STORE(ta, va, ka);
        const int i2 = __builtin_amdgcn_readfirstlane(qn[0]);
        if (i1 >= ntiles) break;
        const BigTile tc = bt_decode(F, WguT, WdT, nf, base + (i2 < ntiles ? i2 : i1));
        BT_LOAD(tc, va, ka);
        if (i2 >= ntiles) budget = 0;
        BG_FETCH(1);
        BT_STORE(tb, vb, kb);
        const int i3 = __builtin_amdgcn_readfirstlane(qn[1]);
        i0 = i2; i1 = i3;
    }
    __syncthreads();
#undef BG_FETCH
}
__device__ __forceinline__ void p0_prologue(Frame& F) {
    if (F.vcu < 32) s5_tables(F, F.vcu);
    const int gw = F.vcu * 8 + F.wave, NGW = F.G * 8;
    bf16* WinT = (bf16*)(F.ws + WS_WIN); bf16* WoT = (bf16*)(F.ws + WS_WO); bf16* WmkvT = (bf16*)(F.ws + WS_WMKV); bf16* WgluT = (bf16*)(F.ws + WS_WGLU);
    const float* nf = F.in[I_NORM_FFN];
    constexpr int I_IN = 32 * 72, I_O = 32 * 64, I_MKV = 32 * 32, I_GLU = 8 * 16;
    constexpr int NITEMS = I_IN + I_O + I_MKV + I_GLU;
    auto decode = [&](int it) -> TrItem {
        int r = it;
        if (r < I_IN) { const int kb = r / 72, nb = r % 72; return TrItem{F.in[I_W_IN], WinT, nullptr, INC, D, kb * 64, nb * 32, nb * 32}; } r -= I_IN;
        if (r < I_O) { const int kb = r / 64, nb = r % 64; return TrItem{F.in[I_W_O], WoT, nullptr, D, D, kb * 64, nb * 32, nb * 32}; } r -= I_O;
        if (r < I_MKV) { const int kb = r / 32, nb = r % 32; return TrItem{F.in[I_W_MEM_KV], WmkvT, nullptr, 1024, D, kb * 64, nb * 32, nb * 32}; } r -= I_MKV;
        const int kb = r / 16, nb = r % 16; return TrItem{F.in[I_W_GLU], WgluT, nullptr, 512, 512, kb * 64, nb * 32, nb * 32};
    };
    {
        f32x4 va[8], vb[8]; int it = gw; TrItem ia, ib;
        if (it < NITEMS) { ia = decode(it); tr_load(ia, va, F.lane); }
        while (it < NITEMS) {
            const int it2 = it + NGW; if (it2 < NITEMS) { ib = decode(it2); tr_load(ib, vb, F.lane); }
            tr_store(ia, va, F.lane);
            if (it2 >= NITEMS) break;
            const int it3 = it2 + NGW; if (it3 < NITEMS) { ia = decode(it3); tr_load(ia, va, F.lane); }
            tr_store(ib, vb, F.lane);
            it = it3;
        }
    }
    { bf16* WrT = (bf16*)(F.ws + WS_WR); const int gt = F.vcu * 512 + F.tid, NT = F.G * 512;
      for (int idx = gt; idx < 4 * 256 * 512; idx += NT) { const int ks = idx >> 17, n = (idx >> 9) & 255, k = ks * 512 + (idx & 511); float v = 0.f;
          if (n < 8) v = F.in[I_WR_G][k * 8 + n] * nf[k]; else if (n < 72) v = F.in[I_WR_E][k * 64 + (n - 8)] * nf[k];
          WrT[idx] = (bf16)f2bf(v); } }
    bf16* XN = (bf16*)(F.ws + WS_XN); bf16* MEMN = (bf16*)(F.ws + WS_MEMN);
    for (int m = gw; m < T; m += NGW) rms_row_to_bf16(F.in[I_X] + (size_t)m * D, F.in[I_NORM_MIX], XN + (size_t)m * D, F.lane);
    for (int m = gw; m < NB * MEML; m += NGW) rms_row_to_bf16(F.in[I_MEM] + (size_t)m * D, F.in[I_MEM_NORM], MEMN + (size_t)m * D, F.lane);
    bg_convert(F, CW_QGU, 0, BT_GU, F.vcu < 32 ? PB0_S5 : PB0);
    bg_convert(F, CW_QD, BT_GU, BT_D, PB0_D);
}

constexpr int SWA_KS = 72, SWA_VS = 264;
constexpr int SWA_KOFF = 0, SWA_VOFF = 256 * SWA_KS * 2, SWA_BOFF = SWA_VOFF + 64 * SWA_VS * 2;
__device__ __forceinline__ int t5_bucket(int n) { if (n < 16) return n; const int v = 16 + (int)(logf((float)n * (1.0f / 16.0f)) / logf(8.0f) * 16.0f); return v < 31 ? v : 31; }
__device__ __forceinline__ void swa_unit(Frame& F, int unit) {
    const int b = unit >> 5, kvh = (unit >> 4) & 1, nb = unit & 15;
    const bf16* PROJ = (const bf16*)(F.ws + WS_PROJ); bf16* MIX = (bf16*)(F.ws + WS_MIX);
    LAS bf16* Ks = (LAS bf16*)(F.lds + SWA_KOFF); LAS bf16* Vt = (LAS bf16*)(F.lds + SWA_VOFF); LAS float* bt = (LAS float*)(F.lds + SWA_BOFF);
    __syncthreads();
    {
        const int key = F.tid >> 1, half = F.tid & 1, s = (nb - 1) * 128 + key;
        v4u kw[4], vw[4];
        if (s >= 0) { const bf16* rp = PROJ + (size_t)(b * SEQ + s) * INC + 1024 + kvh * 64 + half * 32;
#pragma unroll
            for (int j = 0; j < 4; ++j) { kw[j] = *(const v4u*)(rp + j * 8); vw[j] = *(const v4u*)(rp + 128 + j * 8); }
        } else {
#pragma unroll
            for (int j = 0; j < 4; ++j) { kw[j] = (v4u){0u, 0u, 0u, 0u}; vw[j] = (v4u){0u, 0u, 0u, 0u}; } }
        float kf[32]; float ss = 0.f;
#pragma unroll
        for (int j = 0; j < 4; ++j) { kf[j * 8 + 0] = bflo(kw[j].x); kf[j * 8 + 1] = bfhi(kw[j].x); kf[j * 8 + 2] = bflo(kw[j].y); kf[j * 8 + 3] = bfhi(kw[j].y);
            kf[j * 8 + 4] = bflo(kw[j].z); kf[j * 8 + 5] = bfhi(kw[j].z); kf[j * 8 + 6] = bflo(kw[j].w); kf[j * 8 + 7] = bfhi(kw[j].w); }
#pragma unroll
        for (int j = 0; j < 32; ++j) ss += kf[j] * kf[j];
        ss += __shfl_xor(ss, 1);
        const float rstd = 1.0f / sqrtf(ss * (1.f / 64.f) + EPS);
        const float* kn = F.in[I_K_NORM] + half * 32;
#pragma unroll
        for (int j = 0; j < 4; ++j) { v4u o; o.x = pk2(kf[j * 8 + 0] * rstd * kn[j * 8 + 0], kf[j * 8 + 1] * rstd * kn[j * 8 + 1]); o.y = pk2(kf[j * 8 + 2] * rstd * kn[j * 8 + 2], kf[j * 8 + 3] * rstd * kn[j * 8 + 3]);
            o.z = pk2(kf[j * 8 + 4] * rstd * kn[j * 8 + 4], kf[j * 8 + 5] * rstd * kn[j * 8 + 5]); o.w = pk2(kf[j * 8 + 6] * rstd * kn[j * 8 + 6], kf[j * 8 + 7] * rstd * kn[j * 8 + 7]);
            *(LAS v4u*)(Ks + key * SWA_KS + half * 32 + j * 8) = o; }
#pragma unroll
        for (int j = 0; j < 4; ++j) { const unsigned w4[4] = {vw[j].x, vw[j].y, vw[j].z, vw[j].w};
#pragma unroll
            for (int q = 0; q < 4; ++q) { const int d = half * 32 + j * 8 + q * 2; Vt[d * SWA_VS + key] = (bf16)(w4[q] & 0xffffu); Vt[(d + 1) * SWA_VS + key] = (bf16)(w4[q] >> 16); } }
        for (int idx = F.tid; idx < 8 * 128; idx += 512) { const int w = idx >> 7, dl = idx & 127; bt[idx] = F.in[I_REL_BIAS][t5_bucket(dl) * 16 + kvh * 8 + w]; }
    }
    __syncthreads();
    const int w = F.wave, h = kvh * 8 + w, ql = F.lane & 31, hh = F.lane >> 5;
    const float sink = F.in[I_SINKS][h];
    const float* qn = F.in[I_Q_NORM];
    for (int r = 0; r < 4; ++r) {
        const int qi = 32 * r + ql; const size_t t = (size_t)b * SEQ + nb * 128 + qi;
        bf16x8 qf[4];
        {   const bf16* qp = PROJ + t * INC + h * 64 + 8 * hh; v4u qw[4]; float qv[32]; float ss = 0.f;
#pragma unroll
            for (int ks = 0; ks < 4; ++ks) qw[ks] = *(const v4u*)(qp + ks * 16);
#pragma unroll
            for (int ks = 0; ks < 4; ++ks) { qv[ks * 8 + 0] = bflo(qw[ks].x); qv[ks * 8 + 1] = bfhi(qw[ks].x); qv[ks * 8 + 2] = bflo(qw[ks].y); qv[ks * 8 + 3] = bfhi(qw[ks].y);
                qv[ks * 8 + 4] = bflo(qw[ks].z); qv[ks * 8 + 5] = bfhi(qw[ks].z); qv[ks * 8 + 6] = bflo(qw[ks].w); qv[ks * 8 + 7] = bfhi(qw[ks].w); }
#pragma unroll
            for (int j = 0; j < 32; ++j) ss += qv[j] * qv[j];
            ss += __shfl_xor(ss, 32);
            const float sc = 0.125f / sqrtf(ss * (1.f / 64.f) + EPS);
#pragma unroll
            for (int ks = 0; ks < 4; ++ks) { const float* g = qn + ks * 16 + 8 * hh; v4u o;
                o.x = pk2(qv[ks * 8 + 0] * sc * g[0], qv[ks * 8 + 1] * sc * g[1]); o.y = pk2(qv[ks * 8 + 2] * sc * g[2], qv[ks * 8 + 3] * sc * g[3]);
                o.z = pk2(qv[ks * 8 + 4] * sc * g[4], qv[ks * 8 + 5] * sc * g[5]); o.w = pk2(qv[ks * 8 + 6] * sc * g[6], qv[ks * 8 + 7] * sc * g[7]);
                qf[ks] = __builtin_bit_cast(bf16x8, o); } }
        f32x16 s[5];
        const int qh = ql - 4 * hh; const LAS float* pb = bt + w * 128 + qh;
        float mx = sink;
#pragma unroll
        for (int kt = 0; kt < 5; ++kt) {
            const bool live = (nb > 0) || (r + kt >= 4);
            f32x16 a = {0.f, 0.f, 0.f, 0.f, 0.f, 0.f, 0.f, 0.f, 0.f, 0.f, 0.f, 0.f, 0.f, 0.f, 0.f, 0.f};
            if (live) {
#pragma unroll
                for (int ks = 0; ks < 4; ++ks) { const bf16x8 kfrag = *(const LAS bf16x8*)(Ks + (32 * (r + kt) + ql) * SWA_KS + ks * 16 + 8 * hh);
                    a = __builtin_amdgcn_mfma_f32_32x32x16_bf16(kfrag, qf[ks], a, 0, 0, 0); }
#pragma unroll
                for (int rg = 0; rg < 16; ++rg) { const int rowc = (rg & 3) + 8 * (rg >> 2);
                    float v = a[rg] + pb[128 - 32 * kt - rowc];
                    if (kt == 0) v = (rowc > qh) ? v : -1e30f;
                    if (kt == 4) v = (rowc <= qh) ? v : -1e30f;
                    a[rg] = v; mx = fmaxf(mx, v); }
            } else {
#pragma unroll
                for (int rg = 0; rg < 16; ++rg) a[rg] = -1e30f;
            }
            s[kt] = a; }
        mx = fmaxf(mx, __shfl_xor(mx, 32));
        float l = 0.f;
#pragma unroll
        for (int kt = 0; kt < 5; ++kt)
#pragma unroll
            for (int rg = 0; rg < 16; ++rg) { const float p = fast_exp(s[kt][rg] - mx); s[kt][rg] = p; l += p; }
        l += __shfl_xor(l, 32);
        l += fast_exp(sink - mx);
        f32x16 o[2];
#pragma unroll
        for (int dt = 0; dt < 2; ++dt) o[dt] = (f32x16){0.f, 0.f, 0.f, 0.f, 0.f, 0.f, 0.f, 0.f, 0.f, 0.f, 0.f, 0.f, 0.f, 0.f, 0.f, 0.f};
#pragma unroll
        for (int kt = 0; kt < 5; ++kt)
#pragma unroll
            for (int st = 0; st < 2; ++st) { v4u pw; pw.x = pk2(s[kt][8 * st + 0], s[kt][8 * st + 1]); pw.y = pk2(s[kt][8 * st + 2], s[kt][8 * st + 3]); pw.z = pk2(s[kt][8 * st + 4], s[kt][8 * st + 5]); pw.w = pk2(s[kt][8 * st + 6], s[kt][8 * st + 7]);
                const bf16x8 pf = __builtin_bit_cast(bf16x8, pw);
#pragma unroll
                for (int dt = 0; dt < 2; ++dt) { const LAS bf16* vp = Vt + (dt * 32 + ql) * SWA_VS + 32 * (r + kt) + 16 * st + 4 * hh;
                    const v2u lo = *(const LAS v2u*)vp, hi = *(const LAS v2u*)(vp + 8); v4u vv; vv.x = lo.x; vv.y = lo.y; vv.z = hi.x; vv.w = hi.y;
                    o[dt] = __builtin_amdgcn_mfma_f32_32x32x16_bf16(__builtin_bit_cast(bf16x8, vv), pf, o[dt], 0, 0, 0); } }
        const float inv = 1.0f / l;
        bf16* op = MIX + t * D + h * 64 + 4 * hh;
#pragma unroll
        for (int dt = 0; dt < 2; ++dt)
#pragma unroll
            for (int q4 = 0; q4 < 4; ++q4) { v2u ow; ow.x = pk2(o[dt][q4 * 4 + 0] * inv, o[dt][q4 * 4 + 1] * inv); ow.y = pk2(o[dt][q4 * 4 + 2] * inv, o[dt][q4 * 4 + 3] * inv);
                *(v2u*)(op + dt * 32 + q4 * 8) = ow; }
    }
}

constexpr int XA_KS = 136, XA_VS = 264;
constexpr int XA_KOFF = 0, XA_VOFF = 256 * XA_KS * 2;
__device__ __forceinline__ void xattn_unit(Frame& F, int unit) {
    const int b = unit >> 5, hx = (unit >> 3) & 3, qb = unit & 7;
    const bf16* PROJ = (const bf16*)(F.ws + WS_PROJ); const bf16* MKV = (const bf16*)(F.ws + WS_MEMKV); bf16* MIX = (bf16*)(F.ws + WS_MIX);
    LAS bf16* Ks = (LAS bf16*)(F.lds + XA_KOFF); LAS bf16* Vt = (LAS bf16*)(F.lds + XA_VOFF);
    __syncthreads();
    {   const int key = F.tid >> 1, half = F.tid & 1; const bf16* rp = MKV + (size_t)(b * MEML + key) * 1024 + hx * 128 + half * 64;
        float ss = 0.f; v4u kw[8];
#pragma unroll
        for (int j = 0; j < 8; ++j) { kw[j] = *(const v4u*)(rp + j * 8);
            const float a0 = bflo(kw[j].x), a1 = bfhi(kw[j].x), a2 = bflo(kw[j].y), a3 = bfhi(kw[j].y), a4 = bflo(kw[j].z), a5 = bfhi(kw[j].z), a6 = bflo(kw[j].w), a7 = bfhi(kw[j].w);
            ss += (a0 * a0 + a1 * a1) + (a2 * a2 + a3 * a3) + (a4 * a4 + a5 * a5) + (a6 * a6 + a7 * a7); }
        ss += __shfl_xor(ss, 1);
        const float rstd = 1.0f / sqrtf(ss * (1.f / 128.f) + EPS);
        const float* kn = F.in[I_XK_NORM] + half * 64;
#pragma unroll
        for (int j = 0; j < 8; ++j) { v4u o; const float* g = kn + j * 8;
            o.x = pk2(bflo(kw[j].x) * rstd * g[0], bfhi(kw[j].x) * rstd * g[1]); o.y = pk2(bflo(kw[j].y) * rstd * g[2], bfhi(kw[j].y) * rstd * g[3]);
            o.z = pk2(bflo(kw[j].z) * rstd * g[4], bfhi(kw[j].z) * rstd * g[5]); o.w = pk2(bflo(kw[j].w) * rstd * g[6], bfhi(kw[j].w) * rstd * g[7]);
            *(LAS v4u*)(Ks + key * XA_KS + half * 64 + j * 8) = o; }
#pragma unroll
        for (int j = 0; j < 8; ++j) { const v4u vw = *(const v4u*)(rp + 512 + j * 8); const unsigned w4[4] = {vw.x, vw.y, vw.z, vw.w};
#pragma unroll
            for (int q = 0; q < 4; ++q) { const int d = half * 64 + j * 8 + q * 2; Vt[d * XA_VS + key] = (bf16)(w4[q] & 0xffffu); Vt[(d + 1) * XA_VS + key] = (bf16)(w4[q] >> 16); } }
    }
    __syncthreads();
    const int ql = F.lane & 31, hh = F.lane >> 5;
    const size_t t = (size_t)b * SEQ + qb * 256 + F.wave * 32 + ql;
    bf16x8 qf[8];
    {   const bf16* qp = PROJ + t * INC + 1792 + hx * 128 + 8 * hh; v4u qw[8]; float ss = 0.f;
#pragma unroll
        for (int ks = 0; ks < 8; ++ks) { qw[ks] = *(const v4u*)(qp + ks * 16);
            const float a0 = bflo(qw[ks].x), a1 = bfhi(qw[ks].x), a2 = bflo(qw[ks].y), a3 = bfhi(qw[ks].y), a4 = bflo(qw[ks].z), a5 = bfhi(qw[ks].z), a6 = bflo(qw[ks].w), a7 = bfhi(qw[ks].w);
            ss += (a0 * a0 + a1 * a1) + (a2 * a2 + a3 * a3) + (a4 * a4 + a5 * a5) + (a6 * a6 + a7 * a7); }
        ss += __shfl_xor(ss, 32);
        const float sc = 0.08838834764831845f / sqrtf(ss * (1.f / 128.f) + EPS);
        const float* qn = F.in[I_XQ_NORM] + 8 * hh;
#pragma unroll
        for (int ks = 0; ks < 8; ++ks) { const float* g = qn + ks * 16; v4u o;
            o.x = pk2(bflo(qw[ks].x) * sc * g[0], bfhi(qw[ks].x) * sc * g[1]); o.y = pk2(bflo(qw[ks].y) * sc * g[2], bfhi(qw[ks].y) * sc * g[3]);
            o.z = pk2(bflo(qw[ks].z) * sc * g[4], bfhi(qw[ks].z) * sc * g[5]); o.w = pk2(bflo(qw[ks].w) * sc * g[6], bfhi(qw[ks].w) * sc * g[7]);
            qf[ks] = __builtin_bit_cast(bf16x8, o); } }
    f32x16 o[4];
#pragma unroll
    for (int dt = 0; dt < 4; ++dt) o[dt] = (f32x16){0.f, 0.f, 0.f, 0.f, 0.f, 0.f, 0.f, 0.f, 0.f, 0.f, 0.f, 0.f, 0.f, 0.f, 0.f, 0.f};
    float mrun = -1e30f, lrun = 0.f;
    for (int kb = 0; kb < 4; ++kb) {
        f32x16 s[2];
#pragma unroll
        for (int kt = 0; kt < 2; ++kt) { f32x16 a = {0.f, 0.f, 0.f, 0.f, 0.f, 0.f, 0.f, 0.f, 0.f, 0.f, 0.f, 0.f, 0.f, 0.f, 0.f, 0.f};
#pragma unroll
            for (int ks = 0; ks < 8; ++ks) { const bf16x8 kfrag = *(const LAS bf16x8*)(Ks + (64 * kb + 32 * kt + ql) * XA_KS + ks * 16 + 8 * hh);
                a = __builtin_amdgcn_mfma_f32_32x32x16_bf16(kfrag, qf[ks], a, 0, 0, 0); }
            s[kt] = a; }
        float mx = mrun;
#pragma unroll
        for (int kt = 0; kt < 2; ++kt)
#pragma unroll
            for (int rg = 0; rg < 16; ++rg) mx = fmaxf(mx, s[kt][rg]);
        mx = fmaxf(mx, __shfl_xor(mx, 32));
        const float alpha = fast_exp(mrun - mx); mrun = mx;
        float ls = 0.f;
#pragma unroll
        for (int kt = 0; kt < 2; ++kt)
#pragma unroll
            for (int rg = 0; rg < 16; ++rg) { const float p = fast_exp(s[kt][rg] - mx); s[kt][rg] = p; ls += p; }
        lrun = lrun * alpha + ls;
#pragma unroll
        for (int dt = 0; dt < 4; ++dt)
#pragma unroll
            for (int rg = 0; rg < 16; ++rg) o[dt][rg] *= alpha;
#pragma unroll
        for (int kt = 0; kt < 2; ++kt)
#pragma unroll
            for (int st = 0; st < 2; ++st) { v4u pw; pw.x = pk2(s[kt][8 * st + 0], s[kt][8 * st + 1]); pw.y = pk2(s[kt][8 * st + 2], s[kt][8 * st + 3]); pw.z = pk2(s[kt][8 * st + 4], s[kt][8 * st + 5]); pw.w = pk2(s[kt][8 * st + 6], s[kt][8 * st + 7]);
                const bf16x8 pf = __builtin_bit_cast(bf16x8, pw);
#pragma unroll
                for (int dt = 0; dt < 4; ++dt) { const LAS bf16* vp = Vt + (dt * 32 + ql) * XA_VS + 64 * kb + 32 * kt + 16 * st + 4 * hh;
                    const v2u lo = *(const LAS v2u*)vp, hi = *(const LAS v2u*)(vp + 8); v4u vv; vv.x = lo.x; vv.y = lo.y; vv.z = hi.x; vv.w = hi.y;
                    o[dt] = __builtin_amdgcn_mfma_f32_32x32x16_bf16(__builtin_bit_cast(bf16x8, vv), pf, o[dt], 0, 0, 0); } }
    }
    lrun += __shfl_xor(lrun, 32);
    const float inv = 1.0f / lrun;
    bf16* op = MIX + t * D + 1536 + hx * 128 + 4 * hh;
#pragma unroll
    for (int dt = 0; dt < 4; ++dt)
#pragma unroll
        for (int q4 = 0; q4 < 4; ++q4) { v2u ow; ow.x = pk2(o[dt][q4 * 4 + 0] * inv, o[dt][q4 * 4 + 1] * inv); ow.y = pk2(o[dt][q4 * 4 + 2] * inv, o[dt][q4 * 4 + 3] * inv);
            *(v2u*)(op + dt * 32 + q4 * 8) = ow; }
}

__device__ __forceinline__ void moe_tables(Frame& F) {
    LAS int* cnt = (LAS int*)(F.lds + TAB_OFF); LAS int* ts = cnt + 64;
    __syncthreads();
    if (F.tid < 64) { const int c = (int)__hip_atomic_load(F.ctl + CW_CNT + F.tid, __ATOMIC_RELAXED, __HIP_MEMORY_SCOPE_AGENT); const int nt = (c + 255) >> 8; int inc = nt;
#pragma unroll
        for (int o = 1; o < 64; o <<= 1) { const int v = __shfl_up(inc, o); if (F.tid >= o) inc += v; }
        cnt[F.tid] = c; ts[F.tid + 1] = inc; if (F.tid == 0) ts[0] = 0; }
    __syncthreads();
}

struct Args { const float* in[31]; float* out; unsigned char* ws; int ph_lo, ph_hi; };
__global__ void __launch_bounds__(512, 2) hymba_fwd(Args args) {
    extern __shared__ __attribute__((aligned(16))) unsigned char lds_raw[];
    Frame F;
    F.lds = (LAS unsigned char*)lds_raw;
    F.tid = threadIdx.x; F.lane = F.tid & 63; F.wave = __builtin_amdgcn_readfirstlane(F.tid >> 6);
    F.G = gridDim.x; { const int bx = blockIdx.x; F.vcu = (F.G % 8 == 0) ? (bx % 8) * (F.G / 8) + bx / 8 : bx; }
#pragma unroll
    for (int i = 0; i < 31; ++i) F.in[i] = args.in[i];
    F.out = args.out; F.ws = args.ws; F.ctl = (unsigned*)(args.ws + WS_CTL);
    const int lo = args.ph_lo, hi = args.ph_hi;
#if !MK_PER_PHASE
    if (F.tid < 4) ((LAS unsigned*)(F.lds + XBW_OFF))[F.tid] = 0u;
    __syncthreads();
    XcdBarrier bar = xcd_barrier_post(F.ctl + CW_BAR, (volatile LAS unsigned*)(F.lds + XBW_OFF));
#define GRID_BAR() xcd_barrier(bar)
#else
#define GRID_BAR() do {} while (0)
#endif
#define IN(k) (lo <= (k) && (k) < hi)
#define SEAM(k) do { if (IN(k) && IN((k) + 1)) GRID_BAR(); } while (0)
    const int gw = F.vcu * 8 + F.wave, NGW = F.G * 8;
    bf16* const XN = (bf16*)(F.ws + WS_XN); bf16* const PROJ = (bf16*)(F.ws + WS_PROJ); bf16* const MIX = (bf16*)(F.ws + WS_MIX);
    bf16* const UA = (bf16*)(F.ws + WS_UA); bf16* const Gm = (bf16*)(F.ws + WS_G);

    if (IN(0)) { p0_prologue(F); }
    SEAM(0);
    if (IN(1)) {
        { pg8::Gemm g{D, D, D}; pg8::DenseOrder S; S.init(XN, F.ws + WS_WIN, D, D, T, INC, F.G, (int)blockIdx.x);
          pg8::EpiProj E{PROJ, UA}; pg8::gemm_phase<pg8::EpiProj, pg8::DenseOrder>(F.lds, g, S, E); }
        { pg8::Gemm g{D, D, D}; pg8::DenseOrder S; S.init(F.ws + WS_MEMN, F.ws + WS_WMKV, D, D, NB * MEML, 1024, F.G, F.G - 1 - (int)blockIdx.x);
          pg8::EpiBf16 E{(bf16*)(F.ws + WS_MEMKV), 1024}; pg8::gemm_phase<pg8::EpiBf16, pg8::DenseOrder>(F.lds, g, S, E); }
        { const int c = (int)blockIdx.x; const bool has3 = 2 * F.G + c < (T / 256) * (INC / 256), haskv = (F.G - 1 - c) < (NB * MEML / 256) * 4;
          bg_convert(F, CW_QGU, 0, BT_GU, (!has3 && !haskv) ? PB1 : 0); }
    }
    SEAM(1);
    if (IN(2)) {
        for (int u = F.vcu; u < 256; u += F.G) swa_unit(F, u);
        __syncthreads();
        { pg8::Gemm g{S5K, 512, 512}; pg8::GroupOrder S{(const char*)UA, (const char*)(F.ws + WS_SP), S5K, 512, 1, 32, F.G, F.G - 1 - F.vcu};
          pg8::EpiF32 E{(float*)(F.ws + WS_SL), 256, (size_t)512 * 256}; pg8::gemm_phase<pg8::EpiF32, pg8::GroupOrder>(F.lds, g, S, E); }
        bg_convert(F, CW_QGU, 0, BT_GU, (F.G - 1 - F.vcu) >= 64 ? PB2 : 0);
    }
    SEAM(2);
    if (IN(3)) {
        if (F.wave == 0) {
            const float* SL = (const float*)(F.ws + WS_SL); const float* AL = (const float*)(F.ws + WS_AL);
            for (int p = F.vcu; p < 256; p += F.G) { const int b = p >> 5, g = p & 31, n = F.lane;
                const float ar = AL[(g * 64 + n) * 2], ai = AL[(g * 64 + n) * 2 + 1]; float xr = 0.f, xi = 0.f;
                for (int j0 = 0; j0 < 64; j0 += 8) { float sr[8], si[8];
#pragma unroll
                    for (int j = 0; j < 8; ++j) { const float* sp = SL + ((size_t)(g * 512 + b * 64 + j0 + j)) * 256; sr[j] = sp[n]; si[j] = sp[64 + n]; }
#pragma unroll
                    for (int j = 0; j < 8; ++j) { bf16* up = UA + ((size_t)(g * 512 + b * 64 + j0 + j)) * S5K + 512; up[n] = (bf16)f2bf(xr); up[64 + n] = (bf16)f2bf(xi);
                        const float nr = ar * xr - ai * xi + sr[j], ni = ar * xi + ai * xr + si[j]; xr = nr; xi = ni; } } }
        }
        for (int u = F.vcu; u < 256; u += F.G) xattn_unit(F, u);
        __syncthreads();
    }
    SEAM(3);
    if (IN(4)) {
        pg8::Gemm g{S5K, S5K, S5K}; pg8::GroupOrder S{(const char*)UA, (const char*)(F.ws + WS_MQ), S5K, S5K, 2, 32, F.G, F.vcu};
        pg8::EpiS5Y E{UA, F.in[I_SSM_D], Gm}; pg8::gemm_phase<pg8::EpiS5Y, pg8::GroupOrder>(F.lds, g, S, E);
        bg_convert(F, CW_QGU, 0, BT_GU, F.vcu >= 128 ? PB4 : 0);
    }
    SEAM(4);
    if (IN(5)) {
        pg8::Gemm g{512, 512, 512}; pg8::DenseOrder S; S.init(Gm, F.ws + WS_WGLU, 512, 512, T, 512, F.G, (int)blockIdx.x);
        pg8::EpiGlu E{Gm, MIX}; pg8::gemm_phase<pg8::EpiGlu, pg8::DenseOrder>(F.lds, g, S, E);
        bg_convert(F, CW_QGU, 0, BT_GU, (int)blockIdx.x >= (T / 256) * 2 ? PB5 : 0);
    }
    SEAM(5);
    if (IN(6)) {
        for (int m = gw; m < T; m += NGW) { v4u* rp = (v4u*)(MIX + (size_t)m * D) + F.lane; v4u w[4]; float ss[4];
#pragma unroll
            for (int j = 0; j < 4; ++j) { w[j] = rp[64 * j];
                const float a0 = bflo(w[j].x), a1 = bfhi(w[j].x), a2 = bflo(w[j].y), a3 = bfhi(w[j].y), a4 = bflo(w[j].z), a5 = bfhi(w[j].z), a6 = bflo(w[j].w), a7 = bfhi(w[j].w);
                ss[j] = (a0 * a0 + a1 * a1) + (a2 * a2 + a3 * a3) + (a4 * a4 + a5 * a5) + (a6 * a6 + a7 * a7); }
            const float sa = wave_sum(ss[0] + ss[1]), sb = wave_sum(ss[2]), sc = wave_sum(ss[3]);
            const float ra = 1.0f / sqrtf(sa * (1.f / 1024.f) + EPS), rb = 1.0f / sqrtf(sb * (1.f / 512.f) + EPS), rc = 1.0f / sqrtf(sc * (1.f / 512.f) + EPS);
#pragma unroll
            for (int j = 0; j < 4; ++j) { const float rs = j < 2 ? ra : (j == 2 ? rb : rc);
                const float* g = (j < 2 ? F.in[I_ON_ATTN] + j * 512 : (j == 2 ? F.in[I_ON_SSM] : F.in[I_ON_X])) + F.lane * 8; v4u o;
                o.x = pk2(bflo(w[j].x) * rs * g[0], bfhi(w[j].x) * rs * g[1]); o.y = pk2(bflo(w[j].y) * rs * g[2], bfhi(w[j].y) * rs * g[3]);
                o.z = pk2(bflo(w[j].z) * rs * g[4], bfhi(w[j].z) * rs * g[5]); o.w = pk2(bflo(w[j].w) * rs * g[6], bfhi(w[j].w) * rs * g[7]);
                rp[64 * j] = o; } }
    }
    SEAM(6);
    if (IN(7)) {
        pg8::Gemm g{D, D, D}; pg8::DenseOrder S; S.init(MIX, F.ws + WS_WO, D, D, T, D, F.G, (int)blockIdx.x);
        pg8::EpiWo E{F.in[I_X], XN, (float*)(F.ws + WS_PART)}; pg8::gemm_phase<pg8::EpiWo, pg8::DenseOrder>(F.lds, g, S, E);
    }
    SEAM(7);
    if (IN(8)) {
        pg8::Gemm g{D, 512, 512}; pg8::KSplitOrder S{(const char*)XN, (const char*)(F.ws + WS_WR), D, 512, 512, T / 256, 4, F.G, F.vcu};
        pg8::EpiLogit E{(float*)(F.ws + WS_LP)}; pg8::gemm_phase<pg8::EpiLogit, pg8::KSplitOrder>(F.lds, g, S, E);
    }
    SEAM(8);
    const int rt_per = (T + F.G - 1) / F.G, rt_beg = F.vcu * rt_per, rt_end = (rt_beg + rt_per) < T ? (rt_beg + rt_per) : T;
    if (IN(9)) {
        LAS int* hist = (LAS int*)F.lds;
        const float* LP = (const float*)(F.ws + WS_LP); const float* part = (const float*)(F.ws + WS_PART); float* rstdv = (float*)(F.ws + WS_RSTD);
        int* toke = (int*)(F.ws + WS_TOKE); float* wts = (float*)(F.ws + WS_WTS); int* HIST = (int*)(F.ws + WS_HIST);
        __syncthreads();
        if (F.tid < 64) hist[F.tid] = 0;
        __syncthreads();
        for (int t = rt_beg + F.tid; t < rt_end; t += 512) {
            const f32x4* pp = (const f32x4*)(part + (size_t)t * 32); float ss = 0.f;
#pragma unroll
            for (int j = 0; j < 8; ++j) { const f32x4 v = pp[j]; ss += (v[0] + v[1]) + (v[2] + v[3]); }
            const float rs = 1.0f / sqrtf(ss * (1.f / 2048.f) + EPS); rstdv[t] = rs;
            const float* l0 = LP + (size_t)t * 80; const float* l1 = l0 + (size_t)T * 80; const float* l2 = l1 + (size_t)T * 80; const float* l3 = l2 + (size_t)T * 80;
            float gl[8];
#pragma unroll
            for (int j = 0; j < 8; j += 4) { const f32x4 a = *(const f32x4*)(l0 + j), b = *(const f32x4*)(l1 + j), c = *(const f32x4*)(l2 + j), d = *(const f32x4*)(l3 + j);
#pragma unroll
                for (int q = 0; q < 4; ++q) gl[j + q] = rs * (((a[q] + b[q]) + c[q]) + d[q]); }
            int gi = 0; float gm = gl[0];
#pragma unroll
            for (int j = 1; j < 8; ++j) if (gl[j] > gm) { gm = gl[j]; gi = j; }
            float gs = 0.f;
#pragma unroll
            for (int j = 0; j < 8; ++j) gs += expf(gl[j] - gm);
            const float gate = 1.0f / gs;
            float el[8];
#pragma unroll
            for (int j = 0; j < 8; j += 4) { const int o = 8 + gi * 8 + j; const f32x4 a = *(const f32x4*)(l0 + o), b = *(const f32x4*)(l1 + o), c = *(const f32x4*)(l2 + o), d = *(const f32x4*)(l3 + o);
#pragma unroll
                for (int q = 0; q < 4; ++q) el[j + q] = rs * (((a[q] + b[q]) + c[q]) + d[q]); }
            int i1 = 0; float v1 = el[0];
#pragma unroll
            for (int j = 1; j < 8; ++j) if (el[j] > v1) { v1 = el[j]; i1 = j; }
            int i2 = -1; float v2 = -3.0e38f;
#pragma unroll
            for (int j = 0; j < 8; ++j) if (j != i1 && el[j] > v2) { v2 = el[j]; i2 = j; }
            const float ex = expf(v2 - v1);
            const int ea = gi * 8 + i1, eb = gi * 8 + i2;
            const int la = __hip_atomic_fetch_add(hist + ea, 1, __ATOMIC_RELAXED, __HIP_MEMORY_SCOPE_WORKGROUP), lb = __hip_atomic_fetch_add(hist + eb, 1, __ATOMIC_RELAXED, __HIP_MEMORY_SCOPE_WORKGROUP);
            toke[t * 2] = (ea << 16) | la; toke[t * 2 + 1] = (eb << 16) | lb; wts[t * 2] = gate / (1.0f + ex); wts[t * 2 + 1] = gate * ex / (1.0f + ex);
        }
        __syncthreads();
        if (F.tid < 64) HIST[F.vcu * 64 + F.tid] = hist[F.tid];
        __syncthreads();
    }
    SEAM(9);
    if (IN(10)) {
        LAS int* pb = (LAS int*)F.lds; LAS int* pt = pb + 512; LAS int* base = pt + 512;
        const int* HIST = (const int*)(F.ws + WS_HIST); const int* toke = (const int*)(F.ws + WS_TOKE); int* list = (int*)(F.ws + WS_LIST);
        __syncthreads();
        { const int e = F.tid & 63, p8 = F.tid >> 6; int sb = 0, st = 0;
          for (int w = p8; w < F.G; w += 8) { const int h = HIST[w * 64 + e]; st += h; sb += (w < F.vcu) ? h : 0; }
          pb[F.tid] = sb; pt[F.tid] = st; }
        __syncthreads();
        if (F.tid < 64) { int sb = 0, st = 0;
#pragma unroll
            for (int j = 0; j < 8; ++j) { sb += pb[j * 64 + F.tid]; st += pt[j * 64 + F.tid]; }
            base[F.tid] = sb; F.ctl[CW_CNT + F.tid] = (unsigned)st; }
        __syncthreads();
        for (int t = rt_beg + F.tid; t < rt_end; t += 512) {
#pragma unroll
            for (int k = 0; k < 2; ++k) { const int v = toke[t * 2 + k], e = v >> 16, sl = v & 0xffff; list[(size_t)e * LCAP + base[e] + sl] = t * 2 + k; } }
        __syncthreads();
        bg_convert(F, CW_QGU, 0, BT_GU, 0x7fffffff);
    }
    SEAM(10);
    if (IN(11)) {
        moe_tables(F);
        const LAS int* cnt = (const LAS int*)(F.lds + TAB_OFF); const int* list = (const int*)(F.ws + WS_LIST);
        pg8::Gemm g{D, D, D}; pg8::MoeOrder S{(const char*)XN, (const char*)(F.ws + WS_WGU), cnt, cnt + 64, list, D, D, 4, 1024, F.G, F.vcu, true};
        pg8::EpiGU E{list, (const float*)(F.ws + WS_RSTD), cnt, (bf16*)(F.ws + WS_ACT)}; pg8::gemm_phase<pg8::EpiGU, pg8::MoeOrder, true>(F.lds, g, S, E);
        { const int total = cnt[64 + 64] * 4, rounds = (total + F.G - 1) / F.G, mine = F.vcu < total ? (total - 1 - F.vcu) / F.G + 1 : 0;
          bg_convert(F, CW_QD, BT_GU, BT_D, mine < rounds ? PB11 : 0);
          bg_convert(F, CW_QD, BT_GU, BT_D, 0x7fffffff); }
    }
    SEAM(11);
    if (IN(12)) {
        moe_tables(F);
        const LAS int* cnt = (const LAS int*)(F.lds + TAB_OFF); const int* list = (const int*)(F.ws + WS_LIST);
        pg8::Gemm g{DEXP, DEXP, DEXP}; pg8::MoeOrder S{(const char*)(F.ws + WS_ACT), (const char*)(F.ws + WS_WD), cnt, cnt + 64, list, DEXP, DEXP, 8, 2048, F.G, F.vcu, false};
        pg8::EpiDown E{list, (const float*)(F.ws + WS_WTS), cnt, (bf16*)(F.ws + WS_Y2)};
        pg8::gemm_phase<pg8::EpiDown, pg8::MoeOrder>(F.lds, g, S, E);
    }
    SEAM(12);
    if (IN(13)) {
        const bf16* Y2 = (const bf16*)(F.ws + WS_Y2);
        for (int m = gw; m < T; m += NGW) { f32x4* op = (f32x4*)(F.out + (size_t)m * D) + F.lane * 2; const v4u* xb = (const v4u*)(XN + (size_t)m * D) + F.lane;
            const v4u* ya = (const v4u*)(Y2 + (size_t)m * 2 * D) + F.lane; const v4u* yb = ya + 256;
            v4u xw[4], aw[4], cw[4];
#pragma unroll
            for (int j = 0; j < 4; ++j) { xw[j] = __builtin_nontemporal_load(xb + 64 * j); aw[j] = __builtin_nontemporal_load(ya + 64 * j); cw[j] = __builtin_nontemporal_load(yb + 64 * j); }
#pragma unroll
            for (int j = 0; j < 4; ++j) { const v4u x = xw[j], a = aw[j], c = cw[j]; f32x4 x0, x1;
                x0[0] = bflo(x.x) + (bflo(a.x) + bflo(c.x)); x0[1] = bfhi(x.x) + (bfhi(a.x) + bfhi(c.x)); x0[2] = bflo(x.y) + (bflo(a.y) + bflo(c.y)); x0[3] = bfhi(x.y) + (bfhi(a.y) + bfhi(c.y));
                x1[0] = bflo(x.z) + (bflo(a.z) + bflo(c.z)); x1[1] = bfhi(x.z) + (bfhi(a.z) + bfhi(c.z)); x1[2] = bflo(x.w) + (bflo(a.w) + bflo(c.w)); x1[3] = bfhi(x.w) + (bfhi(a.w) + bfhi(c.w));
                __builtin_nontemporal_store(x0, op + 128 * j); __builtin_nontemporal_store(x1, op + 128 * j + 1); } }
    }
#undef IN
#undef SEAM
}

extern "C" void kernel_launch(void* const* d_in, const int* in_sizes, int n_in, void* d_out, int out_size, void* d_ws, size_t ws_size, hipStream_t stream) {
    static int grid = 0;
    if (grid == 0) {
        if (n_in != 31 || out_size != T * D || ws_size < WS_END) { fprintf(stderr, "kernel_launch: unexpected shapes (n_in %d out %d ws %zu)\n", n_in, out_size, ws_size); grid = -1; return; }
        int dev = 0, cus = 0, per_cu = 0;
        if (hipGetDevice(&dev) != hipSuccess || hipDeviceGetAttribute(&cus, hipDeviceAttributeMultiprocessorCount, dev) != hipSuccess) { grid = -1; return; }
        if (hipFuncSetAttribute((const void*)hymba_fwd, hipFuncAttributeMaxDynamicSharedMemorySize, LDS_BYTES) != hipSuccess) { fprintf(stderr, "kernel_launch: hipFuncSetAttribute failed\n"); grid = -1; return; }
        if (hipOccupancyMaxActiveBlocksPerMultiprocessor(&per_cu, (const void*)hymba_fwd, 512, LDS_BYTES) != hipSuccess || per_cu < 1) fprintf(stderr, "kernel_launch: occupancy query reports %d\n", per_cu);
        (void)hipGetLastError();
        grid = cus;
    }
    if (grid < 0) return;
    (void)hipMemsetAsync((char*)d_ws + WS_CTL, 0, CTL_ZERO_BYTES, stream);
    Args a{};
    for (int i = 0; i < 31; ++i) a.in[i] = (const float*)d_in[i];
    a.out = (float*)d_out; a.ws = (unsigned char*)d_ws;
#if MK_PER_PHASE
    for (int p = 0; p < NPH; ++p) { const int reps = ((PROBE_REP_MASK >> p) & 1) ? 2 : 1;
        for (int q = 0; q < reps; ++q) { a.ph_lo = p; a.ph_hi = p + 1; hipLaunchKernelGGL(hymba_fwd, dim3(grid), dim3(512), LDS_BYTES, stream, a); } }
#else
    a.ph_lo = 0; a.ph_hi = NPH; hipLaunchKernelGGL(hymba_fwd, dim3(grid), dim3(512), LDS_BYTES, stream, a);
#endif
}
```

```cpp
#include <hip/hip_runtime.h>
#include <cstdio>
#include <cstdint>

#ifndef PROBE_REP_MASK
#define PROBE_REP_MASK 0
#endif
#ifndef PB0
#define PB0 40
#endif
#ifndef PB0_S5
#define PB0_S5 28
#endif
#ifndef PB0_D
#define PB0_D 0
#endif
#ifndef PB1
#define PB1 0
#endif
#ifndef PB2
#define PB2 0
#endif
#ifndef PB4
#define PB4 0
#endif
#ifndef PB5
#define PB5 0
#endif
#ifndef PB11
#define PB11 0
#endif
#ifndef MK_PER_PHASE
#define MK_PER_PHASE 0
#endif

#define GAS __attribute__((address_space(1)))
#define LAS __attribute__((address_space(3)))
typedef unsigned short bf16;
typedef unsigned v4u __attribute__((ext_vector_type(4)));
typedef unsigned v2u __attribute__((ext_vector_type(2)));
typedef float f32x4 __attribute__((ext_vector_type(4)));
typedef float f32x16 __attribute__((ext_vector_type(16)));
typedef short bf16x8 __attribute__((ext_vector_type(8)));
typedef short bf16x4 __attribute__((ext_vector_type(4)));

constexpr int T = 16384, D = 2048, SEQ = 2048, NB = 8, INC = 2304, MEML = 256;
constexpr int NPH = 14;
constexpr float EPS = 1e-6f;
constexpr int NEXP = 64, DEXP = 512, LCAP = 16384;
constexpr int S5L = 32, S5K = 640;

constexpr size_t MiB = 1u << 20;
constexpr size_t WS_CTL = 0, CTL_ZERO_BYTES = 1 * MiB;
constexpr size_t WS_WIN = 2 * MiB, WS_WO = 11 * MiB, WS_WMKV = 19 * MiB, WS_WGLU = 23 * MiB;
constexpr size_t WS_MQ = 24 * MiB, WS_SP = 44 * MiB, WS_UA = 52 * MiB, WS_SL = 72 * MiB, WS_AL = 88 * MiB, WS_WR = 89 * MiB;
constexpr size_t WS_XN = 96 * MiB;
constexpr size_t WS_MEMN = 160 * MiB, WS_MEMKV = 168 * MiB;
constexpr size_t WS_PROJ = 176 * MiB;
constexpr size_t WS_MIX = 248 * MiB;
constexpr size_t WS_Y2 = 176 * MiB;
constexpr size_t WS_G = 312 * MiB;
constexpr size_t WS_LOG = 328 * MiB;
constexpr size_t WS_LIST = 344 * MiB;
constexpr size_t WS_WTS = 348 * MiB;
constexpr size_t WS_LP = 352 * MiB;
constexpr size_t WS_PART = 376 * MiB;
constexpr size_t WS_RSTD = 379 * MiB;
constexpr size_t WS_HIST = 380 * MiB;
constexpr size_t WS_TOKE = 381 * MiB;
constexpr size_t WS_ACT = 544 * MiB;
constexpr size_t WS_WGU = 592 * MiB;
constexpr size_t WS_WD = 848 * MiB;
constexpr size_t WS_END = 976 * MiB;
constexpr int CW_CNT = 1024;
constexpr int CW_BAR = 4096;
constexpr int CW_QGU = 2048, CW_QD = 2112;

constexpr int RING_BYTES = 131072;
constexpr int TAB_OFF = 139264;
constexpr int XBW_OFF = TAB_OFF + 2048;
constexpr int LDS_BYTES = 147456;

#define LDS_WAIT() asm volatile("s_waitcnt lgkmcnt(0)" ::: "memory")
#define VM_WAIT() asm volatile("s_waitcnt vmcnt(0)" ::: "memory")
__device__ __forceinline__ unsigned f2bf(float f) { unsigned u = __builtin_bit_cast(unsigned, f); return (u + 0x7fffu + ((u >> 16) & 1u)) >> 16; }
__device__ __forceinline__ unsigned pk2(float lo, float hi) { unsigned r; asm volatile("v_cvt_pk_bf16_f32 %0, %1, %2" : "=v"(r) : "v"(lo), "v"(hi)); return r; }
__device__ __forceinline__ float bflo(unsigned w) { return __builtin_bit_cast(float, w << 16); }
__device__ __forceinline__ float bfhi(unsigned w) { return __builtin_bit_cast(float, w & 0xffff0000u); }
__device__ __forceinline__ float wave_sum(float v) {
#pragma unroll
    for (int o = 1; o < 64; o <<= 1) v += __shfl_xor(v, o);
    return v;
}
__device__ __forceinline__ float fast_exp(float x) { return __builtin_amdgcn_exp2f(x * 1.44269504089f); }
__device__ __forceinline__ float sigmoidf_(float x) { return __builtin_amdgcn_rcpf(1.0f + fast_exp(-x)); }
__device__ __forceinline__ float gelu_tanh(float x) { const float z = 1.5957691216f * (x + 0.044715f * x * x * x); return x * sigmoidf_(z); }

#define XB_TMO      128
#define XB_XCNT(j)  (256  + 64 * (j))
#define XB_XSUB(j)  (1280 + 64 * (j))
#define XB_XGEN(j)  (2304 + 64 * (j))
#define XB_TOP      3328
#define XB_TOPGEN   3392
#define XCD_BAR_WORDS 3456
#define XB_SPIN_CAP (1u << 18)
__device__ __forceinline__ unsigned xb_ld(unsigned* p)              { return __hip_atomic_load(p, __ATOMIC_RELAXED, __HIP_MEMORY_SCOPE_AGENT); }
__device__ __forceinline__ unsigned xb_add(unsigned* p, unsigned v) { return __hip_atomic_fetch_add(p, v, __ATOMIC_RELAXED, __HIP_MEMORY_SCOPE_AGENT); }
__device__ __forceinline__ unsigned xb_xcc_id() { return (unsigned)__builtin_amdgcn_s_getreg((3 << 11) | 20) & 0xFu; }
#define XB_SPIN(cond, bar) do { unsigned _sp = 0; while (cond) { __builtin_amdgcn_s_sleep(1); \
    if ((++_sp & 255u) == 0u) { if (xb_ld(&(bar)[XB_TMO])) break; if (_sp > XB_SPIN_CAP) { atomicAdd(&(bar)[XB_TMO], 1u); break; } } } } while (0)
struct XcdBarrier { unsigned* bar; unsigned x; volatile LAS unsigned* st; };
__device__ __forceinline__ XcdBarrier xcd_barrier_post(unsigned* bar, volatile LAS unsigned* st) {
    XcdBarrier b; b.bar = bar; b.x = xb_xcc_id(); b.st = st;
    if (threadIdx.x == 0) (void)xb_add(&bar[XB_XCNT(b.x)], 1u);
    return b;
}
__device__ __forceinline__ void xcd_barrier_complete(unsigned* bar, unsigned x, unsigned& nloc, unsigned& nx) {
    const unsigned G = gridDim.x * gridDim.y * gridDim.z;
    unsigned sum, cnt, mine, sp = 0u;
    for (;;) {
        sum = 0u; cnt = 0u; mine = 0u;
#pragma unroll
        for (unsigned j = 0; j < 16; ++j) { const unsigned c = xb_ld(&bar[XB_XCNT(j)]); sum += c; cnt += (c > 0u) ? 1u : 0u; mine = (j == x) ? c : mine; }
        if (sum == G) break;
        __builtin_amdgcn_s_sleep(1);
        if ((++sp & 255u) == 0u) { if (xb_ld(&bar[XB_TMO])) break; if (sp > XB_SPIN_CAP) { atomicAdd(&bar[XB_TMO], 1u); break; } }
    }
    nloc = mine > 0u ? mine : 1u; nx = cnt > 0u ? cnt : 1u;
}
__device__ __forceinline__ void xcd_barrier(const XcdBarrier& b) {
    asm volatile("s_waitcnt vmcnt(0)" ::: "memory");
    __syncthreads();
    if (threadIdx.x == 0) {
        unsigned* bar = b.bar;
        __builtin_amdgcn_s_waitcnt(0);
        unsigned nloc = b.st[0], nx = b.st[1];
        if (nloc == 0u) { xcd_barrier_complete(bar, b.x, nloc, nx); b.st[0] = nloc; b.st[1] = nx; }
        const unsigned old = xb_add(&bar[XB_XSUB(b.x)], 1u);
        const unsigned gen = old / nloc;
        if (old + 1u == (gen + 1u) * nloc) {
            __builtin_amdgcn_fence(__ATOMIC_RELEASE, "agent");
            asm volatile("s_waitcnt vmcnt(0)" ::: "memory");
            const unsigned og = xb_add(&bar[XB_TOP], 1u);
            const unsigned tg = og / nx;
            if (og + 1u == (tg + 1u) * nx) xb_add(&bar[XB_TOPGEN], 1u);
            else XB_SPIN(xb_ld(&bar[XB_TOPGEN]) == tg, bar);
            __builtin_amdgcn_fence(__ATOMIC_ACQUIRE, "agent");
            xb_add(&bar[XB_XGEN(b.x)], 1u);
            asm volatile("s_waitcnt vmcnt(0)" ::: "memory");
        } else {
            XB_SPIN(xb_ld(&bar[XB_XGEN(b.x)]) == gen, bar);
            __builtin_amdgcn_fence(__ATOMIC_ACQUIRE, "agent");
            asm volatile("s_waitcnt vmcnt(0)" ::: "memory");
        }
    }
    __syncthreads();
}

namespace pg8 {
constexpr int BM = 256, BK = 64, HALF = 128, HTB = HALF * BK * 2, STAGE_BYTES = 8 * HTB, NXCD = 8, WGM = 8;
__host__ __device__ __forceinline__ int lds_byte(int r, int c) { const int st = (r >> 4) * 2 + (c >> 5), rr = r & 15, cc = c & 31, ob = rr * 64 + cc * 2; return st * 1024 + (ob ^ (((ob >> 9) & 1) << 5)); }
__host__ __device__ __forceinline__ void stage_rc(int b, int& R, int& C) { const int st = b / 1024, sb = b % 1024, swz = sb ^ (((sb >> 9) & 1) << 5); R = (st >> 1) * 16 + swz / 64; C = (st & 1) * 32 + (swz % 64) / 2; }
__host__ __device__ __forceinline__ int perm32(int rho) { const int n = rho >> 4, i = rho & 15; return 8 * (i >> 2) + 4 * n + (i & 3); }

struct Unit { const char* a; const char* b; int r0, c0, aux, r1; };
struct Gemm { int lda, ldb, K; };

struct DenseOrder {
    const char* A; const char* Bt; int lda, ldb, nM, nN, nwg, G, c;
    __device__ void init(const void* A_, const void* Bt_, int lda_, int ldb_, int M, int N, int G_, int c_) { A = (const char*)A_; Bt = (const char*)Bt_; lda = lda_; ldb = ldb_; nM = M / BM; nN = N / BM; nwg = nM * nN; G = G_; c = c_; }
    __device__ bool next(int i, Unit& u) const {
        const long L = (long)i * G + c; if (L >= nwg) return false;
        int wgid = (int)L; { const int q = nwg / NXCD, r = nwg % NXCD, xcd = wgid % NXCD, off = wgid / NXCD; wgid = (xcd < r ? xcd * (q + 1) : r * (q + 1) + (xcd - r) * q) + off; }
        const int nig = WGM * nN, gid = wgid / nig, fm = gid * WGM, gsz = (nM - fm) < WGM ? (nM - fm) : WGM;
        const int pm = fm + ((wgid % nig) % gsz), pn = (wgid % nig) / gsz;
        u.a = A + (size_t)pm * BM * lda * 2; u.b = Bt + (size_t)pn * BM * ldb * 2; u.r0 = pm * BM; u.c0 = pn * BM; u.aux = 0; u.r1 = 0; return true;
    }
    __device__ __forceinline__ unsigned arow(const Unit&, int) const { return 0u; }
};
struct GroupOrder {
    const char* A; const char* Bt; int lda, ldb, nN, ngrp, G, c;
    __device__ bool next(int i, Unit& u) const {
        const int L = i * G + c; if (L >= ngrp * 2 * nN) return false;
        const int g = L / (2 * nN), q = L % (2 * nN), pn = q >> 1, pm = q & 1;
        u.a = A + ((size_t)g * 512 + pm * BM) * lda * 2; u.b = Bt + ((size_t)g * nN + pn) * BM * ldb * 2; u.r0 = pm * BM; u.c0 = pn * BM; u.aux = g; u.r1 = 0; return true;
    }
    __device__ __forceinline__ unsigned arow(const Unit&, int) const { return 0u; }
};
struct MoeOrder {
    const char* A; const char* Bt; const LAS int* cnt; const LAS int* ts; const int* list; int lda, ldb, nct, brows, G, c; bool gather;
    __device__ bool next(int i, Unit& u) const {
        const int L = i * G + c; const int lane = threadIdx.x & 63;
        if (L >= ts[64] * nct) return false;
        const int lo = ts[lane] * nct, hi = ts[lane + 1] * nct;
        const unsigned long long m = __ballot(lo <= L && L < hi);
        const int e = __builtin_amdgcn_readfirstlane((int)__builtin_ctzll(m));
        const int tse = ts[e], ne = ts[e + 1] - tse, q = L - tse * nct, ct = q / ne, rt = q % ne;
        u.a = gather ? A : A + (size_t)(tse + rt) * BM * lda * 2; u.b = Bt + ((size_t)e * brows + (size_t)ct * BM) * ldb * 2;
        u.r0 = (tse + rt) * BM; u.r1 = rt * BM; u.c0 = ct; u.aux = e; return true;
    }
    __device__ __forceinline__ unsigned arow(const Unit& u, int r) const {
        const int n = cnt[u.aux]; int rr = u.r1 + r; rr = rr < n ? rr : n - 1;
        return (unsigned)(list[(size_t)u.aux * LCAP + rr] >> 1) * (unsigned)(lda * 2);
    }
};

#define EPI_ROWS_COLS() const int rowb = wr * 64 + fr; (void)rowb;

template <class Epi, class Sched, bool GATHER = false>
__device__ __forceinline__ void gemm_phase(LAS unsigned char* lds, const Gemm g, const Sched& S, const Epi& E) {
    const int tid = threadIdx.x, wid = __builtin_amdgcn_readfirstlane(tid >> 6), lane = tid & 63, wr = wid >> 2, wc = wid & 3, fr = lane & 15, fq = lane >> 4;
    const int K = g.K, nt = K / BK;
    unsigned voffB[2]; int Ra[2], Ca[2];
#pragma unroll
    for (int i = 0; i < 2; ++i) { int R, C; stage_rc(tid * 16 + i * 8192, R, C); const int Rb = Epi::PERM ? ((R & ~31) + perm32(R & 31)) : R;
        Ra[i] = R; Ca[i] = C; voffB[i] = (unsigned)(Rb * g.ldb + C) * 2u; }
    const size_t kstep = (size_t)(BK * 2);
    const size_t hstepB = (size_t)HALF * g.ldb * 2;
    const unsigned ldsw = (unsigned)wid * 1024u;
    const int aoff = lds_byte(wr * 64 + fr, fq * 8), boff = lds_byte(wc * 32 + fr, fq * 8);
#define PG8_SA(b, h) (((b) * 2 + (h)) * HTB)
#define PG8_SB(b, h) ((4 + (b) * 2 + (h)) * HTB)
#define PG8_STAGE(bufoff, gbase, voff) do { _Pragma("unroll") for (int _i = 0; _i < 2; ++_i) \
        __builtin_amdgcn_global_load_lds((const unsigned*)((const char*)(gbase) + (voff)[_i]), (LAS unsigned*)(lds + (bufoff) + ldsw + _i * 8192), 16, 0, 0); } while (0)
#define PG8_STAGEA(bufoff, gbase, o0, o1) do { \
        __builtin_amdgcn_global_load_lds((const unsigned*)((const char*)(gbase) + (o0)), (LAS unsigned*)(lds + (bufoff) + ldsw), 16, 0, 0); \
        __builtin_amdgcn_global_load_lds((const unsigned*)((const char*)(gbase) + (o1)), (LAS unsigned*)(lds + (bufoff) + ldsw + 8192), 16, 0, 0); } while (0)
#define PG8_LDA(dst, b, h) do { _Pragma("unroll") for (int m = 0; m < 4; ++m) _Pragma("unroll") for (int k = 0; k < 2; ++k) dst[m][k] = *(const LAS bf16x8*)(lds + PG8_SA(b, h) + aoff + m * 2048 + k * 1024); } while (0)
#define PG8_LDB(dst, b, h) do { _Pragma("unroll") for (int n = 0; n < 2; ++n) _Pragma("unroll") for (int k = 0; k < 2; ++k) dst[n][k] = *(const LAS bf16x8*)(lds + PG8_SB(b, h) + boff + n * 2048 + k * 1024); } while (0)
#define PG8_MMA(ai, bj, At, Bt) do { __builtin_amdgcn_s_setprio(1); _Pragma("unroll") for (int m = 0; m < 4; ++m) _Pragma("unroll") for (int n = 0; n < 2; ++n) _Pragma("unroll") for (int k = 0; k < 2; ++k) \
        acc[ai][bj][m][n] = __builtin_amdgcn_mfma_f32_16x16x32_bf16(Bt[n][k], At[m][k], acc[ai][bj][m][n], 0, 0, 0); __builtin_amdgcn_s_setprio(0); } while (0)
#define PG8_WAIT_V(n) asm volatile("s_waitcnt vmcnt(" #n ")" ::: "memory")
#define PG8_WAIT_L(n) asm volatile("s_waitcnt lgkmcnt(" #n ")" ::: "memory")
#define PG8_BAR __builtin_amdgcn_s_barrier()
#define PG8_SCHED __builtin_amdgcn_sched_barrier(0)
    Unit cur, nxt; int ui = 0;
    if (!S.next(0, cur)) return;
    f32x4 acc[2][2][4][2];
#pragma unroll
    for (int a = 0; a < 2; ++a)
#pragma unroll
        for (int b = 0; b < 2; ++b)
#pragma unroll
            for (int m = 0; m < 4; ++m)
#pragma unroll
                for (int n = 0; n < 2; ++n) acc[a][b][m][n] = (f32x4){0.f, 0.f, 0.f, 0.f};
    bf16x8 At[4][2], B0[2][2], B1[2][2];
    const char* cA = cur.a; const char* cB = cur.b;
    unsigned c00, c01, c10, c11, n00, n01, n10, n11;
    if constexpr (GATHER) {
        c00 = S.arow(cur, Ra[0]) + Ca[0] * 2u; c01 = S.arow(cur, Ra[1]) + Ca[1] * 2u; c10 = S.arow(cur, HALF + Ra[0]) + Ca[0] * 2u; c11 = S.arow(cur, HALF + Ra[1]) + Ca[1] * 2u;
        asm volatile("s_waitcnt vmcnt(0)" : "+v"(c00), "+v"(c01), "+v"(c10), "+v"(c11) :: "memory");
    } else {
        c00 = (unsigned)(Ra[0] * g.lda + Ca[0]) * 2u; c01 = (unsigned)(Ra[1] * g.lda + Ca[1]) * 2u; c10 = c00 + (unsigned)(HALF * g.lda * 2); c11 = c01 + (unsigned)(HALF * g.lda * 2);
    }
    n00 = c00; n01 = c01; n10 = c10; n11 = c11;
    PG8_STAGE(PG8_SB(0, 0), cB, voffB); PG8_STAGE(PG8_SB(0, 1), cB + hstepB, voffB); PG8_STAGEA(PG8_SA(0, 0), cA, c00, c01); PG8_STAGEA(PG8_SA(0, 1), cA, c10, c11);
    if (wr == 1) PG8_BAR;
    PG8_WAIT_V(2); PG8_BAR;
    PG8_STAGE(PG8_SB(1, 0), cB + kstep, voffB); PG8_STAGEA(PG8_SA(1, 0), cA + kstep, c00, c01); PG8_STAGE(PG8_SB(1, 1), cB + hstepB + kstep, voffB);
    PG8_WAIT_V(6); PG8_BAR;
    for (;;) {
        const bool has_next = S.next(ui + 1, nxt);
        const char* nA = has_next ? nxt.a : cA; const char* nB = has_next ? nxt.b : cB;
        if constexpr (GATHER) {
            if (has_next) { n00 = S.arow(nxt, Ra[0]) + Ca[0] * 2u; n01 = S.arow(nxt, Ra[1]) + Ca[1] * 2u; n10 = S.arow(nxt, HALF + Ra[0]) + Ca[0] * 2u; n11 = S.arow(nxt, HALF + Ra[1]) + Ca[1] * 2u; }
            else { n00 = c00; n01 = c01; n10 = c10; n11 = c11; }
            asm volatile("s_waitcnt vmcnt(0)" : "+v"(n00), "+v"(n01), "+v"(n10), "+v"(n11) :: "memory");
        }
        for (int t = 0; t < nt; t += 2) {
            const bool last = (t == nt - 2);
            const char* a1 = cA + (size_t)(t + 1) * kstep;
            const char* a2 = last ? nA : cA + (size_t)(t + 2) * kstep; const char* b2 = last ? nB : cB + (size_t)(t + 2) * kstep;
            const char* a3 = a2 + kstep; const char* b3 = b2 + kstep;
            const unsigned x00 = (GATHER && last) ? n00 : c00, x01 = (GATHER && last) ? n01 : c01, x10 = (GATHER && last) ? n10 : c10, x11 = (GATHER && last) ? n11 : c11;
            PG8_LDB(B0, 0, 0); PG8_LDB(B1, 0, 1); PG8_SCHED; PG8_LDA(At, 0, 0); PG8_STAGEA(PG8_SA(1, 1), a1, c10, c11);
            PG8_WAIT_V(8); PG8_WAIT_L(0); PG8_BAR; PG8_MMA(0, 0, At, B0); PG8_MMA(0, 1, At, B1); PG8_BAR; PG8_SCHED;
            PG8_LDA(At, 0, 1); PG8_STAGE(PG8_SB(0, 0), b2, voffB); PG8_STAGE(PG8_SB(0, 1), b2 + hstepB, voffB); PG8_STAGEA(PG8_SA(0, 0), a2, x00, x01);
            PG8_WAIT_V(8); PG8_WAIT_L(0); PG8_BAR; PG8_MMA(1, 0, At, B0); PG8_MMA(1, 1, At, B1); PG8_BAR; PG8_SCHED;
            PG8_LDB(B0, 1, 0); PG8_LDB(B1, 1, 1); PG8_SCHED; PG8_LDA(At, 1, 0); PG8_STAGEA(PG8_SA(0, 1), a2, x10, x11);
            PG8_WAIT_V(8); PG8_WAIT_L(0); PG8_BAR; PG8_MMA(0, 0, At, B0); PG8_MMA(0, 1, At, B1); PG8_BAR; PG8_SCHED;
            PG8_LDA(At, 1, 1); PG8_STAGE(PG8_SB(1, 0), b3, voffB); PG8_STAGE(PG8_SB(1, 1), b3 + hstepB, voffB); PG8_STAGEA(PG8_SA(1, 0), a3, x00, x01);
            PG8_WAIT_V(8); PG8_WAIT_L(0); PG8_BAR; PG8_MMA(1, 0, At, B0); PG8_MMA(1, 1, At, B1); PG8_BAR; PG8_SCHED;
        }
        if (wr == 0) PG8_BAR;
        E(acc, cur, wr, wc, fr, fq);
        if (!has_next) break;
#pragma unroll
        for (int a = 0; a < 2; ++a)
#pragma unroll
            for (int b = 0; b < 2; ++b)
#pragma unroll
                for (int m = 0; m < 4; ++m)
#pragma unroll
                    for (int n = 0; n < 2; ++n) acc[a][b][m][n] = (f32x4){0.f, 0.f, 0.f, 0.f};
        cur = nxt; cA = nA; cB = nB; ++ui;
        c00 = n00; c01 = n01; c10 = n10; c11 = n11;
        if (wr == 1) PG8_BAR;
    }
    PG8_WAIT_V(0);
    PG8_BAR;
#undef PG8_SA
#undef PG8_SB
#undef PG8_STAGE
#undef PG8_STAGEA
#undef PG8_LDA
#undef PG8_LDB
#undef PG8_MMA
#undef PG8_WAIT_V
#undef PG8_WAIT_L
#undef PG8_BAR
#undef PG8_SCHED
}

typedef const f32x4 (&AccRef)[2][2][4][2];
__device__ __forceinline__ v4u pack8(const f32x4 a, const f32x4 b) { v4u w; w.x = pk2(a[0], a[1]); w.y = pk2(a[2], a[3]); w.z = pk2(b[0], b[1]); w.w = pk2(b[2], b[3]); return w; }

struct EpiProj {
    static constexpr bool PERM = true;
    bf16* PROJ; bf16* UA;
    __device__ __forceinline__ void operator()(AccRef acc, const Unit& u, int wr, int wc, int fr, int fq) const {
        const int row0 = u.r0 + wr * 64 + fr, colb = u.c0 + wc * 32 + 8 * fq;
        const bool isu = (u.c0 == 1280 || u.c0 == 1536);
#pragma unroll
        for (int ai = 0; ai < 2; ++ai)
#pragma unroll
            for (int m = 0; m < 4; ++m) { const int row = row0 + ai * HALF + m * 16;
#pragma unroll
                for (int bj = 0; bj < 2; ++bj) { const int col = colb + bj * HALF; const v4u w = pack8(acc[ai][bj][m][0], acc[ai][bj][m][1]);
                    if (!isu) *(v4u*)(PROJ + (size_t)row * INC + col) = w;
                    else { const int cc = col - 1280, g = cc >> 4, c0 = cc & 15; *(v4u*)(UA + ((size_t)(g * 512 + (row >> 5)) * S5K + (row & 31) * 16 + c0)) = w; } } }
    }
};
struct EpiBf16 {
    static constexpr bool PERM = true;
    bf16* O; int ldc;
    __device__ __forceinline__ void operator()(AccRef acc, const Unit& u, int wr, int wc, int fr, int fq) const {
        const int row0 = u.r0 + wr * 64 + fr, colb = u.c0 + wc * 32 + 8 * fq;
#pragma unroll
        for (int ai = 0; ai < 2; ++ai)
#pragma unroll
            for (int m = 0; m < 4; ++m) { bf16* rowp = O + (size_t)(row0 + ai * HALF + m * 16) * ldc + colb;
#pragma unroll
                for (int bj = 0; bj < 2; ++bj) *(v4u*)(rowp + bj * HALF) = pack8(acc[ai][bj][m][0], acc[ai][bj][m][1]); }
    }
};
struct EpiF32 {
    static constexpr bool PERM = false;
    float* C; int ldc; size_t gstride;
    __device__ __forceinline__ void operator()(AccRef acc, const Unit& u, int wr, int wc, int fr, int fq) const {
        const int row0 = u.r0 + wr * 64 + fr, col0 = u.c0 + wc * 32 + 4 * fq; float* base = C + (size_t)u.aux * gstride;
#pragma unroll
        for (int ai = 0; ai < 2; ++ai)
#pragma unroll
            for (int m = 0; m < 4; ++m) { float* rowp = base + (size_t)(row0 + ai * HALF + m * 16) * ldc + col0;
#pragma unroll
                for (int bj = 0; bj < 2; ++bj)
#pragma unroll
                    for (int n = 0; n < 2; ++n) *(f32x4*)(rowp + bj * HALF + n * 16) = acc[ai][bj][m][n]; }
    }
};
struct EpiS5Y {
    static constexpr bool PERM = true;
    const bf16* UA; const float* dsk; bf16* Gm;
    __device__ __forceinline__ void operator()(AccRef acc, const Unit& u, int wr, int wc, int fr, int fq) const {
        const int row0 = u.r0 + wr * 64 + fr, colb = u.c0 + wc * 32 + 8 * fq, g = u.aux;
#pragma unroll
        for (int ai = 0; ai < 2; ++ai)
#pragma unroll
            for (int m = 0; m < 4; ++m) { const int row = row0 + ai * HALF + m * 16;
#pragma unroll
                for (int bj = 0; bj < 2; ++bj) { const int col = colb + bj * HALF, i = col >> 4, c0 = col & 15;
                    const v4u uw = *(const v4u*)(UA + ((size_t)(g * 512 + row) * S5K + col));
                    const f32x4 d0 = *(const f32x4*)(dsk + g * 16 + c0), d1 = *(const f32x4*)(dsk + g * 16 + c0 + 4);
                    const f32x4 a0 = acc[ai][bj][m][0], a1 = acc[ai][bj][m][1];
                    f32x4 y0, y1;
                    y0[0] = gelu_tanh(a0[0] + d0[0] * bflo(uw.x)); y0[1] = gelu_tanh(a0[1] + d0[1] * bfhi(uw.x)); y0[2] = gelu_tanh(a0[2] + d0[2] * bflo(uw.y)); y0[3] = gelu_tanh(a0[3] + d0[3] * bfhi(uw.y));
                    y1[0] = gelu_tanh(a1[0] + d1[0] * bflo(uw.z)); y1[1] = gelu_tanh(a1[1] + d1[1] * bfhi(uw.z)); y1[2] = gelu_tanh(a1[2] + d1[2] * bflo(uw.w)); y1[3] = gelu_tanh(a1[3] + d1[3] * bfhi(uw.w));
                    *(v4u*)(Gm + ((size_t)row * 32 + i) * 512 + g * 16 + c0) = pack8(y0, y1); } }
    }
};
struct EpiGlu {
    static constexpr bool PERM = true;
    const bf16* Gm; bf16* MIX;
    __device__ __forceinline__ void operator()(AccRef acc, const Unit& u, int wr, int wc, int fr, int fq) const {
        const int row0 = u.r0 + wr * 64 + fr, colb = u.c0 + wc * 32 + 8 * fq;
#pragma unroll
        for (int ai = 0; ai < 2; ++ai)
#pragma unroll
            for (int m = 0; m < 4; ++m) { const int row = row0 + ai * HALF + m * 16;
#pragma unroll
                for (int bj = 0; bj < 2; ++bj) { const int col = colb + bj * HALF;
                    const v4u gw = *(const v4u*)(Gm + (size_t)row * 512 + col);
                    const f32x4 a0 = acc[ai][bj][m][0], a1 = acc[ai][bj][m][1];
                    f32x4 y0, y1;
                    y0[0] = bflo(gw.x) * sigmoidf_(a0[0]); y0[1] = bfhi(gw.x) * sigmoidf_(a0[1]); y0[2] = bflo(gw.y) * sigmoidf_(a0[2]); y0[3] = bfhi(gw.y) * sigmoidf_(a0[3]);
                    y1[0] = bflo(gw.z) * sigmoidf_(a1[0]); y1[1] = bfhi(gw.z) * sigmoidf_(a1[1]); y1[2] = bflo(gw.w) * sigmoidf_(a1[2]); y1[3] = bfhi(gw.w) * sigmoidf_(a1[3]);
                    *(v4u*)(MIX + (size_t)row * D + 1024 + col) = pack8(y0, y1); } }
    }
};
struct EpiWo {
    static constexpr bool PERM = true;
    const float* X; bf16* X1B; float* part;
    __device__ __forceinline__ void operator()(AccRef acc, const Unit& u, int wr, int wc, int fr, int fq) const {
        const int row0 = u.r0 + wr * 64 + fr, col0 = u.c0 + wc * 32 + 8 * fq;
#pragma unroll
        for (int ai = 0; ai < 2; ++ai) {
            f32x4 xv[4][2][2];
#pragma unroll
            for (int m = 0; m < 4; ++m)
#pragma unroll
                for (int bj = 0; bj < 2; ++bj)
#pragma unroll
                    for (int n = 0; n < 2; ++n) xv[m][bj][n] = __builtin_nontemporal_load((const f32x4*)(X + (size_t)(row0 + ai * HALF + m * 16) * D + col0 + bj * HALF + n * 4));
#pragma unroll
            for (int m = 0; m < 4; ++m) { const int row = row0 + ai * HALF + m * 16; const size_t off = (size_t)row * D + col0; float ss = 0.f;
#pragma unroll
                for (int bj = 0; bj < 2; ++bj) { const f32x4 v0 = xv[m][bj][0] + acc[ai][bj][m][0], v1 = xv[m][bj][1] + acc[ai][bj][m][1];
                    ss += ((v0[0] * v0[0] + v0[1] * v0[1]) + (v0[2] * v0[2] + v0[3] * v0[3])) + ((v1[0] * v1[0] + v1[1] * v1[1]) + (v1[2] * v1[2] + v1[3] * v1[3]));
                    *(v4u*)(X1B + off + bj * HALF) = pack8(v0, v1); }
                ss += __shfl_xor(ss, 16); ss += __shfl_xor(ss, 32);
                if (fq == 0) part[(size_t)row * 32 + (u.c0 >> 8) * 4 + wc] = ss; }
            asm volatile("" ::: "memory");
        }
    }
};
struct EpiLogit {
    static constexpr bool PERM = false;
    float* LP;
    __device__ __forceinline__ void operator()(AccRef acc, const Unit& u, int wr, int wc, int fr, int fq) const {
        const int row0 = u.r0 + wr * 64 + fr, col0 = wc * 32 + 4 * fq; float* base = LP + (size_t)u.aux * T * 80;
#pragma unroll
        for (int ai = 0; ai < 2; ++ai)
#pragma unroll
            for (int m = 0; m < 4; ++m) { float* rowp = base + (size_t)(row0 + ai * HALF + m * 16) * 80 + col0;
#pragma unroll
                for (int n = 0; n < 2; ++n) if (col0 + n * 16 < 80) *(f32x4*)(rowp + n * 16) = acc[ai][0][m][n]; }
    }
};
struct EpiGU {
    static constexpr bool PERM = true;
    const int* list; const float* rstd; const LAS int* cnt; bf16* ACT;
    __device__ __forceinline__ void operator()(AccRef acc, const Unit& u, int wr, int wc, int fr, int fq) const {
        const int e = u.aux, nreal = cnt[e], rb = wr * 64 + fr, colb = u.c0 * 128 + wc * 32 + 8 * fq;
#pragma unroll
        for (int ai = 0; ai < 2; ++ai)
#pragma unroll
            for (int m = 0; m < 4; ++m) { const int r = rb + ai * HALF + m * 16; int rr = u.r1 + r; rr = rr < nreal ? rr : nreal - 1;
                const float rs = rstd[list[(size_t)e * LCAP + rr] >> 1];
                f32x4 y0, y1;
#pragma unroll
                for (int j = 0; j < 4; ++j) { const float g0 = acc[ai][0][m][0][j] * rs, g1 = acc[ai][0][m][1][j] * rs;
                    y0[j] = g0 * sigmoidf_(g0) * (acc[ai][1][m][0][j] * rs); y1[j] = g1 * sigmoidf_(g1) * (acc[ai][1][m][1][j] * rs); }
                *(v4u*)(ACT + (size_t)(u.r0 + r) * DEXP + colb) = pack8(y0, y1); }
    }
};
struct EpiDown {
    static constexpr bool PERM = true;
    const int* list; const float* wts; const LAS int* cnt; bf16* Y2;
    __device__ __forceinline__ void operator()(AccRef acc, const Unit& u, int wr, int wc, int fr, int fq) const {
        const int e = u.aux, n = cnt[e], row0 = u.r1 + wr * 64 + fr, colb = u.c0 * 256 + wc * 32 + 8 * fq;
#pragma unroll
        for (int ai = 0; ai < 2; ++ai)
#pragma unroll
            for (int m = 0; m < 4; ++m) { const int r = row0 + ai * HALF + m * 16;
                if (r < n) { const int ent = list[(size_t)e * LCAP + r]; const float w = wts[ent]; bf16* rowp = Y2 + (size_t)ent * D + colb;
#pragma unroll
                    for (int bj = 0; bj < 2; ++bj) *(v4u*)(rowp + bj * HALF) = pack8(acc[ai][bj][m][0] * w, acc[ai][bj][m][1] * w); } }
    }
};
struct KSplitOrder {
    const char* A; const char* Bt; int lda, ldb, K, nM, nks, G, c;
    __device__ bool next(int i, Unit& u) const {
        const int L = i * G + c; if (L >= nM * nks) return false;
        const int pm = L / nks, ks = L % nks;
        u.a = A + ((size_t)pm * BM * lda + (size_t)ks * K) * 2; u.b = Bt + (size_t)ks * BM * ldb * 2; u.r0 = pm * BM; u.c0 = 0; u.aux = ks; u.r1 = 0; return true;
    }
    __device__ __forceinline__ unsigned arow(const Unit&, int) const { return 0u; }
};
}

struct Frame {
    LAS unsigned char* lds;
    unsigned* ctl;
    int tid, lane, wave, vcu, G;
    const float* in[31]; float* out; unsigned char* ws;
};
enum { I_X = 0, I_MEM, I_NORM_MIX, I_W_IN, I_Q_NORM, I_K_NORM, I_SINKS, I_REL_BIAS, I_LAM_RE, I_LAM_IM, I_LOG_DT, I_B_RE, I_B_IM, I_C_RE, I_C_IM, I_SSM_D, I_W_GLU,
       I_MEM_NORM, I_W_MEM_KV, I_XQ_NORM, I_XK_NORM, I_ON_ATTN, I_ON_SSM, I_ON_X, I_W_O, I_NORM_FFN, I_WR_G, I_WR_E, I_W_GATE, I_W_UP, I_W_DOWN };

struct TrItem { const float* W; bf16* WT; const float* ks; int ldw, ldt, k0, n0, drow0; };
__device__ __forceinline__ void tr_load(const TrItem& it, f32x4 (&v)[8], int lane) {
    const int kc = lane & 7, nq = lane >> 3; const float* src = it.W + (size_t)(it.k0 + kc * 8) * it.ldw + it.n0 + nq * 4;
#pragma unroll
    for (int j = 0; j < 8; ++j) v[j] = __builtin_nontemporal_load((const f32x4*)(src + (size_t)j * it.ldw));
}
__device__ __forceinline__ void tr_store(const TrItem& it, f32x4 (&v)[8], int lane) {
    const int kc = lane & 7, nq = lane >> 3;
    if (it.ks) { const f32x4 s0 = *(const f32x4*)(it.ks + it.k0 + kc * 8), s1 = *(const f32x4*)(it.ks + it.k0 + kc * 8 + 4);
#pragma unroll
        for (int j = 0; j < 4; ++j) { v[j] = v[j] * s0[j]; v[4 + j] = v[4 + j] * s1[j]; } }
#pragma unroll
    for (int i = 0; i < 4; ++i) { v4u o; o.x = pk2(v[0][i], v[1][i]); o.y = pk2(v[2][i], v[3][i]); o.z = pk2(v[4][i], v[5][i]); o.w = pk2(v[6][i], v[7][i]);
        *(v4u*)(it.WT + (size_t)(it.drow0 + nq * 4 + i) * it.ldt + it.k0 + kc * 8) = o; }
}
__device__ __forceinline__ void rms_row_to_bf16(const float* xrow, const float* gain, bf16* orow, int lane) {
    const f32x4* xr = (const f32x4*)xrow + lane; const f32x4* gr = (const f32x4*)gain + lane;
    f32x4 v[8]; float s = 0.f;
#pragma unroll
    for (int j = 0; j < 8; ++j) { v[j] = xr[64 * j]; s += (v[j].x * v[j].x + v[j].y * v[j].y) + (v[j].z * v[j].z + v[j].w * v[j].w); }
    const float rstd = 1.0f / sqrtf(wave_sum(s) * (1.f / 2048.f) + EPS);
    v2u* o8 = (v2u*)orow + lane;
#pragma unroll
    for (int j = 0; j < 8; ++j) { const f32x4 g = gr[64 * j]; v2u w; w.x = pk2(v[j].x * rstd * g.x, v[j].y * rstd * g.y); w.y = pk2(v[j].z * rstd * g.z, v[j].w * rstd * g.w); o8[64 * j] = w; }
}

__device__ __forceinline__ void s5_tables(Frame& F, int g) {
    LAS float* ap = (LAS float*)F.lds;
    LAS float* Bb = ap + 33 * 64 * 2;
    LAS float* Cc = Bb + 64 * 16 * 2;
    LAS float* Km = Cc + 16 * 64 * 2;
    const float dt = expf(F.in[I_LOG_DT][g]);
    const float* lre = F.in[I_LAM_RE] + g * 64; const float* lim = F.in[I_LAM_IM] + g * 64;
    for (int idx = F.tid; idx < 33 * 64; idx += 512) { const int tau = idx >> 6, n = idx & 63; const float lr = lre[n], li = lim[n];
        const float mag = expf((float)tau * (lr * dt)), ang = (float)tau * (li * dt); ap[idx * 2] = mag * cosf(ang); ap[idx * 2 + 1] = mag * sinf(ang); }
    __syncthreads();
    for (int idx = F.tid; idx < 64 * 16; idx += 512) { const int n = idx >> 4; const float lr = lre[n], li = lim[n];
        const float nr = ap[(64 + n) * 2] - 1.0f, ni = ap[(64 + n) * 2 + 1], den = lr * lr + li * li;
        const float cr = (nr * lr + ni * li) / den, ci = (ni * lr - nr * li) / den;
        const float br = F.in[I_B_RE][(size_t)g * 1024 + idx], bi = F.in[I_B_IM][(size_t)g * 1024 + idx];
        Bb[idx * 2] = cr * br - ci * bi; Bb[idx * 2 + 1] = cr * bi + ci * br; }
    for (int idx = F.tid; idx < 16 * 64; idx += 512) { Cc[idx * 2] = F.in[I_C_RE][(size_t)g * 1024 + idx]; Cc[idx * 2 + 1] = F.in[I_C_IM][(size_t)g * 1024 + idx]; }
    __syncthreads();
    for (int idx = F.tid; idx < 32 * 256; idx += 512) { const int tau = idx >> 8, c = (idx >> 4) & 15, c2 = idx & 15; float s = 0.f;
        for (int n = 0; n < 64; ++n) { const float ar = ap[(tau * 64 + n) * 2], ai = ap[(tau * 64 + n) * 2 + 1], cr = Cc[(c * 64 + n) * 2], ci = Cc[(c * 64 + n) * 2 + 1];
            const float er = cr * ar - ci * ai, ei = cr * ai + ci * ar; s += er * Bb[(n * 16 + c2) * 2] - ei * Bb[(n * 16 + c2) * 2 + 1]; }
        Km[idx] = s; }
    __syncthreads();
    bf16* MQ = (bf16*)(F.ws + WS_MQ) + (size_t)g * 512 * S5K;
    for (int idx = F.tid; idx < 512 * 80; idx += 512) { const int row = idx / 80, ch = idx % 80, i = row >> 4, c = row & 15, k0 = ch * 8; float v[8];
        if (k0 < 512) { const int s = k0 >> 4, c20 = k0 & 15, tau = i - s;
#pragma unroll
            for (int j = 0; j < 8; ++j) v[j] = tau >= 0 ? Km[(tau * 16 + c) * 16 + c20 + j] : 0.f;
        } else { const int kk = k0 - 512, ri = kk >> 6, n0 = kk & 63;
#pragma unroll
            for (int j = 0; j < 8; ++j) { const int n = n0 + j; const float ar = ap[((i + 1) * 64 + n) * 2], ai = ap[((i + 1) * 64 + n) * 2 + 1], cr = Cc[(c * 64 + n) * 2], ci = Cc[(c * 64 + n) * 2 + 1];
                v[j] = ri == 0 ? (cr * ar - ci * ai) : -(cr * ai + ci * ar); } }
        v4u o; o.x = pk2(v[0], v[1]); o.y = pk2(v[2], v[3]); o.z = pk2(v[4], v[5]); o.w = pk2(v[6], v[7]);
        *(v4u*)(MQ + (size_t)row * S5K + k0) = o; }
    bf16* SP = (bf16*)(F.ws + WS_SP) + (size_t)g * 256 * 512;
    for (int idx = F.tid; idx < 256 * 64; idx += 512) { const int row = idx >> 6, k0 = (idx & 63) * 8; float v[8];
        if (row < 128) { const int ri = row >> 6, n = row & 63, s = k0 >> 4, c20 = k0 & 15; const float ar = ap[((31 - s) * 64 + n) * 2], ai = ap[((31 - s) * 64 + n) * 2 + 1];
#pragma unroll
            for (int j = 0; j < 8; ++j) { const float br = Bb[(n * 16 + c20 + j) * 2], bi = Bb[(n * 16 + c20 + j) * 2 + 1]; v[j] = ri == 0 ? (ar * br - ai * bi) : (ar * bi + ai * br); }
        } else {
#pragma unroll
            for (int j = 0; j < 8; ++j) v[j] = 0.f; }
        v4u o; o.x = pk2(v[0], v[1]); o.y = pk2(v[2], v[3]); o.z = pk2(v[4], v[5]); o.w = pk2(v[6], v[7]);
        *(v4u*)(SP + (size_t)row * 512 + k0) = o; }
    float* AL = (float*)(F.ws + WS_AL) + g * 128;
    if (F.tid < 64) { AL[F.tid * 2] = ap[(32 * 64 + F.tid) * 2]; AL[F.tid * 2 + 1] = ap[(32 * 64 + F.tid) * 2 + 1]; }
    __syncthreads();
}

struct BigTile { const float* src; bf16* dst; const float* ks; int ldw, ldt; };
constexpr int BT_GU = 64 * 2 * 64, BT_D = 64 * 64, BT_N = BT_GU + BT_D, BT_PITCH = 260;
__device__ __forceinline__ BigTile bt_decode(const Frame& F, bf16* WguT, bf16* WdT, const float* nf, int ti) {
    BigTile t;
    const unsigned long long pg = (unsigned long long)F.in[I_W_GATE], pu = (unsigned long long)F.in[I_W_UP], pd = (unsigned long long)F.in[I_W_DOWN];
    if (ti < BT_GU) { const int e = ti >> 7, r = ti & 127, which = r >> 6, kb = (r >> 2) & 15, nb = r & 3;
        const unsigned long long p = pg + ((pu - pg) & (0ull - (unsigned long long)which));
        t.src = (const float*)p + (size_t)e * D * DEXP + (size_t)kb * 128 * DEXP + nb * 128; t.dst = WguT + ((size_t)e * 1024 + nb * 256 + which * 128) * D + kb * 128; t.ks = nf + kb * 128; t.ldw = DEXP; t.ldt = D; }
    else { const int t2 = ti - BT_GU, e = t2 >> 6, r = t2 & 63, kb = r >> 4, nb = r & 15;
        t.src = (const float*)pd + (size_t)e * DEXP * D + (size_t)kb * 128 * D + nb * 128; t.dst = WdT + ((size_t)e * D + nb * 128) * DEXP + kb * 128; t.ks = nullptr; t.ldw = D; t.ldt = DEXP; }
    return t;
}
#define BT_LOAD(t, v, kv) do { const unsigned _lo = (unsigned)(rl * (t).ldw + cq * 4); \
    _Pragma("unroll") for (int _p = 0; _p < 8; ++_p) kv[_p] = (t).ks ? (t).ks[_p * 16 + rl] : 1.0f; \
    _Pragma("unroll") for (int _p = 0; _p < 8; ++_p) v[_p] = __builtin_nontemporal_load((const f32x4*)((t).src + (size_t)_p * 16 * (t).ldw + _lo)); } while (0)
#define BT_STORE(t, v, kv) do { \
    _Pragma("unroll") for (int _p = 0; _p < 8; ++_p) { const int _r = _p * 16 + rl; const f32x4 _x = v[_p] * kv[_p]; \
        const unsigned _w0 = pk2(_x[0], _x[1]), _w1 = pk2(_x[2], _x[3]); LAS bf16* _q = (LAS bf16*)(img + (cq * 4) * BT_PITCH + _r * 2); \
        _q[0] = (bf16)(_w0 & 0xffffu); _q[BT_PITCH / 2] = (bf16)(_w0 >> 16); _q[2 * (BT_PITCH / 2)] = (bf16)(_w1 & 0xffffu); _q[3 * (BT_PITCH / 2)] = (bf16)(_w1 >> 16); } \
    __syncthreads(); \
    { const unsigned _so = (unsigned)((rl * 2 + (cq >> 4)) * (t).ldt + (cq & 15) * 8); \
    _Pragma("unroll") for (int _q4 = 0; _q4 < 4; ++_q4) { const int _n = _q4 * 32 + rl * 2 + (cq >> 4); const LAS unsigned* _rp = (const LAS unsigned*)(img + _n * BT_PITCH + (cq & 15) * 16); \
        v4u _o; _o.x = _rp[0]; _o.y = _rp[1]; _o.z = _rp[2]; _o.w = _rp[3]; *(v4u*)((t).dst + (size_t)_q4 * 32 * (t).ldt + _so) = _o; } } \
    __syncthreads(); } while (0)
__device__ __forceinline__ void bg_convert(Frame& F, int qword, int base, int ntiles, int budget) {
    if (budget <= 0) return;
    bf16* WguT = (bf16*)(F.ws + WS_WGU); bf16* WdT = (bf16*)(F.ws + WS_WD); const float* nf = F.in[I_NORM_FFN];
    const int rl = F.tid >> 5, cq = F.tid & 31; LAS unsigned char* img = F.lds; LAS int* qn = (LAS int*)(F.lds + TAB_OFF + 1024);
    f32x4 va[8], vb[8]; float ka[8], kb[8];
    int nfetch = 0;
#define BG_FETCH(slot) do { if (nfetch < budget) { if (F.tid == 0) qn[slot] = (int)atomicAdd(F.ctl + qword, 1u); } else if (F.tid == 0) qn[slot] = 0x7fffffff; ++nfetch; } while (0)
    __syncthreads();
    BG_FETCH(0); BG_FETCH(1);
    __syncthreads();
    int i0 = __builtin_amdgcn_readfirstlane(qn[0]), i1 = __builtin_amdgcn_readfirstlane(qn[1]);
    __syncthreads();
    if (i0 < ntiles) { const BigTile t0 = bt_decode(F, WguT, WdT, nf, base + i0); BT_LOAD(t0, va, ka); }
    while (i0 < ntiles) {
        const BigTile ta = bt_decode(F, WguT, WdT, nf, base + i0);
        const BigTile tb = bt_decode(F, WguT, WdT, nf, base + (i1 < ntiles ? i1 : i0));
        BT_LOAD(tb, vb, kb);
        if (i1 >= ntiles) budget = 0;
        BG_FETCH(0);
        BT_STORE(ta, va, ka);
        const int i2 = __builtin_amdgcn_readfirstlane(qn[0]);
        if (i1 >= ntiles) break;
        const BigTile tc = bt_decode(F, WguT, WdT, nf, base + (i2 < ntiles ? i2 : i1));
        BT_LOAD(tc, va, ka);
        if (i2 >= ntiles) budget = 0;
        BG_FETCH(1);
        BT_STORE(tb, vb, kb);
        const int i3 = __builtin_amdgcn_readfirstlane(qn[1]);
        i0 = i2; i1 = i3;
    }
    __syncthreads();
#undef BG_FETCH
}
__device__ __forceinline__ void p0_prologue(Frame& F) {
    if (F.vcu < 32) s5_tables(F, F.vcu);
    const int gw = F.vcu * 8 + F.wave, NGW = F.G * 8;
    bf16* WinT = (bf16*)(F.ws + WS_WIN); bf16* WoT = (bf16*)(F.ws + WS_WO); bf16* WmkvT = (bf16*)(F.ws + WS_WMKV); bf16* WgluT = (bf16*)(F.ws + WS_WGLU);
    const float* nf = F.in[I_NORM_FFN];
    constexpr int I_IN = 32 * 72, I_O = 32 * 64, I_MKV = 32 * 32, I_GLU = 8 * 16;
    constexpr int NITEMS = I_IN + I_O + I_MKV + I_GLU;
    auto decode = [&](int it) -> TrItem {
        int r = it;
        if (r < I_IN) { const int kb = r / 72, nb = r % 72; return TrItem{F.in[I_W_IN], WinT, nullptr, INC, D, kb * 64, nb * 32, nb * 32}; } r -= I_IN;
        if (r < I_O) { const int kb = r / 64, nb = r % 64; return TrItem{F.in[I_W_O], WoT, nullptr, D, D, kb * 64, nb * 32, nb * 32}; } r -= I_O;
        if (r < I_MKV) { const int kb = r / 32, nb = r % 32; return TrItem{F.in[I_W_MEM_KV], WmkvT, nullptr, 1024, D, kb * 64, nb * 32, nb * 32}; } r -= I_MKV;
        const int kb = r / 16, nb = r % 16; return TrItem{F.in[I_W_GLU], WgluT, nullptr, 512, 512, kb * 64, nb * 32, nb * 32};
    };
    {
        f32x4 va[8], vb[8]; int it = gw; TrItem ia, ib;
        if (it < NITEMS) { ia = decode(it); tr_load(ia, va, F.lane); }
        while (it < NITEMS) {
            const int it2 = it + NGW; if (it2 < NITEMS) { ib = decode(it2); tr_load(ib, vb, F.lane); }
            tr_store(ia, va, F.lane);
            if (it2 >= NITEMS) break;
            const int it3 = it2 + NGW; if (it3 < NITEMS) { ia = decode(it3); tr_load(ia, va, F.lane); }
            tr_store(ib, vb, F.lane);
            it = it3;
        }
    }
    { bf16* WrT = (bf16*)(F.ws + WS_WR); const int gt = F.vcu * 512 + F.tid, NT = F.G * 512;
      for (int idx = gt; idx < 4 * 256 * 512; idx += NT) { const int ks = idx >> 17, n = (idx >> 9) & 255, k = ks * 512 + (idx & 511); float v = 0.f;
          if (n < 8) v = F.in[I_WR_G][k * 8 + n] * nf[k]; else if (n < 72) v = F.in[I_WR_E][k * 64 + (n - 8)] * nf[k];
          WrT[idx] = (bf16)f2bf(v); } }
    bf16* XN = (bf16*)(F.ws + WS_XN); bf16* MEMN = (bf16*)(F.ws + WS_MEMN);
    for (int m = gw; m < T; m += NGW) rms_row_to_bf16(F.in[I_X] + (size_t)m * D, F.in[I_NORM_MIX], XN + (size_t)m * D, F.lane);
    for (int m = gw; m < NB * MEML; m += NGW) rms_row_to_bf16(F.in[I_MEM] + (size_t)m * D, F.in[I_MEM_NORM], MEMN + (size_t)m * D, F.lane);
    bg_convert(F, CW_QGU, 0, BT_GU, F.vcu < 32 ? PB0_S5 : PB0);
    bg_convert(F, CW_QD, BT_GU, BT_D, PB0_D);
}

constexpr int SWA_KS = 72, SWA_VS = 264;
constexpr int SWA_KOFF = 0, SWA_VOFF = 256 * SWA_KS * 2, SWA_BOFF = SWA_VOFF + 64 * SWA_VS * 2;
__device__ __forceinline__ int t5_bucket(int n) { if (n < 16) return n; const int v = 16 + (int)(logf((float)n * (1.0f / 16.0f)) / logf(8.0f) * 16.0f); return v < 31 ? v : 31; }
__device__ __forceinline__ void swa_unit(Frame& F, int unit) {
    const int b = unit >> 5, kvh = (unit >> 4) & 1, nb = unit & 15;
    const bf16* PROJ = (const bf16*)(F.ws + WS_PROJ); bf16* MIX = (bf16*)(F.ws + WS_MIX);
    LAS bf16* Ks = (LAS bf16*)(F.lds + SWA_KOFF); LAS bf16* Vt = (LAS bf16*)(F.lds + SWA_VOFF); LAS float* bt = (LAS float*)(F.lds + SWA_BOFF);
    __syncthreads();
    {
        const int key = F.tid >> 1, half = F.tid & 1, s = (nb - 1) * 128 + key;
        v4u kw[4], vw[4];
        if (s >= 0) { const bf16* rp = PROJ + (size_t)(b * SEQ + s) * INC + 1024 + kvh * 64 + half * 32;
#pragma unroll
            for (int j = 0; j < 4; ++j) { kw[j] = *(const v4u*)(rp + j * 8); vw[j] = *(const v4u*)(rp + 128 + j * 8); }
        } else {
#pragma unroll
            for (int j = 0; j < 4; ++j) { kw[j] = (v4u){0u, 0u, 0u, 0u}; vw[j] = (v4u){0u, 0u, 0u, 0u}; } }
        float kf[32]; float ss = 0.f;
#pragma unroll
        for (int j = 0; j < 4; ++j) { kf[j * 8 + 0] = bflo(kw[j].x); kf[j * 8 + 1] = bfhi(kw[j].x); kf[j * 8 + 2] = bflo(kw[j].y); kf[j * 8 + 3] = bfhi(kw[j].y);
            kf[j * 8 + 4] = bflo(kw[j].z); kf[j * 8 + 5] = bfhi(kw[j].z); kf[j * 8 + 6] = bflo(kw[j].w); kf[j * 8 + 7] = bfhi(kw[j].w); }
#pragma unroll
        for (int j = 0; j < 32; ++j) ss += kf[j] * kf[j];
        ss += __shfl_xor(ss, 1);
        const float rstd = 1.0f / sqrtf(ss * (1.f / 64.f) + EPS);
        const float* kn = F.in[I_K_NORM] + half * 32;
#pragma unroll
        for (int j = 0; j < 4; ++j) { v4u o; o.x = pk2(kf[j * 8 + 0] * rstd * kn[j * 8 + 0], kf[j * 8 + 1] * rstd * kn[j * 8 + 1]); o.y = pk2(kf[j * 8 + 2] * rstd * kn[j * 8 + 2], kf[j * 8 + 3] * rstd * kn[j * 8 + 3]);
            o.z = pk2(kf[j * 8 + 4] * rstd * kn[j * 8 + 4], kf[j * 8 + 5] * rstd * kn[j * 8 + 5]); o.w = pk2(kf[j * 8 + 6] * rstd * kn[j * 8 + 6], kf[j * 8 + 7] * rstd * kn[j * 8 + 7]);
            *(LAS v4u*)(Ks + key * SWA_KS + half * 32 + j * 8) = o; }
#pragma unroll
        for (int j = 0; j < 4; ++j) { const unsigned w4[4] = {vw[j].x, vw[j].y, vw[j].z, vw[j].w};
#pragma unroll
            for (int q = 0; q < 4; ++q) { const int d = half * 32 + j * 8 + q * 2; Vt[d * SWA_VS + key] = (bf16)(w4[q] & 0xffffu); Vt[(d + 1) * SWA_VS + key] = (bf16)(w4[q] >> 16); } }
        for (int idx = F.tid; idx < 8 * 128; idx += 512) { const int w = idx >> 7, dl = idx & 127; bt[idx] = F.in[I_REL_BIAS][t5_bucket(dl) * 16 + kvh * 8 + w]; }
    }
    __syncthreads();
    const int w = F.wave, h = kvh * 8 + w, ql = F.lane & 31, hh = F.lane >> 5;
    const float sink = F.in[I_SINKS][h];
    const float* qn = F.in[I_Q_NORM];
    for (int r = 0; r < 4; ++r) {
        const int qi = 32 * r + ql; const size_t t = (size_t)b * SEQ + nb * 128 + qi;
        bf16x8 qf[4];
        {   const bf16* qp = PROJ + t * INC + h * 64 + 8 * hh; v4u qw[4]; float qv[32]; float ss = 0.f;
#pragma unroll
            for (int ks = 0; ks < 4; ++ks) qw[ks] = *(const v4u*)(qp + ks * 16);
#pragma unroll
            for (int ks = 0; ks < 4; ++ks) { qv[ks * 8 + 0] = bflo(qw[ks].x); qv[ks * 8 + 1] = bfhi(qw[ks].x); qv[ks * 8 + 2] = bflo(qw[ks].y); qv[ks * 8 + 3] = bfhi(qw[ks].y);
                qv[ks * 8 + 4] = bflo(qw[ks].z); qv[ks * 8 + 5] = bfhi(qw[ks].z); qv[ks * 8 + 6] = bflo(qw[ks].w); qv[ks * 8 + 7] = bfhi(qw[ks].w); }
#pragma unroll
            for (int j = 0; j < 32; ++j) ss += qv[j] * qv[j];
            ss += __shfl_xor(ss, 32);
            const float sc = 0.125f / sqrtf(ss * (1.f / 64.f) + EPS);
#pragma unroll
            for (int ks = 0; ks < 4; ++ks) { const float* g = qn + ks * 16 + 8 * hh; v4u o;
                o.x = pk2(qv[ks * 8 + 0] * sc * g[0], qv[ks * 8 + 1] * sc * g[1]); o.y = pk2(qv[ks * 8 + 2] * sc * g[2], qv[ks * 8 + 3] * sc * g[3]);
                o.z = pk2(qv[ks * 8 + 4] * sc * g[4], qv[ks * 8 + 5] * sc * g[5]); o.w = pk2(qv[ks * 8 + 6] * sc * g[6], qv[ks * 8 + 7] * sc * g[7]);
                qf[ks] = __builtin_bit_cast(bf16x8, o); } }
        f32x16 s[5];
        const int qh = ql - 4 * hh; const LAS float* pb = bt + w * 128 + qh;
        float mx = sink;
#pragma unroll
        for (int kt = 0; kt < 5; ++kt) {
            const bool live = (nb > 0) || (r + kt >= 4);
            f32x16 a = {0.f, 0.f, 0.f, 0.f, 0.f, 0.f, 0.f, 0.f, 0.f, 0.f, 0.f, 0.f, 0.f, 0.f, 0.f, 0.f};
            if (live) {
#pragma unroll
                for (int ks = 0; ks < 4; ++ks) { const bf16x8 kfrag = *(const LAS bf16x8*)(Ks + (32 * (r + kt) + ql) * SWA_KS + ks * 16 + 8 * hh);
                    a = __builtin_amdgcn_mfma_f32_32x32x16_bf16(kfrag, qf[ks], a, 0, 0, 0); }
#pragma unroll
                for (int rg = 0; rg < 16; ++rg) { const int rowc = (rg & 3) + 8 * (rg >> 2);
                    float v = a[rg] + pb[128 - 32 * kt - rowc];
                    if (kt == 0) v = (rowc > qh) ? v : -1e30f;
                    if (kt == 4) v = (rowc <= qh) ? v : -1e30f;
                    a[rg] = v; mx = fmaxf(mx, v); }
            } else {
#pragma unroll
                for (int rg = 0; rg < 16; ++rg) a[rg] = -1e30f;
            }
            s[kt] = a; }
        mx = fmaxf(mx, __shfl_xor(mx, 32));
        float l = 0.f;
#pragma unroll
        for (int kt = 0; kt < 5; ++kt)
#pragma unroll
            for (int rg = 0; rg < 16; ++rg) { const float p = fast_exp(s[kt][rg] - mx); s[kt][rg] = p; l += p; }
        l += __shfl_xor(l, 32);
        l += fast_exp(sink - mx);
        f32x16 o[2];
#pragma unroll
        for (int dt = 0; dt < 2; ++dt) o[dt] = (f32x16){0.f, 0.f, 0.f, 0.f, 0.f, 0.f, 0.f, 0.f, 0.f, 0.f, 0.f, 0.f, 0.f, 0.f, 0.f, 0.f};
#pragma unroll
        for (int kt = 0; kt < 5; ++kt)
#pragma unroll
            for (int st = 0; st < 2; ++st) { v4u pw; pw.x = pk2(s[kt][8 * st + 0], s[kt][8 * st + 1]); pw.y = pk2(s[kt][8 * st + 2], s[kt][8 * st + 3]); pw.z = pk2(s[kt][8 * st + 4], s[kt][8 * st + 5]); pw.w = pk2(s[kt][8 * st + 6], s[kt][8 * st + 7]);
                const bf16x8 pf = __builtin_bit_cast(bf16x8, pw);
#pragma unroll
                for (int dt = 0; dt < 2; ++dt) { const LAS bf16* vp = Vt + (dt * 32 + ql) * SWA_VS + 32 * (r + kt) + 16 * st + 4 * hh;
                    const v2u lo = *(const LAS v2u*)vp, hi = *(const LAS v2u*)(vp + 8); v4u vv; vv.x = lo.x; vv.y = lo.y; vv.z = hi.x; vv.w = hi.y;
                    o[dt] = __builtin_amdgcn_mfma_f32_32x32x16_bf16(__builtin_bit_cast(bf16x8, vv), pf, o[dt], 0, 0, 0); } }
        const float inv = 1.0f / l;
        bf16* op = MIX + t * D + h * 64 + 4 * hh;
#pragma unroll
        for (int dt = 0; dt < 2; ++dt)
#pragma unroll
            for (int q4 = 0; q4 < 4; ++q4) { v2u ow; ow.x = pk2(o[dt][q4 * 4 + 0] * inv, o[dt][q4 * 4 + 1] * inv); ow.y = pk2(o[dt][q4 * 4 + 2] * inv, o[dt][q4 * 4 + 3] * inv);
                *(v2u*)(op + dt * 32 + q4 * 8) = ow; }
    }
}

constexpr int XA_KS = 136, XA_VS = 264;
constexpr int XA_KOFF = 0, XA_VOFF = 256 * XA_KS * 2;
__device__ __forceinline__ void xattn_unit(Frame& F, int unit) {
    const int b = unit >> 5, hx = (unit >> 3) & 3, qb = unit & 7;
    const bf16* PROJ = (const bf16*)(F.ws + WS_PROJ); const bf16* MKV = (const bf16*)(F.ws + WS_MEMKV); bf16* MIX = (bf16*)(F.ws + WS_MIX);
    LAS bf16* Ks = (LAS bf16*)(F.lds + XA_KOFF); LAS bf16* Vt = (LAS bf16*)(F.lds + XA_VOFF);
    __syncthreads();
    {   const int key = F.tid >> 1, half = F.tid & 1; const bf16* rp = MKV + (size_t)(b * MEML + key) * 1024 + hx * 128 + half * 64;
        float ss = 0.f; v4u kw[8];
#pragma unroll
        for (int j = 0; j < 8; ++j) { kw[j] = *(const v4u*)(rp + j * 8);
            const float a0 = bflo(kw[j].x), a1 = bfhi(kw[j].x), a2 = bflo(kw[j].y), a3 = bfhi(kw[j].y), a4 = bflo(kw[j].z), a5 = bfhi(kw[j].z), a6 = bflo(kw[j].w), a7 = bfhi(kw[j].w);
            ss += (a0 * a0 + a1 * a1) + (a2 * a2 + a3 * a3) + (a4 * a4 + a5 * a5) + (a6 * a6 + a7 * a7); }
        ss += __shfl_xor(ss, 1);
        const float rstd = 1.0f / sqrtf(ss * (1.f / 128.f) + EPS);
        const float* kn = F.in[I_XK_NORM] + half * 64;
#pragma unroll
        for (int j = 0; j < 8; ++j) { v4u o; const float* g = kn + j * 8;
            o.x = pk2(bflo(kw[j].x) * rstd * g[0], bfhi(kw[j].x) * rstd * g[1]); o.y = pk2(bflo(kw[j].y) * rstd * g[2], bfhi(kw[j].y) * rstd * g[3]);
            o.z = pk2(bflo(kw[j].z) * rstd * g[4], bfhi(kw[j].z) * rstd * g[5]); o.w = pk2(bflo(kw[j].w) * rstd * g[6], bfhi(kw[j].w) * rstd * g[7]);
            *(LAS v4u*)(Ks + key * XA_KS + half * 64 + j * 8) = o; }
#pragma unroll
        for (int j = 0; j < 8; ++j) { const v4u vw = *(const v4u*)(rp + 512 + j * 8); const unsigned w4[4] = {vw.x, vw.y, vw.z, vw.w};
#pragma unroll
            for (int q = 0; q < 4; ++q) { const int d = half * 64 + j * 8 + q * 2; Vt[d * XA_VS + key] = (bf16)(w4[q] & 0xffffu); Vt[(d + 1) * XA_VS + key] = (bf16)(w4[q] >> 16); } }
    }
    __syncthreads();
    const int ql = F.lane & 31, hh = F.lane >> 5;
    const size_t t = (size_t)b * SEQ + qb * 256 + F.wave * 32 + ql;
    bf16x8 qf[8];
    {   const bf16* qp = PROJ + t * INC + 1792 + hx * 128 + 8 * hh; v4u qw[8]; float ss = 0.f;
#pragma unroll
        for (int ks = 0; ks < 8; ++ks) { qw[ks] = *(const v4u*)(qp + ks * 16);
            const float a0 = bflo(qw[ks].x), a1 = bfhi(qw[ks].x), a2 = bflo(qw[ks].y), a3 = bfhi(qw[ks].y), a4 = bflo(qw[ks].z), a5 = bfhi(qw[ks].z), a6 = bflo(qw[ks].w), a7 = bfhi(qw[ks].w);
            ss += (a0 * a0 + a1 * a1) + (a2 * a2 + a3 * a3) + (a4 * a4 + a5 * a5) + (a6 * a6 + a7 * a7); }
        ss += __shfl_xor(ss, 32);
        const float sc = 0.08838834764831845f / sqrtf(ss * (1.f / 128.f) + EPS);
        const float* qn = F.in[I_XQ_NORM] + 8 * hh;
#pragma unroll
        for (int ks = 0; ks < 8; ++ks) { const float* g = qn + ks * 16; v4u o;
            o.x = pk2(bflo(qw[ks].x) * sc * g[0], bfhi(qw[ks].x) * sc * g[1]); o.y = pk2(bflo(qw[ks].y) * sc * g[2], bfhi(qw[ks].y) * sc * g[3]);
            o.z = pk2(bflo(qw[ks].z) * sc * g[4], bfhi(qw[ks].z) * sc * g[5]); o.w = pk2(bflo(qw[ks].w) * sc * g[6], bfhi(qw[ks].w) * sc * g[7]);
            qf[ks] = __builtin_bit_cast(bf16x8, o); } }
    f32x16 o[4];
#pragma unroll
    for (int dt = 0; dt < 4; ++dt) o[dt] = (f32x16){0.f, 0.f, 0.f, 0.f, 0.f, 0.f, 0.f, 0.f, 0.f, 0.f, 0.f, 0.f, 0.f, 0.f, 0.f, 0.f};
    float mrun = -1e30f, lrun = 0.f;
    for (int kb = 0; kb < 4; ++kb) {
        f32x16 s[2];
#pragma unroll
        for (int kt = 0; kt < 2; ++kt) { f32x16 a = {0.f, 0.f, 0.f, 0.f, 0.f, 0.f, 0.f, 0.f, 0.f, 0.f, 0.f, 0.f, 0.f, 0.f, 0.f, 0.f};
#pragma unroll
            for (int ks = 0; ks < 8; ++ks) { const bf16x8 kfrag = *(const LAS bf16x8*)(Ks + (64 * kb + 32 * kt + ql) * XA_KS + ks * 16 + 8 * hh);
                a = __builtin_amdgcn_mfma_f32_32x32x16_bf16(kfrag, qf[ks], a, 0, 0, 0); }
            s[kt] = a; }
        float mx = mrun;
#pragma unroll
        for (int kt = 0; kt < 2; ++kt)
#pragma unroll
            for (int rg = 0; rg < 16; ++rg) mx = fmaxf(mx, s[kt][rg]);
        mx = fmaxf(mx, __shfl_xor(mx, 32));
        const float alpha = fast_exp(mrun - mx); mrun = mx;
        float ls = 0.f;
#pragma unroll
        for (int kt = 0; kt < 2; ++kt)
#pragma unroll
            for (int rg = 0; rg < 16; ++rg) { const float p = fast_exp(s[kt][rg] - mx); s[kt][rg] = p; ls += p; }
        lrun = lrun * alpha + ls;
#pragma unroll
        for (int dt = 0; dt < 4; ++dt)
#pragma unroll
            for (int rg = 0; rg < 16; ++rg) o[dt][rg] *= alpha;
#pragma unroll
        for (int kt = 0; kt < 2; ++kt)
#pragma unroll
            for (int st = 0; st < 2; ++st) { v4u pw; pw.x = pk2(s[kt][8 * st + 0], s[kt][8 * st + 1]); pw.y = pk2(s[kt][8 * st + 2], s[kt][8 * st + 3]); pw.z = pk2(s[kt][8 * st + 4], s[kt][8 * st + 5]); pw.w = pk2(s[kt][8 * st + 6], s[kt][8 * st + 7]);
                const bf16x8 pf = __builtin_bit_cast(bf16x8, pw);
#pragma unroll
                for (int dt = 0; dt < 4; ++dt) { const LAS bf16* vp = Vt + (dt * 32 + ql) * XA_VS + 64 * kb + 32 * kt + 16 * st + 4 * hh;
                    const v2u lo = *(const LAS v2u*)vp, hi = *(const LAS v2u*)(vp + 8); v4u vv; vv.x = lo.x; vv.y = lo.y; vv.z = hi.x; vv.w = hi.y;
                    o[dt] = __builtin_amdgcn_mfma_f32_32x32x16_bf16(__builtin_bit_cast(bf16x8, vv), pf, o[dt], 0, 0, 0); } }
    }
    lrun += __shfl_xor(lrun, 32);
    const float inv = 1.0f / lrun;
    bf16* op = MIX + t * D + 1536 + hx * 128 + 4 * hh;
#pragma unroll
    for (int dt = 0; dt < 4; ++dt)
#pragma unroll
        for (int q4 = 0; q4 < 4; ++q4) { v2u ow; ow.x = pk2(o[dt][q4 * 4 + 0] * inv, o[dt][q4 * 4 + 1] * inv); ow.y = pk2(o[dt][q4 * 4 + 2] * inv, o[dt][q4 * 4 + 3] * inv);
            *(v2u*)(op + dt * 32 + q4 * 8) = ow; }
}

__device__ __forceinline__ void moe_tables(Frame& F) {
    LAS int* cnt = (LAS int*)(F.lds + TAB_OFF); LAS int* ts = cnt + 64;
    __syncthreads();
    if (F.tid < 64) { const int c = (int)__hip_atomic_load(F.ctl + CW_CNT + F.tid, __ATOMIC_RELAXED, __HIP_MEMORY_SCOPE_AGENT); const int nt = (c + 255) >> 8; int inc = nt;
#pragma unroll
        for (int o = 1; o < 64; o <<= 1) { const int v = __shfl_up(inc, o); if (F.tid >= o) inc += v; }
        cnt[F.tid] = c; ts[F.tid + 1] = inc; if (F.tid == 0) ts[0] = 0; }
    __syncthreads();
}

struct Args { const float* in[31]; float* out; unsigned char* ws; int ph_lo, ph_hi; };
__global__ void __launch_bounds__(512, 2) hymba_fwd(Args args) {
    extern __shared__ __attribute__((aligned(16))) unsigned char lds_raw[];
    Frame F;
    F.lds = (LAS unsigned char*)lds_raw;
    F.tid = threadIdx.x; F.lane = F.tid & 63; F.wave = __builtin_amdgcn_readfirstlane(F.tid >> 6);
    F.G = gridDim.x; { const int bx = blockIdx.x; F.vcu = (F.G % 8 == 0) ? (bx % 8) * (F.G / 8) + bx / 8 : bx; }
#pragma unroll
    for (int i = 0; i < 31; ++i) F.in[i] = args.in[i];
    F.out = args.out; F.ws = args.ws; F.ctl = (unsigned*)(args.ws + WS_CTL);
    const int lo = args.ph_lo, hi = args.ph_hi;
#if !MK_PER_PHASE
    if (F.tid < 4) ((LAS unsigned*)(F.lds + XBW_OFF))[F.tid] = 0u;
    __syncthreads();
    XcdBarrier bar = xcd_barrier_post(F.ctl + CW_BAR, (volatile LAS unsigned*)(F.lds + XBW_OFF));
#define GRID_BAR() xcd_barrier(bar)
#else
#define GRID_BAR() do {} while (0)
#endif
#define IN(k) (lo <= (k) && (k) < hi)
#define SEAM(k) do { if (IN(k) && IN((k) + 1)) GRID_BAR(); } while (0)
    const int gw = F.vcu * 8 + F.wave, NGW = F.G * 8;
    bf16* const XN = (bf16*)(F.ws + WS_XN); bf16* const PROJ = (bf16*)(F.ws + WS_PROJ); bf16* const MIX = (bf16*)(F.ws + WS_MIX);
    bf16* const UA = (bf16*)(F.ws + WS_UA); bf16* const Gm = (bf16*)(F.ws + WS_G);

    if (IN(0)) { p0_prologue(F); }
    SEAM(0);
    if (IN(1)) {
        { pg8::Gemm g{D, D, D}; pg8::DenseOrder S; S.init(XN, F.ws + WS_WIN, D, D, T, INC, F.G, (int)blockIdx.x);
          pg8::EpiProj E{PROJ, UA}; pg8::gemm_phase<pg8::EpiProj, pg8::DenseOrder>(F.lds, g, S, E); }
        { pg8::Gemm g{D, D, D}; pg8::DenseOrder S; S.init(F.ws + WS_MEMN, F.ws + WS_WMKV, D, D, NB * MEML, 1024, F.G, F.G - 1 - (int)blockIdx.x);
          pg8::EpiBf16 E{(bf16*)(F.ws + WS_MEMKV), 1024}; pg8::gemm_phase<pg8::EpiBf16, pg8::DenseOrder>(F.lds, g, S, E); }
        { const int c = (int)blockIdx.x; const bool has3 = 2 * F.G + c < (T / 256) * (INC / 256), haskv = (F.G - 1 - c) < (NB * MEML / 256) * 4;
          bg_convert(F, CW_QGU, 0, BT_GU, (!has3 && !haskv) ? PB1 : 0); }
    }
    SEAM(1);
    if (IN(2)) {
        for (int u = F.vcu; u < 256; u += F.G) swa_unit(F, u);
        __syncthreads();
        { pg8::Gemm g{S5K, 512, 512}; pg8::GroupOrder S{(const char*)UA, (const char*)(F.ws + WS_SP), S5K, 512, 1, 32, F.G, F.G - 1 - F.vcu};
          pg8::EpiF32 E{(float*)(F.ws + WS_SL), 256, (size_t)512 * 256}; pg8::gemm_phase<pg8::EpiF32, pg8::GroupOrder>(F.lds, g, S, E); }
        bg_convert(F, CW_QGU, 0, BT_GU, (F.G - 1 - F.vcu) >= 64 ? PB2 : 0);
    }
    SEAM(2);
    if (IN(3)) {
        if (F.wave == 0) {
            const float* SL = (const float*)(F.ws + WS_SL); const float* AL = (const float*)(F.ws + WS_AL);
            for (int p = F.vcu; p < 256; p += F.G) { const int b = p >> 5, g = p & 31, n = F.lane;
                const float ar = AL[(g * 64 + n) * 2], ai = AL[(g * 64 + n) * 2 + 1]; float xr = 0.f, xi = 0.f;
                for (int j0 = 0; j0 < 64; j0 += 8) { float sr[8], si[8];
#pragma unroll
                    for (int j = 0; j < 8; ++j) { const float* sp = SL + ((size_t)(g * 512 + b * 64 + j0 + j)) * 256; sr[j] = sp[n]; si[j] = sp[64 + n]; }
#pragma unroll
                    for (int j = 0; j < 8; ++j) { bf16* up = UA + ((size_t)(g * 512 + b * 64 + j0 + j)) * S5K + 512; up[n] = (bf16)f2bf(xr); up[64 + n] = (bf16)f2bf(xi);
                        const float nr = ar * xr - ai * xi + sr[j], ni = ar * xi + ai * xr + si[j]; xr = nr; xi = ni; } } }
        }
        if (F.G < 256) { for (int u = F.vcu; u < 256; u += F.G) xattn_unit(F, u); __syncthreads(); }
    }
    SEAM(3);
    if (IN(4)) {
        pg8::Gemm g{S5K, S5K, S5K}; pg8::GroupOrder S{(const char*)UA, (const char*)(F.ws + WS_MQ), S5K, S5K, 2, 32, F.G, F.vcu};
        pg8::EpiS5Y E{UA, F.in[I_SSM_D], Gm}; pg8::gemm_phase<pg8::EpiS5Y, pg8::GroupOrder>(F.lds, g, S, E);
        if (F.G >= 256 && F.vcu >= 128) { for (int u = F.vcu - 128; u < 128; u += F.G - 128) xattn_unit(F, u); __syncthreads(); }
    }
    SEAM(4);
    if (IN(5)) {
        pg8::Gemm g{512, 512, 512}; pg8::DenseOrder S; S.init(Gm, F.ws + WS_WGLU, 512, 512, T, 512, F.G, (int)blockIdx.x);
        pg8::EpiGlu E{Gm, MIX}; pg8::gemm_phase<pg8::EpiGlu, pg8::DenseOrder>(F.lds, g, S, E);
        if (F.G >= 256 && (int)blockIdx.x >= 128) { for (int u = 128 + (int)blockIdx.x - 128; u < 256; u += F.G - 128) xattn_unit(F, u); __syncthreads(); }
    }
    SEAM(5);
    if (IN(6)) {
        for (int m = gw; m < T; m += NGW) { v4u* rp = (v4u*)(MIX + (size_t)m * D) + F.lane; v4u w[4]; float ss[4];
#pragma unroll
            for (int j = 0; j < 4; ++j) { w[j] = rp[64 * j];
                const float a0 = bflo(w[j].x), a1 = bfhi(w[j].x), a2 = bflo(w[j].y), a3 = bfhi(w[j].y), a4 = bflo(w[j].z), a5 = bfhi(w[j].z), a6 = bflo(w[j].w), a7 = bfhi(w[j].w);
                ss[j] = (a0 * a0 + a1 * a1) + (a2 * a2 + a3 * a3) + (a4 * a4 + a5 * a5) + (a6 * a6 + a7 * a7); }
            const float sa = wave_sum(ss[0] + ss[1]), sb = wave_sum(ss[2]), sc = wave_sum(ss[3]);
            const float ra = 1.0f / sqrtf(sa * (1.f / 1024.f) + EPS), rb = 1.0f / sqrtf(sb * (1.f / 512.f) + EPS), rc = 1.0f / sqrtf(sc * (1.f / 512.f) + EPS);
#pragma unroll
            for (int j = 0; j < 4; ++j) { const float rs = j < 2 ? ra : (j == 2 ? rb : rc);
                const float* g = (j < 2 ? F.in[I_ON_ATTN] + j * 512 : (j == 2 ? F.in[I_ON_SSM] : F.in[I_ON_X])) + F.lane * 8; v4u o;
                o.x = pk2(bflo(w[j].x) * rs * g[0], bfhi(w[j].x) * rs * g[1]); o.y = pk2(bflo(w[j].y) * rs * g[2], bfhi(w[j].y) * rs * g[3]);
                o.z = pk2(bflo(w[j].z) * rs * g[4], bfhi(w[j].z) * rs * g[5]); o.w = pk2(bflo(w[j].w) * rs * g[6], bfhi(w[j].w) * rs * g[7]);
                rp[64 * j] = o; } }
    }
    SEAM(6);
    if (IN(7)) {
        pg8::Gemm g{D, D, D}; pg8::DenseOrder S; S.init(MIX, F.ws + WS_WO, D, D, T, D, F.G, (int)blockIdx.x);
        pg8::EpiWo E{F.in[I_X], XN, (float*)(F.ws + WS_PART)}; pg8::gemm_phase<pg8::EpiWo, pg8::DenseOrder>(F.lds, g, S, E);
    }
    SEAM(7);
    if (IN(8)) {
        pg8::Gemm g{D, 512, 512}; pg8::KSplitOrder S{(const char*)XN, (const char*)(F.ws + WS_WR), D, 512, 512, T / 256, 4, F.G, F.vcu};
        pg8::EpiLogit E{(float*)(F.ws + WS_LP)}; pg8::gemm_phase<pg8::EpiLogit, pg8::KSplitOrder>(F.lds, g, S, E);
    }
    SEAM(8);
    const int rt_per = (T + F.G - 1) / F.G, rt_beg = F.vcu * rt_per, rt_end = (rt_beg + rt_per) < T ? (rt_beg + rt_per) : T;
    if (IN(9)) {
        LAS int* hist = (LAS int*)F.lds;
        const float* LP = (const float*)(F.ws + WS_LP); const float* part = (const float*)(F.ws + WS_PART); float* rstdv = (float*)(F.ws + WS_RSTD);
        int* toke = (int*)(F.ws + WS_TOKE); float* wts = (float*)(F.ws + WS_WTS); int* HIST = (int*)(F.ws + WS_HIST);
        __syncthreads();
        if (F.tid < 64) hist[F.tid] = 0;
        __syncthreads();
        for (int t = rt_beg + F.tid; t < rt_end; t += 512) {
            const f32x4* pp = (const f32x4*)(part + (size_t)t * 32); float ss = 0.f;
#pragma unroll
            for (int j = 0; j < 8; ++j) { const f32x4 v = pp[j]; ss += (v[0] + v[1]) + (v[2] + v[3]); }
            const float rs = 1.0f / sqrtf(ss * (1.f / 2048.f) + EPS); rstdv[t] = rs;
            const float* l0 = LP + (size_t)t * 80; const float* l1 = l0 + (size_t)T * 80; const float* l2 = l1 + (size_t)T * 80; const float* l3 = l2 + (size_t)T * 80;
            float gl[8];
#pragma unroll
            for (int j = 0; j < 8; j += 4) { const f32x4 a = *(const f32x4*)(l0 + j), b = *(const f32x4*)(l1 + j), c = *(const f32x4*)(l2 + j), d = *(const f32x4*)(l3 + j);
#pragma unroll
                for (int q = 0; q < 4; ++q) gl[j + q] = rs * (((a[q] + b[q]) + c[q]) + d[q]); }
            int gi = 0; float gm = gl[0];
#pragma unroll
            for (int j = 1; j < 8; ++j) if (gl[j] > gm) { gm = gl[j]; gi = j; }
            float gs = 0.f;
#pragma unroll
            for (int j = 0; j < 8; ++j) gs += expf(gl[j] - gm);
            const float gate = 1.0f / gs;
            float el[8];
#pragma unroll
            for (int j = 0; j < 8; j += 4) { const int o = 8 + gi * 8 + j; const f32x4 a = *(const f32x4*)(l0 + o), b = *(const f32x4*)(l1 + o), c = *(const f32x4*)(l2 + o), d = *(const f32x4*)(l3 + o);
#pragma unroll
                for (int q = 0; q < 4; ++q) el[j + q] = rs * (((a[q] + b[q]) + c[q]) + d[q]); }
            int i1 = 0; float v1 = el[0];
#pragma unroll
            for (int j = 1; j < 8; ++j) if (el[j] > v1) { v1 = el[j]; i1 = j; }
            int i2 = -1; float v2 = -3.0e38f;
#pragma unroll
            for (int j = 0; j < 8; ++j) if (j != i1 && el[j] > v2) { v2 = el[j]; i2 = j; }
            const float ex = expf(v2 - v1);
            const int ea = gi * 8 + i1, eb = gi * 8 + i2;
            const int la = __hip_atomic_fetch_add(hist + ea, 1, __ATOMIC_RELAXED, __HIP_MEMORY_SCOPE_WORKGROUP), lb = __hip_atomic_fetch_add(hist + eb, 1, __ATOMIC_RELAXED, __HIP_MEMORY_SCOPE_WORKGROUP);
            toke[t * 2] = (ea << 16) | la; toke[t * 2 + 1] = (eb << 16) | lb; wts[t * 2] = gate / (1.0f + ex); wts[t * 2 + 1] = gate * ex / (1.0f + ex);
        }
        __syncthreads();
        if (F.tid < 64) HIST[F.vcu * 64 + F.tid] = hist[F.tid];
        __syncthreads();
    }
    SEAM(9);
    if (IN(10)) {
        LAS int* pb = (LAS int*)F.lds; LAS int* pt = pb + 512; LAS int* base = pt + 512;
        const int* HIST = (const int*)(F.ws + WS_HIST); const int* toke = (const int*)(F.ws + WS_TOKE); int* list = (int*)(F.ws + WS_LIST);
        __syncthreads();
        { const int e = F.tid & 63, p8 = F.tid >> 6; int sb = 0, st = 0;
          for (int w = p8; w < F.G; w += 8) { const int h = HIST[w * 64 + e]; st += h; sb += (w < F.vcu) ? h : 0; }
          pb[F.tid] = sb; pt[F.tid] = st; }
        __syncthreads();
        if (F.tid < 64) { int sb = 0, st = 0;
#pragma unroll
            for (int j = 0; j < 8; ++j) { sb += pb[j * 64 + F.tid]; st += pt[j * 64 + F.tid]; }
            base[F.tid] = sb; F.ctl[CW_CNT + F.tid] = (unsigned)st; }
        __syncthreads();
        for (int t = rt_beg + F.tid; t < rt_end; t += 512) {
#pragma unroll
            for (int k = 0; k < 2; ++k) { const int v = toke[t * 2 + k], e = v >> 16, sl = v & 0xffff; list[(size_t)e * LCAP + base[e] + sl] = t * 2 + k; } }
        __syncthreads();
        bg_convert(F, CW_QGU, 0, BT_GU, 0x7fffffff);
    }
    SEAM(10);
    if (IN(11)) {
        moe_tables(F);
        const LAS int* cnt = (const LAS int*)(F.lds + TAB_OFF); const int* list = (const int*)(F.ws + WS_LIST);
        pg8::Gemm g{D, D, D}; pg8::MoeOrder S{(const char*)XN, (const char*)(F.ws + WS_WGU), cnt, cnt + 64, list, D, D, 4, 1024, F.G, F.vcu, true};
        pg8::EpiGU E{list, (const float*)(F.ws + WS_RSTD), cnt, (bf16*)(F.ws + WS_ACT)}; pg8::gemm_phase<pg8::EpiGU, pg8::MoeOrder, true>(F.lds, g, S, E);
        { const int total = cnt[64 + 64] * 4, rounds = (total + F.G - 1) / F.G, mine = F.vcu < total ? (total - 1 - F.vcu) / F.G + 1 : 0;
          bg_convert(F, CW_QD, BT_GU, BT_D, mine < rounds ? PB11 : 0);
          bg_convert(F, CW_QD, BT_GU, BT_D, 0x7fffffff); }
    }
    SEAM(11);
    if (IN(12)) {
        moe_tables(F);
        const LAS int* cnt = (const LAS int*)(F.lds + TAB_OFF); const int* list = (const int*)(F.ws + WS_LIST);
        pg8::Gemm g{DEXP, DEXP, DEXP}; pg8::MoeOrder S{(const char*)(F.ws + WS_ACT), (const char*)(F.ws + WS_WD), cnt, cnt + 64, list, DEXP, DEXP, 8, 2048, F.G, F.vcu, false};
        pg8::EpiDown E{list, (const float*)(F.ws + WS_WTS), cnt, (bf16*)(F.ws + WS_Y2)};
        pg8::gemm_phase<pg8::EpiDown, pg8::MoeOrder>(F.lds, g, S, E);
    }
    SEAM(12);
    if (IN(13)) {
        const bf16* Y2 = (const bf16*)(F.ws + WS_Y2);
        for (int m = gw; m < T; m += NGW) { f32x4* op = (f32x4*)(F.out + (size_t)m * D) + F.lane * 2; const v4u* xb = (const v4u*)(XN + (size_t)m * D) + F.lane;
            const v4u* ya = (const v4u*)(Y2 + (size_t)m * 2 * D) + F.lane; const v4u* yb = ya + 256;
            v4u xw[4], aw[4], cw[4];
#pragma unroll
            for (int j = 0; j < 4; ++j) { xw[j] = __builtin_nontemporal_load(xb + 64 * j); aw[j] = __builtin_nontemporal_load(ya + 64 * j); cw[j] = __builtin_nontemporal_load(yb + 64 * j); }
#pragma unroll
            for (int j = 0; j < 4; ++j) { const v4u x = xw[j], a = aw[j], c = cw[j]; f32x4 x0, x1;
                x0[0] = bflo(x.x) + (bflo(a.x) + bflo(c.x)); x0[1] = bfhi(x.x) + (bfhi(a.x) + bfhi(c.x)); x0[2] = bflo(x.y) + (bflo(a.y) + bflo(c.y)); x0[3] = bfhi(x.y) + (bfhi(a.y) + bfhi(c.y));
                x1[0] = bflo(x.z) + (bflo(a.z) + bflo(c.z)); x1[1] = bfhi(x.z) + (bfhi(a.z) + bfhi(c.z)); x1[2] = bflo(x.w) + (bflo(a.w) + bflo(c.w)); x1[3] = bfhi(x.w) + (bfhi(a.w) + bfhi(c.w));
                __builtin_nontemporal_store(x0, op + 128 * j); __builtin_nontemporal_store(x1, op + 128 * j + 1); } }
    }
#undef IN
#undef SEAM
}

extern "C" void kernel_launch(void* const* d_in, const int* in_sizes, int n_in, void* d_out, int out_size, void* d_ws, size_t ws_size, hipStream_t stream) {
    static int grid = 0;
    if (grid == 0) {
        if (n_in != 31 || out_size != T * D || ws_size < WS_END) { fprintf(stderr, "kernel_launch: unexpected shapes (n_in %d out %d ws %zu)\n", n_in, out_size, ws_size); grid = -1; return; }
        int dev = 0, cus = 0, per_cu = 0;
        if (hipGetDevice(&dev) != hipSuccess || hipDeviceGetAttribute(&cus, hipDeviceAttributeMultiprocessorCount, dev) != hipSuccess) { grid = -1; return; }
        if (hipFuncSetAttribute((const void*)hymba_fwd, hipFuncAttributeMaxDynamicSharedMemorySize, LDS_BYTES) != hipSuccess) { fprintf(stderr, "kernel_launch: hipFuncSetAttribute failed\n"); grid = -1; return; }
        if (hipOccupancyMaxActiveBlocksPerMultiprocessor(&per_cu, (const void*)hymba_fwd, 512, LDS_BYTES) != hipSuccess || per_cu < 1) fprintf(stderr, "kernel_launch: occupancy query reports %d\n", per_cu);
        (void)hipGetLastError();
        grid = cus;
    }
    if (grid < 0) return;
    (void)hipMemsetAsync((char*)d_ws + WS_CTL, 0, CTL_ZERO_BYTES, stream);
    Args a{};
    for (int i = 0; i < 31; ++i) a.in[i] = (const float*)d_in[i];
    a.out = (float*)d_out; a.ws = (unsigned char*)d_ws;
#if MK_PER_PHASE
    for (int p = 0; p < NPH; ++p) { const int reps = ((PROBE_REP_MASK >> p) & 1) ? 2 : 1;
        for (int q = 0; q < reps; ++q) { a.ph_lo = p; a.ph_hi = p + 1; hipLaunchKernelGGL(hymba_fwd, dim3(grid), dim3(512), LDS_BYTES, stream, a); } }
#else
    a.ph_lo = 0; a.ph_hi = NPH; hipLaunchKernelGGL(hymba_fwd, dim3(grid), dim3(512), LDS_BYTES, stream, a);
#endif
}
```

```cpp
#include <hip/hip_runtime.h>
#include <cstdio>
#include <cstdint>

#ifndef PROBE_REP_MASK
#define PROBE_REP_MASK 0
#endif
#ifndef PB0
#define PB0 40
#endif
#ifndef PB0_S5
#define PB0_S5 28
#endif
#ifndef PB0_D
#define PB0_D 0
#endif
#ifndef PB1
#define PB1 0
#endif
#ifndef PB2
#define PB2 0
#endif
#ifndef PB4
#define PB4 0
#endif
#ifndef PB5
#define PB5 0
#endif
#ifndef PB11
#define PB11 0
#endif
#ifndef MK_PER_PHASE
#define MK_PER_PHASE 0
#endif

#define GAS __attribute__((address_space(1)))
#define LAS __attribute__((address_space(3)))
typedef unsigned short bf16;
typedef unsigned v4u __attribute__((ext_vector_type(4)));
typedef unsigned v2u __attribute__((ext_vector_type(2)));
typedef float f32x4 __attribute__((ext_vector_type(4)));
typedef float f32x16 __attribute__((ext_vector_type(16)));
typedef short bf16x8 __attribute__((ext_vector_type(8)));
typedef short bf16x4 __attribute__((ext_vector_type(4)));
typedef int v8i __attribute__((ext_vector_type(8)));
typedef int v4i_ __attribute__((ext_vector_type(4)));

constexpr int T = 16384, D = 2048, SEQ = 2048, NB = 8, INC = 2304, MEML = 256;
constexpr int NPH = 14;
constexpr float EPS = 1e-6f;
constexpr int NEXP = 64, DEXP = 512, LCAP = 16384;
constexpr int S5L = 32, S5K = 640;

constexpr size_t MiB = 1u << 20;
constexpr size_t WS_CTL = 0, CTL_ZERO_BYTES = 1 * MiB;
constexpr size_t WS_WIN = 2 * MiB, WS_WO = 11 * MiB, WS_WMKV = 19 * MiB, WS_WGLU = 23 * MiB;
constexpr size_t WS_MQ = 24 * MiB, WS_SP = 44 * MiB, WS_UA = 52 * MiB, WS_SL = 72 * MiB, WS_AL = 88 * MiB, WS_WR = 89 * MiB;
constexpr size_t WS_XN = 96 * MiB;
constexpr size_t WS_MEMN = 160 * MiB, WS_MEMKV = 168 * MiB;
constexpr size_t WS_PROJ = 176 * MiB;
constexpr size_t WS_MIX = 248 * MiB;
constexpr size_t WS_Y2 = 176 * MiB;
constexpr size_t WS_G = 312 * MiB;
constexpr size_t WS_LOG = 328 * MiB;
constexpr size_t WS_LIST = 344 * MiB;
constexpr size_t WS_WTS = 348 * MiB;
constexpr size_t WS_LP = 352 * MiB;
constexpr size_t WS_PART = 376 * MiB;
constexpr size_t WS_RSTD = 379 * MiB;
constexpr size_t WS_HIST = 380 * MiB;
constexpr size_t WS_X18 = 384 * MiB;
constexpr size_t WS_TOKE = 381 * MiB;
constexpr size_t WS_ACT = 544 * MiB;
constexpr size_t WS_WGU = 592 * MiB;
constexpr size_t WS_WD = 848 * MiB;
constexpr size_t WS_END = 976 * MiB;
constexpr int CW_CNT = 1024;
constexpr int CW_BAR = 4096;
constexpr int CW_QGU = 2048, CW_QD = 2112;

constexpr int RING_BYTES = 131072;
constexpr int TAB_OFF = 139264;
constexpr int XBW_OFF = TAB_OFF + 2048;
constexpr int LDS_BYTES = 147456;

#define LDS_WAIT() asm volatile("s_waitcnt lgkmcnt(0)" ::: "memory")
#define VM_WAIT() asm volatile("s_waitcnt vmcnt(0)" ::: "memory")
__device__ __forceinline__ unsigned f2bf(float f) { unsigned u = __builtin_bit_cast(unsigned, f); return (u + 0x7fffu + ((u >> 16) & 1u)) >> 16; }
__device__ __forceinline__ unsigned pk2(float lo, float hi) { unsigned r; asm volatile("v_cvt_pk_bf16_f32 %0, %1, %2" : "=v"(r) : "v"(lo), "v"(hi)); return r; }
__device__ __forceinline__ float bflo(unsigned w) { return __builtin_bit_cast(float, w << 16); }
__device__ __forceinline__ float bfhi(unsigned w) { return __builtin_bit_cast(float, w & 0xffff0000u); }
__device__ __forceinline__ float wave_sum(float v) {
#pragma unroll
    for (int o = 1; o < 64; o <<= 1) v += __shfl_xor(v, o);
    return v;
}
constexpr float SC_X = 4.0f, SC_WGU = 32.0f, SC_ACT = 16.0f, SC_WD = 16.0f;
__device__ __forceinline__ float clamp8(float v) { return fminf(fmaxf(v, -448.0f), 448.0f); }
__device__ __forceinline__ unsigned pk4_fp8(float a, float b, float c, float d) { unsigned w = 0u; w = (unsigned)__builtin_amdgcn_cvt_pk_fp8_f32(clamp8(a), clamp8(b), (int)w, false); w = (unsigned)__builtin_amdgcn_cvt_pk_fp8_f32(clamp8(c), clamp8(d), (int)w, true); return w; }
__device__ __forceinline__ float fast_exp(float x) { return __builtin_amdgcn_exp2f(x * 1.44269504089f); }
__device__ __forceinline__ float sigmoidf_(float x) { return __builtin_amdgcn_rcpf(1.0f + fast_exp(-x)); }
__device__ __forceinline__ float gelu_tanh(float x) { const float z = 1.5957691216f * (x + 0.044715f * x * x * x); return x * sigmoidf_(z); }

#define XB_TMO      128
#define XB_XCNT(j)  (256  + 64 * (j))
#define XB_XSUB(j)  (1280 + 64 * (j))
#define XB_XGEN(j)  (2304 + 64 * (j))
#define XB_TOP      3328
#define XB_TOPGEN   3392
#define XCD_BAR_WORDS 3456
#define XB_SPIN_CAP (1u << 18)
__device__ __forceinline__ unsigned xb_ld(unsigned* p)              { return __hip_atomic_load(p, __ATOMIC_RELAXED, __HIP_MEMORY_SCOPE_AGENT); }
__device__ __forceinline__ unsigned xb_add(unsigned* p, unsigned v) { return __hip_atomic_fetch_add(p, v, __ATOMIC_RELAXED, __HIP_MEMORY_SCOPE_AGENT); }
__device__ __forceinline__ unsigned xb_xcc_id() { return (unsigned)__builtin_amdgcn_s_getreg((3 << 11) | 20) & 0xFu; }
#define XB_SPIN(cond, bar) do { unsigned _sp = 0; while (cond) { __builtin_amdgcn_s_sleep(1); \
    if ((++_sp & 255u) == 0u) { if (xb_ld(&(bar)[XB_TMO])) break; if (_sp > XB_SPIN_CAP) { atomicAdd(&(bar)[XB_TMO], 1u); break; } } } } while (0)
struct XcdBarrier { unsigned* bar; unsigned x; volatile LAS unsigned* st; };
__device__ __forceinline__ XcdBarrier xcd_barrier_post(unsigned* bar, volatile LAS unsigned* st) {
    XcdBarrier b; b.bar = bar; b.x = xb_xcc_id(); b.st = st;
    if (threadIdx.x == 0) (void)xb_add(&bar[XB_XCNT(b.x)], 1u);
    return b;
}
__device__ __forceinline__ void xcd_barrier_complete(unsigned* bar, unsigned x, unsigned& nloc, unsigned& nx) {
    const unsigned G = gridDim.x * gridDim.y * gridDim.z;
    unsigned sum, cnt, mine, sp = 0u;
    for (;;) {
        sum = 0u; cnt = 0u; mine = 0u;
#pragma unroll
        for (unsigned j = 0; j < 16; ++j) { const unsigned c = xb_ld(&bar[XB_XCNT(j)]); sum += c; cnt += (c > 0u) ? 1u : 0u; mine = (j == x) ? c : mine; }
        if (sum == G) break;
        __builtin_amdgcn_s_sleep(1);
        if ((++sp & 255u) == 0u) { if (xb_ld(&bar[XB_TMO])) break; if (sp > XB_SPIN_CAP) { atomicAdd(&bar[XB_TMO], 1u); break; } }
    }
    nloc = mine > 0u ? mine : 1u; nx = cnt > 0u ? cnt : 1u;
}
__device__ __forceinline__ void xcd_barrier(const XcdBarrier& b) {
    asm volatile("s_waitcnt vmcnt(0)" ::: "memory");
    __syncthreads();
    if (threadIdx.x == 0) {
        unsigned* bar = b.bar;
        __builtin_amdgcn_s_waitcnt(0);
        unsigned nloc = b.st[0], nx = b.st[1];
        if (nloc == 0u) { xcd_barrier_complete(bar, b.x, nloc, nx); b.st[0] = nloc; b.st[1] = nx; }
        const unsigned old = xb_add(&bar[XB_XSUB(b.x)], 1u);
        const unsigned gen = old / nloc;
        if (old + 1u == (gen + 1u) * nloc) {
            __builtin_amdgcn_fence(__ATOMIC_RELEASE, "agent");
            asm volatile("s_waitcnt vmcnt(0)" ::: "memory");
            const unsigned og = xb_add(&bar[XB_TOP], 1u);
            const unsigned tg = og / nx;
            if (og + 1u == (tg + 1u) * nx) xb_add(&bar[XB_TOPGEN], 1u);
            else XB_SPIN(xb_ld(&bar[XB_TOPGEN]) == tg, bar);
            __builtin_amdgcn_fence(__ATOMIC_ACQUIRE, "agent");
            xb_add(&bar[XB_XGEN(b.x)], 1u);
            asm volatile("s_waitcnt vmcnt(0)" ::: "memory");
        } else {
            XB_SPIN(xb_ld(&bar[XB_XGEN(b.x)]) == gen, bar);
            __builtin_amdgcn_fence(__ATOMIC_ACQUIRE, "agent");
            asm volatile("s_waitcnt vmcnt(0)" ::: "memory");
        }
    }
    __syncthreads();
}

__device__ __forceinline__ int lane_now() { int l = (int)__builtin_amdgcn_mbcnt_hi(~0u, __builtin_amdgcn_mbcnt_lo(~0u, 0u)); asm volatile("" : "+v"(l)); return l; }
namespace pg8 {
constexpr int BM = 256, BK = 64, HALF = 128, HTB = HALF * BK * 2, STAGE_BYTES = 8 * HTB, NXCD = 8, WGM = 8;
__host__ __device__ __forceinline__ int lds_byte(int r, int c) { const int st = (r >> 4) * 2 + (c >> 5), rr = r & 15, cc = c & 31, ob = rr * 64 + cc * 2; return st * 1024 + (ob ^ (((ob >> 9) & 1) << 5)); }
__host__ __device__ __forceinline__ void stage_rc(int b, int& R, int& C) { const int st = b / 1024, sb = b % 1024, swz = sb ^ (((sb >> 9) & 1) << 5); R = (st >> 1) * 16 + swz / 64; C = (st & 1) * 32 + (swz % 64) / 2; }
__host__ __device__ __forceinline__ int perm32(int rho) { const int n = rho >> 4, i = rho & 15; return 8 * (i >> 2) + 4 * n + (i & 3); }

struct Unit { const char* a; const char* b; int r0, c0, aux, r1; };
struct Gemm { int lda, ldb, K; };

struct DenseOrder {
    const char* A; const char* Bt; int lda, ldb, nM, nN, nwg, G, c;
    __device__ void init(const void* A_, const void* Bt_, int lda_, int ldb_, int M, int N, int G_, int c_) { A = (const char*)A_; Bt = (const char*)Bt_; lda = lda_; ldb = ldb_; nM = M / BM; nN = N / BM; nwg = nM * nN; G = G_; c = c_; }
    __device__ bool next(int i, Unit& u) const {
        const long L = (long)i * G + c; if (L >= nwg) return false;
        int wgid = (int)L; { const int q = nwg / NXCD, r = nwg % NXCD, xcd = wgid % NXCD, off = wgid / NXCD; wgid = (xcd < r ? xcd * (q + 1) : r * (q + 1) + (xcd - r) * q) + off; }
        const int nig = WGM * nN, gid = wgid / nig, fm = gid * WGM, gsz = (nM - fm) < WGM ? (nM - fm) : WGM;
        const int pm = fm + ((wgid % nig) % gsz), pn = (wgid % nig) / gsz;
        u.a = A + (size_t)pm * BM * lda * 2; u.b = Bt + (size_t)pn * BM * ldb * 2; u.r0 = pm * BM; u.c0 = pn * BM; u.aux = 0; u.r1 = 0; return true;
    }
    __device__ __forceinline__ unsigned arow(const Unit&, int) const { return 0u; }
};
struct GroupOrder {
    const char* A; const char* Bt; int lda, ldb, nN, ngrp, G, c;
    __device__ bool next(int i, Unit& u) const {
        const int L = i * G + c; if (L >= ngrp * 2 * nN) return false;
        const int g = L / (2 * nN), q = L % (2 * nN), pn = q >> 1, pm = q & 1;
        u.a = A + ((size_t)g * 512 + pm * BM) * lda * 2; u.b = Bt + ((size_t)g * nN + pn) * BM * ldb * 2; u.r0 = pm * BM; u.c0 = pn * BM; u.aux = g; u.r1 = 0; return true;
    }
    __device__ __forceinline__ unsigned arow(const Unit&, int) const { return 0u; }
};
struct MoeOrder {
    const char* A; const char* Bt; const LAS int* cnt; const LAS int* ts; const int* list; int lda, ldb, nct, brows, G, c; bool gather;
    __device__ bool next(int i, Unit& u) const {
        const int L = i * G + c; const int lane = lane_now();
        int i64 = 64; asm volatile("" : "+v"(i64));
        if (L >= __builtin_amdgcn_readfirstlane(ts[i64]) * nct) return false;
        const int lo = ts[lane] * nct, hi = ts[lane + 1] * nct;
        const unsigned long long m = __ballot(lo <= L && L < hi);
        const int e = __builtin_amdgcn_readfirstlane((int)__builtin_ctzll(m));
        const int tse = ts[e], ne = ts[e + 1] - tse, q = L - tse * nct, ct = q / ne, rt = q % ne;
        u.a = gather ? A : A + (size_t)(tse + rt) * BM * lda * 2; u.b = Bt + ((size_t)e * brows + (size_t)ct * BM) * ldb * 2;
        u.r0 = (tse + rt) * BM; u.r1 = rt * BM; u.c0 = ct; u.aux = e; return true;
    }
    __device__ __forceinline__ unsigned arow(const Unit& u, int r) const {
        const int n = cnt[u.aux]; int rr = u.r1 + r; rr = rr < n ? rr : n - 1;
        return (unsigned)(list[(size_t)u.aux * LCAP + rr] >> 1) * (unsigned)(lda * 2);
    }
};

#define EPI_ROWS_COLS() const int rowb = wr * 64 + fr; (void)rowb;

template <class Epi, class Sched, bool GATHER = false, bool FP8 = false>
__device__ __forceinline__ void gemm_phase(LAS unsigned char* lds, const Gemm g, const Sched& S, const Epi& E, const int wave_id) {
    int lane = (int)__builtin_amdgcn_mbcnt_hi(~0u, __builtin_amdgcn_mbcnt_lo(~0u, 0u)); asm volatile("" : "+v"(lane));
    const int wid = wave_id, tid = wid * 64 + lane, wr = wid >> 2, wc = wid & 3, fr = lane & 15, fq = lane >> 4;
    const int K = g.K; int nt = K / BK; asm volatile("" : "+s"(nt));
    unsigned voffB;
    { int R, C; stage_rc(tid * 16, R, C); const int Rb = Epi::PERM ? ((R & ~31) + perm32(R & 31)) : R; voffB = (unsigned)(Rb * g.ldb + C) * 2u; }
    const int soffB = 64 * g.ldb * 2;
#define PG8_RC(i, R, C) int R, C; { int _t = tid; asm volatile("" : "+v"(_t)); stage_rc(_t * 16 + (i) * 8192, R, C); }
#define nxoff ((LAS v4u*)(lds + 131072) + (wid * 64 + lane_now()))
    const size_t kstep = (size_t)(BK * 2);
    const size_t hstepB = (size_t)HALF * g.ldb * 2;
    const unsigned ldsw = (unsigned)wid * 1024u;
    const int aoff = lds_byte(wr * 64 + fr, fq * 8), boff = lds_byte(wc * 32 + fr, fq * 8);
#define PG8_SA(b, h) (((b) * 2 + (h)) * HTB)
#define PG8_SB(b, h) ((4 + (b) * 2 + (h)) * HTB)
#define PG8_RSRC(p) __builtin_amdgcn_make_buffer_rsrc((void*)(p), 0, 0xffffffff, 0x00020000)
#define PG8_STAGE(bufoff, gbase, voff) do { const __amdgpu_buffer_rsrc_t _r = PG8_RSRC(gbase); \
        __builtin_amdgcn_raw_ptr_buffer_load_lds(_r, (LAS void*)(lds + (bufoff) + ldsw), 16, (int)(voff), 0, 0, 0); \
        __builtin_amdgcn_raw_ptr_buffer_load_lds(_r, (LAS void*)(lds + (bufoff) + ldsw + 8192), 16, (int)(voff), soffB, 0, 0); } while (0)
#define PG8_STAGEA(bufoff, gbase, o0, o1) do { const __amdgpu_buffer_rsrc_t _r = PG8_RSRC(gbase); \
        __builtin_amdgcn_raw_ptr_buffer_load_lds(_r, (LAS void*)(lds + (bufoff) + ldsw), 16, (int)(o0), 0, 0, 0); \
        __builtin_amdgcn_raw_ptr_buffer_load_lds(_r, (LAS void*)(lds + (bufoff) + ldsw + 8192), 16, (int)(o1), 0, 0, 0); } while (0)
#define PG8_LDA(dst, b, h) do { _Pragma("unroll") for (int m = 0; m < 4; ++m) { \
        if constexpr (FP8) { dst##8[m].lo = *(const LAS v4i_*)(lds + PG8_SA(b, h) + aoff + m * 2048); dst##8[m].hi = *(const LAS v4i_*)(lds + PG8_SA(b, h) + aoff + m * 2048 + 1024); } \
        else { _Pragma("unroll") for (int k = 0; k < 2; ++k) dst[m][k] = *(const LAS bf16x8*)(lds + PG8_SA(b, h) + aoff + m * 2048 + k * 1024); } } } while (0)
#define PG8_LDB(dst, b, h) do { _Pragma("unroll") for (int n = 0; n < 2; ++n) { \
        if constexpr (FP8) { dst##8[n].lo = *(const LAS v4i_*)(lds + PG8_SB(b, h) + boff + n * 2048); dst##8[n].hi = *(const LAS v4i_*)(lds + PG8_SB(b, h) + boff + n * 2048 + 1024); } \
        else { _Pragma("unroll") for (int k = 0; k < 2; ++k) dst[n][k] = *(const LAS bf16x8*)(lds + PG8_SB(b, h) + boff + n * 2048 + k * 1024); } } } while (0)
#define PG8_MMA(ai, bj, At, Bt) do { __builtin_amdgcn_s_setprio(1); _Pragma("unroll") for (int m = 0; m < 4; ++m) _Pragma("unroll") for (int n = 0; n < 2; ++n) { \
        if constexpr (FP8) { acc[ai][bj][m][n] = __builtin_amdgcn_mfma_scale_f32_16x16x128_f8f6f4(Bt##8[n], At##8[m], acc[ai][bj][m][n], 0, 0, 0, 0x7f7f7f7f, 0, 0x7f7f7f7f); } \
        else { _Pragma("unroll") for (int k = 0; k < 2; ++k) acc[ai][bj][m][n] = __builtin_amdgcn_mfma_f32_16x16x32_bf16(Bt[n][k], At[m][k], acc[ai][bj][m][n], 0, 0, 0); } } \
        __builtin_amdgcn_s_setprio(0); } while (0)
#define PG8_WAIT_V(n) asm volatile("s_waitcnt vmcnt(" #n ")" ::: "memory")
#define PG8_WAIT_L(n) asm volatile("s_waitcnt lgkmcnt(" #n ")" ::: "memory")
#define PG8_BAR __builtin_amdgcn_s_barrier()
#define PG8_SCHED __builtin_amdgcn_sched_barrier(0)
    Unit cur, nxt; int ui = 0;
    if (!S.next(0, cur)) return;
    f32x4 acc[2][2][4][2];
#pragma unroll
    for (int a = 0; a < 2; ++a)
#pragma unroll
        for (int b = 0; b < 2; ++b)
#pragma unroll
            for (int m = 0; m < 4; ++m)
#pragma unroll
                for (int n = 0; n < 2; ++n) acc[a][b][m][n] = (f32x4){0.f, 0.f, 0.f, 0.f};
    bf16x8 At[4][2], B0[2][2], B1[2][2]; v8i At8[4], B08[2], B18[2];
    const char* cA = cur.a; const char* cB = cur.b;
    unsigned c00, c01, c10, c11;
    { PG8_RC(0, R0, C0); PG8_RC(1, R1, C1);
      if constexpr (GATHER) {
        c00 = S.arow(cur, R0) + C0 * 2u; c01 = S.arow(cur, R1) + C1 * 2u; c10 = S.arow(cur, HALF + R0) + C0 * 2u; c11 = S.arow(cur, HALF + R1) + C1 * 2u;
        asm volatile("s_waitcnt vmcnt(0)" : "+v"(c00), "+v"(c01), "+v"(c10), "+v"(c11) :: "memory");
      } else {
        c00 = (unsigned)(R0 * g.lda + C0) * 2u; c01 = (unsigned)(R1 * g.lda + C1) * 2u; c10 = c00 + (unsigned)(HALF * g.lda * 2); c11 = c01 + (unsigned)(HALF * g.lda * 2);
      } }
    PG8_STAGE(PG8_SB(0, 0), cB, voffB); PG8_STAGE(PG8_SB(0, 1), cB + hstepB, voffB); PG8_STAGEA(PG8_SA(0, 0), cA, c00, c01); PG8_STAGEA(PG8_SA(0, 1), cA, c10, c11);
    if (wr == 1) PG8_BAR;
    PG8_WAIT_V(2); PG8_BAR;
    PG8_STAGE(PG8_SB(1, 0), cB + kstep, voffB); PG8_STAGEA(PG8_SA(1, 0), cA + kstep, c00, c01); PG8_STAGE(PG8_SB(1, 1), cB + hstepB + kstep, voffB);
    PG8_WAIT_V(6); PG8_BAR;
    for (;;) {
        const bool has_next = S.next(ui + 1, nxt);
        const char* nA = has_next ? nxt.a : cA; const char* nB = has_next ? nxt.b : cB;
        if constexpr (GATHER) {
            unsigned n00 = c00, n01 = c01, n10 = c10, n11 = c11;
            if (has_next) { PG8_RC(0, R0, C0); PG8_RC(1, R1, C1); n00 = S.arow(nxt, R0) + C0 * 2u; n01 = S.arow(nxt, R1) + C1 * 2u; n10 = S.arow(nxt, HALF + R0) + C0 * 2u; n11 = S.arow(nxt, HALF + R1) + C1 * 2u; }
            asm volatile("s_waitcnt vmcnt(0)" : "+v"(n00), "+v"(n01), "+v"(n10), "+v"(n11) :: "memory");
            v4u nv; nv.x = n00; nv.y = n01; nv.z = n10; nv.w = n11; *nxoff = nv;
        }
#pragma unroll 1
        for (int t = 0; t < nt; t += 2) {
            const bool last = (t == nt - 2);
            const char* a1 = cA + (size_t)(t + 1) * kstep;
            const char* a2 = last ? nA : cA + (size_t)(t + 2) * kstep; const char* b2 = last ? nB : cB + (size_t)(t + 2) * kstep;
            const char* a3 = a2 + kstep; const char* b3 = b2 + kstep;
            unsigned x00 = c00, x01 = c01, x10 = c10, x11 = c11;
            if constexpr (GATHER) { if (last) { const v4u nv = *nxoff; x00 = nv.x; x01 = nv.y; x10 = nv.z; x11 = nv.w; } }
            PG8_LDB(B0, 0, 0); PG8_LDB(B1, 0, 1); PG8_SCHED; PG8_LDA(At, 0, 0); PG8_STAGEA(PG8_SA(1, 1), a1, c10, c11);
            PG8_WAIT_V(8); PG8_WAIT_L(0); PG8_BAR; PG8_MMA(0, 0, At, B0); PG8_MMA(0, 1, At, B1); PG8_BAR; PG8_SCHED;
            PG8_LDA(At, 0, 1); PG8_STAGE(PG8_SB(0, 0), b2, voffB); PG8_STAGE(PG8_SB(0, 1), b2 + hstepB, voffB); PG8_STAGEA(PG8_SA(0, 0), a2, x00, x01);
            PG8_WAIT_V(8); PG8_WAIT_L(0); PG8_BAR; PG8_MMA(1, 0, At, B0); PG8_MMA(1, 1, At, B1); PG8_BAR; PG8_SCHED;
            PG8_LDB(B0, 1, 0); PG8_LDB(B1, 1, 1); PG8_SCHED; PG8_LDA(At, 1, 0); PG8_STAGEA(PG8_SA(0, 1), a2, x10, x11);
            PG8_WAIT_V(8); PG8_WAIT_L(0); PG8_BAR; PG8_MMA(0, 0, At, B0); PG8_MMA(0, 1, At, B1); PG8_BAR; PG8_SCHED;
            PG8_LDA(At, 1, 1); PG8_STAGE(PG8_SB(1, 0), b3, voffB); PG8_STAGE(PG8_SB(1, 1), b3 + hstepB, voffB); PG8_STAGEA(PG8_SA(1, 0), a3, x00, x01);
            PG8_WAIT_V(8); PG8_WAIT_L(0); PG8_BAR; PG8_MMA(1, 0, At, B0); PG8_MMA(1, 1, At, B1); PG8_BAR; PG8_SCHED;
        }
        if (wr == 0) PG8_BAR;
        { const int le = lane_now(); E(acc, cur, wr, wc, le & 15, le >> 4); }
        if (!has_next) break;
#pragma unroll
        for (int a = 0; a < 2; ++a)
#pragma unroll
            for (int b = 0; b < 2; ++b)
#pragma unroll
                for (int m = 0; m < 4; ++m)
#pragma unroll
                    for (int n = 0; n < 2; ++n) acc[a][b][m][n] = (f32x4){0.f, 0.f, 0.f, 0.f};
        cur = nxt; cA = nA; cB = nB; ++ui;
        if constexpr (GATHER) { const v4u nv = *nxoff; c00 = nv.x; c01 = nv.y; c10 = nv.z; c11 = nv.w; }
        if (wr == 1) PG8_BAR;
    }
    PG8_WAIT_V(0);
    PG8_BAR;
#undef PG8_RC
#undef nxoff
#undef PG8_SA
#undef PG8_SB
#undef PG8_STAGE
#undef PG8_STAGEA
#undef PG8_LDA
#undef PG8_LDB
#undef PG8_MMA
#undef PG8_WAIT_V
#undef PG8_WAIT_L
#undef PG8_BAR
#undef PG8_SCHED
}

typedef const f32x4 (&AccRef)[2][2][4][2];
__device__ __forceinline__ v4u pack8(const f32x4 a, const f32x4 b) { v4u w; w.x = pk2(a[0], a[1]); w.y = pk2(a[2], a[3]); w.z = pk2(b[0], b[1]); w.w = pk2(b[2], b[3]); return w; }

struct EpiProj {
    static constexpr bool PERM = true;
    bf16* PROJ; bf16* UA;
    __device__ __forceinline__ void operator()(AccRef acc, const Unit& u, int wr, int wc, int fr, int fq) const {
        const int row0 = u.r0 + wr * 64 + fr, colb = u.c0 + wc * 32 + 8 * fq;
        const bool isu = (u.c0 == 1280 || u.c0 == 1536);
#pragma unroll
        for (int ai = 0; ai < 2; ++ai)
#pragma unroll
            for (int m = 0; m < 4; ++m) { const int row = row0 + ai * HALF + m * 16;
#pragma unroll
                for (int bj = 0; bj < 2; ++bj) { const int col = colb + bj * HALF; const v4u w = pack8(acc[ai][bj][m][0], acc[ai][bj][m][1]);
                    if (!isu) *(v4u*)(PROJ + (size_t)row * INC + col) = w;
                    else { const int cc = col - 1280, g = cc >> 4, c0 = cc & 15; *(v4u*)(UA + ((size_t)(g * 512 + (row >> 5)) * S5K + (row & 31) * 16 + c0)) = w; } } }
    }
};
struct EpiBf16 {
    static constexpr bool PERM = true;
    bf16* O; int ldc;
    __device__ __forceinline__ void operator()(AccRef acc, const Unit& u, int wr, int wc, int fr, int fq) const {
        const int row0 = u.r0 + wr * 64 + fr, colb = u.c0 + wc * 32 + 8 * fq;
#pragma unroll
        for (int ai = 0; ai < 2; ++ai)
#pragma unroll
            for (int m = 0; m < 4; ++m) { bf16* rowp = O + (size_t)(row0 + ai * HALF + m * 16) * ldc + colb;
#pragma unroll
                for (int bj = 0; bj < 2; ++bj) *(v4u*)(rowp + bj * HALF) = pack8(acc[ai][bj][m][0], acc[ai][bj][m][1]); }
    }
};
struct EpiF32 {
    static constexpr bool PERM = false;
    float* C; int ldc; size_t gstride;
    __device__ __forceinline__ void operator()(AccRef acc, const Unit& u, int wr, int wc, int fr, int fq) const {
        const int row0 = u.r0 + wr * 64 + fr, col0 = u.c0 + wc * 32 + 4 * fq; float* base = C + (size_t)u.aux * gstride;
#pragma unroll
        for (int ai = 0; ai < 2; ++ai)
#pragma unroll
            for (int m = 0; m < 4; ++m) { float* rowp = base + (size_t)(row0 + ai * HALF + m * 16) * ldc + col0;
#pragma unroll
                for (int bj = 0; bj < 2; ++bj)
#pragma unroll
                    for (int n = 0; n < 2; ++n) *(f32x4*)(rowp + bj * HALF + n * 16) = acc[ai][bj][m][n]; }
    }
};
struct EpiS5Y {
    static constexpr bool PERM = true;
    const bf16* UA; const float* dsk; bf16* Gm;
    __device__ __forceinline__ void operator()(AccRef acc, const Unit& u, int wr, int wc, int fr, int fq) const {
        const int row0 = u.r0 + wr * 64 + fr, colb = u.c0 + wc * 32 + 8 * fq, g = u.aux;
#pragma unroll
        for (int ai = 0; ai < 2; ++ai)
#pragma unroll
            for (int m = 0; m < 4; ++m) { const int row = row0 + ai * HALF + m * 16;
#pragma unroll
                for (int bj = 0; bj < 2; ++bj) { const int col = colb + bj * HALF, i = col >> 4, c0 = col & 15;
                    const v4u uw = *(const v4u*)(UA + ((size_t)(g * 512 + row) * S5K + col));
                    const f32x4 d0 = *(const f32x4*)(dsk + g * 16 + c0), d1 = *(const f32x4*)(dsk + g * 16 + c0 + 4);
                    const f32x4 a0 = acc[ai][bj][m][0], a1 = acc[ai][bj][m][1];
                    f32x4 y0, y1;
                    y0[0] = gelu_tanh(a0[0] + d0[0] * bflo(uw.x)); y0[1] = gelu_tanh(a0[1] + d0[1] * bfhi(uw.x)); y0[2] = gelu_tanh(a0[2] + d0[2] * bflo(uw.y)); y0[3] = gelu_tanh(a0[3] + d0[3] * bfhi(uw.y));
                    y1[0] = gelu_tanh(a1[0] + d1[0] * bflo(uw.z)); y1[1] = gelu_tanh(a1[1] + d1[1] * bfhi(uw.z)); y1[2] = gelu_tanh(a1[2] + d1[2] * bflo(uw.w)); y1[3] = gelu_tanh(a1[3] + d1[3] * bfhi(uw.w));
                    *(v4u*)(Gm + ((size_t)row * 32 + i) * 512 + g * 16 + c0) = pack8(y0, y1); } }
    }
};
struct EpiGlu {
    static constexpr bool PERM = true;
    const bf16* Gm; bf16* MIX;
    __device__ __forceinline__ void operator()(AccRef acc, const Unit& u, int wr, int wc, int fr, int fq) const {
        const int row0 = u.r0 + wr * 64 + fr, colb = u.c0 + wc * 32 + 8 * fq;
#pragma unroll
        for (int ai = 0; ai < 2; ++ai)
#pragma unroll
            for (int m = 0; m < 4; ++m) { const int row = row0 + ai * HALF + m * 16;
#pragma unroll
                for (int bj = 0; bj < 2; ++bj) { const int col = colb + bj * HALF;
                    const v4u gw = *(const v4u*)(Gm + (size_t)row * 512 + col);
                    const f32x4 a0 = acc[ai][bj][m][0], a1 = acc[ai][bj][m][1];
                    f32x4 y0, y1;
                    y0[0] = bflo(gw.x) * sigmoidf_(a0[0]); y0[1] = bfhi(gw.x) * sigmoidf_(a0[1]); y0[2] = bflo(gw.y) * sigmoidf_(a0[2]); y0[3] = bfhi(gw.y) * sigmoidf_(a0[3]);
                    y1[0] = bflo(gw.z) * sigmoidf_(a1[0]); y1[1] = bfhi(gw.z) * sigmoidf_(a1[1]); y1[2] = bflo(gw.w) * sigmoidf_(a1[2]); y1[3] = bfhi(gw.w) * sigmoidf_(a1[3]);
                    *(v4u*)(MIX + (size_t)row * D + 1024 + col) = pack8(y0, y1); } }
    }
};
struct EpiWo {
    static constexpr bool PERM = true;
    const float* X; bf16* X1B; unsigned char* X18; float* part;
    __device__ __forceinline__ void operator()(AccRef acc, const Unit& u, int wr, int wc, int fr, int fq) const {
        const int row0 = u.r0 + wr * 64 + fr, col0 = u.c0 + wc * 32 + 8 * fq;
#pragma unroll
        for (int ai = 0; ai < 2; ++ai) {
            f32x4 xv[4][2][2];
#pragma unroll
            for (int m = 0; m < 4; ++m)
#pragma unroll
                for (int bj = 0; bj < 2; ++bj)
#pragma unroll
                    for (int n = 0; n < 2; ++n) xv[m][bj][n] = __builtin_nontemporal_load((const f32x4*)(X + (size_t)(row0 + ai * HALF + m * 16) * D + col0 + bj * HALF + n * 4));
#pragma unroll
            for (int m = 0; m < 4; ++m) { const int row = row0 + ai * HALF + m * 16; const size_t off = (size_t)row * D + col0; float ss = 0.f;
#pragma unroll
                for (int bj = 0; bj < 2; ++bj) { const f32x4 v0 = xv[m][bj][0] + acc[ai][bj][m][0], v1 = xv[m][bj][1] + acc[ai][bj][m][1];
                    ss += ((v0[0] * v0[0] + v0[1] * v0[1]) + (v0[2] * v0[2] + v0[3] * v0[3])) + ((v1[0] * v1[0] + v1[1] * v1[1]) + (v1[2] * v1[2] + v1[3] * v1[3]));
                    *(v4u*)(X1B + off + bj * HALF) = pack8(v0, v1);
                    v2u w8; w8.x = pk4_fp8(v0[0] * SC_X, v0[1] * SC_X, v0[2] * SC_X, v0[3] * SC_X); w8.y = pk4_fp8(v1[0] * SC_X, v1[1] * SC_X, v1[2] * SC_X, v1[3] * SC_X);
                    *(v2u*)(X18 + off + bj * HALF) = w8; }
                ss += __shfl_xor(ss, 16); ss += __shfl_xor(ss, 32);
                if (fq == 0) part[(size_t)row * 32 + (u.c0 >> 8) * 4 + wc] = ss; }
            asm volatile("" ::: "memory");
        }
    }
};
struct EpiLogit {
    static constexpr bool PERM = false;
    float* LP;
    __device__ __forceinline__ void operator()(AccRef acc, const Unit& u, int wr, int wc, int fr, int fq) const {
        const int row0 = u.r0 + wr * 64 + fr, col0 = wc * 32 + 4 * fq; float* base = LP + (size_t)u.aux * T * 80;
#pragma unroll
        for (int ai = 0; ai < 2; ++ai)
#pragma unroll
            for (int m = 0; m < 4; ++m) { float* rowp = base + (size_t)(row0 + ai * HALF + m * 16) * 80 + col0;
#pragma unroll
                for (int n = 0; n < 2; ++n) if (col0 + n * 16 < 80) *(f32x4*)(rowp + n * 16) = acc[ai][0][m][n]; }
    }
};
struct EpiGU {
    static constexpr bool PERM = true;
    const int* list; const float* rstd; const LAS int* cnt; unsigned char* ACT;
    __device__ __forceinline__ void operator()(AccRef acc, const Unit& u, int wr, int wc, int fr, int fq) const {
        const int e = u.aux, nreal = cnt[e], rb = wr * 64 + fr, colb = u.c0 * 128 + wc * 32 + 8 * fq;
#pragma unroll
        for (int ai = 0; ai < 2; ++ai)
#pragma unroll
            for (int m = 0; m < 4; ++m) { const int r = rb + ai * HALF + m * 16; int rr = u.r1 + r; rr = rr < nreal ? rr : nreal - 1;
                const float rs = rstd[list[(size_t)e * LCAP + rr] >> 1] * (1.0f / (SC_X * SC_WGU));
                f32x4 y0, y1;
#pragma unroll
                for (int j = 0; j < 4; ++j) { const float g0 = acc[ai][0][m][0][j] * rs, g1 = acc[ai][0][m][1][j] * rs;
                    y0[j] = g0 * sigmoidf_(g0) * (acc[ai][1][m][0][j] * rs) * SC_ACT; y1[j] = g1 * sigmoidf_(g1) * (acc[ai][1][m][1][j] * rs) * SC_ACT; }
                v2u w8; w8.x = pk4_fp8(y0[0], y0[1], y0[2], y0[3]); w8.y = pk4_fp8(y1[0], y1[1], y1[2], y1[3]);
                *(v2u*)(ACT + (size_t)(u.r0 + r) * DEXP + colb) = w8; }
    }
};
struct EpiDown {
    static constexpr bool PERM = true;
    const int* list; const float* wts; const LAS int* cnt; bf16* Y2;
    __device__ __forceinline__ void operator()(AccRef acc, const Unit& u, int wr, int wc, int fr, int fq) const {
        const int e = u.aux, n = cnt[e], row0 = u.r1 + wr * 64 + fr, colb = u.c0 * 256 + wc * 32 + 8 * fq;
#pragma unroll
        for (int ai = 0; ai < 2; ++ai)
#pragma unroll
            for (int m = 0; m < 4; ++m) { const int r = row0 + ai * HALF + m * 16;
                if (r < n) { const int ent = list[(size_t)e * LCAP + r]; const float w = wts[ent] * (1.0f / (SC_ACT * SC_WD)); bf16* rowp = Y2 + (size_t)ent * D + colb;
#pragma unroll
                    for (int bj = 0; bj < 2; ++bj) *(v4u*)(rowp + bj * HALF) = pack8(acc[ai][bj][m][0] * w, acc[ai][bj][m][1] * w); } }
    }
};
struct KSplitOrder {
    const char* A; const char* Bt; int lda, ldb, K, nM, nks, G, c;
    __device__ bool next(int i, Unit& u) const {
        const int L = i * G + c; if (L >= nM * nks) return false;
        const int pm = L / nks, ks = L % nks;
        u.a = A + ((size_t)pm * BM * lda + (size_t)ks * K) * 2; u.b = Bt + (size_t)ks * BM * ldb * 2; u.r0 = pm * BM; u.c0 = 0; u.aux = ks; u.r1 = 0; return true;
    }
    __device__ __forceinline__ unsigned arow(const Unit&, int) const { return 0u; }
};
}

struct Frame {
    LAS unsigned char* lds;
    unsigned* ctl;
    int tid, lane, wave, vcu, G;
    const float* const __attribute__((address_space(4)))* in;
    float* out; unsigned char* ws;
};
enum { I_X = 0, I_MEM, I_NORM_MIX, I_W_IN, I_Q_NORM, I_K_NORM, I_SINKS, I_REL_BIAS, I_LAM_RE, I_LAM_IM, I_LOG_DT, I_B_RE, I_B_IM, I_C_RE, I_C_IM, I_SSM_D, I_W_GLU,
       I_MEM_NORM, I_W_MEM_KV, I_XQ_NORM, I_XK_NORM, I_ON_ATTN, I_ON_SSM, I_ON_X, I_W_O, I_NORM_FFN, I_WR_G, I_WR_E, I_W_GATE, I_W_UP, I_W_DOWN };

struct TrItem { const float* W; bf16* WT; const float* ks; int ldw, ldt, k0, n0, drow0; };
__device__ __forceinline__ void tr_load(const TrItem& it, f32x4 (&v)[8], int lane) {
    const int kc = lane & 7, nq = lane >> 3; const float* src = it.W + (size_t)(it.k0 + kc * 8) * it.ldw + it.n0 + nq * 4;
#pragma unroll
    for (int j = 0; j < 8; ++j) v[j] = __builtin_nontemporal_load((const f32x4*)(src + (size_t)j * it.ldw));
}
__device__ __forceinline__ void tr_store(const TrItem& it, f32x4 (&v)[8], int lane) {
    const int kc = lane & 7, nq = lane >> 3;
    if (it.ks) { const f32x4 s0 = *(const f32x4*)(it.ks + it.k0 + kc * 8), s1 = *(const f32x4*)(it.ks + it.k0 + kc * 8 + 4);
#pragma unroll
        for (int j = 0; j < 4; ++j) { v[j] = v[j] * s0[j]; v[4 + j] = v[4 + j] * s1[j]; } }
#pragma unroll
    for (int i = 0; i < 4; ++i) { v4u o; o.x = pk2(v[0][i], v[1][i]); o.y = pk2(v[2][i], v[3][i]); o.z = pk2(v[4][i], v[5][i]); o.w = pk2(v[6][i], v[7][i]);
        *(v4u*)(it.WT + (size_t)(it.drow0 + nq * 4 + i) * it.ldt + it.k0 + kc * 8) = o; }
}
__device__ __forceinline__ void rms_row_to_bf16(const float* xrow, const float* gain, bf16* orow, int lane) {
    const f32x4* xr = (const f32x4*)xrow + lane; const f32x4* gr = (const f32x4*)gain + lane;
    f32x4 v[8]; float s = 0.f;
#pragma unroll
    for (int j = 0; j < 8; ++j) { v[j] = xr[64 * j]; s += (v[j].x * v[j].x + v[j].y * v[j].y) + (v[j].z * v[j].z + v[j].w * v[j].w); }
    const float rstd = 1.0f / sqrtf(wave_sum(s) * (1.f / 2048.f) + EPS);
    v2u* o8 = (v2u*)orow + lane;
#pragma unroll
    for (int j = 0; j < 8; ++j) { const f32x4 g = gr[64 * j]; v2u w; w.x = pk2(v[j].x * rstd * g.x, v[j].y * rstd * g.y); w.y = pk2(v[j].z * rstd * g.z, v[j].w * rstd * g.w); o8[64 * j] = w; }
}

__device__ __forceinline__ void s5_tables(Frame& F, int g) {
    LAS float* ap = (LAS float*)F.lds;
    LAS float* Bb = ap + 33 * 64 * 2;
    LAS float* Cc = Bb + 64 * 16 * 2;
    LAS float* Km = Cc + 16 * 64 * 2;
    const float dt = expf(F.in[I_LOG_DT][g]);
    const float* lre = F.in[I_LAM_RE] + g * 64; const float* lim = F.in[I_LAM_IM] + g * 64;
    for (int idx = F.tid; idx < 33 * 64; idx += 512) { const int tau = idx >> 6, n = idx & 63; const float lr = lre[n], li = lim[n];
        const float mag = expf((float)tau * (lr * dt)), ang = (float)tau * (li * dt); ap[idx * 2] = mag * cosf(ang); ap[idx * 2 + 1] = mag * sinf(ang); }
    __syncthreads();
    for (int idx = F.tid; idx < 64 * 16; idx += 512) { const int n = idx >> 4; const float lr = lre[n], li = lim[n];
        const float nr = ap[(64 + n) * 2] - 1.0f, ni = ap[(64 + n) * 2 + 1], den = lr * lr + li * li;
        const float cr = (nr * lr + ni * li) / den, ci = (ni * lr - nr * li) / den;
        const float br = F.in[I_B_RE][(size_t)g * 1024 + idx], bi = F.in[I_B_IM][(size_t)g * 1024 + idx];
        Bb[idx * 2] = cr * br - ci * bi; Bb[idx * 2 + 1] = cr * bi + ci * br; }
    for (int idx = F.tid; idx < 16 * 64; idx += 512) { Cc[idx * 2] = F.in[I_C_RE][(size_t)g * 1024 + idx]; Cc[idx * 2 + 1] = F.in[I_C_IM][(size_t)g * 1024 + idx]; }
    __syncthreads();
    for (int idx = F.tid; idx < 32 * 256; idx += 512) { const int tau = idx >> 8, c = (idx >> 4) & 15, c2 = idx & 15; float s = 0.f;
        for (int n = 0; n < 64; ++n) { const float ar = ap[(tau * 64 + n) * 2], ai = ap[(tau * 64 + n) * 2 + 1], cr = Cc[(c * 64 + n) * 2], ci = Cc[(c * 64 + n) * 2 + 1];
            const float er = cr * ar - ci * ai, ei = cr * ai + ci * ar; s += er * Bb[(n * 16 + c2) * 2] - ei * Bb[(n * 16 + c2) * 2 + 1]; }
        Km[idx] = s; }
    __syncthreads();
    bf16* MQ = (bf16*)(F.ws + WS_MQ) + (size_t)g * 512 * S5K;
    for (int idx = F.tid; idx < 512 * 80; idx += 512) { const int row = idx / 80, ch = idx % 80, i = row >> 4, c = row & 15, k0 = ch * 8; float v[8];
        if (k0 < 512) { const int s = k0 >> 4, c20 = k0 & 15, tau = i - s;
#pragma unroll
            for (int j = 0; j < 8; ++j) v[j] = tau >= 0 ? Km[(tau * 16 + c) * 16 + c20 + j] : 0.f;
        } else { const int kk = k0 - 512, ri = kk >> 6, n0 = kk & 63;
#pragma unroll
            for (int j = 0; j < 8; ++j) { const int n = n0 + j; const float ar = ap[((i + 1) * 64 + n) * 2], ai = ap[((i + 1) * 64 + n) * 2 + 1], cr = Cc[(c * 64 + n) * 2], ci = Cc[(c * 64 + n) * 2 + 1];
                v[j] = ri == 0 ? (cr * ar - ci * ai) : -(cr * ai + ci * ar); } }
        v4u o; o.x = pk2(v[0], v[1]); o.y = pk2(v[2], v[3]); o.z = pk2(v[4], v[5]); o.w = pk2(v[6], v[7]);
        *(v4u*)(MQ + (size_t)row * S5K + k0) = o; }
    bf16* SP = (bf16*)(F.ws + WS_SP) + (size_t)g * 256 * 512;
    for (int idx = F.tid; idx < 256 * 64; idx += 512) { const int row = idx >> 6, k0 = (idx & 63) * 8; float v[8];
        if (row < 128) { const int ri = row >> 6, n = row & 63, s = k0 >> 4, c20 = k0 & 15; const float ar = ap[((31 - s) * 64 + n) * 2], ai = ap[((31 - s) * 64 + n) * 2 + 1];
#pragma unroll
            for (int j = 0; j < 8; ++j) { const float br = Bb[(n * 16 + c20 + j) * 2], bi = Bb[(n * 16 + c20 + j) * 2 + 1]; v[j] = ri == 0 ? (ar * br - ai * bi) : (ar * bi + ai * br); }
        } else {
#pragma unroll
            for (int j = 0; j < 8; ++j) v[j] = 0.f; }
        v4u o; o.x = pk2(v[0], v[1]); o.y = pk2(v[2], v[3]); o.z = pk2(v[4], v[5]); o.w = pk2(v[6], v[7]);
        *(v4u*)(SP + (size_t)row * 512 + k0) = o; }
    float* AL = (float*)(F.ws + WS_AL) + g * 128;
    if (F.tid < 64) { AL[F.tid * 2] = ap[(32 * 64 + F.tid) * 2]; AL[F.tid * 2 + 1] = ap[(32 * 64 + F.tid) * 2 + 1]; }
    __syncthreads();
}

struct BigTile { const float* src; unsigned char* dst; const float* ks; float sc; int ldw, ldt; };
constexpr int BT_GU = 64 * 2 * 64, BT_D = 64 * 64, BT_N = BT_GU + BT_D, BT_PITCH = 136;
__device__ __forceinline__ BigTile bt_decode(const Frame& F, unsigned char* Wgu8, unsigned char* Wd8, const float* nf, int ti) {
    BigTile t;
    const unsigned long long pg = (unsigned long long)F.in[I_W_GATE], pu = (unsigned long long)F.in[I_W_UP], pd = (unsigned long long)F.in[I_W_DOWN];
    if (ti < BT_GU) { const int e = ti >> 7, r = ti & 127, which = r >> 6, kb = (r >> 2) & 15, nb = r & 3;
        const unsigned long long p = pg + ((pu - pg) & (0ull - (unsigned long long)which));
        t.src = (const float*)p + (size_t)e * D * DEXP + (size_t)kb * 128 * DEXP + nb * 128; t.dst = Wgu8 + ((size_t)e * 1024 + nb * 256 + which * 128) * D + kb * 128; t.ks = nf + kb * 128; t.sc = SC_WGU; t.ldw = DEXP; t.ldt = D; }
    else { const int t2 = ti - BT_GU, e = t2 >> 6, r = t2 & 63, kb = r >> 4, nb = r & 15;
        t.src = (const float*)pd + (size_t)e * DEXP * D + (size_t)kb * 128 * D + nb * 128; t.dst = Wd8 + ((size_t)e * D + nb * 128) * DEXP + kb * 128; t.ks = nullptr; t.sc = SC_WD; t.ldw = D; t.ldt = DEXP; }
    return t;
}
#define BT_LOAD(t, v, kv) do { const unsigned _lo = (unsigned)(rl * 8 * (t).ldw + cq * 4); \
    _Pragma("unroll") for (int _p = 0; _p < 8; ++_p) kv[_p] = (t).ks ? (t).ks[rl * 8 + _p] * (t).sc : (t).sc; \
    _Pragma("unroll") for (int _p = 0; _p < 8; ++_p) v[_p] = __builtin_nontemporal_load((const f32x4*)((t).src + (size_t)_p * (t).ldw + _lo)); } while (0)
#define BT_STORE(t, v, kv) do { \
    _Pragma("unroll") for (int _i = 0; _i < 4; ++_i) { v2u _w; _w.x = pk4_fp8(v[0][_i] * kv[0], v[1][_i] * kv[1], v[2][_i] * kv[2], v[3][_i] * kv[3]); _w.y = pk4_fp8(v[4][_i] * kv[4], v[5][_i] * kv[5], v[6][_i] * kv[6], v[7][_i] * kv[7]); \
        *(LAS v2u*)(img + (cq * 4 + _i) * BT_PITCH + rl * 8) = _w; } \
    __syncthreads(); \
    _Pragma("unroll") for (int _j = 0; _j < 2; ++_j) { const int _idx = tid_ + _j * 512, _n = _idx >> 3, _ch = _idx & 7; \
        const v2u _a = *(const LAS v2u*)(img + _n * BT_PITCH + _ch * 16), _b = *(const LAS v2u*)(img + _n * BT_PITCH + _ch * 16 + 8); v4u _o; _o.x = _a.x; _o.y = _a.y; _o.z = _b.x; _o.w = _b.y; \
        *(v4u*)((t).dst + (size_t)_n * (t).ldt + _ch * 16) = _o; } \
    __syncthreads(); } while (0)
__device__ __forceinline__ void bg_convert(Frame& F, int qword, int base, int ntiles, int budget) {
    if (budget <= 0) return;
    int lane_ = (int)__builtin_amdgcn_mbcnt_hi(~0u, __builtin_amdgcn_mbcnt_lo(~0u, 0u)); asm volatile("" : "+v"(lane_)); const int tid_ = F.wave * 64 + lane_;
    unsigned char* WguT = F.ws + WS_WGU; unsigned char* WdT = F.ws + WS_WD; const float* nf = F.in[I_NORM_FFN];
    const int rl = tid_ >> 5, cq = tid_ & 31; LAS unsigned char* img = F.lds; LAS int* qn = (LAS int*)(F.lds + TAB_OFF + 1024);
    f32x4 va[8], vb[8]; float ka[8], kb[8];
    int nfetch = 0;
#define BG_FETCH(slot) do { if (nfetch < budget) { if (tid_ == 0) qn[slot] = (int)atomicAdd(F.ctl + qword, 1u); } else if (tid_ == 0) qn[slot] = 0x7fffffff; ++nfetch; } while (0)
    __syncthreads();
    BG_FETCH(0); BG_FETCH(1);
    __syncthreads();
    int i0 = __builtin_amdgcn_readfirstlane(qn[0]), i1 = __builtin_amdgcn_readfirstlane(qn[1]);
    __syncthreads();
    if (i0 < ntiles) { const BigTile t0 = bt_decode(F, WguT, WdT, nf, base + i0); BT_LOAD(t0, va, ka); }
    while (i0 < ntiles) {
        const BigTile ta = bt_decode(F, WguT, WdT, nf, base + i0);
        const BigTile tb = bt_decode(F, WguT, WdT, nf, base + (i1 < ntiles ? i1 : i0));
        BT_LOAD(tb, vb, kb);
        if (i1 >= ntiles) budget = 0;
        BG_FETCH(0);
        BT_STORE(ta, va, ka);
        const int i2 = __builtin_amdgcn_readfirstlane(qn[0]);
        if (i1 >= ntiles) break;
        const BigTile tc = bt_decode(F, WguT, WdT, nf, base + (i2 < ntiles ? i2 : i1));
        BT_LOAD(tc, va, ka);
        if (i2 >= ntiles) budget = 0;
        BG_FETCH(1);
        BT_STORE(tb, vb, kb);
        const int i3 = __builtin_amdgcn_readfirstlane(qn[1]);
        i0 = i2; i1 = i3;
    }
    __syncthreads();
#undef BG_FETCH
}
__device__ __forceinline__ void p0_prologue(Frame& F) {
    if (F.vcu < 32) s5_tables(F, F.vcu);
    const int gw = F.vcu * 8 + F.wave, NGW = F.G * 8;
    bf16* WinT = (bf16*)(F.ws + WS_WIN); bf16* WoT = (bf16*)(F.ws + WS_WO); bf16* WmkvT = (bf16*)(F.ws + WS_WMKV); bf16* WgluT = (bf16*)(F.ws + WS_WGLU);
    const float* nf = F.in[I_NORM_FFN];
    constexpr int I_IN = 32 * 72, I_O = 32 * 64, I_MKV = 32 * 32, I_GLU = 8 * 16;
    constexpr int NITEMS = I_IN + I_O + I_MKV + I_GLU;
    auto decode = [&](int it) -> TrItem {
        int r = it;
        if (r < I_IN) { const int kb = r / 72, nb = r % 72; return TrItem{F.in[I_W_IN], WinT, nullptr, INC, D, kb * 64, nb * 32, nb * 32}; } r -= I_IN;
        if (r < I_O) { const int kb = r / 64, nb = r % 64; return TrItem{F.in[I_W_O], WoT, nullptr, D, D, kb * 64, nb * 32, nb * 32}; } r -= I_O;
        if (r < I_MKV) { const int kb = r / 32, nb = r % 32; return TrItem{F.in[I_W_MEM_KV], WmkvT, nullptr, 1024, D, kb * 64, nb * 32, nb * 32}; } r -= I_MKV;
        const int kb = r / 16, nb = r % 16; return TrItem{F.in[I_W_GLU], WgluT, nullptr, 512, 512, kb * 64, nb * 32, nb * 32};
    };
    {
        f32x4 va[8], vb[8]; int it = gw; TrItem ia, ib;
        if (it < NITEMS) { ia = decode(it); tr_load(ia, va, F.lane); }
        while (it < NITEMS) {
            const int it2 = it + NGW; if (it2 < NITEMS) { ib = decode(it2); tr_load(ib, vb, F.lane); }
            tr_store(ia, va, F.lane);
            if (it2 >= NITEMS) break;
            const int it3 = it2 + NGW; if (it3 < NITEMS) { ia = decode(it3); tr_load(ia, va, F.lane); }
            tr_store(ib, vb, F.lane);
            it = it3;
        }
    }
    { bf16* WrT = (bf16*)(F.ws + WS_WR); const int gt = F.vcu * 512 + F.tid, NT = F.G * 512;
      for (int idx = gt; idx < 4 * 256 * 512; idx += NT) { const int ks = idx >> 17, n = (idx >> 9) & 255, k = ks * 512 + (idx & 511); float v = 0.f;
          if (n < 8) v = F.in[I_WR_G][k * 8 + n] * nf[k]; else if (n < 72) v = F.in[I_WR_E][k * 64 + (n - 8)] * nf[k];
          WrT[idx] = (bf16)f2bf(v); } }
    bf16* XN = (bf16*)(F.ws + WS_XN); bf16* MEMN = (bf16*)(F.ws + WS_MEMN);
    for (int m = gw; m < T; m += NGW) rms_row_to_bf16(F.in[I_X] + (size_t)m * D, F.in[I_NORM_MIX], XN + (size_t)m * D, F.lane);
    for (int m = gw; m < NB * MEML; m += NGW) rms_row_to_bf16(F.in[I_MEM] + (size_t)m * D, F.in[I_MEM_NORM], MEMN + (size_t)m * D, F.lane);
    bg_convert(F, CW_QGU, 0, BT_GU, F.vcu < 32 ? PB0_S5 : PB0);
    bg_convert(F, CW_QD, BT_GU, BT_D, PB0_D);
}

constexpr int SWA_KS = 72, SWA_VS = 264;
constexpr int SWA_KOFF = 0, SWA_VOFF = 256 * SWA_KS * 2, SWA_BOFF = SWA_VOFF + 64 * SWA_VS * 2;
__device__ __forceinline__ int t5_bucket(int n) { if (n < 16) return n; const int v = 16 + (int)(logf((float)n * (1.0f / 16.0f)) / logf(8.0f) * 16.0f); return v < 31 ? v : 31; }
__device__ __forceinline__ void swa_unit(Frame& F, int unit) {
    const int b = unit >> 5, kvh = (unit >> 4) & 1, nb = unit & 15;
    const bf16* PROJ = (const bf16*)(F.ws + WS_PROJ); bf16* MIX = (bf16*)(F.ws + WS_MIX);
    LAS bf16* Ks = (LAS bf16*)(F.lds + SWA_KOFF); LAS bf16* Vt = (LAS bf16*)(F.lds + SWA_VOFF); LAS float* bt = (LAS float*)(F.lds + SWA_BOFF);
    __syncthreads();
    {
        const int key = F.tid >> 1, half = F.tid & 1, s = (nb - 1) * 128 + key;
        v4u kw[4], vw[4];
        if (s >= 0) { const bf16* rp = PROJ + (size_t)(b * SEQ + s) * INC + 1024 + kvh * 64 + half * 32;
#pragma unroll
            for (int j = 0; j < 4; ++j) { kw[j] = *(const v4u*)(rp + j * 8); vw[j] = *(const v4u*)(rp + 128 + j * 8); }
        } else {
#pragma unroll
            for (int j = 0; j < 4; ++j) { kw[j] = (v4u){0u, 0u, 0u, 0u}; vw[j] = (v4u){0u, 0u, 0u, 0u}; } }
        float kf[32]; float ss = 0.f;
#pragma unroll
        for (int j = 0; j < 4; ++j) { kf[j * 8 + 0] = bflo(kw[j].x); kf[j * 8 + 1] = bfhi(kw[j].x); kf[j * 8 + 2] = bflo(kw[j].y); kf[j * 8 + 3] = bfhi(kw[j].y);
            kf[j * 8 + 4] = bflo(kw[j].z); kf[j * 8 + 5] = bfhi(kw[j].z); kf[j * 8 + 6] = bflo(kw[j].w); kf[j * 8 + 7] = bfhi(kw[j].w); }
#pragma unroll
        for (int j = 0; j < 32; ++j) ss += kf[j] * kf[j];
        ss += __shfl_xor(ss, 1);
        const float rstd = 1.0f / sqrtf(ss * (1.f / 64.f) + EPS);
        const float* kn = F.in[I_K_NORM] + half * 32;
#pragma unroll
        for (int j = 0; j < 4; ++j) { v4u o; o.x = pk2(kf[j * 8 + 0] * rstd * kn[j * 8 + 0], kf[j * 8 + 1] * rstd * kn[j * 8 + 1]); o.y = pk2(kf[j * 8 + 2] * rstd * kn[j * 8 + 2], kf[j * 8 + 3] * rstd * kn[j * 8 + 3]);
            o.z = pk2(kf[j * 8 + 4] * rstd * kn[j * 8 + 4], kf[j * 8 + 5] * rstd * kn[j * 8 + 5]); o.w = pk2(kf[j * 8 + 6] * rstd * kn[j * 8 + 6], kf[j * 8 + 7] * rstd * kn[j * 8 + 7]);
            *(LAS v4u*)(Ks + key * SWA_KS + half * 32 + j * 8) = o; }
#pragma unroll
        for (int j = 0; j < 4; ++j) { const unsigned w4[4] = {vw[j].x, vw[j].y, vw[j].z, vw[j].w};
#pragma unroll
            for (int q = 0; q < 4; ++q) { const int d = half * 32 + j * 8 + q * 2; Vt[d * SWA_VS + key] = (bf16)(w4[q] & 0xffffu); Vt[(d + 1) * SWA_VS + key] = (bf16)(w4[q] >> 16); } }
        for (int idx = F.tid; idx < 8 * 128; idx += 512) { const int w = idx >> 7, dl = idx & 127; bt[idx] = F.in[I_REL_BIAS][t5_bucket(dl) * 16 + kvh * 8 + w]; }
    }
    __syncthreads();
    const int w = F.wave, h = kvh * 8 + w, ql = F.lane & 31, hh = F.lane >> 5;
    const float sink = F.in[I_SINKS][h];
    const float* qn = F.in[I_Q_NORM];
    for (int r = 0; r < 4; ++r) {
        const int qi = 32 * r + ql; const size_t t = (size_t)b * SEQ + nb * 128 + qi;
        bf16x8 qf[4];
        {   const bf16* qp = PROJ + t * INC + h * 64 + 8 * hh; v4u qw[4]; float qv[32]; float ss = 0.f;
#pragma unroll
            for (int ks = 0; ks < 4; ++ks) qw[ks] = *(const v4u*)(qp + ks * 16);
#pragma unroll
            for (int ks = 0; ks < 4; ++ks) { qv[ks * 8 + 0] = bflo(qw[ks].x); qv[ks * 8 + 1] = bfhi(qw[ks].x); qv[ks * 8 + 2] = bflo(qw[ks].y); qv[ks * 8 + 3] = bfhi(qw[ks].y);
                qv[ks * 8 + 4] = bflo(qw[ks].z); qv[ks * 8 + 5] = bfhi(qw[ks].z); qv[ks * 8 + 6] = bflo(qw[ks].w); qv[ks * 8 + 7] = bfhi(qw[ks].w); }
#pragma unroll
            for (int j = 0; j < 32; ++j) ss += qv[j] * qv[j];
            ss += __shfl_xor(ss, 32);
            const float sc = 0.125f / sqrtf(ss * (1.f / 64.f) + EPS);
#pragma unroll
            for (int ks = 0; ks < 4; ++ks) { const float* g = qn + ks * 16 + 8 * hh; v4u o;
                o.x = pk2(qv[ks * 8 + 0] * sc * g[0], qv[ks * 8 + 1] * sc * g[1]); o.y = pk2(qv[ks * 8 + 2] * sc * g[2], qv[ks * 8 + 3] * sc * g[3]);
                o.z = pk2(qv[ks * 8 + 4] * sc * g[4], qv[ks * 8 + 5] * sc * g[5]); o.w = pk2(qv[ks * 8 + 6] * sc * g[6], qv[ks * 8 + 7] * sc * g[7]);
                qf[ks] = __builtin_bit_cast(bf16x8, o); } }
        f32x16 s[5];
        const int qh = ql - 4 * hh; const LAS float* pb = bt + w * 128 + qh;
        float mx = sink;
#pragma unroll
        for (int kt = 0; kt < 5; ++kt) {
            const bool live = (nb > 0) || (r + kt >= 4);
            f32x16 a = {0.f, 0.f, 0.f, 0.f, 0.f, 0.f, 0.f, 0.f, 0.f, 0.f, 0.f, 0.f, 0.f, 0.f, 0.f, 0.f};
            if (live) {
#pragma unroll
                for (int ks = 0; ks < 4; ++ks) { const bf16x8 kfrag = *(const LAS bf16x8*)(Ks + (32 * (r + kt) + ql) * SWA_KS + ks * 16 + 8 * hh);
                    a = __builtin_amdgcn_mfma_f32_32x32x16_bf16(kfrag, qf[ks], a, 0, 0, 0); }
#pragma unroll
                for (int rg = 0; rg < 16; ++rg) { const int rowc = (rg & 3) + 8 * (rg >> 2);
                    float v = a[rg] + pb[128 - 32 * kt - rowc];
                    if (kt == 0) v = (rowc > qh) ? v : -1e30f;
                    if (kt == 4) v = (rowc <= qh) ? v : -1e30f;
                    a[rg] = v; mx = fmaxf(mx, v); }
            } else {
#pragma unroll
                for (int rg = 0; rg < 16; ++rg) a[rg] = -1e30f;
            }
            s[kt] = a; }
        mx = fmaxf(mx, __shfl_xor(mx, 32));
        float l = 0.f;
#pragma unroll
        for (int kt = 0; kt < 5; ++kt)
#pragma unroll
            for (int rg = 0; rg < 16; ++rg) { const float p = fast_exp(s[kt][rg] - mx); s[kt][rg] = p; l += p; }
        l += __shfl_xor(l, 32);
        l += fast_exp(sink - mx);
        f32x16 o[2];
#pragma unroll
        for (int dt = 0; dt < 2; ++dt) o[dt] = (f32x16){0.f, 0.f, 0.f, 0.f, 0.f, 0.f, 0.f, 0.f, 0.f, 0.f, 0.f, 0.f, 0.f, 0.f, 0.f, 0.f};
#pragma unroll
        for (int kt = 0; kt < 5; ++kt)
#pragma unroll
            for (int st = 0; st < 2; ++st) { v4u pw; pw.x = pk2(s[kt][8 * st + 0], s[kt][8 * st + 1]); pw.y = pk2(s[kt][8 * st + 2], s[kt][8 * st + 3]); pw.z = pk2(s[kt][8 * st + 4], s[kt][8 * st + 5]); pw.w = pk2(s[kt][8 * st + 6], s[kt][8 * st + 7]);
                const bf16x8 pf = __builtin_bit_cast(bf16x8, pw);
#pragma unroll
                for (int dt = 0; dt < 2; ++dt) { const LAS bf16* vp = Vt + (dt * 32 + ql) * SWA_VS + 32 * (r + kt) + 16 * st + 4 * hh;
                    const v2u lo = *(const LAS v2u*)vp, hi = *(const LAS v2u*)(vp + 8); v4u vv; vv.x = lo.x; vv.y = lo.y; vv.z = hi.x; vv.w = hi.y;
                    o[dt] = __builtin_amdgcn_mfma_f32_32x32x16_bf16(__builtin_bit_cast(bf16x8, vv), pf, o[dt], 0, 0, 0); } }
        const float inv = 1.0f / l;
        bf16* op = MIX + t * D + h * 64 + 4 * hh;
#pragma unroll
        for (int dt = 0; dt < 2; ++dt)
#pragma unroll
            for (int q4 = 0; q4 < 4; ++q4) { v2u ow; ow.x = pk2(o[dt][q4 * 4 + 0] * inv, o[dt][q4 * 4 + 1] * inv); ow.y = pk2(o[dt][q4 * 4 + 2] * inv, o[dt][q4 * 4 + 3] * inv);
                *(v2u*)(op + dt * 32 + q4 * 8) = ow; }
    }
}

constexpr int XA_KS = 136, XA_VS = 264;
constexpr int XA_KOFF = 0, XA_VOFF = 256 * XA_KS * 2;
__device__ __forceinline__ void xattn_unit(Frame& F, int unit) {
    const int b = unit >> 5, hx = (unit >> 3) & 3, qb = unit & 7;
    const bf16* PROJ = (const bf16*)(F.ws + WS_PROJ); const bf16* MKV = (const bf16*)(F.ws + WS_MEMKV); bf16* MIX = (bf16*)(F.ws + WS_MIX);
    LAS bf16* Ks = (LAS bf16*)(F.lds + XA_KOFF); LAS bf16* Vt = (LAS bf16*)(F.lds + XA_VOFF);
    __syncthreads();
    {   const int key = F.tid >> 1, half = F.tid & 1; const bf16* rp = MKV + (size_t)(b * MEML + key) * 1024 + hx * 128 + half * 64;
        float ss = 0.f; v4u kw[8];
#pragma unroll
        for (int j = 0; j < 8; ++j) { kw[j] = *(const v4u*)(rp + j * 8);
            const float a0 = bflo(kw[j].x), a1 = bfhi(kw[j].x), a2 = bflo(kw[j].y), a3 = bfhi(kw[j].y), a4 = bflo(kw[j].z), a5 = bfhi(kw[j].z), a6 = bflo(kw[j].w), a7 = bfhi(kw[j].w);
            ss += (a0 * a0 + a1 * a1) + (a2 * a2 + a3 * a3) + (a4 * a4 + a5 * a5) + (a6 * a6 + a7 * a7); }
        ss += __shfl_xor(ss, 1);
        const float rstd = 1.0f / sqrtf(ss * (1.f / 128.f) + EPS);
        const float* kn = F.in[I_XK_NORM] + half * 64;
#pragma unroll
        for (int j = 0; j < 8; ++j) { v4u o; const float* g = kn + j * 8;
            o.x = pk2(bflo(kw[j].x) * rstd * g[0], bfhi(kw[j].x) * rstd * g[1]); o.y = pk2(bflo(kw[j].y) * rstd * g[2], bfhi(kw[j].y) * rstd * g[3]);
            o.z = pk2(bflo(kw[j].z) * rstd * g[4], bfhi(kw[j].z) * rstd * g[5]); o.w = pk2(bflo(kw[j].w) * rstd * g[6], bfhi(kw[j].w) * rstd * g[7]);
            *(LAS v4u*)(Ks + key * XA_KS + half * 64 + j * 8) = o; }
#pragma unroll
        for (int j = 0; j < 8; ++j) { const v4u vw = *(const v4u*)(rp + 512 + j * 8); const unsigned w4[4] = {vw.x, vw.y, vw.z, vw.w};
#pragma unroll
            for (int q = 0; q < 4; ++q) { const int d = half * 64 + j * 8 + q * 2; Vt[d * XA_VS + key] = (bf16)(w4[q] & 0xffffu); Vt[(d + 1) * XA_VS + key] = (bf16)(w4[q] >> 16); } }
    }
    __syncthreads();
    const int ql = F.lane & 31, hh = F.lane >> 5;
    const size_t t = (size_t)b * SEQ + qb * 256 + F.wave * 32 + ql;
    bf16x8 qf[8];
    {   const bf16* qp = PROJ + t * INC + 1792 + hx * 128 + 8 * hh; v4u qw[8]; float ss = 0.f;
#pragma unroll
        for (int ks = 0; ks < 8; ++ks) { qw[ks] = *(const v4u*)(qp + ks * 16);
            const float a0 = bflo(qw[ks].x), a1 = bfhi(qw[ks].x), a2 = bflo(qw[ks].y), a3 = bfhi(qw[ks].y), a4 = bflo(qw[ks].z), a5 = bfhi(qw[ks].z), a6 = bflo(qw[ks].w), a7 = bfhi(qw[ks].w);
            ss += (a0 * a0 + a1 * a1) + (a2 * a2 + a3 * a3) + (a4 * a4 + a5 * a5) + (a6 * a6 + a7 * a7); }
        ss += __shfl_xor(ss, 32);
        const float sc = 0.08838834764831845f / sqrtf(ss * (1.f / 128.f) + EPS);
        const float* qn = F.in[I_XQ_NORM] + 8 * hh;
#pragma unroll
        for (int ks = 0; ks < 8; ++ks) { const float* g = qn + ks * 16; v4u o;
            o.x = pk2(bflo(qw[ks].x) * sc * g[0], bfhi(qw[ks].x) * sc * g[1]); o.y = pk2(bflo(qw[ks].y) * sc * g[2], bfhi(qw[ks].y) * sc * g[3]);
            o.z = pk2(bflo(qw[ks].z) * sc * g[4], bfhi(qw[ks].z) * sc * g[5]); o.w = pk2(bflo(qw[ks].w) * sc * g[6], bfhi(qw[ks].w) * sc * g[7]);
            qf[ks] = __builtin_bit_cast(bf16x8, o); } }
    f32x16 o[4];
#pragma unroll
    for (int dt = 0; dt < 4; ++dt) o[dt] = (f32x16){0.f, 0.f, 0.f, 0.f, 0.f, 0.f, 0.f, 0.f, 0.f, 0.f, 0.f, 0.f, 0.f, 0.f, 0.f, 0.f};
    float mrun = -1e30f, lrun = 0.f;
    for (int kb = 0; kb < 4; ++kb) {
        f32x16 s[2];
#pragma unroll
        for (int kt = 0; kt < 2; ++kt) { f32x16 a = {0.f, 0.f, 0.f, 0.f, 0.f, 0.f, 0.f, 0.f, 0.f, 0.f, 0.f, 0.f, 0.f, 0.f, 0.f, 0.f};
#pragma unroll
            for (int ks = 0; ks < 8; ++ks) { const bf16x8 kfrag = *(const LAS bf16x8*)(Ks + (64 * kb + 32 * kt + ql) * XA_KS + ks * 16 + 8 * hh);
                a = __builtin_amdgcn_mfma_f32_32x32x16_bf16(kfrag, qf[ks], a, 0, 0, 0); }
            s[kt] = a; }
        float mx = mrun;
#pragma unroll
        for (int kt = 0; kt < 2; ++kt)
#pragma unroll
            for (int rg = 0; rg < 16; ++rg) mx = fmaxf(mx, s[kt][rg]);
        mx = fmaxf(mx, __shfl_xor(mx, 32));
        const float alpha = fast_exp(mrun - mx); mrun = mx;
        float ls = 0.f;
#pragma unroll
        for (int kt = 0; kt < 2; ++kt)
#pragma unroll
            for (int rg = 0; rg < 16; ++rg) { const float p = fast_exp(s[kt][rg] - mx); s[kt][rg] = p; ls += p; }
        lrun = lrun * alpha + ls;
#pragma unroll
        for (int dt = 0; dt < 4; ++dt)
#pragma unroll
            for (int rg = 0; rg < 16; ++rg) o[dt][rg] *= alpha;
#pragma unroll
        for (int kt = 0; kt < 2; ++kt)
#pragma unroll
            for (int st = 0; st < 2; ++st) { v4u pw; pw.x = pk2(s[kt][8 * st + 0], s[kt][8 * st + 1]); pw.y = pk2(s[kt][8 * st + 2], s[kt][8 * st + 3]); pw.z = pk2(s[kt][8 * st + 4], s[kt][8 * st + 5]); pw.w = pk2(s[kt][8 * st + 6], s[kt][8 * st + 7]);
                const bf16x8 pf = __builtin_bit_cast(bf16x8, pw);
#pragma unroll
                for (int dt = 0; dt < 4; ++dt) { const LAS bf16* vp = Vt + (dt * 32 + ql) * XA_VS + 64 * kb + 32 * kt + 16 * st + 4 * hh;
                    const v2u lo = *(const LAS v2u*)vp, hi = *(const LAS v2u*)(vp + 8); v4u vv; vv.x = lo.x; vv.y = lo.y; vv.z = hi.x; vv.w = hi.y;
                    o[dt] = __builtin_amdgcn_mfma_f32_32x32x16_bf16(__builtin_bit_cast(bf16x8, vv), pf, o[dt], 0, 0, 0); } }
    }
    lrun += __shfl_xor(lrun, 32);
    const float inv = 1.0f / lrun;
    bf16* op = MIX + t * D + 1536 + hx * 128 + 4 * hh;
#pragma unroll
    for (int dt = 0; dt < 4; ++dt)
#pragma unroll
        for (int q4 = 0; q4 < 4; ++q4) { v2u ow; ow.x = pk2(o[dt][q4 * 4 + 0] * inv, o[dt][q4 * 4 + 1] * inv); ow.y = pk2(o[dt][q4 * 4 + 2] * inv, o[dt][q4 * 4 + 3] * inv);
            *(v2u*)(op + dt * 32 + q4 * 8) = ow; }
}

__device__ __forceinline__ void moe_tables(Frame& F) {
    LAS int* cnt = (LAS int*)(F.lds + TAB_OFF); LAS int* ts = cnt + 64;
    __syncthreads();
    if (F.tid < 64) { const int c = (int)__hip_atomic_load(F.ctl + CW_CNT + F.tid, __ATOMIC_RELAXED, __HIP_MEMORY_SCOPE_AGENT); const int nt = (c + 255) >> 8; int inc = nt;
#pragma unroll
        for (int o = 1; o < 64; o <<= 1) { const int v = __shfl_up(inc, o); if (F.tid >= o) inc += v; }
        cnt[F.tid] = c; ts[F.tid + 1] = inc; if (F.tid == 0) ts[0] = 0; }
    __syncthreads();
}

struct Args { const float* in[31]; float* out; unsigned char* ws; int ph_lo, ph_hi; };
__global__ void __launch_bounds__(512, 2) hymba_fwd(Args args) {
    extern __shared__ __attribute__((aligned(16))) unsigned char lds_raw[];
    Frame F;
    F.lds = (LAS unsigned char*)lds_raw;
    F.tid = threadIdx.x; F.lane = F.tid & 63; F.wave = __builtin_amdgcn_readfirstlane(F.tid >> 6);
    F.G = gridDim.x; { const int bx = blockIdx.x; F.vcu = (F.G % 8 == 0) ? (bx % 8) * (F.G / 8) + bx / 8 : bx; }
    F.in = (const float* const __attribute__((address_space(4)))*)__builtin_amdgcn_kernarg_segment_ptr();
    F.out = args.out; F.ws = args.ws; F.ctl = (unsigned*)(args.ws + WS_CTL);
    const int lo = args.ph_lo, hi = args.ph_hi;
#if !MK_PER_PHASE
    if (F.tid < 4) ((LAS unsigned*)(F.lds + XBW_OFF))[F.tid] = 0u;
    __syncthreads();
    XcdBarrier bar = xcd_barrier_post(F.ctl + CW_BAR, (volatile LAS unsigned*)(F.lds + XBW_OFF));
#define GRID_BAR() xcd_barrier(bar)
#else
#define GRID_BAR() do {} while (0)
#endif
#define PHASE_REGS() do { int _l = (int)__builtin_amdgcn_mbcnt_hi(~0u, __builtin_amdgcn_mbcnt_lo(~0u, 0u)); asm volatile("" : "+v"(_l)); F.lane = _l; F.tid = F.wave * 64 + _l; } while (0)
#define IN(k) (lo <= (k) && (k) < hi)
#define SEAM(k) do { if (IN(k) && IN((k) + 1)) GRID_BAR(); } while (0)
    const int gw = F.vcu * 8 + F.wave, NGW = F.G * 8;
    bf16* const XN = (bf16*)(F.ws + WS_XN); bf16* const PROJ = (bf16*)(F.ws + WS_PROJ); bf16* const MIX = (bf16*)(F.ws + WS_MIX);
    bf16* const UA = (bf16*)(F.ws + WS_UA); bf16* const Gm = (bf16*)(F.ws + WS_G);

    if (IN(0)) { PHASE_REGS(); p0_prologue(F); }
    SEAM(0);
    if (IN(1)) { PHASE_REGS();
        { pg8::Gemm g{D, D, D}; pg8::DenseOrder S; S.init(XN, F.ws + WS_WIN, D, D, T, INC, F.G, (int)blockIdx.x);
          pg8::EpiProj E{PROJ, UA}; pg8::gemm_phase<pg8::EpiProj, pg8::DenseOrder>(F.lds, g, S, E, F.wave); }
        { pg8::Gemm g{D, D, D}; pg8::DenseOrder S; S.init(F.ws + WS_MEMN, F.ws + WS_WMKV, D, D, NB * MEML, 1024, F.G, F.G - 1 - (int)blockIdx.x);
          pg8::EpiBf16 E{(bf16*)(F.ws + WS_MEMKV), 1024}; pg8::gemm_phase<pg8::EpiBf16, pg8::DenseOrder>(F.lds, g, S, E, F.wave); }
        { const int c = (int)blockIdx.x; const bool has3 = 2 * F.G + c < (T / 256) * (INC / 256), haskv = (F.G - 1 - c) < (NB * MEML / 256) * 4;
          bg_convert(F, CW_QGU, 0, BT_GU, (!has3 && !haskv) ? PB1 : 0); }
    }
    SEAM(1);
    if (IN(2)) { PHASE_REGS();
        for (int u = F.vcu; u < 256; u += F.G) swa_unit(F, u);
        __syncthreads();
        { pg8::Gemm g{S5K, 512, 512}; pg8::GroupOrder S{(const char*)UA, (const char*)(F.ws + WS_SP), S5K, 512, 1, 32, F.G, F.G - 1 - F.vcu};
          pg8::EpiF32 E{(float*)(F.ws + WS_SL), 256, (size_t)512 * 256}; pg8::gemm_phase<pg8::EpiF32, pg8::GroupOrder>(F.lds, g, S, E, F.wave); }
        bg_convert(F, CW_QGU, 0, BT_GU, (F.G - 1 - F.vcu) >= 64 ? PB2 : 0);
    }
    SEAM(2);
    if (IN(3)) { PHASE_REGS();
        if (F.wave == 0) {
            const float* SL = (const float*)(F.ws + WS_SL); const float* AL = (const float*)(F.ws + WS_AL);
            for (int p = F.vcu; p < 256; p += F.G) { const int b = p >> 5, g = p & 31, n = F.lane;
                const float ar = AL[(g * 64 + n) * 2], ai = AL[(g * 64 + n) * 2 + 1]; float xr = 0.f, xi = 0.f;
                for (int j0 = 0; j0 < 64; j0 += 8) { float sr[8], si[8];
#pragma unroll
                    for (int j = 0; j < 8; ++j) { const float* sp = SL + ((size_t)(g * 512 + b * 64 + j0 + j)) * 256; sr[j] = sp[n]; si[j] = sp[64 + n]; }
#pragma unroll
                    for (int j = 0; j < 8; ++j) { bf16* up = UA + ((size_t)(g * 512 + b * 64 + j0 + j)) * S5K + 512; up[n] = (bf16)f2bf(xr); up[64 + n] = (bf16)f2bf(xi);
                        const float nr = ar * xr - ai * xi + sr[j], ni = ar * xi + ai * xr + si[j]; xr = nr; xi = ni; } } }
        }
        if (F.G < 256) { for (int u = F.vcu; u < 256; u += F.G) xattn_unit(F, u); __syncthreads(); }
    }
    SEAM(3);
    if (IN(4)) { PHASE_REGS();
        pg8::Gemm g{S5K, S5K, S5K}; pg8::GroupOrder S{(const char*)UA, (const char*)(F.ws + WS_MQ), S5K, S5K, 2, 32, F.G, F.vcu};
        pg8::EpiS5Y E{UA, F.in[I_SSM_D], Gm}; pg8::gemm_phase<pg8::EpiS5Y, pg8::GroupOrder>(F.lds, g, S, E, F.wave);
        if (F.G >= 256 && F.vcu >= 128) { for (int u = F.vcu - 128; u < 128; u += F.G - 128) xattn_unit(F, u); __syncthreads(); }
    }
    SEAM(4);
    if (IN(5)) { PHASE_REGS();
        pg8::Gemm g{512, 512, 512}; pg8::DenseOrder S; S.init(Gm, F.ws + WS_WGLU, 512, 512, T, 512, F.G, (int)blockIdx.x);
        pg8::EpiGlu E{Gm, MIX}; pg8::gemm_phase<pg8::EpiGlu, pg8::DenseOrder>(F.lds, g, S, E, F.wave);
        if (F.G >= 256 && (int)blockIdx.x >= 128) { for (int u = 128 + (int)blockIdx.x - 128; u < 256; u += F.G - 128) xattn_unit(F, u); __syncthreads(); }
    }
    SEAM(5);
    if (IN(6)) { PHASE_REGS();
        for (int m = gw; m < T; m += NGW) { v4u* rp = (v4u*)(MIX + (size_t)m * D) + F.lane; v4u w[4]; float ss[4];
#pragma unroll
            for (int j = 0; j < 4; ++j) { w[j] = rp[64 * j];
                const float a0 = bflo(w[j].x), a1 = bfhi(w[j].x), a2 = bflo(w[j].y), a3 = bfhi(w[j].y), a4 = bflo(w[j].z), a5 = bfhi(w[j].z), a6 = bflo(w[j].w), a7 = bfhi(w[j].w);
                ss[j] = (a0 * a0 + a1 * a1) + (a2 * a2 + a3 * a3) + (a4 * a4 + a5 * a5) + (a6 * a6 + a7 * a7); }
            const float sa = wave_sum(ss[0] + ss[1]), sb = wave_sum(ss[2]), sc = wave_sum(ss[3]);
            const float ra = 1.0f / sqrtf(sa * (1.f / 1024.f) + EPS), rb = 1.0f / sqrtf(sb * (1.f / 512.f) + EPS), rc = 1.0f / sqrtf(sc * (1.f / 512.f) + EPS);
#pragma unroll
            for (int j = 0; j < 4; ++j) { const float rs = j < 2 ? ra : (j == 2 ? rb : rc);
                const float* g = (j < 2 ? F.in[I_ON_ATTN] + j * 512 : (j == 2 ? F.in[I_ON_SSM] : F.in[I_ON_X])) + F.lane * 8; v4u o;
                o.x = pk2(bflo(w[j].x) * rs * g[0], bfhi(w[j].x) * rs * g[1]); o.y = pk2(bflo(w[j].y) * rs * g[2], bfhi(w[j].y) * rs * g[3]);
                o.z = pk2(bflo(w[j].z) * rs * g[4], bfhi(w[j].z) * rs * g[5]); o.w = pk2(bflo(w[j].w) * rs * g[6], bfhi(w[j].w) * rs * g[7]);
                rp[64 * j] = o; } }
    }
    SEAM(6);
    if (IN(7)) { PHASE_REGS();
        pg8::Gemm g{D, D, D}; pg8::DenseOrder S; S.init(MIX, F.ws + WS_WO, D, D, T, D, F.G, (int)blockIdx.x);
        pg8::EpiWo E{F.in[I_X], XN, (unsigned char*)(F.ws + WS_X18), (float*)(F.ws + WS_PART)}; pg8::gemm_phase<pg8::EpiWo, pg8::DenseOrder>(F.lds, g, S, E, F.wave);
    }
    SEAM(7);
    if (IN(8)) { PHASE_REGS();
        pg8::Gemm g{D, 512, 512}; pg8::KSplitOrder S{(const char*)XN, (const char*)(F.ws + WS_WR), D, 512, 512, T / 256, 4, F.G, F.vcu};
        pg8::EpiLogit E{(float*)(F.ws + WS_LP)}; pg8::gemm_phase<pg8::EpiLogit, pg8::KSplitOrder>(F.lds, g, S, E, F.wave);
    }
    SEAM(8);
    const int rt_per = (T + F.G - 1) / F.G, rt_beg = F.vcu * rt_per, rt_end = (rt_beg + rt_per) < T ? (rt_beg + rt_per) : T;
    if (IN(9)) { PHASE_REGS();
        LAS int* hist = (LAS int*)F.lds;
        const float* LP = (const float*)(F.ws + WS_LP); const float* part = (const float*)(F.ws + WS_PART); float* rstdv = (float*)(F.ws + WS_RSTD);
        int* toke = (int*)(F.ws + WS_TOKE); float* wts = (float*)(F.ws + WS_WTS); int* HIST = (int*)(F.ws + WS_HIST);
        __syncthreads();
        if (F.tid < 64) hist[F.tid] = 0;
        __syncthreads();
        for (int t = rt_beg + F.tid; t < rt_end; t += 512) {
            const f32x4* pp = (const f32x4*)(part + (size_t)t * 32); float ss = 0.f;
#pragma unroll
            for (int j = 0; j < 8; ++j) { const f32x4 v = pp[j]; ss += (v[0] + v[1]) + (v[2] + v[3]); }
            const float rs = 1.0f / sqrtf(ss * (1.f / 2048.f) + EPS); rstdv[t] = rs;
            const float* l0 = LP + (size_t)t * 80; const float* l1 = l0 + (size_t)T * 80; const float* l2 = l1 + (size_t)T * 80; const float* l3 = l2 + (size_t)T * 80;
            float gl[8];
#pragma unroll
            for (int j = 0; j < 8; j += 4) { const f32x4 a = *(const f32x4*)(l0 + j), b = *(const f32x4*)(l1 + j), c = *(const f32x4*)(l2 + j), d = *(const f32x4*)(l3 + j);
#pragma unroll
                for (int q = 0; q < 4; ++q) gl[j + q] = rs * (((a[q] + b[q]) + c[q]) + d[q]); }
            int gi = 0; float gm = gl[0];
#pragma unroll
            for (int j = 1; j < 8; ++j) if (gl[j] > gm) { gm = gl[j]; gi = j; }
            float gs = 0.f;
#pragma unroll
            for (int j = 0; j < 8; ++j) gs += expf(gl[j] - gm);
            const float gate = 1.0f / gs;
            float el[8];
#pragma unroll
            for (int j = 0; j < 8; j += 4) { const int o = 8 + gi * 8 + j; const f32x4 a = *(const f32x4*)(l0 + o), b = *(const f32x4*)(l1 + o), c = *(const f32x4*)(l2 + o), d = *(const f32x4*)(l3 + o);
#pragma unroll
                for (int q = 0; q < 4; ++q) el[j + q] = rs * (((a[q] + b[q]) + c[q]) + d[q]); }
            int i1 = 0; float v1 = el[0];
#pragma unroll
            for (int j = 1; j < 8; ++j) if (el[j] > v1) { v1 = el[j]; i1 = j; }
            int i2 = -1; float v2 = -3.0e38f;
#pragma unroll
            for (int j = 0; j < 8; ++j) if (j != i1 && el[j] > v2) { v2 = el[j]; i2 = j; }
            const float ex = expf(v2 - v1);
            const int ea = gi * 8 + i1, eb = gi * 8 + i2;
            const int la = __hip_atomic_fetch_add(hist + ea, 1, __ATOMIC_RELAXED, __HIP_MEMORY_SCOPE_WORKGROUP), lb = __hip_atomic_fetch_add(hist + eb, 1, __ATOMIC_RELAXED, __HIP_MEMORY_SCOPE_WORKGROUP);
            toke[t * 2] = (ea << 16) | la; toke[t * 2 + 1] = (eb << 16) | lb; wts[t * 2] = gate / (1.0f + ex); wts[t * 2 + 1] = gate * ex / (1.0f + ex);
        }
        __syncthreads();
        if (F.tid < 64) HIST[F.vcu * 64 + F.tid] = hist[F.tid];
        __syncthreads();
    }
    SEAM(9);
    if (IN(10)) { PHASE_REGS();
        LAS int* pb = (LAS int*)F.lds; LAS int* pt = pb + 512; LAS int* base = pt + 512;
        const int* HIST = (const int*)(F.ws + WS_HIST); const int* toke = (const int*)(F.ws + WS_TOKE); int* list = (int*)(F.ws + WS_LIST);
        __syncthreads();
        { const int e = F.tid & 63, p8 = F.tid >> 6; int sb = 0, st = 0;
          for (int w = p8; w < F.G; w += 8) { const int h = HIST[w * 64 + e]; st += h; sb += (w < F.vcu) ? h : 0; }
          pb[F.tid] = sb; pt[F.tid] = st; }
        __syncthreads();
        if (F.tid < 64) { int sb = 0, st = 0;
#pragma unroll
            for (int j = 0; j < 8; ++j) { sb += pb[j * 64 + F.tid]; st += pt[j * 64 + F.tid]; }
            base[F.tid] = sb; F.ctl[CW_CNT + F.tid] = (unsigned)st; }
        __syncthreads();
        for (int t = rt_beg + F.tid; t < rt_end; t += 512) {
#pragma unroll
            for (int k = 0; k < 2; ++k) { const int v = toke[t * 2 + k], e = v >> 16, sl = v & 0xffff; list[(size_t)e * LCAP + base[e] + sl] = t * 2 + k; } }
        __syncthreads();
        bg_convert(F, CW_QGU, 0, BT_GU, 0x7fffffff);
    }
    SEAM(10);
    if (IN(11)) { PHASE_REGS();
        moe_tables(F);
        const LAS int* cnt = (const LAS int*)(F.lds + TAB_OFF); const int* list = (const int*)(F.ws + WS_LIST);
        pg8::Gemm g{D / 2, D / 2, D / 2}; pg8::MoeOrder S{(const char*)(F.ws + WS_X18), (const char*)(F.ws + WS_WGU), cnt, cnt + 64, list, D / 2, D / 2, 4, 1024, F.G, F.vcu, true};
        pg8::EpiGU E{list, (const float*)(F.ws + WS_RSTD), cnt, F.ws + WS_ACT}; pg8::gemm_phase<pg8::EpiGU, pg8::MoeOrder, true, true>(F.lds, g, S, E, F.wave);
        PHASE_REGS();
        bg_convert(F, CW_QD, BT_GU, BT_D, 0x7fffffff);
    }
    SEAM(11);
    if (IN(12)) { PHASE_REGS();
        moe_tables(F);
        const LAS int* cnt = (const LAS int*)(F.lds + TAB_OFF); const int* list = (const int*)(F.ws + WS_LIST);
        pg8::Gemm g{DEXP / 2, DEXP / 2, DEXP / 2}; pg8::MoeOrder S{(const char*)(F.ws + WS_ACT), (const char*)(F.ws + WS_WD), cnt, cnt + 64, list, DEXP / 2, DEXP / 2, 8, 2048, F.G, F.vcu, false};
        pg8::EpiDown E{list, (const float*)(F.ws + WS_WTS), cnt, (bf16*)(F.ws + WS_Y2)};
        pg8::gemm_phase<pg8::EpiDown, pg8::MoeOrder, false, true>(F.lds, g, S, E, F.wave);
    }
    SEAM(12);
    if (IN(13)) { PHASE_REGS();
        const bf16* Y2 = (const bf16*)(F.ws + WS_Y2);
        for (int m = gw; m < T; m += NGW) { f32x4* op = (f32x4*)(F.out + (size_t)m * D) + F.lane * 2; const v4u* xb = (const v4u*)(XN + (size_t)m * D) + F.lane;
            const v4u* ya = (const v4u*)(Y2 + (size_t)m * 2 * D) + F.lane; const v4u* yb = ya + 256;
            v4u xw[4], aw[4], cw[4];
#pragma unroll
            for (int j = 0; j < 4; ++j) { xw[j] = __builtin_nontemporal_load(xb + 64 * j); aw[j] = __builtin_nontemporal_load(ya + 64 * j); cw[j] = __builtin_nontemporal_load(yb + 64 * j); }
#pragma unroll
            for (int j = 0; j < 4; ++j) { const v4u x = xw[j], a = aw[j], c = cw[j]; f32x4 x0, x1;
                x0[0] = bflo(x.x) + (bflo(a.x) + bflo(c.x)); x0[1] = bfhi(x.x) + (bfhi(a.x) + bfhi(c.x)); x0[2] = bflo(x.y) + (bflo(a.y) + bflo(c.y)); x0[3] = bfhi(x.y) + (bfhi(a.y) + bfhi(c.y));
                x1[0] = bflo(x.z) + (bflo(a.z) + bflo(c.z)); x1[1] = bfhi(x.z) + (bfhi(a.z) + bfhi(c.z)); x1[2] = bflo(x.w) + (bflo(a.w) + bflo(c.w)); x1[3] = bfhi(x.w) + (bfhi(a.w) + bfhi(c.w));
                __builtin_nontemporal_store(x0, op + 128 * j); __builtin_nontemporal_store(x1, op + 128 * j + 1); } }
    }
#undef IN
#undef SEAM
}

extern "C" void kernel_launch(void* const* d_in, const int* in_sizes, int n_in, void* d_out, int out_size, void* d_ws, size_t ws_size, hipStream_t stream) {
    static int grid = 0;
    if (grid == 0) {
        if (n_in != 31 || out_size != T * D || ws_size < WS_END) { fprintf(stderr, "kernel_launch: unexpected shapes (n_in %d out %d ws %zu)\n", n_in, out_size, ws_size); grid = -1; return; }
        int dev = 0, cus = 0, per_cu = 0;
        if (hipGetDevice(&dev) != hipSuccess || hipDeviceGetAttribute(&cus, hipDeviceAttributeMultiprocessorCount, dev) != hipSuccess) { grid = -1; return; }
        if (hipFuncSetAttribute((const void*)hymba_fwd, hipFuncAttributeMaxDynamicSharedMemorySize, LDS_BYTES) != hipSuccess) { fprintf(stderr, "kernel_launch: hipFuncSetAttribute failed\n"); grid = -1; return; }
        if (hipOccupancyMaxActiveBlocksPerMultiprocessor(&per_cu, (const void*)hymba_fwd, 512, LDS_BYTES) != hipSuccess || per_cu < 1) fprintf(stderr, "kernel_launch: occupancy query reports %d\n", per_cu);
        (void)hipGetLastError();
        grid = cus;
    }
    if (grid < 0) return;
    (void)hipMemsetAsync((char*)d_ws + WS_CTL, 0, CTL_ZERO_BYTES, stream);
    Args a{};
    for (int i = 0; i < 31; ++i) a.in[i] = (const float*)d_in[i];
    a.out = (float*)d_out; a.ws = (unsigned char*)d_ws;
#if MK_PER_PHASE
    for (int p = 0; p < NPH; ++p) { const int reps = ((PROBE_REP_MASK >> p) & 1) ? 2 : 1;
        for (int q = 0; q < reps; ++q) { a.ph_lo = p; a.ph_hi = p + 1; hipLaunchKernelGGL(hymba_fwd, dim3(grid), dim3(512), LDS_BYTES, stream, a); } }
#else
    a.ph_lo = 0; a.ph_hi = NPH; hipLaunchKernelGGL(hymba_fwd, dim3(grid), dim3(512), LDS_BYTES, stream, a);
#endif
}
```

```cpp
#include <hip/hip_runtime.h>
#include <cstdio>
#include <cstdint>

#ifndef PROBE_REP_MASK
#define PROBE_REP_MASK 0
#endif
#ifndef PB0
#define PB0 40
#endif
#ifndef PB0_S5
#define PB0_S5 28
#endif
#ifndef PB0_D
#define PB0_D 0
#endif
#ifndef PB1
#define PB1 0
#endif
#ifndef PB2
#define PB2 0
#endif
#ifndef PB4
#define PB4 0
#endif
#ifndef PB5
#define PB5 0
#endif
#ifndef PB11
#define PB11 0
#endif
#ifndef MK_PER_PHASE
#define MK_PER_PHASE 0
#endif

#define GAS __attribute__((address_space(1)))
#define LAS __attribute__((address_space(3)))
typedef unsigned short bf16;
typedef unsigned v4u __attribute__((ext_vector_type(4)));
typedef unsigned v2u __attribute__((ext_vector_type(2)));
typedef float f32x4 __attribute__((ext_vector_type(4)));
typedef float f32x16 __attribute__((ext_vector_type(16)));
typedef short bf16x8 __attribute__((ext_vector_type(8)));
typedef short bf16x4 __attribute__((ext_vector_type(4)));
typedef int v8i __attribute__((ext_vector_type(8)));
typedef int v4i_ __attribute__((ext_vector_type(4)));

constexpr int T = 16384, D = 2048, SEQ = 2048, NB = 8, INC = 2304, MEML = 256;
constexpr int NPH = 14;
constexpr float EPS = 1e-6f;
constexpr int NEXP = 64, DEXP = 512, LCAP = 16384;
constexpr int S5L = 32, S5K = 640;

constexpr size_t MiB = 1u << 20;
constexpr size_t WS_CTL = 0, CTL_ZERO_BYTES = 1 * MiB;
constexpr size_t WS_WIN = 2 * MiB, WS_WO = 11 * MiB, WS_WMKV = 19 * MiB, WS_WGLU = 23 * MiB;
constexpr size_t WS_MQ = 24 * MiB, WS_SP = 44 * MiB, WS_UA = 52 * MiB, WS_SL = 72 * MiB, WS_AL = 88 * MiB, WS_WR = 89 * MiB;
constexpr size_t WS_XN = 96 * MiB;
constexpr size_t WS_MEMN = 160 * MiB, WS_MEMKV = 168 * MiB;
constexpr size_t WS_PROJ = 176 * MiB;
constexpr size_t WS_MIX = 248 * MiB;
constexpr size_t WS_Y2 = 176 * MiB;
constexpr size_t WS_G = 312 * MiB;
constexpr size_t WS_LOG = 328 * MiB;
constexpr size_t WS_LIST = 344 * MiB;
constexpr size_t WS_WTS = 348 * MiB;
constexpr size_t WS_LP = 352 * MiB;
constexpr size_t WS_PART = 376 * MiB;
constexpr size_t WS_RSTD = 379 * MiB;
constexpr size_t WS_HIST = 380 * MiB;
constexpr size_t WS_X18 = 384 * MiB;
constexpr size_t WS_TOKE = 381 * MiB;
constexpr size_t WS_ACT = 544 * MiB;
constexpr size_t WS_WGU = 592 * MiB;
constexpr size_t WS_WD = 848 * MiB;
constexpr size_t WS_END = 976 * MiB;
constexpr int CW_CNT = 1024;
constexpr int CW_BAR = 4096;
constexpr int CW_QGU = 2048, CW_QD = 2112;

constexpr int RING_BYTES = 131072;
constexpr int TAB_OFF = 139264;
constexpr int XBW_OFF = TAB_OFF + 2048;
constexpr int LDS_BYTES = 147456;

#define LDS_WAIT() asm volatile("s_waitcnt lgkmcnt(0)" ::: "memory")
#define VM_WAIT() asm volatile("s_waitcnt vmcnt(0)" ::: "memory")
__device__ __forceinline__ unsigned f2bf(float f) { unsigned u = __builtin_bit_cast(unsigned, f); return (u + 0x7fffu + ((u >> 16) & 1u)) >> 16; }
__device__ __forceinline__ unsigned pk2(float lo, float hi) { unsigned r; asm volatile("v_cvt_pk_bf16_f32 %0, %1, %2" : "=v"(r) : "v"(lo), "v"(hi)); return r; }
__device__ __forceinline__ float bflo(unsigned w) { return __builtin_bit_cast(float, w << 16); }
__device__ __forceinline__ float bfhi(unsigned w) { return __builtin_bit_cast(float, w & 0xffff0000u); }
__device__ __forceinline__ float wave_sum(float v) {
#pragma unroll
    for (int o = 1; o < 64; o <<= 1) v += __shfl_xor(v, o);
    return v;
}
constexpr float SC_X = 4.0f, SC_WGU = 32.0f, SC_ACT = 16.0f, SC_WD = 16.0f, SC_Y = 64.0f;
__device__ __forceinline__ float clamp8(float v) { return fminf(fmaxf(v, -448.0f), 448.0f); }
__device__ __forceinline__ unsigned pk4_fp8(float a, float b, float c, float d) { unsigned w = 0u; w = (unsigned)__builtin_amdgcn_cvt_pk_fp8_f32(clamp8(a), clamp8(b), (int)w, false); w = (unsigned)__builtin_amdgcn_cvt_pk_fp8_f32(clamp8(c), clamp8(d), (int)w, true); return w; }
__device__ __forceinline__ float fast_exp(float x) { return __builtin_amdgcn_exp2f(x * 1.44269504089f); }
__device__ __forceinline__ float sigmoidf_(float x) { return __builtin_amdgcn_rcpf(1.0f + fast_exp(-x)); }
__device__ __forceinline__ float gelu_tanh(float x) { const float z = 1.5957691216f * (x + 0.044715f * x * x * x); return x * sigmoidf_(z); }

#define XB_TMO      128
#define XB_XCNT(j)  (256  + 64 * (j))
#define XB_XSUB(j)  (1280 + 64 * (j))
#define XB_XGEN(j)  (2304 + 64 * (j))
#define XB_TOP      3328
#define XB_TOPGEN   3392
#define XCD_BAR_WORDS 3456
#define XB_SPIN_CAP (1u << 18)
__device__ __forceinline__ unsigned xb_ld(unsigned* p)              { return __hip_atomic_load(p, __ATOMIC_RELAXED, __HIP_MEMORY_SCOPE_AGENT); }
__device__ __forceinline__ unsigned xb_add(unsigned* p, unsigned v) { return __hip_atomic_fetch_add(p, v, __ATOMIC_RELAXED, __HIP_MEMORY_SCOPE_AGENT); }
__device__ __forceinline__ unsigned xb_xcc_id() { return (unsigned)__builtin_amdgcn_s_getreg((3 << 11) | 20) & 0xFu; }
#define XB_SPIN(cond, bar) do { unsigned _sp = 0; while (cond) { __builtin_amdgcn_s_sleep(1); \
    if ((++_sp & 255u) == 0u) { if (xb_ld(&(bar)[XB_TMO])) break; if (_sp > XB_SPIN_CAP) { atomicAdd(&(bar)[XB_TMO], 1u); break; } } } } while (0)
struct XcdBarrier { unsigned* bar; unsigned x; volatile LAS unsigned* st; };
__device__ __forceinline__ XcdBarrier xcd_barrier_post(unsigned* bar, volatile LAS unsigned* st) {
    XcdBarrier b; b.bar = bar; b.x = xb_xcc_id(); b.st = st;
    if (threadIdx.x == 0) (void)xb_add(&bar[XB_XCNT(b.x)], 1u);
    return b;
}
__device__ __forceinline__ void xcd_barrier_complete(unsigned* bar, unsigned x, unsigned& nloc, unsigned& nx) {
    const unsigned G = gridDim.x * gridDim.y * gridDim.z;
    unsigned sum, cnt, mine, sp = 0u;
    for (;;) {
        sum = 0u; cnt = 0u; mine = 0u;
#pragma unroll
        for (unsigned j = 0; j < 16; ++j) { const unsigned c = xb_ld(&bar[XB_XCNT(j)]); sum += c; cnt += (c > 0u) ? 1u : 0u; mine = (j == x) ? c : mine; }
        if (sum == G) break;
        __builtin_amdgcn_s_sleep(1);
        if ((++sp & 255u) == 0u) { if (xb_ld(&bar[XB_TMO])) break; if (sp > XB_SPIN_CAP) { atomicAdd(&bar[XB_TMO], 1u); break; } }
    }
    nloc = mine > 0u ? mine : 1u; nx = cnt > 0u ? cnt : 1u;
}
__device__ __forceinline__ void xcd_barrier(const XcdBarrier& b) {
    asm volatile("s_waitcnt vmcnt(0)" ::: "memory");
    __syncthreads();
    if (threadIdx.x == 0) {
        unsigned* bar = b.bar;
        __builtin_amdgcn_s_waitcnt(0);
        unsigned nloc = b.st[0], nx = b.st[1];
        if (nloc == 0u) { xcd_barrier_complete(bar, b.x, nloc, nx); b.st[0] = nloc; b.st[1] = nx; }
        const unsigned old = xb_add(&bar[XB_XSUB(b.x)], 1u);
        const unsigned gen = old / nloc;
        if (old + 1u == (gen + 1u) * nloc) {
            __builtin_amdgcn_fence(__ATOMIC_RELEASE, "agent");
            asm volatile("s_waitcnt vmcnt(0)" ::: "memory");
            const unsigned og = xb_add(&bar[XB_TOP], 1u);
            const unsigned tg = og / nx;
            if (og + 1u == (tg + 1u) * nx) xb_add(&bar[XB_TOPGEN], 1u);
            else XB_SPIN(xb_ld(&bar[XB_TOPGEN]) == tg, bar);
            __builtin_amdgcn_fence(__ATOMIC_ACQUIRE, "agent");
            xb_add(&bar[XB_XGEN(b.x)], 1u);
            asm volatile("s_waitcnt vmcnt(0)" ::: "memory");
        } else {
            XB_SPIN(xb_ld(&bar[XB_XGEN(b.x)]) == gen, bar);
            __builtin_amdgcn_fence(__ATOMIC_ACQUIRE, "agent");
            asm volatile("s_waitcnt vmcnt(0)" ::: "memory");
        }
    }
    __syncthreads();
}

__device__ __forceinline__ int lane_now() { int l = (int)__builtin_amdgcn_mbcnt_hi(~0u, __builtin_amdgcn_mbcnt_lo(~0u, 0u)); asm volatile("" : "+v"(l)); return l; }
namespace pg8 {
constexpr int BM = 256, BK = 64, HALF = 128, HTB = HALF * BK * 2, STAGE_BYTES = 8 * HTB, NXCD = 8, WGM = 8;
__host__ __device__ __forceinline__ int lds_byte(int r, int c) { const int st = (r >> 4) * 2 + (c >> 5), rr = r & 15, cc = c & 31, ob = rr * 64 + cc * 2; return st * 1024 + (ob ^ (((ob >> 9) & 1) << 5)); }
__host__ __device__ __forceinline__ void stage_rc(int b, int& R, int& C) { const int st = b / 1024, sb = b % 1024, swz = sb ^ (((sb >> 9) & 1) << 5); R = (st >> 1) * 16 + swz / 64; C = (st & 1) * 32 + (swz % 64) / 2; }
__host__ __device__ __forceinline__ int perm32(int rho) { const int n = rho >> 4, i = rho & 15; return 8 * (i >> 2) + 4 * n + (i & 3); }

struct Unit { const char* a; const char* b; int r0, c0, aux, r1; };
struct Gemm { int lda, ldb, K; };

struct DenseOrder {
    const char* A; const char* Bt; int lda, ldb, nM, nN, nwg, G, c;
    __device__ void init(const void* A_, const void* Bt_, int lda_, int ldb_, int M, int N, int G_, int c_) { A = (const char*)A_; Bt = (const char*)Bt_; lda = lda_; ldb = ldb_; nM = M / BM; nN = N / BM; nwg = nM * nN; G = G_; c = c_; }
    __device__ bool next(int i, Unit& u) const {
        const long L = (long)i * G + c; if (L >= nwg) return false;
        int wgid = (int)L; { const int q = nwg / NXCD, r = nwg % NXCD, xcd = wgid % NXCD, off = wgid / NXCD; wgid = (xcd < r ? xcd * (q + 1) : r * (q + 1) + (xcd - r) * q) + off; }
        const int nig = WGM * nN, gid = wgid / nig, fm = gid * WGM, gsz = (nM - fm) < WGM ? (nM - fm) : WGM;
        const int pm = fm + ((wgid % nig) % gsz), pn = (wgid % nig) / gsz;
        u.a = A + (size_t)pm * BM * lda * 2; u.b = Bt + (size_t)pn * BM * ldb * 2; u.r0 = pm * BM; u.c0 = pn * BM; u.aux = 0; u.r1 = 0; return true;
    }
    __device__ __forceinline__ unsigned arow(const Unit&, int) const { return 0u; }
};
struct GroupOrder {
    const char* A; const char* Bt; int lda, ldb, nN, ngrp, G, c;
    __device__ bool next(int i, Unit& u) const {
        const int L = i * G + c; if (L >= ngrp * 2 * nN) return false;
        const int g = L / (2 * nN), q = L % (2 * nN), pn = q >> 1, pm = q & 1;
        u.a = A + ((size_t)g * 512 + pm * BM) * lda * 2; u.b = Bt + ((size_t)g * nN + pn) * BM * ldb * 2; u.r0 = pm * BM; u.c0 = pn * BM; u.aux = g; u.r1 = 0; return true;
    }
    __device__ __forceinline__ unsigned arow(const Unit&, int) const { return 0u; }
};
struct MoeOrder {
    const char* A; const char* Bt; const LAS int* cnt; const LAS int* ts; const int* list; int lda, ldb, nct, brows, G, c; bool gather;
    __device__ bool next(int i, Unit& u) const {
        const int L = i * G + c; const int lane = lane_now();
        int i64 = 64; asm volatile("" : "+v"(i64));
        if (L >= __builtin_amdgcn_readfirstlane(ts[i64]) * nct) return false;
        const int lo = ts[lane] * nct, hi = ts[lane + 1] * nct;
        const unsigned long long m = __ballot(lo <= L && L < hi);
        const int e = __builtin_amdgcn_readfirstlane((int)__builtin_ctzll(m));
        const int tse = ts[e], ne = ts[e + 1] - tse, q = L - tse * nct, ct = q / ne, rt = q % ne;
        u.a = gather ? A : A + (size_t)(tse + rt) * BM * lda * 2; u.b = Bt + ((size_t)e * brows + (size_t)ct * BM) * ldb * 2;
        u.r0 = (tse + rt) * BM; u.r1 = rt * BM; u.c0 = ct; u.aux = e; return true;
    }
    __device__ __forceinline__ unsigned arow(const Unit& u, int r) const {
        const int n = cnt[u.aux]; int rr = u.r1 + r; rr = rr < n ? rr : n - 1;
        return (unsigned)(list[(size_t)u.aux * LCAP + rr] >> 1) * (unsigned)(lda * 2);
    }
};

#define EPI_ROWS_COLS() const int rowb = wr * 64 + fr; (void)rowb;

template <class Epi, class Sched, bool GATHER = false, bool FP8 = false>
__device__ __forceinline__ void gemm_phase(LAS unsigned char* lds, const Gemm g, const Sched& S, const Epi& E, const int wave_id) {
    int lane = (int)__builtin_amdgcn_mbcnt_hi(~0u, __builtin_amdgcn_mbcnt_lo(~0u, 0u)); asm volatile("" : "+v"(lane));
    const int wid = wave_id, tid = wid * 64 + lane, wr = wid >> 2, wc = wid & 3, fr = lane & 15, fq = lane >> 4;
    const int K = g.K; int nt = K / BK; asm volatile("" : "+s"(nt));
    unsigned voffB;
    { int R, C; stage_rc(tid * 16, R, C); const int Rb = Epi::PERM ? ((R & ~31) + perm32(R & 31)) : R; voffB = (unsigned)(Rb * g.ldb + C) * 2u; }
    const int soffB = 64 * g.ldb * 2;
#define PG8_RC(i, R, C) int R, C; { int _t = tid; asm volatile("" : "+v"(_t)); stage_rc(_t * 16 + (i) * 8192, R, C); }
#define nxoff ((LAS v4u*)(lds + 131072) + (wid * 64 + lane_now()))
    const size_t kstep = (size_t)(BK * 2);
    const size_t hstepB = (size_t)HALF * g.ldb * 2;
    const unsigned ldsw = (unsigned)wid * 1024u;
    const int aoff = lds_byte(wr * 64 + fr, fq * 8), boff = lds_byte(wc * 32 + fr, fq * 8);
#define PG8_SA(b, h) (((b) * 2 + (h)) * HTB)
#define PG8_SB(b, h) ((4 + (b) * 2 + (h)) * HTB)
#define PG8_RSRC(p) __builtin_amdgcn_make_buffer_rsrc((void*)(p), 0, 0xffffffff, 0x00020000)
#define PG8_STAGE(bufoff, gbase, voff) do { const __amdgpu_buffer_rsrc_t _r = PG8_RSRC(gbase); \
        __builtin_amdgcn_raw_ptr_buffer_load_lds(_r, (LAS void*)(lds + (bufoff) + ldsw), 16, (int)(voff), 0, 0, 0); \
        __builtin_amdgcn_raw_ptr_buffer_load_lds(_r, (LAS void*)(lds + (bufoff) + ldsw + 8192), 16, (int)(voff), soffB, 0, 0); } while (0)
#define PG8_STAGEA(bufoff, gbase, o0, o1) do { const __amdgpu_buffer_rsrc_t _r = PG8_RSRC(gbase); \
        __builtin_amdgcn_raw_ptr_buffer_load_lds(_r, (LAS void*)(lds + (bufoff) + ldsw), 16, (int)(o0), 0, 0, 0); \
        __builtin_amdgcn_raw_ptr_buffer_load_lds(_r, (LAS void*)(lds + (bufoff) + ldsw + 8192), 16, (int)(o1), 0, 0, 0); } while (0)
#define PG8_LDA(dst, b, h) do { _Pragma("unroll") for (int m = 0; m < 4; ++m) { \
        if constexpr (FP8) { dst##8[m].lo = *(const LAS v4i_*)(lds + PG8_SA(b, h) + aoff + m * 2048); dst##8[m].hi = *(const LAS v4i_*)(lds + PG8_SA(b, h) + aoff + m * 2048 + 1024); } \
        else { _Pragma("unroll") for (int k = 0; k < 2; ++k) dst[m][k] = *(const LAS bf16x8*)(lds + PG8_SA(b, h) + aoff + m * 2048 + k * 1024); } } } while (0)
#define PG8_LDB(dst, b, h) do { _Pragma("unroll") for (int n = 0; n < 2; ++n) { \
        if constexpr (FP8) { dst##8[n].lo = *(const LAS v4i_*)(lds + PG8_SB(b, h) + boff + n * 2048); dst##8[n].hi = *(const LAS v4i_*)(lds + PG8_SB(b, h) + boff + n * 2048 + 1024); } \
        else { _Pragma("unroll") for (int k = 0; k < 2; ++k) dst[n][k] = *(const LAS bf16x8*)(lds + PG8_SB(b, h) + boff + n * 2048 + k * 1024); } } } while (0)
#define PG8_MMA(ai, bj, At, Bt) do { __builtin_amdgcn_s_setprio(1); _Pragma("unroll") for (int m = 0; m < 4; ++m) _Pragma("unroll") for (int n = 0; n < 2; ++n) { \
        if constexpr (FP8) { acc[ai][bj][m][n] = __builtin_amdgcn_mfma_scale_f32_16x16x128_f8f6f4(Bt##8[n], At##8[m], acc[ai][bj][m][n], 0, 0, 0, 0x7f7f7f7f, 0, 0x7f7f7f7f); } \
        else { _Pragma("unroll") for (int k = 0; k < 2; ++k) acc[ai][bj][m][n] = __builtin_amdgcn_mfma_f32_16x16x32_bf16(Bt[n][k], At[m][k], acc[ai][bj][m][n], 0, 0, 0); } } \
        __builtin_amdgcn_s_setprio(0); } while (0)
#define PG8_WAIT_V(n) asm volatile("s_waitcnt vmcnt(" #n ")" ::: "memory")
#define PG8_WAIT_L(n) asm volatile("s_waitcnt lgkmcnt(" #n ")" ::: "memory")
#define PG8_BAR __builtin_amdgcn_s_barrier()
#define PG8_SCHED __builtin_amdgcn_sched_barrier(0)
    Unit cur, nxt; int ui = 0;
    if (!S.next(0, cur)) return;
    f32x4 acc[2][2][4][2];
#pragma unroll
    for (int a = 0; a < 2; ++a)
#pragma unroll
        for (int b = 0; b < 2; ++b)
#pragma unroll
            for (int m = 0; m < 4; ++m)
#pragma unroll
                for (int n = 0; n < 2; ++n) acc[a][b][m][n] = (f32x4){0.f, 0.f, 0.f, 0.f};
    bf16x8 At[4][2], B0[2][2], B1[2][2]; v8i At8[4], B08[2], B18[2];
    const char* cA = cur.a; const char* cB = cur.b;
    unsigned c00, c01, c10, c11;
    { PG8_RC(0, R0, C0); PG8_RC(1, R1, C1);
      if constexpr (GATHER) {
        c00 = S.arow(cur, R0) + C0 * 2u; c01 = S.arow(cur, R1) + C1 * 2u; c10 = S.arow(cur, HALF + R0) + C0 * 2u; c11 = S.arow(cur, HALF + R1) + C1 * 2u;
        asm volatile("s_waitcnt vmcnt(0)" : "+v"(c00), "+v"(c01), "+v"(c10), "+v"(c11) :: "memory");
      } else {
        c00 = (unsigned)(R0 * g.lda + C0) * 2u; c01 = (unsigned)(R1 * g.lda + C1) * 2u; c10 = c00 + (unsigned)(HALF * g.lda * 2); c11 = c01 + (unsigned)(HALF * g.lda * 2);
      } }
    PG8_STAGE(PG8_SB(0, 0), cB, voffB); PG8_STAGE(PG8_SB(0, 1), cB + hstepB, voffB); PG8_STAGEA(PG8_SA(0, 0), cA, c00, c01); PG8_STAGEA(PG8_SA(0, 1), cA, c10, c11);
    if (wr == 1) PG8_BAR;
    PG8_WAIT_V(2); PG8_BAR;
    PG8_STAGE(PG8_SB(1, 0), cB + kstep, voffB); PG8_STAGEA(PG8_SA(1, 0), cA + kstep, c00, c01); PG8_STAGE(PG8_SB(1, 1), cB + hstepB + kstep, voffB);
    PG8_WAIT_V(6); PG8_BAR;
    for (;;) {
        const bool has_next = S.next(ui + 1, nxt);
        const char* nA = has_next ? nxt.a : cA; const char* nB = has_next ? nxt.b : cB;
        if constexpr (GATHER) {
            unsigned n00 = c00, n01 = c01, n10 = c10, n11 = c11;
            if (has_next) { PG8_RC(0, R0, C0); PG8_RC(1, R1, C1); n00 = S.arow(nxt, R0) + C0 * 2u; n01 = S.arow(nxt, R1) + C1 * 2u; n10 = S.arow(nxt, HALF + R0) + C0 * 2u; n11 = S.arow(nxt, HALF + R1) + C1 * 2u; }
            asm volatile("s_waitcnt vmcnt(0)" : "+v"(n00), "+v"(n01), "+v"(n10), "+v"(n11) :: "memory");
            v4u nv; nv.x = n00; nv.y = n01; nv.z = n10; nv.w = n11; *nxoff = nv;
        }
#pragma unroll 1
        for (int t = 0; t < nt; t += 2) {
            const bool last = (t == nt - 2);
            const char* a1 = cA + (size_t)(t + 1) * kstep;
            const char* a2 = last ? nA : cA + (size_t)(t + 2) * kstep; const char* b2 = last ? nB : cB + (size_t)(t + 2) * kstep;
            const char* a3 = a2 + kstep; const char* b3 = b2 + kstep;
            unsigned x00 = c00, x01 = c01, x10 = c10, x11 = c11;
            if constexpr (GATHER) { if (last) { const v4u nv = *nxoff; x00 = nv.x; x01 = nv.y; x10 = nv.z; x11 = nv.w; } }
            PG8_LDB(B0, 0, 0); PG8_LDB(B1, 0, 1); PG8_SCHED; PG8_LDA(At, 0, 0); PG8_STAGEA(PG8_SA(1, 1), a1, c10, c11);
            PG8_WAIT_V(8); PG8_WAIT_L(0); PG8_BAR; PG8_MMA(0, 0, At, B0); PG8_MMA(0, 1, At, B1); PG8_BAR; PG8_SCHED;
            PG8_LDA(At, 0, 1); PG8_STAGE(PG8_SB(0, 0), b2, voffB); PG8_STAGE(PG8_SB(0, 1), b2 + hstepB, voffB); PG8_STAGEA(PG8_SA(0, 0), a2, x00, x01);
            PG8_WAIT_V(8); PG8_WAIT_L(0); PG8_BAR; PG8_MMA(1, 0, At, B0); PG8_MMA(1, 1, At, B1); PG8_BAR; PG8_SCHED;
            PG8_LDB(B0, 1, 0); PG8_LDB(B1, 1, 1); PG8_SCHED; PG8_LDA(At, 1, 0); PG8_STAGEA(PG8_SA(0, 1), a2, x10, x11);
            PG8_WAIT_V(8); PG8_WAIT_L(0); PG8_BAR; PG8_MMA(0, 0, At, B0); PG8_MMA(0, 1, At, B1); PG8_BAR; PG8_SCHED;
            PG8_LDA(At, 1, 1); PG8_STAGE(PG8_SB(1, 0), b3, voffB); PG8_STAGE(PG8_SB(1, 1), b3 + hstepB, voffB); PG8_STAGEA(PG8_SA(1, 0), a3, x00, x01);
            PG8_WAIT_V(8); PG8_WAIT_L(0); PG8_BAR; PG8_MMA(1, 0, At, B0); PG8_MMA(1, 1, At, B1); PG8_BAR; PG8_SCHED;
        }
        if (wr == 0) PG8_BAR;
        { const int le = lane_now(); E(acc, cur, wr, wc, le & 15, le >> 4); }
        if (!has_next) break;
#pragma unroll
        for (int a = 0; a < 2; ++a)
#pragma unroll
            for (int b = 0; b < 2; ++b)
#pragma unroll
                for (int m = 0; m < 4; ++m)
#pragma unroll
                    for (int n = 0; n < 2; ++n) acc[a][b][m][n] = (f32x4){0.f, 0.f, 0.f, 0.f};
        cur = nxt; cA = nA; cB = nB; ++ui;
        if constexpr (GATHER) { const v4u nv = *nxoff; c00 = nv.x; c01 = nv.y; c10 = nv.z; c11 = nv.w; }
        if (wr == 1) PG8_BAR;
    }
    PG8_WAIT_V(0);
    PG8_BAR;
#undef PG8_RC
#undef nxoff
#undef PG8_SA
#undef PG8_SB
#undef PG8_STAGE
#undef PG8_STAGEA
#undef PG8_LDA
#undef PG8_LDB
#undef PG8_MMA
#undef PG8_WAIT_V
#undef PG8_WAIT_L
#undef PG8_BAR
#undef PG8_SCHED
}

typedef const f32x4 (&AccRef)[2][2][4][2];
__device__ __forceinline__ v4u pack8(const f32x4 a, const f32x4 b) { v4u w; w.x = pk2(a[0], a[1]); w.y = pk2(a[2], a[3]); w.z = pk2(b[0], b[1]); w.w = pk2(b[2], b[3]); return w; }

struct EpiProj {
    static constexpr bool PERM = true;
    bf16* PROJ; bf16* UA;
    __device__ __forceinline__ void operator()(AccRef acc, const Unit& u, int wr, int wc, int fr, int fq) const {
        const int row0 = u.r0 + wr * 64 + fr, colb = u.c0 + wc * 32 + 8 * fq;
        const bool isu = (u.c0 == 1280 || u.c0 == 1536);
#pragma unroll
        for (int ai = 0; ai < 2; ++ai)
#pragma unroll
            for (int m = 0; m < 4; ++m) { const int row = row0 + ai * HALF + m * 16;
#pragma unroll
                for (int bj = 0; bj < 2; ++bj) { const int col = colb + bj * HALF; const v4u w = pack8(acc[ai][bj][m][0], acc[ai][bj][m][1]);
                    if (!isu) *(v4u*)(PROJ + (size_t)row * INC + col) = w;
                    else { const int cc = col - 1280, g = cc >> 4, c0 = cc & 15; *(v4u*)(UA + ((size_t)(g * 512 + (row >> 5)) * S5K + (row & 31) * 16 + c0)) = w; } } }
    }
};
struct EpiBf16 {
    static constexpr bool PERM = true;
    bf16* O; int ldc;
    __device__ __forceinline__ void operator()(AccRef acc, const Unit& u, int wr, int wc, int fr, int fq) const {
        const int row0 = u.r0 + wr * 64 + fr, colb = u.c0 + wc * 32 + 8 * fq;
#pragma unroll
        for (int ai = 0; ai < 2; ++ai)
#pragma unroll
            for (int m = 0; m < 4; ++m) { bf16* rowp = O + (size_t)(row0 + ai * HALF + m * 16) * ldc + colb;
#pragma unroll
                for (int bj = 0; bj < 2; ++bj) *(v4u*)(rowp + bj * HALF) = pack8(acc[ai][bj][m][0], acc[ai][bj][m][1]); }
    }
};
struct EpiF32 {
    static constexpr bool PERM = false;
    float* C; int ldc; size_t gstride;
    __device__ __forceinline__ void operator()(AccRef acc, const Unit& u, int wr, int wc, int fr, int fq) const {
        const int row0 = u.r0 + wr * 64 + fr, col0 = u.c0 + wc * 32 + 4 * fq; float* base = C + (size_t)u.aux * gstride;
#pragma unroll
        for (int ai = 0; ai < 2; ++ai)
#pragma unroll
            for (int m = 0; m < 4; ++m) { float* rowp = base + (size_t)(row0 + ai * HALF + m * 16) * ldc + col0;
#pragma unroll
                for (int bj = 0; bj < 2; ++bj)
#pragma unroll
                    for (int n = 0; n < 2; ++n) *(f32x4*)(rowp + bj * HALF + n * 16) = acc[ai][bj][m][n]; }
    }
};
struct EpiS5Y {
    static constexpr bool PERM = true;
    const bf16* UA; const float* dsk; bf16* Gm;
    __device__ __forceinline__ void operator()(AccRef acc, const Unit& u, int wr, int wc, int fr, int fq) const {
        const int row0 = u.r0 + wr * 64 + fr, colb = u.c0 + wc * 32 + 8 * fq, g = u.aux;
#pragma unroll
        for (int ai = 0; ai < 2; ++ai)
#pragma unroll
            for (int m = 0; m < 4; ++m) { const int row = row0 + ai * HALF + m * 16;
#pragma unroll
                for (int bj = 0; bj < 2; ++bj) { const int col = colb + bj * HALF, i = col >> 4, c0 = col & 15;
                    const v4u uw = *(const v4u*)(UA + ((size_t)(g * 512 + row) * S5K + col));
                    const f32x4 d0 = *(const f32x4*)(dsk + g * 16 + c0), d1 = *(const f32x4*)(dsk + g * 16 + c0 + 4);
                    const f32x4 a0 = acc[ai][bj][m][0], a1 = acc[ai][bj][m][1];
                    f32x4 y0, y1;
                    y0[0] = gelu_tanh(a0[0] + d0[0] * bflo(uw.x)); y0[1] = gelu_tanh(a0[1] + d0[1] * bfhi(uw.x)); y0[2] = gelu_tanh(a0[2] + d0[2] * bflo(uw.y)); y0[3] = gelu_tanh(a0[3] + d0[3] * bfhi(uw.y));
                    y1[0] = gelu_tanh(a1[0] + d1[0] * bflo(uw.z)); y1[1] = gelu_tanh(a1[1] + d1[1] * bfhi(uw.z)); y1[2] = gelu_tanh(a1[2] + d1[2] * bflo(uw.w)); y1[3] = gelu_tanh(a1[3] + d1[3] * bfhi(uw.w));
                    *(v4u*)(Gm + ((size_t)row * 32 + i) * 512 + g * 16 + c0) = pack8(y0, y1); } }
    }
};
struct EpiGlu {
    static constexpr bool PERM = true;
    const bf16* Gm; bf16* MIX;
    __device__ __forceinline__ void operator()(AccRef acc, const Unit& u, int wr, int wc, int fr, int fq) const {
        const int row0 = u.r0 + wr * 64 + fr, colb = u.c0 + wc * 32 + 8 * fq;
#pragma unroll
        for (int ai = 0; ai < 2; ++ai)
#pragma unroll
            for (int m = 0; m < 4; ++m) { const int row = row0 + ai * HALF + m * 16;
#pragma unroll
                for (int bj = 0; bj < 2; ++bj) { const int col = colb + bj * HALF;
                    const v4u gw = *(const v4u*)(Gm + (size_t)row * 512 + col);
                    const f32x4 a0 = acc[ai][bj][m][0], a1 = acc[ai][bj][m][1];
                    f32x4 y0, y1;
                    y0[0] = bflo(gw.x) * sigmoidf_(a0[0]); y0[1] = bfhi(gw.x) * sigmoidf_(a0[1]); y0[2] = bflo(gw.y) * sigmoidf_(a0[2]); y0[3] = bfhi(gw.y) * sigmoidf_(a0[3]);
                    y1[0] = bflo(gw.z) * sigmoidf_(a1[0]); y1[1] = bfhi(gw.z) * sigmoidf_(a1[1]); y1[2] = bflo(gw.w) * sigmoidf_(a1[2]); y1[3] = bfhi(gw.w) * sigmoidf_(a1[3]);
                    *(v4u*)(MIX + (size_t)row * D + 1024 + col) = pack8(y0, y1); } }
    }
};
struct EpiWo {
    static constexpr bool PERM = true;
    const float* X; bf16* X1B; unsigned char* X18; float* part;
    __device__ __forceinline__ void operator()(AccRef acc, const Unit& u, int wr, int wc, int fr, int fq) const {
        const int row0 = u.r0 + wr * 64 + fr, col0 = u.c0 + wc * 32 + 8 * fq;
#pragma unroll
        for (int ai = 0; ai < 2; ++ai) {
            f32x4 xv[4][2][2];
#pragma unroll
            for (int m = 0; m < 4; ++m)
#pragma unroll
                for (int bj = 0; bj < 2; ++bj)
#pragma unroll
                    for (int n = 0; n < 2; ++n) xv[m][bj][n] = __builtin_nontemporal_load((const f32x4*)(X + (size_t)(row0 + ai * HALF + m * 16) * D + col0 + bj * HALF + n * 4));
#pragma unroll
            for (int m = 0; m < 4; ++m) { const int row = row0 + ai * HALF + m * 16; const size_t off = (size_t)row * D + col0; float ss = 0.f;
#pragma unroll
                for (int bj = 0; bj < 2; ++bj) { const f32x4 v0 = xv[m][bj][0] + acc[ai][bj][m][0], v1 = xv[m][bj][1] + acc[ai][bj][m][1];
                    ss += ((v0[0] * v0[0] + v0[1] * v0[1]) + (v0[2] * v0[2] + v0[3] * v0[3])) + ((v1[0] * v1[0] + v1[1] * v1[1]) + (v1[2] * v1[2] + v1[3] * v1[3]));
                    *(v4u*)(X1B + off + bj * HALF) = pack8(v0, v1);
                    v2u w8; w8.x = pk4_fp8(v0[0] * SC_X, v0[1] * SC_X, v0[2] * SC_X, v0[3] * SC_X); w8.y = pk4_fp8(v1[0] * SC_X, v1[1] * SC_X, v1[2] * SC_X, v1[3] * SC_X);
                    *(v2u*)(X18 + off + bj * HALF) = w8; }
                ss += __shfl_xor(ss, 16); ss += __shfl_xor(ss, 32);
                if (fq == 0) part[(size_t)row * 32 + (u.c0 >> 8) * 4 + wc] = ss; }
            asm volatile("" ::: "memory");
        }
    }
};
struct EpiLogit {
    static constexpr bool PERM = false;
    float* LP;
    __device__ __forceinline__ void operator()(AccRef acc, const Unit& u, int wr, int wc, int fr, int fq) const {
        const int row0 = u.r0 + wr * 64 + fr, col0 = wc * 32 + 4 * fq; float* base = LP + (size_t)u.aux * T * 80;
#pragma unroll
        for (int ai = 0; ai < 2; ++ai)
#pragma unroll
            for (int m = 0; m < 4; ++m) { float* rowp = base + (size_t)(row0 + ai * HALF + m * 16) * 80 + col0;
#pragma unroll
                for (int n = 0; n < 2; ++n) if (col0 + n * 16 < 80) *(f32x4*)(rowp + n * 16) = acc[ai][0][m][n]; }
    }
};
struct EpiGU {
    static constexpr bool PERM = true;
    const int* list; const float* rstd; const LAS int* cnt; unsigned char* ACT;
    __device__ __forceinline__ void operator()(AccRef acc, const Unit& u, int wr, int wc, int fr, int fq) const {
        const int e = u.aux, nreal = cnt[e], rb = wr * 64 + fr, colb = u.c0 * 128 + wc * 32 + 8 * fq;
#pragma unroll
        for (int ai = 0; ai < 2; ++ai)
#pragma unroll
            for (int m = 0; m < 4; ++m) { const int r = rb + ai * HALF + m * 16; int rr = u.r1 + r; rr = rr < nreal ? rr : nreal - 1;
                const float rs = rstd[list[(size_t)e * LCAP + rr] >> 1] * (1.0f / (SC_X * SC_WGU));
                f32x4 y0, y1;
#pragma unroll
                for (int j = 0; j < 4; ++j) { const float g0 = acc[ai][0][m][0][j] * rs, g1 = acc[ai][0][m][1][j] * rs;
                    y0[j] = g0 * sigmoidf_(g0) * (acc[ai][1][m][0][j] * rs) * SC_ACT; y1[j] = g1 * sigmoidf_(g1) * (acc[ai][1][m][1][j] * rs) * SC_ACT; }
                v2u w8; w8.x = pk4_fp8(y0[0], y0[1], y0[2], y0[3]); w8.y = pk4_fp8(y1[0], y1[1], y1[2], y1[3]);
                *(v2u*)(ACT + (size_t)(u.r0 + r) * DEXP + colb) = w8; }
    }
};
struct EpiDown {
    static constexpr bool PERM = true;
    const int* list; const float* wts; const LAS int* cnt; unsigned char* Y2;
    __device__ __forceinline__ void operator()(AccRef acc, const Unit& u, int wr, int wc, int fr, int fq) const {
        const int e = u.aux, n = cnt[e], row0 = u.r1 + wr * 64 + fr, colb = u.c0 * 256 + wc * 32 + 8 * fq;
#pragma unroll
        for (int ai = 0; ai < 2; ++ai)
#pragma unroll
            for (int m = 0; m < 4; ++m) { const int r = row0 + ai * HALF + m * 16;
                if (r < n) { const int ent = list[(size_t)e * LCAP + r]; const float w = wts[ent] * (SC_Y / (SC_ACT * SC_WD)); unsigned char* rowp = Y2 + (size_t)ent * D + colb;
#pragma unroll
                    for (int bj = 0; bj < 2; ++bj) { const f32x4 a0 = acc[ai][bj][m][0] * w, a1 = acc[ai][bj][m][1] * w; v2u w8; w8.x = pk4_fp8(a0[0], a0[1], a0[2], a0[3]); w8.y = pk4_fp8(a1[0], a1[1], a1[2], a1[3]);
                        *(v2u*)(rowp + bj * HALF) = w8; } } }
    }
};
struct KSplitOrder {
    const char* A; const char* Bt; int lda, ldb, K, nM, nks, G, c;
    __device__ bool next(int i, Unit& u) const {
        const int L = i * G + c; if (L >= nM * nks) return false;
        const int pm = L / nks, ks = L % nks;
        u.a = A + ((size_t)pm * BM * lda + (size_t)ks * K) * 2; u.b = Bt + (size_t)ks * BM * ldb * 2; u.r0 = pm * BM; u.c0 = 0; u.aux = ks; u.r1 = 0; return true;
    }
    __device__ __forceinline__ unsigned arow(const Unit&, int) const { return 0u; }
};
}

struct Frame {
    LAS unsigned char* lds;
    unsigned* ctl;
    int tid, lane, wave, vcu, G;
    const float* const __attribute__((address_space(4)))* in;
    float* out; unsigned char* ws;
};
enum { I_X = 0, I_MEM, I_NORM_MIX, I_W_IN, I_Q_NORM, I_K_NORM, I_SINKS, I_REL_BIAS, I_LAM_RE, I_LAM_IM, I_LOG_DT, I_B_RE, I_B_IM, I_C_RE, I_C_IM, I_SSM_D, I_W_GLU,
       I_MEM_NORM, I_W_MEM_KV, I_XQ_NORM, I_XK_NORM, I_ON_ATTN, I_ON_SSM, I_ON_X, I_W_O, I_NORM_FFN, I_WR_G, I_WR_E, I_W_GATE, I_W_UP, I_W_DOWN };

struct TrItem { const float* W; bf16* WT; const float* ks; int ldw, ldt, k0, n0, drow0; };
__device__ __forceinline__ void tr_load(const TrItem& it, f32x4 (&v)[8], int lane) {
    const int kc = lane & 7, nq = lane >> 3; const float* src = it.W + (size_t)(it.k0 + kc * 8) * it.ldw + it.n0 + nq * 4;
#pragma unroll
    for (int j = 0; j < 8; ++j) v[j] = __builtin_nontemporal_load((const f32x4*)(src + (size_t)j * it.ldw));
}
__device__ __forceinline__ void tr_store(const TrItem& it, f32x4 (&v)[8], int lane) {
    const int kc = lane & 7, nq = lane >> 3;
    if (it.ks) { const f32x4 s0 = *(const f32x4*)(it.ks + it.k0 + kc * 8), s1 = *(const f32x4*)(it.ks + it.k0 + kc * 8 + 4);
#pragma unroll
        for (int j = 0; j < 4; ++j) { v[j] = v[j] * s0[j]; v[4 + j] = v[4 + j] * s1[j]; } }
#pragma unroll
    for (int i = 0; i < 4; ++i) { v4u o; o.x = pk2(v[0][i], v[1][i]); o.y = pk2(v[2][i], v[3][i]); o.z = pk2(v[4][i], v[5][i]); o.w = pk2(v[6][i], v[7][i]);
        *(v4u*)(it.WT + (size_t)(it.drow0 + nq * 4 + i) * it.ldt + it.k0 + kc * 8) = o; }
}
__device__ __forceinline__ void rms_row_to_bf16(const float* xrow, const float* gain, bf16* orow, int lane) {
    const f32x4* xr = (const f32x4*)xrow + lane; const f32x4* gr = (const f32x4*)gain + lane;
    f32x4 v[8]; float s = 0.f;
#pragma unroll
    for (int j = 0; j < 8; ++j) { v[j] = xr[64 * j]; s += (v[j].x * v[j].x + v[j].y * v[j].y) + (v[j].z * v[j].z + v[j].w * v[j].w); }
    const float rstd = 1.0f / sqrtf(wave_sum(s) * (1.f / 2048.f) + EPS);
    v2u* o8 = (v2u*)orow + lane;
#pragma unroll
    for (int j = 0; j < 8; ++j) { const f32x4 g = gr[64 * j]; v2u w; w.x = pk2(v[j].x * rstd * g.x, v[j].y * rstd * g.y); w.y = pk2(v[j].z * rstd * g.z, v[j].w * rstd * g.w); o8[64 * j] = w; }
}

__device__ __forceinline__ void s5_tables(Frame& F, int g) {
    LAS float* ap = (LAS float*)F.lds;
    LAS float* Bb = ap + 33 * 64 * 2;
    LAS float* Cc = Bb + 64 * 16 * 2;
    LAS float* Km = Cc + 16 * 64 * 2;
    const float dt = expf(F.in[I_LOG_DT][g]);
    const float* lre = F.in[I_LAM_RE] + g * 64; const float* lim = F.in[I_LAM_IM] + g * 64;
    for (int idx = F.tid; idx < 33 * 64; idx += 512) { const int tau = idx >> 6, n = idx & 63; const float lr = lre[n], li = lim[n];
        const float mag = expf((float)tau * (lr * dt)), ang = (float)tau * (li * dt); ap[idx * 2] = mag * cosf(ang); ap[idx * 2 + 1] = mag * sinf(ang); }
    __syncthreads();
    for (int idx = F.tid; idx < 64 * 16; idx += 512) { const int n = idx >> 4; const float lr = lre[n], li = lim[n];
        const float nr = ap[(64 + n) * 2] - 1.0f, ni = ap[(64 + n) * 2 + 1], den = lr * lr + li * li;
        const float cr = (nr * lr + ni * li) / den, ci = (ni * lr - nr * li) / den;
        const float br = F.in[I_B_RE][(size_t)g * 1024 + idx], bi = F.in[I_B_IM][(size_t)g * 1024 + idx];
        Bb[idx * 2] = cr * br - ci * bi; Bb[idx * 2 + 1] = cr * bi + ci * br; }
    for (int idx = F.tid; idx < 16 * 64; idx += 512) { Cc[idx * 2] = F.in[I_C_RE][(size_t)g * 1024 + idx]; Cc[idx * 2 + 1] = F.in[I_C_IM][(size_t)g * 1024 + idx]; }
    __syncthreads();
    for (int idx = F.tid; idx < 32 * 256; idx += 512) { const int tau = idx >> 8, c = (idx >> 4) & 15, c2 = idx & 15; float s = 0.f;
        for (int n = 0; n < 64; ++n) { const float ar = ap[(tau * 64 + n) * 2], ai = ap[(tau * 64 + n) * 2 + 1], cr = Cc[(c * 64 + n) * 2], ci = Cc[(c * 64 + n) * 2 + 1];
            const float er = cr * ar - ci * ai, ei = cr * ai + ci * ar; s += er * Bb[(n * 16 + c2) * 2] - ei * Bb[(n * 16 + c2) * 2 + 1]; }
        Km[idx] = s; }
    __syncthreads();
    bf16* MQ = (bf16*)(F.ws + WS_MQ) + (size_t)g * 512 * S5K;
    for (int idx = F.tid; idx < 512 * 80; idx += 512) { const int row = idx / 80, ch = idx % 80, i = row >> 4, c = row & 15, k0 = ch * 8; float v[8];
        if (k0 < 512) { const int s = k0 >> 4, c20 = k0 & 15, tau = i - s;
#pragma unroll
            for (int j = 0; j < 8; ++j) v[j] = tau >= 0 ? Km[(tau * 16 + c) * 16 + c20 + j] : 0.f;
        } else { const int kk = k0 - 512, ri = kk >> 6, n0 = kk & 63;
#pragma unroll
            for (int j = 0; j < 8; ++j) { const int n = n0 + j; const float ar = ap[((i + 1) * 64 + n) * 2], ai = ap[((i + 1) * 64 + n) * 2 + 1], cr = Cc[(c * 64 + n) * 2], ci = Cc[(c * 64 + n) * 2 + 1];
                v[j] = ri == 0 ? (cr * ar - ci * ai) : -(cr * ai + ci * ar); } }
        v4u o; o.x = pk2(v[0], v[1]); o.y = pk2(v[2], v[3]); o.z = pk2(v[4], v[5]); o.w = pk2(v[6], v[7]);
        *(v4u*)(MQ + (size_t)row * S5K + k0) = o; }
    bf16* SP = (bf16*)(F.ws + WS_SP) + (size_t)g * 256 * 512;
    for (int idx = F.tid; idx < 256 * 64; idx += 512) { const int row = idx >> 6, k0 = (idx & 63) * 8; float v[8];
        if (row < 128) { const int ri = row >> 6, n = row & 63, s = k0 >> 4, c20 = k0 & 15; const float ar = ap[((31 - s) * 64 + n) * 2], ai = ap[((31 - s) * 64 + n) * 2 + 1];
#pragma unroll
            for (int j = 0; j < 8; ++j) { const float br = Bb[(n * 16 + c20 + j) * 2], bi = Bb[(n * 16 + c20 + j) * 2 + 1]; v[j] = ri == 0 ? (ar * br - ai * bi) : (ar * bi + ai * br); }
        } else {
#pragma unroll
            for (int j = 0; j < 8; ++j) v[j] = 0.f; }
        v4u o; o.x = pk2(v[0], v[1]); o.y = pk2(v[2], v[3]); o.z = pk2(v[4], v[5]); o.w = pk2(v[6], v[7]);
        *(v4u*)(SP + (size_t)row * 512 + k0) = o; }
    float* AL = (float*)(F.ws + WS_AL) + g * 128;
    if (F.tid < 64) { AL[F.tid * 2] = ap[(32 * 64 + F.tid) * 2]; AL[F.tid * 2 + 1] = ap[(32 * 64 + F.tid) * 2 + 1]; }
    __syncthreads();
}

struct BigTile { const float* src; unsigned char* dst; const float* ks; float sc; int ldw, ldt; };
constexpr int BT_GU = 64 * 2 * 64, BT_D = 64 * 64, BT_N = BT_GU + BT_D, BT_PITCH = 136;
__device__ __forceinline__ BigTile bt_decode(const Frame& F, unsigned char* Wgu8, unsigned char* Wd8, const float* nf, int ti) {
    BigTile t;
    const unsigned long long pg = (unsigned long long)F.in[I_W_GATE], pu = (unsigned long long)F.in[I_W_UP], pd = (unsigned long long)F.in[I_W_DOWN];
    if (ti < BT_GU) { const int e = ti >> 7, r = ti & 127, which = r >> 6, kb = (r >> 2) & 15, nb = r & 3;
        const unsigned long long p = pg + ((pu - pg) & (0ull - (unsigned long long)which));
        t.src = (const float*)p + (size_t)e * D * DEXP + (size_t)kb * 128 * DEXP + nb * 128; t.dst = Wgu8 + ((size_t)e * 1024 + nb * 256 + which * 128) * D + kb * 128; t.ks = nf + kb * 128; t.sc = SC_WGU; t.ldw = DEXP; t.ldt = D; }
    else { const int t2 = ti - BT_GU, e = t2 >> 6, r = t2 & 63, kb = r >> 4, nb = r & 15;
        t.src = (const float*)pd + (size_t)e * DEXP * D + (size_t)kb * 128 * D + nb * 128; t.dst = Wd8 + ((size_t)e * D + nb * 128) * DEXP + kb * 128; t.ks = nullptr; t.sc = SC_WD; t.ldw = D; t.ldt = DEXP; }
    return t;
}
#define BT_LOAD(t, v, kv) do { const unsigned _lo = (unsigned)(rl * 8 * (t).ldw + cq * 4); \
    _Pragma("unroll") for (int _p = 0; _p < 8; ++_p) kv[_p] = (t).ks ? (t).ks[rl * 8 + _p] * (t).sc : (t).sc; \
    _Pragma("unroll") for (int _p = 0; _p < 8; ++_p) v[_p] = __builtin_nontemporal_load((const f32x4*)((t).src + (size_t)_p * (t).ldw + _lo)); } while (0)
#define BT_STORE(t, v, kv) do { \
    _Pragma("unroll") for (int _i = 0; _i < 4; ++_i) { v2u _w; _w.x = pk4_fp8(v[0][_i] * kv[0], v[1][_i] * kv[1], v[2][_i] * kv[2], v[3][_i] * kv[3]); _w.y = pk4_fp8(v[4][_i] * kv[4], v[5][_i] * kv[5], v[6][_i] * kv[6], v[7][_i] * kv[7]); \
        *(LAS v2u*)(img + (cq * 4 + _i) * BT_PITCH + rl * 8) = _w; } \
    __syncthreads(); \
    _Pragma("unroll") for (int _j = 0; _j < 2; ++_j) { const int _idx = tid_ + _j * 512, _n = _idx >> 3, _ch = _idx & 7; \
        const v2u _a = *(const LAS v2u*)(img + _n * BT_PITCH + _ch * 16), _b = *(const LAS v2u*)(img + _n * BT_PITCH + _ch * 16 + 8); v4u _o; _o.x = _a.x; _o.y = _a.y; _o.z = _b.x; _o.w = _b.y; \
        *(v4u*)((t).dst + (size_t)_n * (t).ldt + _ch * 16) = _o; } \
    __syncthreads(); } while (0)
__device__ __forceinline__ void bg_convert(Frame& F, int qword, int base, int ntiles, int budget) {
    if (budget <= 0) return;
    int lane_ = (int)__builtin_amdgcn_mbcnt_hi(~0u, __builtin_amdgcn_mbcnt_lo(~0u, 0u)); asm volatile("" : "+v"(lane_)); const int tid_ = F.wave * 64 + lane_;
    unsigned char* WguT = F.ws + WS_WGU; unsigned char* WdT = F.ws + WS_WD; const float* nf = F.in[I_NORM_FFN];
    const int rl = tid_ >> 5, cq = tid_ & 31; LAS unsigned char* img = F.lds; LAS int* qn = (LAS int*)(F.lds + TAB_OFF + 1024);
    f32x4 va[8], vb[8]; float ka[8], kb[8];
    int nfetch = 0;
#define BG_FETCH(slot) do { if (nfetch < budget) { if (tid_ == 0) qn[slot] = (int)atomicAdd(F.ctl + qword, 1u); } else if (tid_ == 0) qn[slot] = 0x7fffffff; ++nfetch; } while (0)
    __syncthreads();
    BG_FETCH(0); BG_FETCH(1);
    __syncthreads();
    int i0 = __builtin_amdgcn_readfirstlane(qn[0]), i1 = __builtin_amdgcn_readfirstlane(qn[1]);
    __syncthreads();
    if (i0 < ntiles) { const BigTile t0 = bt_decode(F, WguT, WdT, nf, base + i0); BT_LOAD(t0, va, ka); }
    while (i0 < ntiles) {
        const BigTile ta = bt_decode(F, WguT, WdT, nf, base + i0);
        const BigTile tb = bt_decode(F, WguT, WdT, nf, base + (i1 < ntiles ? i1 : i0));
        BT_LOAD(tb, vb, kb);
        if (i1 >= ntiles) budget = 0;
        BG_FETCH(0);
        BT_STORE(ta, va, ka);
        const int i2 = __builtin_amdgcn_readfirstlane(qn[0]);
        if (i1 >= ntiles) break;
        const BigTile tc = bt_decode(F, WguT, WdT, nf, base + (i2 < ntiles ? i2 : i1));
        BT_LOAD(tc, va, ka);
        if (i2 >= ntiles) budget = 0;
        BG_FETCH(1);
        BT_STORE(tb, vb, kb);
        const int i3 = __builtin_amdgcn_readfirstlane(qn[1]);
        i0 = i2; i1 = i3;
    }
    __syncthreads();
#undef BG_FETCH
}
__device__ __forceinline__ void p0_prologue(Frame& F) {
    if (F.vcu < 32) s5_tables(F, F.vcu);
    const int gw = F.vcu * 8 + F.wave, NGW = F.G * 8;
    bf16* WinT = (bf16*)(F.ws + WS_WIN); bf16* WoT = (bf16*)(F.ws + WS_WO); bf16* WmkvT = (bf16*)(F.ws + WS_WMKV); bf16* WgluT = (bf16*)(F.ws + WS_WGLU);
    const float* nf = F.in[I_NORM_FFN];
    constexpr int I_IN = 32 * 72, I_O = 32 * 64, I_MKV = 32 * 32, I_GLU = 8 * 16;
    constexpr int NITEMS = I_IN + I_O + I_MKV + I_GLU;
    auto decode = [&](int it) -> TrItem {
        int r = it;
        if (r < I_IN) { const int kb = r / 72, nb = r % 72; return TrItem{F.in[I_W_IN], WinT, nullptr, INC, D, kb * 64, nb * 32, nb * 32}; } r -= I_IN;
        if (r < I_O) { const int kb = r / 64, nb = r % 64; return TrItem{F.in[I_W_O], WoT, nullptr, D, D, kb * 64, nb * 32, nb * 32}; } r -= I_O;
        if (r < I_MKV) { const int kb = r / 32, nb = r % 32; return TrItem{F.in[I_W_MEM_KV], WmkvT, nullptr, 1024, D, kb * 64, nb * 32, nb * 32}; } r -= I_MKV;
        const int kb = r / 16, nb = r % 16; return TrItem{F.in[I_W_GLU], WgluT, nullptr, 512, 512, kb * 64, nb * 32, nb * 32};
    };
    {
        f32x4 va[8], vb[8]; int it = gw; TrItem ia, ib;
        if (it < NITEMS) { ia = decode(it); tr_load(ia, va, F.lane); }
        while (it < NITEMS) {
            const int it2 = it + NGW; if (it2 < NITEMS) { ib = decode(it2); tr_load(ib, vb, F.lane); }
            tr_store(ia, va, F.lane);
            if (it2 >= NITEMS) break;
            const int it3 = it2 + NGW; if (it3 < NITEMS) { ia = decode(it3); tr_load(ia, va, F.lane); }
            tr_store(ib, vb, F.lane);
            it = it3;
        }
    }
    { bf16* WrT = (bf16*)(F.ws + WS_WR); const int gt = F.vcu * 512 + F.tid, NT = F.G * 512;
      for (int idx = gt; idx < 4 * 256 * 512; idx += NT) { const int ks = idx >> 17, n = (idx >> 9) & 255, k = ks * 512 + (idx & 511); float v = 0.f;
          if (n < 8) v = F.in[I_WR_G][k * 8 + n] * nf[k]; else if (n < 72) v = F.in[I_WR_E][k * 64 + (n - 8)] * nf[k];
          WrT[idx] = (bf16)f2bf(v); } }
    bf16* XN = (bf16*)(F.ws + WS_XN); bf16* MEMN = (bf16*)(F.ws + WS_MEMN);
    for (int m = gw; m < T; m += NGW) rms_row_to_bf16(F.in[I_X] + (size_t)m * D, F.in[I_NORM_MIX], XN + (size_t)m * D, F.lane);
    for (int m = gw; m < NB * MEML; m += NGW) rms_row_to_bf16(F.in[I_MEM] + (size_t)m * D, F.in[I_MEM_NORM], MEMN + (size_t)m * D, F.lane);
    bg_convert(F, CW_QGU, 0, BT_GU, F.vcu < 32 ? PB0_S5 : PB0);
    bg_convert(F, CW_QD, BT_GU, BT_D, PB0_D);
}

constexpr int SWA_KS = 72, SWA_VS = 264;
constexpr int SWA_KOFF = 0, SWA_VOFF = 256 * SWA_KS * 2, SWA_BOFF = SWA_VOFF + 64 * SWA_VS * 2;
__device__ __forceinline__ int t5_bucket(int n) { if (n < 16) return n; const int v = 16 + (int)(logf((float)n * (1.0f / 16.0f)) / logf(8.0f) * 16.0f); return v < 31 ? v : 31; }
__device__ __forceinline__ void swa_unit(Frame& F, int unit) {
    const int b = unit >> 5, kvh = (unit >> 4) & 1, nb = unit & 15;
    const bf16* PROJ = (const bf16*)(F.ws + WS_PROJ); bf16* MIX = (bf16*)(F.ws + WS_MIX);
    LAS bf16* Ks = (LAS bf16*)(F.lds + SWA_KOFF); LAS bf16* Vt = (LAS bf16*)(F.lds + SWA_VOFF); LAS float* bt = (LAS float*)(F.lds + SWA_BOFF);
    __syncthreads();
    {
        const int key = F.tid >> 1, half = F.tid & 1, s = (nb - 1) * 128 + key;
        v4u kw[4], vw[4];
        if (s >= 0) { const bf16* rp = PROJ + (size_t)(b * SEQ + s) * INC + 1024 + kvh * 64 + half * 32;
#pragma unroll
            for (int j = 0; j < 4; ++j) { kw[j] = *(const v4u*)(rp + j * 8); vw[j] = *(const v4u*)(rp + 128 + j * 8); }
        } else {
#pragma unroll
            for (int j = 0; j < 4; ++j) { kw[j] = (v4u){0u, 0u, 0u, 0u}; vw[j] = (v4u){0u, 0u, 0u, 0u}; } }
        float kf[32]; float ss = 0.f;
#pragma unroll
        for (int j = 0; j < 4; ++j) { kf[j * 8 + 0] = bflo(kw[j].x); kf[j * 8 + 1] = bfhi(kw[j].x); kf[j * 8 + 2] = bflo(kw[j].y); kf[j * 8 + 3] = bfhi(kw[j].y);
            kf[j * 8 + 4] = bflo(kw[j].z); kf[j * 8 + 5] = bfhi(kw[j].z); kf[j * 8 + 6] = bflo(kw[j].w); kf[j * 8 + 7] = bfhi(kw[j].w); }
#pragma unroll
        for (int j = 0; j < 32; ++j) ss += kf[j] * kf[j];
        ss += __shfl_xor(ss, 1);
        const float rstd = 1.0f / sqrtf(ss * (1.f / 64.f) + EPS);
        const float* kn = F.in[I_K_NORM] + half * 32;
#pragma unroll
        for (int j = 0; j < 4; ++j) { v4u o; o.x = pk2(kf[j * 8 + 0] * rstd * kn[j * 8 + 0], kf[j * 8 + 1] * rstd * kn[j * 8 + 1]); o.y = pk2(kf[j * 8 + 2] * rstd * kn[j * 8 + 2], kf[j * 8 + 3] * rstd * kn[j * 8 + 3]);
            o.z = pk2(kf[j * 8 + 4] * rstd * kn[j * 8 + 4], kf[j * 8 + 5] * rstd * kn[j * 8 + 5]); o.w = pk2(kf[j * 8 + 6] * rstd * kn[j * 8 + 6], kf[j * 8 + 7] * rstd * kn[j * 8 + 7]);
            *(LAS v4u*)(Ks + key * SWA_KS + half * 32 + j * 8) = o; }
#pragma unroll
        for (int j = 0; j < 4; ++j) { const unsigned w4[4] = {vw[j].x, vw[j].y, vw[j].z, vw[j].w};
#pragma unroll
            for (int q = 0; q < 4; ++q) { const int d = half * 32 + j * 8 + q * 2; Vt[d * SWA_VS + key] = (bf16)(w4[q] & 0xffffu); Vt[(d + 1) * SWA_VS + key] = (bf16)(w4[q] >> 16); } }
        for (int idx = F.tid; idx < 8 * 128; idx += 512) { const int w = idx >> 7, dl = idx & 127; bt[idx] = F.in[I_REL_BIAS][t5_bucket(dl) * 16 + kvh * 8 + w]; }
    }
    __syncthreads();
    const int w = F.wave, h = kvh * 8 + w, ql = F.lane & 31, hh = F.lane >> 5;
    const float sink = F.in[I_SINKS][h];
    const float* qn = F.in[I_Q_NORM];
    for (int r = 0; r < 4; ++r) {
        const int qi = 32 * r + ql; const size_t t = (size_t)b * SEQ + nb * 128 + qi;
        bf16x8 qf[4];
        {   const bf16* qp = PROJ + t * INC + h * 64 + 8 * hh; v4u qw[4]; float qv[32]; float ss = 0.f;
#pragma unroll
            for (int ks = 0; ks < 4; ++ks) qw[ks] = *(const v4u*)(qp + ks * 16);
#pragma unroll
            for (int ks = 0; ks < 4; ++ks) { qv[ks * 8 + 0] = bflo(qw[ks].x); qv[ks * 8 + 1] = bfhi(qw[ks].x); qv[ks * 8 + 2] = bflo(qw[ks].y); qv[ks * 8 + 3] = bfhi(qw[ks].y);
                qv[ks * 8 + 4] = bflo(qw[ks].z); qv[ks * 8 + 5] = bfhi(qw[ks].z); qv[ks * 8 + 6] = bflo(qw[ks].w); qv[ks * 8 + 7] = bfhi(qw[ks].w); }
#pragma unroll
            for (int j = 0; j < 32; ++j) ss += qv[j] * qv[j];
            ss += __shfl_xor(ss, 32);
            const float sc = 0.125f / sqrtf(ss * (1.f / 64.f) + EPS);
#pragma unroll
            for (int ks = 0; ks < 4; ++ks) { const float* g = qn + ks * 16 + 8 * hh; v4u o;
                o.x = pk2(qv[ks * 8 + 0] * sc * g[0], qv[ks * 8 + 1] * sc * g[1]); o.y = pk2(qv[ks * 8 + 2] * sc * g[2], qv[ks * 8 + 3] * sc * g[3]);
                o.z = pk2(qv[ks * 8 + 4] * sc * g[4], qv[ks * 8 + 5] * sc * g[5]); o.w = pk2(qv[ks * 8 + 6] * sc * g[6], qv[ks * 8 + 7] * sc * g[7]);
                qf[ks] = __builtin_bit_cast(bf16x8, o); } }
        f32x16 s[5];
        const int qh = ql - 4 * hh; const LAS float* pb = bt + w * 128 + qh;
        float mx = sink;
#pragma unroll
        for (int kt = 0; kt < 5; ++kt) {
            const bool live = (nb > 0) || (r + kt >= 4);
            f32x16 a = {0.f, 0.f, 0.f, 0.f, 0.f, 0.f, 0.f, 0.f, 0.f, 0.f, 0.f, 0.f, 0.f, 0.f, 0.f, 0.f};
            if (live) {
#pragma unroll
                for (int ks = 0; ks < 4; ++ks) { const bf16x8 kfrag = *(const LAS bf16x8*)(Ks + (32 * (r + kt) + ql) * SWA_KS + ks * 16 + 8 * hh);
                    a = __builtin_amdgcn_mfma_f32_32x32x16_bf16(kfrag, qf[ks], a, 0, 0, 0); }
#pragma unroll
                for (int rg = 0; rg < 16; ++rg) { const int rowc = (rg & 3) + 8 * (rg >> 2);
                    float v = a[rg] + pb[128 - 32 * kt - rowc];
                    if (kt == 0) v = (rowc > qh) ? v : -1e30f;
                    if (kt == 4) v = (rowc <= qh) ? v : -1e30f;
                    a[rg] = v; mx = fmaxf(mx, v); }
            } else {
#pragma unroll
                for (int rg = 0; rg < 16; ++rg) a[rg] = -1e30f;
            }
            s[kt] = a; }
        mx = fmaxf(mx, __shfl_xor(mx, 32));
        float l = 0.f;
#pragma unroll
        for (int kt = 0; kt < 5; ++kt)
#pragma unroll
            for (int rg = 0; rg < 16; ++rg) { const float p = fast_exp(s[kt][rg] - mx); s[kt][rg] = p; l += p; }
        l += __shfl_xor(l, 32);
        l += fast_exp(sink - mx);
        f32x16 o[2];
#pragma unroll
        for (int dt = 0; dt < 2; ++dt) o[dt] = (f32x16){0.f, 0.f, 0.f, 0.f, 0.f, 0.f, 0.f, 0.f, 0.f, 0.f, 0.f, 0.f, 0.f, 0.f, 0.f, 0.f};
#pragma unroll
        for (int kt = 0; kt < 5; ++kt)
#pragma unroll
            for (int st = 0; st < 2; ++st) { v4u pw; pw.x = pk2(s[kt][8 * st + 0], s[kt][8 * st + 1]); pw.y = pk2(s[kt][8 * st + 2], s[kt][8 * st + 3]); pw.z = pk2(s[kt][8 * st + 4], s[kt][8 * st + 5]); pw.w = pk2(s[kt][8 * st + 6], s[kt][8 * st + 7]);
                const bf16x8 pf = __builtin_bit_cast(bf16x8, pw);
#pragma unroll
                for (int dt = 0; dt < 2; ++dt) { const LAS bf16* vp = Vt + (dt * 32 + ql) * SWA_VS + 32 * (r + kt) + 16 * st + 4 * hh;
                    const v2u lo = *(const LAS v2u*)vp, hi = *(const LAS v2u*)(vp + 8); v4u vv; vv.x = lo.x; vv.y = lo.y; vv.z = hi.x; vv.w = hi.y;
                    o[dt] = __builtin_amdgcn_mfma_f32_32x32x16_bf16(__builtin_bit_cast(bf16x8, vv), pf, o[dt], 0, 0, 0); } }
        const float inv = 1.0f / l;
        bf16* op = MIX + t * D + h * 64 + 4 * hh;
#pragma unroll
        for (int dt = 0; dt < 2; ++dt)
#pragma unroll
            for (int q4 = 0; q4 < 4; ++q4) { v2u ow; ow.x = pk2(o[dt][q4 * 4 + 0] * inv, o[dt][q4 * 4 + 1] * inv); ow.y = pk2(o[dt][q4 * 4 + 2] * inv, o[dt][q4 * 4 + 3] * inv);
                *(v2u*)(op + dt * 32 + q4 * 8) = ow; }
    }
}

constexpr int XA_KS = 136, XA_VS = 264;
constexpr int XA_KOFF = 0, XA_VOFF = 256 * XA_KS * 2;
__device__ __forceinline__ void xattn_unit(Frame& F, int unit) {
    const int b = unit >> 5, hx = (unit >> 3) & 3, qb = unit & 7;
    const bf16* PROJ = (const bf16*)(F.ws + WS_PROJ); const bf16* MKV = (const bf16*)(F.ws + WS_MEMKV); bf16* MIX = (bf16*)(F.ws + WS_MIX);
    LAS bf16* Ks = (LAS bf16*)(F.lds + XA_KOFF); LAS bf16* Vt = (LAS bf16*)(F.lds + XA_VOFF);
    __syncthreads();
    {   const int key = F.tid >> 1, half = F.tid & 1; const bf16* rp = MKV + (size_t)(b * MEML + key) * 1024 + hx * 128 + half * 64;
        float ss = 0.f; v4u kw[8];
#pragma unroll
        for (int j = 0; j < 8; ++j) { kw[j] = *(const v4u*)(rp + j * 8);
            const float a0 = bflo(kw[j].x), a1 = bfhi(kw[j].x), a2 = bflo(kw[j].y), a3 = bfhi(kw[j].y), a4 = bflo(kw[j].z), a5 = bfhi(kw[j].z), a6 = bflo(kw[j].w), a7 = bfhi(kw[j].w);
            ss += (a0 * a0 + a1 * a1) + (a2 * a2 + a3 * a3) + (a4 * a4 + a5 * a5) + (a6 * a6 + a7 * a7); }
        ss += __shfl_xor(ss, 1);
        const float rstd = 1.0f / sqrtf(ss * (1.f / 128.f) + EPS);
        const float* kn = F.in[I_XK_NORM] + half * 64;
#pragma unroll
        for (int j = 0; j < 8; ++j) { v4u o; const float* g = kn + j * 8;
            o.x = pk2(bflo(kw[j].x) * rstd * g[0], bfhi(kw[j].x) * rstd * g[1]); o.y = pk2(bflo(kw[j].y) * rstd * g[2], bfhi(kw[j].y) * rstd * g[3]);
            o.z = pk2(bflo(kw[j].z) * rstd * g[4], bfhi(kw[j].z) * rstd * g[5]); o.w = pk2(bflo(kw[j].w) * rstd * g[6], bfhi(kw[j].w) * rstd * g[7]);
            *(LAS v4u*)(Ks + key * XA_KS + half * 64 + j * 8) = o; }
#pragma unroll
        for (int j = 0; j < 8; ++j) { const v4u vw = *(const v4u*)(rp + 512 + j * 8); const unsigned w4[4] = {vw.x, vw.y, vw.z, vw.w};
#pragma unroll
            for (int q = 0; q < 4; ++q) { const int d = half * 64 + j * 8 + q * 2; Vt[d * XA_VS + key] = (bf16)(w4[q] & 0xffffu); Vt[(d + 1) * XA_VS + key] = (bf16)(w4[q] >> 16); } }
    }
    __syncthreads();
    const int ql = F.lane & 31, hh = F.lane >> 5;
    const size_t t = (size_t)b * SEQ + qb * 256 + F.wave * 32 + ql;
    bf16x8 qf[8];
    {   const bf16* qp = PROJ + t * INC + 1792 + hx * 128 + 8 * hh; v4u qw[8]; float ss = 0.f;
#pragma unroll
        for (int ks = 0; ks < 8; ++ks) { qw[ks] = *(const v4u*)(qp + ks * 16);
            const float a0 = bflo(qw[ks].x), a1 = bfhi(qw[ks].x), a2 = bflo(qw[ks].y), a3 = bfhi(qw[ks].y), a4 = bflo(qw[ks].z), a5 = bfhi(qw[ks].z), a6 = bflo(qw[ks].w), a7 = bfhi(qw[ks].w);
            ss += (a0 * a0 + a1 * a1) + (a2 * a2 + a3 * a3) + (a4 * a4 + a5 * a5) + (a6 * a6 + a7 * a7); }
        ss += __shfl_xor(ss, 32);
        const float sc = 0.08838834764831845f / sqrtf(ss * (1.f / 128.f) + EPS);
        const float* qn = F.in[I_XQ_NORM] + 8 * hh;
#pragma unroll
        for (int ks = 0; ks < 8; ++ks) { const float* g = qn + ks * 16; v4u o;
            o.x = pk2(bflo(qw[ks].x) * sc * g[0], bfhi(qw[ks].x) * sc * g[1]); o.y = pk2(bflo(qw[ks].y) * sc * g[2], bfhi(qw[ks].y) * sc * g[3]);
            o.z = pk2(bflo(qw[ks].z) * sc * g[4], bfhi(qw[ks].z) * sc * g[5]); o.w = pk2(bflo(qw[ks].w) * sc * g[6], bfhi(qw[ks].w) * sc * g[7]);
            qf[ks] = __builtin_bit_cast(bf16x8, o); } }
    f32x16 o[4];
#pragma unroll
    for (int dt = 0; dt < 4; ++dt) o[dt] = (f32x16){0.f, 0.f, 0.f, 0.f, 0.f, 0.f, 0.f, 0.f, 0.f, 0.f, 0.f, 0.f, 0.f, 0.f, 0.f, 0.f};
    float mrun = -1e30f, lrun = 0.f;
    for (int kb = 0; kb < 4; ++kb) {
        f32x16 s[2];
#pragma unroll
        for (int kt = 0; kt < 2; ++kt) { f32x16 a = {0.f, 0.f, 0.f, 0.f, 0.f, 0.f, 0.f, 0.f, 0.f, 0.f, 0.f, 0.f, 0.f, 0.f, 0.f, 0.f};
#pragma unroll
            for (int ks = 0; ks < 8; ++ks) { const bf16x8 kfrag = *(const LAS bf16x8*)(Ks + (64 * kb + 32 * kt + ql) * XA_KS + ks * 16 + 8 * hh);
                a = __builtin_amdgcn_mfma_f32_32x32x16_bf16(kfrag, qf[ks], a, 0, 0, 0); }
            s[kt] = a; }
        float mx = mrun;
#pragma unroll
        for (int kt = 0; kt < 2; ++kt)
#pragma unroll
            for (int rg = 0; rg < 16; ++rg) mx = fmaxf(mx, s[kt][rg]);
        mx = fmaxf(mx, __shfl_xor(mx, 32));
        const float alpha = fast_exp(mrun - mx); mrun = mx;
        float ls = 0.f;
#pragma unroll
        for (int kt = 0; kt < 2; ++kt)
#pragma unroll
            for (int rg = 0; rg < 16; ++rg) { const float p = fast_exp(s[kt][rg] - mx); s[kt][rg] = p; ls += p; }
        lrun = lrun * alpha + ls;
#pragma unroll
        for (int dt = 0; dt < 4; ++dt)
#pragma unroll
            for (int rg = 0; rg < 16; ++rg) o[dt][rg] *= alpha;
#pragma unroll
        for (int kt = 0; kt < 2; ++kt)
#pragma unroll
            for (int st = 0; st < 2; ++st) { v4u pw; pw.x = pk2(s[kt][8 * st + 0], s[kt][8 * st + 1]); pw.y = pk2(s[kt][8 * st + 2], s[kt][8 * st + 3]); pw.z = pk2(s[kt][8 * st + 4], s[kt][8 * st + 5]); pw.w = pk2(s[kt][8 * st + 6], s[kt][8 * st + 7]);
                const bf16x8 pf = __builtin_bit_cast(bf16x8, pw);
#pragma unroll
                for (int dt = 0; dt < 4; ++dt) { const LAS bf16* vp = Vt + (dt * 32 + ql) * XA_VS + 64 * kb + 32 * kt + 16 * st + 4 * hh;
                    const v2u lo = *(const LAS v2u*)vp, hi = *(const LAS v2u*)(vp + 8); v4u vv; vv.x = lo.x; vv.y = lo.y; vv.z = hi.x; vv.w = hi.y;
                    o[dt] = __builtin_amdgcn_mfma_f32_32x32x16_bf16(__builtin_bit_cast(bf16x8, vv), pf, o[dt], 0, 0, 0); } }
    }
    lrun += __shfl_xor(lrun, 32);
    const float inv = 1.0f / lrun;
    bf16* op = MIX + t * D + 1536 + hx * 128 + 4 * hh;
#pragma unroll
    for (int dt = 0; dt < 4; ++dt)
#pragma unroll
        for (int q4 = 0; q4 < 4; ++q4) { v2u ow; ow.x = pk2(o[dt][q4 * 4 + 0] * inv, o[dt][q4 * 4 + 1] * inv); ow.y = pk2(o[dt][q4 * 4 + 2] * inv, o[dt][q4 * 4 + 3] * inv);
            *(v2u*)(op + dt * 32 + q4 * 8) = ow; }
}

__device__ __forceinline__ void moe_tables(Frame& F) {
    LAS int* cnt = (LAS int*)(F.lds + TAB_OFF); LAS int* ts = cnt + 64;
    __syncthreads();
    if (F.tid < 64) { const int c = (int)__hip_atomic_load(F.ctl + CW_CNT + F.tid, __ATOMIC_RELAXED, __HIP_MEMORY_SCOPE_AGENT); const int nt = (c + 255) >> 8; int inc = nt;
#pragma unroll
        for (int o = 1; o < 64; o <<= 1) { const int v = __shfl_up(inc, o); if (F.tid >= o) inc += v; }
        cnt[F.tid] = c; ts[F.tid + 1] = inc; if (F.tid == 0) ts[0] = 0; }
    __syncthreads();
}

struct Args { const float* in[31]; float* out; unsigned char* ws; int ph_lo, ph_hi; };
__global__ void __launch_bounds__(512, 2) hymba_fwd(Args args) {
    extern __shared__ __attribute__((aligned(16))) unsigned char lds_raw[];
    Frame F;
    F.lds = (LAS unsigned char*)lds_raw;
    F.tid = threadIdx.x; F.lane = F.tid & 63; F.wave = __builtin_amdgcn_readfirstlane(F.tid >> 6);
    F.G = gridDim.x; { const int bx = blockIdx.x; F.vcu = (F.G % 8 == 0) ? (bx % 8) * (F.G / 8) + bx / 8 : bx; }
    F.in = (const float* const __attribute__((address_space(4)))*)__builtin_amdgcn_kernarg_segment_ptr();
    F.out = args.out; F.ws = args.ws; F.ctl = (unsigned*)(args.ws + WS_CTL);
    const int lo = args.ph_lo, hi = args.ph_hi;
#if !MK_PER_PHASE
    if (F.tid < 4) ((LAS unsigned*)(F.lds + XBW_OFF))[F.tid] = 0u;
    __syncthreads();
    XcdBarrier bar = xcd_barrier_post(F.ctl + CW_BAR, (volatile LAS unsigned*)(F.lds + XBW_OFF));
#define GRID_BAR() xcd_barrier(bar)
#else
#define GRID_BAR() do {} while (0)
#endif
#define PHASE_REGS() do { int _l = (int)__builtin_amdgcn_mbcnt_hi(~0u, __builtin_amdgcn_mbcnt_lo(~0u, 0u)); asm volatile("" : "+v"(_l)); F.lane = _l; F.tid = F.wave * 64 + _l; } while (0)
#define IN(k) (lo <= (k) && (k) < hi)
#define SEAM(k) do { if (IN(k) && IN((k) + 1)) GRID_BAR(); } while (0)
    const int gw = F.vcu * 8 + F.wave, NGW = F.G * 8;
    bf16* const XN = (bf16*)(F.ws + WS_XN); bf16* const PROJ = (bf16*)(F.ws + WS_PROJ); bf16* const MIX = (bf16*)(F.ws + WS_MIX);
    bf16* const UA = (bf16*)(F.ws + WS_UA); bf16* const Gm = (bf16*)(F.ws + WS_G);

    if (IN(0)) { PHASE_REGS(); p0_prologue(F); }
    SEAM(0);
    if (IN(1)) { PHASE_REGS();
        { pg8::Gemm g{D, D, D}; pg8::DenseOrder S; S.init(XN, F.ws + WS_WIN, D, D, T, INC, F.G, (int)blockIdx.x);
          pg8::EpiProj E{PROJ, UA}; pg8::gemm_phase<pg8::EpiProj, pg8::DenseOrder>(F.lds, g, S, E, F.wave); }
        { pg8::Gemm g{D, D, D}; pg8::DenseOrder S; S.init(F.ws + WS_MEMN, F.ws + WS_WMKV, D, D, NB * MEML, 1024, F.G, F.G - 1 - (int)blockIdx.x);
          pg8::EpiBf16 E{(bf16*)(F.ws + WS_MEMKV), 1024}; pg8::gemm_phase<pg8::EpiBf16, pg8::DenseOrder>(F.lds, g, S, E, F.wave); }
        { const int c = (int)blockIdx.x; const bool has3 = 2 * F.G + c < (T / 256) * (INC / 256), haskv = (F.G - 1 - c) < (NB * MEML / 256) * 4;
          bg_convert(F, CW_QGU, 0, BT_GU, (!has3 && !haskv) ? PB1 : 0); }
    }
    SEAM(1);
    if (IN(2)) { PHASE_REGS();
        for (int u = F.vcu; u < 256; u += F.G) swa_unit(F, u);
        __syncthreads();
        { pg8::Gemm g{S5K, 512, 512}; pg8::GroupOrder S{(const char*)UA, (const char*)(F.ws + WS_SP), S5K, 512, 1, 32, F.G, F.G - 1 - F.vcu};
          pg8::EpiF32 E{(float*)(F.ws + WS_SL), 256, (size_t)512 * 256}; pg8::gemm_phase<pg8::EpiF32, pg8::GroupOrder>(F.lds, g, S, E, F.wave); }
        bg_convert(F, CW_QGU, 0, BT_GU, (F.G - 1 - F.vcu) >= 64 ? PB2 : 0);
    }
    SEAM(2);
    if (IN(3)) { PHASE_REGS();
        if (F.wave == 0) {
            const float* SL = (const float*)(F.ws + WS_SL); const float* AL = (const float*)(F.ws + WS_AL);
            for (int p = F.vcu; p < 256; p += F.G) { const int b = p >> 5, g = p & 31, n = F.lane;
                const float ar = AL[(g * 64 + n) * 2], ai = AL[(g * 64 + n) * 2 + 1]; float xr = 0.f, xi = 0.f;
                for (int j0 = 0; j0 < 64; j0 += 8) { float sr[8], si[8];
#pragma unroll
                    for (int j = 0; j < 8; ++j) { const float* sp = SL + ((size_t)(g * 512 + b * 64 + j0 + j)) * 256; sr[j] = sp[n]; si[j] = sp[64 + n]; }
#pragma unroll
                    for (int j = 0; j < 8; ++j) { bf16* up = UA + ((size_t)(g * 512 + b * 64 + j0 + j)) * S5K + 512; up[n] = (bf16)f2bf(xr); up[64 + n] = (bf16)f2bf(xi);
                        const float nr = ar * xr - ai * xi + sr[j], ni = ar * xi + ai * xr + si[j]; xr = nr; xi = ni; } } }
        }
        if (F.G < 256) { for (int u = F.vcu; u < 256; u += F.G) xattn_unit(F, u); __syncthreads(); }
    }
    SEAM(3);
    if (IN(4)) { PHASE_REGS();
        pg8::Gemm g{S5K, S5K, S5K}; pg8::GroupOrder S{(const char*)UA, (const char*)(F.ws + WS_MQ), S5K, S5K, 2, 32, F.G, F.vcu};
        pg8::EpiS5Y E{UA, F.in[I_SSM_D], Gm}; pg8::gemm_phase<pg8::EpiS5Y, pg8::GroupOrder>(F.lds, g, S, E, F.wave);
        if (F.G >= 256 && F.vcu >= 128) { for (int u = F.vcu - 128; u < 128; u += F.G - 128) xattn_unit(F, u); __syncthreads(); }
    }
    SEAM(4);
    if (IN(5)) { PHASE_REGS();
        pg8::Gemm g{512, 512, 512}; pg8::DenseOrder S; S.init(Gm, F.ws + WS_WGLU, 512, 512, T, 512, F.G, (int)blockIdx.x);
        pg8::EpiGlu E{Gm, MIX}; pg8::gemm_phase<pg8::EpiGlu, pg8::DenseOrder>(F.lds, g, S, E, F.wave);
        if (F.G >= 256 && (int)blockIdx.x >= 128) { for (int u = 128 + (int)blockIdx.x - 128; u < 256; u += F.G - 128) xattn_unit(F, u); __syncthreads(); }
    }
    SEAM(5);
    if (IN(6)) { PHASE_REGS();
        for (int m = gw; m < T; m += NGW) { v4u* rp = (v4u*)(MIX + (size_t)m * D) + F.lane; v4u w[4]; float ss[4];
#pragma unroll
            for (int j = 0; j < 4; ++j) { w[j] = rp[64 * j];
                const float a0 = bflo(w[j].x), a1 = bfhi(w[j].x), a2 = bflo(w[j].y), a3 = bfhi(w[j].y), a4 = bflo(w[j].z), a5 = bfhi(w[j].z), a6 = bflo(w[j].w), a7 = bfhi(w[j].w);
                ss[j] = (a0 * a0 + a1 * a1) + (a2 * a2 + a3 * a3) + (a4 * a4 + a5 * a5) + (a6 * a6 + a7 * a7); }
            const float sa = wave_sum(ss[0] + ss[1]), sb = wave_sum(ss[2]), sc = wave_sum(ss[3]);
            const float ra = 1.0f / sqrtf(sa * (1.f / 1024.f) + EPS), rb = 1.0f / sqrtf(sb * (1.f / 512.f) + EPS), rc = 1.0f / sqrtf(sc * (1.f / 512.f) + EPS);
#pragma unroll
            for (int j = 0; j < 4; ++j) { const float rs = j < 2 ? ra : (j == 2 ? rb : rc);
                const float* g = (j < 2 ? F.in[I_ON_ATTN] + j * 512 : (j == 2 ? F.in[I_ON_SSM] : F.in[I_ON_X])) + F.lane * 8; v4u o;
                o.x = pk2(bflo(w[j].x) * rs * g[0], bfhi(w[j].x) * rs * g[1]); o.y = pk2(bflo(w[j].y) * rs * g[2], bfhi(w[j].y) * rs * g[3]);
                o.z = pk2(bflo(w[j].z) * rs * g[4], bfhi(w[j].z) * rs * g[5]); o.w = pk2(bflo(w[j].w) * rs * g[6], bfhi(w[j].w) * rs * g[7]);
                rp[64 * j] = o; } }
    }
    SEAM(6);
    if (IN(7)) { PHASE_REGS();
        pg8::Gemm g{D, D, D}; pg8::DenseOrder S; S.init(MIX, F.ws + WS_WO, D, D, T, D, F.G, (int)blockIdx.x);
        pg8::EpiWo E{F.in[I_X], XN, (unsigned char*)(F.ws + WS_X18), (float*)(F.ws + WS_PART)}; pg8::gemm_phase<pg8::EpiWo, pg8::DenseOrder>(F.lds, g, S, E, F.wave);
    }
    SEAM(7);
    if (IN(8)) { PHASE_REGS();
        pg8::Gemm g{D, 512, 512}; pg8::KSplitOrder S{(const char*)XN, (const char*)(F.ws + WS_WR), D, 512, 512, T / 256, 4, F.G, F.vcu};
        pg8::EpiLogit E{(float*)(F.ws + WS_LP)}; pg8::gemm_phase<pg8::EpiLogit, pg8::KSplitOrder>(F.lds, g, S, E, F.wave);
    }
    SEAM(8);
    const int rt_per = (T + F.G - 1) / F.G, rt_beg = F.vcu * rt_per, rt_end = (rt_beg + rt_per) < T ? (rt_beg + rt_per) : T;
    if (IN(9)) { PHASE_REGS();
        LAS int* hist = (LAS int*)F.lds;
        const float* LP = (const float*)(F.ws + WS_LP); const float* part = (const float*)(F.ws + WS_PART); float* rstdv = (float*)(F.ws + WS_RSTD);
        int* toke = (int*)(F.ws + WS_TOKE); float* wts = (float*)(F.ws + WS_WTS); int* HIST = (int*)(F.ws + WS_HIST);
        __syncthreads();
        if (F.tid < 64) hist[F.tid] = 0;
        __syncthreads();
        for (int t = rt_beg + F.tid; t < rt_end; t += 512) {
            const f32x4* pp = (const f32x4*)(part + (size_t)t * 32); float ss = 0.f;
#pragma unroll
            for (int j = 0; j < 8; ++j) { const f32x4 v = pp[j]; ss += (v[0] + v[1]) + (v[2] + v[3]); }
            const float rs = 1.0f / sqrtf(ss * (1.f / 2048.f) + EPS); rstdv[t] = rs;
            const float* l0 = LP + (size_t)t * 80; const float* l1 = l0 + (size_t)T * 80; const float* l2 = l1 + (size_t)T * 80; const float* l3 = l2 + (size_t)T * 80;
            float gl[8];
#pragma unroll
            for (int j = 0; j < 8; j += 4) { const f32x4 a = *(const f32x4*)(l0 + j), b = *(const f32x4*)(l1 + j), c = *(const f32x4*)(l2 + j), d = *(const f32x4*)(l3 + j);
#pragma unroll
                for (int q = 0; q < 4; ++q) gl[j + q] = rs * (((a[q] + b[q]) + c[q]) + d[q]); }
            int gi = 0; float gm = gl[0];
#pragma unroll
            for (int j = 1; j < 8; ++j) if (gl[j] > gm) { gm = gl[j]; gi = j; }
            float gs = 0.f;
#pragma unroll
            for (int j = 0; j < 8; ++j) gs += expf(gl[j] - gm);
            const float gate = 1.0f / gs;
            float el[8];
#pragma unroll
            for (int j = 0; j < 8; j += 4) { const int o = 8 + gi * 8 + j; const f32x4 a = *(const f32x4*)(l0 + o), b = *(const f32x4*)(l1 + o), c = *(const f32x4*)(l2 + o), d = *(const f32x4*)(l3 + o);
#pragma unroll
                for (int q = 0; q < 4; ++q) el[j + q] = rs * (((a[q] + b[q]) + c[q]) + d[q]); }
            int i1 = 0; float v1 = el[0];
#pragma unroll
            for (int j = 1; j < 8; ++j) if (el[j] > v1) { v1 = el[j]; i1 = j; }
            int i2 = -1; float v2 = -3.0e38f;
#pragma unroll
            for (int j = 0; j < 8; ++j) if (j != i1 && el[j] > v2) { v2 = el[j]; i2 = j; }
            const float ex = expf(v2 - v1);
            const int ea = gi * 8 + i1, eb = gi * 8 + i2;
            const int la = __hip_atomic_fetch_add(hist + ea, 1, __ATOMIC_RELAXED, __HIP_MEMORY_SCOPE_WORKGROUP), lb = __hip_atomic_fetch_add(hist + eb, 1, __ATOMIC_RELAXED, __HIP_MEMORY_SCOPE_WORKGROUP);
            toke[t * 2] = (ea << 16) | la; toke[t * 2 + 1] = (eb << 16) | lb; wts[t * 2] = gate / (1.0f + ex); wts[t * 2 + 1] = gate * ex / (1.0f + ex);
        }
        __syncthreads();
        if (F.tid < 64) HIST[F.vcu * 64 + F.tid] = hist[F.tid];
        __syncthreads();
    }
    SEAM(9);
    if (IN(10)) { PHASE_REGS();
        LAS int* pb = (LAS int*)F.lds; LAS int* pt = pb + 512; LAS int* base = pt + 512;
        const int* HIST = (const int*)(F.ws + WS_HIST); const int* toke = (const int*)(F.ws + WS_TOKE); int* list = (int*)(F.ws + WS_LIST);
        __syncthreads();
        { const int e = F.tid & 63, p8 = F.tid >> 6; int sb = 0, st = 0;
          for (int w = p8; w < F.G; w += 8) { const int h = HIST[w * 64 + e]; st += h; sb += (w < F.vcu) ? h : 0; }
          pb[F.tid] = sb; pt[F.tid] = st; }
        __syncthreads();
        if (F.tid < 64) { int sb = 0, st = 0;
#pragma unroll
            for (int j = 0; j < 8; ++j) { sb += pb[j * 64 + F.tid]; st += pt[j * 64 + F.tid]; }
            base[F.tid] = sb; F.ctl[CW_CNT + F.tid] = (unsigned)st; }
        __syncthreads();
        for (int t = rt_beg + F.tid; t < rt_end; t += 512) {
#pragma unroll
            for (int k = 0; k < 2; ++k) { const int v = toke[t * 2 + k], e = v >> 16, sl = v & 0xffff; list[(size_t)e * LCAP + base[e] + sl] = t * 2 + k; } }
        __syncthreads();
        bg_convert(F, CW_QGU, 0, BT_GU, 0x7fffffff);
    }
    SEAM(10);
    if (IN(11)) { PHASE_REGS();
        moe_tables(F);
        const LAS int* cnt = (const LAS int*)(F.lds + TAB_OFF); const int* list = (const int*)(F.ws + WS_LIST);
        pg8::Gemm g{D / 2, D / 2, D / 2}; pg8::MoeOrder S{(const char*)(F.ws + WS_X18), (const char*)(F.ws + WS_WGU), cnt, cnt + 64, list, D / 2, D / 2, 4, 1024, F.G, F.vcu, true};
        pg8::EpiGU E{list, (const float*)(F.ws + WS_RSTD), cnt, F.ws + WS_ACT}; pg8::gemm_phase<pg8::EpiGU, pg8::MoeOrder, true, true>(F.lds, g, S, E, F.wave);
        PHASE_REGS();
        bg_convert(F, CW_QD, BT_GU, BT_D, 0x7fffffff);
    }
    SEAM(11);
    if (IN(12)) { PHASE_REGS();
        moe_tables(F);
        const LAS int* cnt = (const LAS int*)(F.lds + TAB_OFF); const int* list = (const int*)(F.ws + WS_LIST);
        pg8::Gemm g{DEXP / 2, DEXP / 2, DEXP / 2}; pg8::MoeOrder S{(const char*)(F.ws + WS_ACT), (const char*)(F.ws + WS_WD), cnt, cnt + 64, list, DEXP / 2, DEXP / 2, 8, 2048, F.G, F.vcu, false};
        pg8::EpiDown E{list, (const float*)(F.ws + WS_WTS), cnt, F.ws + WS_Y2};
        pg8::gemm_phase<pg8::EpiDown, pg8::MoeOrder, false, true>(F.lds, g, S, E, F.wave);
    }
    SEAM(12);
    if (IN(13)) { PHASE_REGS();
        const unsigned char* Y2 = F.ws + WS_Y2; typedef float f32x2_ __attribute__((ext_vector_type(2)));
        for (int m = gw; m < T; m += NGW) { f32x4* op = (f32x4*)(F.out + (size_t)m * D) + F.lane * 2; const v4u* xb = (const v4u*)(XN + (size_t)m * D) + F.lane;
            const v2u* ya = (const v2u*)(Y2 + (size_t)m * 2 * D) + F.lane; const v2u* yb = ya + 256;
            v4u xw[4]; v2u aw[4], cw[4];
#pragma unroll
            for (int j = 0; j < 4; ++j) { xw[j] = __builtin_nontemporal_load(xb + 64 * j); aw[j] = __builtin_nontemporal_load(ya + 64 * j); cw[j] = __builtin_nontemporal_load(yb + 64 * j); }
#pragma unroll
            for (int j = 0; j < 4; ++j) { const v4u x = xw[j]; const v2u a = aw[j], c = cw[j]; f32x4 x0, x1; const float is = 1.0f / SC_Y;
                const f32x2_ a0 = __builtin_amdgcn_cvt_pk_f32_fp8((int)a.x, false), a1 = __builtin_amdgcn_cvt_pk_f32_fp8((int)a.x, true), a2 = __builtin_amdgcn_cvt_pk_f32_fp8((int)a.y, false), a3 = __builtin_amdgcn_cvt_pk_f32_fp8((int)a.y, true);
                const f32x2_ c0 = __builtin_amdgcn_cvt_pk_f32_fp8((int)c.x, false), c1 = __builtin_amdgcn_cvt_pk_f32_fp8((int)c.x, true), c2 = __builtin_amdgcn_cvt_pk_f32_fp8((int)c.y, false), c3 = __builtin_amdgcn_cvt_pk_f32_fp8((int)c.y, true);
                x0[0] = bflo(x.x) + (a0[0] + c0[0]) * is; x0[1] = bfhi(x.x) + (a0[1] + c0[1]) * is; x0[2] = bflo(x.y) + (a1[0] + c1[0]) * is; x0[3] = bfhi(x.y) + (a1[1] + c1[1]) * is;
                x1[0] = bflo(x.z) + (a2[0] + c2[0]) * is; x1[1] = bfhi(x.z) + (a2[1] + c2[1]) * is; x1[2] = bflo(x.w) + (a3[0] + c3[0]) * is; x1[3] = bfhi(x.w) + (a3[1] + c3[1]) * is;
                __builtin_nontemporal_store(x0, op + 128 * j); __builtin_nontemporal_store(x1, op + 128 * j + 1); } }
    }
#undef IN
#undef SEAM
}

extern "C" void kernel_launch(void* const* d_in, const int* in_sizes, int n_in, void* d_out, int out_size, void* d_ws, size_t ws_size, hipStream_t stream) {
    static int grid = 0;
    if (grid == 0) {
        if (n_in != 31 || out_size != T * D || ws_size < WS_END) { fprintf(stderr, "kernel_launch: unexpected shapes (n_in %d out %d ws %zu)\n", n_in, out_size, ws_size); grid = -1; return; }
        int dev = 0, cus = 0, per_cu = 0;
        if (hipGetDevice(&dev) != hipSuccess || hipDeviceGetAttribute(&cus, hipDeviceAttributeMultiprocessorCount, dev) != hipSuccess) { grid = -1; return; }
        if (hipFuncSetAttribute((const void*)hymba_fwd, hipFuncAttributeMaxDynamicSharedMemorySize, LDS_BYTES) != hipSuccess) { fprintf(stderr, "kernel_launch: hipFuncSetAttribute failed\n"); grid = -1; return; }
        if (hipOccupancyMaxActiveBlocksPerMultiprocessor(&per_cu, (const void*)hymba_fwd, 512, LDS_BYTES) != hipSuccess || per_cu < 1) fprintf(stderr, "kernel_launch: occupancy query reports %d\n", per_cu);
        (void)hipGetLastError();
        grid = cus;
    }
    if (grid < 0) return;
    (void)hipMemsetAsync((char*)d_ws + WS_CTL, 0, CTL_ZERO_BYTES, stream);
    Args a{};
    for (int i = 0; i < 31; ++i) a.in[i] = (const float*)d_in[i];
    a.out = (float*)d_out; a.ws = (unsigned char*)d_ws;
#if MK_PER_PHASE
    for (int p = 0; p < NPH; ++p) { const int reps = ((PROBE_REP_MASK >> p) & 1) ? 2 : 1;
        for (int q = 0; q < reps; ++q) { a.ph_lo = p; a.ph_hi = p + 1; hipLaunchKernelGGL(hymba_fwd, dim3(grid), dim3(512), LDS_BYTES, stream, a); } }
#else
    a.ph_lo = 0; a.ph_hi = NPH; hipLaunchKernelGGL(hymba_fwd, dim3(grid), dim3(512), LDS_BYTES, stream, a);
#endif
}
```

```cpp
#include <hip/hip_runtime.h>
#include <cstdio>
#include <cstdint>

#ifndef PROBE_REP_MASK
#define PROBE_REP_MASK 0
#endif
#ifndef PB0
#define PB0 40
#endif
#ifndef PB0_S5
#define PB0_S5 28
#endif
#ifndef PB0_D
#define PB0_D 0
#endif
#ifndef PB1
#define PB1 0
#endif
#ifndef PB2
#define PB2 0
#endif
#ifndef PB4
#define PB4 0
#endif
#ifndef PB5
#define PB5 0
#endif
#ifndef PB11
#define PB11 0
#endif
#ifndef MK_PER_PHASE
#define MK_PER_PHASE 0
#endif

#define GAS __attribute__((address_space(1)))
#define LAS __attribute__((address_space(3)))
typedef unsigned short bf16;
typedef unsigned v4u __attribute__((ext_vector_type(4)));
typedef unsigned v2u __attribute__((ext_vector_type(2)));
typedef float f32x4 __attribute__((ext_vector_type(4)));
typedef float f32x16 __attribute__((ext_vector_type(16)));
typedef short bf16x8 __attribute__((ext_vector_type(8)));
typedef short bf16x4 __attribute__((ext_vector_type(4)));
typedef int v8i __attribute__((ext_vector_type(8)));
typedef int v4i_ __attribute__((ext_vector_type(4)));

constexpr int T = 16384, D = 2048, SEQ = 2048, NB = 8, INC = 2304, MEML = 256;
constexpr int NPH = 13;
constexpr float EPS = 1e-6f;
constexpr int NEXP = 64, DEXP = 512, LCAP = 16384;
constexpr int S5L = 32, S5K = 640;

constexpr size_t MiB = 1u << 20;
constexpr size_t WS_CTL = 0, CTL_ZERO_BYTES = 1 * MiB;
constexpr size_t WS_WIN = 2 * MiB, WS_WO = 11 * MiB, WS_WMKV = 19 * MiB, WS_WGLU = 23 * MiB;
constexpr size_t WS_MQ = 24 * MiB, WS_SP = 44 * MiB, WS_UA = 52 * MiB, WS_SL = 72 * MiB, WS_AL = 88 * MiB, WS_WR = 89 * MiB;
constexpr size_t WS_XN = 96 * MiB;
constexpr size_t WS_MEMN = 160 * MiB, WS_MEMKV = 168 * MiB;
constexpr size_t WS_PROJ = 176 * MiB;
constexpr size_t WS_MIX = 248 * MiB;
constexpr size_t WS_Y2 = 176 * MiB;
constexpr size_t WS_G = 312 * MiB;
constexpr size_t WS_LOG = 328 * MiB;
constexpr size_t WS_LIST = 344 * MiB;
constexpr size_t WS_WTS = 348 * MiB;
constexpr size_t WS_LP = 352 * MiB;
constexpr size_t WS_PART = 376 * MiB;
constexpr size_t WS_RSTD = 379 * MiB;
constexpr size_t WS_HIST = 380 * MiB;
constexpr size_t WS_X18 = 384 * MiB;
constexpr size_t WS_SS = 382 * MiB;
constexpr size_t WS_TOKE = 381 * MiB;
constexpr size_t WS_ACT = 544 * MiB;
constexpr size_t WS_WGU = 592 * MiB;
constexpr size_t WS_WD = 848 * MiB;
constexpr size_t WS_END = 976 * MiB;
constexpr int CW_CNT = 1024;
constexpr int CW_BAR = 4096;
constexpr int CW_QGU = 2048, CW_QD = 2112;

constexpr int RING_BYTES = 131072;
constexpr int TAB_OFF = 139264;
constexpr int XBW_OFF = TAB_OFF + 2048;
constexpr int LDS_BYTES = 147456;

#define LDS_WAIT() asm volatile("s_waitcnt lgkmcnt(0)" ::: "memory")
#define VM_WAIT() asm volatile("s_waitcnt vmcnt(0)" ::: "memory")
__device__ __forceinline__ unsigned f2bf(float f) { unsigned u = __builtin_bit_cast(unsigned, f); return (u + 0x7fffu + ((u >> 16) & 1u)) >> 16; }
__device__ __forceinline__ unsigned pk2(float lo, float hi) { unsigned r; asm volatile("v_cvt_pk_bf16_f32 %0, %1, %2" : "=v"(r) : "v"(lo), "v"(hi)); return r; }
__device__ __forceinline__ float bflo(unsigned w) { return __builtin_bit_cast(float, w << 16); }
__device__ __forceinline__ float bfhi(unsigned w) { return __builtin_bit_cast(float, w & 0xffff0000u); }
__device__ __forceinline__ float wave_sum(float v) {
#pragma unroll
    for (int o = 1; o < 64; o <<= 1) v += __shfl_xor(v, o);
    return v;
}
constexpr float SC_X = 4.0f, SC_WGU = 32.0f, SC_ACT = 16.0f, SC_WD = 16.0f, SC_Y = 64.0f;
__device__ __forceinline__ float clamp8(float v) { return fminf(fmaxf(v, -448.0f), 448.0f); }
__device__ __forceinline__ unsigned pk4_fp8(float a, float b, float c, float d) { unsigned w = 0u; w = (unsigned)__builtin_amdgcn_cvt_pk_fp8_f32(clamp8(a), clamp8(b), (int)w, false); w = (unsigned)__builtin_amdgcn_cvt_pk_fp8_f32(clamp8(c), clamp8(d), (int)w, true); return w; }
__device__ __forceinline__ float fast_exp(float x) { return __builtin_amdgcn_exp2f(x * 1.44269504089f); }
__device__ __forceinline__ float sigmoidf_(float x) { return __builtin_amdgcn_rcpf(1.0f + fast_exp(-x)); }
__device__ __forceinline__ float gelu_tanh(float x) { const float z = 1.5957691216f * (x + 0.044715f * x * x * x); return x * sigmoidf_(z); }

#define XB_TMO      128
#define XB_XCNT(j)  (256  + 64 * (j))
#define XB_XSUB(j)  (1280 + 64 * (j))
#define XB_XGEN(j)  (2304 + 64 * (j))
#define XB_TOP      3328
#define XB_TOPGEN   3392
#define XCD_BAR_WORDS 3456
#define XB_SPIN_CAP (1u << 18)
__device__ __forceinline__ unsigned xb_ld(unsigned* p)              { return __hip_atomic_load(p, __ATOMIC_RELAXED, __HIP_MEMORY_SCOPE_AGENT); }
__device__ __forceinline__ unsigned xb_add(unsigned* p, unsigned v) { return __hip_atomic_fetch_add(p, v, __ATOMIC_RELAXED, __HIP_MEMORY_SCOPE_AGENT); }
__device__ __forceinline__ unsigned xb_xcc_id() { return (unsigned)__builtin_amdgcn_s_getreg((3 << 11) | 20) & 0xFu; }
#define XB_SPIN(cond, bar) do { unsigned _sp = 0; while (cond) { __builtin_amdgcn_s_sleep(1); \
    if ((++_sp & 255u) == 0u) { if (xb_ld(&(bar)[XB_TMO])) break; if (_sp > XB_SPIN_CAP) { atomicAdd(&(bar)[XB_TMO], 1u); break; } } } } while (0)
struct XcdBarrier { unsigned* bar; unsigned x; volatile LAS unsigned* st; };
__device__ __forceinline__ XcdBarrier xcd_barrier_post(unsigned* bar, volatile LAS unsigned* st) {
    XcdBarrier b; b.bar = bar; b.x = xb_xcc_id(); b.st = st;
    if (threadIdx.x == 0) (void)xb_add(&bar[XB_XCNT(b.x)], 1u);
    return b;
}
__device__ __forceinline__ void xcd_barrier_complete(unsigned* bar, unsigned x, unsigned& nloc, unsigned& nx) {
    const unsigned G = gridDim.x * gridDim.y * gridDim.z;
    unsigned sum, cnt, mine, sp = 0u;
    for (;;) {
        sum = 0u; cnt = 0u; mine = 0u;
#pragma unroll
        for (unsigned j = 0; j < 16; ++j) { const unsigned c = xb_ld(&bar[XB_XCNT(j)]); sum += c; cnt += (c > 0u) ? 1u : 0u; mine = (j == x) ? c : mine; }
        if (sum == G) break;
        __builtin_amdgcn_s_sleep(1);
        if ((++sp & 255u) == 0u) { if (xb_ld(&bar[XB_TMO])) break; if (sp > XB_SPIN_CAP) { atomicAdd(&bar[XB_TMO], 1u); break; } }
    }
    nloc = mine > 0u ? mine : 1u; nx = cnt > 0u ? cnt : 1u;
}
__device__ __forceinline__ void xcd_barrier(const XcdBarrier& b) {
    asm volatile("s_waitcnt vmcnt(0)" ::: "memory");
    __syncthreads();
    if (threadIdx.x == 0) {
        unsigned* bar = b.bar;
        __builtin_amdgcn_s_waitcnt(0);
        unsigned nloc = b.st[0], nx = b.st[1];
        if (nloc == 0u) { xcd_barrier_complete(bar, b.x, nloc, nx); b.st[0] = nloc; b.st[1] = nx; }
        const unsigned old = xb_add(&bar[XB_XSUB(b.x)], 1u);
        const unsigned gen = old / nloc;
        if (old + 1u == (gen + 1u) * nloc) {
            __builtin_amdgcn_fence(__ATOMIC_RELEASE, "agent");
            asm volatile("s_waitcnt vmcnt(0)" ::: "memory");
            const unsigned og = xb_add(&bar[XB_TOP], 1u);
            const unsigned tg = og / nx;
            if (og + 1u == (tg + 1u) * nx) xb_add(&bar[XB_TOPGEN], 1u);
            else XB_SPIN(xb_ld(&bar[XB_TOPGEN]) == tg, bar);
            __builtin_amdgcn_fence(__ATOMIC_ACQUIRE, "agent");
            xb_add(&bar[XB_XGEN(b.x)], 1u);
            asm volatile("s_waitcnt vmcnt(0)" ::: "memory");
        } else {
            XB_SPIN(xb_ld(&bar[XB_XGEN(b.x)]) == gen, bar);
            __builtin_amdgcn_fence(__ATOMIC_ACQUIRE, "agent");
            asm volatile("s_waitcnt vmcnt(0)" ::: "memory");
        }
    }
    __syncthreads();
}

__device__ __forceinline__ int lane_now() { int l = (int)__builtin_amdgcn_mbcnt_hi(~0u, __builtin_amdgcn_mbcnt_lo(~0u, 0u)); asm volatile("" : "+v"(l)); return l; }
namespace pg8 {
constexpr int BM = 256, BK = 64, HALF = 128, HTB = HALF * BK * 2, STAGE_BYTES = 8 * HTB, NXCD = 8, WGM = 8;
__host__ __device__ __forceinline__ int lds_byte(int r, int c) { const int st = (r >> 4) * 2 + (c >> 5), rr = r & 15, cc = c & 31, ob = rr * 64 + cc * 2; return st * 1024 + (ob ^ (((ob >> 9) & 1) << 5)); }
__host__ __device__ __forceinline__ void stage_rc(int b, int& R, int& C) { const int st = b / 1024, sb = b % 1024, swz = sb ^ (((sb >> 9) & 1) << 5); R = (st >> 1) * 16 + swz / 64; C = (st & 1) * 32 + (swz % 64) / 2; }
__host__ __device__ __forceinline__ int perm32(int rho) { const int n = rho >> 4, i = rho & 15; return 8 * (i >> 2) + 4 * n + (i & 3); }

struct Unit { const char* a; const char* b; int r0, c0, aux, r1; };
struct Gemm { int lda, ldb, K; };

struct DenseOrder {
    const char* A; const char* Bt; int lda, ldb, nM, nN, nwg, G, c;
    __device__ void init(const void* A_, const void* Bt_, int lda_, int ldb_, int M, int N, int G_, int c_) { A = (const char*)A_; Bt = (const char*)Bt_; lda = lda_; ldb = ldb_; nM = M / BM; nN = N / BM; nwg = nM * nN; G = G_; c = c_; }
    __device__ bool next(int i, Unit& u) const {
        const long L = (long)i * G + c; if (L >= nwg) return false;
        int wgid = (int)L; { const int q = nwg / NXCD, r = nwg % NXCD, xcd = wgid % NXCD, off = wgid / NXCD; wgid = (xcd < r ? xcd * (q + 1) : r * (q + 1) + (xcd - r) * q) + off; }
        const int nig = WGM * nN, gid = wgid / nig, fm = gid * WGM, gsz = (nM - fm) < WGM ? (nM - fm) : WGM;
        const int pm = fm + ((wgid % nig) % gsz), pn = (wgid % nig) / gsz;
        u.a = A + (size_t)pm * BM * lda * 2; u.b = Bt + (size_t)pn * BM * ldb * 2; u.r0 = pm * BM; u.c0 = pn * BM; u.aux = 0; u.r1 = 0; return true;
    }
    __device__ __forceinline__ unsigned arow(const Unit&, int) const { return 0u; }
};
struct GroupOrder {
    const char* A; const char* Bt; int lda, ldb, nN, ngrp, G, c;
    __device__ bool next(int i, Unit& u) const {
        const int L = i * G + c; if (L >= ngrp * 2 * nN) return false;
        const int g = L / (2 * nN), q = L % (2 * nN), pn = q >> 1, pm = q & 1;
        u.a = A + ((size_t)g * 512 + pm * BM) * lda * 2; u.b = Bt + ((size_t)g * nN + pn) * BM * ldb * 2; u.r0 = pm * BM; u.c0 = pn * BM; u.aux = g; u.r1 = 0; return true;
    }
    __device__ __forceinline__ unsigned arow(const Unit&, int) const { return 0u; }
};
struct MoeOrder {
    const char* A; const char* Bt; const LAS int* cnt; const LAS int* ts; const int* list; int lda, ldb, nct, brows, G, c; bool gather;
    __device__ bool next(int i, Unit& u) const {
        const int L = i * G + c; const int lane = lane_now();
        int i64 = 64; asm volatile("" : "+v"(i64));
        if (L >= __builtin_amdgcn_readfirstlane(ts[i64]) * nct) return false;
        const int lo = ts[lane] * nct, hi = ts[lane + 1] * nct;
        const unsigned long long m = __ballot(lo <= L && L < hi);
        const int e = __builtin_amdgcn_readfirstlane((int)__builtin_ctzll(m));
        const int tse = ts[e], ne = ts[e + 1] - tse, q = L - tse * nct, ct = q / ne, rt = q % ne;
        u.a = gather ? A : A + (size_t)(tse + rt) * BM * lda * 2; u.b = Bt + ((size_t)e * brows + (size_t)ct * BM) * ldb * 2;
        u.r0 = (tse + rt) * BM; u.r1 = rt * BM; u.c0 = ct; u.aux = e; return true;
    }
    __device__ __forceinline__ unsigned arow(const Unit& u, int r) const {
        const int n = cnt[u.aux]; int rr = u.r1 + r; rr = rr < n ? rr : n - 1;
        return (unsigned)(list[(size_t)u.aux * LCAP + rr] >> 1) * (unsigned)(lda * 2);
    }
};

#define EPI_ROWS_COLS() const int rowb = wr * 64 + fr; (void)rowb;

template <class Epi, class Sched, bool GATHER = false, bool FP8 = false, bool KSEG = false>
__device__ __forceinline__ void gemm_phase(LAS unsigned char* lds, const Gemm g, const Sched& S, const Epi& E, const int wave_id, const float* ssq = nullptr) {
    int lane = (int)__builtin_amdgcn_mbcnt_hi(~0u, __builtin_amdgcn_mbcnt_lo(~0u, 0u)); asm volatile("" : "+v"(lane));
    const int wid = wave_id, tid = wid * 64 + lane, wr = wid >> 2, wc = wid & 3, fr = lane & 15, fq = lane >> 4;
    const int K = g.K; int nt = K / BK; asm volatile("" : "+s"(nt));
    unsigned voffB;
    { int R, C; stage_rc(tid * 16, R, C); const int Rb = Epi::PERM ? ((R & ~31) + perm32(R & 31)) : R; voffB = (unsigned)(Rb * g.ldb + C) * 2u; }
    const int soffB = 64 * g.ldb * 2, soffA = 64 * g.lda * 2;
#define PG8_RC(i, R, C) int R, C; { int _t = tid; asm volatile("" : "+v"(_t)); stage_rc(_t * 16 + (i) * 8192, R, C); }
#define nxoff ((LAS v4u*)(lds + 131072) + (wid * 64 + lane_now()))
    const size_t kstep = (size_t)(BK * 2);
    const size_t hstepB = (size_t)HALF * g.ldb * 2;
    const unsigned ldsw = (unsigned)wid * 1024u;
    const int aoff = lds_byte(wr * 64 + fr, fq * 8), boff = lds_byte(wc * 32 + fr, fq * 8);
#define PG8_SA(b, h) (((b) * 2 + (h)) * HTB)
#define PG8_SB(b, h) ((4 + (b) * 2 + (h)) * HTB)
#define PG8_RSRC(p) __builtin_amdgcn_make_buffer_rsrc((void*)(p), 0, 0xffffffff, 0x00020000)
#define PG8_STAGE(bufoff, gbase, voff) do { const __amdgpu_buffer_rsrc_t _r = PG8_RSRC(gbase); \
        __builtin_amdgcn_raw_ptr_buffer_load_lds(_r, (LAS void*)(lds + (bufoff) + ldsw), 16, (int)(voff), 0, 0, 0); \
        __builtin_amdgcn_raw_ptr_buffer_load_lds(_r, (LAS void*)(lds + (bufoff) + ldsw + 8192), 16, (int)(voff), soffB, 0, 0); } while (0)
#define PG8_STAGEA(bufoff, gbase, o0, o1, h) do { const __amdgpu_buffer_rsrc_t _r = PG8_RSRC(gbase); \
        if constexpr (GATHER) { __builtin_amdgcn_raw_ptr_buffer_load_lds(_r, (LAS void*)(lds + (bufoff) + ldsw), 16, (int)(o0), 0, 0, 0); \
                                __builtin_amdgcn_raw_ptr_buffer_load_lds(_r, (LAS void*)(lds + (bufoff) + ldsw + 8192), 16, (int)(o1), 0, 0, 0); } \
        else { __builtin_amdgcn_raw_ptr_buffer_load_lds(_r, (LAS void*)(lds + (bufoff) + ldsw), 16, (int)c00, (h) * 2 * soffA, 0, 0); \
               __builtin_amdgcn_raw_ptr_buffer_load_lds(_r, (LAS void*)(lds + (bufoff) + ldsw + 8192), 16, (int)c00, (h) * 2 * soffA + soffA, 0, 0); } } while (0)
#define PG8_LDA(dst, b, h) do { _Pragma("unroll") for (int m = 0; m < 4; ++m) { \
        if constexpr (FP8) { dst##8[m].lo = *(const LAS v4i_*)(lds + PG8_SA(b, h) + aoff + m * 2048); dst##8[m].hi = *(const LAS v4i_*)(lds + PG8_SA(b, h) + aoff + m * 2048 + 1024); } \
        else { _Pragma("unroll") for (int k = 0; k < 2; ++k) dst[m][k] = *(const LAS bf16x8*)(lds + PG8_SA(b, h) + aoff + m * 2048 + k * 1024); } } } while (0)
#define PG8_LDB(dst, b, h) do { _Pragma("unroll") for (int n = 0; n < 2; ++n) { \
        if constexpr (FP8) { dst##8[n].lo = *(const LAS v4i_*)(lds + PG8_SB(b, h) + boff + n * 2048); dst##8[n].hi = *(const LAS v4i_*)(lds + PG8_SB(b, h) + boff + n * 2048 + 1024); } \
        else { _Pragma("unroll") for (int k = 0; k < 2; ++k) dst[n][k] = *(const LAS bf16x8*)(lds + PG8_SB(b, h) + boff + n * 2048 + k * 1024); } } } while (0)
#define PG8_MMA(ai, bj, At, Bt) do { __builtin_amdgcn_s_setprio(1); _Pragma("unroll") for (int m = 0; m < 4; ++m) _Pragma("unroll") for (int n = 0; n < 2; ++n) { \
        if constexpr (FP8) { acc[ai][bj][m][n] = __builtin_amdgcn_mfma_scale_f32_16x16x128_f8f6f4(Bt##8[n], At##8[m], acc[ai][bj][m][n], 0, 0, 0, 0x7f7f7f7f, 0, 0x7f7f7f7f); } \
        else { _Pragma("unroll") for (int k = 0; k < 2; ++k) acc[ai][bj][m][n] = __builtin_amdgcn_mfma_f32_16x16x32_bf16(Bt[n][k], At[m][k], acc[ai][bj][m][n], 0, 0, 0); } } \
        __builtin_amdgcn_s_setprio(0); } while (0)
#define PG8_WAIT_V(n) asm volatile("s_waitcnt vmcnt(" #n ")" ::: "memory")
#define PG8_WAIT_L(n) asm volatile("s_waitcnt lgkmcnt(" #n ")" ::: "memory")
#define PG8_BAR __builtin_amdgcn_s_barrier()
#define PG8_SCHED __builtin_amdgcn_sched_barrier(0)
    LAS f32x4* scl = (LAS f32x4*)(lds + 131072);
#define PG8_FILL_SCL(u) do { if constexpr (KSEG) { if (tid < 256) { const f32x4* sp = (const f32x4*)(ssq + (size_t)((u).r0 + tid) * 32); \
        const f32x4 p0 = sp[0], p1 = sp[1], p2 = sp[2], p3 = sp[3], p4 = sp[4], p5 = sp[5], p6 = sp[6]; \
        const float sa = (((p0[0] + p0[1]) + (p0[2] + p0[3])) + ((p1[0] + p1[1]) + (p1[2] + p1[3]))) + (((p2[0] + p2[1]) + (p2[2] + p2[3])) + ((p3[0] + p3[1]) + (p3[2] + p3[3]))); \
        const float sb = ((p4[0] + p4[1]) + (p4[2] + p4[3])) + ((p5[0] + p5[1]) + (p5[2] + p5[3])), sc = (p6[0] + p6[1]) + (p6[2] + p6[3]); \
        const float ra = 1.0f / sqrtf(sa * (1.f / 1024.f) + EPS), rb = 1.0f / sqrtf(sb * (1.f / 512.f) + EPS), rc = 1.0f / sqrtf(sc * (1.f / 512.f) + EPS); \
        scl[(ui & 1) * 256 + tid] = (f32x4){ra / rb, rb / rc, rc, 0.f}; } } } while (0)
#define PG8_SCALE(k) do { _Pragma("unroll") for (int _ai = 0; _ai < 2; ++_ai) _Pragma("unroll") for (int _m = 0; _m < 4; ++_m) { const float _f = ((const LAS float*)scl)[((ui & 1) * 256 + _ai * HALF + wr * 64 + _m * 16 + fr) * 4 + (k)]; \
        _Pragma("unroll") for (int _bj = 0; _bj < 2; ++_bj) _Pragma("unroll") for (int _n = 0; _n < 2; ++_n) acc[_ai][_bj][_m][_n] = acc[_ai][_bj][_m][_n] * _f; } } while (0)
    Unit cur, nxt; int ui = 0;
    if (!S.next(0, cur)) return;
    PG8_FILL_SCL(cur);
    f32x4 acc[2][2][4][2];
#pragma unroll
    for (int a = 0; a < 2; ++a)
#pragma unroll
        for (int b = 0; b < 2; ++b)
#pragma unroll
            for (int m = 0; m < 4; ++m)
#pragma unroll
                for (int n = 0; n < 2; ++n) acc[a][b][m][n] = (f32x4){0.f, 0.f, 0.f, 0.f};
    bf16x8 At[4][2], B0[2][2], B1[2][2]; v8i At8[4], B08[2], B18[2];
    const char* cA = cur.a; const char* cB = cur.b;
    unsigned c00, c01, c10, c11;
    { PG8_RC(0, R0, C0); PG8_RC(1, R1, C1);
      if constexpr (GATHER) {
        c00 = S.arow(cur, R0) + C0 * 2u; c01 = S.arow(cur, R1) + C1 * 2u; c10 = S.arow(cur, HALF + R0) + C0 * 2u; c11 = S.arow(cur, HALF + R1) + C1 * 2u;
        asm volatile("s_waitcnt vmcnt(0)" : "+v"(c00), "+v"(c01), "+v"(c10), "+v"(c11) :: "memory");
      } else {
        c00 = (unsigned)(R0 * g.lda + C0) * 2u; c01 = c00; c10 = c00; c11 = c00; (void)R1; (void)C1;
      } }
    PG8_STAGE(PG8_SB(0, 0), cB, voffB); PG8_STAGE(PG8_SB(0, 1), cB + hstepB, voffB); PG8_STAGEA(PG8_SA(0, 0), cA, c00, c01, 0); PG8_STAGEA(PG8_SA(0, 1), cA, c10, c11, 1);
    if (wr == 1) PG8_BAR;
    PG8_WAIT_V(2); PG8_BAR;
    PG8_STAGE(PG8_SB(1, 0), cB + kstep, voffB); PG8_STAGEA(PG8_SA(1, 0), cA + kstep, c00, c01, 0); PG8_STAGE(PG8_SB(1, 1), cB + hstepB + kstep, voffB);
    PG8_WAIT_V(6); PG8_BAR;
#define PG8_KITER(t) do { \
            const bool last = (t == nt - 2); \
            const char* a1 = cA + (size_t)(t + 1) * kstep; \
            const char* a2 = last ? nA : cA + (size_t)(t + 2) * kstep; const char* b2 = last ? nB : cB + (size_t)(t + 2) * kstep; \
            const char* a3 = a2 + kstep; const char* b3 = b2 + kstep; \
            unsigned x00 = c00, x01 = c01, x10 = c10, x11 = c11; \
            if constexpr (GATHER) { if (last) { const v4u nv = *nxoff; x00 = nv.x; x01 = nv.y; x10 = nv.z; x11 = nv.w; } } \
 \
            PG8_LDB(B0, 0, 0); PG8_LDB(B1, 0, 1); PG8_SCHED; PG8_LDA(At, 0, 0); PG8_STAGEA(PG8_SA(1, 1), a1, c10, c11, 1); \
            PG8_WAIT_V(8); PG8_WAIT_L(0); PG8_BAR; PG8_MMA(0, 0, At, B0); PG8_MMA(0, 1, At, B1); PG8_BAR; PG8_SCHED; \
 \
            PG8_LDA(At, 0, 1); PG8_STAGE(PG8_SB(0, 0), b2, voffB); PG8_STAGE(PG8_SB(0, 1), b2 + hstepB, voffB); PG8_STAGEA(PG8_SA(0, 0), a2, x00, x01, 0); \
            PG8_WAIT_V(8); PG8_WAIT_L(0); PG8_BAR; PG8_MMA(1, 0, At, B0); PG8_MMA(1, 1, At, B1); PG8_BAR; PG8_SCHED; \
 \
            PG8_LDB(B0, 1, 0); PG8_LDB(B1, 1, 1); PG8_SCHED; PG8_LDA(At, 1, 0); PG8_STAGEA(PG8_SA(0, 1), a2, x10, x11, 1); \
            PG8_WAIT_V(8); PG8_WAIT_L(0); PG8_BAR; PG8_MMA(0, 0, At, B0); PG8_MMA(0, 1, At, B1); PG8_BAR; PG8_SCHED; \
 \
            PG8_LDA(At, 1, 1); PG8_STAGE(PG8_SB(1, 0), b3, voffB); PG8_STAGE(PG8_SB(1, 1), b3 + hstepB, voffB); PG8_STAGEA(PG8_SA(1, 0), a3, x00, x01, 0); \
            PG8_WAIT_V(8); PG8_WAIT_L(0); PG8_BAR; PG8_MMA(1, 0, At, B0); PG8_MMA(1, 1, At, B1); PG8_BAR; PG8_SCHED; \
        } while (0)
    for (;;) {
        const bool has_next = S.next(ui + 1, nxt);
        const char* nA = has_next ? nxt.a : cA; const char* nB = has_next ? nxt.b : cB;
        if constexpr (GATHER) {
            unsigned n00 = c00, n01 = c01, n10 = c10, n11 = c11;
            if (has_next) { PG8_RC(0, R0, C0); PG8_RC(1, R1, C1); n00 = S.arow(nxt, R0) + C0 * 2u; n01 = S.arow(nxt, R1) + C1 * 2u; n10 = S.arow(nxt, HALF + R0) + C0 * 2u; n11 = S.arow(nxt, HALF + R1) + C1 * 2u; }
            asm volatile("s_waitcnt vmcnt(0)" : "+v"(n00), "+v"(n01), "+v"(n10), "+v"(n11) :: "memory");
            v4u nv; nv.x = n00; nv.y = n01; nv.z = n10; nv.w = n11; *nxoff = nv;
        }
        if constexpr (KSEG) {
#pragma unroll 1
            for (int t = 0; t < 16; t += 2) PG8_KITER(t);
            PG8_SCALE(0);
#pragma unroll 1
            for (int t = 16; t < 24; t += 2) PG8_KITER(t);
            PG8_SCALE(1);
#pragma unroll 1
            for (int t = 24; t < nt; t += 2) PG8_KITER(t);
        } else {
#pragma unroll 1
            for (int t = 0; t < nt; t += 2) PG8_KITER(t);
        }
        if (wr == 0) PG8_BAR;
        if constexpr (KSEG) PG8_SCALE(2);
        { const int le = lane_now(); E(acc, cur, wr, wc, le & 15, le >> 4); }
        if (!has_next) break;
#pragma unroll
        for (int a = 0; a < 2; ++a)
#pragma unroll
            for (int b = 0; b < 2; ++b)
#pragma unroll
                for (int m = 0; m < 4; ++m)
#pragma unroll
                    for (int n = 0; n < 2; ++n) acc[a][b][m][n] = (f32x4){0.f, 0.f, 0.f, 0.f};
        cur = nxt; cA = nA; cB = nB; ++ui;
        if constexpr (KSEG) { PG8_WAIT_L(0); PG8_FILL_SCL(cur); }
        if constexpr (GATHER) { const v4u nv = *nxoff; c00 = nv.x; c01 = nv.y; c10 = nv.z; c11 = nv.w; }
        if (wr == 1) PG8_BAR;
    }
    PG8_WAIT_V(0);
    PG8_BAR;
#undef PG8_RC
#undef PG8_KITER
#undef PG8_FILL_SCL
#undef PG8_SCALE
#undef nxoff
#undef PG8_SA
#undef PG8_SB
#undef PG8_STAGE
#undef PG8_STAGEA
#undef PG8_LDA
#undef PG8_LDB
#undef PG8_MMA
#undef PG8_WAIT_V
#undef PG8_WAIT_L
#undef PG8_BAR
#undef PG8_SCHED
}

typedef const f32x4 (&AccRef)[2][2][4][2];
__device__ __forceinline__ v4u pack8(const f32x4 a, const f32x4 b) { v4u w; w.x = pk2(a[0], a[1]); w.y = pk2(a[2], a[3]); w.z = pk2(b[0], b[1]); w.w = pk2(b[2], b[3]); return w; }

struct EpiProj {
    static constexpr bool PERM = true;
    bf16* PROJ; bf16* UA;
    __device__ __forceinline__ void operator()(AccRef acc, const Unit& u, int wr, int wc, int fr, int fq) const {
        const int row0 = u.r0 + wr * 64 + fr, colb = u.c0 + wc * 32 + 8 * fq;
        const bool isu = (u.c0 == 1280 || u.c0 == 1536);
#pragma unroll
        for (int ai = 0; ai < 2; ++ai)
#pragma unroll
            for (int m = 0; m < 4; ++m) { const int row = row0 + ai * HALF + m * 16;
#pragma unroll
                for (int bj = 0; bj < 2; ++bj) { const int col = colb + bj * HALF; const v4u w = pack8(acc[ai][bj][m][0], acc[ai][bj][m][1]);
                    if (!isu) *(v4u*)(PROJ + (size_t)row * INC + col) = w;
                    else { const int cc = col - 1280, g = cc >> 4, c0 = cc & 15; *(v4u*)(UA + ((size_t)(g * 512 + (row >> 5)) * S5K + (row & 31) * 16 + c0)) = w; } } }
    }
};
struct EpiBf16 {
    static constexpr bool PERM = true;
    bf16* O; int ldc;
    __device__ __forceinline__ void operator()(AccRef acc, const Unit& u, int wr, int wc, int fr, int fq) const {
        const int row0 = u.r0 + wr * 64 + fr, colb = u.c0 + wc * 32 + 8 * fq;
#pragma unroll
        for (int ai = 0; ai < 2; ++ai)
#pragma unroll
            for (int m = 0; m < 4; ++m) { bf16* rowp = O + (size_t)(row0 + ai * HALF + m * 16) * ldc + colb;
#pragma unroll
                for (int bj = 0; bj < 2; ++bj) *(v4u*)(rowp + bj * HALF) = pack8(acc[ai][bj][m][0], acc[ai][bj][m][1]); }
    }
};
struct EpiF32 {
    static constexpr bool PERM = false;
    float* C; int ldc; size_t gstride;
    __device__ __forceinline__ void operator()(AccRef acc, const Unit& u, int wr, int wc, int fr, int fq) const {
        const int row0 = u.r0 + wr * 64 + fr, col0 = u.c0 + wc * 32 + 4 * fq; float* base = C + (size_t)u.aux * gstride;
#pragma unroll
        for (int ai = 0; ai < 2; ++ai)
#pragma unroll
            for (int m = 0; m < 4; ++m) { float* rowp = base + (size_t)(row0 + ai * HALF + m * 16) * ldc + col0;
#pragma unroll
                for (int bj = 0; bj < 2; ++bj)
#pragma unroll
                    for (int n = 0; n < 2; ++n) *(f32x4*)(rowp + bj * HALF + n * 16) = acc[ai][bj][m][n]; }
    }
};
struct EpiS5Y {
    static constexpr bool PERM = true;
    const bf16* UA; const float* dsk; bf16* Gm;
    __device__ __forceinline__ void operator()(AccRef acc, const Unit& u, int wr, int wc, int fr, int fq) const {
        const int row0 = u.r0 + wr * 64 + fr, colb = u.c0 + wc * 32 + 8 * fq, g = u.aux;
#pragma unroll
        for (int ai = 0; ai < 2; ++ai)
#pragma unroll
            for (int m = 0; m < 4; ++m) { const int row = row0 + ai * HALF + m * 16;
#pragma unroll
                for (int bj = 0; bj < 2; ++bj) { const int col = colb + bj * HALF, i = col >> 4, c0 = col & 15;
                    const v4u uw = *(const v4u*)(UA + ((size_t)(g * 512 + row) * S5K + col));
                    const f32x4 d0 = *(const f32x4*)(dsk + g * 16 + c0), d1 = *(const f32x4*)(dsk + g * 16 + c0 + 4);
                    const f32x4 a0 = acc[ai][bj][m][0], a1 = acc[ai][bj][m][1];
                    f32x4 y0, y1;
                    y0[0] = gelu_tanh(a0[0] + d0[0] * bflo(uw.x)); y0[1] = gelu_tanh(a0[1] + d0[1] * bfhi(uw.x)); y0[2] = gelu_tanh(a0[2] + d0[2] * bflo(uw.y)); y0[3] = gelu_tanh(a0[3] + d0[3] * bfhi(uw.y));
                    y1[0] = gelu_tanh(a1[0] + d1[0] * bflo(uw.z)); y1[1] = gelu_tanh(a1[1] + d1[1] * bfhi(uw.z)); y1[2] = gelu_tanh(a1[2] + d1[2] * bflo(uw.w)); y1[3] = gelu_tanh(a1[3] + d1[3] * bfhi(uw.w));
                    *(v4u*)(Gm + ((size_t)row * 32 + i) * 512 + g * 16 + c0) = pack8(y0, y1); } }
    }
};
struct EpiGlu {
    static constexpr bool PERM = true;
    const bf16* Gm; bf16* MIX; float* SS;
    __device__ __forceinline__ void operator()(AccRef acc, const Unit& u, int wr, int wc, int fr, int fq) const {
        const int row0 = u.r0 + wr * 64 + fr, colb = u.c0 + wc * 32 + 8 * fq;
#pragma unroll
        for (int ai = 0; ai < 2; ++ai)
#pragma unroll
            for (int m = 0; m < 4; ++m) { const int row = row0 + ai * HALF + m * 16; float ss = 0.f;
#pragma unroll
                for (int bj = 0; bj < 2; ++bj) { const int col = colb + bj * HALF;
                    const v4u gw = *(const v4u*)(Gm + (size_t)row * 512 + col);
                    const f32x4 a0 = acc[ai][bj][m][0], a1 = acc[ai][bj][m][1];
                    f32x4 y0, y1;
                    y0[0] = bflo(gw.x) * sigmoidf_(a0[0]); y0[1] = bfhi(gw.x) * sigmoidf_(a0[1]); y0[2] = bflo(gw.y) * sigmoidf_(a0[2]); y0[3] = bfhi(gw.y) * sigmoidf_(a0[3]);
                    y1[0] = bflo(gw.z) * sigmoidf_(a1[0]); y1[1] = bfhi(gw.z) * sigmoidf_(a1[1]); y1[2] = bflo(gw.w) * sigmoidf_(a1[2]); y1[3] = bfhi(gw.w) * sigmoidf_(a1[3]);
                    ss += ((y0[0] * y0[0] + y0[1] * y0[1]) + (y0[2] * y0[2] + y0[3] * y0[3])) + ((y1[0] * y1[0] + y1[1] * y1[1]) + (y1[2] * y1[2] + y1[3] * y1[3]));
                    *(v4u*)(MIX + (size_t)row * D + 1024 + col) = pack8(y0, y1); }
                ss += __shfl_xor(ss, 16); ss += __shfl_xor(ss, 32);
                if (fq == 0) SS[(size_t)row * 32 + 16 + (u.c0 >> 8) * 4 + wc] = ss; }
    }
};
struct EpiWo {
    static constexpr bool PERM = true;
    const float* X; bf16* X1B; unsigned char* X18; float* part;
    __device__ __forceinline__ void operator()(AccRef acc, const Unit& u, int wr, int wc, int fr, int fq) const {
        const int row0 = u.r0 + wr * 64 + fr, col0 = u.c0 + wc * 32 + 8 * fq;
#pragma unroll
        for (int ai = 0; ai < 2; ++ai)
#pragma unroll
          for (int mh = 0; mh < 2; ++mh) {
            f32x4 xv[2][2][2];
#pragma unroll
            for (int m = 0; m < 2; ++m)
#pragma unroll
                for (int bj = 0; bj < 2; ++bj)
#pragma unroll
                    for (int n = 0; n < 2; ++n) xv[m][bj][n] = __builtin_nontemporal_load((const f32x4*)(X + (size_t)(row0 + ai * HALF + (mh * 2 + m) * 16) * D + col0 + bj * HALF + n * 4));
#pragma unroll
            for (int m2 = 0; m2 < 2; ++m2) { const int m = mh * 2 + m2; const int row = row0 + ai * HALF + m * 16; const size_t off = (size_t)row * D + col0; float ss = 0.f;
#pragma unroll
                for (int bj = 0; bj < 2; ++bj) { const f32x4 v0 = xv[m2][bj][0] + acc[ai][bj][m][0], v1 = xv[m2][bj][1] + acc[ai][bj][m][1];
                    ss += ((v0[0] * v0[0] + v0[1] * v0[1]) + (v0[2] * v0[2] + v0[3] * v0[3])) + ((v1[0] * v1[0] + v1[1] * v1[1]) + (v1[2] * v1[2] + v1[3] * v1[3]));
                    *(v4u*)(X1B + off + bj * HALF) = pack8(v0, v1);
                    v2u w8; w8.x = pk4_fp8(v0[0] * SC_X, v0[1] * SC_X, v0[2] * SC_X, v0[3] * SC_X); w8.y = pk4_fp8(v1[0] * SC_X, v1[1] * SC_X, v1[2] * SC_X, v1[3] * SC_X);
                    *(v2u*)(X18 + off + bj * HALF) = w8; }
                ss += __shfl_xor(ss, 16); ss += __shfl_xor(ss, 32);
                if (fq == 0) part[(size_t)row * 32 + (u.c0 >> 8) * 4 + wc] = ss; }
            asm volatile("" ::: "memory");
          }
    }
};
struct EpiLogit {
    static constexpr bool PERM = false;
    float* LP;
    __device__ __forceinline__ void operator()(AccRef acc, const Unit& u, int wr, int wc, int fr, int fq) const {
        const int row0 = u.r0 + wr * 64 + fr, col0 = wc * 32 + 4 * fq; float* base = LP + (size_t)u.aux * T * 80;
#pragma unroll
        for (int ai = 0; ai < 2; ++ai)
#pragma unroll
            for (int m = 0; m < 4; ++m) { float* rowp = base + (size_t)(row0 + ai * HALF + m * 16) * 80 + col0;
#pragma unroll
                for (int n = 0; n < 2; ++n) if (col0 + n * 16 < 80) *(f32x4*)(rowp + n * 16) = acc[ai][0][m][n]; }
    }
};
struct EpiGU {
    static constexpr bool PERM = true;
    const int* list; const float* rstd; const LAS int* cnt; unsigned char* ACT;
    __device__ __forceinline__ void operator()(AccRef acc, const Unit& u, int wr, int wc, int fr, int fq) const {
        const int e = u.aux, nreal = cnt[e], rb = wr * 64 + fr, colb = u.c0 * 128 + wc * 32 + 8 * fq;
#pragma unroll
        for (int ai = 0; ai < 2; ++ai)
#pragma unroll
            for (int m = 0; m < 4; ++m) { const int r = rb + ai * HALF + m * 16; int rr = u.r1 + r; rr = rr < nreal ? rr : nreal - 1;
                const float rs = rstd[list[(size_t)e * LCAP + rr] >> 1] * (1.0f / (SC_X * SC_WGU));
                f32x4 y0, y1;
#pragma unroll
                for (int j = 0; j < 4; ++j) { const float g0 = acc[ai][0][m][0][j] * rs, g1 = acc[ai][0][m][1][j] * rs;
                    y0[j] = g0 * sigmoidf_(g0) * (acc[ai][1][m][0][j] * rs) * SC_ACT; y1[j] = g1 * sigmoidf_(g1) * (acc[ai][1][m][1][j] * rs) * SC_ACT; }
                v2u w8; w8.x = pk4_fp8(y0[0], y0[1], y0[2], y0[3]); w8.y = pk4_fp8(y1[0], y1[1], y1[2], y1[3]);
                *(v2u*)(ACT + (size_t)(u.r0 + r) * DEXP + colb) = w8; }
    }
};
struct EpiDown {
    static constexpr bool PERM = true;
    const int* list; const float* wts; const LAS int* cnt; unsigned char* Y2;
    __device__ __forceinline__ void operator()(AccRef acc, const Unit& u, int wr, int wc, int fr, int fq) const {
        const int e = u.aux, n = cnt[e], row0 = u.r1 + wr * 64 + fr, colb = u.c0 * 256 + wc * 32 + 8 * fq;
#pragma unroll
        for (int ai = 0; ai < 2; ++ai)
#pragma unroll
            for (int m = 0; m < 4; ++m) { const int r = row0 + ai * HALF + m * 16;
                if (r < n) { const int ent = list[(size_t)e * LCAP + r]; const float w = wts[ent] * (SC_Y / (SC_ACT * SC_WD)); unsigned char* rowp = Y2 + (size_t)ent * D + colb;
#pragma unroll
                    for (int bj = 0; bj < 2; ++bj) { const f32x4 a0 = acc[ai][bj][m][0] * w, a1 = acc[ai][bj][m][1] * w; v2u w8; w8.x = pk4_fp8(a0[0], a0[1], a0[2], a0[3]); w8.y = pk4_fp8(a1[0], a1[1], a1[2], a1[3]);
                        *(v2u*)(rowp + bj * HALF) = w8; } } }
    }
};
struct KSplitOrder {
    const char* A; const char* Bt; int lda, ldb, K, nM, nks, G, c;
    __device__ bool next(int i, Unit& u) const {
        const int L = i * G + c; if (L >= nM * nks) return false;
        const int pm = L / nks, ks = L % nks;
        u.a = A + ((size_t)pm * BM * lda + (size_t)ks * K) * 2; u.b = Bt + (size_t)ks * BM * ldb * 2; u.r0 = pm * BM; u.c0 = 0; u.aux = ks; u.r1 = 0; return true;
    }
    __device__ __forceinline__ unsigned arow(const Unit&, int) const { return 0u; }
};
}

struct Frame {
    LAS unsigned char* lds;
    unsigned* ctl;
    int tid, lane, wave, vcu, G;
    const float* const __attribute__((address_space(4)))* in;
    float* out; unsigned char* ws;
};
enum { I_X = 0, I_MEM, I_NORM_MIX, I_W_IN, I_Q_NORM, I_K_NORM, I_SINKS, I_REL_BIAS, I_LAM_RE, I_LAM_IM, I_LOG_DT, I_B_RE, I_B_IM, I_C_RE, I_C_IM, I_SSM_D, I_W_GLU,
       I_MEM_NORM, I_W_MEM_KV, I_XQ_NORM, I_XK_NORM, I_ON_ATTN, I_ON_SSM, I_ON_X, I_W_O, I_NORM_FFN, I_WR_G, I_WR_E, I_W_GATE, I_W_UP, I_W_DOWN };

struct TrItem { const float* W; bf16* WT; const float* ks; int ldw, ldt, k0, n0, drow0; };
__device__ __forceinline__ void tr_load(const TrItem& it, f32x4 (&v)[8], int lane) {
    const int kc = lane & 7, nq = lane >> 3; const float* src = it.W + (size_t)(it.k0 + kc * 8) * it.ldw + it.n0 + nq * 4;
#pragma unroll
    for (int j = 0; j < 8; ++j) v[j] = __builtin_nontemporal_load((const f32x4*)(src + (size_t)j * it.ldw));
}
__device__ __forceinline__ void tr_store(const TrItem& it, f32x4 (&v)[8], int lane) {
    const int kc = lane & 7, nq = lane >> 3;
    if (it.ks) { const f32x4 s0 = *(const f32x4*)(it.ks + it.k0 + kc * 8), s1 = *(const f32x4*)(it.ks + it.k0 + kc * 8 + 4);
#pragma unroll
        for (int j = 0; j < 4; ++j) { v[j] = v[j] * s0[j]; v[4 + j] = v[4 + j] * s1[j]; } }
#pragma unroll
    for (int i = 0; i < 4; ++i) { v4u o; o.x = pk2(v[0][i], v[1][i]); o.y = pk2(v[2][i], v[3][i]); o.z = pk2(v[4][i], v[5][i]); o.w = pk2(v[6][i], v[7][i]);
        *(v4u*)(it.WT + (size_t)(it.drow0 + nq * 4 + i) * it.ldt + it.k0 + kc * 8) = o; }
}
__device__ __forceinline__ void rms_row_to_bf16(const float* xrow, const float* gain, bf16* orow, int lane) {
    const f32x4* xr = (const f32x4*)xrow + lane; const f32x4* gr = (const f32x4*)gain + lane;
    f32x4 v[8]; float s = 0.f;
#pragma unroll
    for (int j = 0; j < 8; ++j) { v[j] = xr[64 * j]; s += (v[j].x * v[j].x + v[j].y * v[j].y) + (v[j].z * v[j].z + v[j].w * v[j].w); }
    const float rstd = 1.0f / sqrtf(wave_sum(s) * (1.f / 2048.f) + EPS);
    v2u* o8 = (v2u*)orow + lane;
#pragma unroll
    for (int j = 0; j < 8; ++j) { const f32x4 g = gr[64 * j]; v2u w; w.x = pk2(v[j].x * rstd * g.x, v[j].y * rstd * g.y); w.y = pk2(v[j].z * rstd * g.z, v[j].w * rstd * g.w); o8[64 * j] = w; }
}

__device__ __forceinline__ void s5_tables(Frame& F, int g) {
    LAS float* ap = (LAS float*)F.lds;
    LAS float* Bb = ap + 33 * 64 * 2;
    LAS float* Cc = Bb + 64 * 16 * 2;
    LAS float* Km = Cc + 16 * 64 * 2;
    const float dt = expf(F.in[I_LOG_DT][g]);
    const float* lre = F.in[I_LAM_RE] + g * 64; const float* lim = F.in[I_LAM_IM] + g * 64;
    for (int idx = F.tid; idx < 33 * 64; idx += 512) { const int tau = idx >> 6, n = idx & 63; const float lr = lre[n], li = lim[n];
        const float mag = expf((float)tau * (lr * dt)), ang = (float)tau * (li * dt); ap[idx * 2] = mag * cosf(ang); ap[idx * 2 + 1] = mag * sinf(ang); }
    __syncthreads();
    for (int idx = F.tid; idx < 64 * 16; idx += 512) { const int n = idx >> 4; const float lr = lre[n], li = lim[n];
        const float nr = ap[(64 + n) * 2] - 1.0f, ni = ap[(64 + n) * 2 + 1], den = lr * lr + li * li;
        const float cr = (nr * lr + ni * li) / den, ci = (ni * lr - nr * li) / den;
        const float br = F.in[I_B_RE][(size_t)g * 1024 + idx], bi = F.in[I_B_IM][(size_t)g * 1024 + idx];
        Bb[idx * 2] = cr * br - ci * bi; Bb[idx * 2 + 1] = cr * bi + ci * br; }
    for (int idx = F.tid; idx < 16 * 64; idx += 512) { Cc[idx * 2] = F.in[I_C_RE][(size_t)g * 1024 + idx]; Cc[idx * 2 + 1] = F.in[I_C_IM][(size_t)g * 1024 + idx]; }
    __syncthreads();
    for (int idx = F.tid; idx < 32 * 256; idx += 512) { const int tau = idx >> 8, c = (idx >> 4) & 15, c2 = idx & 15; float s = 0.f;
        for (int n = 0; n < 64; ++n) { const float ar = ap[(tau * 64 + n) * 2], ai = ap[(tau * 64 + n) * 2 + 1], cr = Cc[(c * 64 + n) * 2], ci = Cc[(c * 64 + n) * 2 + 1];
            const float er = cr * ar - ci * ai, ei = cr * ai + ci * ar; s += er * Bb[(n * 16 + c2) * 2] - ei * Bb[(n * 16 + c2) * 2 + 1]; }
        Km[idx] = s; }
    __syncthreads();
    bf16* MQ = (bf16*)(F.ws + WS_MQ) + (size_t)g * 512 * S5K;
    for (int idx = F.tid; idx < 512 * 80; idx += 512) { const int row = idx / 80, ch = idx % 80, i = row >> 4, c = row & 15, k0 = ch * 8; float v[8];
        if (k0 < 512) { const int s = k0 >> 4, c20 = k0 & 15, tau = i - s;
#pragma unroll
            for (int j = 0; j < 8; ++j) v[j] = tau >= 0 ? Km[(tau * 16 + c) * 16 + c20 + j] : 0.f;
        } else { const int kk = k0 - 512, ri = kk >> 6, n0 = kk & 63;
#pragma unroll
            for (int j = 0; j < 8; ++j) { const int n = n0 + j; const float ar = ap[((i + 1) * 64 + n) * 2], ai = ap[((i + 1) * 64 + n) * 2 + 1], cr = Cc[(c * 64 + n) * 2], ci = Cc[(c * 64 + n) * 2 + 1];
                v[j] = ri == 0 ? (cr * ar - ci * ai) : -(cr * ai + ci * ar); } }
        v4u o; o.x = pk2(v[0], v[1]); o.y = pk2(v[2], v[3]); o.z = pk2(v[4], v[5]); o.w = pk2(v[6], v[7]);
        *(v4u*)(MQ + (size_t)row * S5K + k0) = o; }
    bf16* SP = (bf16*)(F.ws + WS_SP) + (size_t)g * 256 * 512;
    for (int idx = F.tid; idx < 256 * 64; idx += 512) { const int row = idx >> 6, k0 = (idx & 63) * 8; float v[8];
        if (row < 128) { const int ri = row >> 6, n = row & 63, s = k0 >> 4, c20 = k0 & 15; const float ar = ap[((31 - s) * 64 + n) * 2], ai = ap[((31 - s) * 64 + n) * 2 + 1];
#pragma unroll
            for (int j = 0; j < 8; ++j) { const float br = Bb[(n * 16 + c20 + j) * 2], bi = Bb[(n * 16 + c20 + j) * 2 + 1]; v[j] = ri == 0 ? (ar * br - ai * bi) : (ar * bi + ai * br); }
        } else {
#pragma unroll
            for (int j = 0; j < 8; ++j) v[j] = 0.f; }
        v4u o; o.x = pk2(v[0], v[1]); o.y = pk2(v[2], v[3]); o.z = pk2(v[4], v[5]); o.w = pk2(v[6], v[7]);
        *(v4u*)(SP + (size_t)row * 512 + k0) = o; }
    float* AL = (float*)(F.ws + WS_AL) + g * 128;
    if (F.tid < 64) { AL[F.tid * 2] = ap[(32 * 64 + F.tid) * 2]; AL[F.tid * 2 + 1] = ap[(32 * 64 + F.tid) * 2 + 1]; }
    __syncthreads();
}

struct BigTile { const float* src; unsigned char* dst; const float* ks; float sc; int ldw, ldt; };
constexpr int BT_GU = 64 * 2 * 64, BT_D = 64 * 64, BT_N = BT_GU + BT_D, BT_PITCH = 136;
__device__ __forceinline__ BigTile bt_decode(const Frame& F, unsigned char* Wgu8, unsigned char* Wd8, const float* nf, int ti) {
    BigTile t;
    const unsigned long long pg = (unsigned long long)F.in[I_W_GATE], pu = (unsigned long long)F.in[I_W_UP], pd = (unsigned long long)F.in[I_W_DOWN];
    if (ti < BT_GU) { const int e = ti >> 7, r = ti & 127, which = r >> 6, kb = (r >> 2) & 15, nb = r & 3;
        const unsigned long long p = pg + ((pu - pg) & (0ull - (unsigned long long)which));
        t.src = (const float*)p + (size_t)e * D * DEXP + (size_t)kb * 128 * DEXP + nb * 128; t.dst = Wgu8 + ((size_t)e * 1024 + nb * 256 + which * 128) * D + kb * 128; t.ks = nf + kb * 128; t.sc = SC_WGU; t.ldw = DEXP; t.ldt = D; }
    else { const int t2 = ti - BT_GU, e = t2 >> 6, r = t2 & 63, kb = r >> 4, nb = r & 15;
        t.src = (const float*)pd + (size_t)e * DEXP * D + (size_t)kb * 128 * D + nb * 128; t.dst = Wd8 + ((size_t)e * D + nb * 128) * DEXP + kb * 128; t.ks = nullptr; t.sc = SC_WD; t.ldw = D; t.ldt = DEXP; }
    return t;
}
#define BT_LOAD(t, v, kv) do { const unsigned _lo = (unsigned)(rl * 8 * (t).ldw + cq * 4); \
    _Pragma("unroll") for (int _p = 0; _p < 8; ++_p) kv[_p] = (t).ks ? (t).ks[rl * 8 + _p] * (t).sc : (t).sc; \
    _Pragma("unroll") for (int _p = 0; _p < 8; ++_p) v[_p] = __builtin_nontemporal_load((const f32x4*)((t).src + (size_t)_p * (t).ldw + _lo)); } while (0)
#define BT_STORE(t, v, kv) do { \
    _Pragma("unroll") for (int _i = 0; _i < 4; ++_i) { v2u _w; _w.x = pk4_fp8(v[0][_i] * kv[0], v[1][_i] * kv[1], v[2][_i] * kv[2], v[3][_i] * kv[3]); _w.y = pk4_fp8(v[4][_i] * kv[4], v[5][_i] * kv[5], v[6][_i] * kv[6], v[7][_i] * kv[7]); \
        *(LAS v2u*)(img + (cq * 4 + _i) * BT_PITCH + rl * 8) = _w; } \
    __syncthreads(); \
    _Pragma("unroll") for (int _j = 0; _j < 2; ++_j) { const int _idx = tid_ + _j * 512, _n = _idx >> 3, _ch = _idx & 7; \
        const v2u _a = *(const LAS v2u*)(img + _n * BT_PITCH + _ch * 16), _b = *(const LAS v2u*)(img + _n * BT_PITCH + _ch * 16 + 8); v4u _o; _o.x = _a.x; _o.y = _a.y; _o.z = _b.x; _o.w = _b.y; \
        *(v4u*)((t).dst + (size_t)_n * (t).ldt + _ch * 16) = _o; } \
    __syncthreads(); } while (0)
__device__ __forceinline__ void bg_convert(Frame& F, int qword, int base, int ntiles, int budget) {
    if (budget <= 0) return;
    int lane_ = (int)__builtin_amdgcn_mbcnt_hi(~0u, __builtin_amdgcn_mbcnt_lo(~0u, 0u)); asm volatile("" : "+v"(lane_)); const int tid_ = F.wave * 64 + lane_;
    unsigned char* WguT = F.ws + WS_WGU; unsigned char* WdT = F.ws + WS_WD; const float* nf = F.in[I_NORM_FFN];
    const int rl = tid_ >> 5, cq = tid_ & 31; LAS unsigned char* img = F.lds; LAS int* qn = (LAS int*)(F.lds + TAB_OFF + 1024);
    f32x4 va[8], vb[8]; float ka[8], kb[8];
    int nfetch = 0;
#define BG_FETCH(slot) do { if (nfetch < budget) { if (tid_ == 0) qn[slot] = (int)atomicAdd(F.ctl + qword, 1u); } else if (tid_ == 0) qn[slot] = 0x7fffffff; ++nfetch; } while (0)
    __syncthreads();
    BG_FETCH(0); BG_FETCH(1);
    __syncthreads();
    int i0 = __builtin_amdgcn_readfirstlane(qn[0]), i1 = __builtin_amdgcn_readfirstlane(qn[1]);
    __syncthreads();
    if (i0 < ntiles) { const BigTile t0 = bt_decode(F, WguT, WdT, nf, base + i0); BT_LOAD(t0, va, ka); }
    while (i0 < ntiles) {
        const BigTile ta = bt_decode(F, WguT, WdT, nf, base + i0);
        const BigTile tb = bt_decode(F, WguT, WdT, nf, base + (i1 < ntiles ? i1 : i0));
        BT_LOAD(tb, vb, kb);
        if (i1 >= ntiles) budget = 0;
        BG_FETCH(0);
        BT_STORE(ta, va, ka);
        const int i2 = __builtin_amdgcn_readfirstlane(qn[0]);
        if (i1 >= ntiles) break;
        const BigTile tc = bt_decode(F, WguT, WdT, nf, base + (i2 < ntiles ? i2 : i1));
        BT_LOAD(tc, va, ka);
        if (i2 >= ntiles) budget = 0;
        BG_FETCH(1);
        BT_STORE(tb, vb, kb);
        const int i3 = __builtin_amdgcn_readfirstlane(qn[1]);
        i0 = i2; i1 = i3;
    }
    __syncthreads();
#undef BG_FETCH
}
__device__ __forceinline__ void p0_prologue(Frame& F) {
    if (F.vcu < 32) s5_tables(F, F.vcu);
    const int gw = F.vcu * 8 + F.wave, NGW = F.G * 8;
    bf16* WinT = (bf16*)(F.ws + WS_WIN); bf16* WoT = (bf16*)(F.ws + WS_WO); bf16* WmkvT = (bf16*)(F.ws + WS_WMKV); bf16* WgluT = (bf16*)(F.ws + WS_WGLU);
    const float* nf = F.in[I_NORM_FFN];
    constexpr int I_IN = 32 * 72, I_O = 32 * 64, I_MKV = 32 * 32, I_GLU = 8 * 16;
    constexpr int NITEMS = I_IN + I_O + I_MKV + I_GLU;
    auto decode = [&](int it) -> TrItem {
        int r = it;
        if (r < I_IN) { const int kb = r / 72, nb = r % 72; return TrItem{F.in[I_W_IN], WinT, nullptr, INC, D, kb * 64, nb * 32, nb * 32}; } r -= I_IN;
        if (r < I_O) { const int kb = r / 64, nb = r % 64, k0 = kb * 64;
            const unsigned long long pa = (unsigned long long)F.in[I_ON_ATTN], ps = (unsigned long long)(F.in[I_ON_SSM] - 1024), px = (unsigned long long)(F.in[I_ON_X] - 1536);
            const unsigned long long m1 = 0ull - (unsigned long long)(k0 >= 1024), m2 = 0ull - (unsigned long long)(k0 >= 1536);
            const unsigned long long pk = pa + ((ps - pa) & m1) + ((px - ps) & m2);
            return TrItem{F.in[I_W_O], WoT, (const float*)pk, D, D, k0, nb * 32, nb * 32}; } r -= I_O;
        if (r < I_MKV) { const int kb = r / 32, nb = r % 32; return TrItem{F.in[I_W_MEM_KV], WmkvT, nullptr, 1024, D, kb * 64, nb * 32, nb * 32}; } r -= I_MKV;
        const int kb = r / 16, nb = r % 16; return TrItem{F.in[I_W_GLU], WgluT, nullptr, 512, 512, kb * 64, nb * 32, nb * 32};
    };
    {
        f32x4 va[8], vb[8]; int it = gw; TrItem ia, ib;
        if (it < NITEMS) { ia = decode(it); tr_load(ia, va, F.lane); }
        while (it < NITEMS) {
            const int it2 = it + NGW; if (it2 < NITEMS) { ib = decode(it2); tr_load(ib, vb, F.lane); }
            tr_store(ia, va, F.lane);
            if (it2 >= NITEMS) break;
            const int it3 = it2 + NGW; if (it3 < NITEMS) { ia = decode(it3); tr_load(ia, va, F.lane); }
            tr_store(ib, vb, F.lane);
            it = it3;
        }
    }
    { bf16* WrT = (bf16*)(F.ws + WS_WR); const int gt = F.vcu * 512 + F.tid, NT = F.G * 512;
      for (int idx = gt; idx < 4 * 256 * 512; idx += NT) { const int ks = idx >> 17, n = (idx >> 9) & 255, k = ks * 512 + (idx & 511); float v = 0.f;
          if (n < 8) v = F.in[I_WR_G][k * 8 + n] * nf[k]; else if (n < 72) v = F.in[I_WR_E][k * 64 + (n - 8)] * nf[k];
          WrT[idx] = (bf16)f2bf(v); } }
    bf16* XN = (bf16*)(F.ws + WS_XN); bf16* MEMN = (bf16*)(F.ws + WS_MEMN);
    for (int m = gw; m < T; m += NGW) rms_row_to_bf16(F.in[I_X] + (size_t)m * D, F.in[I_NORM_MIX], XN + (size_t)m * D, F.lane);
    for (int m = gw; m < NB * MEML; m += NGW) rms_row_to_bf16(F.in[I_MEM] + (size_t)m * D, F.in[I_MEM_NORM], MEMN + (size_t)m * D, F.lane);
    bg_convert(F, CW_QGU, 0, BT_GU, F.vcu < 32 ? PB0_S5 : PB0);
    bg_convert(F, CW_QD, BT_GU, BT_D, PB0_D);
}

constexpr int SWA_KS = 72, SWA_VS = 264;
constexpr int SWA_KOFF = 0, SWA_VOFF = 256 * SWA_KS * 2, SWA_BOFF = SWA_VOFF + 64 * SWA_VS * 2;
__device__ __forceinline__ int t5_bucket(int n) { if (n < 16) return n; const int v = 16 + (int)(logf((float)n * (1.0f / 16.0f)) / logf(8.0f) * 16.0f); return v < 31 ? v : 31; }
__device__ __forceinline__ void swa_unit(Frame& F, int unit) {
    const int b = unit >> 5, kvh = (unit >> 4) & 1, nb = unit & 15;
    const bf16* PROJ = (const bf16*)(F.ws + WS_PROJ); bf16* MIX = (bf16*)(F.ws + WS_MIX);
    LAS bf16* Ks = (LAS bf16*)(F.lds + SWA_KOFF); LAS bf16* Vt = (LAS bf16*)(F.lds + SWA_VOFF); LAS float* bt = (LAS float*)(F.lds + SWA_BOFF);
    __syncthreads();
    {
        const int key = F.tid >> 1, half = F.tid & 1, s = (nb - 1) * 128 + key;
        v4u kw[4], vw[4];
        if (s >= 0) { const bf16* rp = PROJ + (size_t)(b * SEQ + s) * INC + 1024 + kvh * 64 + half * 32;
#pragma unroll
            for (int j = 0; j < 4; ++j) { kw[j] = *(const v4u*)(rp + j * 8); vw[j] = *(const v4u*)(rp + 128 + j * 8); }
        } else {
#pragma unroll
            for (int j = 0; j < 4; ++j) { kw[j] = (v4u){0u, 0u, 0u, 0u}; vw[j] = (v4u){0u, 0u, 0u, 0u}; } }
        float kf[32]; float ss = 0.f;
#pragma unroll
        for (int j = 0; j < 4; ++j) { kf[j * 8 + 0] = bflo(kw[j].x); kf[j * 8 + 1] = bfhi(kw[j].x); kf[j * 8 + 2] = bflo(kw[j].y); kf[j * 8 + 3] = bfhi(kw[j].y);
            kf[j * 8 + 4] = bflo(kw[j].z); kf[j * 8 + 5] = bfhi(kw[j].z); kf[j * 8 + 6] = bflo(kw[j].w); kf[j * 8 + 7] = bfhi(kw[j].w); }
#pragma unroll
        for (int j = 0; j < 32; ++j) ss += kf[j] * kf[j];
        ss += __shfl_xor(ss, 1);
        const float rstd = 1.0f / sqrtf(ss * (1.f / 64.f) + EPS);
        const float* kn = F.in[I_K_NORM] + half * 32;
#pragma unroll
        for (int j = 0; j < 4; ++j) { v4u o; o.x = pk2(kf[j * 8 + 0] * rstd * kn[j * 8 + 0], kf[j * 8 + 1] * rstd * kn[j * 8 + 1]); o.y = pk2(kf[j * 8 + 2] * rstd * kn[j * 8 + 2], kf[j * 8 + 3] * rstd * kn[j * 8 + 3]);
            o.z = pk2(kf[j * 8 + 4] * rstd * kn[j * 8 + 4], kf[j * 8 + 5] * rstd * kn[j * 8 + 5]); o.w = pk2(kf[j * 8 + 6] * rstd * kn[j * 8 + 6], kf[j * 8 + 7] * rstd * kn[j * 8 + 7]);
            *(LAS v4u*)(Ks + key * SWA_KS + half * 32 + j * 8) = o; }
#pragma unroll
        for (int j = 0; j < 4; ++j) { const unsigned w4[4] = {vw[j].x, vw[j].y, vw[j].z, vw[j].w};
#pragma unroll
            for (int q = 0; q < 4; ++q) { const int d = half * 32 + j * 8 + q * 2; Vt[d * SWA_VS + key] = (bf16)(w4[q] & 0xffffu); Vt[(d + 1) * SWA_VS + key] = (bf16)(w4[q] >> 16); } }
        for (int idx = F.tid; idx < 8 * 128; idx += 512) { const int w = idx >> 7, dl = idx & 127; bt[idx] = F.in[I_REL_BIAS][t5_bucket(dl) * 16 + kvh * 8 + w]; }
    }
    __syncthreads();
    const int w = F.wave, h = kvh * 8 + w, ql = F.lane & 31, hh = F.lane >> 5;
    const float sink = F.in[I_SINKS][h];
    const float* qn = F.in[I_Q_NORM];
    for (int r = 0; r < 4; ++r) {
        const int qi = 32 * r + ql; const size_t t = (size_t)b * SEQ + nb * 128 + qi;
        bf16x8 qf[4];
        {   const bf16* qp = PROJ + t * INC + h * 64 + 8 * hh; v4u qw[4]; float qv[32]; float ss = 0.f;
#pragma unroll
            for (int ks = 0; ks < 4; ++ks) qw[ks] = *(const v4u*)(qp + ks * 16);
#pragma unroll
            for (int ks = 0; ks < 4; ++ks) { qv[ks * 8 + 0] = bflo(qw[ks].x); qv[ks * 8 + 1] = bfhi(qw[ks].x); qv[ks * 8 + 2] = bflo(qw[ks].y); qv[ks * 8 + 3] = bfhi(qw[ks].y);
                qv[ks * 8 + 4] = bflo(qw[ks].z); qv[ks * 8 + 5] = bfhi(qw[ks].z); qv[ks * 8 + 6] = bflo(qw[ks].w); qv[ks * 8 + 7] = bfhi(qw[ks].w); }
#pragma unroll
            for (int j = 0; j < 32; ++j) ss += qv[j] * qv[j];
            ss += __shfl_xor(ss, 32);
            const float sc = 0.125f / sqrtf(ss * (1.f / 64.f) + EPS);
#pragma unroll
            for (int ks = 0; ks < 4; ++ks) { const float* g = qn + ks * 16 + 8 * hh; v4u o;
                o.x = pk2(qv[ks * 8 + 0] * sc * g[0], qv[ks * 8 + 1] * sc * g[1]); o.y = pk2(qv[ks * 8 + 2] * sc * g[2], qv[ks * 8 + 3] * sc * g[3]);
                o.z = pk2(qv[ks * 8 + 4] * sc * g[4], qv[ks * 8 + 5] * sc * g[5]); o.w = pk2(qv[ks * 8 + 6] * sc * g[6], qv[ks * 8 + 7] * sc * g[7]);
                qf[ks] = __builtin_bit_cast(bf16x8, o); } }
        f32x16 s[5];
        const int qh = ql - 4 * hh; const LAS float* pb = bt + w * 128 + qh;
        float mx = sink;
#pragma unroll
        for (int kt = 0; kt < 5; ++kt) {
            const bool live = (nb > 0) || (r + kt >= 4);
            f32x16 a = {0.f, 0.f, 0.f, 0.f, 0.f, 0.f, 0.f, 0.f, 0.f, 0.f, 0.f, 0.f, 0.f, 0.f, 0.f, 0.f};
            if (live) {
#pragma unroll
                for (int ks = 0; ks < 4; ++ks) { const bf16x8 kfrag = *(const LAS bf16x8*)(Ks + (32 * (r + kt) + ql) * SWA_KS + ks * 16 + 8 * hh);
                    a = __builtin_amdgcn_mfma_f32_32x32x16_bf16(kfrag, qf[ks], a, 0, 0, 0); }
#pragma unroll
                for (int rg = 0; rg < 16; ++rg) { const int rowc = (rg & 3) + 8 * (rg >> 2);
                    float v = a[rg] + pb[128 - 32 * kt - rowc];
                    if (kt == 0) v = (rowc > qh) ? v : -1e30f;
                    if (kt == 4) v = (rowc <= qh) ? v : -1e30f;
                    a[rg] = v; mx = fmaxf(mx, v); }
            } else {
#pragma unroll
                for (int rg = 0; rg < 16; ++rg) a[rg] = -1e30f;
            }
            s[kt] = a; }
        mx = fmaxf(mx, __shfl_xor(mx, 32));
        float l = 0.f;
#pragma unroll
        for (int kt = 0; kt < 5; ++kt)
#pragma unroll
            for (int rg = 0; rg < 16; ++rg) { const float p = fast_exp(s[kt][rg] - mx); s[kt][rg] = p; l += p; }
        l += __shfl_xor(l, 32);
        l += fast_exp(sink - mx);
        f32x16 o[2];
#pragma unroll
        for (int dt = 0; dt < 2; ++dt) o[dt] = (f32x16){0.f, 0.f, 0.f, 0.f, 0.f, 0.f, 0.f, 0.f, 0.f, 0.f, 0.f, 0.f, 0.f, 0.f, 0.f, 0.f};
#pragma unroll
        for (int kt = 0; kt < 5; ++kt)
#pragma unroll
            for (int st = 0; st < 2; ++st) { v4u pw; pw.x = pk2(s[kt][8 * st + 0], s[kt][8 * st + 1]); pw.y = pk2(s[kt][8 * st + 2], s[kt][8 * st + 3]); pw.z = pk2(s[kt][8 * st + 4], s[kt][8 * st + 5]); pw.w = pk2(s[kt][8 * st + 6], s[kt][8 * st + 7]);
                const bf16x8 pf = __builtin_bit_cast(bf16x8, pw);
#pragma unroll
                for (int dt = 0; dt < 2; ++dt) { const LAS bf16* vp = Vt + (dt * 32 + ql) * SWA_VS + 32 * (r + kt) + 16 * st + 4 * hh;
                    const v2u lo = *(const LAS v2u*)vp, hi = *(const LAS v2u*)(vp + 8); v4u vv; vv.x = lo.x; vv.y = lo.y; vv.z = hi.x; vv.w = hi.y;
                    o[dt] = __builtin_amdgcn_mfma_f32_32x32x16_bf16(__builtin_bit_cast(bf16x8, vv), pf, o[dt], 0, 0, 0); } }
        const float inv = 1.0f / l;
        { float ssq = 0.f;
#pragma unroll
          for (int dt = 0; dt < 2; ++dt)
#pragma unroll
              for (int rg = 0; rg < 16; ++rg) { const float v = o[dt][rg] * inv; ssq += v * v; }
          ssq += __shfl_xor(ssq, 32);
          if (hh == 0) ((float*)(F.ws + WS_SS))[t * 32 + h] = ssq; }
        bf16* op = MIX + t * D + h * 64 + 4 * hh;
#pragma unroll
        for (int dt = 0; dt < 2; ++dt)
#pragma unroll
            for (int q4 = 0; q4 < 4; ++q4) { v2u ow; ow.x = pk2(o[dt][q4 * 4 + 0] * inv, o[dt][q4 * 4 + 1] * inv); ow.y = pk2(o[dt][q4 * 4 + 2] * inv, o[dt][q4 * 4 + 3] * inv);
                *(v2u*)(op + dt * 32 + q4 * 8) = ow; }
    }
}

constexpr int XA_KS = 136, XA_VS = 264;
constexpr int XA_KOFF = 0, XA_VOFF = 256 * XA_KS * 2;
__device__ __forceinline__ void xattn_unit(Frame& F, int unit) {
    const int b = unit >> 5, hx = (unit >> 3) & 3, qb = unit & 7;
    const bf16* PROJ = (const bf16*)(F.ws + WS_PROJ); const bf16* MKV = (const bf16*)(F.ws + WS_MEMKV); bf16* MIX = (bf16*)(F.ws + WS_MIX);
    LAS bf16* Ks = (LAS bf16*)(F.lds + XA_KOFF); LAS bf16* Vt = (LAS bf16*)(F.lds + XA_VOFF);
    __syncthreads();
    {   const int key = F.tid >> 1, half = F.tid & 1; const bf16* rp = MKV + (size_t)(b * MEML + key) * 1024 + hx * 128 + half * 64;
        float ss = 0.f; v4u kw[8];
#pragma unroll
        for (int j = 0; j < 8; ++j) { kw[j] = *(const v4u*)(rp + j * 8);
            const float a0 = bflo(kw[j].x), a1 = bfhi(kw[j].x), a2 = bflo(kw[j].y), a3 = bfhi(kw[j].y), a4 = bflo(kw[j].z), a5 = bfhi(kw[j].z), a6 = bflo(kw[j].w), a7 = bfhi(kw[j].w);
            ss += (a0 * a0 + a1 * a1) + (a2 * a2 + a3 * a3) + (a4 * a4 + a5 * a5) + (a6 * a6 + a7 * a7); }
        ss += __shfl_xor(ss, 1);
        const float rstd = 1.0f / sqrtf(ss * (1.f / 128.f) + EPS);
        const float* kn = F.in[I_XK_NORM] + half * 64;
#pragma unroll
        for (int j = 0; j < 8; ++j) { v4u o; const float* g = kn + j * 8;
            o.x = pk2(bflo(kw[j].x) * rstd * g[0], bfhi(kw[j].x) * rstd * g[1]); o.y = pk2(bflo(kw[j].y) * rstd * g[2], bfhi(kw[j].y) * rstd * g[3]);
            o.z = pk2(bflo(kw[j].z) * rstd * g[4], bfhi(kw[j].z) * rstd * g[5]); o.w = pk2(bflo(kw[j].w) * rstd * g[6], bfhi(kw[j].w) * rstd * g[7]);
            *(LAS v4u*)(Ks + key * XA_KS + half * 64 + j * 8) = o; }
#pragma unroll
        for (int j = 0; j < 8; ++j) { const v4u vw = *(const v4u*)(rp + 512 + j * 8); const unsigned w4[4] = {vw.x, vw.y, vw.z, vw.w};
#pragma unroll
            for (int q = 0; q < 4; ++q) { const int d = half * 64 + j * 8 + q * 2; Vt[d * XA_VS + key] = (bf16)(w4[q] & 0xffffu); Vt[(d + 1) * XA_VS + key] = (bf16)(w4[q] >> 16); } }
    }
    __syncthreads();
    const int ql = F.lane & 31, hh = F.lane >> 5;
    const size_t t = (size_t)b * SEQ + qb * 256 + F.wave * 32 + ql;
    bf16x8 qf[8];
    {   const bf16* qp = PROJ + t * INC + 1792 + hx * 128 + 8 * hh; v4u qw[8]; float ss = 0.f;
#pragma unroll
        for (int ks = 0; ks < 8; ++ks) { qw[ks] = *(const v4u*)(qp + ks * 16);
            const float a0 = bflo(qw[ks].x), a1 = bfhi(qw[ks].x), a2 = bflo(qw[ks].y), a3 = bfhi(qw[ks].y), a4 = bflo(qw[ks].z), a5 = bfhi(qw[ks].z), a6 = bflo(qw[ks].w), a7 = bfhi(qw[ks].w);
            ss += (a0 * a0 + a1 * a1) + (a2 * a2 + a3 * a3) + (a4 * a4 + a5 * a5) + (a6 * a6 + a7 * a7); }
        ss += __shfl_xor(ss, 32);
        const float sc = 0.08838834764831845f / sqrtf(ss * (1.f / 128.f) + EPS);
        const float* qn = F.in[I_XQ_NORM] + 8 * hh;
#pragma unroll
        for (int ks = 0; ks < 8; ++ks) { const float* g = qn + ks * 16; v4u o;
            o.x = pk2(bflo(qw[ks].x) * sc * g[0], bfhi(qw[ks].x) * sc * g[1]); o.y = pk2(bflo(qw[ks].y) * sc * g[2], bfhi(qw[ks].y) * sc * g[3]);
            o.z = pk2(bflo(qw[ks].z) * sc * g[4], bfhi(qw[ks].z) * sc * g[5]); o.w = pk2(bflo(qw[ks].w) * sc * g[6], bfhi(qw[ks].w) * sc * g[7]);
            qf[ks] = __builtin_bit_cast(bf16x8, o); } }
    f32x16 o[4];
#pragma unroll
    for (int dt = 0; dt < 4; ++dt) o[dt] = (f32x16){0.f, 0.f, 0.f, 0.f, 0.f, 0.f, 0.f, 0.f, 0.f, 0.f, 0.f, 0.f, 0.f, 0.f, 0.f, 0.f};
    float mrun = -1e30f, lrun = 0.f;
    for (int kb = 0; kb < 4; ++kb) {
        f32x16 s[2];
#pragma unroll
        for (int kt = 0; kt < 2; ++kt) { f32x16 a = {0.f, 0.f, 0.f, 0.f, 0.f, 0.f, 0.f, 0.f, 0.f, 0.f, 0.f, 0.f, 0.f, 0.f, 0.f, 0.f};
#pragma unroll
            for (int ks = 0; ks < 8; ++ks) { const bf16x8 kfrag = *(const LAS bf16x8*)(Ks + (64 * kb + 32 * kt + ql) * XA_KS + ks * 16 + 8 * hh);
                a = __builtin_amdgcn_mfma_f32_32x32x16_bf16(kfrag, qf[ks], a, 0, 0, 0); }
            s[kt] = a; }
        float mx = mrun;
#pragma unroll
        for (int kt = 0; kt < 2; ++kt)
#pragma unroll
            for (int rg = 0; rg < 16; ++rg) mx = fmaxf(mx, s[kt][rg]);
        mx = fmaxf(mx, __shfl_xor(mx, 32));
        const float alpha = fast_exp(mrun - mx); mrun = mx;
        float ls = 0.f;
#pragma unroll
        for (int kt = 0; kt < 2; ++kt)
#pragma unroll
            for (int rg = 0; rg < 16; ++rg) { const float p = fast_exp(s[kt][rg] - mx); s[kt][rg] = p; ls += p; }
        lrun = lrun * alpha + ls;
#pragma unroll
        for (int dt = 0; dt < 4; ++dt)
#pragma unroll
            for (int rg = 0; rg < 16; ++rg) o[dt][rg] *= alpha;
#pragma unroll
        for (int kt = 0; kt < 2; ++kt)
#pragma unroll
            for (int st = 0; st < 2; ++st) { v4u pw; pw.x = pk2(s[kt][8 * st + 0], s[kt][8 * st + 1]); pw.y = pk2(s[kt][8 * st + 2], s[kt][8 * st + 3]); pw.z = pk2(s[kt][8 * st + 4], s[kt][8 * st + 5]); pw.w = pk2(s[kt][8 * st + 6], s[kt][8 * st + 7]);
                const bf16x8 pf = __builtin_bit_cast(bf16x8, pw);
#pragma unroll
                for (int dt = 0; dt < 4; ++dt) { const LAS bf16* vp = Vt + (dt * 32 + ql) * XA_VS + 64 * kb + 32 * kt + 16 * st + 4 * hh;
                    const v2u lo = *(const LAS v2u*)vp, hi = *(const LAS v2u*)(vp + 8); v4u vv; vv.x = lo.x; vv.y = lo.y; vv.z = hi.x; vv.w = hi.y;
                    o[dt] = __builtin_amdgcn_mfma_f32_32x32x16_bf16(__builtin_bit_cast(bf16x8, vv), pf, o[dt], 0, 0, 0); } }
    }
    lrun += __shfl_xor(lrun, 32);
    const float inv = 1.0f / lrun;
    { float ssq = 0.f;
#pragma unroll
      for (int dt = 0; dt < 4; ++dt)
#pragma unroll
          for (int rg = 0; rg < 16; ++rg) { const float v = o[dt][rg] * inv; ssq += v * v; }
      ssq += __shfl_xor(ssq, 32);
      if (hh == 0) ((float*)(F.ws + WS_SS))[t * 32 + 24 + hx] = ssq; }
    bf16* op = MIX + t * D + 1536 + hx * 128 + 4 * hh;
#pragma unroll
    for (int dt = 0; dt < 4; ++dt)
#pragma unroll
        for (int q4 = 0; q4 < 4; ++q4) { v2u ow; ow.x = pk2(o[dt][q4 * 4 + 0] * inv, o[dt][q4 * 4 + 1] * inv); ow.y = pk2(o[dt][q4 * 4 + 2] * inv, o[dt][q4 * 4 + 3] * inv);
            *(v2u*)(op + dt * 32 + q4 * 8) = ow; }
}

__device__ __forceinline__ void moe_tables(Frame& F) {
    LAS int* cnt = (LAS int*)(F.lds + TAB_OFF); LAS int* ts = cnt + 64;
    __syncthreads();
    if (F.tid < 64) { const int c = (int)__hip_atomic_load(F.ctl + CW_CNT + F.tid, __ATOMIC_RELAXED, __HIP_MEMORY_SCOPE_AGENT); const int nt = (c + 255) >> 8; int inc = nt;
#pragma unroll
        for (int o = 1; o < 64; o <<= 1) { const int v = __shfl_up(inc, o); if (F.tid >= o) inc += v; }
        cnt[F.tid] = c; ts[F.tid + 1] = inc; if (F.tid == 0) ts[0] = 0; }
    __syncthreads();
}

struct Args { const float* in[31]; float* out; unsigned char* ws; int ph_lo, ph_hi; };
__global__ void __launch_bounds__(512, 2) hymba_fwd(Args args) {
    extern __shared__ __attribute__((aligned(16))) unsigned char lds_raw[];
    Frame F;
    F.lds = (LAS unsigned char*)lds_raw;
    F.tid = threadIdx.x; F.lane = F.tid & 63; F.wave = __builtin_amdgcn_readfirstlane(F.tid >> 6);
    F.G = gridDim.x; { const int bx = blockIdx.x; F.vcu = (F.G % 8 == 0) ? (bx % 8) * (F.G / 8) + bx / 8 : bx; }
    F.in = (const float* const __attribute__((address_space(4)))*)__builtin_amdgcn_kernarg_segment_ptr();
    F.out = args.out; F.ws = args.ws; F.ctl = (unsigned*)(args.ws + WS_CTL);
    const int lo = args.ph_lo, hi = args.ph_hi;
#if !MK_PER_PHASE
    if (F.tid < 4) ((LAS unsigned*)(F.lds + XBW_OFF))[F.tid] = 0u;
    __syncthreads();
    XcdBarrier bar = xcd_barrier_post(F.ctl + CW_BAR, (volatile LAS unsigned*)(F.lds + XBW_OFF));
#define GRID_BAR() xcd_barrier(bar)
#else
#define GRID_BAR() do {} while (0)
#endif
#define PHASE_REGS() do { int _l = (int)__builtin_amdgcn_mbcnt_hi(~0u, __builtin_amdgcn_mbcnt_lo(~0u, 0u)); asm volatile("" : "+v"(_l)); F.lane = _l; F.tid = F.wave * 64 + _l; } while (0)
#define IN(k) (lo <= (k) && (k) < hi)
#define SEAM(k) do { if (IN(k) && IN((k) + 1)) GRID_BAR(); } while (0)
    const int gw = F.vcu * 8 + F.wave, NGW = F.G * 8;
    bf16* const XN = (bf16*)(F.ws + WS_XN); bf16* const PROJ = (bf16*)(F.ws + WS_PROJ); bf16* const MIX = (bf16*)(F.ws + WS_MIX);
    bf16* const UA = (bf16*)(F.ws + WS_UA); bf16* const Gm = (bf16*)(F.ws + WS_G);

    if (IN(0)) { PHASE_REGS(); p0_prologue(F); }
    SEAM(0);
    if (IN(1)) { PHASE_REGS();
        { pg8::Gemm g{D, D, D}; pg8::DenseOrder S; S.init(XN, F.ws + WS_WIN, D, D, T, INC, F.G, (int)blockIdx.x);
          pg8::EpiProj E{PROJ, UA}; pg8::gemm_phase<pg8::EpiProj, pg8::DenseOrder>(F.lds, g, S, E, F.wave); }
        { pg8::Gemm g{D, D, D}; pg8::DenseOrder S; S.init(F.ws + WS_MEMN, F.ws + WS_WMKV, D, D, NB * MEML, 1024, F.G, F.G - 1 - (int)blockIdx.x);
          pg8::EpiBf16 E{(bf16*)(F.ws + WS_MEMKV), 1024}; pg8::gemm_phase<pg8::EpiBf16, pg8::DenseOrder>(F.lds, g, S, E, F.wave); }
        { const int c = (int)blockIdx.x; const bool has3 = 2 * F.G + c < (T / 256) * (INC / 256), haskv = (F.G - 1 - c) < (NB * MEML / 256) * 4;
          bg_convert(F, CW_QGU, 0, BT_GU, (!has3 && !haskv) ? PB1 : 0); }
    }
    SEAM(1);
    if (IN(2)) { PHASE_REGS();
        for (int u = F.vcu; u < 256; u += F.G) swa_unit(F, u);
        __syncthreads();
        { pg8::Gemm g{S5K, 512, 512}; pg8::GroupOrder S{(const char*)UA, (const char*)(F.ws + WS_SP), S5K, 512, 1, 32, F.G, F.G - 1 - F.vcu};
          pg8::EpiF32 E{(float*)(F.ws + WS_SL), 256, (size_t)512 * 256}; pg8::gemm_phase<pg8::EpiF32, pg8::GroupOrder>(F.lds, g, S, E, F.wave); }
        bg_convert(F, CW_QGU, 0, BT_GU, (F.G - 1 - F.vcu) >= 64 ? PB2 : 0);
    }
    SEAM(2);
    if (IN(3)) { PHASE_REGS();
        if (F.wave == 0) {
            const float* SL = (const float*)(F.ws + WS_SL); const float* AL = (const float*)(F.ws + WS_AL);
            for (int p = F.vcu; p < 256; p += F.G) { const int b = p >> 5, g = p & 31, n = F.lane;
                const float ar = AL[(g * 64 + n) * 2], ai = AL[(g * 64 + n) * 2 + 1]; float xr = 0.f, xi = 0.f;
                for (int j0 = 0; j0 < 64; j0 += 8) { float sr[8], si[8];
#pragma unroll
                    for (int j = 0; j < 8; ++j) { const float* sp = SL + ((size_t)(g * 512 + b * 64 + j0 + j)) * 256; sr[j] = sp[n]; si[j] = sp[64 + n]; }
#pragma unroll
                    for (int j = 0; j < 8; ++j) { bf16* up = UA + ((size_t)(g * 512 + b * 64 + j0 + j)) * S5K + 512; up[n] = (bf16)f2bf(xr); up[64 + n] = (bf16)f2bf(xi);
                        const float nr = ar * xr - ai * xi + sr[j], ni = ar * xi + ai * xr + si[j]; xr = nr; xi = ni; } } }
        }
        if (F.G < 256) { for (int u = F.vcu; u < 256; u += F.G) xattn_unit(F, u); __syncthreads(); }
    }
    SEAM(3);
    if (IN(4)) { PHASE_REGS();
        pg8::Gemm g{S5K, S5K, S5K}; pg8::GroupOrder S{(const char*)UA, (const char*)(F.ws + WS_MQ), S5K, S5K, 2, 32, F.G, F.vcu};
        pg8::EpiS5Y E{UA, F.in[I_SSM_D], Gm}; pg8::gemm_phase<pg8::EpiS5Y, pg8::GroupOrder>(F.lds, g, S, E, F.wave);
        if (F.G >= 256 && F.vcu >= 128) { for (int u = F.vcu - 128; u < 128; u += F.G - 128) xattn_unit(F, u); __syncthreads(); }
    }
    SEAM(4);
    if (IN(5)) { PHASE_REGS();
        pg8::Gemm g{512, 512, 512}; pg8::DenseOrder S; S.init(Gm, F.ws + WS_WGLU, 512, 512, T, 512, F.G, (int)blockIdx.x);
        pg8::EpiGlu E{Gm, MIX, (float*)(F.ws + WS_SS)}; pg8::gemm_phase<pg8::EpiGlu, pg8::DenseOrder>(F.lds, g, S, E, F.wave);
        if (F.G >= 256 && (int)blockIdx.x >= 128) { for (int u = 128 + (int)blockIdx.x - 128; u < 256; u += F.G - 128) xattn_unit(F, u); __syncthreads(); }
    }
    SEAM(5);
    if (IN(6)) { PHASE_REGS();
        pg8::Gemm g{D, D, D}; pg8::DenseOrder S; S.init(MIX, F.ws + WS_WO, D, D, T, D, F.G, (int)blockIdx.x);
        pg8::EpiWo E{F.in[I_X], XN, (unsigned char*)(F.ws + WS_X18), (float*)(F.ws + WS_PART)}; pg8::gemm_phase<pg8::EpiWo, pg8::DenseOrder, false, false, true>(F.lds, g, S, E, F.wave, (const float*)(F.ws + WS_SS));
    }
    SEAM(6);
    if (IN(7)) { PHASE_REGS();
        pg8::Gemm g{D, 512, 512}; pg8::KSplitOrder S{(const char*)XN, (const char*)(F.ws + WS_WR), D, 512, 512, T / 256, 4, F.G, F.vcu};
        pg8::EpiLogit E{(float*)(F.ws + WS_LP)}; pg8::gemm_phase<pg8::EpiLogit, pg8::KSplitOrder>(F.lds, g, S, E, F.wave);
    }
    SEAM(7);
    const int rt_per = (T + F.G - 1) / F.G, rt_beg = F.vcu * rt_per, rt_end = (rt_beg + rt_per) < T ? (rt_beg + rt_per) : T;
    if (IN(8)) { PHASE_REGS();
        LAS int* hist = (LAS int*)F.lds;
        const float* LP = (const float*)(F.ws + WS_LP); const float* part = (const float*)(F.ws + WS_PART); float* rstdv = (float*)(F.ws + WS_RSTD);
        int* toke = (int*)(F.ws + WS_TOKE); float* wts = (float*)(F.ws + WS_WTS); int* HIST = (int*)(F.ws + WS_HIST);
        __syncthreads();
        if (F.tid < 64) hist[F.tid] = 0;
        __syncthreads();
        for (int t = rt_beg + F.tid; t < rt_end; t += 512) {
            const f32x4* pp = (const f32x4*)(part + (size_t)t * 32); float ss = 0.f;
#pragma unroll
            for (int j = 0; j < 8; ++j) { const f32x4 v = pp[j]; ss += (v[0] + v[1]) + (v[2] + v[3]); }
            const float rs = 1.0f / sqrtf(ss * (1.f / 2048.f) + EPS); rstdv[t] = rs;
            const float* l0 = LP + (size_t)t * 80; const float* l1 = l0 + (size_t)T * 80; const float* l2 = l1 + (size_t)T * 80; const float* l3 = l2 + (size_t)T * 80;
            float gl[8];
#pragma unroll
            for (int j = 0; j < 8; j += 4) { const f32x4 a = *(const f32x4*)(l0 + j), b = *(const f32x4*)(l1 + j), c = *(const f32x4*)(l2 + j), d = *(const f32x4*)(l3 + j);
#pragma unroll
                for (int q = 0; q < 4; ++q) gl[j + q] = rs * (((a[q] + b[q]) + c[q]) + d[q]); }
            int gi = 0; float gm = gl[0];
#pragma unroll
            for (int j = 1; j < 8; ++j) if (gl[j] > gm) { gm = gl[j]; gi = j; }
            float gs = 0.f;
#pragma unroll
            for (int j = 0; j < 8; ++j) gs += expf(gl[j] - gm);
            const float gate = 1.0f / gs;
            float el[8];
#pragma unroll
            for (int j = 0; j < 8; j += 4) { const int o = 8 + gi * 8 + j; const f32x4 a = *(const f32x4*)(l0 + o), b = *(const f32x4*)(l1 + o), c = *(const f32x4*)(l2 + o), d = *(const f32x4*)(l3 + o);
#pragma unroll
                for (int q = 0; q < 4; ++q) el[j + q] = rs * (((a[q] + b[q]) + c[q]) + d[q]); }
            int i1 = 0; float v1 = el[0];
#pragma unroll
            for (int j = 1; j < 8; ++j) if (el[j] > v1) { v1 = el[j]; i1 = j; }
            int i2 = -1; float v2 = -3.0e38f;
#pragma unroll
            for (int j = 0; j < 8; ++j) if (j != i1 && el[j] > v2) { v2 = el[j]; i2 = j; }
            const float ex = expf(v2 - v1);
            const int ea = gi * 8 + i1, eb = gi * 8 + i2;
            const int la = __hip_atomic_fetch_add(hist + ea, 1, __ATOMIC_RELAXED, __HIP_MEMORY_SCOPE_WORKGROUP), lb = __hip_atomic_fetch_add(hist + eb, 1, __ATOMIC_RELAXED, __HIP_MEMORY_SCOPE_WORKGROUP);
            toke[t * 2] = (ea << 16) | la; toke[t * 2 + 1] = (eb << 16) | lb; wts[t * 2] = gate / (1.0f + ex); wts[t * 2 + 1] = gate * ex / (1.0f + ex);
        }
        __syncthreads();
        if (F.tid < 64) HIST[F.vcu * 64 + F.tid] = hist[F.tid];
        __syncthreads();
    }
    SEAM(8);
    if (IN(9)) { PHASE_REGS();
        LAS int* pb = (LAS int*)F.lds; LAS int* pt = pb + 512; LAS int* base = pt + 512;
        const int* HIST = (const int*)(F.ws + WS_HIST); const int* toke = (const int*)(F.ws + WS_TOKE); int* list = (int*)(F.ws + WS_LIST);
        __syncthreads();
        { const int e = F.tid & 63, p8 = F.tid >> 6; int sb = 0, st = 0;
          for (int w = p8; w < F.G; w += 8) { const int h = HIST[w * 64 + e]; st += h; sb += (w < F.vcu) ? h : 0; }
          pb[F.tid] = sb; pt[F.tid] = st; }
        __syncthreads();
        if (F.tid < 64) { int sb = 0, st = 0;
#pragma unroll
            for (int j = 0; j < 8; ++j) { sb += pb[j * 64 + F.tid]; st += pt[j * 64 + F.tid]; }
            base[F.tid] = sb; F.ctl[CW_CNT + F.tid] = (unsigned)st; }
        __syncthreads();
        for (int t = rt_beg + F.tid; t < rt_end; t += 512) {
#pragma unroll
            for (int k = 0; k < 2; ++k) { const int v = toke[t * 2 + k], e = v >> 16, sl = v & 0xffff; list[(size_t)e * LCAP + base[e] + sl] = t * 2 + k; } }
        __syncthreads();
        bg_convert(F, CW_QGU, 0, BT_GU, 0x7fffffff);
    }
    SEAM(9);
    if (IN(10)) { PHASE_REGS();
        moe_tables(F);
        const LAS int* cnt = (const LAS int*)(F.lds + TAB_OFF); const int* list = (const int*)(F.ws + WS_LIST);
        pg8::Gemm g{D / 2, D / 2, D / 2}; pg8::MoeOrder S{(const char*)(F.ws + WS_X18), (const char*)(F.ws + WS_WGU), cnt, cnt + 64, list, D / 2, D / 2, 4, 1024, F.G, F.vcu, true};
        pg8::EpiGU E{list, (const float*)(F.ws + WS_RSTD), cnt, F.ws + WS_ACT}; pg8::gemm_phase<pg8::EpiGU, pg8::MoeOrder, true, true>(F.lds, g, S, E, F.wave);
        PHASE_REGS();
        bg_convert(F, CW_QD, BT_GU, BT_D, 0x7fffffff);
    }
    SEAM(10);
    if (IN(11)) { PHASE_REGS();
        moe_tables(F);
        const LAS int* cnt = (const LAS int*)(F.lds + TAB_OFF); const int* list = (const int*)(F.ws + WS_LIST);
        pg8::Gemm g{DEXP / 2, DEXP / 2, DEXP / 2}; pg8::MoeOrder S{(const char*)(F.ws + WS_ACT), (const char*)(F.ws + WS_WD), cnt, cnt + 64, list, DEXP / 2, DEXP / 2, 8, 2048, F.G, F.vcu, false};
        pg8::EpiDown E{list, (const float*)(F.ws + WS_WTS), cnt, F.ws + WS_Y2};
        pg8::gemm_phase<pg8::EpiDown, pg8::MoeOrder, false, true>(F.lds, g, S, E, F.wave);
    }
    SEAM(11);
    if (IN(12)) { PHASE_REGS();
        const unsigned char* Y2 = F.ws + WS_Y2; typedef float f32x2_ __attribute__((ext_vector_type(2)));
        for (int m = gw; m < T; m += NGW) { f32x4* op = (f32x4*)(F.out + (size_t)m * D) + F.lane * 2; const v4u* xb = (const v4u*)(XN + (size_t)m * D) + F.lane;
            const v2u* ya = (const v2u*)(Y2 + (size_t)m * 2 * D) + F.lane; const v2u* yb = ya + 256;
            v4u xw[4]; v2u aw[4], cw[4];
#pragma unroll
            for (int j = 0; j < 4; ++j) { xw[j] = __builtin_nontemporal_load(xb + 64 * j); aw[j] = __builtin_nontemporal_load(ya + 64 * j); cw[j] = __builtin_nontemporal_load(yb + 64 * j); }
#pragma unroll
            for (int j = 0; j < 4; ++j) { const v4u x = xw[j]; const v2u a = aw[j], c = cw[j]; f32x4 x0, x1; const float is = 1.0f / SC_Y;
                const f32x2_ a0 = __builtin_amdgcn_cvt_pk_f32_fp8((int)a.x, false), a1 = __builtin_amdgcn_cvt_pk_f32_fp8((int)a.x, true), a2 = __builtin_amdgcn_cvt_pk_f32_fp8((int)a.y, false), a3 = __builtin_amdgcn_cvt_pk_f32_fp8((int)a.y, true);
                const f32x2_ c0 = __builtin_amdgcn_cvt_pk_f32_fp8((int)c.x, false), c1 = __builtin_amdgcn_cvt_pk_f32_fp8((int)c.x, true), c2 = __builtin_amdgcn_cvt_pk_f32_fp8((int)c.y, false), c3 = __builtin_amdgcn_cvt_pk_f32_fp8((int)c.y, true);
                x0[0] = bflo(x.x) + (a0[0] + c0[0]) * is; x0[1] = bfhi(x.x) + (a0[1] + c0[1]) * is; x0[2] = bflo(x.y) + (a1[0] + c1[0]) * is; x0[3] = bfhi(x.y) + (a1[1] + c1[1]) * is;
                x1[0] = bflo(x.z) + (a2[0] + c2[0]) * is; x1[1] = bfhi(x.z) + (a2[1] + c2[1]) * is; x1[2] = bflo(x.w) + (a3[0] + c3[0]) * is; x1[3] = bfhi(x.w) + (a3[1] + c3[1]) * is;
                __builtin_nontemporal_store(x0, op + 128 * j); __builtin_nontemporal_store(x1, op + 128 * j + 1); } }
    }
#undef IN
#undef SEAM
}

extern "C" void kernel_launch(void* const* d_in, const int* in_sizes, int n_in, void* d_out, int out_size, void* d_ws, size_t ws_size, hipStream_t stream) {
    static int grid = 0;
    if (grid == 0) {
        if (n_in != 31 || out_size != T * D || ws_size < WS_END) { fprintf(stderr, "kernel_launch: unexpected shapes (n_in %d out %d ws %zu)\n", n_in, out_size, ws_size); grid = -1; return; }
        int dev = 0, cus = 0, per_cu = 0;
        if (hipGetDevice(&dev) != hipSuccess || hipDeviceGetAttribute(&cus, hipDeviceAttributeMultiprocessorCount, dev) != hipSuccess) { grid = -1; return; }
        if (hipFuncSetAttribute((const void*)hymba_fwd, hipFuncAttributeMaxDynamicSharedMemorySize, LDS_BYTES) != hipSuccess) { fprintf(stderr, "kernel_launch: hipFuncSetAttribute failed\n"); grid = -1; return; }
        if (hipOccupancyMaxActiveBlocksPerMultiprocessor(&per_cu, (const void*)hymba_fwd, 512, LDS_BYTES) != hipSuccess || per_cu < 1) fprintf(stderr, "kernel_launch: occupancy query reports %d\n", per_cu);
        (void)hipGetLastError();
        grid = cus;
    }
    if (grid < 0) return;
    (void)hipMemsetAsync((char*)d_ws + WS_CTL, 0, CTL_ZERO_BYTES, stream);
    Args a{};
    for (int i = 0; i < 31; ++i) a.in[i] = (const float*)d_in[i];
    a.out = (float*)d_out; a.ws = (unsigned char*)d_ws;
#if MK_PER_PHASE
    for (int p = 0; p < NPH; ++p) { const int reps = ((PROBE_REP_MASK >> p) & 1) ? 2 : 1;
        for (int q = 0; q < reps; ++q) { a.ph_lo = p; a.ph_hi = p + 1; hipLaunchKernelGGL(hymba_fwd, dim3(grid), dim3(512), LDS_BYTES, stream, a); } }
#else
    a.ph_lo = 0; a.ph_hi = NPH; hipLaunchKernelGGL(hymba_fwd, dim3(grid), dim3(512), LDS_BYTES, stream, a);
#endif
}
```

```cpp
#include <hip/hip_runtime.h>
#include <cstdio>
#include <cstdint>

#ifndef PROBE_REP_MASK
#define PROBE_REP_MASK 0
#endif
#ifndef PB0
#define PB0 40
#endif
#ifndef PB0_S5
#define PB0_S5 28
#endif
#ifndef PB0_D
#define PB0_D 0
#endif
#ifndef PB1
#define PB1 0
#endif
#ifndef PB2
#define PB2 0
#endif
#ifndef PB4
#define PB4 0
#endif
#ifndef PB5
#define PB5 0
#endif
#ifndef PB11
#define PB11 0
#endif
#ifndef MK_PER_PHASE
#define MK_PER_PHASE 0
#endif

#define GAS __attribute__((address_space(1)))
#define LAS __attribute__((address_space(3)))
typedef unsigned short bf16;
typedef unsigned v4u __attribute__((ext_vector_type(4)));
typedef unsigned v2u __attribute__((ext_vector_type(2)));
typedef float f32x4 __attribute__((ext_vector_type(4)));
typedef float f32x16 __attribute__((ext_vector_type(16)));
typedef short bf16x8 __attribute__((ext_vector_type(8)));
typedef short bf16x4 __attribute__((ext_vector_type(4)));
typedef int v8i __attribute__((ext_vector_type(8)));
typedef int v4i_ __attribute__((ext_vector_type(4)));

constexpr int T = 16384, D = 2048, SEQ = 2048, NB = 8, INC = 2304, MEML = 256;
constexpr int NPH = 12;
constexpr float EPS = 1e-6f;
constexpr int NEXP = 64, DEXP = 512, LCAP = 16384;
constexpr int S5L = 32, S5K = 640;

constexpr size_t MiB = 1u << 20;
constexpr size_t WS_CTL = 0, CTL_ZERO_BYTES = 1 * MiB;
constexpr size_t WS_WIN = 2 * MiB, WS_WO = 11 * MiB, WS_WMKV = 19 * MiB, WS_WGLU = 23 * MiB;
constexpr size_t WS_MQ = 24 * MiB, WS_SP = 44 * MiB, WS_UA = 52 * MiB, WS_SL = 72 * MiB, WS_AL = 88 * MiB, WS_WR = 89 * MiB;
constexpr size_t WS_XN = 96 * MiB;
constexpr size_t WS_MEMN = 160 * MiB, WS_MEMKV = 168 * MiB;
constexpr size_t WS_PROJ = 176 * MiB;
constexpr size_t WS_MIX = 248 * MiB;
constexpr size_t WS_Y2 = 176 * MiB;
constexpr size_t WS_G = 312 * MiB;
constexpr size_t WS_LOG = 328 * MiB;
constexpr size_t WS_LIST = 344 * MiB;
constexpr size_t WS_WTS = 348 * MiB;
constexpr size_t WS_LP = 352 * MiB;
constexpr size_t WS_PART = 376 * MiB;
constexpr size_t WS_RSTD = 379 * MiB;
constexpr size_t WS_HIST = 380 * MiB;
constexpr size_t WS_X18 = 384 * MiB;
constexpr size_t WS_SS = 382 * MiB;
constexpr size_t WS_LRS = 452 * MiB;
constexpr size_t WS_LWT = 456 * MiB;
constexpr size_t WS_TOKE = 381 * MiB;
constexpr size_t WS_ACT = 544 * MiB;
constexpr size_t WS_WGU = 592 * MiB;
constexpr size_t WS_WD = 848 * MiB;
constexpr size_t WS_END = 976 * MiB;
constexpr int CW_CNT = 1024;
constexpr int CW_BAR = 4096;
constexpr int CW_QGU = 2048, CW_QD = 2112;

constexpr int RING_BYTES = 131072;
constexpr int TAB_OFF = 139264;
constexpr int XBW_OFF = TAB_OFF + 2048;
constexpr int LDS_BYTES = 147456;

#define LDS_WAIT() asm volatile("s_waitcnt lgkmcnt(0)" ::: "memory")
#define VM_WAIT() asm volatile("s_waitcnt vmcnt(0)" ::: "memory")
__device__ __forceinline__ unsigned f2bf(float f) { unsigned u = __builtin_bit_cast(unsigned, f); return (u + 0x7fffu + ((u >> 16) & 1u)) >> 16; }
__device__ __forceinline__ unsigned pk2(float lo, float hi) { unsigned r; asm volatile("v_cvt_pk_bf16_f32 %0, %1, %2" : "=v"(r) : "v"(lo), "v"(hi)); return r; }
__device__ __forceinline__ float bflo(unsigned w) { return __builtin_bit_cast(float, w << 16); }
__device__ __forceinline__ float bfhi(unsigned w) { return __builtin_bit_cast(float, w & 0xffff0000u); }
__device__ __forceinline__ float wave_sum(float v) {
#pragma unroll
    for (int o = 1; o < 64; o <<= 1) v += __shfl_xor(v, o);
    return v;
}
constexpr float SC_X = 4.0f, SC_WGU = 32.0f, SC_ACT = 16.0f, SC_WD = 16.0f, SC_Y = 64.0f;
__device__ __forceinline__ float clamp8(float v) { return fminf(fmaxf(v, -448.0f), 448.0f); }
__device__ __forceinline__ unsigned pk4_fp8(float a, float b, float c, float d) { unsigned w = 0u; w = (unsigned)__builtin_amdgcn_cvt_pk_fp8_f32(clamp8(a), clamp8(b), (int)w, false); w = (unsigned)__builtin_amdgcn_cvt_pk_fp8_f32(clamp8(c), clamp8(d), (int)w, true); return w; }
__device__ __forceinline__ float fast_exp(float x) { return __builtin_amdgcn_exp2f(x * 1.44269504089f); }
__device__ __forceinline__ float sigmoidf_(float x) { return __builtin_amdgcn_rcpf(1.0f + fast_exp(-x)); }
__device__ __forceinline__ float gelu_tanh(float x) { const float z = 1.5957691216f * (x + 0.044715f * x * x * x); return x * sigmoidf_(z); }

#define XB_TMO      128
#define XB_XCNT(j)  (256  + 64 * (j))
#define XB_XSUB(j)  (1280 + 64 * (j))
#define XB_XGEN(j)  (2304 + 64 * (j))
#define XB_TOP      3328
#define XB_TOPGEN   3392
#define XCD_BAR_WORDS 3456
#define XB_SPIN_CAP (1u << 18)
__device__ __forceinline__ unsigned xb_ld(unsigned* p)              { return __hip_atomic_load(p, __ATOMIC_RELAXED, __HIP_MEMORY_SCOPE_AGENT); }
__device__ __forceinline__ unsigned xb_add(unsigned* p, unsigned v) { return __hip_atomic_fetch_add(p, v, __ATOMIC_RELAXED, __HIP_MEMORY_SCOPE_AGENT); }
__device__ __forceinline__ unsigned xb_xcc_id() { return (unsigned)__builtin_amdgcn_s_getreg((3 << 11) | 20) & 0xFu; }
#define XB_SPIN(cond, bar) do { unsigned _sp = 0; while (cond) { __builtin_amdgcn_s_sleep(1); \
    if ((++_sp & 255u) == 0u) { if (xb_ld(&(bar)[XB_TMO])) break; if (_sp > XB_SPIN_CAP) { atomicAdd(&(bar)[XB_TMO], 1u); break; } } } } while (0)
struct XcdBarrier { unsigned* bar; unsigned x; volatile LAS unsigned* st; };
__device__ __forceinline__ XcdBarrier xcd_barrier_post(unsigned* bar, volatile LAS unsigned* st) {
    XcdBarrier b; b.bar = bar; b.x = xb_xcc_id(); b.st = st;
    if (threadIdx.x == 0) (void)xb_add(&bar[XB_XCNT(b.x)], 1u);
    return b;
}
__device__ __forceinline__ void xcd_barrier_complete(unsigned* bar, unsigned x, unsigned& nloc, unsigned& nx) {
    const unsigned G = gridDim.x * gridDim.y * gridDim.z;
    unsigned sum, cnt, mine, sp = 0u;
    for (;;) {
        sum = 0u; cnt = 0u; mine = 0u;
#pragma unroll
        for (unsigned j = 0; j < 16; ++j) { const unsigned c = xb_ld(&bar[XB_XCNT(j)]); sum += c; cnt += (c > 0u) ? 1u : 0u; mine = (j == x) ? c : mine; }
        if (sum == G) break;
        __builtin_amdgcn_s_sleep(1);
        if ((++sp & 255u) == 0u) { if (xb_ld(&bar[XB_TMO])) break; if (sp > XB_SPIN_CAP) { atomicAdd(&bar[XB_TMO], 1u); break; } }
    }
    nloc = mine > 0u ? mine : 1u; nx = cnt > 0u ? cnt : 1u;
}
__device__ __forceinline__ void xcd_barrier(const XcdBarrier& b) {
    asm volatile("s_waitcnt vmcnt(0)" ::: "memory");
    __syncthreads();
    if (threadIdx.x == 0) {
        unsigned* bar = b.bar;
        __builtin_amdgcn_s_waitcnt(0);
        unsigned nloc = b.st[0], nx = b.st[1];
        if (nloc == 0u) { xcd_barrier_complete(bar, b.x, nloc, nx); b.st[0] = nloc; b.st[1] = nx; }
        const unsigned old = xb_add(&bar[XB_XSUB(b.x)], 1u);
        const unsigned gen = old / nloc;
        if (old + 1u == (gen + 1u) * nloc) {
            __builtin_amdgcn_fence(__ATOMIC_RELEASE, "agent");
            asm volatile("s_waitcnt vmcnt(0)" ::: "memory");
            const unsigned og = xb_add(&bar[XB_TOP], 1u);
            const unsigned tg = og / nx;
            if (og + 1u == (tg + 1u) * nx) xb_add(&bar[XB_TOPGEN], 1u);
            else XB_SPIN(xb_ld(&bar[XB_TOPGEN]) == tg, bar);
            __builtin_amdgcn_fence(__ATOMIC_ACQUIRE, "agent");
            xb_add(&bar[XB_XGEN(b.x)], 1u);
            asm volatile("s_waitcnt vmcnt(0)" ::: "memory");
        } else {
            XB_SPIN(xb_ld(&bar[XB_XGEN(b.x)]) == gen, bar);
            __builtin_amdgcn_fence(__ATOMIC_ACQUIRE, "agent");
            asm volatile("s_waitcnt vmcnt(0)" ::: "memory");
        }
    }
    __syncthreads();
}

__device__ __forceinline__ int lane_now() { int l = (int)__builtin_amdgcn_mbcnt_hi(~0u, __builtin_amdgcn_mbcnt_lo(~0u, 0u)); asm volatile("" : "+v"(l)); return l; }
namespace pg8 {
constexpr int BM = 256, BK = 64, HALF = 128, HTB = HALF * BK * 2, STAGE_BYTES = 8 * HTB, NXCD = 8, WGM = 8;
__host__ __device__ __forceinline__ int lds_byte(int r, int c) { const int st = (r >> 4) * 2 + (c >> 5), rr = r & 15, cc = c & 31, ob = rr * 64 + cc * 2; return st * 1024 + (ob ^ (((ob >> 9) & 1) << 5)); }
__host__ __device__ __forceinline__ void stage_rc(int b, int& R, int& C) { const int st = b / 1024, sb = b % 1024, swz = sb ^ (((sb >> 9) & 1) << 5); R = (st >> 1) * 16 + swz / 64; C = (st & 1) * 32 + (swz % 64) / 2; }
__host__ __device__ __forceinline__ int perm32(int rho) { const int n = rho >> 4, i = rho & 15; return 8 * (i >> 2) + 4 * n + (i & 3); }

struct Unit { const char* a; const char* b; int r0, c0, aux, r1; };
struct Gemm { int lda, ldb, K; };

struct DenseOrder {
    const char* A; const char* Bt; int lda, ldb, nM, nN, nwg, G, c;
    __device__ void init(const void* A_, const void* Bt_, int lda_, int ldb_, int M, int N, int G_, int c_) { A = (const char*)A_; Bt = (const char*)Bt_; lda = lda_; ldb = ldb_; nM = M / BM; nN = N / BM; nwg = nM * nN; G = G_; c = c_; }
    __device__ bool next(int i, Unit& u) const {
        const long L = (long)i * G + c; if (L >= nwg) return false;
        int wgid = (int)L; { const int q = nwg / NXCD, r = nwg % NXCD, xcd = wgid % NXCD, off = wgid / NXCD; wgid = (xcd < r ? xcd * (q + 1) : r * (q + 1) + (xcd - r) * q) + off; }
        const int nig = WGM * nN, gid = wgid / nig, fm = gid * WGM, gsz = (nM - fm) < WGM ? (nM - fm) : WGM;
        const int pm = fm + ((wgid % nig) % gsz), pn = (wgid % nig) / gsz;
        u.a = A + (size_t)pm * BM * lda * 2; u.b = Bt + (size_t)pn * BM * ldb * 2; u.r0 = pm * BM; u.c0 = pn * BM; u.aux = 0; u.r1 = 0; return true;
    }
    __device__ __forceinline__ unsigned arow(const Unit&, int) const { return 0u; }
};
struct GroupOrder {
    const char* A; const char* Bt; int lda, ldb, nN, ngrp, G, c;
    __device__ bool next(int i, Unit& u) const {
        const int L = i * G + c; if (L >= ngrp * 2 * nN) return false;
        const int g = L / (2 * nN), q = L % (2 * nN), pn = q >> 1, pm = q & 1;
        u.a = A + ((size_t)g * 512 + pm * BM) * lda * 2; u.b = Bt + ((size_t)g * nN + pn) * BM * ldb * 2; u.r0 = pm * BM; u.c0 = pn * BM; u.aux = g; u.r1 = 0; return true;
    }
    __device__ __forceinline__ unsigned arow(const Unit&, int) const { return 0u; }
};
struct MoeOrder {
    const char* A; const char* Bt; const LAS int* cnt; const LAS int* ts; const int* list; int lda, ldb, nct, brows, G, c; bool gather;
    __device__ bool next(int i, Unit& u) const {
        const int L = i * G + c; const int lane = lane_now();
        int i64 = 64; asm volatile("" : "+v"(i64));
        if (L >= __builtin_amdgcn_readfirstlane(ts[i64]) * nct) return false;
        const int lo = ts[lane] * nct, hi = ts[lane + 1] * nct;
        const unsigned long long m = __ballot(lo <= L && L < hi);
        const int e = __builtin_amdgcn_readfirstlane((int)__builtin_ctzll(m));
        const int tse = ts[e], ne = ts[e + 1] - tse, q = L - tse * nct, ct = q / ne, rt = q % ne;
        u.a = gather ? A : A + (size_t)(tse + rt) * BM * lda * 2; u.b = Bt + ((size_t)e * brows + (size_t)ct * BM) * ldb * 2;
        u.r0 = (tse + rt) * BM; u.r1 = rt * BM; u.c0 = ct; u.aux = e; return true;
    }
    __device__ __forceinline__ unsigned arow(const Unit& u, int r) const {
        const int n = cnt[u.aux]; int rr = u.r1 + r; rr = rr < n ? rr : n - 1;
        return (unsigned)(list[(size_t)u.aux * LCAP + rr] >> 1) * (unsigned)(lda * 2);
    }
};

#define EPI_ROWS_COLS() const int rowb = wr * 64 + fr; (void)rowb;

template <class Epi, class Sched, bool GATHER = false, bool FP8 = false, bool KSEG = false>
__device__ __forceinline__ void gemm_phase(LAS unsigned char* lds, const Gemm g, const Sched& S, const Epi& E, const int wave_id, const float* ssq = nullptr) {
    int lane = (int)__builtin_amdgcn_mbcnt_hi(~0u, __builtin_amdgcn_mbcnt_lo(~0u, 0u)); asm volatile("" : "+v"(lane));
    const int wid = wave_id, tid = wid * 64 + lane, wr = wid >> 2, wc = wid & 3, fr = lane & 15, fq = lane >> 4;
    const int K = g.K; int nt = K / BK; asm volatile("" : "+s"(nt));
    unsigned voffB;
    { int R, C; stage_rc(tid * 16, R, C); const int Rb = Epi::PERM ? ((R & ~31) + perm32(R & 31)) : R; voffB = (unsigned)(Rb * g.ldb + C) * 2u; }
    const int soffB = 64 * g.ldb * 2, soffA = 64 * g.lda * 2;
#define PG8_RC(i, R, C) int R, C; { int _t = tid; asm volatile("" : "+v"(_t)); stage_rc(_t * 16 + (i) * 8192, R, C); }
#define nxoff ((LAS v4u*)(lds + 131072) + (wid * 64 + lane_now()))
    const size_t kstep = (size_t)(BK * 2);
    const size_t hstepB = (size_t)HALF * g.ldb * 2;
    const unsigned ldsw = (unsigned)wid * 1024u;
    const int aoff = lds_byte(wr * 64 + fr, fq * 8), boff = lds_byte(wc * 32 + fr, fq * 8);
#define PG8_SA(b, h) (((b) * 2 + (h)) * HTB)
#define PG8_SB(b, h) ((4 + (b) * 2 + (h)) * HTB)
#define PG8_RSRC(p) __builtin_amdgcn_make_buffer_rsrc((void*)(p), 0, 0xffffffff, 0x00020000)
#define PG8_STAGE(bufoff, gbase, voff) do { const __amdgpu_buffer_rsrc_t _r = PG8_RSRC(gbase); \
        __builtin_amdgcn_raw_ptr_buffer_load_lds(_r, (LAS void*)(lds + (bufoff) + ldsw), 16, (int)(voff), 0, 0, 0); \
        __builtin_amdgcn_raw_ptr_buffer_load_lds(_r, (LAS void*)(lds + (bufoff) + ldsw + 8192), 16, (int)(voff), soffB, 0, 0); } while (0)
#define PG8_STAGEA(bufoff, gbase, o0, o1, h) do { const __amdgpu_buffer_rsrc_t _r = PG8_RSRC(gbase); \
        if constexpr (GATHER) { __builtin_amdgcn_raw_ptr_buffer_load_lds(_r, (LAS void*)(lds + (bufoff) + ldsw), 16, (int)(o0), 0, 0, 0); \
                                __builtin_amdgcn_raw_ptr_buffer_load_lds(_r, (LAS void*)(lds + (bufoff) + ldsw + 8192), 16, (int)(o1), 0, 0, 0); } \
        else { __builtin_amdgcn_raw_ptr_buffer_load_lds(_r, (LAS void*)(lds + (bufoff) + ldsw), 16, (int)c00, (h) * 2 * soffA, 0, 0); \
               __builtin_amdgcn_raw_ptr_buffer_load_lds(_r, (LAS void*)(lds + (bufoff) + ldsw + 8192), 16, (int)c00, (h) * 2 * soffA + soffA, 0, 0); } } while (0)
#define PG8_LDA(dst, b, h) do { _Pragma("unroll") for (int m = 0; m < 4; ++m) { \
        if constexpr (FP8) { dst##8[m].lo = *(const LAS v4i_*)(lds + PG8_SA(b, h) + aoff + m * 2048); dst##8[m].hi = *(const LAS v4i_*)(lds + PG8_SA(b, h) + aoff + m * 2048 + 1024); } \
        else { _Pragma("unroll") for (int k = 0; k < 2; ++k) dst[m][k] = *(const LAS bf16x8*)(lds + PG8_SA(b, h) + aoff + m * 2048 + k * 1024); } } } while (0)
#define PG8_LDB(dst, b, h) do { _Pragma("unroll") for (int n = 0; n < 2; ++n) { \
        if constexpr (FP8) { dst##8[n].lo = *(const LAS v4i_*)(lds + PG8_SB(b, h) + boff + n * 2048); dst##8[n].hi = *(const LAS v4i_*)(lds + PG8_SB(b, h) + boff + n * 2048 + 1024); } \
        else { _Pragma("unroll") for (int k = 0; k < 2; ++k) dst[n][k] = *(const LAS bf16x8*)(lds + PG8_SB(b, h) + boff + n * 2048 + k * 1024); } } } while (0)
#define PG8_MMA(ai, bj, At, Bt) do { __builtin_amdgcn_s_setprio(1); _Pragma("unroll") for (int m = 0; m < 4; ++m) _Pragma("unroll") for (int n = 0; n < 2; ++n) { \
        if constexpr (FP8) { acc[ai][bj][m][n] = __builtin_amdgcn_mfma_scale_f32_16x16x128_f8f6f4(Bt##8[n], At##8[m], acc[ai][bj][m][n], 0, 0, 0, 0x7f7f7f7f, 0, 0x7f7f7f7f); } \
        else { _Pragma("unroll") for (int k = 0; k < 2; ++k) acc[ai][bj][m][n] = __builtin_amdgcn_mfma_f32_16x16x32_bf16(Bt[n][k], At[m][k], acc[ai][bj][m][n], 0, 0, 0); } } \
        __builtin_amdgcn_s_setprio(0); } while (0)
#define PG8_WAIT_V(n) asm volatile("s_waitcnt vmcnt(" #n ")" ::: "memory")
#define PG8_WAIT_L(n) asm volatile("s_waitcnt lgkmcnt(" #n ")" ::: "memory")
#define PG8_BAR __builtin_amdgcn_s_barrier()
#define PG8_SCHED __builtin_amdgcn_sched_barrier(0)
    LAS f32x4* scl = (LAS f32x4*)(lds + 131072);
#define PG8_FILL_SCL(u) do { if constexpr (KSEG) { if (tid < 256) { const f32x4* sp = (const f32x4*)(ssq + (size_t)((u).r0 + tid) * 32); \
        const f32x4 p0 = sp[0], p1 = sp[1], p2 = sp[2], p3 = sp[3], p4 = sp[4], p5 = sp[5], p6 = sp[6]; \
        const float sa = (((p0[0] + p0[1]) + (p0[2] + p0[3])) + ((p1[0] + p1[1]) + (p1[2] + p1[3]))) + (((p2[0] + p2[1]) + (p2[2] + p2[3])) + ((p3[0] + p3[1]) + (p3[2] + p3[3]))); \
        const float sb = ((p4[0] + p4[1]) + (p4[2] + p4[3])) + ((p5[0] + p5[1]) + (p5[2] + p5[3])), sc = (p6[0] + p6[1]) + (p6[2] + p6[3]); \
        const float ra = 1.0f / sqrtf(sa * (1.f / 1024.f) + EPS), rb = 1.0f / sqrtf(sb * (1.f / 512.f) + EPS), rc = 1.0f / sqrtf(sc * (1.f / 512.f) + EPS); \
        scl[(ui & 1) * 256 + tid] = (f32x4){ra / rb, rb / rc, rc, 0.f}; } } } while (0)
#define PG8_SCALE(k) do { _Pragma("unroll") for (int _ai = 0; _ai < 2; ++_ai) _Pragma("unroll") for (int _m = 0; _m < 4; ++_m) { const float _f = ((const LAS float*)scl)[((ui & 1) * 256 + _ai * HALF + wr * 64 + _m * 16 + fr) * 4 + (k)]; \
        _Pragma("unroll") for (int _bj = 0; _bj < 2; ++_bj) _Pragma("unroll") for (int _n = 0; _n < 2; ++_n) acc[_ai][_bj][_m][_n] = acc[_ai][_bj][_m][_n] * _f; } } while (0)
    Unit cur, nxt; int ui = 0;
    if (!S.next(0, cur)) return;
    PG8_FILL_SCL(cur);
    f32x4 acc[2][2][4][2];
#pragma unroll
    for (int a = 0; a < 2; ++a)
#pragma unroll
        for (int b = 0; b < 2; ++b)
#pragma unroll
            for (int m = 0; m < 4; ++m)
#pragma unroll
                for (int n = 0; n < 2; ++n) acc[a][b][m][n] = (f32x4){0.f, 0.f, 0.f, 0.f};
    bf16x8 At[4][2], B0[2][2], B1[2][2]; v8i At8[4], B08[2], B18[2];
    const char* cA = cur.a; const char* cB = cur.b;
    unsigned c00, c01, c10, c11;
    { PG8_RC(0, R0, C0); PG8_RC(1, R1, C1);
      if constexpr (GATHER) {
        c00 = S.arow(cur, R0) + C0 * 2u; c01 = S.arow(cur, R1) + C1 * 2u; c10 = S.arow(cur, HALF + R0) + C0 * 2u; c11 = S.arow(cur, HALF + R1) + C1 * 2u;
        asm volatile("s_waitcnt vmcnt(0)" : "+v"(c00), "+v"(c01), "+v"(c10), "+v"(c11) :: "memory");
      } else {
        c00 = (unsigned)(R0 * g.lda + C0) * 2u; c01 = c00; c10 = c00; c11 = c00; (void)R1; (void)C1;
      } }
    PG8_STAGE(PG8_SB(0, 0), cB, voffB); PG8_STAGE(PG8_SB(0, 1), cB + hstepB, voffB); PG8_STAGEA(PG8_SA(0, 0), cA, c00, c01, 0); PG8_STAGEA(PG8_SA(0, 1), cA, c10, c11, 1);
    if (wr == 1) PG8_BAR;
    PG8_WAIT_V(2); PG8_BAR;
    PG8_STAGE(PG8_SB(1, 0), cB + kstep, voffB); PG8_STAGEA(PG8_SA(1, 0), cA + kstep, c00, c01, 0); PG8_STAGE(PG8_SB(1, 1), cB + hstepB + kstep, voffB);
    PG8_WAIT_V(6); PG8_BAR;
#define PG8_KITER(t) do { \
            const bool last = (t == nt - 2); \
            const char* a1 = cA + (size_t)(t + 1) * kstep; \
            const char* a2 = last ? nA : cA + (size_t)(t + 2) * kstep; const char* b2 = last ? nB : cB + (size_t)(t + 2) * kstep; \
            const char* a3 = a2 + kstep; const char* b3 = b2 + kstep; \
            unsigned x00 = c00, x01 = c01, x10 = c10, x11 = c11; \
            if constexpr (GATHER) { if (last) { const v4u nv = *nxoff; x00 = nv.x; x01 = nv.y; x10 = nv.z; x11 = nv.w; } } \
 \
            PG8_LDB(B0, 0, 0); PG8_LDB(B1, 0, 1); PG8_SCHED; PG8_LDA(At, 0, 0); PG8_STAGEA(PG8_SA(1, 1), a1, c10, c11, 1); \
            PG8_WAIT_V(8); PG8_WAIT_L(0); PG8_BAR; PG8_MMA(0, 0, At, B0); PG8_MMA(0, 1, At, B1); PG8_BAR; PG8_SCHED; \
 \
            PG8_LDA(At, 0, 1); PG8_STAGE(PG8_SB(0, 0), b2, voffB); PG8_STAGE(PG8_SB(0, 1), b2 + hstepB, voffB); PG8_STAGEA(PG8_SA(0, 0), a2, x00, x01, 0); \
            PG8_WAIT_V(8); PG8_WAIT_L(0); PG8_BAR; PG8_MMA(1, 0, At, B0); PG8_MMA(1, 1, At, B1); PG8_BAR; PG8_SCHED; \
 \
            PG8_LDB(B0, 1, 0); PG8_LDB(B1, 1, 1); PG8_SCHED; PG8_LDA(At, 1, 0); PG8_STAGEA(PG8_SA(0, 1), a2, x10, x11, 1); \
            PG8_WAIT_V(8); PG8_WAIT_L(0); PG8_BAR; PG8_MMA(0, 0, At, B0); PG8_MMA(0, 1, At, B1); PG8_BAR; PG8_SCHED; \
 \
            PG8_LDA(At, 1, 1); PG8_STAGE(PG8_SB(1, 0), b3, voffB); PG8_STAGE(PG8_SB(1, 1), b3 + hstepB, voffB); PG8_STAGEA(PG8_SA(1, 0), a3, x00, x01, 0); \
            PG8_WAIT_V(8); PG8_WAIT_L(0); PG8_BAR; PG8_MMA(1, 0, At, B0); PG8_MMA(1, 1, At, B1); PG8_BAR; PG8_SCHED; \
        } while (0)
    for (;;) {
        const bool has_next = S.next(ui + 1, nxt);
        const char* nA = has_next ? nxt.a : cA; const char* nB = has_next ? nxt.b : cB;
        if constexpr (GATHER) {
            unsigned n00 = c00, n01 = c01, n10 = c10, n11 = c11;
            if (has_next) { PG8_RC(0, R0, C0); PG8_RC(1, R1, C1); n00 = S.arow(nxt, R0) + C0 * 2u; n01 = S.arow(nxt, R1) + C1 * 2u; n10 = S.arow(nxt, HALF + R0) + C0 * 2u; n11 = S.arow(nxt, HALF + R1) + C1 * 2u; }
            asm volatile("s_waitcnt vmcnt(0)" : "+v"(n00), "+v"(n01), "+v"(n10), "+v"(n11) :: "memory");
            v4u nv; nv.x = n00; nv.y = n01; nv.z = n10; nv.w = n11; *nxoff = nv;
        }
        if constexpr (KSEG) {
#pragma unroll 1
            for (int t = 0; t < 16; t += 2) PG8_KITER(t);
            PG8_SCALE(0);
#pragma unroll 1
            for (int t = 16; t < 24; t += 2) PG8_KITER(t);
            PG8_SCALE(1);
#pragma unroll 1
            for (int t = 24; t < nt; t += 2) PG8_KITER(t);
        } else {
#pragma unroll 1
            for (int t = 0; t < nt; t += 2) PG8_KITER(t);
        }
        if (wr == 0) PG8_BAR;
        if constexpr (KSEG) PG8_SCALE(2);
        { const int le = lane_now(); E(acc, cur, wr, wc, le & 15, le >> 4); }
        if (!has_next) break;
#pragma unroll
        for (int a = 0; a < 2; ++a)
#pragma unroll
            for (int b = 0; b < 2; ++b)
#pragma unroll
                for (int m = 0; m < 4; ++m)
#pragma unroll
                    for (int n = 0; n < 2; ++n) acc[a][b][m][n] = (f32x4){0.f, 0.f, 0.f, 0.f};
        cur = nxt; cA = nA; cB = nB; ++ui;
        if constexpr (KSEG) { PG8_WAIT_L(0); PG8_FILL_SCL(cur); }
        if constexpr (GATHER) { const v4u nv = *nxoff; c00 = nv.x; c01 = nv.y; c10 = nv.z; c11 = nv.w; }
        if (wr == 1) PG8_BAR;
    }
    PG8_WAIT_V(0);
    PG8_BAR;
#undef PG8_RC
#undef PG8_KITER
#undef PG8_FILL_SCL
#undef PG8_SCALE
#undef nxoff
#undef PG8_SA
#undef PG8_SB
#undef PG8_STAGE
#undef PG8_STAGEA
#undef PG8_LDA
#undef PG8_LDB
#undef PG8_MMA
#undef PG8_WAIT_V
#undef PG8_WAIT_L
#undef PG8_BAR
#undef PG8_SCHED
}

typedef const f32x4 (&AccRef)[2][2][4][2];
__device__ __forceinline__ v4u pack8(const f32x4 a, const f32x4 b) { v4u w; w.x = pk2(a[0], a[1]); w.y = pk2(a[2], a[3]); w.z = pk2(b[0], b[1]); w.w = pk2(b[2], b[3]); return w; }

struct EpiProj {
    static constexpr bool PERM = true;
    bf16* PROJ; bf16* UA;
    __device__ __forceinline__ void operator()(AccRef acc, const Unit& u, int wr, int wc, int fr, int fq) const {
        const int row0 = u.r0 + wr * 64 + fr, colb = u.c0 + wc * 32 + 8 * fq;
        const bool isu = (u.c0 == 1280 || u.c0 == 1536);
#pragma unroll
        for (int ai = 0; ai < 2; ++ai)
#pragma unroll
            for (int m = 0; m < 4; ++m) { const int row = row0 + ai * HALF + m * 16;
#pragma unroll
                for (int bj = 0; bj < 2; ++bj) { const int col = colb + bj * HALF; const v4u w = pack8(acc[ai][bj][m][0], acc[ai][bj][m][1]);
                    if (!isu) *(v4u*)(PROJ + (size_t)row * INC + col) = w;
                    else { const int cc = col - 1280, g = cc >> 4, c0 = cc & 15; *(v4u*)(UA + ((size_t)(g * 512 + (row >> 5)) * S5K + (row & 31) * 16 + c0)) = w; } } }
    }
};
struct EpiBf16 {
    static constexpr bool PERM = true;
    bf16* O; int ldc;
    __device__ __forceinline__ void operator()(AccRef acc, const Unit& u, int wr, int wc, int fr, int fq) const {
        const int row0 = u.r0 + wr * 64 + fr, colb = u.c0 + wc * 32 + 8 * fq;
#pragma unroll
        for (int ai = 0; ai < 2; ++ai)
#pragma unroll
            for (int m = 0; m < 4; ++m) { bf16* rowp = O + (size_t)(row0 + ai * HALF + m * 16) * ldc + colb;
#pragma unroll
                for (int bj = 0; bj < 2; ++bj) *(v4u*)(rowp + bj * HALF) = pack8(acc[ai][bj][m][0], acc[ai][bj][m][1]); }
    }
};
struct EpiF32 {
    static constexpr bool PERM = false;
    float* C; int ldc; size_t gstride;
    __device__ __forceinline__ void operator()(AccRef acc, const Unit& u, int wr, int wc, int fr, int fq) const {
        const int row0 = u.r0 + wr * 64 + fr, col0 = u.c0 + wc * 32 + 4 * fq; float* base = C + (size_t)u.aux * gstride;
#pragma unroll
        for (int ai = 0; ai < 2; ++ai)
#pragma unroll
            for (int m = 0; m < 4; ++m) { float* rowp = base + (size_t)(row0 + ai * HALF + m * 16) * ldc + col0;
#pragma unroll
                for (int bj = 0; bj < 2; ++bj)
#pragma unroll
                    for (int n = 0; n < 2; ++n) *(f32x4*)(rowp + bj * HALF + n * 16) = acc[ai][bj][m][n]; }
    }
};
struct EpiS5Y {
    static constexpr bool PERM = true;
    const bf16* UA; const float* dsk; bf16* Gm;
    __device__ __forceinline__ void operator()(AccRef acc, const Unit& u, int wr, int wc, int fr, int fq) const {
        const int row0 = u.r0 + wr * 64 + fr, colb = u.c0 + wc * 32 + 8 * fq, g = u.aux;
#pragma unroll
        for (int ai = 0; ai < 2; ++ai)
#pragma unroll
            for (int m = 0; m < 4; ++m) { const int row = row0 + ai * HALF + m * 16;
#pragma unroll
                for (int bj = 0; bj < 2; ++bj) { const int col = colb + bj * HALF, i = col >> 4, c0 = col & 15;
                    const v4u uw = *(const v4u*)(UA + ((size_t)(g * 512 + row) * S5K + col));
                    const f32x4 d0 = *(const f32x4*)(dsk + g * 16 + c0), d1 = *(const f32x4*)(dsk + g * 16 + c0 + 4);
                    const f32x4 a0 = acc[ai][bj][m][0], a1 = acc[ai][bj][m][1];
                    f32x4 y0, y1;
                    y0[0] = gelu_tanh(a0[0] + d0[0] * bflo(uw.x)); y0[1] = gelu_tanh(a0[1] + d0[1] * bfhi(uw.x)); y0[2] = gelu_tanh(a0[2] + d0[2] * bflo(uw.y)); y0[3] = gelu_tanh(a0[3] + d0[3] * bfhi(uw.y));
                    y1[0] = gelu_tanh(a1[0] + d1[0] * bflo(uw.z)); y1[1] = gelu_tanh(a1[1] + d1[1] * bfhi(uw.z)); y1[2] = gelu_tanh(a1[2] + d1[2] * bflo(uw.w)); y1[3] = gelu_tanh(a1[3] + d1[3] * bfhi(uw.w));
                    *(v4u*)(Gm + ((size_t)row * 32 + i) * 512 + g * 16 + c0) = pack8(y0, y1); } }
    }
};
struct EpiGlu {
    static constexpr bool PERM = true;
    const bf16* Gm; bf16* MIX; float* SS;
    __device__ __forceinline__ void operator()(AccRef acc, const Unit& u, int wr, int wc, int fr, int fq) const {
        const int row0 = u.r0 + wr * 64 + fr, colb = u.c0 + wc * 32 + 8 * fq;
#pragma unroll
        for (int ai = 0; ai < 2; ++ai)
#pragma unroll
            for (int m = 0; m < 4; ++m) { const int row = row0 + ai * HALF + m * 16; float ss = 0.f;
#pragma unroll
                for (int bj = 0; bj < 2; ++bj) { const int col = colb + bj * HALF;
                    const v4u gw = *(const v4u*)(Gm + (size_t)row * 512 + col);
                    const f32x4 a0 = acc[ai][bj][m][0], a1 = acc[ai][bj][m][1];
                    f32x4 y0, y1;
                    y0[0] = bflo(gw.x) * sigmoidf_(a0[0]); y0[1] = bfhi(gw.x) * sigmoidf_(a0[1]); y0[2] = bflo(gw.y) * sigmoidf_(a0[2]); y0[3] = bfhi(gw.y) * sigmoidf_(a0[3]);
                    y1[0] = bflo(gw.z) * sigmoidf_(a1[0]); y1[1] = bfhi(gw.z) * sigmoidf_(a1[1]); y1[2] = bflo(gw.w) * sigmoidf_(a1[2]); y1[3] = bfhi(gw.w) * sigmoidf_(a1[3]);
                    ss += ((y0[0] * y0[0] + y0[1] * y0[1]) + (y0[2] * y0[2] + y0[3] * y0[3])) + ((y1[0] * y1[0] + y1[1] * y1[1]) + (y1[2] * y1[2] + y1[3] * y1[3]));
                    *(v4u*)(MIX + (size_t)row * D + 1024 + col) = pack8(y0, y1); }
                ss += __shfl_xor(ss, 16); ss += __shfl_xor(ss, 32);
                if (fq == 0) SS[(size_t)row * 32 + 16 + (u.c0 >> 8) * 4 + wc] = ss; }
    }
};
struct EpiWo {
    static constexpr bool PERM = true;
    const float* X; bf16* X1B; unsigned char* X18; float* part;
    __device__ __forceinline__ void operator()(AccRef acc, const Unit& u, int wr, int wc, int fr, int fq) const {
        const int row0 = u.r0 + wr * 64 + fr, col0 = u.c0 + wc * 32 + 8 * fq;
#pragma unroll
        for (int ai = 0; ai < 2; ++ai)
#pragma unroll
          for (int mh = 0; mh < 2; ++mh) {
            f32x4 xv[2][2][2];
#pragma unroll
            for (int m = 0; m < 2; ++m)
#pragma unroll
                for (int bj = 0; bj < 2; ++bj)
#pragma unroll
                    for (int n = 0; n < 2; ++n) xv[m][bj][n] = __builtin_nontemporal_load((const f32x4*)(X + (size_t)(row0 + ai * HALF + (mh * 2 + m) * 16) * D + col0 + bj * HALF + n * 4));
#pragma unroll
            for (int m2 = 0; m2 < 2; ++m2) { const int m = mh * 2 + m2; const int row = row0 + ai * HALF + m * 16; const size_t off = (size_t)row * D + col0; float ss = 0.f;
#pragma unroll
                for (int bj = 0; bj < 2; ++bj) { const f32x4 v0 = xv[m2][bj][0] + acc[ai][bj][m][0], v1 = xv[m2][bj][1] + acc[ai][bj][m][1];
                    ss += ((v0[0] * v0[0] + v0[1] * v0[1]) + (v0[2] * v0[2] + v0[3] * v0[3])) + ((v1[0] * v1[0] + v1[1] * v1[1]) + (v1[2] * v1[2] + v1[3] * v1[3]));
                    *(v4u*)(X1B + off + bj * HALF) = pack8(v0, v1);
                    v2u w8; w8.x = pk4_fp8(v0[0] * SC_X, v0[1] * SC_X, v0[2] * SC_X, v0[3] * SC_X); w8.y = pk4_fp8(v1[0] * SC_X, v1[1] * SC_X, v1[2] * SC_X, v1[3] * SC_X);
                    *(v2u*)(X18 + off + bj * HALF) = w8; }
                ss += __shfl_xor(ss, 16); ss += __shfl_xor(ss, 32);
                if (fq == 0) part[(size_t)row * 32 + (u.c0 >> 8) * 4 + wc] = ss; }
            asm volatile("" ::: "memory");
          }
    }
};
struct EpiLogit {
    static constexpr bool PERM = false;
    float* LP;
    __device__ __forceinline__ void operator()(AccRef acc, const Unit& u, int wr, int wc, int fr, int fq) const {
        const int row0 = u.r0 + wr * 64 + fr, col0 = wc * 32 + 4 * fq; float* base = LP + (size_t)u.aux * T * 80;
#pragma unroll
        for (int ai = 0; ai < 2; ++ai)
#pragma unroll
            for (int m = 0; m < 4; ++m) { float* rowp = base + (size_t)(row0 + ai * HALF + m * 16) * 80 + col0;
#pragma unroll
                for (int n = 0; n < 2; ++n) if (col0 + n * 16 < 80) *(f32x4*)(rowp + n * 16) = acc[ai][0][m][n]; }
    }
};
struct EpiGU {
    static constexpr bool PERM = true;
    const int* list; const float* rstd; const LAS int* cnt; unsigned char* ACT;
    __device__ __forceinline__ void operator()(AccRef acc, const Unit& u, int wr, int wc, int fr, int fq) const {
        const int e = u.aux, nreal = cnt[e], rb = wr * 64 + fr, colb = u.c0 * 128 + wc * 32 + 8 * fq;
#pragma unroll
        for (int ai = 0; ai < 2; ++ai)
#pragma unroll
            for (int m = 0; m < 4; ++m) { const int r = rb + ai * HALF + m * 16; int rr = u.r1 + r; rr = rr < nreal ? rr : nreal - 1;
                const float rs = rstd[(size_t)e * LCAP + rr] * (1.0f / (SC_X * SC_WGU));
                f32x4 y0, y1;
#pragma unroll
                for (int j = 0; j < 4; ++j) { const float g0 = acc[ai][0][m][0][j] * rs, g1 = acc[ai][0][m][1][j] * rs;
                    y0[j] = g0 * sigmoidf_(g0) * (acc[ai][1][m][0][j] * rs) * SC_ACT; y1[j] = g1 * sigmoidf_(g1) * (acc[ai][1][m][1][j] * rs) * SC_ACT; }
                v2u w8; w8.x = pk4_fp8(y0[0], y0[1], y0[2], y0[3]); w8.y = pk4_fp8(y1[0], y1[1], y1[2], y1[3]);
                *(v2u*)(ACT + (size_t)(u.r0 + r) * DEXP + colb) = w8; }
    }
};
struct EpiDown {
    static constexpr bool PERM = true;
    const int* list; const float* wts; const LAS int* cnt; unsigned char* Y2;
    __device__ __forceinline__ void operator()(AccRef acc, const Unit& u, int wr, int wc, int fr, int fq) const {
        const int e = u.aux, n = cnt[e], row0 = u.r1 + wr * 64 + fr, colb = u.c0 * 256 + wc * 32 + 8 * fq;
#pragma unroll
        for (int ai = 0; ai < 2; ++ai)
#pragma unroll
            for (int m = 0; m < 4; ++m) { const int r = row0 + ai * HALF + m * 16;
                if (r < n) { const int ent = list[(size_t)e * LCAP + r]; const float w = wts[(size_t)e * LCAP + r] * (SC_Y / (SC_ACT * SC_WD));   unsigned char* rowp = Y2 + (size_t)ent * D + colb;
#pragma unroll
                    for (int bj = 0; bj < 2; ++bj) { const f32x4 a0 = acc[ai][bj][m][0] * w, a1 = acc[ai][bj][m][1] * w; v2u w8; w8.x = pk4_fp8(a0[0], a0[1], a0[2], a0[3]); w8.y = pk4_fp8(a1[0], a1[1], a1[2], a1[3]);
                        *(v2u*)(rowp + bj * HALF) = w8; } } }
    }
};
struct KSplitOrder {
    const char* A; const char* Bt; int lda, ldb, K, nM, nks, G, c;
    __device__ bool next(int i, Unit& u) const {
        const int L = i * G + c; if (L >= nM * nks) return false;
        const int pm = L / nks, ks = L % nks;
        u.a = A + ((size_t)pm * BM * lda + (size_t)ks * K) * 2; u.b = Bt + (size_t)ks * BM * ldb * 2; u.r0 = pm * BM; u.c0 = 0; u.aux = ks; u.r1 = 0; return true;
    }
    __device__ __forceinline__ unsigned arow(const Unit&, int) const { return 0u; }
};
}

struct Frame {
    LAS unsigned char* lds;
    unsigned* ctl;
    int tid, lane, wave, vcu, G;
    const float* const __attribute__((address_space(4)))* in;
    float* out; unsigned char* ws;
};
enum { I_X = 0, I_MEM, I_NORM_MIX, I_W_IN, I_Q_NORM, I_K_NORM, I_SINKS, I_REL_BIAS, I_LAM_RE, I_LAM_IM, I_LOG_DT, I_B_RE, I_B_IM, I_C_RE, I_C_IM, I_SSM_D, I_W_GLU,
       I_MEM_NORM, I_W_MEM_KV, I_XQ_NORM, I_XK_NORM, I_ON_ATTN, I_ON_SSM, I_ON_X, I_W_O, I_NORM_FFN, I_WR_G, I_WR_E, I_W_GATE, I_W_UP, I_W_DOWN };

struct TrItem { const float* W; bf16* WT; const float* ks; int ldw, ldt, k0, n0, drow0; };
__device__ __forceinline__ void tr_load(const TrItem& it, f32x4 (&v)[8], int lane) {
    const int kc = lane & 7, nq = lane >> 3; const float* src = it.W + (size_t)(it.k0 + kc * 8) * it.ldw + it.n0 + nq * 4;
#pragma unroll
    for (int j = 0; j < 8; ++j) v[j] = __builtin_nontemporal_load((const f32x4*)(src + (size_t)j * it.ldw));
}
__device__ __forceinline__ void tr_store(const TrItem& it, f32x4 (&v)[8], int lane) {
    const int kc = lane & 7, nq = lane >> 3;
    if (it.ks) { const f32x4 s0 = *(const f32x4*)(it.ks + it.k0 + kc * 8), s1 = *(const f32x4*)(it.ks + it.k0 + kc * 8 + 4);
#pragma unroll
        for (int j = 0; j < 4; ++j) { v[j] = v[j] * s0[j]; v[4 + j] = v[4 + j] * s1[j]; } }
#pragma unroll
    for (int i = 0; i < 4; ++i) { v4u o; o.x = pk2(v[0][i], v[1][i]); o.y = pk2(v[2][i], v[3][i]); o.z = pk2(v[4][i], v[5][i]); o.w = pk2(v[6][i], v[7][i]);
        *(v4u*)(it.WT + (size_t)(it.drow0 + nq * 4 + i) * it.ldt + it.k0 + kc * 8) = o; }
}
__device__ __forceinline__ void rms_row_to_bf16(const float* xrow, const float* gain, bf16* orow, int lane) {
    const f32x4* xr = (const f32x4*)xrow + lane; const f32x4* gr = (const f32x4*)gain + lane;
    f32x4 v[8]; float s = 0.f;
#pragma unroll
    for (int j = 0; j < 8; ++j) { v[j] = xr[64 * j]; s += (v[j].x * v[j].x + v[j].y * v[j].y) + (v[j].z * v[j].z + v[j].w * v[j].w); }
    const float rstd = 1.0f / sqrtf(wave_sum(s) * (1.f / 2048.f) + EPS);
    v2u* o8 = (v2u*)orow + lane;
#pragma unroll
    for (int j = 0; j < 8; ++j) { const f32x4 g = gr[64 * j]; v2u w; w.x = pk2(v[j].x * rstd * g.x, v[j].y * rstd * g.y); w.y = pk2(v[j].z * rstd * g.z, v[j].w * rstd * g.w); o8[64 * j] = w; }
}

__device__ __forceinline__ void s5_tables(Frame& F, int g) {
    LAS float* ap = (LAS float*)F.lds;
    LAS float* Bb = ap + 33 * 64 * 2;
    LAS float* Cc = Bb + 64 * 16 * 2;
    LAS float* Km = Cc + 16 * 64 * 2;
    const float dt = expf(F.in[I_LOG_DT][g]);
    const float* lre = F.in[I_LAM_RE] + g * 64; const float* lim = F.in[I_LAM_IM] + g * 64;
    for (int idx = F.tid; idx < 33 * 64; idx += 512) { const int tau = idx >> 6, n = idx & 63; const float lr = lre[n], li = lim[n];
        const float mag = expf((float)tau * (lr * dt)), ang = (float)tau * (li * dt); ap[idx * 2] = mag * cosf(ang); ap[idx * 2 + 1] = mag * sinf(ang); }
    __syncthreads();
    for (int idx = F.tid; idx < 64 * 16; idx += 512) { const int n = idx >> 4; const float lr = lre[n], li = lim[n];
        const float nr = ap[(64 + n) * 2] - 1.0f, ni = ap[(64 + n) * 2 + 1], den = lr * lr + li * li;
        const float cr = (nr * lr + ni * li) / den, ci = (ni * lr - nr * li) / den;
        const float br = F.in[I_B_RE][(size_t)g * 1024 + idx], bi = F.in[I_B_IM][(size_t)g * 1024 + idx];
        Bb[idx * 2] = cr * br - ci * bi; Bb[idx * 2 + 1] = cr * bi + ci * br; }
    for (int idx = F.tid; idx < 16 * 64; idx += 512) { Cc[idx * 2] = F.in[I_C_RE][(size_t)g * 1024 + idx]; Cc[idx * 2 + 1] = F.in[I_C_IM][(size_t)g * 1024 + idx]; }
    __syncthreads();
    for (int idx = F.tid; idx < 32 * 256; idx += 512) { const int tau = idx >> 8, c = (idx >> 4) & 15, c2 = idx & 15; float s = 0.f;
        for (int n = 0; n < 64; ++n) { const float ar = ap[(tau * 64 + n) * 2], ai = ap[(tau * 64 + n) * 2 + 1], cr = Cc[(c * 64 + n) * 2], ci = Cc[(c * 64 + n) * 2 + 1];
            const float er = cr * ar - ci * ai, ei = cr * ai + ci * ar; s += er * Bb[(n * 16 + c2) * 2] - ei * Bb[(n * 16 + c2) * 2 + 1]; }
        Km[idx] = s; }
    __syncthreads();
    bf16* MQ = (bf16*)(F.ws + WS_MQ) + (size_t)g * 512 * S5K;
    for (int idx = F.tid; idx < 512 * 80; idx += 512) { const int row = idx / 80, ch = idx % 80, i = row >> 4, c = row & 15, k0 = ch * 8; float v[8];
        if (k0 < 512) { const int s = k0 >> 4, c20 = k0 & 15, tau = i - s;
#pragma unroll
            for (int j = 0; j < 8; ++j) v[j] = tau >= 0 ? Km[(tau * 16 + c) * 16 + c20 + j] : 0.f;
        } else { const int kk = k0 - 512, ri = kk >> 6, n0 = kk & 63;
#pragma unroll
            for (int j = 0; j < 8; ++j) { const int n = n0 + j; const float ar = ap[((i + 1) * 64 + n) * 2], ai = ap[((i + 1) * 64 + n) * 2 + 1], cr = Cc[(c * 64 + n) * 2], ci = Cc[(c * 64 + n) * 2 + 1];
                v[j] = ri == 0 ? (cr * ar - ci * ai) : -(cr * ai + ci * ar); } }
        v4u o; o.x = pk2(v[0], v[1]); o.y = pk2(v[2], v[3]); o.z = pk2(v[4], v[5]); o.w = pk2(v[6], v[7]);
        *(v4u*)(MQ + (size_t)row * S5K + k0) = o; }
    bf16* SP = (bf16*)(F.ws + WS_SP) + (size_t)g * 256 * 512;
    for (int idx = F.tid; idx < 256 * 64; idx += 512) { const int row = idx >> 6, k0 = (idx & 63) * 8; float v[8];
        if (row < 128) { const int ri = row >> 6, n = row & 63, s = k0 >> 4, c20 = k0 & 15; const float ar = ap[((31 - s) * 64 + n) * 2], ai = ap[((31 - s) * 64 + n) * 2 + 1];
#pragma unroll
            for (int j = 0; j < 8; ++j) { const float br = Bb[(n * 16 + c20 + j) * 2], bi = Bb[(n * 16 + c20 + j) * 2 + 1]; v[j] = ri == 0 ? (ar * br - ai * bi) : (ar * bi + ai * br); }
        } else {
#pragma unroll
            for (int j = 0; j < 8; ++j) v[j] = 0.f; }
        v4u o; o.x = pk2(v[0], v[1]); o.y = pk2(v[2], v[3]); o.z = pk2(v[4], v[5]); o.w = pk2(v[6], v[7]);
        *(v4u*)(SP + (size_t)row * 512 + k0) = o; }
    float* AL = (float*)(F.ws + WS_AL) + g * 128;
    if (F.tid < 64) { AL[F.tid * 2] = ap[(32 * 64 + F.tid) * 2]; AL[F.tid * 2 + 1] = ap[(32 * 64 + F.tid) * 2 + 1]; }
    __syncthreads();
}

struct BigTile { const float* src; unsigned char* dst; const float* ks; float sc; int ldw, ldt; };
constexpr int BT_GU = 64 * 2 * 64, BT_D = 64 * 64, BT_N = BT_GU + BT_D, BT_PITCH = 136;
__device__ __forceinline__ BigTile bt_decode(const Frame& F, unsigned char* Wgu8, unsigned char* Wd8, const float* nf, int ti) {
    BigTile t;
    const unsigned long long pg = (unsigned long long)F.in[I_W_GATE], pu = (unsigned long long)F.in[I_W_UP], pd = (unsigned long long)F.in[I_W_DOWN];
    if (ti < BT_GU) { const int e = ti >> 7, r = ti & 127, which = r >> 6, kb = (r >> 2) & 15, nb = r & 3;
        const unsigned long long p = pg + ((pu - pg) & (0ull - (unsigned long long)which));
        t.src = (const float*)p + (size_t)e * D * DEXP + (size_t)kb * 128 * DEXP + nb * 128; t.dst = Wgu8 + ((size_t)e * 1024 + nb * 256 + which * 128) * D + kb * 128; t.ks = nf + kb * 128; t.sc = SC_WGU; t.ldw = DEXP; t.ldt = D; }
    else { const int t2 = ti - BT_GU, e = t2 >> 6, r = t2 & 63, kb = r >> 4, nb = r & 15;
        t.src = (const float*)pd + (size_t)e * DEXP * D + (size_t)kb * 128 * D + nb * 128; t.dst = Wd8 + ((size_t)e * D + nb * 128) * DEXP + kb * 128; t.ks = nullptr; t.sc = SC_WD; t.ldw = D; t.ldt = DEXP; }
    return t;
}
#define BT_LOAD(t, v, kv) do { const unsigned _lo = (unsigned)(rl * 8 * (t).ldw + cq * 4); \
    _Pragma("unroll") for (int _p = 0; _p < 8; ++_p) kv[_p] = (t).ks ? (t).ks[rl * 8 + _p] * (t).sc : (t).sc; \
    _Pragma("unroll") for (int _p = 0; _p < 8; ++_p) v[_p] = __builtin_nontemporal_load((const f32x4*)((t).src + (size_t)_p * (t).ldw + _lo)); } while (0)
#define BT_STORE(t, v, kv) do { \
    _Pragma("unroll") for (int _i = 0; _i < 4; ++_i) { v2u _w; _w.x = pk4_fp8(v[0][_i] * kv[0], v[1][_i] * kv[1], v[2][_i] * kv[2], v[3][_i] * kv[3]); _w.y = pk4_fp8(v[4][_i] * kv[4], v[5][_i] * kv[5], v[6][_i] * kv[6], v[7][_i] * kv[7]); \
        *(LAS v2u*)(img + (cq * 4 + _i) * BT_PITCH + rl * 8) = _w; } \
    __syncthreads(); \
    _Pragma("unroll") for (int _j = 0; _j < 2; ++_j) { const int _idx = tid_ + _j * 512, _n = _idx >> 3, _ch = _idx & 7; \
        const v2u _a = *(const LAS v2u*)(img + _n * BT_PITCH + _ch * 16), _b = *(const LAS v2u*)(img + _n * BT_PITCH + _ch * 16 + 8); v4u _o; _o.x = _a.x; _o.y = _a.y; _o.z = _b.x; _o.w = _b.y; \
        *(v4u*)((t).dst + (size_t)_n * (t).ldt + _ch * 16) = _o; } \
    __syncthreads(); } while (0)
__device__ __forceinline__ void bg_convert(Frame& F, int qword, int base, int ntiles, int budget) {
    if (budget <= 0) return;
    int lane_ = (int)__builtin_amdgcn_mbcnt_hi(~0u, __builtin_amdgcn_mbcnt_lo(~0u, 0u)); asm volatile("" : "+v"(lane_)); const int tid_ = F.wave * 64 + lane_;
    unsigned char* WguT = F.ws + WS_WGU; unsigned char* WdT = F.ws + WS_WD; const float* nf = F.in[I_NORM_FFN];
    const int rl = tid_ >> 5, cq = tid_ & 31; LAS unsigned char* img = F.lds; LAS int* qn = (LAS int*)(F.lds + TAB_OFF + 1024);
    f32x4 va[8], vb[8]; float ka[8], kb[8];
    int nfetch = 0;
#define BG_FETCH(slot) do { if (nfetch < budget) { if (tid_ == 0) qn[slot] = (int)atomicAdd(F.ctl + qword, 1u); } else if (tid_ == 0) qn[slot] = 0x7fffffff; ++nfetch; } while (0)
    __syncthreads();
    BG_FETCH(0); BG_FETCH(1);
    __syncthreads();
    int i0 = __builtin_amdgcn_readfirstlane(qn[0]), i1 = __builtin_amdgcn_readfirstlane(qn[1]);
    __syncthreads();
    if (i0 < ntiles) { const BigTile t0 = bt_decode(F, WguT, WdT, nf, base + i0); BT_LOAD(t0, va, ka); }
    while (i0 < ntiles) {
        const BigTile ta = bt_decode(F, WguT, WdT, nf, base + i0);
        const BigTile tb = bt_decode(F, WguT, WdT, nf, base + (i1 < ntiles ? i1 : i0));
        BT_LOAD(tb, vb, kb);
        if (i1 >= ntiles) budget = 0;
        BG_FETCH(0);
        BT_STORE(ta, va, ka);
        const int i2 = __builtin_amdgcn_readfirstlane(qn[0]);
        if (i1 >= ntiles) break;
        const BigTile tc = bt_decode(F, WguT, WdT, nf, base + (i2 < ntiles ? i2 : i1));
        BT_LOAD(tc, va, ka);
        if (i2 >= ntiles) budget = 0;
        BG_FETCH(1);
        BT_STORE(tb, vb, kb);
        const int i3 = __builtin_amdgcn_readfirstlane(qn[1]);
        i0 = i2; i1 = i3;
    }
    __syncthreads();
#undef BG_FETCH
}
__device__ __forceinline__ void p0_prologue(Frame& F) {
    if (F.vcu < 32) s5_tables(F, F.vcu);
    const int gw = F.vcu * 8 + F.wave, NGW = F.G * 8;
    bf16* WinT = (bf16*)(F.ws + WS_WIN); bf16* WoT = (bf16*)(F.ws + WS_WO); bf16* WmkvT = (bf16*)(F.ws + WS_WMKV); bf16* WgluT = (bf16*)(F.ws + WS_WGLU);
    const float* nf = F.in[I_NORM_FFN];
    constexpr int I_IN = 32 * 72, I_O = 32 * 64, I_MKV = 32 * 32, I_GLU = 8 * 16;
    constexpr int NITEMS = I_IN + I_O + I_MKV + I_GLU;
    auto decode = [&](int it) -> TrItem {
        int r = it;
        if (r < I_IN) { const int kb = r / 72, nb = r % 72; return TrItem{F.in[I_W_IN], WinT, nullptr, INC, D, kb * 64, nb * 32, nb * 32}; } r -= I_IN;
        if (r < I_O) { const int kb = r / 64, nb = r % 64, k0 = kb * 64;
            const unsigned long long pa = (unsigned long long)F.in[I_ON_ATTN], ps = (unsigned long long)(F.in[I_ON_SSM] - 1024), px = (unsigned long long)(F.in[I_ON_X] - 1536);
            const unsigned long long m1 = 0ull - (unsigned long long)(k0 >= 1024), m2 = 0ull - (unsigned long long)(k0 >= 1536);
            const unsigned long long pk = pa + ((ps - pa) & m1) + ((px - ps) & m2);
            return TrItem{F.in[I_W_O], WoT, (const float*)pk, D, D, k0, nb * 32, nb * 32}; } r -= I_O;
        if (r < I_MKV) { const int kb = r / 32, nb = r % 32; return TrItem{F.in[I_W_MEM_KV], WmkvT, nullptr, 1024, D, kb * 64, nb * 32, nb * 32}; } r -= I_MKV;
        const int kb = r / 16, nb = r % 16; return TrItem{F.in[I_W_GLU], WgluT, nullptr, 512, 512, kb * 64, nb * 32, nb * 32};
    };
    {
        f32x4 va[8], vb[8]; int it = gw; TrItem ia, ib;
        if (it < NITEMS) { ia = decode(it); tr_load(ia, va, F.lane); }
        while (it < NITEMS) {
            const int it2 = it + NGW; if (it2 < NITEMS) { ib = decode(it2); tr_load(ib, vb, F.lane); }
            tr_store(ia, va, F.lane);
            if (it2 >= NITEMS) break;
            const int it3 = it2 + NGW; if (it3 < NITEMS) { ia = decode(it3); tr_load(ia, va, F.lane); }
            tr_store(ib, vb, F.lane);
            it = it3;
        }
    }
    { bf16* WrT = (bf16*)(F.ws + WS_WR); const int gt = F.vcu * 512 + F.tid, NT = F.G * 512;
      for (int idx = gt; idx < 4 * 256 * 512; idx += NT) { const int ks = idx >> 17, n = (idx >> 9) & 255, k = ks * 512 + (idx & 511); float v = 0.f;
          if (n < 8) v = F.in[I_WR_G][k * 8 + n] * nf[k]; else if (n < 72) v = F.in[I_WR_E][k * 64 + (n - 8)] * nf[k];
          WrT[idx] = (bf16)f2bf(v); } }
    bf16* XN = (bf16*)(F.ws + WS_XN); bf16* MEMN = (bf16*)(F.ws + WS_MEMN);
    for (int m = gw; m < T; m += NGW) rms_row_to_bf16(F.in[I_X] + (size_t)m * D, F.in[I_NORM_MIX], XN + (size_t)m * D, F.lane);
    for (int m = gw; m < NB * MEML; m += NGW) rms_row_to_bf16(F.in[I_MEM] + (size_t)m * D, F.in[I_MEM_NORM], MEMN + (size_t)m * D, F.lane);
    bg_convert(F, CW_QGU, 0, BT_GU, F.vcu < 32 ? PB0_S5 : PB0);
    bg_convert(F, CW_QD, BT_GU, BT_D, PB0_D);
}

constexpr int SWA_KS = 72, SWA_VS = 264;
constexpr int SWA_KOFF = 0, SWA_VOFF = 256 * SWA_KS * 2, SWA_BOFF = SWA_VOFF + 64 * SWA_VS * 2;
__device__ __forceinline__ int t5_bucket(int n) { if (n < 16) return n; const int v = 16 + (int)(logf((float)n * (1.0f / 16.0f)) / logf(8.0f) * 16.0f); return v < 31 ? v : 31; }
__device__ __forceinline__ void swa_unit(Frame& F, int unit) {
    const int b = unit >> 5, kvh = (unit >> 4) & 1, nb = unit & 15;
    const bf16* PROJ = (const bf16*)(F.ws + WS_PROJ); bf16* MIX = (bf16*)(F.ws + WS_MIX);
    LAS bf16* Ks = (LAS bf16*)(F.lds + SWA_KOFF); LAS bf16* Vt = (LAS bf16*)(F.lds + SWA_VOFF); LAS float* bt = (LAS float*)(F.lds + SWA_BOFF);
    __syncthreads();
    {
        const int key = F.tid >> 1, half = F.tid & 1, s = (nb - 1) * 128 + key;
        v4u kw[4], vw[4];
        if (s >= 0) { const bf16* rp = PROJ + (size_t)(b * SEQ + s) * INC + 1024 + kvh * 64 + half * 32;
#pragma unroll
            for (int j = 0; j < 4; ++j) { kw[j] = *(const v4u*)(rp + j * 8); vw[j] = *(const v4u*)(rp + 128 + j * 8); }
        } else {
#pragma unroll
            for (int j = 0; j < 4; ++j) { kw[j] = (v4u){0u, 0u, 0u, 0u}; vw[j] = (v4u){0u, 0u, 0u, 0u}; } }
        float kf[32]; float ss = 0.f;
#pragma unroll
        for (int j = 0; j < 4; ++j) { kf[j * 8 + 0] = bflo(kw[j].x); kf[j * 8 + 1] = bfhi(kw[j].x); kf[j * 8 + 2] = bflo(kw[j].y); kf[j * 8 + 3] = bfhi(kw[j].y);
            kf[j * 8 + 4] = bflo(kw[j].z); kf[j * 8 + 5] = bfhi(kw[j].z); kf[j * 8 + 6] = bflo(kw[j].w); kf[j * 8 + 7] = bfhi(kw[j].w); }
#pragma unroll
        for (int j = 0; j < 32; ++j) ss += kf[j] * kf[j];
        ss += __shfl_xor(ss, 1);
        const float rstd = 1.0f / sqrtf(ss * (1.f / 64.f) + EPS);
        const float* kn = F.in[I_K_NORM] + half * 32;
#pragma unroll
        for (int j = 0; j < 4; ++j) { v4u o; o.x = pk2(kf[j * 8 + 0] * rstd * kn[j * 8 + 0], kf[j * 8 + 1] * rstd * kn[j * 8 + 1]); o.y = pk2(kf[j * 8 + 2] * rstd * kn[j * 8 + 2], kf[j * 8 + 3] * rstd * kn[j * 8 + 3]);
            o.z = pk2(kf[j * 8 + 4] * rstd * kn[j * 8 + 4], kf[j * 8 + 5] * rstd * kn[j * 8 + 5]); o.w = pk2(kf[j * 8 + 6] * rstd * kn[j * 8 + 6], kf[j * 8 + 7] * rstd * kn[j * 8 + 7]);
            *(LAS v4u*)(Ks + key * SWA_KS + half * 32 + j * 8) = o; }
#pragma unroll
        for (int j = 0; j < 4; ++j) { const unsigned w4[4] = {vw[j].x, vw[j].y, vw[j].z, vw[j].w};
#pragma unroll
            for (int q = 0; q < 4; ++q) { const int d = half * 32 + j * 8 + q * 2; Vt[d * SWA_VS + key] = (bf16)(w4[q] & 0xffffu); Vt[(d + 1) * SWA_VS + key] = (bf16)(w4[q] >> 16); } }
        for (int idx = F.tid; idx < 8 * 128; idx += 512) { const int w = idx >> 7, dl = idx & 127; bt[idx] = F.in[I_REL_BIAS][t5_bucket(dl) * 16 + kvh * 8 + w]; }
    }
    __syncthreads();
    const int w = F.wave, h = kvh * 8 + w, ql = F.lane & 31, hh = F.lane >> 5;
    const float sink = F.in[I_SINKS][h];
    const float* qn = F.in[I_Q_NORM];
    for (int r = 0; r < 4; ++r) {
        const int qi = 32 * r + ql; const size_t t = (size_t)b * SEQ + nb * 128 + qi;
        bf16x8 qf[4];
        {   const bf16* qp = PROJ + t * INC + h * 64 + 8 * hh; v4u qw[4]; float qv[32]; float ss = 0.f;
#pragma unroll
            for (int ks = 0; ks < 4; ++ks) qw[ks] = *(const v4u*)(qp + ks * 16);
#pragma unroll
            for (int ks = 0; ks < 4; ++ks) { qv[ks * 8 + 0] = bflo(qw[ks].x); qv[ks * 8 + 1] = bfhi(qw[ks].x); qv[ks * 8 + 2] = bflo(qw[ks].y); qv[ks * 8 + 3] = bfhi(qw[ks].y);
                qv[ks * 8 + 4] = bflo(qw[ks].z); qv[ks * 8 + 5] = bfhi(qw[ks].z); qv[ks * 8 + 6] = bflo(qw[ks].w); qv[ks * 8 + 7] = bfhi(qw[ks].w); }
#pragma unroll
            for (int j = 0; j < 32; ++j) ss += qv[j] * qv[j];
            ss += __shfl_xor(ss, 32);
            const float sc = 0.125f / sqrtf(ss * (1.f / 64.f) + EPS);
#pragma unroll
            for (int ks = 0; ks < 4; ++ks) { const float* g = qn + ks * 16 + 8 * hh; v4u o;
                o.x = pk2(qv[ks * 8 + 0] * sc * g[0], qv[ks * 8 + 1] * sc * g[1]); o.y = pk2(qv[ks * 8 + 2] * sc * g[2], qv[ks * 8 + 3] * sc * g[3]);
                o.z = pk2(qv[ks * 8 + 4] * sc * g[4], qv[ks * 8 + 5] * sc * g[5]); o.w = pk2(qv[ks * 8 + 6] * sc * g[6], qv[ks * 8 + 7] * sc * g[7]);
                qf[ks] = __builtin_bit_cast(bf16x8, o); } }
        f32x16 s[5];
        const int qh = ql - 4 * hh; const LAS float* pb = bt + w * 128 + qh;
        float mx = sink;
#pragma unroll
        for (int kt = 0; kt < 5; ++kt) {
            const bool live = (nb > 0) || (r + kt >= 4);
            f32x16 a = {0.f, 0.f, 0.f, 0.f, 0.f, 0.f, 0.f, 0.f, 0.f, 0.f, 0.f, 0.f, 0.f, 0.f, 0.f, 0.f};
            if (live) {
#pragma unroll
                for (int ks = 0; ks < 4; ++ks) { const bf16x8 kfrag = *(const LAS bf16x8*)(Ks + (32 * (r + kt) + ql) * SWA_KS + ks * 16 + 8 * hh);
                    a = __builtin_amdgcn_mfma_f32_32x32x16_bf16(kfrag, qf[ks], a, 0, 0, 0); }
#pragma unroll
                for (int rg = 0; rg < 16; ++rg) { const int rowc = (rg & 3) + 8 * (rg >> 2);
                    float v = a[rg] + pb[128 - 32 * kt - rowc];
                    if (kt == 0) v = (rowc > qh) ? v : -1e30f;
                    if (kt == 4) v = (rowc <= qh) ? v : -1e30f;
                    a[rg] = v; mx = fmaxf(mx, v); }
            } else {
#pragma unroll
                for (int rg = 0; rg < 16; ++rg) a[rg] = -1e30f;
            }
            s[kt] = a; }
        mx = fmaxf(mx, __shfl_xor(mx, 32));
        float l = 0.f;
#pragma unroll
        for (int kt = 0; kt < 5; ++kt)
#pragma unroll
            for (int rg = 0; rg < 16; ++rg) { const float p = fast_exp(s[kt][rg] - mx); s[kt][rg] = p; l += p; }
        l += __shfl_xor(l, 32);
        l += fast_exp(sink - mx);
        f32x16 o[2];
#pragma unroll
        for (int dt = 0; dt < 2; ++dt) o[dt] = (f32x16){0.f, 0.f, 0.f, 0.f, 0.f, 0.f, 0.f, 0.f, 0.f, 0.f, 0.f, 0.f, 0.f, 0.f, 0.f, 0.f};
#pragma unroll
        for (int kt = 0; kt < 5; ++kt)
#pragma unroll
            for (int st = 0; st < 2; ++st) { v4u pw; pw.x = pk2(s[kt][8 * st + 0], s[kt][8 * st + 1]); pw.y = pk2(s[kt][8 * st + 2], s[kt][8 * st + 3]); pw.z = pk2(s[kt][8 * st + 4], s[kt][8 * st + 5]); pw.w = pk2(s[kt][8 * st + 6], s[kt][8 * st + 7]);
                const bf16x8 pf = __builtin_bit_cast(bf16x8, pw);
#pragma unroll
                for (int dt = 0; dt < 2; ++dt) { const LAS bf16* vp = Vt + (dt * 32 + ql) * SWA_VS + 32 * (r + kt) + 16 * st + 4 * hh;
                    const v2u lo = *(const LAS v2u*)vp, hi = *(const LAS v2u*)(vp + 8); v4u vv; vv.x = lo.x; vv.y = lo.y; vv.z = hi.x; vv.w = hi.y;
                    o[dt] = __builtin_amdgcn_mfma_f32_32x32x16_bf16(__builtin_bit_cast(bf16x8, vv), pf, o[dt], 0, 0, 0); } }
        const float inv = 1.0f / l;
        { float ssq = 0.f;
#pragma unroll
          for (int dt = 0; dt < 2; ++dt)
#pragma unroll
              for (int rg = 0; rg < 16; ++rg) { const float v = o[dt][rg] * inv; ssq += v * v; }
          ssq += __shfl_xor(ssq, 32);
          if (hh == 0) ((float*)(F.ws + WS_SS))[t * 32 + h] = ssq; }
        bf16* op = MIX + t * D + h * 64 + 4 * hh;
#pragma unroll
        for (int dt = 0; dt < 2; ++dt)
#pragma unroll
            for (int q4 = 0; q4 < 4; ++q4) { v2u ow; ow.x = pk2(o[dt][q4 * 4 + 0] * inv, o[dt][q4 * 4 + 1] * inv); ow.y = pk2(o[dt][q4 * 4 + 2] * inv, o[dt][q4 * 4 + 3] * inv);
                *(v2u*)(op + dt * 32 + q4 * 8) = ow; }
    }
}

constexpr int XA_KS = 136, XA_VS = 264;
constexpr int XA_KOFF = 0, XA_VOFF = 256 * XA_KS * 2;
__device__ __forceinline__ void xattn_unit(Frame& F, int unit) {
    const int b = unit >> 5, hx = (unit >> 3) & 3, qb = unit & 7;
    const bf16* PROJ = (const bf16*)(F.ws + WS_PROJ); const bf16* MKV = (const bf16*)(F.ws + WS_MEMKV); bf16* MIX = (bf16*)(F.ws + WS_MIX);
    LAS bf16* Ks = (LAS bf16*)(F.lds + XA_KOFF); LAS bf16* Vt = (LAS bf16*)(F.lds + XA_VOFF);
    __syncthreads();
    {   const int key = F.tid >> 1, half = F.tid & 1; const bf16* rp = MKV + (size_t)(b * MEML + key) * 1024 + hx * 128 + half * 64;
        float ss = 0.f; v4u kw[8];
#pragma unroll
        for (int j = 0; j < 8; ++j) { kw[j] = *(const v4u*)(rp + j * 8);
            const float a0 = bflo(kw[j].x), a1 = bfhi(kw[j].x), a2 = bflo(kw[j].y), a3 = bfhi(kw[j].y), a4 = bflo(kw[j].z), a5 = bfhi(kw[j].z), a6 = bflo(kw[j].w), a7 = bfhi(kw[j].w);
            ss += (a0 * a0 + a1 * a1) + (a2 * a2 + a3 * a3) + (a4 * a4 + a5 * a5) + (a6 * a6 + a7 * a7); }
        ss += __shfl_xor(ss, 1);
        const float rstd = 1.0f / sqrtf(ss * (1.f / 128.f) + EPS);
        const float* kn = F.in[I_XK_NORM] + half * 64;
#pragma unroll
        for (int j = 0; j < 8; ++j) { v4u o; const float* g = kn + j * 8;
            o.x = pk2(bflo(kw[j].x) * rstd * g[0], bfhi(kw[j].x) * rstd * g[1]); o.y = pk2(bflo(kw[j].y) * rstd * g[2], bfhi(kw[j].y) * rstd * g[3]);
            o.z = pk2(bflo(kw[j].z) * rstd * g[4], bfhi(kw[j].z) * rstd * g[5]); o.w = pk2(bflo(kw[j].w) * rstd * g[6], bfhi(kw[j].w) * rstd * g[7]);
            *(LAS v4u*)(Ks + key * XA_KS + half * 64 + j * 8) = o; }
#pragma unroll
        for (int j = 0; j < 8; ++j) { const v4u vw = *(const v4u*)(rp + 512 + j * 8); const unsigned w4[4] = {vw.x, vw.y, vw.z, vw.w};
#pragma unroll
            for (int q = 0; q < 4; ++q) { const int d = half * 64 + j * 8 + q * 2; Vt[d * XA_VS + key] = (bf16)(w4[q] & 0xffffu); Vt[(d + 1) * XA_VS + key] = (bf16)(w4[q] >> 16); } }
    }
    __syncthreads();
    const int ql = F.lane & 31, hh = F.lane >> 5;
    const size_t t = (size_t)b * SEQ + qb * 256 + F.wave * 32 + ql;
    bf16x8 qf[8];
    {   const bf16* qp = PROJ + t * INC + 1792 + hx * 128 + 8 * hh; v4u qw[8]; float ss = 0.f;
#pragma unroll
        for (int ks = 0; ks < 8; ++ks) { qw[ks] = *(const v4u*)(qp + ks * 16);
            const float a0 = bflo(qw[ks].x), a1 = bfhi(qw[ks].x), a2 = bflo(qw[ks].y), a3 = bfhi(qw[ks].y), a4 = bflo(qw[ks].z), a5 = bfhi(qw[ks].z), a6 = bflo(qw[ks].w), a7 = bfhi(qw[ks].w);
            ss += (a0 * a0 + a1 * a1) + (a2 * a2 + a3 * a3) + (a4 * a4 + a5 * a5) + (a6 * a6 + a7 * a7); }
        ss += __shfl_xor(ss, 32);
        const float sc = 0.08838834764831845f / sqrtf(ss * (1.f / 128.f) + EPS);
        const float* qn = F.in[I_XQ_NORM] + 8 * hh;
#pragma unroll
        for (int ks = 0; ks < 8; ++ks) { const float* g = qn + ks * 16; v4u o;
            o.x = pk2(bflo(qw[ks].x) * sc * g[0], bfhi(qw[ks].x) * sc * g[1]); o.y = pk2(bflo(qw[ks].y) * sc * g[2], bfhi(qw[ks].y) * sc * g[3]);
            o.z = pk2(bflo(qw[ks].z) * sc * g[4], bfhi(qw[ks].z) * sc * g[5]); o.w = pk2(bflo(qw[ks].w) * sc * g[6], bfhi(qw[ks].w) * sc * g[7]);
            qf[ks] = __builtin_bit_cast(bf16x8, o); } }
    f32x16 o[4];
#pragma unroll
    for (int dt = 0; dt < 4; ++dt) o[dt] = (f32x16){0.f, 0.f, 0.f, 0.f, 0.f, 0.f, 0.f, 0.f, 0.f, 0.f, 0.f, 0.f, 0.f, 0.f, 0.f, 0.f};
    float mrun = -1e30f, lrun = 0.f;
    for (int kb = 0; kb < 4; ++kb) {
        f32x16 s[2];
#pragma unroll
        for (int kt = 0; kt < 2; ++kt) { f32x16 a = {0.f, 0.f, 0.f, 0.f, 0.f, 0.f, 0.f, 0.f, 0.f, 0.f, 0.f, 0.f, 0.f, 0.f, 0.f, 0.f};
#pragma unroll
            for (int ks = 0; ks < 8; ++ks) { const bf16x8 kfrag = *(const LAS bf16x8*)(Ks + (64 * kb + 32 * kt + ql) * XA_KS + ks * 16 + 8 * hh);
                a = __builtin_amdgcn_mfma_f32_32x32x16_bf16(kfrag, qf[ks], a, 0, 0, 0); }
            s[kt] = a; }
        float mx = mrun;
#pragma unroll
        for (int kt = 0; kt < 2; ++kt)
#pragma unroll
            for (int rg = 0; rg < 16; ++rg) mx = fmaxf(mx, s[kt][rg]);
        mx = fmaxf(mx, __shfl_xor(mx, 32));
        const float alpha = fast_exp(mrun - mx); mrun = mx;
        float ls = 0.f;
#pragma unroll
        for (int kt = 0; kt < 2; ++kt)
#pragma unroll
            for (int rg = 0; rg < 16; ++rg) { const float p = fast_exp(s[kt][rg] - mx); s[kt][rg] = p; ls += p; }
        lrun = lrun * alpha + ls;
#pragma unroll
        for (int dt = 0; dt < 4; ++dt)
#pragma unroll
            for (int rg = 0; rg < 16; ++rg) o[dt][rg] *= alpha;
#pragma unroll
        for (int kt = 0; kt < 2; ++kt)
#pragma unroll
            for (int st = 0; st < 2; ++st) { v4u pw; pw.x = pk2(s[kt][8 * st + 0], s[kt][8 * st + 1]); pw.y = pk2(s[kt][8 * st + 2], s[kt][8 * st + 3]); pw.z = pk2(s[kt][8 * st + 4], s[kt][8 * st + 5]); pw.w = pk2(s[kt][8 * st + 6], s[kt][8 * st + 7]);
                const bf16x8 pf = __builtin_bit_cast(bf16x8, pw);
#pragma unroll
                for (int dt = 0; dt < 4; ++dt) { const LAS bf16* vp = Vt + (dt * 32 + ql) * XA_VS + 64 * kb + 32 * kt + 16 * st + 4 * hh;
                    const v2u lo = *(const LAS v2u*)vp, hi = *(const LAS v2u*)(vp + 8); v4u vv; vv.x = lo.x; vv.y = lo.y; vv.z = hi.x; vv.w = hi.y;
                    o[dt] = __builtin_amdgcn_mfma_f32_32x32x16_bf16(__builtin_bit_cast(bf16x8, vv), pf, o[dt], 0, 0, 0); } }
    }
    lrun += __shfl_xor(lrun, 32);
    const float inv = 1.0f / lrun;
    { float ssq = 0.f;
#pragma unroll
      for (int dt = 0; dt < 4; ++dt)
#pragma unroll
          for (int rg = 0; rg < 16; ++rg) { const float v = o[dt][rg] * inv; ssq += v * v; }
      ssq += __shfl_xor(ssq, 32);
      if (hh == 0) ((float*)(F.ws + WS_SS))[t * 32 + 24 + hx] = ssq; }
    bf16* op = MIX + t * D + 1536 + hx * 128 + 4 * hh;
#pragma unroll
    for (int dt = 0; dt < 4; ++dt)
#pragma unroll
        for (int q4 = 0; q4 < 4; ++q4) { v2u ow; ow.x = pk2(o[dt][q4 * 4 + 0] * inv, o[dt][q4 * 4 + 1] * inv); ow.y = pk2(o[dt][q4 * 4 + 2] * inv, o[dt][q4 * 4 + 3] * inv);
            *(v2u*)(op + dt * 32 + q4 * 8) = ow; }
}

__device__ __forceinline__ void moe_tables(Frame& F) {
    LAS int* cnt = (LAS int*)(F.lds + TAB_OFF); LAS int* ts = cnt + 64;
    __syncthreads();
    if (F.tid < 64) { const int c = (int)__hip_atomic_load(F.ctl + CW_CNT + F.tid, __ATOMIC_RELAXED, __HIP_MEMORY_SCOPE_AGENT); const int nt = (c + 255) >> 8; int inc = nt;
#pragma unroll
        for (int o = 1; o < 64; o <<= 1) { const int v = __shfl_up(inc, o); if (F.tid >= o) inc += v; }
        cnt[F.tid] = c; ts[F.tid + 1] = inc; if (F.tid == 0) ts[0] = 0; }
    __syncthreads();
}

struct Args { const float* in[31]; float* out; unsigned char* ws; int ph_lo, ph_hi; };
__global__ void __launch_bounds__(512, 2) hymba_fwd(Args args) {
    extern __shared__ __attribute__((aligned(16))) unsigned char lds_raw[];
    Frame F;
    F.lds = (LAS unsigned char*)lds_raw;
    F.tid = threadIdx.x; F.lane = F.tid & 63; F.wave = __builtin_amdgcn_readfirstlane(F.tid >> 6);
    F.G = gridDim.x; { const int bx = blockIdx.x; F.vcu = (F.G % 8 == 0) ? (bx % 8) * (F.G / 8) + bx / 8 : bx; }
    F.in = (const float* const __attribute__((address_space(4)))*)__builtin_amdgcn_kernarg_segment_ptr();
    F.out = args.out; F.ws = args.ws; F.ctl = (unsigned*)(args.ws + WS_CTL);
    const int lo = args.ph_lo, hi = args.ph_hi;
#if !MK_PER_PHASE
    if (F.tid < 4) ((LAS unsigned*)(F.lds + XBW_OFF))[F.tid] = 0u;
    __syncthreads();
    XcdBarrier bar = xcd_barrier_post(F.ctl + CW_BAR, (volatile LAS unsigned*)(F.lds + XBW_OFF));
#define GRID_BAR() xcd_barrier(bar)
#else
#define GRID_BAR() do {} while (0)
#endif
#define PHASE_REGS() do { int _l = (int)__builtin_amdgcn_mbcnt_hi(~0u, __builtin_amdgcn_mbcnt_lo(~0u, 0u)); asm volatile("" : "+v"(_l)); F.lane = _l; F.tid = F.wave * 64 + _l; } while (0)
#define IN(k) (lo <= (k) && (k) < hi)
#define SEAM(k) do { if (IN(k) && IN((k) + 1)) GRID_BAR(); } while (0)
    const int gw = F.vcu * 8 + F.wave, NGW = F.G * 8;
    bf16* const XN = (bf16*)(F.ws + WS_XN); bf16* const PROJ = (bf16*)(F.ws + WS_PROJ); bf16* const MIX = (bf16*)(F.ws + WS_MIX);
    bf16* const UA = (bf16*)(F.ws + WS_UA); bf16* const Gm = (bf16*)(F.ws + WS_G);

    if (IN(0)) { PHASE_REGS(); p0_prologue(F); }
    SEAM(0);
    if (IN(1)) { PHASE_REGS();
        { pg8::Gemm g{D, D, D}; pg8::DenseOrder S; S.init(XN, F.ws + WS_WIN, D, D, T, INC, F.G, (int)blockIdx.x);
          pg8::EpiProj E{PROJ, UA}; pg8::gemm_phase<pg8::EpiProj, pg8::DenseOrder>(F.lds, g, S, E, F.wave); }
        { pg8::Gemm g{D, D, D}; pg8::DenseOrder S; S.init(F.ws + WS_MEMN, F.ws + WS_WMKV, D, D, NB * MEML, 1024, F.G, F.G - 1 - (int)blockIdx.x);
          pg8::EpiBf16 E{(bf16*)(F.ws + WS_MEMKV), 1024}; pg8::gemm_phase<pg8::EpiBf16, pg8::DenseOrder>(F.lds, g, S, E, F.wave); }
        { const int c = (int)blockIdx.x; const bool has3 = 2 * F.G + c < (T / 256) * (INC / 256), haskv = (F.G - 1 - c) < (NB * MEML / 256) * 4;
          bg_convert(F, CW_QGU, 0, BT_GU, (!has3 && !haskv) ? PB1 : 0); }
    }
    SEAM(1);
    if (IN(2)) { PHASE_REGS();
        for (int u = F.vcu; u < 256; u += F.G) swa_unit(F, u);
        __syncthreads();
        { pg8::Gemm g{S5K, 512, 512}; pg8::GroupOrder S{(const char*)UA, (const char*)(F.ws + WS_SP), S5K, 512, 1, 32, F.G, F.G - 1 - F.vcu};
          pg8::EpiF32 E{(float*)(F.ws + WS_SL), 256, (size_t)512 * 256}; pg8::gemm_phase<pg8::EpiF32, pg8::GroupOrder>(F.lds, g, S, E, F.wave); }
        bg_convert(F, CW_QGU, 0, BT_GU, (F.G - 1 - F.vcu) >= 64 ? PB2 : 0);
    }
    SEAM(2);
    if (IN(3)) { PHASE_REGS();
        if (F.wave < 4) { const float* SL = (const float*)(F.ws + WS_SL); const float* AL = (const float*)(F.ws + WS_AL);
            for (int L = F.vcu; L < 128; L += F.G) { const int g = L >> 2, pm = L & 1, b = 4 * pm + F.wave, n = F.lane;
                const float ar = AL[(g * 64 + n) * 2], ai = AL[(g * 64 + n) * 2 + 1]; float xr = 0.f, xi = 0.f;
                for (int j0 = 0; j0 < 64; j0 += 8) { float sr[8], si[8];
#pragma unroll
                    for (int j = 0; j < 8; ++j) { const float* sp = SL + ((size_t)(g * 512 + b * 64 + j0 + j)) * 256; sr[j] = sp[n]; si[j] = sp[64 + n]; }
#pragma unroll
                    for (int j = 0; j < 8; ++j) { bf16* up = UA + ((size_t)(g * 512 + b * 64 + j0 + j)) * S5K + 512; up[n] = (bf16)f2bf(xr); up[64 + n] = (bf16)f2bf(xi);
                        const float nr = ar * xr - ai * xi + sr[j], ni = ar * xi + ai * xr + si[j]; xr = nr; xi = ni; } } } }
        asm volatile("s_waitcnt vmcnt(0)" ::: "memory");
        __syncthreads();
        pg8::Gemm g{S5K, S5K, S5K}; pg8::GroupOrder S{(const char*)UA, (const char*)(F.ws + WS_MQ), S5K, S5K, 2, 32, F.G, F.vcu};
        pg8::EpiS5Y E{UA, F.in[I_SSM_D], Gm}; pg8::gemm_phase<pg8::EpiS5Y, pg8::GroupOrder>(F.lds, g, S, E, F.wave);
        if (F.G >= 256 && F.vcu >= 128) { for (int u = F.vcu - 128; u < 128; u += F.G - 128) xattn_unit(F, u); __syncthreads(); }
    }
    SEAM(3);
    if (IN(4)) { PHASE_REGS();
        pg8::Gemm g{512, 512, 512}; pg8::DenseOrder S; S.init(Gm, F.ws + WS_WGLU, 512, 512, T, 512, F.G, (int)blockIdx.x);
        pg8::EpiGlu E{Gm, MIX, (float*)(F.ws + WS_SS)}; pg8::gemm_phase<pg8::EpiGlu, pg8::DenseOrder>(F.lds, g, S, E, F.wave);
        if (F.G >= 256 && (int)blockIdx.x >= 128) { for (int u = 128 + (int)blockIdx.x - 128; u < 256; u += F.G - 128) xattn_unit(F, u); __syncthreads(); }
    }
    SEAM(4);
    if (IN(5)) { PHASE_REGS();
        pg8::Gemm g{D, D, D}; pg8::DenseOrder S; S.init(MIX, F.ws + WS_WO, D, D, T, D, F.G, (int)blockIdx.x);
        pg8::EpiWo E{F.in[I_X], XN, (unsigned char*)(F.ws + WS_X18), (float*)(F.ws + WS_PART)}; pg8::gemm_phase<pg8::EpiWo, pg8::DenseOrder, false, false, true>(F.lds, g, S, E, F.wave, (const float*)(F.ws + WS_SS));
    }
    SEAM(5);
    if (IN(6)) { PHASE_REGS();
        pg8::Gemm g{D, 512, 512}; pg8::KSplitOrder S{(const char*)XN, (const char*)(F.ws + WS_WR), D, 512, 512, T / 256, 4, F.G, F.vcu};
        pg8::EpiLogit E{(float*)(F.ws + WS_LP)}; pg8::gemm_phase<pg8::EpiLogit, pg8::KSplitOrder>(F.lds, g, S, E, F.wave);
    }
    SEAM(6);
    const int rt_per = (T + F.G - 1) / F.G, rt_beg = F.vcu * rt_per, rt_end = (rt_beg + rt_per) < T ? (rt_beg + rt_per) : T;
    if (IN(7)) { PHASE_REGS();
        LAS int* hist = (LAS int*)F.lds;
        const float* LP = (const float*)(F.ws + WS_LP); const float* part = (const float*)(F.ws + WS_PART); float* rstdv = (float*)(F.ws + WS_RSTD);
        int* toke = (int*)(F.ws + WS_TOKE); float* wts = (float*)(F.ws + WS_WTS); int* HIST = (int*)(F.ws + WS_HIST);
        __syncthreads();
        if (F.tid < 64) hist[F.tid] = 0;
        __syncthreads();
        for (int t = rt_beg + F.tid; t < rt_end; t += 512) {
            const f32x4* pp = (const f32x4*)(part + (size_t)t * 32); float ss = 0.f;
#pragma unroll
            for (int j = 0; j < 8; ++j) { const f32x4 v = pp[j]; ss += (v[0] + v[1]) + (v[2] + v[3]); }
            const float rs = 1.0f / sqrtf(ss * (1.f / 2048.f) + EPS); rstdv[t] = rs;
            const float* l0 = LP + (size_t)t * 80; const float* l1 = l0 + (size_t)T * 80; const float* l2 = l1 + (size_t)T * 80; const float* l3 = l2 + (size_t)T * 80;
            float gl[8];
#pragma unroll
            for (int j = 0; j < 8; j += 4) { const f32x4 a = *(const f32x4*)(l0 + j), b = *(const f32x4*)(l1 + j), c = *(const f32x4*)(l2 + j), d = *(const f32x4*)(l3 + j);
#pragma unroll
                for (int q = 0; q < 4; ++q) gl[j + q] = rs * (((a[q] + b[q]) + c[q]) + d[q]); }
            int gi = 0; float gm = gl[0];
#pragma unroll
            for (int j = 1; j < 8; ++j) if (gl[j] > gm) { gm = gl[j]; gi = j; }
            float gs = 0.f;
#pragma unroll
            for (int j = 0; j < 8; ++j) gs += expf(gl[j] - gm);
            const float gate = 1.0f / gs;
            float el[8];
#pragma unroll
            for (int j = 0; j < 8; j += 4) { const int o = 8 + gi * 8 + j; const f32x4 a = *(const f32x4*)(l0 + o), b = *(const f32x4*)(l1 + o), c = *(const f32x4*)(l2 + o), d = *(const f32x4*)(l3 + o);
#pragma unroll
                for (int q = 0; q < 4; ++q) el[j + q] = rs * (((a[q] + b[q]) + c[q]) + d[q]); }
            int i1 = 0; float v1 = el[0];
#pragma unroll
            for (int j = 1; j < 8; ++j) if (el[j] > v1) { v1 = el[j]; i1 = j; }
            int i2 = -1; float v2 = -3.0e38f;
#pragma unroll
            for (int j = 0; j < 8; ++j) if (j != i1 && el[j] > v2) { v2 = el[j]; i2 = j; }
            const float ex = expf(v2 - v1);
            const int ea = gi * 8 + i1, eb = gi * 8 + i2;
            const int la = __hip_atomic_fetch_add(hist + ea, 1, __ATOMIC_RELAXED, __HIP_MEMORY_SCOPE_WORKGROUP), lb = __hip_atomic_fetch_add(hist + eb, 1, __ATOMIC_RELAXED, __HIP_MEMORY_SCOPE_WORKGROUP);
            toke[t * 2] = (ea << 16) | la; toke[t * 2 + 1] = (eb << 16) | lb; wts[t * 2] = gate / (1.0f + ex); wts[t * 2 + 1] = gate * ex / (1.0f + ex);
        }
        __syncthreads();
        if (F.tid < 64) HIST[F.vcu * 64 + F.tid] = hist[F.tid];
        __syncthreads();
    }
    SEAM(7);
    if (IN(8)) { PHASE_REGS();
        LAS int* pb = (LAS int*)F.lds; LAS int* pt = pb + 512; LAS int* base = pt + 512;
        const int* HIST = (const int*)(F.ws + WS_HIST); const int* toke = (const int*)(F.ws + WS_TOKE); int* list = (int*)(F.ws + WS_LIST);
        __syncthreads();
        { const int e = F.tid & 63, p8 = F.tid >> 6; int sb = 0, st = 0;
          for (int w = p8; w < F.G; w += 8) { const int h = HIST[w * 64 + e]; st += h; sb += (w < F.vcu) ? h : 0; }
          pb[F.tid] = sb; pt[F.tid] = st; }
        __syncthreads();
        if (F.tid < 64) { int sb = 0, st = 0;
#pragma unroll
            for (int j = 0; j < 8; ++j) { sb += pb[j * 64 + F.tid]; st += pt[j * 64 + F.tid]; }
            base[F.tid] = sb; F.ctl[CW_CNT + F.tid] = (unsigned)st; }
        __syncthreads();
        for (int t = rt_beg + F.tid; t < rt_end; t += 512) {
#pragma unroll
            for (int k = 0; k < 2; ++k) { const int v = toke[t * 2 + k], e = v >> 16, sl = v & 0xffff; const size_t pos = (size_t)e * LCAP + base[e] + sl;
                list[pos] = t * 2 + k; ((float*)(F.ws + WS_LRS))[pos] = ((const float*)(F.ws + WS_RSTD))[t]; ((float*)(F.ws + WS_LWT))[pos] = ((const float*)(F.ws + WS_WTS))[t * 2 + k]; } }
        __syncthreads();
        bg_convert(F, CW_QGU, 0, BT_GU, 0x7fffffff);
    }
    SEAM(8);
    if (IN(9)) { PHASE_REGS();
        moe_tables(F);
        const LAS int* cnt = (const LAS int*)(F.lds + TAB_OFF); const int* list = (const int*)(F.ws + WS_LIST);
        pg8::Gemm g{D / 2, D / 2, D / 2}; pg8::MoeOrder S{(const char*)(F.ws + WS_X18), (const char*)(F.ws + WS_WGU), cnt, cnt + 64, list, D / 2, D / 2, 4, 1024, F.G, F.vcu, true};
        pg8::EpiGU E{list, (const float*)(F.ws + WS_LRS), cnt, F.ws + WS_ACT}; pg8::gemm_phase<pg8::EpiGU, pg8::MoeOrder, true, true>(F.lds, g, S, E, F.wave);
        PHASE_REGS();
        bg_convert(F, CW_QD, BT_GU, BT_D, 0x7fffffff);
    }
    SEAM(9);
    if (IN(10)) { PHASE_REGS();
        moe_tables(F);
        const LAS int* cnt = (const LAS int*)(F.lds + TAB_OFF); const int* list = (const int*)(F.ws + WS_LIST);
        pg8::Gemm g{DEXP / 2, DEXP / 2, DEXP / 2}; pg8::MoeOrder S{(const char*)(F.ws + WS_ACT), (const char*)(F.ws + WS_WD), cnt, cnt + 64, list, DEXP / 2, DEXP / 2, 8, 2048, F.G, F.vcu, false};
        pg8::EpiDown E{list, (const float*)(F.ws + WS_LWT), cnt, F.ws + WS_Y2};
        pg8::gemm_phase<pg8::EpiDown, pg8::MoeOrder, false, true>(F.lds, g, S, E, F.wave);
    }
    SEAM(10);
    if (IN(11)) { PHASE_REGS();
        const unsigned char* Y2 = F.ws + WS_Y2; typedef float f32x2_ __attribute__((ext_vector_type(2)));
        for (int m = gw; m < T; m += NGW) { f32x4* op = (f32x4*)(F.out + (size_t)m * D) + F.lane * 2; const v4u* xb = (const v4u*)(XN + (size_t)m * D) + F.lane;
            const v2u* ya = (const v2u*)(Y2 + (size_t)m * 2 * D) + F.lane; const v2u* yb = ya + 256;
            v4u xw[4]; v2u aw[4], cw[4];
#pragma unroll
            for (int j = 0; j < 4; ++j) { xw[j] = __builtin_nontemporal_load(xb + 64 * j); aw[j] = __builtin_nontemporal_load(ya + 64 * j); cw[j] = __builtin_nontemporal_load(yb + 64 * j); }
#pragma unroll
            for (int j = 0; j < 4; ++j) { const v4u x = xw[j]; const v2u a = aw[j], c = cw[j]; f32x4 x0, x1; const float is = 1.0f / SC_Y;
                const f32x2_ a0 = __builtin_amdgcn_cvt_pk_f32_fp8((int)a.x, false), a1 = __builtin_amdgcn_cvt_pk_f32_fp8((int)a.x, true), a2 = __builtin_amdgcn_cvt_pk_f32_fp8((int)a.y, false), a3 = __builtin_amdgcn_cvt_pk_f32_fp8((int)a.y, true);
                const f32x2_ c0 = __builtin_amdgcn_cvt_pk_f32_fp8((int)c.x, false), c1 = __builtin_amdgcn_cvt_pk_f32_fp8((int)c.x, true), c2 = __builtin_amdgcn_cvt_pk_f32_fp8((int)c.y, false), c3 = __builtin_amdgcn_cvt_pk_f32_fp8((int)c.y, true);
                x0[0] = bflo(x.x) + (a0[0] + c0[0]) * is; x0[1] = bfhi(x.x) + (a0[1] + c0[1]) * is; x0[2] = bflo(x.y) + (a1[0] + c1[0]) * is; x0[3] = bfhi(x.y) + (a1[1] + c1[1]) * is;
                x1[0] = bflo(x.z) + (a2[0] + c2[0]) * is; x1[1] = bfhi(x.z) + (a2[1] + c2[1]) * is; x1[2] = bflo(x.w) + (a3[0] + c3[0]) * is; x1[3] = bfhi(x.w) + (a3[1] + c3[1]) * is;
                __builtin_nontemporal_store(x0, op + 128 * j); __builtin_nontemporal_store(x1, op + 128 * j + 1); } }
    }
#undef IN
#undef SEAM
}

extern "C" void kernel_launch(void* const* d_in, const int* in_sizes, int n_in, void* d_out, int out_size, void* d_ws, size_t ws_size, hipStream_t stream) {
    static int grid = 0;
    if (grid == 0) {
        if (n_in != 31 || out_size != T * D || ws_size < WS_END) { fprintf(stderr, "kernel_launch: unexpected shapes (n_in %d out %d ws %zu)\n", n_in, out_size, ws_size); grid = -1; return; }
        int dev = 0, cus = 0, per_cu = 0;
        if (hipGetDevice(&dev) != hipSuccess || hipDeviceGetAttribute(&cus, hipDeviceAttributeMultiprocessorCount, dev) != hipSuccess) { grid = -1; return; }
        if (hipFuncSetAttribute((const void*)hymba_fwd, hipFuncAttributeMaxDynamicSharedMemorySize, LDS_BYTES) != hipSuccess) { fprintf(stderr, "kernel_launch: hipFuncSetAttribute failed\n"); grid = -1; return; }
        if (hipOccupancyMaxActiveBlocksPerMultiprocessor(&per_cu, (const void*)hymba_fwd, 512, LDS_BYTES) != hipSuccess || per_cu < 1) fprintf(stderr, "kernel_launch: occupancy query reports %d\n", per_cu);
        (void)hipGetLastError();
        grid = cus;
    }
    if (grid < 0) return;
    (void)hipMemsetAsync((char*)d_ws + WS_CTL, 0, CTL_ZERO_BYTES, stream);
    Args a{};
    for (int i = 0; i < 31; ++i) a.in[i] = (const float*)d_in[i];
    a.out = (float*)d_out; a.ws = (unsigned char*)d_ws;
#if MK_PER_PHASE
    for (int p = 0; p < NPH; ++p) { const int reps = ((PROBE_REP_MASK >> p) & 1) ? 2 : 1;
        for (int q = 0; q < reps; ++q) { a.ph_lo = p; a.ph_hi = p + 1; hipLaunchKernelGGL(hymba_fwd, dim3(grid), dim3(512), LDS_BYTES, stream, a); } }
#else
    a.ph_lo = 0; a.ph_hi = NPH; hipLaunchKernelGGL(hymba_fwd, dim3(grid), dim3(512), LDS_BYTES, stream, a);
#endif
}
```

```cpp
#include <hip/hip_runtime.h>
#include <cstdio>
#include <cstdint>

#ifndef PROBE_REP_MASK
#define PROBE_REP_MASK 0
#endif
#ifndef PB0
#define PB0 40
#endif
#ifndef PB0_S5
#define PB0_S5 28
#endif
#ifndef PB0_D
#define PB0_D 0
#endif
#ifndef PB1
#define PB1 0
#endif
#ifndef PB2
#define PB2 0
#endif
#ifndef PB4
#define PB4 0
#endif
#ifndef PB5
#define PB5 0
#endif
#ifndef PB11
#define PB11 0
#endif
#ifndef MK_PER_PHASE
#define MK_PER_PHASE 0
#endif

#define GAS __attribute__((address_space(1)))
#define LAS __attribute__((address_space(3)))
typedef unsigned short bf16;
typedef unsigned v4u __attribute__((ext_vector_type(4)));
typedef unsigned v2u __attribute__((ext_vector_type(2)));
typedef float f32x4 __attribute__((ext_vector_type(4)));
typedef float f32x16 __attribute__((ext_vector_type(16)));
typedef short bf16x8 __attribute__((ext_vector_type(8)));
typedef short bf16x4 __attribute__((ext_vector_type(4)));
typedef int v8i __attribute__((ext_vector_type(8)));
typedef int v4i_ __attribute__((ext_vector_type(4)));

constexpr int T = 16384, D = 2048, SEQ = 2048, NB = 8, INC = 2304, MEML = 256;
constexpr int NPH = 12;
constexpr float EPS = 1e-6f;
constexpr int NEXP = 64, DEXP = 512, LCAP = 16384;
constexpr int S5L = 32, S5K = 640;

constexpr size_t MiB = 1u << 20;
constexpr size_t WS_CTL = 0, CTL_ZERO_BYTES = 1 * MiB;
constexpr size_t WS_WIN = 2 * MiB, WS_WO = 11 * MiB, WS_WMKV = 19 * MiB, WS_WGLU = 23 * MiB;
constexpr size_t WS_MQ = 24 * MiB, WS_SP = 44 * MiB, WS_UA = 52 * MiB, WS_SL = 72 * MiB, WS_AL = 88 * MiB, WS_WR = 89 * MiB;
constexpr size_t WS_XN = 96 * MiB;
constexpr size_t WS_MEMN = 160 * MiB, WS_MEMKV = 168 * MiB;
constexpr size_t WS_PROJ = 176 * MiB;
constexpr size_t WS_MIX = 248 * MiB;
constexpr size_t WS_Y2 = 176 * MiB;
constexpr size_t WS_G = 312 * MiB;
constexpr size_t WS_LOG = 328 * MiB;
constexpr size_t WS_LIST = 344 * MiB;
constexpr size_t WS_WTS = 348 * MiB;
constexpr size_t WS_LP = 352 * MiB;
constexpr size_t WS_PART = 376 * MiB;
constexpr size_t WS_RSTD = 379 * MiB;
constexpr size_t WS_HIST = 380 * MiB;
constexpr size_t WS_X18 = 384 * MiB;
constexpr size_t WS_SS = 382 * MiB;
constexpr size_t WS_LRS = 452 * MiB;
constexpr size_t WS_LWT = 456 * MiB;
constexpr size_t WS_RINV = 460 * MiB;
constexpr size_t WS_TOKE = 381 * MiB;
constexpr size_t WS_ACT = 544 * MiB;
constexpr size_t WS_WGU = 592 * MiB;
constexpr size_t WS_WD = 848 * MiB;
constexpr size_t WS_END = 976 * MiB;
constexpr int CW_CNT = 1024;
constexpr int CW_BAR = 4096;
constexpr int CW_QGU = 2048, CW_QD = 2112;

constexpr int RING_BYTES = 131072;
constexpr int TAB_OFF = 139264;
constexpr int XBW_OFF = TAB_OFF + 2048;
constexpr int LDS_BYTES = 147456;

#define LDS_WAIT() asm volatile("s_waitcnt lgkmcnt(0)" ::: "memory")
#define VM_WAIT() asm volatile("s_waitcnt vmcnt(0)" ::: "memory")
__device__ __forceinline__ unsigned f2bf(float f) { unsigned u = __builtin_bit_cast(unsigned, f); return (u + 0x7fffu + ((u >> 16) & 1u)) >> 16; }
__device__ __forceinline__ unsigned pk2(float lo, float hi) { unsigned r; asm volatile("v_cvt_pk_bf16_f32 %0, %1, %2" : "=v"(r) : "v"(lo), "v"(hi)); return r; }
__device__ __forceinline__ float bflo(unsigned w) { return __builtin_bit_cast(float, w << 16); }
__device__ __forceinline__ float bfhi(unsigned w) { return __builtin_bit_cast(float, w & 0xffff0000u); }
__device__ __forceinline__ float wave_sum(float v) {
#pragma unroll
    for (int o = 1; o < 64; o <<= 1) v += __shfl_xor(v, o);
    return v;
}
constexpr float SC_X = 4.0f, SC_WGU = 32.0f, SC_ACT = 16.0f, SC_WD = 16.0f, SC_Y = 64.0f;
__device__ __forceinline__ float clamp8(float v) { return __builtin_amdgcn_fmed3f(v, -448.0f, 448.0f); }
__device__ __forceinline__ unsigned pk4_fp8(float a, float b, float c, float d) { unsigned w = 0u; w = (unsigned)__builtin_amdgcn_cvt_pk_fp8_f32(clamp8(a), clamp8(b), (int)w, false); w = (unsigned)__builtin_amdgcn_cvt_pk_fp8_f32(clamp8(c), clamp8(d), (int)w, true); return w; }
__device__ __forceinline__ float fast_exp(float x) { return __builtin_amdgcn_exp2f(x * 1.44269504089f); }
__device__ __forceinline__ float sigmoidf_(float x) { return __builtin_amdgcn_rcpf(1.0f + fast_exp(-x)); }
__device__ __forceinline__ float gelu_tanh(float x) { const float z = 1.5957691216f * (x + 0.044715f * x * x * x); return x * sigmoidf_(z); }

#define XB_TMO      128
#define XB_XCNT(j)  (256  + 64 * (j))
#define XB_XSUB(j)  (1280 + 64 * (j))
#define XB_XGEN(j)  (2304 + 64 * (j))
#define XB_TOP      3328
#define XB_TOPGEN   3392
#define XCD_BAR_WORDS 3456
#define XB_SPIN_CAP (1u << 18)
__device__ __forceinline__ unsigned xb_ld(unsigned* p)              { return __hip_atomic_load(p, __ATOMIC_RELAXED, __HIP_MEMORY_SCOPE_AGENT); }
__device__ __forceinline__ unsigned xb_add(unsigned* p, unsigned v) { return __hip_atomic_fetch_add(p, v, __ATOMIC_RELAXED, __HIP_MEMORY_SCOPE_AGENT); }
__device__ __forceinline__ unsigned xb_xcc_id() { return (unsigned)__builtin_amdgcn_s_getreg((3 << 11) | 20) & 0xFu; }
#define XB_SPIN(cond, bar) do { unsigned _sp = 0; while (cond) { __builtin_amdgcn_s_sleep(1); \
    if ((++_sp & 255u) == 0u) { if (xb_ld(&(bar)[XB_TMO])) break; if (_sp > XB_SPIN_CAP) { atomicAdd(&(bar)[XB_TMO], 1u); break; } } } } while (0)
struct XcdBarrier { unsigned* bar; unsigned x; volatile LAS unsigned* st; };
__device__ __forceinline__ XcdBarrier xcd_barrier_post(unsigned* bar, volatile LAS unsigned* st) {
    XcdBarrier b; b.bar = bar; b.x = xb_xcc_id(); b.st = st;
    if (threadIdx.x == 0) (void)xb_add(&bar[XB_XCNT(b.x)], 1u);
    return b;
}
__device__ __forceinline__ void xcd_barrier_complete(unsigned* bar, unsigned x, unsigned& nloc, unsigned& nx) {
    const unsigned G = gridDim.x * gridDim.y * gridDim.z;
    unsigned sum, cnt, mine, sp = 0u;
    for (;;) {
        sum = 0u; cnt = 0u; mine = 0u;
#pragma unroll
        for (unsigned j = 0; j < 16; ++j) { const unsigned c = xb_ld(&bar[XB_XCNT(j)]); sum += c; cnt += (c > 0u) ? 1u : 0u; mine = (j == x) ? c : mine; }
        if (sum == G) break;
        __builtin_amdgcn_s_sleep(1);
        if ((++sp & 255u) == 0u) { if (xb_ld(&bar[XB_TMO])) break; if (sp > XB_SPIN_CAP) { atomicAdd(&bar[XB_TMO], 1u); break; } }
    }
    nloc = mine > 0u ? mine : 1u; nx = cnt > 0u ? cnt : 1u;
}
__device__ __forceinline__ void xcd_barrier(const XcdBarrier& b) {
    asm volatile("s_waitcnt vmcnt(0)" ::: "memory");
    __syncthreads();
    if (threadIdx.x == 0) {
        unsigned* bar = b.bar;
        __builtin_amdgcn_s_waitcnt(0);
        unsigned nloc = b.st[0], nx = b.st[1];
        if (nloc == 0u) { xcd_barrier_complete(bar, b.x, nloc, nx); b.st[0] = nloc; b.st[1] = nx; }
        const unsigned old = xb_add(&bar[XB_XSUB(b.x)], 1u);
        const unsigned gen = old / nloc;
        if (old + 1u == (gen + 1u) * nloc) {
            __builtin_amdgcn_fence(__ATOMIC_RELEASE, "agent");
            asm volatile("s_waitcnt vmcnt(0)" ::: "memory");
            const unsigned og = xb_add(&bar[XB_TOP], 1u);
            const unsigned tg = og / nx;
            if (og + 1u == (tg + 1u) * nx) xb_add(&bar[XB_TOPGEN], 1u);
            else XB_SPIN(xb_ld(&bar[XB_TOPGEN]) == tg, bar);
            __builtin_amdgcn_fence(__ATOMIC_ACQUIRE, "agent");
            xb_add(&bar[XB_XGEN(b.x)], 1u);
            asm volatile("s_waitcnt vmcnt(0)" ::: "memory");
        } else {
            XB_SPIN(xb_ld(&bar[XB_XGEN(b.x)]) == gen, bar);
            __builtin_amdgcn_fence(__ATOMIC_ACQUIRE, "agent");
            asm volatile("s_waitcnt vmcnt(0)" ::: "memory");
        }
    }
    __syncthreads();
}

__device__ __forceinline__ int lane_now() { int l = (int)__builtin_amdgcn_mbcnt_hi(~0u, __builtin_amdgcn_mbcnt_lo(~0u, 0u)); asm volatile("" : "+v"(l)); return l; }
namespace pg8 {
constexpr int BM = 256, BK = 64, HALF = 128, HTB = HALF * BK * 2, STAGE_BYTES = 8 * HTB, NXCD = 8, WGM = 8;
__host__ __device__ __forceinline__ int lds_byte(int r, int c) { const int st = (r >> 4) * 2 + (c >> 5), rr = r & 15, cc = c & 31, ob = rr * 64 + cc * 2; return st * 1024 + (ob ^ (((ob >> 9) & 1) << 5)); }
__host__ __device__ __forceinline__ void stage_rc(int b, int& R, int& C) { const int st = b / 1024, sb = b % 1024, swz = sb ^ (((sb >> 9) & 1) << 5); R = (st >> 1) * 16 + swz / 64; C = (st & 1) * 32 + (swz % 64) / 2; }
__host__ __device__ __forceinline__ int perm32(int rho) { const int n = rho >> 4, i = rho & 15; return 8 * (i >> 2) + 4 * n + (i & 3); }

struct Unit { const char* a; const char* b; int r0, c0, aux, r1; };
struct Gemm { int lda, ldb, K; };

struct DenseOrder {
    const char* A; const char* Bt; int lda, ldb, nM, nN, nwg, G, c;
    __device__ void init(const void* A_, const void* Bt_, int lda_, int ldb_, int M, int N, int G_, int c_) { A = (const char*)A_; Bt = (const char*)Bt_; lda = lda_; ldb = ldb_; nM = M / BM; nN = N / BM; nwg = nM * nN; G = G_; c = c_; }
    __device__ bool next(int i, Unit& u) const {
        const long L = (long)i * G + c; if (L >= nwg) return false;
        int wgid = (int)L; { const int q = nwg / NXCD, r = nwg % NXCD, xcd = wgid % NXCD, off = wgid / NXCD; wgid = (xcd < r ? xcd * (q + 1) : r * (q + 1) + (xcd - r) * q) + off; }
        const int nig = WGM * nN, gid = wgid / nig, fm = gid * WGM, gsz = (nM - fm) < WGM ? (nM - fm) : WGM;
        const int pm = fm + ((wgid % nig) % gsz), pn = (wgid % nig) / gsz;
        u.a = A + (size_t)pm * BM * lda * 2; u.b = Bt + (size_t)pn * BM * ldb * 2; u.r0 = pm * BM; u.c0 = pn * BM; u.aux = 0; u.r1 = 0; return true;
    }
    __device__ __forceinline__ unsigned arow(const Unit&, int) const { return 0u; }
};
struct GroupOrder {
    const char* A; const char* Bt; int lda, ldb, nN, ngrp, G, c;
    __device__ bool next(int i, Unit& u) const {
        const int L = i * G + c; if (L >= ngrp * 2 * nN) return false;
        const int g = L / (2 * nN), q = L % (2 * nN), pn = q >> 1, pm = q & 1;
        u.a = A + ((size_t)g * 512 + pm * BM) * lda * 2; u.b = Bt + ((size_t)g * nN + pn) * BM * ldb * 2; u.r0 = pm * BM; u.c0 = pn * BM; u.aux = g; u.r1 = 0; return true;
    }
    __device__ __forceinline__ unsigned arow(const Unit&, int) const { return 0u; }
};
struct MoeOrder {
    const char* A; const char* Bt; const LAS int* cnt; const LAS int* ts; const int* list; int lda, ldb, nct, brows, G, c; bool gather;
    __device__ bool next(int i, Unit& u) const {
        const int L = i * G + c; const int lane = lane_now();
        int i64 = 64; asm volatile("" : "+v"(i64));
        if (L >= __builtin_amdgcn_readfirstlane(ts[i64]) * nct) return false;
        const int lo = ts[lane] * nct, hi = ts[lane + 1] * nct;
        const unsigned long long m = __ballot(lo <= L && L < hi);
        const int e = __builtin_amdgcn_readfirstlane((int)__builtin_ctzll(m));
        const int tse = ts[e], ne = ts[e + 1] - tse, q = L - tse * nct, ct = q / ne, rt = q % ne;
        u.a = gather ? A : A + (size_t)(tse + rt) * BM * lda * 2; u.b = Bt + ((size_t)e * brows + (size_t)ct * BM) * ldb * 2;
        u.r0 = (tse + rt) * BM; u.r1 = rt * BM; u.c0 = ct; u.aux = e; return true;
    }
    __device__ __forceinline__ unsigned arow(const Unit& u, int r) const {
        const int n = cnt[u.aux]; int rr = u.r1 + r; rr = rr < n ? rr : n - 1;
        return (unsigned)(list[(size_t)u.aux * LCAP + rr] >> 1) * (unsigned)(lda * 2);
    }
};

#define EPI_ROWS_COLS() const int rowb = wr * 64 + fr; (void)rowb;

template <class Epi, class Sched, bool GATHER = false, bool FP8 = false, bool KSEG = false>
__device__ __forceinline__ void gemm_phase(LAS unsigned char* lds, const Gemm g, const Sched& S, const Epi& E, const int wave_id, const float* ssq = nullptr) {
    int lane = (int)__builtin_amdgcn_mbcnt_hi(~0u, __builtin_amdgcn_mbcnt_lo(~0u, 0u)); asm volatile("" : "+v"(lane));
    const int wid = wave_id, tid = wid * 64 + lane, wr = wid >> 2, wc = wid & 3, fr = lane & 15, fq = lane >> 4;
    const int K = g.K; int nt = K / BK; asm volatile("" : "+s"(nt));
    unsigned voffB;
    { int R, C; stage_rc(tid * 16, R, C); const int Rb = Epi::PERM ? ((R & ~31) + perm32(R & 31)) : R; voffB = (unsigned)(Rb * g.ldb + C) * 2u; }
    const int soffB = 64 * g.ldb * 2, soffA = 64 * g.lda * 2;
#define PG8_RC(i, R, C) int R, C; { int _t = tid; asm volatile("" : "+v"(_t)); stage_rc(_t * 16 + (i) * 8192, R, C); }
#define nxoff ((LAS v4u*)(lds + 131072) + (wid * 64 + lane_now()))
    const size_t kstep = (size_t)(BK * 2);
    const size_t hstepB = (size_t)HALF * g.ldb * 2;
    const unsigned ldsw = (unsigned)wid * 1024u;
    const int aoff = lds_byte(wr * 64 + fr, fq * 8), boff = lds_byte(wc * 32 + fr, fq * 8);
#define PG8_SA(b, h) (((b) * 2 + (h)) * HTB)
#define PG8_SB(b, h) ((4 + (b) * 2 + (h)) * HTB)
#define PG8_RSRC(p) __builtin_amdgcn_make_buffer_rsrc((void*)(p), 0, 0xffffffff, 0x00020000)
#define PG8_STAGE(bufoff, gbase, voff) do { const __amdgpu_buffer_rsrc_t _r = PG8_RSRC(gbase); \
        __builtin_amdgcn_raw_ptr_buffer_load_lds(_r, (LAS void*)(lds + (bufoff) + ldsw), 16, (int)(voff), 0, 0, 0); \
        __builtin_amdgcn_raw_ptr_buffer_load_lds(_r, (LAS void*)(lds + (bufoff) + ldsw + 8192), 16, (int)(voff), soffB, 0, 0); } while (0)
#define PG8_STAGEA(bufoff, gbase, o0, o1, h) do { const __amdgpu_buffer_rsrc_t _r = PG8_RSRC(gbase); \
        if constexpr (GATHER) { __builtin_amdgcn_raw_ptr_buffer_load_lds(_r, (LAS void*)(lds + (bufoff) + ldsw), 16, (int)(o0), 0, 0, 0); \
                                __builtin_amdgcn_raw_ptr_buffer_load_lds(_r, (LAS void*)(lds + (bufoff) + ldsw + 8192), 16, (int)(o1), 0, 0, 0); } \
        else { __builtin_amdgcn_raw_ptr_buffer_load_lds(_r, (LAS void*)(lds + (bufoff) + ldsw), 16, (int)c00, (h) * 2 * soffA, 0, 0); \
               __builtin_amdgcn_raw_ptr_buffer_load_lds(_r, (LAS void*)(lds + (bufoff) + ldsw + 8192), 16, (int)c00, (h) * 2 * soffA + soffA, 0, 0); } } while (0)
#define PG8_LDA(dst, b, h) do { _Pragma("unroll") for (int m = 0; m < 4; ++m) { \
        if constexpr (FP8) { dst##8[m].lo = *(const LAS v4i_*)(lds + PG8_SA(b, h) + aoff + m * 2048); dst##8[m].hi = *(const LAS v4i_*)(lds + PG8_SA(b, h) + aoff + m * 2048 + 1024); } \
        else { _Pragma("unroll") for (int k = 0; k < 2; ++k) dst[m][k] = *(const LAS bf16x8*)(lds + PG8_SA(b, h) + aoff + m * 2048 + k * 1024); } } } while (0)
#define PG8_LDB(dst, b, h) do { _Pragma("unroll") for (int n = 0; n < 2; ++n) { \
        if constexpr (FP8) { dst##8[n].lo = *(const LAS v4i_*)(lds + PG8_SB(b, h) + boff + n * 2048); dst##8[n].hi = *(const LAS v4i_*)(lds + PG8_SB(b, h) + boff + n * 2048 + 1024); } \
        else { _Pragma("unroll") for (int k = 0; k < 2; ++k) dst[n][k] = *(const LAS bf16x8*)(lds + PG8_SB(b, h) + boff + n * 2048 + k * 1024); } } } while (0)
#define PG8_MMA(ai, bj, At, Bt) do { __builtin_amdgcn_s_setprio(1); _Pragma("unroll") for (int m = 0; m < 4; ++m) _Pragma("unroll") for (int n = 0; n < 2; ++n) { \
        if constexpr (FP8) { acc[ai][bj][m][n] = __builtin_amdgcn_mfma_scale_f32_16x16x128_f8f6f4(Bt##8[n], At##8[m], acc[ai][bj][m][n], 0, 0, 0, 0x7f7f7f7f, 0, 0x7f7f7f7f); } \
        else { _Pragma("unroll") for (int k = 0; k < 2; ++k) acc[ai][bj][m][n] = __builtin_amdgcn_mfma_f32_16x16x32_bf16(Bt[n][k], At[m][k], acc[ai][bj][m][n], 0, 0, 0); } } \
        __builtin_amdgcn_s_setprio(0); } while (0)
#define PG8_WAIT_V(n) asm volatile("s_waitcnt vmcnt(" #n ")" ::: "memory")
#define PG8_WAIT_L(n) asm volatile("s_waitcnt lgkmcnt(" #n ")" ::: "memory")
#define PG8_BAR __builtin_amdgcn_s_barrier()
#define PG8_SCHED __builtin_amdgcn_sched_barrier(0)
    LAS f32x4* scl = (LAS f32x4*)(lds + 131072);
#define PG8_FILL_SCL(u) do { if constexpr (KSEG) { if (tid < 256) { const f32x4* sp = (const f32x4*)(ssq + (size_t)((u).r0 + tid) * 32); \
        const f32x4 p0 = sp[0], p1 = sp[1], p2 = sp[2], p3 = sp[3], p4 = sp[4], p5 = sp[5], p6 = sp[6]; \
        const float sa = (((p0[0] + p0[1]) + (p0[2] + p0[3])) + ((p1[0] + p1[1]) + (p1[2] + p1[3]))) + (((p2[0] + p2[1]) + (p2[2] + p2[3])) + ((p3[0] + p3[1]) + (p3[2] + p3[3]))); \
        const float sb = ((p4[0] + p4[1]) + (p4[2] + p4[3])) + ((p5[0] + p5[1]) + (p5[2] + p5[3])), sc = (p6[0] + p6[1]) + (p6[2] + p6[3]); \
        const float ra = 1.0f / sqrtf(sa * (1.f / 1024.f) + EPS), rb = 1.0f / sqrtf(sb * (1.f / 512.f) + EPS), rc = 1.0f / sqrtf(sc * (1.f / 512.f) + EPS); \
        scl[(ui & 1) * 256 + tid] = (f32x4){ra / rb, rb / rc, rc, 0.f}; } } } while (0)
#define PG8_SCALE(k) do { _Pragma("unroll") for (int _ai = 0; _ai < 2; ++_ai) _Pragma("unroll") for (int _m = 0; _m < 4; ++_m) { const float _f = ((const LAS float*)scl)[((ui & 1) * 256 + _ai * HALF + wr * 64 + _m * 16 + fr) * 4 + (k)]; \
        _Pragma("unroll") for (int _bj = 0; _bj < 2; ++_bj) _Pragma("unroll") for (int _n = 0; _n < 2; ++_n) acc[_ai][_bj][_m][_n] = acc[_ai][_bj][_m][_n] * _f; } } while (0)
    Unit cur, nxt; int ui = 0;
    if (!S.next(0, cur)) return;
    PG8_FILL_SCL(cur);
    f32x4 acc[2][2][4][2];
#pragma unroll
    for (int a = 0; a < 2; ++a)
#pragma unroll
        for (int b = 0; b < 2; ++b)
#pragma unroll
            for (int m = 0; m < 4; ++m)
#pragma unroll
                for (int n = 0; n < 2; ++n) acc[a][b][m][n] = (f32x4){0.f, 0.f, 0.f, 0.f};
    bf16x8 At[4][2], B0[2][2], B1[2][2]; v8i At8[4], B08[2], B18[2];
    const char* cA = cur.a; const char* cB = cur.b;
    unsigned c00, c01, c10, c11;
    { PG8_RC(0, R0, C0); PG8_RC(1, R1, C1);
      if constexpr (GATHER) {
        c00 = S.arow(cur, R0) + C0 * 2u; c01 = S.arow(cur, R1) + C1 * 2u; c10 = S.arow(cur, HALF + R0) + C0 * 2u; c11 = S.arow(cur, HALF + R1) + C1 * 2u;
        asm volatile("s_waitcnt vmcnt(0)" : "+v"(c00), "+v"(c01), "+v"(c10), "+v"(c11) :: "memory");
      } else {
        c00 = (unsigned)(R0 * g.lda + C0) * 2u; c01 = c00; c10 = c00; c11 = c00; (void)R1; (void)C1;
      } }
    PG8_STAGE(PG8_SB(0, 0), cB, voffB); PG8_STAGE(PG8_SB(0, 1), cB + hstepB, voffB); PG8_STAGEA(PG8_SA(0, 0), cA, c00, c01, 0); PG8_STAGEA(PG8_SA(0, 1), cA, c10, c11, 1);
    if (wr == 1) PG8_BAR;
    PG8_WAIT_V(2); PG8_BAR;
    PG8_STAGE(PG8_SB(1, 0), cB + kstep, voffB); PG8_STAGEA(PG8_SA(1, 0), cA + kstep, c00, c01, 0); PG8_STAGE(PG8_SB(1, 1), cB + hstepB + kstep, voffB);
    PG8_WAIT_V(6); PG8_BAR;
#define PG8_KITER(t) do { \
            const bool last = (t == nt - 2); \
            const char* a1 = cA + (size_t)(t + 1) * kstep; \
            const char* a2 = last ? nA : cA + (size_t)(t + 2) * kstep; const char* b2 = last ? nB : cB + (size_t)(t + 2) * kstep; \
            const char* a3 = a2 + kstep; const char* b3 = b2 + kstep; \
            unsigned x00 = c00, x01 = c01, x10 = c10, x11 = c11; \
            if constexpr (GATHER) { if (last) { const v4u nv = *nxoff; x00 = nv.x; x01 = nv.y; x10 = nv.z; x11 = nv.w; } } \
 \
            PG8_LDB(B0, 0, 0); PG8_LDB(B1, 0, 1); PG8_SCHED; PG8_LDA(At, 0, 0); PG8_STAGEA(PG8_SA(1, 1), a1, c10, c11, 1); \
            PG8_WAIT_V(8); PG8_WAIT_L(0); PG8_BAR; PG8_MMA(0, 0, At, B0); PG8_MMA(0, 1, At, B1); PG8_BAR; PG8_SCHED; \
 \
            PG8_LDA(At, 0, 1); PG8_STAGE(PG8_SB(0, 0), b2, voffB); PG8_STAGE(PG8_SB(0, 1), b2 + hstepB, voffB); PG8_STAGEA(PG8_SA(0, 0), a2, x00, x01, 0); \
            PG8_WAIT_V(8); PG8_WAIT_L(0); PG8_BAR; PG8_MMA(1, 0, At, B0); PG8_MMA(1, 1, At, B1); PG8_BAR; PG8_SCHED; \
 \
            PG8_LDB(B0, 1, 0); PG8_LDB(B1, 1, 1); PG8_SCHED; PG8_LDA(At, 1, 0); PG8_STAGEA(PG8_SA(0, 1), a2, x10, x11, 1); \
            PG8_WAIT_V(8); PG8_WAIT_L(0); PG8_BAR; PG8_MMA(0, 0, At, B0); PG8_MMA(0, 1, At, B1); PG8_BAR; PG8_SCHED; \
 \
            PG8_LDA(At, 1, 1); PG8_STAGE(PG8_SB(1, 0), b3, voffB); PG8_STAGE(PG8_SB(1, 1), b3 + hstepB, voffB); PG8_STAGEA(PG8_SA(1, 0), a3, x00, x01, 0); \
            PG8_WAIT_V(8); PG8_WAIT_L(0); PG8_BAR; PG8_MMA(1, 0, At, B0); PG8_MMA(1, 1, At, B1); PG8_BAR; PG8_SCHED; \
        } while (0)
    for (;;) {
        const bool has_next = S.next(ui + 1, nxt);
        const char* nA = has_next ? nxt.a : cA; const char* nB = has_next ? nxt.b : cB;
        if constexpr (GATHER) {
            unsigned n00 = c00, n01 = c01, n10 = c10, n11 = c11;
            if (has_next) { PG8_RC(0, R0, C0); PG8_RC(1, R1, C1); n00 = S.arow(nxt, R0) + C0 * 2u; n01 = S.arow(nxt, R1) + C1 * 2u; n10 = S.arow(nxt, HALF + R0) + C0 * 2u; n11 = S.arow(nxt, HALF + R1) + C1 * 2u; }
            asm volatile("s_waitcnt vmcnt(0)" : "+v"(n00), "+v"(n01), "+v"(n10), "+v"(n11) :: "memory");
            v4u nv; nv.x = n00; nv.y = n01; nv.z = n10; nv.w = n11; *nxoff = nv;
        }
        if constexpr (KSEG) {
#pragma unroll 1
            for (int t = 0; t < 16; t += 2) PG8_KITER(t);
            PG8_SCALE(0);
#pragma unroll 1
            for (int t = 16; t < 24; t += 2) PG8_KITER(t);
            PG8_SCALE(1);
#pragma unroll 1
            for (int t = 24; t < nt; t += 2) PG8_KITER(t);
        } else {
#pragma unroll 1
            for (int t = 0; t < nt; t += 2) PG8_KITER(t);
        }
        if (wr == 0) PG8_BAR;
        if constexpr (KSEG) PG8_SCALE(2);
        { const int le = lane_now(); E(acc, cur, wr, wc, le & 15, le >> 4); }
        if (!has_next) break;
#pragma unroll
        for (int a = 0; a < 2; ++a)
#pragma unroll
            for (int b = 0; b < 2; ++b)
#pragma unroll
                for (int m = 0; m < 4; ++m)
#pragma unroll
                    for (int n = 0; n < 2; ++n) acc[a][b][m][n] = (f32x4){0.f, 0.f, 0.f, 0.f};
        cur = nxt; cA = nA; cB = nB; ++ui;
        if constexpr (KSEG) { PG8_WAIT_L(0); PG8_FILL_SCL(cur); }
        if constexpr (GATHER) { const v4u nv = *nxoff; c00 = nv.x; c01 = nv.y; c10 = nv.z; c11 = nv.w; }
        if (wr == 1) PG8_BAR;
    }
    PG8_WAIT_V(0);
    PG8_BAR;
#undef PG8_RC
#undef PG8_KITER
#undef PG8_FILL_SCL
#undef PG8_SCALE
#undef nxoff
#undef PG8_SA
#undef PG8_SB
#undef PG8_STAGE
#undef PG8_STAGEA
#undef PG8_LDA
#undef PG8_LDB
#undef PG8_MMA
#undef PG8_WAIT_V
#undef PG8_WAIT_L
#undef PG8_BAR
#undef PG8_SCHED
}

typedef const f32x4 (&AccRef)[2][2][4][2];
__device__ __forceinline__ v4u pack8(const f32x4 a, const f32x4 b) { v4u w; w.x = pk2(a[0], a[1]); w.y = pk2(a[2], a[3]); w.z = pk2(b[0], b[1]); w.w = pk2(b[2], b[3]); return w; }

struct EpiProj {
    static constexpr bool PERM = true;
    bf16* PROJ; bf16* UA;
    __device__ __forceinline__ void operator()(AccRef acc, const Unit& u, int wr, int wc, int fr, int fq) const {
        const int row0 = u.r0 + wr * 64 + fr, colb = u.c0 + wc * 32 + 8 * fq;
        const bool isu = (u.c0 == 1280 || u.c0 == 1536);
#pragma unroll
        for (int ai = 0; ai < 2; ++ai)
#pragma unroll
            for (int m = 0; m < 4; ++m) { const int row = row0 + ai * HALF + m * 16;
#pragma unroll
                for (int bj = 0; bj < 2; ++bj) { const int col = colb + bj * HALF; const v4u w = pack8(acc[ai][bj][m][0], acc[ai][bj][m][1]);
                    if (!isu) *(v4u*)(PROJ + (size_t)row * INC + col) = w;
                    else { const int cc = col - 1280, g = cc >> 4, c0 = cc & 15; *(v4u*)(UA + ((size_t)(g * 512 + (row >> 5)) * S5K + (row & 31) * 16 + c0)) = w; } } }
    }
};
struct EpiBf16 {
    static constexpr bool PERM = true;
    bf16* O; int ldc;
    __device__ __forceinline__ void operator()(AccRef acc, const Unit& u, int wr, int wc, int fr, int fq) const {
        const int row0 = u.r0 + wr * 64 + fr, colb = u.c0 + wc * 32 + 8 * fq;
#pragma unroll
        for (int ai = 0; ai < 2; ++ai)
#pragma unroll
            for (int m = 0; m < 4; ++m) { bf16* rowp = O + (size_t)(row0 + ai * HALF + m * 16) * ldc + colb;
#pragma unroll
                for (int bj = 0; bj < 2; ++bj) *(v4u*)(rowp + bj * HALF) = pack8(acc[ai][bj][m][0], acc[ai][bj][m][1]); }
    }
};
struct EpiF32 {
    static constexpr bool PERM = false;
    float* C; int ldc; size_t gstride;
    __device__ __forceinline__ void operator()(AccRef acc, const Unit& u, int wr, int wc, int fr, int fq) const {
        const int row0 = u.r0 + wr * 64 + fr, col0 = u.c0 + wc * 32 + 4 * fq; float* base = C + (size_t)u.aux * gstride;
#pragma unroll
        for (int ai = 0; ai < 2; ++ai)
#pragma unroll
            for (int m = 0; m < 4; ++m) { float* rowp = base + (size_t)(row0 + ai * HALF + m * 16) * ldc + col0;
#pragma unroll
                for (int bj = 0; bj < 2; ++bj)
#pragma unroll
                    for (int n = 0; n < 2; ++n) *(f32x4*)(rowp + bj * HALF + n * 16) = acc[ai][bj][m][n]; }
    }
};
struct EpiS5Y {
    static constexpr bool PERM = true;
    const bf16* UA; const float* dsk; bf16* Gm;
    __device__ __forceinline__ void operator()(AccRef acc, const Unit& u, int wr, int wc, int fr, int fq) const {
        const int row0 = u.r0 + wr * 64 + fr, colb = u.c0 + wc * 32 + 8 * fq, g = u.aux;
#pragma unroll
        for (int ai = 0; ai < 2; ++ai)
#pragma unroll
            for (int m = 0; m < 4; ++m) { const int row = row0 + ai * HALF + m * 16;
#pragma unroll
                for (int bj = 0; bj < 2; ++bj) { const int col = colb + bj * HALF, i = col >> 4, c0 = col & 15;
                    const v4u uw = *(const v4u*)(UA + ((size_t)(g * 512 + row) * S5K + col));
                    const f32x4 d0 = *(const f32x4*)(dsk + g * 16 + c0), d1 = *(const f32x4*)(dsk + g * 16 + c0 + 4);
                    const f32x4 a0 = acc[ai][bj][m][0], a1 = acc[ai][bj][m][1];
                    f32x4 y0, y1;
                    y0[0] = gelu_tanh(a0[0] + d0[0] * bflo(uw.x)); y0[1] = gelu_tanh(a0[1] + d0[1] * bfhi(uw.x)); y0[2] = gelu_tanh(a0[2] + d0[2] * bflo(uw.y)); y0[3] = gelu_tanh(a0[3] + d0[3] * bfhi(uw.y));
                    y1[0] = gelu_tanh(a1[0] + d1[0] * bflo(uw.z)); y1[1] = gelu_tanh(a1[1] + d1[1] * bfhi(uw.z)); y1[2] = gelu_tanh(a1[2] + d1[2] * bflo(uw.w)); y1[3] = gelu_tanh(a1[3] + d1[3] * bfhi(uw.w));
                    *(v4u*)(Gm + ((size_t)row * 32 + i) * 512 + g * 16 + c0) = pack8(y0, y1); } }
    }
};
struct EpiGlu {
    static constexpr bool PERM = true;
    const bf16* Gm; bf16* MIX; float* SS;
    __device__ __forceinline__ void operator()(AccRef acc, const Unit& u, int wr, int wc, int fr, int fq) const {
        const int row0 = u.r0 + wr * 64 + fr, colb = u.c0 + wc * 32 + 8 * fq;
#pragma unroll
        for (int ai = 0; ai < 2; ++ai)
#pragma unroll
            for (int m = 0; m < 4; ++m) { const int row = row0 + ai * HALF + m * 16; float ss = 0.f;
#pragma unroll
                for (int bj = 0; bj < 2; ++bj) { const int col = colb + bj * HALF;
                    const v4u gw = *(const v4u*)(Gm + (size_t)row * 512 + col);
                    const f32x4 a0 = acc[ai][bj][m][0], a1 = acc[ai][bj][m][1];
                    f32x4 y0, y1;
                    y0[0] = bflo(gw.x) * sigmoidf_(a0[0]); y0[1] = bfhi(gw.x) * sigmoidf_(a0[1]); y0[2] = bflo(gw.y) * sigmoidf_(a0[2]); y0[3] = bfhi(gw.y) * sigmoidf_(a0[3]);
                    y1[0] = bflo(gw.z) * sigmoidf_(a1[0]); y1[1] = bfhi(gw.z) * sigmoidf_(a1[1]); y1[2] = bflo(gw.w) * sigmoidf_(a1[2]); y1[3] = bfhi(gw.w) * sigmoidf_(a1[3]);
                    ss += ((y0[0] * y0[0] + y0[1] * y0[1]) + (y0[2] * y0[2] + y0[3] * y0[3])) + ((y1[0] * y1[0] + y1[1] * y1[1]) + (y1[2] * y1[2] + y1[3] * y1[3]));
                    *(v4u*)(MIX + (size_t)row * D + 1024 + col) = pack8(y0, y1); }
                ss += __shfl_xor(ss, 16); ss += __shfl_xor(ss, 32);
                if (fq == 0) SS[(size_t)row * 32 + 16 + (u.c0 >> 8) * 4 + wc] = ss; }
    }
};
struct EpiWo {
    static constexpr bool PERM = true;
    const float* rinv; bf16* X1B; unsigned char* X18; float* part;
    __device__ __forceinline__ void operator()(AccRef acc, const Unit& u, int wr, int wc, int fr, int fq) const {
        const int row0 = u.r0 + wr * 64 + fr, col0 = u.c0 + wc * 32 + 8 * fq;
#pragma unroll
        for (int ai = 0; ai < 2; ++ai) {
            v4u xw[4][2]; float ri[4];
#pragma unroll
            for (int m = 0; m < 4; ++m) { const int row = row0 + ai * HALF + m * 16; ri[m] = rinv[row];
#pragma unroll
                for (int bj = 0; bj < 2; ++bj) xw[m][bj] = *(const v4u*)(X1B + (size_t)row * D + col0 + bj * HALF); }
#pragma unroll
            for (int m = 0; m < 4; ++m) { const int row = row0 + ai * HALF + m * 16; const size_t off = (size_t)row * D + col0; float ss = 0.f;
#pragma unroll
                for (int bj = 0; bj < 2; ++bj) { const v4u x = xw[m][bj]; const float r = ri[m];
                    f32x4 v0, v1;
                    v0[0] = bflo(x.x) * r + acc[ai][bj][m][0][0]; v0[1] = bfhi(x.x) * r + acc[ai][bj][m][0][1]; v0[2] = bflo(x.y) * r + acc[ai][bj][m][0][2]; v0[3] = bfhi(x.y) * r + acc[ai][bj][m][0][3];
                    v1[0] = bflo(x.z) * r + acc[ai][bj][m][1][0]; v1[1] = bfhi(x.z) * r + acc[ai][bj][m][1][1]; v1[2] = bflo(x.w) * r + acc[ai][bj][m][1][2]; v1[3] = bfhi(x.w) * r + acc[ai][bj][m][1][3];
                    ss += ((v0[0] * v0[0] + v0[1] * v0[1]) + (v0[2] * v0[2] + v0[3] * v0[3])) + ((v1[0] * v1[0] + v1[1] * v1[1]) + (v1[2] * v1[2] + v1[3] * v1[3]));
                    *(v4u*)(X1B + off + bj * HALF) = pack8(v0, v1);
                    v2u w8; w8.x = pk4_fp8(v0[0] * SC_X, v0[1] * SC_X, v0[2] * SC_X, v0[3] * SC_X); w8.y = pk4_fp8(v1[0] * SC_X, v1[1] * SC_X, v1[2] * SC_X, v1[3] * SC_X);
                    *(v2u*)(X18 + off + bj * HALF) = w8; }
                ss += __shfl_xor(ss, 16); ss += __shfl_xor(ss, 32);
                if (fq == 0) part[(size_t)row * 32 + (u.c0 >> 8) * 4 + wc] = ss; }
            asm volatile("" ::: "memory");
        }
    }
};
struct EpiLogit {
    static constexpr bool PERM = false;
    float* LP;
    __device__ __forceinline__ void operator()(AccRef acc, const Unit& u, int wr, int wc, int fr, int fq) const {
        const int row0 = u.r0 + wr * 64 + fr, col0 = wc * 32 + 4 * fq; float* base = LP + (size_t)u.aux * T * 80;
#pragma unroll
        for (int ai = 0; ai < 2; ++ai)
#pragma unroll
            for (int m = 0; m < 4; ++m) { float* rowp = base + (size_t)(row0 + ai * HALF + m * 16) * 80 + col0;
#pragma unroll
                for (int n = 0; n < 2; ++n) if (col0 + n * 16 < 80) *(f32x4*)(rowp + n * 16) = acc[ai][0][m][n]; }
    }
};
struct EpiGU {
    static constexpr bool PERM = true;
    const int* list; const float* rstd; const LAS int* cnt; unsigned char* ACT;
    __device__ __forceinline__ void operator()(AccRef acc, const Unit& u, int wr, int wc, int fr, int fq) const {
        const int e = u.aux, nreal = cnt[e], rb = wr * 64 + fr, colb = u.c0 * 128 + wc * 32 + 8 * fq;
#pragma unroll
        for (int ai = 0; ai < 2; ++ai)
#pragma unroll
            for (int m = 0; m < 4; ++m) { const int r = rb + ai * HALF + m * 16; int rr = u.r1 + r; rr = rr < nreal ? rr : nreal - 1;
                const float rs = rstd[(size_t)e * LCAP + rr] * (1.0f / (SC_X * SC_WGU));
                f32x4 y0, y1;
#pragma unroll
                for (int j = 0; j < 4; ++j) { const float g0 = acc[ai][0][m][0][j] * rs, g1 = acc[ai][0][m][1][j] * rs;
                    y0[j] = g0 * sigmoidf_(g0) * (acc[ai][1][m][0][j] * rs) * SC_ACT; y1[j] = g1 * sigmoidf_(g1) * (acc[ai][1][m][1][j] * rs) * SC_ACT; }
                v2u w8; w8.x = pk4_fp8(y0[0], y0[1], y0[2], y0[3]); w8.y = pk4_fp8(y1[0], y1[1], y1[2], y1[3]);
                *(v2u*)(ACT + (size_t)(u.r0 + r) * DEXP + colb) = w8; }
    }
};
struct EpiDown {
    static constexpr bool PERM = true;
    const int* list; const float* wts; const LAS int* cnt; unsigned char* Y2;
    __device__ __forceinline__ void operator()(AccRef acc, const Unit& u, int wr, int wc, int fr, int fq) const {
        const int e = u.aux, n = cnt[e], row0 = u.r1 + wr * 64 + fr, colb = u.c0 * 256 + wc * 32 + 8 * fq;
#pragma unroll
        for (int ai = 0; ai < 2; ++ai)
#pragma unroll
            for (int m = 0; m < 4; ++m) { const int r = row0 + ai * HALF + m * 16;
                if (r < n) { const int ent = list[(size_t)e * LCAP + r]; const float w = wts[(size_t)e * LCAP + r] * (SC_Y / (SC_ACT * SC_WD));   unsigned char* rowp = Y2 + (size_t)ent * D + colb;
#pragma unroll
                    for (int bj = 0; bj < 2; ++bj) { const f32x4 a0 = acc[ai][bj][m][0] * w, a1 = acc[ai][bj][m][1] * w; v2u w8; w8.x = pk4_fp8(a0[0], a0[1], a0[2], a0[3]); w8.y = pk4_fp8(a1[0], a1[1], a1[2], a1[3]);
                        *(v2u*)(rowp + bj * HALF) = w8; } } }
    }
};
struct KSplitOrder {
    const char* A; const char* Bt; int lda, ldb, K, nM, nks, G, c;
    __device__ bool next(int i, Unit& u) const {
        const int L = i * G + c; if (L >= nM * nks) return false;
        const int pm = L / nks, ks = L % nks;
        u.a = A + ((size_t)pm * BM * lda + (size_t)ks * K) * 2; u.b = Bt + (size_t)ks * BM * ldb * 2; u.r0 = pm * BM; u.c0 = 0; u.aux = ks; u.r1 = 0; return true;
    }
    __device__ __forceinline__ unsigned arow(const Unit&, int) const { return 0u; }
};
}

struct Frame {
    LAS unsigned char* lds;
    unsigned* ctl;
    int tid, lane, wave, vcu, G;
    const float* const __attribute__((address_space(4)))* in;
    float* out; unsigned char* ws;
};
enum { I_X = 0, I_MEM, I_NORM_MIX, I_W_IN, I_Q_NORM, I_K_NORM, I_SINKS, I_REL_BIAS, I_LAM_RE, I_LAM_IM, I_LOG_DT, I_B_RE, I_B_IM, I_C_RE, I_C_IM, I_SSM_D, I_W_GLU,
       I_MEM_NORM, I_W_MEM_KV, I_XQ_NORM, I_XK_NORM, I_ON_ATTN, I_ON_SSM, I_ON_X, I_W_O, I_NORM_FFN, I_WR_G, I_WR_E, I_W_GATE, I_W_UP, I_W_DOWN };

struct TrItem { const float* W; bf16* WT; const float* ks; int ldw, ldt, k0, n0, drow0; };
__device__ __forceinline__ void tr_load(const TrItem& it, f32x4 (&v)[8], int lane) {
    const int kc = lane & 7, nq = lane >> 3; const float* src = it.W + (size_t)(it.k0 + kc * 8) * it.ldw + it.n0 + nq * 4;
#pragma unroll
    for (int j = 0; j < 8; ++j) v[j] = __builtin_nontemporal_load((const f32x4*)(src + (size_t)j * it.ldw));
}
__device__ __forceinline__ void tr_store(const TrItem& it, f32x4 (&v)[8], int lane) {
    const int kc = lane & 7, nq = lane >> 3;
    if (it.ks) { const f32x4 s0 = *(const f32x4*)(it.ks + it.k0 + kc * 8), s1 = *(const f32x4*)(it.ks + it.k0 + kc * 8 + 4);
#pragma unroll
        for (int j = 0; j < 4; ++j) { v[j] = v[j] * s0[j]; v[4 + j] = v[4 + j] * s1[j]; } }
#pragma unroll
    for (int i = 0; i < 4; ++i) { v4u o; o.x = pk2(v[0][i], v[1][i]); o.y = pk2(v[2][i], v[3][i]); o.z = pk2(v[4][i], v[5][i]); o.w = pk2(v[6][i], v[7][i]);
        *(v4u*)(it.WT + (size_t)(it.drow0 + nq * 4 + i) * it.ldt + it.k0 + kc * 8) = o; }
}
__device__ __forceinline__ void rms_row_to_bf16(const float* xrow, const float* gain, bf16* orow, int lane, float* rinv = nullptr) {
    const f32x4* xr = (const f32x4*)xrow + lane; const f32x4* gr = (const f32x4*)gain + lane;
    f32x4 v[8]; float s = 0.f;
#pragma unroll
    for (int j = 0; j < 8; ++j) { v[j] = xr[64 * j]; s += (v[j].x * v[j].x + v[j].y * v[j].y) + (v[j].z * v[j].z + v[j].w * v[j].w); }
    const float ms = wave_sum(s) * (1.f / 2048.f) + EPS; const float rstd = 1.0f / sqrtf(ms);
    if (rinv && lane == 0) *rinv = sqrtf(ms);
    v2u* o8 = (v2u*)orow + lane;
#pragma unroll
    for (int j = 0; j < 8; ++j) { const f32x4 g = gain ? gr[64 * j] : (f32x4){1.f, 1.f, 1.f, 1.f}; v2u w; w.x = pk2(v[j].x * rstd * g.x, v[j].y * rstd * g.y); w.y = pk2(v[j].z * rstd * g.z, v[j].w * rstd * g.w); o8[64 * j] = w; }
}

__device__ __forceinline__ void s5_tables(Frame& F, int g) {
    LAS float* ap = (LAS float*)F.lds;
    LAS float* Bb = ap + 33 * 64 * 2;
    LAS float* Cc = Bb + 64 * 16 * 2;
    LAS float* Km = Cc + 16 * 64 * 2;
    const float dt = expf(F.in[I_LOG_DT][g]);
    const float* lre = F.in[I_LAM_RE] + g * 64; const float* lim = F.in[I_LAM_IM] + g * 64;
    for (int idx = F.tid; idx < 33 * 64; idx += 512) { const int tau = idx >> 6, n = idx & 63; const float lr = lre[n], li = lim[n];
        const float mag = expf((float)tau * (lr * dt)), ang = (float)tau * (li * dt); ap[idx * 2] = mag * cosf(ang); ap[idx * 2 + 1] = mag * sinf(ang); }
    __syncthreads();
    for (int idx = F.tid; idx < 64 * 16; idx += 512) { const int n = idx >> 4; const float lr = lre[n], li = lim[n];
        const float nr = ap[(64 + n) * 2] - 1.0f, ni = ap[(64 + n) * 2 + 1], den = lr * lr + li * li;
        const float cr = (nr * lr + ni * li) / den, ci = (ni * lr - nr * li) / den;
        const float br = F.in[I_B_RE][(size_t)g * 1024 + idx], bi = F.in[I_B_IM][(size_t)g * 1024 + idx];
        Bb[idx * 2] = cr * br - ci * bi; Bb[idx * 2 + 1] = cr * bi + ci * br; }
    for (int idx = F.tid; idx < 16 * 64; idx += 512) { Cc[idx * 2] = F.in[I_C_RE][(size_t)g * 1024 + idx]; Cc[idx * 2 + 1] = F.in[I_C_IM][(size_t)g * 1024 + idx]; }
    __syncthreads();
    for (int idx = F.tid; idx < 32 * 256; idx += 512) { const int tau = idx >> 8, c = (idx >> 4) & 15, c2 = idx & 15; float s = 0.f;
        for (int n = 0; n < 64; ++n) { const float ar = ap[(tau * 64 + n) * 2], ai = ap[(tau * 64 + n) * 2 + 1], cr = Cc[(c * 64 + n) * 2], ci = Cc[(c * 64 + n) * 2 + 1];
            const float er = cr * ar - ci * ai, ei = cr * ai + ci * ar; s += er * Bb[(n * 16 + c2) * 2] - ei * Bb[(n * 16 + c2) * 2 + 1]; }
        Km[idx] = s; }
    __syncthreads();
    bf16* MQ = (bf16*)(F.ws + WS_MQ) + (size_t)g * 512 * S5K;
    for (int idx = F.tid; idx < 512 * 80; idx += 512) { const int row = idx / 80, ch = idx % 80, i = row >> 4, c = row & 15, k0 = ch * 8; float v[8];
        if (k0 < 512) { const int s = k0 >> 4, c20 = k0 & 15, tau = i - s;
#pragma unroll
            for (int j = 0; j < 8; ++j) v[j] = tau >= 0 ? Km[(tau * 16 + c) * 16 + c20 + j] : 0.f;
        } else { const int kk = k0 - 512, ri = kk >> 6, n0 = kk & 63;
#pragma unroll
            for (int j = 0; j < 8; ++j) { const int n = n0 + j; const float ar = ap[((i + 1) * 64 + n) * 2], ai = ap[((i + 1) * 64 + n) * 2 + 1], cr = Cc[(c * 64 + n) * 2], ci = Cc[(c * 64 + n) * 2 + 1];
                v[j] = ri == 0 ? (cr * ar - ci * ai) : -(cr * ai + ci * ar); } }
        v4u o; o.x = pk2(v[0], v[1]); o.y = pk2(v[2], v[3]); o.z = pk2(v[4], v[5]); o.w = pk2(v[6], v[7]);
        *(v4u*)(MQ + (size_t)row * S5K + k0) = o; }
    bf16* SP = (bf16*)(F.ws + WS_SP) + (size_t)g * 256 * 512;
    for (int idx = F.tid; idx < 256 * 64; idx += 512) { const int row = idx >> 6, k0 = (idx & 63) * 8; float v[8];
        if (row < 128) { const int ri = row >> 6, n = row & 63, s = k0 >> 4, c20 = k0 & 15; const float ar = ap[((31 - s) * 64 + n) * 2], ai = ap[((31 - s) * 64 + n) * 2 + 1];
#pragma unroll
            for (int j = 0; j < 8; ++j) { const float br = Bb[(n * 16 + c20 + j) * 2], bi = Bb[(n * 16 + c20 + j) * 2 + 1]; v[j] = ri == 0 ? (ar * br - ai * bi) : (ar * bi + ai * br); }
        } else {
#pragma unroll
            for (int j = 0; j < 8; ++j) v[j] = 0.f; }
        v4u o; o.x = pk2(v[0], v[1]); o.y = pk2(v[2], v[3]); o.z = pk2(v[4], v[5]); o.w = pk2(v[6], v[7]);
        *(v4u*)(SP + (size_t)row * 512 + k0) = o; }
    float* AL = (float*)(F.ws + WS_AL) + g * 128;
    if (F.tid < 64) { AL[F.tid * 2] = ap[(32 * 64 + F.tid) * 2]; AL[F.tid * 2 + 1] = ap[(32 * 64 + F.tid) * 2 + 1]; }
    __syncthreads();
}

struct BigTile { const float* src; unsigned char* dst; const float* ks; float sc; int ldw, ldt; };
constexpr int BT_GU = 64 * 2 * 64, BT_D = 64 * 64, BT_N = BT_GU + BT_D, BT_PITCH = 136;
__device__ __forceinline__ BigTile bt_decode(const Frame& F, unsigned char* Wgu8, unsigned char* Wd8, const float* nf, int ti) {
    BigTile t;
    const unsigned long long pg = (unsigned long long)F.in[I_W_GATE], pu = (unsigned long long)F.in[I_W_UP], pd = (unsigned long long)F.in[I_W_DOWN];
    if (ti < BT_GU) { const int e = ti >> 7, r = ti & 127, which = r >> 6, kb = (r >> 2) & 15, nb = r & 3;
        const unsigned long long p = pg + ((pu - pg) & (0ull - (unsigned long long)which));
        t.src = (const float*)p + (size_t)e * D * DEXP + (size_t)kb * 128 * DEXP + nb * 128; t.dst = Wgu8 + ((size_t)e * 1024 + nb * 256 + which * 128) * D + kb * 128; t.ks = nf + kb * 128; t.sc = SC_WGU; t.ldw = DEXP; t.ldt = D; }
    else { const int t2 = ti - BT_GU, e = t2 >> 6, r = t2 & 63, kb = r >> 4, nb = r & 15;
        t.src = (const float*)pd + (size_t)e * DEXP * D + (size_t)kb * 128 * D + nb * 128; t.dst = Wd8 + ((size_t)e * D + nb * 128) * DEXP + kb * 128; t.ks = nullptr; t.sc = SC_WD; t.ldw = D; t.ldt = DEXP; }
    return t;
}
#define BT_LOAD(t, v, kv) do { const unsigned _lo = (unsigned)(rl * 8 * (t).ldw + cq * 4); \
    _Pragma("unroll") for (int _p = 0; _p < 8; ++_p) kv[_p] = (t).ks ? (t).ks[rl * 8 + _p] * (t).sc : (t).sc; \
    _Pragma("unroll") for (int _p = 0; _p < 8; ++_p) v[_p] = __builtin_nontemporal_load((const f32x4*)((t).src + (size_t)_p * (t).ldw + _lo)); } while (0)
#define BT_STORE(t, v, kv) do { \
    _Pragma("unroll") for (int _i = 0; _i < 4; ++_i) { v2u _w; _w.x = pk4_fp8(v[0][_i] * kv[0], v[1][_i] * kv[1], v[2][_i] * kv[2], v[3][_i] * kv[3]); _w.y = pk4_fp8(v[4][_i] * kv[4], v[5][_i] * kv[5], v[6][_i] * kv[6], v[7][_i] * kv[7]); \
        *(LAS v2u*)(img + (cq * 4 + _i) * BT_PITCH + rl * 8) = _w; } \
    __syncthreads(); \
    _Pragma("unroll") for (int _j = 0; _j < 2; ++_j) { const int _idx = tid_ + _j * 512, _n = _idx >> 3, _ch = _idx & 7; \
        const v2u _a = *(const LAS v2u*)(img + _n * BT_PITCH + _ch * 16), _b = *(const LAS v2u*)(img + _n * BT_PITCH + _ch * 16 + 8); v4u _o; _o.x = _a.x; _o.y = _a.y; _o.z = _b.x; _o.w = _b.y; \
        *(v4u*)((t).dst + (size_t)_n * (t).ldt + _ch * 16) = _o; } \
    __syncthreads(); } while (0)
__device__ __forceinline__ void bg_convert(Frame& F, int qword, int base, int ntiles, int budget) {
    if (budget <= 0) return;
    int lane_ = (int)__builtin_amdgcn_mbcnt_hi(~0u, __builtin_amdgcn_mbcnt_lo(~0u, 0u)); asm volatile("" : "+v"(lane_)); const int tid_ = F.wave * 64 + lane_;
    unsigned char* WguT = F.ws + WS_WGU; unsigned char* WdT = F.ws + WS_WD; const float* nf = F.in[I_NORM_FFN];
    const int rl = tid_ >> 5, cq = tid_ & 31; LAS unsigned char* img = F.lds; LAS int* qn = (LAS int*)(F.lds + TAB_OFF + 1024);
    f32x4 va[8], vb[8]; float ka[8], kb[8];
    int nfetch = 0;
#define BG_FETCH(slot) do { if (nfetch < budget) { if (tid_ == 0) qn[slot] = (int)atomicAdd(F.ctl + qword, 1u); } else if (tid_ == 0) qn[slot] = 0x7fffffff; ++nfetch; } while (0)
    __syncthreads();
    BG_FETCH(0); BG_FETCH(1);
    __syncthreads();
    int i0 = __builtin_amdgcn_readfirstlane(qn[0]), i1 = __builtin_amdgcn_readfirstlane(qn[1]);
    __syncthreads();
    if (i0 < ntiles) { const BigTile t0 = bt_decode(F, WguT, WdT, nf, base + i0); BT_LOAD(t0, va, ka); }
    while (i0 < ntiles) {
        const BigTile ta = bt_decode(F, WguT, WdT, nf, base + i0);
        const BigTile tb = bt_decode(F, WguT, WdT, nf, base + (i1 < ntiles ? i1 : i0));
        BT_LOAD(tb, vb, kb);
        if (i1 >= ntiles) budget = 0;
        BG_FETCH(0);
        BT_STORE(ta, va, ka);
        const int i2 = __builtin_amdgcn_readfirstlane(qn[0]);
        if (i1 >= ntiles) break;
        const BigTile tc = bt_decode(F, WguT, WdT, nf, base + (i2 < ntiles ? i2 : i1));
        BT_LOAD(tc, va, ka);
        if (i2 >= ntiles) budget = 0;
        BG_FETCH(1);
        BT_STORE(tb, vb, kb);
        const int i3 = __builtin_amdgcn_readfirstlane(qn[1]);
        i0 = i2; i1 = i3;
    }
    __syncthreads();
#undef BG_FETCH
}
__device__ __forceinline__ void p0_prologue(Frame& F) {
    if (F.vcu < 32) s5_tables(F, F.vcu);
    const int gw = F.vcu * 8 + F.wave, NGW = F.G * 8;
    bf16* WinT = (bf16*)(F.ws + WS_WIN); bf16* WoT = (bf16*)(F.ws + WS_WO); bf16* WmkvT = (bf16*)(F.ws + WS_WMKV); bf16* WgluT = (bf16*)(F.ws + WS_WGLU);
    const float* nf = F.in[I_NORM_FFN];
    constexpr int I_IN = 32 * 72, I_O = 32 * 64, I_MKV = 32 * 32, I_GLU = 8 * 16;
    constexpr int NITEMS = I_IN + I_O + I_MKV + I_GLU;
    auto decode = [&](int it) -> TrItem {
        int r = it;
        if (r < I_IN) { const int kb = r / 72, nb = r % 72; return TrItem{F.in[I_W_IN], WinT, F.in[I_NORM_MIX]  , INC, D, kb * 64, nb * 32, nb * 32}; } r -= I_IN;
        if (r < I_O) { const int kb = r / 64, nb = r % 64, k0 = kb * 64;
            const unsigned long long pa = (unsigned long long)F.in[I_ON_ATTN], ps = (unsigned long long)(F.in[I_ON_SSM] - 1024), px = (unsigned long long)(F.in[I_ON_X] - 1536);
            const unsigned long long m1 = 0ull - (unsigned long long)(k0 >= 1024), m2 = 0ull - (unsigned long long)(k0 >= 1536);
            const unsigned long long pk = pa + ((ps - pa) & m1) + ((px - ps) & m2);
            return TrItem{F.in[I_W_O], WoT, (const float*)pk, D, D, k0, nb * 32, nb * 32}; } r -= I_O;
        if (r < I_MKV) { const int kb = r / 32, nb = r % 32; return TrItem{F.in[I_W_MEM_KV], WmkvT, nullptr, 1024, D, kb * 64, nb * 32, nb * 32}; } r -= I_MKV;
        const int kb = r / 16, nb = r % 16; return TrItem{F.in[I_W_GLU], WgluT, nullptr, 512, 512, kb * 64, nb * 32, nb * 32};
    };
    {
        f32x4 va[8], vb[8]; int it = gw; TrItem ia, ib;
        if (it < NITEMS) { ia = decode(it); tr_load(ia, va, F.lane); }
        while (it < NITEMS) {
            const int it2 = it + NGW; if (it2 < NITEMS) { ib = decode(it2); tr_load(ib, vb, F.lane); }
            tr_store(ia, va, F.lane);
            if (it2 >= NITEMS) break;
            const int it3 = it2 + NGW; if (it3 < NITEMS) { ia = decode(it3); tr_load(ia, va, F.lane); }
            tr_store(ib, vb, F.lane);
            it = it3;
        }
    }
    { bf16* WrT = (bf16*)(F.ws + WS_WR); const int gt = F.vcu * 512 + F.tid, NT = F.G * 512;
      for (int idx = gt; idx < 4 * 256 * 512; idx += NT) { const int ks = idx >> 17, n = (idx >> 9) & 255, k = ks * 512 + (idx & 511); float v = 0.f;
          if (n < 8) v = F.in[I_WR_G][k * 8 + n] * nf[k]; else if (n < 72) v = F.in[I_WR_E][k * 64 + (n - 8)] * nf[k];
          WrT[idx] = (bf16)f2bf(v); } }
    bf16* XN = (bf16*)(F.ws + WS_XN); bf16* MEMN = (bf16*)(F.ws + WS_MEMN);
    for (int m = gw; m < T; m += NGW) rms_row_to_bf16(F.in[I_X] + (size_t)m * D, nullptr, XN + (size_t)m * D, F.lane, (float*)(F.ws + WS_RINV) + m);
    for (int m = gw; m < NB * MEML; m += NGW) rms_row_to_bf16(F.in[I_MEM] + (size_t)m * D, F.in[I_MEM_NORM], MEMN + (size_t)m * D, F.lane);
    bg_convert(F, CW_QGU, 0, BT_GU, F.vcu < 32 ? PB0_S5 : PB0);
    bg_convert(F, CW_QD, BT_GU, BT_D, PB0_D);
}

constexpr int SWA_KS = 72, SWA_VS = 264;
constexpr int SWA_KOFF = 0, SWA_VOFF = 256 * SWA_KS * 2, SWA_BOFF = SWA_VOFF + 64 * SWA_VS * 2;
__device__ __forceinline__ int t5_bucket(int n) { if (n < 16) return n; const int v = 16 + (int)(logf((float)n * (1.0f / 16.0f)) / logf(8.0f) * 16.0f); return v < 31 ? v : 31; }
__device__ __forceinline__ void swa_unit(Frame& F, int unit) {
    const int b = unit >> 5, kvh = (unit >> 4) & 1, nb = unit & 15;
    const bf16* PROJ = (const bf16*)(F.ws + WS_PROJ); bf16* MIX = (bf16*)(F.ws + WS_MIX);
    LAS bf16* Ks = (LAS bf16*)(F.lds + SWA_KOFF); LAS bf16* Vt = (LAS bf16*)(F.lds + SWA_VOFF); LAS float* bt = (LAS float*)(F.lds + SWA_BOFF);
    const int w = F.wave, h = kvh * 8 + w, ql = F.lane & 31, hh = F.lane >> 5;
    v4u qnx[4];
    { const bf16* qp = PROJ + ((size_t)b * SEQ + nb * 128 + ql) * INC + h * 64 + 8 * hh;
#pragma unroll
      for (int ks = 0; ks < 4; ++ks) qnx[ks] = *(const v4u*)(qp + ks * 16); }
    __syncthreads();
    {
        const int key = F.tid >> 1, half = F.tid & 1, s = (nb - 1) * 128 + key;
        v4u kw[4], vw[4];
        if (s >= 0) { const bf16* rp = PROJ + (size_t)(b * SEQ + s) * INC + 1024 + kvh * 64 + half * 32;
#pragma unroll
            for (int j = 0; j < 4; ++j) { kw[j] = *(const v4u*)(rp + j * 8); vw[j] = *(const v4u*)(rp + 128 + j * 8); }
        } else {
#pragma unroll
            for (int j = 0; j < 4; ++j) { kw[j] = (v4u){0u, 0u, 0u, 0u}; vw[j] = (v4u){0u, 0u, 0u, 0u}; } }
        float kf[32]; float ss = 0.f;
#pragma unroll
        for (int j = 0; j < 4; ++j) { kf[j * 8 + 0] = bflo(kw[j].x); kf[j * 8 + 1] = bfhi(kw[j].x); kf[j * 8 + 2] = bflo(kw[j].y); kf[j * 8 + 3] = bfhi(kw[j].y);
            kf[j * 8 + 4] = bflo(kw[j].z); kf[j * 8 + 5] = bfhi(kw[j].z); kf[j * 8 + 6] = bflo(kw[j].w); kf[j * 8 + 7] = bfhi(kw[j].w); }
#pragma unroll
        for (int j = 0; j < 32; ++j) ss += kf[j] * kf[j];
        ss += __shfl_xor(ss, 1);
        const float rstd = 1.0f / sqrtf(ss * (1.f / 64.f) + EPS);
        const float* kn = F.in[I_K_NORM] + half * 32;
#pragma unroll
        for (int j = 0; j < 4; ++j) { v4u o; o.x = pk2(kf[j * 8 + 0] * rstd * kn[j * 8 + 0], kf[j * 8 + 1] * rstd * kn[j * 8 + 1]); o.y = pk2(kf[j * 8 + 2] * rstd * kn[j * 8 + 2], kf[j * 8 + 3] * rstd * kn[j * 8 + 3]);
            o.z = pk2(kf[j * 8 + 4] * rstd * kn[j * 8 + 4], kf[j * 8 + 5] * rstd * kn[j * 8 + 5]); o.w = pk2(kf[j * 8 + 6] * rstd * kn[j * 8 + 6], kf[j * 8 + 7] * rstd * kn[j * 8 + 7]);
            *(LAS v4u*)(Ks + key * SWA_KS + half * 32 + j * 8) = o; }
#pragma unroll
        for (int j = 0; j < 4; ++j) { const unsigned w4[4] = {vw[j].x, vw[j].y, vw[j].z, vw[j].w};
#pragma unroll
            for (int q = 0; q < 4; ++q) { const int d = half * 32 + j * 8 + q * 2; Vt[d * SWA_VS + key] = (bf16)(w4[q] & 0xffffu); Vt[(d + 1) * SWA_VS + key] = (bf16)(w4[q] >> 16); } }
        for (int idx = F.tid; idx < 8 * 128; idx += 512) { const int w = idx >> 7, dl = idx & 127; bt[idx] = F.in[I_REL_BIAS][t5_bucket(dl) * 16 + kvh * 8 + w]; }
    }
    __syncthreads();
    const float sink = F.in[I_SINKS][h];
    const float* qn = F.in[I_Q_NORM];
    for (int r = 0; r < 4; ++r) {
        const int qi = 32 * r + ql; const size_t t = (size_t)b * SEQ + nb * 128 + qi;
        bf16x8 qf[4];
        {   v4u qw[4]; float qv[32]; float ss = 0.f;
#pragma unroll
            for (int ks = 0; ks < 4; ++ks) qw[ks] = qnx[ks];
            if (r < 3) { const bf16* qp = PROJ + (t + 32) * INC + h * 64 + 8 * hh;
#pragma unroll
                for (int ks = 0; ks < 4; ++ks) qnx[ks] = *(const v4u*)(qp + ks * 16); }
#pragma unroll
            for (int ks = 0; ks < 4; ++ks) { qv[ks * 8 + 0] = bflo(qw[ks].x); qv[ks * 8 + 1] = bfhi(qw[ks].x); qv[ks * 8 + 2] = bflo(qw[ks].y); qv[ks * 8 + 3] = bfhi(qw[ks].y);
                qv[ks * 8 + 4] = bflo(qw[ks].z); qv[ks * 8 + 5] = bfhi(qw[ks].z); qv[ks * 8 + 6] = bflo(qw[ks].w); qv[ks * 8 + 7] = bfhi(qw[ks].w); }
#pragma unroll
            for (int j = 0; j < 32; ++j) ss += qv[j] * qv[j];
            ss += __shfl_xor(ss, 32);
            const float sc = 0.125f / sqrtf(ss * (1.f / 64.f) + EPS);
#pragma unroll
            for (int ks = 0; ks < 4; ++ks) { const float* g = qn + ks * 16 + 8 * hh; v4u o;
                o.x = pk2(qv[ks * 8 + 0] * sc * g[0], qv[ks * 8 + 1] * sc * g[1]); o.y = pk2(qv[ks * 8 + 2] * sc * g[2], qv[ks * 8 + 3] * sc * g[3]);
                o.z = pk2(qv[ks * 8 + 4] * sc * g[4], qv[ks * 8 + 5] * sc * g[5]); o.w = pk2(qv[ks * 8 + 6] * sc * g[6], qv[ks * 8 + 7] * sc * g[7]);
                qf[ks] = __builtin_bit_cast(bf16x8, o); } }
        f32x16 s[5];
        const int qh = ql - 4 * hh; const LAS float* pb = bt + w * 128 + qh;
        float mx = sink;
#pragma unroll
        for (int kt = 0; kt < 5; ++kt) {
            const bool live = (nb > 0) || (r + kt >= 4);
            f32x16 a = {0.f, 0.f, 0.f, 0.f, 0.f, 0.f, 0.f, 0.f, 0.f, 0.f, 0.f, 0.f, 0.f, 0.f, 0.f, 0.f};
            if (live) {
#pragma unroll
                for (int ks = 0; ks < 4; ++ks) { const bf16x8 kfrag = *(const LAS bf16x8*)(Ks + (32 * (r + kt) + ql) * SWA_KS + ks * 16 + 8 * hh);
                    a = __builtin_amdgcn_mfma_f32_32x32x16_bf16(kfrag, qf[ks], a, 0, 0, 0); }
#pragma unroll
                for (int rg = 0; rg < 16; ++rg) { const int rowc = (rg & 3) + 8 * (rg >> 2);
                    float v = a[rg] + pb[128 - 32 * kt - rowc];
                    if (kt == 0) v = (rowc > qh) ? v : -1e30f;
                    if (kt == 4) v = (rowc <= qh) ? v : -1e30f;
                    a[rg] = v; mx = fmaxf(mx, v); }
            } else {
#pragma unroll
                for (int rg = 0; rg < 16; ++rg) a[rg] = -1e30f;
            }
            s[kt] = a; }
        mx = fmaxf(mx, __shfl_xor(mx, 32));
        float l = 0.f;
#pragma unroll
        for (int kt = 0; kt < 5; ++kt)
#pragma unroll
            for (int rg = 0; rg < 16; ++rg) { const float p = fast_exp(s[kt][rg] - mx); s[kt][rg] = p; l += p; }
        l += __shfl_xor(l, 32);
        l += fast_exp(sink - mx);
        f32x16 o[2];
#pragma unroll
        for (int dt = 0; dt < 2; ++dt) o[dt] = (f32x16){0.f, 0.f, 0.f, 0.f, 0.f, 0.f, 0.f, 0.f, 0.f, 0.f, 0.f, 0.f, 0.f, 0.f, 0.f, 0.f};
#pragma unroll
        for (int kt = 0; kt < 5; ++kt)
#pragma unroll
            for (int st = 0; st < 2; ++st) { v4u pw; pw.x = pk2(s[kt][8 * st + 0], s[kt][8 * st + 1]); pw.y = pk2(s[kt][8 * st + 2], s[kt][8 * st + 3]); pw.z = pk2(s[kt][8 * st + 4], s[kt][8 * st + 5]); pw.w = pk2(s[kt][8 * st + 6], s[kt][8 * st + 7]);
                const bf16x8 pf = __builtin_bit_cast(bf16x8, pw);
#pragma unroll
                for (int dt = 0; dt < 2; ++dt) { const LAS bf16* vp = Vt + (dt * 32 + ql) * SWA_VS + 32 * (r + kt) + 16 * st + 4 * hh;
                    const v2u lo = *(const LAS v2u*)vp, hi = *(const LAS v2u*)(vp + 8); v4u vv; vv.x = lo.x; vv.y = lo.y; vv.z = hi.x; vv.w = hi.y;
                    o[dt] = __builtin_amdgcn_mfma_f32_32x32x16_bf16(__builtin_bit_cast(bf16x8, vv), pf, o[dt], 0, 0, 0); } }
        const float inv = 1.0f / l;
        { float ssq = 0.f;
#pragma unroll
          for (int dt = 0; dt < 2; ++dt)
#pragma unroll
              for (int rg = 0; rg < 16; ++rg) { const float v = o[dt][rg] * inv; ssq += v * v; }
          ssq += __shfl_xor(ssq, 32);
          if (hh == 0) ((float*)(F.ws + WS_SS))[t * 32 + h] = ssq; }
        bf16* op = MIX + t * D + h * 64 + 4 * hh;
#pragma unroll
        for (int dt = 0; dt < 2; ++dt)
#pragma unroll
            for (int q4 = 0; q4 < 4; ++q4) { v2u ow; ow.x = pk2(o[dt][q4 * 4 + 0] * inv, o[dt][q4 * 4 + 1] * inv); ow.y = pk2(o[dt][q4 * 4 + 2] * inv, o[dt][q4 * 4 + 3] * inv);
                *(v2u*)(op + dt * 32 + q4 * 8) = ow; }
    }
}

constexpr int XA_KS = 136, XA_VS = 264;
constexpr int XA_KOFF = 0, XA_VOFF = 256 * XA_KS * 2;
__device__ __forceinline__ void xattn_unit(Frame& F, int unit) {
    const int b = unit >> 5, hx = (unit >> 3) & 3, qb = unit & 7;
    const bf16* PROJ = (const bf16*)(F.ws + WS_PROJ); const bf16* MKV = (const bf16*)(F.ws + WS_MEMKV); bf16* MIX = (bf16*)(F.ws + WS_MIX);
    LAS bf16* Ks = (LAS bf16*)(F.lds + XA_KOFF); LAS bf16* Vt = (LAS bf16*)(F.lds + XA_VOFF);
    __syncthreads();
    {   const int key = F.tid >> 1, half = F.tid & 1; const bf16* rp = MKV + (size_t)(b * MEML + key) * 1024 + hx * 128 + half * 64;
        float ss = 0.f; v4u kw[8];
#pragma unroll
        for (int j = 0; j < 8; ++j) { kw[j] = *(const v4u*)(rp + j * 8);
            const float a0 = bflo(kw[j].x), a1 = bfhi(kw[j].x), a2 = bflo(kw[j].y), a3 = bfhi(kw[j].y), a4 = bflo(kw[j].z), a5 = bfhi(kw[j].z), a6 = bflo(kw[j].w), a7 = bfhi(kw[j].w);
            ss += (a0 * a0 + a1 * a1) + (a2 * a2 + a3 * a3) + (a4 * a4 + a5 * a5) + (a6 * a6 + a7 * a7); }
        ss += __shfl_xor(ss, 1);
        const float rstd = 1.0f / sqrtf(ss * (1.f / 128.f) + EPS);
        const float* kn = F.in[I_XK_NORM] + half * 64;
#pragma unroll
        for (int j = 0; j < 8; ++j) { v4u o; const float* g = kn + j * 8;
            o.x = pk2(bflo(kw[j].x) * rstd * g[0], bfhi(kw[j].x) * rstd * g[1]); o.y = pk2(bflo(kw[j].y) * rstd * g[2], bfhi(kw[j].y) * rstd * g[3]);
            o.z = pk2(bflo(kw[j].z) * rstd * g[4], bfhi(kw[j].z) * rstd * g[5]); o.w = pk2(bflo(kw[j].w) * rstd * g[6], bfhi(kw[j].w) * rstd * g[7]);
            *(LAS v4u*)(Ks + key * XA_KS + half * 64 + j * 8) = o; }
#pragma unroll
        for (int j = 0; j < 8; ++j) { const v4u vw = *(const v4u*)(rp + 512 + j * 8); const unsigned w4[4] = {vw.x, vw.y, vw.z, vw.w};
#pragma unroll
            for (int q = 0; q < 4; ++q) { const int d = half * 64 + j * 8 + q * 2; Vt[d * XA_VS + key] = (bf16)(w4[q] & 0xffffu); Vt[(d + 1) * XA_VS + key] = (bf16)(w4[q] >> 16); } }
    }
    __syncthreads();
    const int ql = F.lane & 31, hh = F.lane >> 5;
    const size_t t = (size_t)b * SEQ + qb * 256 + F.wave * 32 + ql;
    bf16x8 qf[8];
    {   const bf16* qp = PROJ + t * INC + 1792 + hx * 128 + 8 * hh; v4u qw[8]; float ss = 0.f;
#pragma unroll
        for (int ks = 0; ks < 8; ++ks) { qw[ks] = *(const v4u*)(qp + ks * 16);
            const float a0 = bflo(qw[ks].x), a1 = bfhi(qw[ks].x), a2 = bflo(qw[ks].y), a3 = bfhi(qw[ks].y), a4 = bflo(qw[ks].z), a5 = bfhi(qw[ks].z), a6 = bflo(qw[ks].w), a7 = bfhi(qw[ks].w);
            ss += (a0 * a0 + a1 * a1) + (a2 * a2 + a3 * a3) + (a4 * a4 + a5 * a5) + (a6 * a6 + a7 * a7); }
        ss += __shfl_xor(ss, 32);
        const float sc = 0.08838834764831845f / sqrtf(ss * (1.f / 128.f) + EPS);
        const float* qn = F.in[I_XQ_NORM] + 8 * hh;
#pragma unroll
        for (int ks = 0; ks < 8; ++ks) { const float* g = qn + ks * 16; v4u o;
            o.x = pk2(bflo(qw[ks].x) * sc * g[0], bfhi(qw[ks].x) * sc * g[1]); o.y = pk2(bflo(qw[ks].y) * sc * g[2], bfhi(qw[ks].y) * sc * g[3]);
            o.z = pk2(bflo(qw[ks].z) * sc * g[4], bfhi(qw[ks].z) * sc * g[5]); o.w = pk2(bflo(qw[ks].w) * sc * g[6], bfhi(qw[ks].w) * sc * g[7]);
            qf[ks] = __builtin_bit_cast(bf16x8, o); } }
    f32x16 o[4];
#pragma unroll
    for (int dt = 0; dt < 4; ++dt) o[dt] = (f32x16){0.f, 0.f, 0.f, 0.f, 0.f, 0.f, 0.f, 0.f, 0.f, 0.f, 0.f, 0.f, 0.f, 0.f, 0.f, 0.f};
    float mrun = -1e30f, lrun = 0.f;
    for (int kb = 0; kb < 4; ++kb) {
        f32x16 s[2];
#pragma unroll
        for (int kt = 0; kt < 2; ++kt) { f32x16 a = {0.f, 0.f, 0.f, 0.f, 0.f, 0.f, 0.f, 0.f, 0.f, 0.f, 0.f, 0.f, 0.f, 0.f, 0.f, 0.f};
#pragma unroll
            for (int ks = 0; ks < 8; ++ks) { const bf16x8 kfrag = *(const LAS bf16x8*)(Ks + (64 * kb + 32 * kt + ql) * XA_KS + ks * 16 + 8 * hh);
                a = __builtin_amdgcn_mfma_f32_32x32x16_bf16(kfrag, qf[ks], a, 0, 0, 0); }
            s[kt] = a; }
        float mx = mrun;
#pragma unroll
        for (int kt = 0; kt < 2; ++kt)
#pragma unroll
            for (int rg = 0; rg < 16; ++rg) mx = fmaxf(mx, s[kt][rg]);
        mx = fmaxf(mx, __shfl_xor(mx, 32));
        const float alpha = fast_exp(mrun - mx); mrun = mx;
        float ls = 0.f;
#pragma unroll
        for (int kt = 0; kt < 2; ++kt)
#pragma unroll
            for (int rg = 0; rg < 16; ++rg) { const float p = fast_exp(s[kt][rg] - mx); s[kt][rg] = p; ls += p; }
        lrun = lrun * alpha + ls;
#pragma unroll
        for (int dt = 0; dt < 4; ++dt)
#pragma unroll
            for (int rg = 0; rg < 16; ++rg) o[dt][rg] *= alpha;
#pragma unroll
        for (int kt = 0; kt < 2; ++kt)
#pragma unroll
            for (int st = 0; st < 2; ++st) { v4u pw; pw.x = pk2(s[kt][8 * st + 0], s[kt][8 * st + 1]); pw.y = pk2(s[kt][8 * st + 2], s[kt][8 * st + 3]); pw.z = pk2(s[kt][8 * st + 4], s[kt][8 * st + 5]); pw.w = pk2(s[kt][8 * st + 6], s[kt][8 * st + 7]);
                const bf16x8 pf = __builtin_bit_cast(bf16x8, pw);
#pragma unroll
                for (int dt = 0; dt < 4; ++dt) { const LAS bf16* vp = Vt + (dt * 32 + ql) * XA_VS + 64 * kb + 32 * kt + 16 * st + 4 * hh;
                    const v2u lo = *(const LAS v2u*)vp, hi = *(const LAS v2u*)(vp + 8); v4u vv; vv.x = lo.x; vv.y = lo.y; vv.z = hi.x; vv.w = hi.y;
                    o[dt] = __builtin_amdgcn_mfma_f32_32x32x16_bf16(__builtin_bit_cast(bf16x8, vv), pf, o[dt], 0, 0, 0); } }
    }
    lrun += __shfl_xor(lrun, 32);
    const float inv = 1.0f / lrun;
    { float ssq = 0.f;
#pragma unroll
      for (int dt = 0; dt < 4; ++dt)
#pragma unroll
          for (int rg = 0; rg < 16; ++rg) { const float v = o[dt][rg] * inv; ssq += v * v; }
      ssq += __shfl_xor(ssq, 32);
      if (hh == 0) ((float*)(F.ws + WS_SS))[t * 32 + 24 + hx] = ssq; }
    bf16* op = MIX + t * D + 1536 + hx * 128 + 4 * hh;
#pragma unroll
    for (int dt = 0; dt < 4; ++dt)
#pragma unroll
        for (int q4 = 0; q4 < 4; ++q4) { v2u ow; ow.x = pk2(o[dt][q4 * 4 + 0] * inv, o[dt][q4 * 4 + 1] * inv); ow.y = pk2(o[dt][q4 * 4 + 2] * inv, o[dt][q4 * 4 + 3] * inv);
            *(v2u*)(op + dt * 32 + q4 * 8) = ow; }
}

__device__ __forceinline__ void moe_tables(Frame& F) {
    LAS int* cnt = (LAS int*)(F.lds + TAB_OFF); LAS int* ts = cnt + 64;
    __syncthreads();
    if (F.tid < 64) { const int c = (int)__hip_atomic_load(F.ctl + CW_CNT + F.tid, __ATOMIC_RELAXED, __HIP_MEMORY_SCOPE_AGENT); const int nt = (c + 255) >> 8; int inc = nt;
#pragma unroll
        for (int o = 1; o < 64; o <<= 1) { const int v = __shfl_up(inc, o); if (F.tid >= o) inc += v; }
        cnt[F.tid] = c; ts[F.tid + 1] = inc; if (F.tid == 0) ts[0] = 0; }
    __syncthreads();
}

struct Args { const float* in[31]; float* out; unsigned char* ws; int ph_lo, ph_hi; };
__global__ void __launch_bounds__(512, 2) hymba_fwd(Args args) {
    extern __shared__ __attribute__((aligned(16))) unsigned char lds_raw[];
    Frame F;
    F.lds = (LAS unsigned char*)lds_raw;
    F.tid = threadIdx.x; F.lane = F.tid & 63; F.wave = __builtin_amdgcn_readfirstlane(F.tid >> 6);
    F.G = gridDim.x; { const int bx = blockIdx.x; F.vcu = (F.G % 8 == 0) ? (bx % 8) * (F.G / 8) + bx / 8 : bx; }
    F.in = (const float* const __attribute__((address_space(4)))*)__builtin_amdgcn_kernarg_segment_ptr();
    F.out = args.out; F.ws = args.ws; F.ctl = (unsigned*)(args.ws + WS_CTL);
    const int lo = args.ph_lo, hi = args.ph_hi;
#if !MK_PER_PHASE
    if (F.tid < 4) ((LAS unsigned*)(F.lds + XBW_OFF))[F.tid] = 0u;
    __syncthreads();
    XcdBarrier bar = xcd_barrier_post(F.ctl + CW_BAR, (volatile LAS unsigned*)(F.lds + XBW_OFF));
#define GRID_BAR() xcd_barrier(bar)
#else
#define GRID_BAR() do {} while (0)
#endif
#define PHASE_REGS() do { int _l = (int)__builtin_amdgcn_mbcnt_hi(~0u, __builtin_amdgcn_mbcnt_lo(~0u, 0u)); asm volatile("" : "+v"(_l)); F.lane = _l; F.tid = F.wave * 64 + _l; } while (0)
#define IN(k) (lo <= (k) && (k) < hi)
#define SEAM(k) do { if (IN(k) && IN((k) + 1)) GRID_BAR(); } while (0)
    const int gw = F.vcu * 8 + F.wave, NGW = F.G * 8;
    bf16* const XN = (bf16*)(F.ws + WS_XN); bf16* const PROJ = (bf16*)(F.ws + WS_PROJ); bf16* const MIX = (bf16*)(F.ws + WS_MIX);
    bf16* const UA = (bf16*)(F.ws + WS_UA); bf16* const Gm = (bf16*)(F.ws + WS_G);

    if (IN(0)) { PHASE_REGS(); p0_prologue(F); }
    SEAM(0);
    if (IN(1)) { PHASE_REGS();
        { pg8::Gemm g{D, D, D}; pg8::DenseOrder S; S.init(XN, F.ws + WS_WIN, D, D, T, INC, F.G, (int)blockIdx.x);
          pg8::EpiProj E{PROJ, UA}; pg8::gemm_phase<pg8::EpiProj, pg8::DenseOrder>(F.lds, g, S, E, F.wave); }
        { pg8::Gemm g{D, D, D}; pg8::DenseOrder S; S.init(F.ws + WS_MEMN, F.ws + WS_WMKV, D, D, NB * MEML, 1024, F.G, F.G - 1 - (int)blockIdx.x);
          pg8::EpiBf16 E{(bf16*)(F.ws + WS_MEMKV), 1024}; pg8::gemm_phase<pg8::EpiBf16, pg8::DenseOrder>(F.lds, g, S, E, F.wave); }
        { const int c = (int)blockIdx.x; const bool has3 = 2 * F.G + c < (T / 256) * (INC / 256), haskv = (F.G - 1 - c) < (NB * MEML / 256) * 4;
          bg_convert(F, CW_QGU, 0, BT_GU, (!has3 && !haskv) ? PB1 : 0); }
    }
    SEAM(1);
    if (IN(2)) { PHASE_REGS();
        for (int u = F.vcu; u < 256; u += F.G) swa_unit(F, u);
        __syncthreads();
        { pg8::Gemm g{S5K, 512, 512}; pg8::GroupOrder S{(const char*)UA, (const char*)(F.ws + WS_SP), S5K, 512, 1, 32, F.G, F.G - 1 - F.vcu};
          pg8::EpiF32 E{(float*)(F.ws + WS_SL), 256, (size_t)512 * 256}; pg8::gemm_phase<pg8::EpiF32, pg8::GroupOrder>(F.lds, g, S, E, F.wave); }
        bg_convert(F, CW_QGU, 0, BT_GU, (F.G - 1 - F.vcu) >= 64 ? PB2 : 0);
    }
    SEAM(2);
    if (IN(3)) { PHASE_REGS();
        if (F.wave < 4) { const float* SL = (const float*)(F.ws + WS_SL); const float* AL = (const float*)(F.ws + WS_AL);
            for (int L = F.vcu; L < 128; L += F.G) { const int g = L >> 2, pm = L & 1, b = 4 * pm + F.wave, n = F.lane;
                const float ar = AL[(g * 64 + n) * 2], ai = AL[(g * 64 + n) * 2 + 1]; float xr = 0.f, xi = 0.f;
                for (int j0 = 0; j0 < 64; j0 += 8) { float sr[8], si[8];
#pragma unroll
                    for (int j = 0; j < 8; ++j) { const float* sp = SL + ((size_t)(g * 512 + b * 64 + j0 + j)) * 256; sr[j] = sp[n]; si[j] = sp[64 + n]; }
#pragma unroll
                    for (int j = 0; j < 8; ++j) { bf16* up = UA + ((size_t)(g * 512 + b * 64 + j0 + j)) * S5K + 512; up[n] = (bf16)f2bf(xr); up[64 + n] = (bf16)f2bf(xi);
                        const float nr = ar * xr - ai * xi + sr[j], ni = ar * xi + ai * xr + si[j]; xr = nr; xi = ni; } } } }
        asm volatile("s_waitcnt vmcnt(0)" ::: "memory");
        __syncthreads();
        pg8::Gemm g{S5K, S5K, S5K}; pg8::GroupOrder S{(const char*)UA, (const char*)(F.ws + WS_MQ), S5K, S5K, 2, 32, F.G, F.vcu};
        pg8::EpiS5Y E{UA, F.in[I_SSM_D], Gm}; pg8::gemm_phase<pg8::EpiS5Y, pg8::GroupOrder>(F.lds, g, S, E, F.wave);
        if (F.G >= 256 && F.vcu >= 128) { for (int u = F.vcu - 128; u < 128; u += F.G - 128) xattn_unit(F, u); __syncthreads(); }
    }
    SEAM(3);
    if (IN(4)) { PHASE_REGS();
        pg8::Gemm g{512, 512, 512}; pg8::DenseOrder S; S.init(Gm, F.ws + WS_WGLU, 512, 512, T, 512, F.G, (int)blockIdx.x);
        pg8::EpiGlu E{Gm, MIX, (float*)(F.ws + WS_SS)}; pg8::gemm_phase<pg8::EpiGlu, pg8::DenseOrder>(F.lds, g, S, E, F.wave);
        if (F.G >= 256 && (int)blockIdx.x >= 128) { for (int u = 128 + (int)blockIdx.x - 128; u < 256; u += F.G - 128) xattn_unit(F, u); __syncthreads(); }
    }
    SEAM(4);
    if (IN(5)) { PHASE_REGS();
        pg8::Gemm g{D, D, D}; pg8::DenseOrder S; S.init(MIX, F.ws + WS_WO, D, D, T, D, F.G, (int)blockIdx.x);
        pg8::EpiWo E{(const float*)(F.ws + WS_RINV), XN, (unsigned char*)(F.ws + WS_X18), (float*)(F.ws + WS_PART)}; pg8::gemm_phase<pg8::EpiWo, pg8::DenseOrder, false, false, true>(F.lds, g, S, E, F.wave, (const float*)(F.ws + WS_SS));
    }
    SEAM(5);
    if (IN(6)) { PHASE_REGS();
        pg8::Gemm g{D, 512, 512}; pg8::KSplitOrder S{(const char*)XN, (const char*)(F.ws + WS_WR), D, 512, 512, T / 256, 4, F.G, F.vcu};
        pg8::EpiLogit E{(float*)(F.ws + WS_LP)}; pg8::gemm_phase<pg8::EpiLogit, pg8::KSplitOrder>(F.lds, g, S, E, F.wave);
    }
    SEAM(6);
    const int rt_per = (T + F.G - 1) / F.G, rt_beg = F.vcu * rt_per, rt_end = (rt_beg + rt_per) < T ? (rt_beg + rt_per) : T;
    if (IN(7)) { PHASE_REGS();
        LAS int* hist = (LAS int*)F.lds;
        const float* LP = (const float*)(F.ws + WS_LP); const float* part = (const float*)(F.ws + WS_PART); float* rstdv = (float*)(F.ws + WS_RSTD);
        int* toke = (int*)(F.ws + WS_TOKE); float* wts = (float*)(F.ws + WS_WTS); int* HIST = (int*)(F.ws + WS_HIST);
        __syncthreads();
        if (F.tid < 64) hist[F.tid] = 0;
        __syncthreads();
        for (int t = rt_beg + F.tid; t < rt_end; t += 512) {
            const f32x4* pp = (const f32x4*)(part + (size_t)t * 32); float ss = 0.f;
#pragma unroll
            for (int j = 0; j < 8; ++j) { const f32x4 v = pp[j]; ss += (v[0] + v[1]) + (v[2] + v[3]); }
            const float rs = 1.0f / sqrtf(ss * (1.f / 2048.f) + EPS); rstdv[t] = rs;
            const float* l0 = LP + (size_t)t * 80; const float* l1 = l0 + (size_t)T * 80; const float* l2 = l1 + (size_t)T * 80; const float* l3 = l2 + (size_t)T * 80;
            float gl[8];
#pragma unroll
            for (int j = 0; j < 8; j += 4) { const f32x4 a = *(const f32x4*)(l0 + j), b = *(const f32x4*)(l1 + j), c = *(const f32x4*)(l2 + j), d = *(const f32x4*)(l3 + j);
#pragma unroll
                for (int q = 0; q < 4; ++q) gl[j + q] = rs * (((a[q] + b[q]) + c[q]) + d[q]); }
            int gi = 0; float gm = gl[0];
#pragma unroll
            for (int j = 1; j < 8; ++j) if (gl[j] > gm) { gm = gl[j]; gi = j; }
            float gs = 0.f;
#pragma unroll
            for (int j = 0; j < 8; ++j) gs += expf(gl[j] - gm);
            const float gate = 1.0f / gs;
            float el[8];
#pragma unroll
            for (int j = 0; j < 8; j += 4) { const int o = 8 + gi * 8 + j; const f32x4 a = *(const f32x4*)(l0 + o), b = *(const f32x4*)(l1 + o), c = *(const f32x4*)(l2 + o), d = *(const f32x4*)(l3 + o);
#pragma unroll
                for (int q = 0; q < 4; ++q) el[j + q] = rs * (((a[q] + b[q]) + c[q]) + d[q]); }
            int i1 = 0; float v1 = el[0];
#pragma unroll
            for (int j = 1; j < 8; ++j) if (el[j] > v1) { v1 = el[j]; i1 = j; }
            int i2 = -1; float v2 = -3.0e38f;
#pragma unroll
            for (int j = 0; j < 8; ++j) if (j != i1 && el[j] > v2) { v2 = el[j]; i2 = j; }
            const float ex = expf(v2 - v1);
            const int ea = gi * 8 + i1, eb = gi * 8 + i2;
            const int la = __hip_atomic_fetch_add(hist + ea, 1, __ATOMIC_RELAXED, __HIP_MEMORY_SCOPE_WORKGROUP), lb = __hip_atomic_fetch_add(hist + eb, 1, __ATOMIC_RELAXED, __HIP_MEMORY_SCOPE_WORKGROUP);
            toke[t * 2] = (ea << 16) | la; toke[t * 2 + 1] = (eb << 16) | lb; wts[t * 2] = gate / (1.0f + ex); wts[t * 2 + 1] = gate * ex / (1.0f + ex);
        }
        __syncthreads();
        if (F.tid < 64) HIST[F.vcu * 64 + F.tid] = hist[F.tid];
        __syncthreads();
    }
    SEAM(7);
    if (IN(8)) { PHASE_REGS();
        LAS int* pb = (LAS int*)F.lds; LAS int* pt = pb + 512; LAS int* base = pt + 512;
        const int* HIST = (const int*)(F.ws + WS_HIST); const int* toke = (const int*)(F.ws + WS_TOKE); int* list = (int*)(F.ws + WS_LIST);
        __syncthreads();
        { const int e = F.tid & 63, p8 = F.tid >> 6; int sb = 0, st = 0;
          for (int w = p8; w < F.G; w += 8) { const int h = HIST[w * 64 + e]; st += h; sb += (w < F.vcu) ? h : 0; }
          pb[F.tid] = sb; pt[F.tid] = st; }
        __syncthreads();
        if (F.tid < 64) { int sb = 0, st = 0;
#pragma unroll
            for (int j = 0; j < 8; ++j) { sb += pb[j * 64 + F.tid]; st += pt[j * 64 + F.tid]; }
            base[F.tid] = sb; F.ctl[CW_CNT + F.tid] = (unsigned)st; }
        __syncthreads();
        for (int t = rt_beg + F.tid; t < rt_end; t += 512) {
#pragma unroll
            for (int k = 0; k < 2; ++k) { const int v = toke[t * 2 + k], e = v >> 16, sl = v & 0xffff; const size_t pos = (size_t)e * LCAP + base[e] + sl;
                list[pos] = t * 2 + k; ((float*)(F.ws + WS_LRS))[pos] = ((const float*)(F.ws + WS_RSTD))[t]; ((float*)(F.ws + WS_LWT))[pos] = ((const float*)(F.ws + WS_WTS))[t * 2 + k]; } }
        __syncthreads();
        bg_convert(F, CW_QGU, 0, BT_GU, 0x7fffffff);
    }
    SEAM(8);
    if (IN(9)) { PHASE_REGS();
        moe_tables(F);
        const LAS int* cnt = (const LAS int*)(F.lds + TAB_OFF); const int* list = (const int*)(F.ws + WS_LIST);
        pg8::Gemm g{D / 2, D / 2, D / 2}; pg8::MoeOrder S{(const char*)(F.ws + WS_X18), (const char*)(F.ws + WS_WGU), cnt, cnt + 64, list, D / 2, D / 2, 4, 1024, F.G, F.vcu, true};
        pg8::EpiGU E{list, (const float*)(F.ws + WS_LRS), cnt, F.ws + WS_ACT}; pg8::gemm_phase<pg8::EpiGU, pg8::MoeOrder, true, true>(F.lds, g, S, E, F.wave);
        PHASE_REGS();
        bg_convert(F, CW_QD, BT_GU, BT_D, 0x7fffffff);
    }
    SEAM(9);
    if (IN(10)) { PHASE_REGS();
        moe_tables(F);
        const LAS int* cnt = (const LAS int*)(F.lds + TAB_OFF); const int* list = (const int*)(F.ws + WS_LIST);
        pg8::Gemm g{DEXP / 2, DEXP / 2, DEXP / 2}; pg8::MoeOrder S{(const char*)(F.ws + WS_ACT), (const char*)(F.ws + WS_WD), cnt, cnt + 64, list, DEXP / 2, DEXP / 2, 8, 2048, F.G, F.vcu, false};
        pg8::EpiDown E{list, (const float*)(F.ws + WS_LWT), cnt, F.ws + WS_Y2};
        pg8::gemm_phase<pg8::EpiDown, pg8::MoeOrder, false, true>(F.lds, g, S, E, F.wave);
    }
    SEAM(10);
    if (IN(11)) { PHASE_REGS();
        const unsigned char* Y2 = F.ws + WS_Y2; typedef float f32x2_ __attribute__((ext_vector_type(2)));
        for (int m = gw; m < T; m += NGW) { f32x4* op = (f32x4*)(F.out + (size_t)m * D) + F.lane * 2; const v4u* xb = (const v4u*)(XN + (size_t)m * D) + F.lane;
            const v2u* ya = (const v2u*)(Y2 + (size_t)m * 2 * D) + F.lane; const v2u* yb = ya + 256;
            v4u xw[4]; v2u aw[4], cw[4];
#pragma unroll
            for (int j = 0; j < 4; ++j) { xw[j] = __builtin_nontemporal_load(xb + 64 * j); aw[j] = __builtin_nontemporal_load(ya + 64 * j); cw[j] = __builtin_nontemporal_load(yb + 64 * j); }
#pragma unroll
            for (int j = 0; j < 4; ++j) { const v4u x = xw[j]; const v2u a = aw[j], c = cw[j]; f32x4 x0, x1; const float is = 1.0f / SC_Y;
                const f32x2_ a0 = __builtin_amdgcn_cvt_pk_f32_fp8((int)a.x, false), a1 = __builtin_amdgcn_cvt_pk_f32_fp8((int)a.x, true), a2 = __builtin_amdgcn_cvt_pk_f32_fp8((int)a.y, false), a3 = __builtin_amdgcn_cvt_pk_f32_fp8((int)a.y, true);
                const f32x2_ c0 = __builtin_amdgcn_cvt_pk_f32_fp8((int)c.x, false), c1 = __builtin_amdgcn_cvt_pk_f32_fp8((int)c.x, true), c2 = __builtin_amdgcn_cvt_pk_f32_fp8((int)c.y, false), c3 = __builtin_amdgcn_cvt_pk_f32_fp8((int)c.y, true);
                x0[0] = bflo(x.x) + (a0[0] + c0[0]) * is; x0[1] = bfhi(x.x) + (a0[1] + c0[1]) * is; x0[2] = bflo(x.y) + (a1[0] + c1[0]) * is; x0[3] = bfhi(x.y) + (a1[1] + c1[1]) * is;
                x1[0] = bflo(x.z) + (a2[0] + c2[0]) * is; x1[1] = bfhi(x.z) + (a2[1] + c2[1]) * is; x1[2] = bflo(x.w) + (a3[0] + c3[0]) * is; x1[3] = bfhi(x.w) + (a3[1] + c3[1]) * is;
                __builtin_nontemporal_store(x0, op + 128 * j); __builtin_nontemporal_store(x1, op + 128 * j + 1); } }
    }
#undef IN
#undef SEAM
}

extern "C" void kernel_launch(void* const* d_in, const int* in_sizes, int n_in, void* d_out, int out_size, void* d_ws, size_t ws_size, hipStream_t stream) {
    static int grid = 0;
    if (grid == 0) {
        if (n_in != 31 || out_size != T * D || ws_size < WS_END) { fprintf(stderr, "kernel_launch: unexpected shapes (n_in %d out %d ws %zu)\n", n_in, out_size, ws_size); grid = -1; return; }
        int dev = 0, cus = 0, per_cu = 0;
        if (hipGetDevice(&dev) != hipSuccess || hipDeviceGetAttribute(&cus, hipDeviceAttributeMultiprocessorCount, dev) != hipSuccess) { grid = -1; return; }
        if (hipFuncSetAttribute((const void*)hymba_fwd, hipFuncAttributeMaxDynamicSharedMemorySize, LDS_BYTES) != hipSuccess) { fprintf(stderr, "kernel_launch: hipFuncSetAttribute failed\n"); grid = -1; return; }
        if (hipOccupancyMaxActiveBlocksPerMultiprocessor(&per_cu, (const void*)hymba_fwd, 512, LDS_BYTES) != hipSuccess || per_cu < 1) fprintf(stderr, "kernel_launch: occupancy query reports %d\n", per_cu);
        (void)hipGetLastError();
        grid = cus;
    }
    if (grid < 0) return;
    (void)hipMemsetAsync((char*)d_ws + WS_CTL, 0, CTL_ZERO_BYTES, stream);
    Args a{};
    for (int i = 0; i < 31; ++i) a.in[i] = (const float*)d_in[i];
    a.out = (float*)d_out; a.ws = (unsigned char*)d_ws;
#if MK_PER_PHASE
    for (int p = 0; p < NPH; ++p) { const int reps = ((PROBE_REP_MASK >> p) & 1) ? 2 : 1;
        for (int q = 0; q < reps; ++q) { a.ph_lo = p; a.ph_hi = p + 1; hipLaunchKernelGGL(hymba_fwd, dim3(grid), dim3(512), LDS_BYTES, stream, a); } }
#else
    a.ph_lo = 0; a.ph_hi = NPH; hipLaunchKernelGGL(hymba_fwd, dim3(grid), dim3(512), LDS_BYTES, stream, a);
#endif
}
```

```cpp
#include <hip/hip_runtime.h>
#include <cstdio>
#include <cstdint>

#ifndef PROBE_REP_MASK
#define PROBE_REP_MASK 0
#endif
#ifndef PB0
#define PB0 40
#endif
#ifndef PB0_S5
#define PB0_S5 28
#endif
#ifndef PB0_D
#define PB0_D 0
#endif
#ifndef PB1
#define PB1 0
#endif
#ifndef PB2
#define PB2 0
#endif
#ifndef PB4
#define PB4 0
#endif
#ifndef PB5
#define PB5 0
#endif
#ifndef PB11
#define PB11 0
#endif
#ifndef MK_PER_PHASE
#define MK_PER_PHASE 0
#endif

#define GAS __attribute__((address_space(1)))
#define LAS __attribute__((address_space(3)))
typedef unsigned short bf16;
typedef unsigned v4u __attribute__((ext_vector_type(4)));
typedef unsigned v2u __attribute__((ext_vector_type(2)));
typedef float f32x4 __attribute__((ext_vector_type(4)));
typedef float f32x16 __attribute__((ext_vector_type(16)));
typedef short bf16x8 __attribute__((ext_vector_type(8)));
typedef short bf16x4 __attribute__((ext_vector_type(4)));
typedef int v8i __attribute__((ext_vector_type(8)));
typedef int v4i_ __attribute__((ext_vector_type(4)));

constexpr int T = 16384, D = 2048, SEQ = 2048, NB = 8, INC = 2304, MEML = 256;
constexpr int NPH = 12;
constexpr float EPS = 1e-6f;
constexpr int NEXP = 64, DEXP = 512, LCAP = 16384;
constexpr int S5L = 32, S5K = 640;

constexpr size_t MiB = 1u << 20;
constexpr size_t WS_CTL = 0, CTL_ZERO_BYTES = 1 * MiB;
constexpr size_t WS_WIN = 2 * MiB, WS_WO = 11 * MiB, WS_WMKV = 19 * MiB, WS_WGLU = 23 * MiB;
constexpr size_t WS_MQ = 24 * MiB, WS_SP = 44 * MiB, WS_UA = 52 * MiB, WS_SL = 468 * MiB  , WS_AL = 88 * MiB, WS_WR = 89 * MiB;
constexpr size_t WS_XN = 96 * MiB;
constexpr size_t WS_MEMN = 160 * MiB, WS_MEMKV = 168 * MiB;
constexpr size_t WS_PROJ = 176 * MiB;
constexpr size_t WS_MIX = 248 * MiB;
constexpr size_t WS_Y2 = 176 * MiB;
constexpr size_t WS_G = 312 * MiB;
constexpr size_t WS_LOG = 328 * MiB;
constexpr size_t WS_LIST = 344 * MiB;
constexpr size_t WS_WTS = 348 * MiB;
constexpr size_t WS_LP = 352 * MiB;
constexpr size_t WS_PART = 376 * MiB;
constexpr size_t WS_RSTD = 379 * MiB;
constexpr size_t WS_HIST = 380 * MiB;
constexpr size_t WS_X18 = 384 * MiB;
constexpr size_t WS_SS = 382 * MiB;
constexpr size_t WS_LRS = 452 * MiB;
constexpr size_t WS_LWT = 456 * MiB;
constexpr size_t WS_RINV = 460 * MiB;
constexpr size_t WS_TOKE = 381 * MiB;
constexpr size_t WS_ACT = 544 * MiB;
constexpr size_t WS_WGU = 592 * MiB;
constexpr size_t WS_WD = 848 * MiB;
constexpr size_t WS_END = 976 * MiB;
constexpr int CW_CNT = 1024;
constexpr int CW_BAR = 4096;
constexpr int CW_QGU = 2048, CW_QD = 2112;

constexpr int RING_BYTES = 131072;
constexpr int TAB_OFF = 139264;
constexpr int XBW_OFF = TAB_OFF + 2048;
constexpr int LDS_BYTES = 147456;

#define LDS_WAIT() asm volatile("s_waitcnt lgkmcnt(0)" ::: "memory")
#define VM_WAIT() asm volatile("s_waitcnt vmcnt(0)" ::: "memory")
__device__ __forceinline__ unsigned f2bf(float f) { unsigned u = __builtin_bit_cast(unsigned, f); return (u + 0x7fffu + ((u >> 16) & 1u)) >> 16; }
__device__ __forceinline__ unsigned pk2(float lo, float hi) { unsigned r; asm volatile("v_cvt_pk_bf16_f32 %0, %1, %2" : "=v"(r) : "v"(lo), "v"(hi)); return r; }
__device__ __forceinline__ float bflo(unsigned w) { return __builtin_bit_cast(float, w << 16); }
__device__ __forceinline__ float bfhi(unsigned w) { return __builtin_bit_cast(float, w & 0xffff0000u); }
__device__ __forceinline__ float wave_sum(float v) {
#pragma unroll
    for (int o = 1; o < 64; o <<= 1) v += __shfl_xor(v, o);
    return v;
}
constexpr float SC_X = 4.0f, SC_WGU = 32.0f, SC_ACT = 16.0f, SC_WD = 16.0f, SC_Y = 64.0f;
__device__ __forceinline__ float clamp8(float v) { return __builtin_amdgcn_fmed3f(v, -448.0f, 448.0f); }
__device__ __forceinline__ unsigned pk4_fp8(float a, float b, float c, float d) { unsigned w = 0u; w = (unsigned)__builtin_amdgcn_cvt_pk_fp8_f32(clamp8(a), clamp8(b), (int)w, false); w = (unsigned)__builtin_amdgcn_cvt_pk_fp8_f32(clamp8(c), clamp8(d), (int)w, true); return w; }
__device__ __forceinline__ float fast_exp(float x) { return __builtin_amdgcn_exp2f(x * 1.44269504089f); }
__device__ __forceinline__ float sigmoidf_(float x) { return __builtin_amdgcn_rcpf(1.0f + fast_exp(-x)); }
__device__ __forceinline__ float gelu_tanh(float x) { const float z = 1.5957691216f * (x + 0.044715f * x * x * x); return x * sigmoidf_(z); }

#define XB_TMO      128
#define XB_XCNT(j)  (256  + 64 * (j))
#define XB_XSUB(j)  (1280 + 64 * (j))
#define XB_XGEN(j)  (2304 + 64 * (j))
#define XB_TOP      3328
#define XB_TOPGEN   3392
#define XCD_BAR_WORDS 3456
#define XB_SPIN_CAP (1u << 18)
__device__ __forceinline__ unsigned xb_ld(unsigned* p)              { return __hip_atomic_load(p, __ATOMIC_RELAXED, __HIP_MEMORY_SCOPE_AGENT); }
__device__ __forceinline__ unsigned xb_add(unsigned* p, unsigned v) { return __hip_atomic_fetch_add(p, v, __ATOMIC_RELAXED, __HIP_MEMORY_SCOPE_AGENT); }
__device__ __forceinline__ unsigned xb_xcc_id() { return (unsigned)__builtin_amdgcn_s_getreg((3 << 11) | 20) & 0xFu; }
#define XB_SPIN(cond, bar) do { unsigned _sp = 0; while (cond) { __builtin_amdgcn_s_sleep(1); \
    if ((++_sp & 255u) == 0u) { if (xb_ld(&(bar)[XB_TMO])) break; if (_sp > XB_SPIN_CAP) { atomicAdd(&(bar)[XB_TMO], 1u); break; } } } } while (0)
struct XcdBarrier { unsigned* bar; unsigned x; volatile LAS unsigned* st; };
__device__ __forceinline__ XcdBarrier xcd_barrier_post(unsigned* bar, volatile LAS unsigned* st) {
    XcdBarrier b; b.bar = bar; b.x = xb_xcc_id(); b.st = st;
    if (threadIdx.x == 0) (void)xb_add(&bar[XB_XCNT(b.x)], 1u);
    return b;
}
__device__ __forceinline__ void xcd_barrier_complete(unsigned* bar, unsigned x, unsigned& nloc, unsigned& nx) {
    const unsigned G = gridDim.x * gridDim.y * gridDim.z;
    unsigned sum, cnt, mine, sp = 0u;
    for (;;) {
        sum = 0u; cnt = 0u; mine = 0u;
#pragma unroll
        for (unsigned j = 0; j < 16; ++j) { const unsigned c = xb_ld(&bar[XB_XCNT(j)]); sum += c; cnt += (c > 0u) ? 1u : 0u; mine = (j == x) ? c : mine; }
        if (sum == G) break;
        __builtin_amdgcn_s_sleep(1);
        if ((++sp & 255u) == 0u) { if (xb_ld(&bar[XB_TMO])) break; if (sp > XB_SPIN_CAP) { atomicAdd(&bar[XB_TMO], 1u); break; } }
    }
    nloc = mine > 0u ? mine : 1u; nx = cnt > 0u ? cnt : 1u;
}
__device__ __forceinline__ void xcd_barrier(const XcdBarrier& b) {
    asm volatile("s_waitcnt vmcnt(0)" ::: "memory");
    __syncthreads();
    if (threadIdx.x == 0) {
        unsigned* bar = b.bar;
        __builtin_amdgcn_s_waitcnt(0);
        unsigned nloc = b.st[0], nx = b.st[1];
        if (nloc == 0u) { xcd_barrier_complete(bar, b.x, nloc, nx); b.st[0] = nloc; b.st[1] = nx; }
        const unsigned old = xb_add(&bar[XB_XSUB(b.x)], 1u);
        const unsigned gen = old / nloc;
        if (old + 1u == (gen + 1u) * nloc) {
            __builtin_amdgcn_fence(__ATOMIC_RELEASE, "agent");
            asm volatile("s_waitcnt vmcnt(0)" ::: "memory");
            const unsigned og = xb_add(&bar[XB_TOP], 1u);
            const unsigned tg = og / nx;
            if (og + 1u == (tg + 1u) * nx) xb_add(&bar[XB_TOPGEN], 1u);
            else XB_SPIN(xb_ld(&bar[XB_TOPGEN]) == tg, bar);
            __builtin_amdgcn_fence(__ATOMIC_ACQUIRE, "agent");
            xb_add(&bar[XB_XGEN(b.x)], 1u);
            asm volatile("s_waitcnt vmcnt(0)" ::: "memory");
        } else {
            XB_SPIN(xb_ld(&bar[XB_XGEN(b.x)]) == gen, bar);
            __builtin_amdgcn_fence(__ATOMIC_ACQUIRE, "agent");
            asm volatile("s_waitcnt vmcnt(0)" ::: "memory");
        }
    }
    __syncthreads();
}

__device__ __forceinline__ int lane_now() { int l = (int)__builtin_amdgcn_mbcnt_hi(~0u, __builtin_amdgcn_mbcnt_lo(~0u, 0u)); asm volatile("" : "+v"(l)); return l; }
namespace pg8 {
constexpr int BM = 256, BK = 64, HALF = 128, HTB = HALF * BK * 2, STAGE_BYTES = 8 * HTB, NXCD = 8, WGM = 8;
__host__ __device__ __forceinline__ int lds_byte(int r, int c) { const int st = (r >> 4) * 2 + (c >> 5), rr = r & 15, cc = c & 31, ob = rr * 64 + cc * 2; return st * 1024 + (ob ^ (((ob >> 9) & 1) << 5)); }
__host__ __device__ __forceinline__ void stage_rc(int b, int& R, int& C) { const int st = b / 1024, sb = b % 1024, swz = sb ^ (((sb >> 9) & 1) << 5); R = (st >> 1) * 16 + swz / 64; C = (st & 1) * 32 + (swz % 64) / 2; }
__host__ __device__ __forceinline__ int perm32(int rho) { const int n = rho >> 4, i = rho & 15; return 8 * (i >> 2) + 4 * n + (i & 3); }

struct Unit { const char* a; const char* b; int r0, c0, aux, r1; };
struct Gemm { int lda, ldb, K; };

struct DenseOrder {
    const char* A; const char* Bt; int lda, ldb, nM, nN, nwg, G, c;
    __device__ void init(const void* A_, const void* Bt_, int lda_, int ldb_, int M, int N, int G_, int c_) { A = (const char*)A_; Bt = (const char*)Bt_; lda = lda_; ldb = ldb_; nM = M / BM; nN = N / BM; nwg = nM * nN; G = G_; c = c_; }
    __device__ bool next(int i, Unit& u) const {
        const long L = (long)i * G + c; if (L >= nwg) return false;
        int wgid = (int)L; { const int q = nwg / NXCD, r = nwg % NXCD, xcd = wgid % NXCD, off = wgid / NXCD; wgid = (xcd < r ? xcd * (q + 1) : r * (q + 1) + (xcd - r) * q) + off; }
        const int nig = WGM * nN, gid = wgid / nig, fm = gid * WGM, gsz = (nM - fm) < WGM ? (nM - fm) : WGM;
        const int pm = fm + ((wgid % nig) % gsz), pn = (wgid % nig) / gsz;
        u.a = A + (size_t)pm * BM * lda * 2; u.b = Bt + (size_t)pn * BM * ldb * 2; u.r0 = pm * BM; u.c0 = pn * BM; u.aux = 0; u.r1 = 0; return true;
    }
    __device__ __forceinline__ unsigned arow(const Unit&, int) const { return 0u; }
};
struct GroupOrder {
    const char* A; const char* Bt; int lda, ldb, nN, ngrp, G, c;
    __device__ bool next(int i, Unit& u) const {
        const int L = i * G + c; if (L >= ngrp * 2 * nN) return false;
        const int g = L / (2 * nN), q = L % (2 * nN), pn = q >> 1, pm = q & 1;
        u.a = A + ((size_t)g * 512 + pm * BM) * lda * 2; u.b = Bt + ((size_t)g * nN + pn) * BM * ldb * 2; u.r0 = pm * BM; u.c0 = pn * BM; u.aux = g; u.r1 = 0; return true;
    }
    __device__ __forceinline__ unsigned arow(const Unit&, int) const { return 0u; }
};
struct StateOrder {
    const char* A; const char* Bt; int G, c;
    __device__ bool next(int i, Unit& u) const {
        const int L = i * G + c; if (L >= 128) return false;
        const int g = L >> 2, pm = (L >> 1) & 1, ks = L & 1;
        u.a = A + (((size_t)g * 512 + pm * BM) * S5K + ks * 256) * 2; u.b = Bt + ((size_t)g * 256 * 512 + ks * 256) * 2; u.r0 = pm * BM; u.c0 = 0; u.aux = g * 2 + ks; u.r1 = 0; return true;
    }
    __device__ __forceinline__ unsigned arow(const Unit&, int) const { return 0u; }
};
struct MoeOrder {
    const char* A; const char* Bt; const LAS int* cnt; const LAS int* ts; const int* list; int lda, ldb, nct, brows, G, c; bool gather;
    __device__ bool next(int i, Unit& u) const {
        const int L = i * G + c; const int lane = lane_now();
        int i64 = 64; asm volatile("" : "+v"(i64));
        if (L >= __builtin_amdgcn_readfirstlane(ts[i64]) * nct) return false;
        const int lo = ts[lane] * nct, hi = ts[lane + 1] * nct;
        const unsigned long long m = __ballot(lo <= L && L < hi);
        const int e = __builtin_amdgcn_readfirstlane((int)__builtin_ctzll(m));
        const int tse = ts[e], ne = ts[e + 1] - tse, q = L - tse * nct, ct = q / ne, rt = q % ne;
        u.a = gather ? A : A + (size_t)(tse + rt) * BM * lda * 2; u.b = Bt + ((size_t)e * brows + (size_t)ct * BM) * ldb * 2;
        u.r0 = (tse + rt) * BM; u.r1 = rt * BM; u.c0 = ct; u.aux = e; return true;
    }
    __device__ __forceinline__ unsigned arow(const Unit& u, int r) const {
        const int n = cnt[u.aux]; int rr = u.r1 + r; rr = rr < n ? rr : n - 1;
        return (unsigned)(list[(size_t)u.aux * LCAP + rr] >> 1) * (unsigned)(lda * 2);
    }
};

#define EPI_ROWS_COLS() const int rowb = wr * 64 + fr; (void)rowb;

template <class Epi, class Sched, bool GATHER = false, bool FP8 = false, bool KSEG = false>
__device__ __forceinline__ void gemm_phase(LAS unsigned char* lds, const Gemm g, const Sched& S, const Epi& E, const int wave_id, const float* ssq = nullptr) {
    int lane = (int)__builtin_amdgcn_mbcnt_hi(~0u, __builtin_amdgcn_mbcnt_lo(~0u, 0u)); asm volatile("" : "+v"(lane));
    const int wid = wave_id, tid = wid * 64 + lane, wr = wid >> 2, wc = wid & 3, fr = lane & 15, fq = lane >> 4;
    const int K = g.K; int nt = K / BK; asm volatile("" : "+s"(nt));
    unsigned voffB;
    { int R, C; stage_rc(tid * 16, R, C); const int Rb = Epi::PERM ? ((R & ~31) + perm32(R & 31)) : R; voffB = (unsigned)(Rb * g.ldb + C) * 2u; }
    const int soffB = 64 * g.ldb * 2, soffA = 64 * g.lda * 2;
#define PG8_RC(i, R, C) int R, C; { int _t = tid; asm volatile("" : "+v"(_t)); stage_rc(_t * 16 + (i) * 8192, R, C); }
#define nxoff ((LAS v4u*)(lds + 131072) + (wid * 64 + lane_now()))
    const size_t kstep = (size_t)(BK * 2);
    const size_t hstepB = (size_t)HALF * g.ldb * 2;
    const unsigned ldsw = (unsigned)wid * 1024u;
    const int aoff = lds_byte(wr * 64 + fr, fq * 8), boff = lds_byte(wc * 32 + fr, fq * 8);
#define PG8_SA(b, h) (((b) * 2 + (h)) * HTB)
#define PG8_SB(b, h) ((4 + (b) * 2 + (h)) * HTB)
#define PG8_RSRC(p) __builtin_amdgcn_make_buffer_rsrc((void*)(p), 0, 0xffffffff, 0x00020000)
#define PG8_STAGE(bufoff, gbase, voff) do { const __amdgpu_buffer_rsrc_t _r = PG8_RSRC(gbase); \
        __builtin_amdgcn_raw_ptr_buffer_load_lds(_r, (LAS void*)(lds + (bufoff) + ldsw), 16, (int)(voff), 0, 0, 0); \
        __builtin_amdgcn_raw_ptr_buffer_load_lds(_r, (LAS void*)(lds + (bufoff) + ldsw + 8192), 16, (int)(voff), soffB, 0, 0); } while (0)
#define PG8_STAGEA(bufoff, gbase, o0, o1, h) do { const __amdgpu_buffer_rsrc_t _r = PG8_RSRC(gbase); \
        if constexpr (GATHER) { __builtin_amdgcn_raw_ptr_buffer_load_lds(_r, (LAS void*)(lds + (bufoff) + ldsw), 16, (int)(o0), 0, 0, 0); \
                                __builtin_amdgcn_raw_ptr_buffer_load_lds(_r, (LAS void*)(lds + (bufoff) + ldsw + 8192), 16, (int)(o1), 0, 0, 0); } \
        else { __builtin_amdgcn_raw_ptr_buffer_load_lds(_r, (LAS void*)(lds + (bufoff) + ldsw), 16, (int)c00, (h) * 2 * soffA, 0, 0); \
               __builtin_amdgcn_raw_ptr_buffer_load_lds(_r, (LAS void*)(lds + (bufoff) + ldsw + 8192), 16, (int)c00, (h) * 2 * soffA + soffA, 0, 0); } } while (0)
#define PG8_LDA(dst, b, h) do { _Pragma("unroll") for (int m = 0; m < 4; ++m) { \
        if constexpr (FP8) { dst##8[m].lo = *(const LAS v4i_*)(lds + PG8_SA(b, h) + aoff + m * 2048); dst##8[m].hi = *(const LAS v4i_*)(lds + PG8_SA(b, h) + aoff + m * 2048 + 1024); } \
        else { _Pragma("unroll") for (int k = 0; k < 2; ++k) dst[m][k] = *(const LAS bf16x8*)(lds + PG8_SA(b, h) + aoff + m * 2048 + k * 1024); } } } while (0)
#define PG8_LDB(dst, b, h) do { _Pragma("unroll") for (int n = 0; n < 2; ++n) { \
        if constexpr (FP8) { dst##8[n].lo = *(const LAS v4i_*)(lds + PG8_SB(b, h) + boff + n * 2048); dst##8[n].hi = *(const LAS v4i_*)(lds + PG8_SB(b, h) + boff + n * 2048 + 1024); } \
        else { _Pragma("unroll") for (int k = 0; k < 2; ++k) dst[n][k] = *(const LAS bf16x8*)(lds + PG8_SB(b, h) + boff + n * 2048 + k * 1024); } } } while (0)
#define PG8_MMA(ai, bj, At, Bt) do { __builtin_amdgcn_s_setprio(1); _Pragma("unroll") for (int m = 0; m < 4; ++m) _Pragma("unroll") for (int n = 0; n < 2; ++n) { \
        if constexpr (FP8) { acc[ai][bj][m][n] = __builtin_amdgcn_mfma_scale_f32_16x16x128_f8f6f4(Bt##8[n], At##8[m], acc[ai][bj][m][n], 0, 0, 0, 0x7f7f7f7f, 0, 0x7f7f7f7f); } \
        else { _Pragma("unroll") for (int k = 0; k < 2; ++k) acc[ai][bj][m][n] = __builtin_amdgcn_mfma_f32_16x16x32_bf16(Bt[n][k], At[m][k], acc[ai][bj][m][n], 0, 0, 0); } } \
        __builtin_amdgcn_s_setprio(0); } while (0)
#define PG8_WAIT_V(n) asm volatile("s_waitcnt vmcnt(" #n ")" ::: "memory")
#define PG8_WAIT_L(n) asm volatile("s_waitcnt lgkmcnt(" #n ")" ::: "memory")
#define PG8_BAR __builtin_amdgcn_s_barrier()
#define PG8_SCHED __builtin_amdgcn_sched_barrier(0)
    LAS f32x4* scl = (LAS f32x4*)(lds + 131072);
#define PG8_FILL_SCL(u) do { if constexpr (KSEG) { if (tid < 256) { const f32x4* sp = (const f32x4*)(ssq + (size_t)((u).r0 + tid) * 32); \
        const f32x4 p0 = sp[0], p1 = sp[1], p2 = sp[2], p3 = sp[3], p4 = sp[4], p5 = sp[5], p6 = sp[6]; \
        const float sa = (((p0[0] + p0[1]) + (p0[2] + p0[3])) + ((p1[0] + p1[1]) + (p1[2] + p1[3]))) + (((p2[0] + p2[1]) + (p2[2] + p2[3])) + ((p3[0] + p3[1]) + (p3[2] + p3[3]))); \
        const float sb = ((p4[0] + p4[1]) + (p4[2] + p4[3])) + ((p5[0] + p5[1]) + (p5[2] + p5[3])), sc = (p6[0] + p6[1]) + (p6[2] + p6[3]); \
        const float ra = 1.0f / sqrtf(sa * (1.f / 1024.f) + EPS), rb = 1.0f / sqrtf(sb * (1.f / 512.f) + EPS), rc = 1.0f / sqrtf(sc * (1.f / 512.f) + EPS); \
        scl[(ui & 1) * 256 + tid] = (f32x4){ra / rb, rb / rc, rc, 0.f}; } } } while (0)
#define PG8_SCALE(k) do { _Pragma("unroll") for (int _ai = 0; _ai < 2; ++_ai) _Pragma("unroll") for (int _m = 0; _m < 4; ++_m) { const float _f = ((const LAS float*)scl)[((ui & 1) * 256 + _ai * HALF + wr * 64 + _m * 16 + fr) * 4 + (k)]; \
        _Pragma("unroll") for (int _bj = 0; _bj < 2; ++_bj) _Pragma("unroll") for (int _n = 0; _n < 2; ++_n) acc[_ai][_bj][_m][_n] = acc[_ai][_bj][_m][_n] * _f; } } while (0)
    Unit cur, nxt; int ui = 0;
    if (!S.next(0, cur)) return;
    PG8_FILL_SCL(cur);
    f32x4 acc[2][2][4][2];
#pragma unroll
    for (int a = 0; a < 2; ++a)
#pragma unroll
        for (int b = 0; b < 2; ++b)
#pragma unroll
            for (int m = 0; m < 4; ++m)
#pragma unroll
                for (int n = 0; n < 2; ++n) acc[a][b][m][n] = (f32x4){0.f, 0.f, 0.f, 0.f};
    bf16x8 At[4][2], B0[2][2], B1[2][2]; v8i At8[4], B08[2], B18[2];
    const char* cA = cur.a; const char* cB = cur.b;
    unsigned c00, c01, c10, c11;
    { PG8_RC(0, R0, C0); PG8_RC(1, R1, C1);
      if constexpr (GATHER) {
        c00 = S.arow(cur, R0) + C0 * 2u; c01 = S.arow(cur, R1) + C1 * 2u; c10 = S.arow(cur, HALF + R0) + C0 * 2u; c11 = S.arow(cur, HALF + R1) + C1 * 2u;
        asm volatile("s_waitcnt vmcnt(0)" : "+v"(c00), "+v"(c01), "+v"(c10), "+v"(c11) :: "memory");
      } else {
        c00 = (unsigned)(R0 * g.lda + C0) * 2u; c01 = c00; c10 = c00; c11 = c00; (void)R1; (void)C1;
      } }
    PG8_STAGE(PG8_SB(0, 0), cB, voffB); PG8_STAGE(PG8_SB(0, 1), cB + hstepB, voffB); PG8_STAGEA(PG8_SA(0, 0), cA, c00, c01, 0); PG8_STAGEA(PG8_SA(0, 1), cA, c10, c11, 1);
    if (wr == 1) PG8_BAR;
    PG8_WAIT_V(2); PG8_BAR;
    PG8_STAGE(PG8_SB(1, 0), cB + kstep, voffB); PG8_STAGEA(PG8_SA(1, 0), cA + kstep, c00, c01, 0); PG8_STAGE(PG8_SB(1, 1), cB + hstepB + kstep, voffB);
    PG8_WAIT_V(6); PG8_BAR;
#define PG8_KITER(t) do { \
            const bool last = (t == nt - 2); \
            const char* a1 = cA + (size_t)(t + 1) * kstep; \
            const char* a2 = last ? nA : cA + (size_t)(t + 2) * kstep; const char* b2 = last ? nB : cB + (size_t)(t + 2) * kstep; \
            const char* a3 = a2 + kstep; const char* b3 = b2 + kstep; \
            unsigned x00 = c00, x01 = c01, x10 = c10, x11 = c11; \
            if constexpr (GATHER) { if (last) { const v4u nv = *nxoff; x00 = nv.x; x01 = nv.y; x10 = nv.z; x11 = nv.w; } } \
 \
            PG8_LDB(B0, 0, 0); PG8_LDB(B1, 0, 1); PG8_SCHED; PG8_LDA(At, 0, 0); PG8_STAGEA(PG8_SA(1, 1), a1, c10, c11, 1); \
            PG8_WAIT_V(8); PG8_WAIT_L(0); PG8_BAR; PG8_MMA(0, 0, At, B0); PG8_MMA(0, 1, At, B1); PG8_BAR; PG8_SCHED; \
 \
            PG8_LDA(At, 0, 1); PG8_STAGE(PG8_SB(0, 0), b2, voffB); PG8_STAGE(PG8_SB(0, 1), b2 + hstepB, voffB); PG8_STAGEA(PG8_SA(0, 0), a2, x00, x01, 0); \
            PG8_WAIT_V(8); PG8_WAIT_L(0); PG8_BAR; PG8_MMA(1, 0, At, B0); PG8_MMA(1, 1, At, B1); PG8_BAR; PG8_SCHED; \
 \
            PG8_LDB(B0, 1, 0); PG8_LDB(B1, 1, 1); PG8_SCHED; PG8_LDA(At, 1, 0); PG8_STAGEA(PG8_SA(0, 1), a2, x10, x11, 1); \
            PG8_WAIT_V(8); PG8_WAIT_L(0); PG8_BAR; PG8_MMA(0, 0, At, B0); PG8_MMA(0, 1, At, B1); PG8_BAR; PG8_SCHED; \
 \
            PG8_LDA(At, 1, 1); PG8_STAGE(PG8_SB(1, 0), b3, voffB); PG8_STAGE(PG8_SB(1, 1), b3 + hstepB, voffB); PG8_STAGEA(PG8_SA(1, 0), a3, x00, x01, 0); \
            PG8_WAIT_V(8); PG8_WAIT_L(0); PG8_BAR; PG8_MMA(1, 0, At, B0); PG8_MMA(1, 1, At, B1); PG8_BAR; PG8_SCHED; \
        } while (0)
    for (;;) {
        const bool has_next = S.next(ui + 1, nxt);
        const char* nA = has_next ? nxt.a : cA; const char* nB = has_next ? nxt.b : cB;
        if constexpr (GATHER) {
            unsigned n00 = c00, n01 = c01, n10 = c10, n11 = c11;
            if (has_next) { PG8_RC(0, R0, C0); PG8_RC(1, R1, C1); n00 = S.arow(nxt, R0) + C0 * 2u; n01 = S.arow(nxt, R1) + C1 * 2u; n10 = S.arow(nxt, HALF + R0) + C0 * 2u; n11 = S.arow(nxt, HALF + R1) + C1 * 2u; }
            asm volatile("s_waitcnt vmcnt(0)" : "+v"(n00), "+v"(n01), "+v"(n10), "+v"(n11) :: "memory");
            v4u nv; nv.x = n00; nv.y = n01; nv.z = n10; nv.w = n11; *nxoff = nv;
        }
        if constexpr (KSEG) {
#pragma unroll 1
            for (int t = 0; t < 16; t += 2) PG8_KITER(t);
            PG8_SCALE(0);
#pragma unroll 1
            for (int t = 16; t < 24; t += 2) PG8_KITER(t);
            PG8_SCALE(1);
#pragma unroll 1
            for (int t = 24; t < nt; t += 2) PG8_KITER(t);
        } else {
#pragma unroll 1
            for (int t = 0; t < nt; t += 2) PG8_KITER(t);
        }
        if (wr == 0) PG8_BAR;
        if constexpr (KSEG) PG8_SCALE(2);
        { const int le = lane_now(); E(acc, cur, wr, wc, le & 15, le >> 4); }
        if (!has_next) break;
#pragma unroll
        for (int a = 0; a < 2; ++a)
#pragma unroll
            for (int b = 0; b < 2; ++b)
#pragma unroll
                for (int m = 0; m < 4; ++m)
#pragma unroll
                    for (int n = 0; n < 2; ++n) acc[a][b][m][n] = (f32x4){0.f, 0.f, 0.f, 0.f};
        cur = nxt; cA = nA; cB = nB; ++ui;
        if constexpr (KSEG) { PG8_WAIT_L(0); PG8_FILL_SCL(cur); }
        if constexpr (GATHER) { const v4u nv = *nxoff; c00 = nv.x; c01 = nv.y; c10 = nv.z; c11 = nv.w; }
        if (wr == 1) PG8_BAR;
    }
    PG8_WAIT_V(0);
    PG8_BAR;
#undef PG8_RC
#undef PG8_KITER
#undef PG8_FILL_SCL
#undef PG8_SCALE
#undef nxoff
#undef PG8_SA
#undef PG8_SB
#undef PG8_STAGE
#undef PG8_STAGEA
#undef PG8_LDA
#undef PG8_LDB
#undef PG8_MMA
#undef PG8_WAIT_V
#undef PG8_WAIT_L
#undef PG8_BAR
#undef PG8_SCHED
}

typedef const f32x4 (&AccRef)[2][2][4][2];
__device__ __forceinline__ v4u pack8(const f32x4 a, const f32x4 b) { v4u w; w.x = pk2(a[0], a[1]); w.y = pk2(a[2], a[3]); w.z = pk2(b[0], b[1]); w.w = pk2(b[2], b[3]); return w; }

struct EpiProj {
    static constexpr bool PERM = true;
    bf16* PROJ; bf16* UA;
    __device__ __forceinline__ void operator()(AccRef acc, const Unit& u, int wr, int wc, int fr, int fq) const {
        const int row0 = u.r0 + wr * 64 + fr, colb = u.c0 + wc * 32 + 8 * fq;
        const bool isu = (u.c0 == 1280 || u.c0 == 1536);
#pragma unroll
        for (int ai = 0; ai < 2; ++ai)
#pragma unroll
            for (int m = 0; m < 4; ++m) { const int row = row0 + ai * HALF + m * 16;
#pragma unroll
                for (int bj = 0; bj < 2; ++bj) { const int col = colb + bj * HALF; const v4u w = pack8(acc[ai][bj][m][0], acc[ai][bj][m][1]);
                    if (!isu) *(v4u*)(PROJ + (size_t)row * INC + col) = w;
                    else { const int cc = col - 1280, g = cc >> 4, c0 = cc & 15; *(v4u*)(UA + ((size_t)(g * 512 + (row >> 5)) * S5K + (row & 31) * 16 + c0)) = w; } } }
    }
};
struct EpiBf16 {
    static constexpr bool PERM = true;
    bf16* O; int ldc;
    __device__ __forceinline__ void operator()(AccRef acc, const Unit& u, int wr, int wc, int fr, int fq) const {
        const int row0 = u.r0 + wr * 64 + fr, colb = u.c0 + wc * 32 + 8 * fq;
#pragma unroll
        for (int ai = 0; ai < 2; ++ai)
#pragma unroll
            for (int m = 0; m < 4; ++m) { bf16* rowp = O + (size_t)(row0 + ai * HALF + m * 16) * ldc + colb;
#pragma unroll
                for (int bj = 0; bj < 2; ++bj) *(v4u*)(rowp + bj * HALF) = pack8(acc[ai][bj][m][0], acc[ai][bj][m][1]); }
    }
};
struct EpiF32 {
    static constexpr bool PERM = false;
    float* C; int ldc; size_t gstride;
    __device__ __forceinline__ void operator()(AccRef acc, const Unit& u, int wr, int wc, int fr, int fq) const {
        const int row0 = u.r0 + wr * 64 + fr, col0 = u.c0 + wc * 32 + 4 * fq; float* base = C + (size_t)u.aux * gstride;
#pragma unroll
        for (int ai = 0; ai < 2; ++ai)
#pragma unroll
            for (int m = 0; m < 4; ++m) { float* rowp = base + (size_t)(row0 + ai * HALF + m * 16) * ldc + col0;
#pragma unroll
                for (int bj = 0; bj < 2; ++bj)
#pragma unroll
                    for (int n = 0; n < 2; ++n) *(f32x4*)(rowp + bj * HALF + n * 16) = acc[ai][bj][m][n]; }
    }
};
struct EpiS5Y {
    static constexpr bool PERM = true;
    const bf16* UA; const float* dsk; bf16* Gm;
    __device__ __forceinline__ void operator()(AccRef acc, const Unit& u, int wr, int wc, int fr, int fq) const {
        const int row0 = u.r0 + wr * 64 + fr, colb = u.c0 + wc * 32 + 8 * fq, g = u.aux;
#pragma unroll
        for (int ai = 0; ai < 2; ++ai)
#pragma unroll
            for (int m = 0; m < 4; ++m) { const int row = row0 + ai * HALF + m * 16;
#pragma unroll
                for (int bj = 0; bj < 2; ++bj) { const int col = colb + bj * HALF, i = col >> 4, c0 = col & 15;
                    const v4u uw = *(const v4u*)(UA + ((size_t)(g * 512 + row) * S5K + col));
                    const f32x4 d0 = *(const f32x4*)(dsk + g * 16 + c0), d1 = *(const f32x4*)(dsk + g * 16 + c0 + 4);
                    const f32x4 a0 = acc[ai][bj][m][0], a1 = acc[ai][bj][m][1];
                    f32x4 y0, y1;
                    y0[0] = gelu_tanh(a0[0] + d0[0] * bflo(uw.x)); y0[1] = gelu_tanh(a0[1] + d0[1] * bfhi(uw.x)); y0[2] = gelu_tanh(a0[2] + d0[2] * bflo(uw.y)); y0[3] = gelu_tanh(a0[3] + d0[3] * bfhi(uw.y));
                    y1[0] = gelu_tanh(a1[0] + d1[0] * bflo(uw.z)); y1[1] = gelu_tanh(a1[1] + d1[1] * bfhi(uw.z)); y1[2] = gelu_tanh(a1[2] + d1[2] * bflo(uw.w)); y1[3] = gelu_tanh(a1[3] + d1[3] * bfhi(uw.w));
                    *(v4u*)(Gm + ((size_t)row * 32 + i) * 512 + g * 16 + c0) = pack8(y0, y1); } }
    }
};
struct EpiGlu {
    static constexpr bool PERM = true;
    const bf16* Gm; bf16* MIX; float* SS;
    __device__ __forceinline__ void operator()(AccRef acc, const Unit& u, int wr, int wc, int fr, int fq) const {
        const int row0 = u.r0 + wr * 64 + fr, colb = u.c0 + wc * 32 + 8 * fq;
#pragma unroll
        for (int ai = 0; ai < 2; ++ai)
#pragma unroll
            for (int m = 0; m < 4; ++m) { const int row = row0 + ai * HALF + m * 16; float ss = 0.f;
#pragma unroll
                for (int bj = 0; bj < 2; ++bj) { const int col = colb + bj * HALF;
                    const v4u gw = *(const v4u*)(Gm + (size_t)row * 512 + col);
                    const f32x4 a0 = acc[ai][bj][m][0], a1 = acc[ai][bj][m][1];
                    f32x4 y0, y1;
                    y0[0] = bflo(gw.x) * sigmoidf_(a0[0]); y0[1] = bfhi(gw.x) * sigmoidf_(a0[1]); y0[2] = bflo(gw.y) * sigmoidf_(a0[2]); y0[3] = bfhi(gw.y) * sigmoidf_(a0[3]);
                    y1[0] = bflo(gw.z) * sigmoidf_(a1[0]); y1[1] = bfhi(gw.z) * sigmoidf_(a1[1]); y1[2] = bflo(gw.w) * sigmoidf_(a1[2]); y1[3] = bfhi(gw.w) * sigmoidf_(a1[3]);
                    ss += ((y0[0] * y0[0] + y0[1] * y0[1]) + (y0[2] * y0[2] + y0[3] * y0[3])) + ((y1[0] * y1[0] + y1[1] * y1[1]) + (y1[2] * y1[2] + y1[3] * y1[3]));
                    *(v4u*)(MIX + (size_t)row * D + 1024 + col) = pack8(y0, y1); }
                ss += __shfl_xor(ss, 16); ss += __shfl_xor(ss, 32);
                if (fq == 0) SS[(size_t)row * 32 + 16 + (u.c0 >> 8) * 4 + wc] = ss; }
    }
};
struct EpiWo {
    static constexpr bool PERM = true;
    const float* rinv; bf16* X1B; unsigned char* X18; float* part;
    __device__ __forceinline__ void operator()(AccRef acc, const Unit& u, int wr, int wc, int fr, int fq) const {
        const int row0 = u.r0 + wr * 64 + fr, col0 = u.c0 + wc * 32 + 8 * fq;
#pragma unroll
        for (int ai = 0; ai < 2; ++ai) {
            v4u xw[4][2]; float ri[4];
#pragma unroll
            for (int m = 0; m < 4; ++m) { const int row = row0 + ai * HALF + m * 16; ri[m] = rinv[row];
#pragma unroll
                for (int bj = 0; bj < 2; ++bj) xw[m][bj] = *(const v4u*)(X1B + (size_t)row * D + col0 + bj * HALF); }
#pragma unroll
            for (int m = 0; m < 4; ++m) { const int row = row0 + ai * HALF + m * 16; const size_t off = (size_t)row * D + col0; float ss = 0.f;
#pragma unroll
                for (int bj = 0; bj < 2; ++bj) { const v4u x = xw[m][bj]; const float r = ri[m];
                    f32x4 v0, v1;
                    v0[0] = bflo(x.x) * r + acc[ai][bj][m][0][0]; v0[1] = bfhi(x.x) * r + acc[ai][bj][m][0][1]; v0[2] = bflo(x.y) * r + acc[ai][bj][m][0][2]; v0[3] = bfhi(x.y) * r + acc[ai][bj][m][0][3];
                    v1[0] = bflo(x.z) * r + acc[ai][bj][m][1][0]; v1[1] = bfhi(x.z) * r + acc[ai][bj][m][1][1]; v1[2] = bflo(x.w) * r + acc[ai][bj][m][1][2]; v1[3] = bfhi(x.w) * r + acc[ai][bj][m][1][3];
                    ss += ((v0[0] * v0[0] + v0[1] * v0[1]) + (v0[2] * v0[2] + v0[3] * v0[3])) + ((v1[0] * v1[0] + v1[1] * v1[1]) + (v1[2] * v1[2] + v1[3] * v1[3]));
                    *(v4u*)(X1B + off + bj * HALF) = pack8(v0, v1);
                    v2u w8; w8.x = pk4_fp8(v0[0] * SC_X, v0[1] * SC_X, v0[2] * SC_X, v0[3] * SC_X); w8.y = pk4_fp8(v1[0] * SC_X, v1[1] * SC_X, v1[2] * SC_X, v1[3] * SC_X);
                    *(v2u*)(X18 + off + bj * HALF) = w8; }
                ss += __shfl_xor(ss, 16); ss += __shfl_xor(ss, 32);
                if (fq == 0) part[(size_t)row * 32 + (u.c0 >> 8) * 4 + wc] = ss; }
            asm volatile("" ::: "memory");
        }
    }
};
struct EpiLogit {
    static constexpr bool PERM = false;
    float* LP;
    __device__ __forceinline__ void operator()(AccRef acc, const Unit& u, int wr, int wc, int fr, int fq) const {
        const int row0 = u.r0 + wr * 64 + fr, col0 = wc * 32 + 4 * fq; float* base = LP + (size_t)u.aux * T * 80;
#pragma unroll
        for (int ai = 0; ai < 2; ++ai)
#pragma unroll
            for (int m = 0; m < 4; ++m) { float* rowp = base + (size_t)(row0 + ai * HALF + m * 16) * 80 + col0;
#pragma unroll
                for (int n = 0; n < 2; ++n) if (col0 + n * 16 < 80) *(f32x4*)(rowp + n * 16) = acc[ai][0][m][n]; }
    }
};
struct EpiGU {
    static constexpr bool PERM = true;
    const int* list; const float* rstd; const LAS int* cnt; unsigned char* ACT;
    __device__ __forceinline__ void operator()(AccRef acc, const Unit& u, int wr, int wc, int fr, int fq) const {
        const int e = u.aux, nreal = cnt[e], rb = wr * 64 + fr, colb = u.c0 * 128 + wc * 32 + 8 * fq;
#pragma unroll
        for (int ai = 0; ai < 2; ++ai)
#pragma unroll
            for (int m = 0; m < 4; ++m) { const int r = rb + ai * HALF + m * 16; int rr = u.r1 + r; rr = rr < nreal ? rr : nreal - 1;
                const float rs = rstd[(size_t)e * LCAP + rr] * (1.0f / (SC_X * SC_WGU));
                f32x4 y0, y1;
#pragma unroll
                for (int j = 0; j < 4; ++j) { const float g0 = acc[ai][0][m][0][j] * rs, g1 = acc[ai][0][m][1][j] * rs;
                    y0[j] = g0 * sigmoidf_(g0) * (acc[ai][1][m][0][j] * rs) * SC_ACT; y1[j] = g1 * sigmoidf_(g1) * (acc[ai][1][m][1][j] * rs) * SC_ACT; }
                v2u w8; w8.x = pk4_fp8(y0[0], y0[1], y0[2], y0[3]); w8.y = pk4_fp8(y1[0], y1[1], y1[2], y1[3]);
                *(v2u*)(ACT + (size_t)(u.r0 + r) * DEXP + colb) = w8; }
    }
};
struct EpiDown {
    static constexpr bool PERM = true;
    const int* list; const float* wts; const LAS int* cnt; unsigned char* Y2;
    __device__ __forceinline__ void operator()(AccRef acc, const Unit& u, int wr, int wc, int fr, int fq) const {
        const int e = u.aux, n = cnt[e], row0 = u.r1 + wr * 64 + fr, colb = u.c0 * 256 + wc * 32 + 8 * fq;
#pragma unroll
        for (int ai = 0; ai < 2; ++ai)
#pragma unroll
            for (int m = 0; m < 4; ++m) { const int r = row0 + ai * HALF + m * 16;
                if (r < n) { const int ent = list[(size_t)e * LCAP + r]; const float w = wts[(size_t)e * LCAP + r] * (SC_Y / (SC_ACT * SC_WD));   unsigned char* rowp = Y2 + (size_t)ent * D + colb;
#pragma unroll
                    for (int bj = 0; bj < 2; ++bj) { const f32x4 a0 = acc[ai][bj][m][0] * w, a1 = acc[ai][bj][m][1] * w; v2u w8; w8.x = pk4_fp8(a0[0], a0[1], a0[2], a0[3]); w8.y = pk4_fp8(a1[0], a1[1], a1[2], a1[3]);
                        *(v2u*)(rowp + bj * HALF) = w8; } } }
    }
};
struct KSplitOrder {
    const char* A; const char* Bt; int lda, ldb, K, nM, nks, G, c;
    __device__ bool next(int i, Unit& u) const {
        const int L = i * G + c; if (L >= nM * nks) return false;
        const int pm = L / nks, ks = L % nks;
        u.a = A + ((size_t)pm * BM * lda + (size_t)ks * K) * 2; u.b = Bt + (size_t)ks * BM * ldb * 2; u.r0 = pm * BM; u.c0 = 0; u.aux = ks; u.r1 = 0; return true;
    }
    __device__ __forceinline__ unsigned arow(const Unit&, int) const { return 0u; }
};
}

struct Frame {
    LAS unsigned char* lds;
    unsigned* ctl;
    int tid, lane, wave, vcu, G;
    const float* const __attribute__((address_space(4)))* in;
    float* out; unsigned char* ws;
};
enum { I_X = 0, I_MEM, I_NORM_MIX, I_W_IN, I_Q_NORM, I_K_NORM, I_SINKS, I_REL_BIAS, I_LAM_RE, I_LAM_IM, I_LOG_DT, I_B_RE, I_B_IM, I_C_RE, I_C_IM, I_SSM_D, I_W_GLU,
       I_MEM_NORM, I_W_MEM_KV, I_XQ_NORM, I_XK_NORM, I_ON_ATTN, I_ON_SSM, I_ON_X, I_W_O, I_NORM_FFN, I_WR_G, I_WR_E, I_W_GATE, I_W_UP, I_W_DOWN };

struct TrItem { const float* W; bf16* WT; const float* ks; int ldw, ldt, k0, n0, drow0; };
__device__ __forceinline__ void tr_load(const TrItem& it, f32x4 (&v)[8], int lane) {
    const int kc = lane & 7, nq = lane >> 3; const float* src = it.W + (size_t)(it.k0 + kc * 8) * it.ldw + it.n0 + nq * 4;
#pragma unroll
    for (int j = 0; j < 8; ++j) v[j] = __builtin_nontemporal_load((const f32x4*)(src + (size_t)j * it.ldw));
}
__device__ __forceinline__ void tr_store(const TrItem& it, f32x4 (&v)[8], int lane) {
    const int kc = lane & 7, nq = lane >> 3;
    if (it.ks) { const f32x4 s0 = *(const f32x4*)(it.ks + it.k0 + kc * 8), s1 = *(const f32x4*)(it.ks + it.k0 + kc * 8 + 4);
#pragma unroll
        for (int j = 0; j < 4; ++j) { v[j] = v[j] * s0[j]; v[4 + j] = v[4 + j] * s1[j]; } }
#pragma unroll
    for (int i = 0; i < 4; ++i) { v4u o; o.x = pk2(v[0][i], v[1][i]); o.y = pk2(v[2][i], v[3][i]); o.z = pk2(v[4][i], v[5][i]); o.w = pk2(v[6][i], v[7][i]);
        *(v4u*)(it.WT + (size_t)(it.drow0 + nq * 4 + i) * it.ldt + it.k0 + kc * 8) = o; }
}
__device__ __forceinline__ void rms_row_to_bf16(const float* xrow, const float* gain, bf16* orow, int lane, float* rinv = nullptr) {
    const f32x4* xr = (const f32x4*)xrow + lane; const f32x4* gr = (const f32x4*)gain + lane;
    f32x4 v[8]; float s = 0.f;
#pragma unroll
    for (int j = 0; j < 8; ++j) { v[j] = xr[64 * j]; s += (v[j].x * v[j].x + v[j].y * v[j].y) + (v[j].z * v[j].z + v[j].w * v[j].w); }
    const float ms = wave_sum(s) * (1.f / 2048.f) + EPS; const float rstd = 1.0f / sqrtf(ms);
    if (rinv && lane == 0) *rinv = sqrtf(ms);
    v2u* o8 = (v2u*)orow + lane;
#pragma unroll
    for (int j = 0; j < 8; ++j) { const f32x4 g = gain ? gr[64 * j] : (f32x4){1.f, 1.f, 1.f, 1.f}; v2u w; w.x = pk2(v[j].x * rstd * g.x, v[j].y * rstd * g.y); w.y = pk2(v[j].z * rstd * g.z, v[j].w * rstd * g.w); o8[64 * j] = w; }
}

__device__ __forceinline__ void s5_tables(Frame& F, int g) {
    LAS float* ap = (LAS float*)F.lds;
    LAS float* Bb = ap + 33 * 64 * 2;
    LAS float* Cc = Bb + 64 * 16 * 2;
    LAS float* Km = Cc + 16 * 64 * 2;
    const float dt = expf(F.in[I_LOG_DT][g]);
    const float* lre = F.in[I_LAM_RE] + g * 64; const float* lim = F.in[I_LAM_IM] + g * 64;
    for (int idx = F.tid; idx < 33 * 64; idx += 512) { const int tau = idx >> 6, n = idx & 63; const float lr = lre[n], li = lim[n];
        const float mag = expf((float)tau * (lr * dt)), ang = (float)tau * (li * dt); ap[idx * 2] = mag * cosf(ang); ap[idx * 2 + 1] = mag * sinf(ang); }
    __syncthreads();
    for (int idx = F.tid; idx < 64 * 16; idx += 512) { const int n = idx >> 4; const float lr = lre[n], li = lim[n];
        const float nr = ap[(64 + n) * 2] - 1.0f, ni = ap[(64 + n) * 2 + 1], den = lr * lr + li * li;
        const float cr = (nr * lr + ni * li) / den, ci = (ni * lr - nr * li) / den;
        const float br = F.in[I_B_RE][(size_t)g * 1024 + idx], bi = F.in[I_B_IM][(size_t)g * 1024 + idx];
        Bb[idx * 2] = cr * br - ci * bi; Bb[idx * 2 + 1] = cr * bi + ci * br; }
    for (int idx = F.tid; idx < 16 * 64; idx += 512) { Cc[idx * 2] = F.in[I_C_RE][(size_t)g * 1024 + idx]; Cc[idx * 2 + 1] = F.in[I_C_IM][(size_t)g * 1024 + idx]; }
    __syncthreads();
    for (int idx = F.tid; idx < 32 * 256; idx += 512) { const int tau = idx >> 8, c = (idx >> 4) & 15, c2 = idx & 15; float s = 0.f;
        for (int n = 0; n < 64; ++n) { const float ar = ap[(tau * 64 + n) * 2], ai = ap[(tau * 64 + n) * 2 + 1], cr = Cc[(c * 64 + n) * 2], ci = Cc[(c * 64 + n) * 2 + 1];
            const float er = cr * ar - ci * ai, ei = cr * ai + ci * ar; s += er * Bb[(n * 16 + c2) * 2] - ei * Bb[(n * 16 + c2) * 2 + 1]; }
        Km[idx] = s; }
    __syncthreads();
    bf16* MQ = (bf16*)(F.ws + WS_MQ) + (size_t)g * 512 * S5K;
    for (int idx = F.tid; idx < 512 * 80; idx += 512) { const int row = idx / 80, ch = idx % 80, i = row >> 4, c = row & 15, k0 = ch * 8; float v[8];
        if (k0 < 512) { const int s = k0 >> 4, c20 = k0 & 15, tau = i - s;
#pragma unroll
            for (int j = 0; j < 8; ++j) v[j] = tau >= 0 ? Km[(tau * 16 + c) * 16 + c20 + j] : 0.f;
        } else { const int kk = k0 - 512, ri = kk >> 6, n0 = kk & 63;
#pragma unroll
            for (int j = 0; j < 8; ++j) { const int n = n0 + j; const float ar = ap[((i + 1) * 64 + n) * 2], ai = ap[((i + 1) * 64 + n) * 2 + 1], cr = Cc[(c * 64 + n) * 2], ci = Cc[(c * 64 + n) * 2 + 1];
                v[j] = ri == 0 ? (cr * ar - ci * ai) : -(cr * ai + ci * ar); } }
        v4u o; o.x = pk2(v[0], v[1]); o.y = pk2(v[2], v[3]); o.z = pk2(v[4], v[5]); o.w = pk2(v[6], v[7]);
        *(v4u*)(MQ + (size_t)row * S5K + k0) = o; }
    bf16* SP = (bf16*)(F.ws + WS_SP) + (size_t)g * 256 * 512;
    for (int idx = F.tid; idx < 256 * 64; idx += 512) { const int row = idx >> 6, k0 = (idx & 63) * 8; float v[8];
        if (row < 128) { const int ri = row >> 6, n = row & 63, s = k0 >> 4, c20 = k0 & 15; const float ar = ap[((31 - s) * 64 + n) * 2], ai = ap[((31 - s) * 64 + n) * 2 + 1];
#pragma unroll
            for (int j = 0; j < 8; ++j) { const float br = Bb[(n * 16 + c20 + j) * 2], bi = Bb[(n * 16 + c20 + j) * 2 + 1]; v[j] = ri == 0 ? (ar * br - ai * bi) : (ar * bi + ai * br); }
        } else {
#pragma unroll
            for (int j = 0; j < 8; ++j) v[j] = 0.f; }
        v4u o; o.x = pk2(v[0], v[1]); o.y = pk2(v[2], v[3]); o.z = pk2(v[4], v[5]); o.w = pk2(v[6], v[7]);
        *(v4u*)(SP + (size_t)row * 512 + k0) = o; }
    float* AL = (float*)(F.ws + WS_AL) + g * 128;
    if (F.tid < 64) { AL[F.tid * 2] = ap[(32 * 64 + F.tid) * 2]; AL[F.tid * 2 + 1] = ap[(32 * 64 + F.tid) * 2 + 1]; }
    __syncthreads();
}

struct BigTile { const float* src; unsigned char* dst; const float* ks; float sc; int ldw, ldt; };
constexpr int BT_GU = 64 * 2 * 64, BT_D = 64 * 64, BT_N = BT_GU + BT_D, BT_PITCH = 136;
__device__ __forceinline__ BigTile bt_decode(const Frame& F, unsigned char* Wgu8, unsigned char* Wd8, const float* nf, int ti) {
    BigTile t;
    const unsigned long long pg = (unsigned long long)F.in[I_W_GATE], pu = (unsigned long long)F.in[I_W_UP], pd = (unsigned long long)F.in[I_W_DOWN];
    if (ti < BT_GU) { const int e = ti >> 7, r = ti & 127, which = r >> 6, kb = (r >> 2) & 15, nb = r & 3;
        const unsigned long long p = pg + ((pu - pg) & (0ull - (unsigned long long)which));
        t.src = (const float*)p + (size_t)e * D * DEXP + (size_t)kb * 128 * DEXP + nb * 128; t.dst = Wgu8 + ((size_t)e * 1024 + nb * 256 + which * 128) * D + kb * 128; t.ks = nf + kb * 128; t.sc = SC_WGU; t.ldw = DEXP; t.ldt = D; }
    else { const int t2 = ti - BT_GU, e = t2 >> 6, r = t2 & 63, kb = r >> 4, nb = r & 15;
        t.src = (const float*)pd + (size_t)e * DEXP * D + (size_t)kb * 128 * D + nb * 128; t.dst = Wd8 + ((size_t)e * D + nb * 128) * DEXP + kb * 128; t.ks = nullptr; t.sc = SC_WD; t.ldw = D; t.ldt = DEXP; }
    return t;
}
#define BT_LOAD(t, v, kv) do { const unsigned _lo = (unsigned)(rl * 8 * (t).ldw + cq * 4); \
    _Pragma("unroll") for (int _p = 0; _p < 8; ++_p) kv[_p] = (t).ks ? (t).ks[rl * 8 + _p] * (t).sc : (t).sc; \
    _Pragma("unroll") for (int _p = 0; _p < 8; ++_p) v[_p] = __builtin_nontemporal_load((const f32x4*)((t).src + (size_t)_p * (t).ldw + _lo)); } while (0)
#define BT_STORE(t, v, kv) do { \
    _Pragma("unroll") for (int _i = 0; _i < 4; ++_i) { v2u _w; _w.x = pk4_fp8(v[0][_i] * kv[0], v[1][_i] * kv[1], v[2][_i] * kv[2], v[3][_i] * kv[3]); _w.y = pk4_fp8(v[4][_i] * kv[4], v[5][_i] * kv[5], v[6][_i] * kv[6], v[7][_i] * kv[7]); \
        *(LAS v2u*)(img + (cq * 4 + _i) * BT_PITCH + rl * 8) = _w; } \
    __syncthreads(); \
    _Pragma("unroll") for (int _j = 0; _j < 2; ++_j) { const int _idx = tid_ + _j * 512, _n = _idx >> 3, _ch = _idx & 7; \
        const v2u _a = *(const LAS v2u*)(img + _n * BT_PITCH + _ch * 16), _b = *(const LAS v2u*)(img + _n * BT_PITCH + _ch * 16 + 8); v4u _o; _o.x = _a.x; _o.y = _a.y; _o.z = _b.x; _o.w = _b.y; \
        *(v4u*)((t).dst + (size_t)_n * (t).ldt + _ch * 16) = _o; } \
    __syncthreads(); } while (0)
__device__ __forceinline__ void bg_convert(Frame& F, int qword, int base, int ntiles, int budget) {
    if (budget <= 0) return;
    int lane_ = (int)__builtin_amdgcn_mbcnt_hi(~0u, __builtin_amdgcn_mbcnt_lo(~0u, 0u)); asm volatile("" : "+v"(lane_)); const int tid_ = F.wave * 64 + lane_;
    unsigned char* WguT = F.ws + WS_WGU; unsigned char* WdT = F.ws + WS_WD; const float* nf = F.in[I_NORM_FFN];
    const int rl = tid_ >> 5, cq = tid_ & 31; LAS unsigned char* img = F.lds; LAS int* qn = (LAS int*)(F.lds + TAB_OFF + 1024);
    f32x4 va[8], vb[8]; float ka[8], kb[8];
    int nfetch = 0;
#define BG_FETCH(slot) do { if (nfetch < budget) { if (tid_ == 0) qn[slot] = (int)atomicAdd(F.ctl + qword, 1u); } else if (tid_ == 0) qn[slot] = 0x7fffffff; ++nfetch; } while (0)
    __syncthreads();
    BG_FETCH(0); BG_FETCH(1);
    __syncthreads();
    int i0 = __builtin_amdgcn_readfirstlane(qn[0]), i1 = __builtin_amdgcn_readfirstlane(qn[1]);
    __syncthreads();
    if (i0 < ntiles) { const BigTile t0 = bt_decode(F, WguT, WdT, nf, base + i0); BT_LOAD(t0, va, ka); }
    while (i0 < ntiles) {
        const BigTile ta = bt_decode(F, WguT, WdT, nf, base + i0);
        const BigTile tb = bt_decode(F, WguT, WdT, nf, base + (i1 < ntiles ? i1 : i0));
        BT_LOAD(tb, vb, kb);
        if (i1 >= ntiles) budget = 0;
        BG_FETCH(0);
        BT_STORE(ta, va, ka);
        const int i2 = __builtin_amdgcn_readfirstlane(qn[0]);
        if (i1 >= ntiles) break;
        const BigTile tc = bt_decode(F, WguT, WdT, nf, base + (i2 < ntiles ? i2 : i1));
        BT_LOAD(tc, va, ka);
        if (i2 >= ntiles) budget = 0;
        BG_FETCH(1);
        BT_STORE(tb, vb, kb);
        const int i3 = __builtin_amdgcn_readfirstlane(qn[1]);
        i0 = i2; i1 = i3;
    }
    __syncthreads();
#undef BG_FETCH
}
__device__ __forceinline__ void p0_prologue(Frame& F) {
    if (F.vcu < 32) s5_tables(F, F.vcu);
    const int gw = F.vcu * 8 + F.wave, NGW = F.G * 8;
    bf16* WinT = (bf16*)(F.ws + WS_WIN); bf16* WoT = (bf16*)(F.ws + WS_WO); bf16* WmkvT = (bf16*)(F.ws + WS_WMKV); bf16* WgluT = (bf16*)(F.ws + WS_WGLU);
    const float* nf = F.in[I_NORM_FFN];
    constexpr int I_IN = 32 * 72, I_O = 32 * 64, I_MKV = 32 * 32, I_GLU = 8 * 16;
    constexpr int NITEMS = I_IN + I_O + I_MKV + I_GLU;
    auto decode = [&](int it) -> TrItem {
        int r = it;
        if (r < I_IN) { const int kb = r / 72, nb = r % 72; return TrItem{F.in[I_W_IN], WinT, F.in[I_NORM_MIX]  , INC, D, kb * 64, nb * 32, nb * 32}; } r -= I_IN;
        if (r < I_O) { const int kb = r / 64, nb = r % 64, k0 = kb * 64;
            const unsigned long long pa = (unsigned long long)F.in[I_ON_ATTN], ps = (unsigned long long)(F.in[I_ON_SSM] - 1024), px = (unsigned long long)(F.in[I_ON_X] - 1536);
            const unsigned long long m1 = 0ull - (unsigned long long)(k0 >= 1024), m2 = 0ull - (unsigned long long)(k0 >= 1536);
            const unsigned long long pk = pa + ((ps - pa) & m1) + ((px - ps) & m2);
            return TrItem{F.in[I_W_O], WoT, (const float*)pk, D, D, k0, nb * 32, nb * 32}; } r -= I_O;
        if (r < I_MKV) { const int kb = r / 32, nb = r % 32; return TrItem{F.in[I_W_MEM_KV], WmkvT, nullptr, 1024, D, kb * 64, nb * 32, nb * 32}; } r -= I_MKV;
        const int kb = r / 16, nb = r % 16; return TrItem{F.in[I_W_GLU], WgluT, nullptr, 512, 512, kb * 64, nb * 32, nb * 32};
    };
    {
        f32x4 va[8], vb[8]; int it = gw; TrItem ia, ib;
        if (it < NITEMS) { ia = decode(it); tr_load(ia, va, F.lane); }
        while (it < NITEMS) {
            const int it2 = it + NGW; if (it2 < NITEMS) { ib = decode(it2); tr_load(ib, vb, F.lane); }
            tr_store(ia, va, F.lane);
            if (it2 >= NITEMS) break;
            const int it3 = it2 + NGW; if (it3 < NITEMS) { ia = decode(it3); tr_load(ia, va, F.lane); }
            tr_store(ib, vb, F.lane);
            it = it3;
        }
    }
    { bf16* WrT = (bf16*)(F.ws + WS_WR); const int gt = F.vcu * 512 + F.tid, NT = F.G * 512;
      for (int idx = gt; idx < 4 * 256 * 512; idx += NT) { const int ks = idx >> 17, n = (idx >> 9) & 255, k = ks * 512 + (idx & 511); float v = 0.f;
          if (n < 8) v = F.in[I_WR_G][k * 8 + n] * nf[k]; else if (n < 72) v = F.in[I_WR_E][k * 64 + (n - 8)] * nf[k];
          WrT[idx] = (bf16)f2bf(v); } }
    bf16* XN = (bf16*)(F.ws + WS_XN); bf16* MEMN = (bf16*)(F.ws + WS_MEMN);
    for (int m = gw; m < T; m += NGW) rms_row_to_bf16(F.in[I_X] + (size_t)m * D, nullptr, XN + (size_t)m * D, F.lane, (float*)(F.ws + WS_RINV) + m);
    for (int m = gw; m < NB * MEML; m += NGW) rms_row_to_bf16(F.in[I_MEM] + (size_t)m * D, F.in[I_MEM_NORM], MEMN + (size_t)m * D, F.lane);
    bg_convert(F, CW_QGU, 0, BT_GU, F.vcu < 32 ? PB0_S5 : PB0);
    bg_convert(F, CW_QD, BT_GU, BT_D, PB0_D);
}

constexpr int SWA_KS = 72, SWA_VS = 264;
constexpr int SWA_KOFF = 0, SWA_VOFF = 256 * SWA_KS * 2, SWA_BOFF = SWA_VOFF + 64 * SWA_VS * 2;
__device__ __forceinline__ int t5_bucket(int n) { if (n < 16) return n; const int v = 16 + (int)(logf((float)n * (1.0f / 16.0f)) / logf(8.0f) * 16.0f); return v < 31 ? v : 31; }
__device__ __forceinline__ void swa_unit(Frame& F, int unit) {
    const int b = unit >> 5, kvh = (unit >> 4) & 1, nb = unit & 15;
    const bf16* PROJ = (const bf16*)(F.ws + WS_PROJ); bf16* MIX = (bf16*)(F.ws + WS_MIX);
    LAS bf16* Ks = (LAS bf16*)(F.lds + SWA_KOFF); LAS bf16* Vt = (LAS bf16*)(F.lds + SWA_VOFF); LAS float* bt = (LAS float*)(F.lds + SWA_BOFF);
    const int w = F.wave, h = kvh * 8 + w, ql = F.lane & 31, hh = F.lane >> 5;
    v4u qnx[4];
    { const bf16* qp = PROJ + ((size_t)b * SEQ + nb * 128 + ql) * INC + h * 64 + 8 * hh;
#pragma unroll
      for (int ks = 0; ks < 4; ++ks) qnx[ks] = *(const v4u*)(qp + ks * 16); }
    __syncthreads();
    {
        const int key = F.tid >> 1, half = F.tid & 1, s = (nb - 1) * 128 + key;
        v4u kw[4], vw[4];
        if (s >= 0) { const bf16* rp = PROJ + (size_t)(b * SEQ + s) * INC + 1024 + kvh * 64 + half * 32;
#pragma unroll
            for (int j = 0; j < 4; ++j) { kw[j] = *(const v4u*)(rp + j * 8); vw[j] = *(const v4u*)(rp + 128 + j * 8); }
        } else {
#pragma unroll
            for (int j = 0; j < 4; ++j) { kw[j] = (v4u){0u, 0u, 0u, 0u}; vw[j] = (v4u){0u, 0u, 0u, 0u}; } }
        float kf[32]; float ss = 0.f;
#pragma unroll
        for (int j = 0; j < 4; ++j) { kf[j * 8 + 0] = bflo(kw[j].x); kf[j * 8 + 1] = bfhi(kw[j].x); kf[j * 8 + 2] = bflo(kw[j].y); kf[j * 8 + 3] = bfhi(kw[j].y);
            kf[j * 8 + 4] = bflo(kw[j].z); kf[j * 8 + 5] = bfhi(kw[j].z); kf[j * 8 + 6] = bflo(kw[j].w); kf[j * 8 + 7] = bfhi(kw[j].w); }
#pragma unroll
        for (int j = 0; j < 32; ++j) ss += kf[j] * kf[j];
        ss += __shfl_xor(ss, 1);
        const float rstd = 1.0f / sqrtf(ss * (1.f / 64.f) + EPS);
        const float* kn = F.in[I_K_NORM] + half * 32;
#pragma unroll
        for (int j = 0; j < 4; ++j) { v4u o; o.x = pk2(kf[j * 8 + 0] * rstd * kn[j * 8 + 0], kf[j * 8 + 1] * rstd * kn[j * 8 + 1]); o.y = pk2(kf[j * 8 + 2] * rstd * kn[j * 8 + 2], kf[j * 8 + 3] * rstd * kn[j * 8 + 3]);
            o.z = pk2(kf[j * 8 + 4] * rstd * kn[j * 8 + 4], kf[j * 8 + 5] * rstd * kn[j * 8 + 5]); o.w = pk2(kf[j * 8 + 6] * rstd * kn[j * 8 + 6], kf[j * 8 + 7] * rstd * kn[j * 8 + 7]);
            *(LAS v4u*)(Ks + key * SWA_KS + half * 32 + j * 8) = o; }
#pragma unroll
        for (int j = 0; j < 4; ++j) { const unsigned w4[4] = {vw[j].x, vw[j].y, vw[j].z, vw[j].w};
#pragma unroll
            for (int q = 0; q < 4; ++q) { const int d = half * 32 + j * 8 + q * 2; Vt[d * SWA_VS + key] = (bf16)(w4[q] & 0xffffu); Vt[(d + 1) * SWA_VS + key] = (bf16)(w4[q] >> 16); } }
        for (int idx = F.tid; idx < 8 * 128; idx += 512) { const int w = idx >> 7, dl = idx & 127; bt[idx] = F.in[I_REL_BIAS][t5_bucket(dl) * 16 + kvh * 8 + w]; }
    }
    __syncthreads();
    const float sink = F.in[I_SINKS][h];
    const float* qn = F.in[I_Q_NORM];
    for (int r = 0; r < 4; ++r) {
        const int qi = 32 * r + ql; const size_t t = (size_t)b * SEQ + nb * 128 + qi;
        bf16x8 qf[4];
        {   v4u qw[4]; float qv[32]; float ss = 0.f;
#pragma unroll
            for (int ks = 0; ks < 4; ++ks) qw[ks] = qnx[ks];
            if (r < 3) { const bf16* qp = PROJ + (t + 32) * INC + h * 64 + 8 * hh;
#pragma unroll
                for (int ks = 0; ks < 4; ++ks) qnx[ks] = *(const v4u*)(qp + ks * 16); }
#pragma unroll
            for (int ks = 0; ks < 4; ++ks) { qv[ks * 8 + 0] = bflo(qw[ks].x); qv[ks * 8 + 1] = bfhi(qw[ks].x); qv[ks * 8 + 2] = bflo(qw[ks].y); qv[ks * 8 + 3] = bfhi(qw[ks].y);
                qv[ks * 8 + 4] = bflo(qw[ks].z); qv[ks * 8 + 5] = bfhi(qw[ks].z); qv[ks * 8 + 6] = bflo(qw[ks].w); qv[ks * 8 + 7] = bfhi(qw[ks].w); }
#pragma unroll
            for (int j = 0; j < 32; ++j) ss += qv[j] * qv[j];
            ss += __shfl_xor(ss, 32);
            const float sc = 0.125f / sqrtf(ss * (1.f / 64.f) + EPS);
#pragma unroll
            for (int ks = 0; ks < 4; ++ks) { const float* g = qn + ks * 16 + 8 * hh; v4u o;
                o.x = pk2(qv[ks * 8 + 0] * sc * g[0], qv[ks * 8 + 1] * sc * g[1]); o.y = pk2(qv[ks * 8 + 2] * sc * g[2], qv[ks * 8 + 3] * sc * g[3]);
                o.z = pk2(qv[ks * 8 + 4] * sc * g[4], qv[ks * 8 + 5] * sc * g[5]); o.w = pk2(qv[ks * 8 + 6] * sc * g[6], qv[ks * 8 + 7] * sc * g[7]);
                qf[ks] = __builtin_bit_cast(bf16x8, o); } }
        f32x16 s[5];
        const int qh = ql - 4 * hh; const LAS float* pb = bt + w * 128 + qh;
        float mx = sink;
#pragma unroll
        for (int kt = 0; kt < 5; ++kt) {
            const bool live = (nb > 0) || (r + kt >= 4);
            f32x16 a = {0.f, 0.f, 0.f, 0.f, 0.f, 0.f, 0.f, 0.f, 0.f, 0.f, 0.f, 0.f, 0.f, 0.f, 0.f, 0.f};
            if (live) {
#pragma unroll
                for (int ks = 0; ks < 4; ++ks) { const bf16x8 kfrag = *(const LAS bf16x8*)(Ks + (32 * (r + kt) + ql) * SWA_KS + ks * 16 + 8 * hh);
                    a = __builtin_amdgcn_mfma_f32_32x32x16_bf16(kfrag, qf[ks], a, 0, 0, 0); }
#pragma unroll
                for (int rg = 0; rg < 16; ++rg) { const int rowc = (rg & 3) + 8 * (rg >> 2);
                    float v = a[rg] + pb[128 - 32 * kt - rowc];
                    if (kt == 0) v = (rowc > qh) ? v : -1e30f;
                    if (kt == 4) v = (rowc <= qh) ? v : -1e30f;
                    a[rg] = v; mx = fmaxf(mx, v); }
            } else {
#pragma unroll
                for (int rg = 0; rg < 16; ++rg) a[rg] = -1e30f;
            }
            s[kt] = a; }
        mx = fmaxf(mx, __shfl_xor(mx, 32));
        float l = 0.f;
#pragma unroll
        for (int kt = 0; kt < 5; ++kt)
#pragma unroll
            for (int rg = 0; rg < 16; ++rg) { const float p = fast_exp(s[kt][rg] - mx); s[kt][rg] = p; l += p; }
        l += __shfl_xor(l, 32);
        l += fast_exp(sink - mx);
        f32x16 o[2];
#pragma unroll
        for (int dt = 0; dt < 2; ++dt) o[dt] = (f32x16){0.f, 0.f, 0.f, 0.f, 0.f, 0.f, 0.f, 0.f, 0.f, 0.f, 0.f, 0.f, 0.f, 0.f, 0.f, 0.f};
#pragma unroll
        for (int kt = 0; kt < 5; ++kt)
#pragma unroll
            for (int st = 0; st < 2; ++st) { v4u pw; pw.x = pk2(s[kt][8 * st + 0], s[kt][8 * st + 1]); pw.y = pk2(s[kt][8 * st + 2], s[kt][8 * st + 3]); pw.z = pk2(s[kt][8 * st + 4], s[kt][8 * st + 5]); pw.w = pk2(s[kt][8 * st + 6], s[kt][8 * st + 7]);
                const bf16x8 pf = __builtin_bit_cast(bf16x8, pw);
#pragma unroll
                for (int dt = 0; dt < 2; ++dt) { const LAS bf16* vp = Vt + (dt * 32 + ql) * SWA_VS + 32 * (r + kt) + 16 * st + 4 * hh;
                    const v2u lo = *(const LAS v2u*)vp, hi = *(const LAS v2u*)(vp + 8); v4u vv; vv.x = lo.x; vv.y = lo.y; vv.z = hi.x; vv.w = hi.y;
                    o[dt] = __builtin_amdgcn_mfma_f32_32x32x16_bf16(__builtin_bit_cast(bf16x8, vv), pf, o[dt], 0, 0, 0); } }
        const float inv = 1.0f / l;
        { float ssq = 0.f;
#pragma unroll
          for (int dt = 0; dt < 2; ++dt)
#pragma unroll
              for (int rg = 0; rg < 16; ++rg) { const float v = o[dt][rg] * inv; ssq += v * v; }
          ssq += __shfl_xor(ssq, 32);
          if (hh == 0) ((float*)(F.ws + WS_SS))[t * 32 + h] = ssq; }
        bf16* op = MIX + t * D + h * 64 + 4 * hh;
#pragma unroll
        for (int dt = 0; dt < 2; ++dt)
#pragma unroll
            for (int q4 = 0; q4 < 4; ++q4) { v2u ow; ow.x = pk2(o[dt][q4 * 4 + 0] * inv, o[dt][q4 * 4 + 1] * inv); ow.y = pk2(o[dt][q4 * 4 + 2] * inv, o[dt][q4 * 4 + 3] * inv);
                *(v2u*)(op + dt * 32 + q4 * 8) = ow; }
    }
}

constexpr int XA_KS = 136, XA_VS = 264;
constexpr int XA_KOFF = 0, XA_VOFF = 256 * XA_KS * 2;
__device__ __forceinline__ void xattn_unit(Frame& F, int unit) {
    const int b = unit >> 5, hx = (unit >> 3) & 3, qb = unit & 7;
    const bf16* PROJ = (const bf16*)(F.ws + WS_PROJ); const bf16* MKV = (const bf16*)(F.ws + WS_MEMKV); bf16* MIX = (bf16*)(F.ws + WS_MIX);
    LAS bf16* Ks = (LAS bf16*)(F.lds + XA_KOFF); LAS bf16* Vt = (LAS bf16*)(F.lds + XA_VOFF);
    __syncthreads();
    {   const int key = F.tid >> 1, half = F.tid & 1; const bf16* rp = MKV + (size_t)(b * MEML + key) * 1024 + hx * 128 + half * 64;
        float ss = 0.f; v4u kw[8];
#pragma unroll
        for (int j = 0; j < 8; ++j) { kw[j] = *(const v4u*)(rp + j * 8);
            const float a0 = bflo(kw[j].x), a1 = bfhi(kw[j].x), a2 = bflo(kw[j].y), a3 = bfhi(kw[j].y), a4 = bflo(kw[j].z), a5 = bfhi(kw[j].z), a6 = bflo(kw[j].w), a7 = bfhi(kw[j].w);
            ss += (a0 * a0 + a1 * a1) + (a2 * a2 + a3 * a3) + (a4 * a4 + a5 * a5) + (a6 * a6 + a7 * a7); }
        ss += __shfl_xor(ss, 1);
        const float rstd = 1.0f / sqrtf(ss * (1.f / 128.f) + EPS);
        const float* kn = F.in[I_XK_NORM] + half * 64;
#pragma unroll
        for (int j = 0; j < 8; ++j) { v4u o; const float* g = kn + j * 8;
            o.x = pk2(bflo(kw[j].x) * rstd * g[0], bfhi(kw[j].x) * rstd * g[1]); o.y = pk2(bflo(kw[j].y) * rstd * g[2], bfhi(kw[j].y) * rstd * g[3]);
            o.z = pk2(bflo(kw[j].z) * rstd * g[4], bfhi(kw[j].z) * rstd * g[5]); o.w = pk2(bflo(kw[j].w) * rstd * g[6], bfhi(kw[j].w) * rstd * g[7]);
            *(LAS v4u*)(Ks + key * XA_KS + half * 64 + j * 8) = o; }
#pragma unroll
        for (int j = 0; j < 8; ++j) { const v4u vw = *(const v4u*)(rp + 512 + j * 8); const unsigned w4[4] = {vw.x, vw.y, vw.z, vw.w};
#pragma unroll
            for (int q = 0; q < 4; ++q) { const int d = half * 64 + j * 8 + q * 2; Vt[d * XA_VS + key] = (bf16)(w4[q] & 0xffffu); Vt[(d + 1) * XA_VS + key] = (bf16)(w4[q] >> 16); } }
    }
    __syncthreads();
    const int ql = F.lane & 31, hh = F.lane >> 5;
    const size_t t = (size_t)b * SEQ + qb * 256 + F.wave * 32 + ql;
    bf16x8 qf[8];
    {   const bf16* qp = PROJ + t * INC + 1792 + hx * 128 + 8 * hh; v4u qw[8]; float ss = 0.f;
#pragma unroll
        for (int ks = 0; ks < 8; ++ks) { qw[ks] = *(const v4u*)(qp + ks * 16);
            const float a0 = bflo(qw[ks].x), a1 = bfhi(qw[ks].x), a2 = bflo(qw[ks].y), a3 = bfhi(qw[ks].y), a4 = bflo(qw[ks].z), a5 = bfhi(qw[ks].z), a6 = bflo(qw[ks].w), a7 = bfhi(qw[ks].w);
            ss += (a0 * a0 + a1 * a1) + (a2 * a2 + a3 * a3) + (a4 * a4 + a5 * a5) + (a6 * a6 + a7 * a7); }
        ss += __shfl_xor(ss, 32);
        const float sc = 0.08838834764831845f / sqrtf(ss * (1.f / 128.f) + EPS);
        const float* qn = F.in[I_XQ_NORM] + 8 * hh;
#pragma unroll
        for (int ks = 0; ks < 8; ++ks) { const float* g = qn + ks * 16; v4u o;
            o.x = pk2(bflo(qw[ks].x) * sc * g[0], bfhi(qw[ks].x) * sc * g[1]); o.y = pk2(bflo(qw[ks].y) * sc * g[2], bfhi(qw[ks].y) * sc * g[3]);
            o.z = pk2(bflo(qw[ks].z) * sc * g[4], bfhi(qw[ks].z) * sc * g[5]); o.w = pk2(bflo(qw[ks].w) * sc * g[6], bfhi(qw[ks].w) * sc * g[7]);
            qf[ks] = __builtin_bit_cast(bf16x8, o); } }
    f32x16 o[4];
#pragma unroll
    for (int dt = 0; dt < 4; ++dt) o[dt] = (f32x16){0.f, 0.f, 0.f, 0.f, 0.f, 0.f, 0.f, 0.f, 0.f, 0.f, 0.f, 0.f, 0.f, 0.f, 0.f, 0.f};
    float mrun = -1e30f, lrun = 0.f;
    for (int kb = 0; kb < 4; ++kb) {
        f32x16 s[2];
#pragma unroll
        for (int kt = 0; kt < 2; ++kt) { f32x16 a = {0.f, 0.f, 0.f, 0.f, 0.f, 0.f, 0.f, 0.f, 0.f, 0.f, 0.f, 0.f, 0.f, 0.f, 0.f, 0.f};
#pragma unroll
            for (int ks = 0; ks < 8; ++ks) { const bf16x8 kfrag = *(const LAS bf16x8*)(Ks + (64 * kb + 32 * kt + ql) * XA_KS + ks * 16 + 8 * hh);
                a = __builtin_amdgcn_mfma_f32_32x32x16_bf16(kfrag, qf[ks], a, 0, 0, 0); }
            s[kt] = a; }
        float mx = mrun;
#pragma unroll
        for (int kt = 0; kt < 2; ++kt)
#pragma unroll
            for (int rg = 0; rg < 16; ++rg) mx = fmaxf(mx, s[kt][rg]);
        mx = fmaxf(mx, __shfl_xor(mx, 32));
        const float alpha = fast_exp(mrun - mx); mrun = mx;
        float ls = 0.f;
#pragma unroll
        for (int kt = 0; kt < 2; ++kt)
#pragma unroll
            for (int rg = 0; rg < 16; ++rg) { const float p = fast_exp(s[kt][rg] - mx); s[kt][rg] = p; ls += p; }
        lrun = lrun * alpha + ls;
#pragma unroll
        for (int dt = 0; dt < 4; ++dt)
#pragma unroll
            for (int rg = 0; rg < 16; ++rg) o[dt][rg] *= alpha;
#pragma unroll
        for (int kt = 0; kt < 2; ++kt)
#pragma unroll
            for (int st = 0; st < 2; ++st) { v4u pw; pw.x = pk2(s[kt][8 * st + 0], s[kt][8 * st + 1]); pw.y = pk2(s[kt][8 * st + 2], s[kt][8 * st + 3]); pw.z = pk2(s[kt][8 * st + 4], s[kt][8 * st + 5]); pw.w = pk2(s[kt][8 * st + 6], s[kt][8 * st + 7]);
                const bf16x8 pf = __builtin_bit_cast(bf16x8, pw);
#pragma unroll
                for (int dt = 0; dt < 4; ++dt) { const LAS bf16* vp = Vt + (dt * 32 + ql) * XA_VS + 64 * kb + 32 * kt + 16 * st + 4 * hh;
                    const v2u lo = *(const LAS v2u*)vp, hi = *(const LAS v2u*)(vp + 8); v4u vv; vv.x = lo.x; vv.y = lo.y; vv.z = hi.x; vv.w = hi.y;
                    o[dt] = __builtin_amdgcn_mfma_f32_32x32x16_bf16(__builtin_bit_cast(bf16x8, vv), pf, o[dt], 0, 0, 0); } }
    }
    lrun += __shfl_xor(lrun, 32);
    const float inv = 1.0f / lrun;
    { float ssq = 0.f;
#pragma unroll
      for (int dt = 0; dt < 4; ++dt)
#pragma unroll
          for (int rg = 0; rg < 16; ++rg) { const float v = o[dt][rg] * inv; ssq += v * v; }
      ssq += __shfl_xor(ssq, 32);
      if (hh == 0) ((float*)(F.ws + WS_SS))[t * 32 + 24 + hx] = ssq; }
    bf16* op = MIX + t * D + 1536 + hx * 128 + 4 * hh;
#pragma unroll
    for (int dt = 0; dt < 4; ++dt)
#pragma unroll
        for (int q4 = 0; q4 < 4; ++q4) { v2u ow; ow.x = pk2(o[dt][q4 * 4 + 0] * inv, o[dt][q4 * 4 + 1] * inv); ow.y = pk2(o[dt][q4 * 4 + 2] * inv, o[dt][q4 * 4 + 3] * inv);
            *(v2u*)(op + dt * 32 + q4 * 8) = ow; }
}

__device__ __forceinline__ void moe_tables(Frame& F) {
    LAS int* cnt = (LAS int*)(F.lds + TAB_OFF); LAS int* ts = cnt + 64;
    __syncthreads();
    if (F.tid < 64) { const int c = (int)__hip_atomic_load(F.ctl + CW_CNT + F.tid, __ATOMIC_RELAXED, __HIP_MEMORY_SCOPE_AGENT); const int nt = (c + 255) >> 8; int inc = nt;
#pragma unroll
        for (int o = 1; o < 64; o <<= 1) { const int v = __shfl_up(inc, o); if (F.tid >= o) inc += v; }
        cnt[F.tid] = c; ts[F.tid + 1] = inc; if (F.tid == 0) ts[0] = 0; }
    __syncthreads();
}

struct Args { const float* in[31]; float* out; unsigned char* ws; int ph_lo, ph_hi; };
__global__ void __launch_bounds__(512, 2) hymba_fwd(Args args) {
    extern __shared__ __attribute__((aligned(16))) unsigned char lds_raw[];
    Frame F;
    F.lds = (LAS unsigned char*)lds_raw;
    F.tid = threadIdx.x; F.lane = F.tid & 63; F.wave = __builtin_amdgcn_readfirstlane(F.tid >> 6);
    F.G = gridDim.x; { const int bx = blockIdx.x; F.vcu = (F.G % 8 == 0) ? (bx % 8) * (F.G / 8) + bx / 8 : bx; }
    F.in = (const float* const __attribute__((address_space(4)))*)__builtin_amdgcn_kernarg_segment_ptr();
    F.out = args.out; F.ws = args.ws; F.ctl = (unsigned*)(args.ws + WS_CTL);
    const int lo = args.ph_lo, hi = args.ph_hi;
#if !MK_PER_PHASE
    if (F.tid < 4) ((LAS unsigned*)(F.lds + XBW_OFF))[F.tid] = 0u;
    __syncthreads();
    XcdBarrier bar = xcd_barrier_post(F.ctl + CW_BAR, (volatile LAS unsigned*)(F.lds + XBW_OFF));
#define GRID_BAR() xcd_barrier(bar)
#else
#define GRID_BAR() do {} while (0)
#endif
#define PHASE_REGS() do { int _l = (int)__builtin_amdgcn_mbcnt_hi(~0u, __builtin_amdgcn_mbcnt_lo(~0u, 0u)); asm volatile("" : "+v"(_l)); F.lane = _l; F.tid = F.wave * 64 + _l; } while (0)
#define IN(k) (lo <= (k) && (k) < hi)
#define SEAM(k) do { if (IN(k) && IN((k) + 1)) GRID_BAR(); } while (0)
    const int gw = F.vcu * 8 + F.wave, NGW = F.G * 8;
    bf16* const XN = (bf16*)(F.ws + WS_XN); bf16* const PROJ = (bf16*)(F.ws + WS_PROJ); bf16* const MIX = (bf16*)(F.ws + WS_MIX);
    bf16* const UA = (bf16*)(F.ws + WS_UA); bf16* const Gm = (bf16*)(F.ws + WS_G);

    if (IN(0)) { PHASE_REGS(); p0_prologue(F); }
    SEAM(0);
    if (IN(1)) { PHASE_REGS();
        { pg8::Gemm g{D, D, D}; pg8::DenseOrder S; S.init(XN, F.ws + WS_WIN, D, D, T, INC, F.G, (int)blockIdx.x);
          pg8::EpiProj E{PROJ, UA}; pg8::gemm_phase<pg8::EpiProj, pg8::DenseOrder>(F.lds, g, S, E, F.wave); }
        { pg8::Gemm g{D, D, D}; pg8::DenseOrder S; S.init(F.ws + WS_MEMN, F.ws + WS_WMKV, D, D, NB * MEML, 1024, F.G, F.G - 1 - (int)blockIdx.x);
          pg8::EpiBf16 E{(bf16*)(F.ws + WS_MEMKV), 1024}; pg8::gemm_phase<pg8::EpiBf16, pg8::DenseOrder>(F.lds, g, S, E, F.wave); }
        { const int c = (int)blockIdx.x; const bool has3 = 2 * F.G + c < (T / 256) * (INC / 256), haskv = (F.G - 1 - c) < (NB * MEML / 256) * 4;
          bg_convert(F, CW_QGU, 0, BT_GU, (!has3 && !haskv) ? PB1 : 0); }
    }
    SEAM(1);
    if (IN(2)) { PHASE_REGS();
        for (int u = F.vcu; u < 256; u += F.G) swa_unit(F, u);
        __syncthreads();
        { pg8::Gemm g{S5K, 512, 256}; pg8::StateOrder S{(const char*)UA, (const char*)(F.ws + WS_SP), F.G, F.G - 1 - F.vcu};
          pg8::EpiF32 E{(float*)(F.ws + WS_SL), 256, (size_t)512 * 256}; pg8::gemm_phase<pg8::EpiF32, pg8::StateOrder>(F.lds, g, S, E, F.wave); }
    }
    SEAM(2);
    if (IN(3)) { PHASE_REGS();
        if (F.wave < 4) { const float* SL = (const float*)(F.ws + WS_SL); const float* AL = (const float*)(F.ws + WS_AL);
            for (int L = F.vcu; L < 128; L += F.G) { const int g = L >> 2, pm = L & 1, b = 4 * pm + F.wave, n = F.lane;
                const float ar = AL[(g * 64 + n) * 2], ai = AL[(g * 64 + n) * 2 + 1]; float xr = 0.f, xi = 0.f;
                for (int j0 = 0; j0 < 64; j0 += 8) { float sr[8], si[8];
#pragma unroll
                    for (int j = 0; j < 8; ++j) { const float* sp = SL + ((size_t)(g * 1024 + b * 64 + j0 + j)) * 256; const float* sq = sp + (size_t)512 * 256; sr[j] = sp[n] + sq[n]; si[j] = sp[64 + n] + sq[64 + n]; }
#pragma unroll
                    for (int j = 0; j < 8; ++j) { bf16* up = UA + ((size_t)(g * 512 + b * 64 + j0 + j)) * S5K + 512; up[n] = (bf16)f2bf(xr); up[64 + n] = (bf16)f2bf(xi);
                        const float nr = ar * xr - ai * xi + sr[j], ni = ar * xi + ai * xr + si[j]; xr = nr; xi = ni; } } } }
        asm volatile("s_waitcnt vmcnt(0)" ::: "memory");
        __syncthreads();
        pg8::Gemm g{S5K, S5K, S5K}; pg8::GroupOrder S{(const char*)UA, (const char*)(F.ws + WS_MQ), S5K, S5K, 2, 32, F.G, F.vcu};
        pg8::EpiS5Y E{UA, F.in[I_SSM_D], Gm}; pg8::gemm_phase<pg8::EpiS5Y, pg8::GroupOrder>(F.lds, g, S, E, F.wave);
        if (F.G >= 256 && F.vcu >= 128) { for (int u = F.vcu - 128; u < 128; u += F.G - 128) xattn_unit(F, u); __syncthreads(); }
    }
    SEAM(3);
    if (IN(4)) { PHASE_REGS();
        pg8::Gemm g{512, 512, 512}; pg8::DenseOrder S; S.init(Gm, F.ws + WS_WGLU, 512, 512, T, 512, F.G, (int)blockIdx.x);
        pg8::EpiGlu E{Gm, MIX, (float*)(F.ws + WS_SS)}; pg8::gemm_phase<pg8::EpiGlu, pg8::DenseOrder>(F.lds, g, S, E, F.wave);
        if (F.G >= 256 && (int)blockIdx.x >= 128) { for (int u = 128 + (int)blockIdx.x - 128; u < 256; u += F.G - 128) xattn_unit(F, u); __syncthreads(); }
    }
    SEAM(4);
    if (IN(5)) { PHASE_REGS();
        pg8::Gemm g{D, D, D}; pg8::DenseOrder S; S.init(MIX, F.ws + WS_WO, D, D, T, D, F.G, (int)blockIdx.x);
        pg8::EpiWo E{(const float*)(F.ws + WS_RINV), XN, (unsigned char*)(F.ws + WS_X18), (float*)(F.ws + WS_PART)}; pg8::gemm_phase<pg8::EpiWo, pg8::DenseOrder, false, false, true>(F.lds, g, S, E, F.wave, (const float*)(F.ws + WS_SS));
    }
    SEAM(5);
    if (IN(6)) { PHASE_REGS();
        pg8::Gemm g{D, 512, 512}; pg8::KSplitOrder S{(const char*)XN, (const char*)(F.ws + WS_WR), D, 512, 512, T / 256, 4, F.G, F.vcu};
        pg8::EpiLogit E{(float*)(F.ws + WS_LP)}; pg8::gemm_phase<pg8::EpiLogit, pg8::KSplitOrder>(F.lds, g, S, E, F.wave);
    }
    SEAM(6);
    const int rt_per = (T + F.G - 1) / F.G, rt_beg = F.vcu * rt_per, rt_end = (rt_beg + rt_per) < T ? (rt_beg + rt_per) : T;
    if (IN(7)) { PHASE_REGS();
        LAS int* hist = (LAS int*)F.lds;
        const float* LP = (const float*)(F.ws + WS_LP); const float* part = (const float*)(F.ws + WS_PART); float* rstdv = (float*)(F.ws + WS_RSTD);
        int* toke = (int*)(F.ws + WS_TOKE); float* wts = (float*)(F.ws + WS_WTS); int* HIST = (int*)(F.ws + WS_HIST);
        __syncthreads();
        if (F.tid < 64) hist[F.tid] = 0;
        __syncthreads();
        for (int t = rt_beg + F.tid; t < rt_end; t += 512) {
            const f32x4* pp = (const f32x4*)(part + (size_t)t * 32); float ss = 0.f;
#pragma unroll
            for (int j = 0; j < 8; ++j) { const f32x4 v = pp[j]; ss += (v[0] + v[1]) + (v[2] + v[3]); }
            const float rs = 1.0f / sqrtf(ss * (1.f / 2048.f) + EPS); rstdv[t] = rs;
            const float* l0 = LP + (size_t)t * 80; const float* l1 = l0 + (size_t)T * 80; const float* l2 = l1 + (size_t)T * 80; const float* l3 = l2 + (size_t)T * 80;
            float gl[8];
#pragma unroll
            for (int j = 0; j < 8; j += 4) { const f32x4 a = *(const f32x4*)(l0 + j), b = *(const f32x4*)(l1 + j), c = *(const f32x4*)(l2 + j), d = *(const f32x4*)(l3 + j);
#pragma unroll
                for (int q = 0; q < 4; ++q) gl[j + q] = rs * (((a[q] + b[q]) + c[q]) + d[q]); }
            int gi = 0; float gm = gl[0];
#pragma unroll
            for (int j = 1; j < 8; ++j) if (gl[j] > gm) { gm = gl[j]; gi = j; }
            float gs = 0.f;
#pragma unroll
            for (int j = 0; j < 8; ++j) gs += expf(gl[j] - gm);
            const float gate = 1.0f / gs;
            float el[8];
#pragma unroll
            for (int j = 0; j < 8; j += 4) { const int o = 8 + gi * 8 + j; const f32x4 a = *(const f32x4*)(l0 + o), b = *(const f32x4*)(l1 + o), c = *(const f32x4*)(l2 + o), d = *(const f32x4*)(l3 + o);
#pragma unroll
                for (int q = 0; q < 4; ++q) el[j + q] = rs * (((a[q] + b[q]) + c[q]) + d[q]); }
            int i1 = 0; float v1 = el[0];
#pragma unroll
            for (int j = 1; j < 8; ++j) if (el[j] > v1) { v1 = el[j]; i1 = j; }
            int i2 = -1; float v2 = -3.0e38f;
#pragma unroll
            for (int j = 0; j < 8; ++j) if (j != i1 && el[j] > v2) { v2 = el[j]; i2 = j; }
            const float ex = expf(v2 - v1);
            const int ea = gi * 8 + i1, eb = gi * 8 + i2;
            const int la = __hip_atomic_fetch_add(hist + ea, 1, __ATOMIC_RELAXED, __HIP_MEMORY_SCOPE_WORKGROUP), lb = __hip_atomic_fetch_add(hist + eb, 1, __ATOMIC_RELAXED, __HIP_MEMORY_SCOPE_WORKGROUP);
            toke[t * 2] = (ea << 16) | la; toke[t * 2 + 1] = (eb << 16) | lb; wts[t * 2] = gate / (1.0f + ex); wts[t * 2 + 1] = gate * ex / (1.0f + ex);
        }
        __syncthreads();
        if (F.tid < 64) HIST[F.vcu * 64 + F.tid] = hist[F.tid];
        __syncthreads();
    }
    SEAM(7);
    if (IN(8)) { PHASE_REGS();
        LAS int* pb = (LAS int*)F.lds; LAS int* pt = pb + 512; LAS int* base = pt + 512;
        const int* HIST = (const int*)(F.ws + WS_HIST); const int* toke = (const int*)(F.ws + WS_TOKE); int* list = (int*)(F.ws + WS_LIST);
        __syncthreads();
        { const int e = F.tid & 63, p8 = F.tid >> 6; int sb = 0, st = 0;
          for (int w = p8; w < F.G; w += 8) { const int h = HIST[w * 64 + e]; st += h; sb += (w < F.vcu) ? h : 0; }
          pb[F.tid] = sb; pt[F.tid] = st; }
        __syncthreads();
        if (F.tid < 64) { int sb = 0, st = 0;
#pragma unroll
            for (int j = 0; j < 8; ++j) { sb += pb[j * 64 + F.tid]; st += pt[j * 64 + F.tid]; }
            base[F.tid] = sb; F.ctl[CW_CNT + F.tid] = (unsigned)st; }
        __syncthreads();
        for (int t = rt_beg + F.tid; t < rt_end; t += 512) {
#pragma unroll
            for (int k = 0; k < 2; ++k) { const int v = toke[t * 2 + k], e = v >> 16, sl = v & 0xffff; const size_t pos = (size_t)e * LCAP + base[e] + sl;
                list[pos] = t * 2 + k; ((float*)(F.ws + WS_LRS))[pos] = ((const float*)(F.ws + WS_RSTD))[t]; ((float*)(F.ws + WS_LWT))[pos] = ((const float*)(F.ws + WS_WTS))[t * 2 + k]; } }
        __syncthreads();
        bg_convert(F, CW_QGU, 0, BT_GU, 0x7fffffff);
    }
    SEAM(8);
    if (IN(9)) { PHASE_REGS();
        moe_tables(F);
        const LAS int* cnt = (const LAS int*)(F.lds + TAB_OFF); const int* list = (const int*)(F.ws + WS_LIST);
        pg8::Gemm g{D / 2, D / 2, D / 2}; pg8::MoeOrder S{(const char*)(F.ws + WS_X18), (const char*)(F.ws + WS_WGU), cnt, cnt + 64, list, D / 2, D / 2, 4, 1024, F.G, F.vcu, true};
        pg8::EpiGU E{list, (const float*)(F.ws + WS_LRS), cnt, F.ws + WS_ACT}; pg8::gemm_phase<pg8::EpiGU, pg8::MoeOrder, true, true>(F.lds, g, S, E, F.wave);
        PHASE_REGS();
        bg_convert(F, CW_QD, BT_GU, BT_D, 0x7fffffff);
    }
    SEAM(9);
    if (IN(10)) { PHASE_REGS();
        moe_tables(F);
        const LAS int* cnt = (const LAS int*)(F.lds + TAB_OFF); const int* list = (const int*)(F.ws + WS_LIST);
        pg8::Gemm g{DEXP / 2, DEXP / 2, DEXP / 2}; pg8::MoeOrder S{(const char*)(F.ws + WS_ACT), (const char*)(F.ws + WS_WD), cnt, cnt + 64, list, DEXP / 2, DEXP / 2, 8, 2048, F.G, F.vcu, false};
        pg8::EpiDown E{list, (const float*)(F.ws + WS_LWT), cnt, F.ws + WS_Y2};
        pg8::gemm_phase<pg8::EpiDown, pg8::MoeOrder, false, true>(F.lds, g, S, E, F.wave);
    }
    SEAM(10);
    if (IN(11)) { PHASE_REGS();
        const unsigned char* Y2 = F.ws + WS_Y2; typedef float f32x2_ __attribute__((ext_vector_type(2)));
        for (int m = gw; m < T; m += NGW) { f32x4* op = (f32x4*)(F.out + (size_t)m * D) + F.lane * 2; const v4u* xb = (const v4u*)(XN + (size_t)m * D) + F.lane;
            const v2u* ya = (const v2u*)(Y2 + (size_t)m * 2 * D) + F.lane; const v2u* yb = ya + 256;
            v4u xw[4]; v2u aw[4], cw[4];
#pragma unroll
            for (int j = 0; j < 4; ++j) { xw[j] = __builtin_nontemporal_load(xb + 64 * j); aw[j] = __builtin_nontemporal_load(ya + 64 * j); cw[j] = __builtin_nontemporal_load(yb + 64 * j); }
#pragma unroll
            for (int j = 0; j < 4; ++j) { const v4u x = xw[j]; const v2u a = aw[j], c = cw[j]; f32x4 x0, x1; const float is = 1.0f / SC_Y;
                const f32x2_ a0 = __builtin_amdgcn_cvt_pk_f32_fp8((int)a.x, false), a1 = __builtin_amdgcn_cvt_pk_f32_fp8((int)a.x, true), a2 = __builtin_amdgcn_cvt_pk_f32_fp8((int)a.y, false), a3 = __builtin_amdgcn_cvt_pk_f32_fp8((int)a.y, true);
                const f32x2_ c0 = __builtin_amdgcn_cvt_pk_f32_fp8((int)c.x, false), c1 = __builtin_amdgcn_cvt_pk_f32_fp8((int)c.x, true), c2 = __builtin_amdgcn_cvt_pk_f32_fp8((int)c.y, false), c3 = __builtin_amdgcn_cvt_pk_f32_fp8((int)c.y, true);
                x0[0] = bflo(x.x) + (a0[0] + c0[0]) * is; x0[1] = bfhi(x.x) + (a0[1] + c0[1]) * is; x0[2] = bflo(x.y) + (a1[0] + c1[0]) * is; x0[3] = bfhi(x.y) + (a1[1] + c1[1]) * is;
                x1[0] = bflo(x.z) + (a2[0] + c2[0]) * is; x1[1] = bfhi(x.z) + (a2[1] + c2[1]) * is; x1[2] = bflo(x.w) + (a3[0] + c3[0]) * is; x1[3] = bfhi(x.w) + (a3[1] + c3[1]) * is;
                __builtin_nontemporal_store(x0, op + 128 * j); __builtin_nontemporal_store(x1, op + 128 * j + 1); } }
    }
#undef IN
#undef SEAM
}

extern "C" void kernel_launch(void* const* d_in, const int* in_sizes, int n_in, void* d_out, int out_size, void* d_ws, size_t ws_size, hipStream_t stream) {
    static int grid = 0;
    if (grid == 0) {
        if (n_in != 31 || out_size != T * D || ws_size < WS_END) { fprintf(stderr, "kernel_launch: unexpected shapes (n_in %d out %d ws %zu)\n", n_in, out_size, ws_size); grid = -1; return; }
        int dev = 0, cus = 0, per_cu = 0;
        if (hipGetDevice(&dev) != hipSuccess || hipDeviceGetAttribute(&cus, hipDeviceAttributeMultiprocessorCount, dev) != hipSuccess) { grid = -1; return; }
        if (hipFuncSetAttribute((const void*)hymba_fwd, hipFuncAttributeMaxDynamicSharedMemorySize, LDS_BYTES) != hipSuccess) { fprintf(stderr, "kernel_launch: hipFuncSetAttribute failed\n"); grid = -1; return; }
        if (hipOccupancyMaxActiveBlocksPerMultiprocessor(&per_cu, (const void*)hymba_fwd, 512, LDS_BYTES) != hipSuccess || per_cu < 1) fprintf(stderr, "kernel_launch: occupancy query reports %d\n", per_cu);
        (void)hipGetLastError();
        grid = cus;
    }
    if (grid < 0) return;
    (void)hipMemsetAsync((char*)d_ws + WS_CTL, 0, CTL_ZERO_BYTES, stream);
    Args a{};
    for (int i = 0; i < 31; ++i) a.in[i] = (const float*)d_in[i];
    a.out = (float*)d_out; a.ws = (unsigned char*)d_ws;
#if MK_PER_PHASE
    for (int p = 0; p < NPH; ++p) { const int reps = ((PROBE_REP_MASK >> p) & 1) ? 2 : 1;
        for (int q = 0; q < reps; ++q) { a.ph_lo = p; a.ph_hi = p + 1; hipLaunchKernelGGL(hymba_fwd, dim3(grid), dim3(512), LDS_BYTES, stream, a); } }
#else
    a.ph_lo = 0; a.ph_hi = NPH; hipLaunchKernelGGL(hymba_fwd, dim3(grid), dim3(512), LDS_BYTES, stream, a);
#endif
}
```

```cpp
#include <hip/hip_runtime.h>
#include <cstdio>
#include <cstdint>

#ifndef PROBE_REP_MASK
#define PROBE_REP_MASK 0
#endif
#ifndef PB0
#define PB0 40
#endif
#ifndef PB0_S5
#define PB0_S5 28
#endif
#ifndef PB0_D
#define PB0_D 0
#endif
#ifndef PB1
#define PB1 18
#endif
#ifndef PB2
#define PB2 0
#endif
#ifndef PB4
#define PB4 3
#endif
#ifndef PB5
#define PB5 0
#endif
#ifndef PB11
#define PB11 0
#endif
#ifndef MK_PER_PHASE
#define MK_PER_PHASE 0
#endif

#define GAS __attribute__((address_space(1)))
#define LAS __attribute__((address_space(3)))
typedef unsigned short bf16;
typedef unsigned v4u __attribute__((ext_vector_type(4)));
typedef unsigned v2u __attribute__((ext_vector_type(2)));
typedef float f32x4 __attribute__((ext_vector_type(4)));
typedef float f32x16 __attribute__((ext_vector_type(16)));
typedef short bf16x8 __attribute__((ext_vector_type(8)));
typedef short bf16x4 __attribute__((ext_vector_type(4)));
typedef int v8i __attribute__((ext_vector_type(8)));
typedef int v4i_ __attribute__((ext_vector_type(4)));

constexpr int T = 16384, D = 2048, SEQ = 2048, NB = 8, INC = 2304, MEML = 256;
constexpr int NPH = 12;
constexpr float EPS = 1e-6f;
constexpr int NEXP = 64, DEXP = 512, LCAP = 16384;
constexpr int S5L = 32, S5K = 640;

constexpr size_t MiB = 1u << 20;
constexpr size_t WS_CTL = 0, CTL_ZERO_BYTES = 1 * MiB;
constexpr size_t WS_WIN = 2 * MiB, WS_WO = 11 * MiB, WS_WMKV = 19 * MiB, WS_WGLU = 23 * MiB;
constexpr size_t WS_MQ = 24 * MiB, WS_SP = 44 * MiB, WS_UA = 52 * MiB, WS_SL = 468 * MiB  , WS_AL = 88 * MiB, WS_WR = 89 * MiB;
constexpr size_t WS_XN = 96 * MiB;
constexpr size_t WS_MEMN = 160 * MiB, WS_MEMKV = 168 * MiB;
constexpr size_t WS_PROJ = 176 * MiB;
constexpr size_t WS_MIX = 248 * MiB;
constexpr size_t WS_Y2 = 176 * MiB;
constexpr size_t WS_G = 312 * MiB;
constexpr size_t WS_LOG = 328 * MiB;
constexpr size_t WS_LIST = 344 * MiB;
constexpr size_t WS_WTS = 348 * MiB;
constexpr size_t WS_LP = 352 * MiB;
constexpr size_t WS_PART = 376 * MiB;
constexpr size_t WS_RSTD = 379 * MiB;
constexpr size_t WS_HIST = 380 * MiB;
constexpr size_t WS_X18 = 384 * MiB;
constexpr size_t WS_SS = 382 * MiB;
constexpr size_t WS_LRS = 452 * MiB;
constexpr size_t WS_LWT = 456 * MiB;
constexpr size_t WS_RINV = 460 * MiB;
constexpr size_t WS_TOKE = 381 * MiB;
constexpr size_t WS_ACT = 544 * MiB;
constexpr size_t WS_WGU = 592 * MiB;
constexpr size_t WS_WD = 848 * MiB;
constexpr size_t WS_END = 976 * MiB;
constexpr int CW_CNT = 1024;
constexpr int CW_BAR = 4096;
constexpr int CW_QGU = 2048, CW_QD = 2112;

constexpr int RING_BYTES = 131072;
constexpr int TAB_OFF = 139264;
constexpr int XBW_OFF = TAB_OFF + 2048;
constexpr int LDS_BYTES = 147456;

#define LDS_WAIT() asm volatile("s_waitcnt lgkmcnt(0)" ::: "memory")
#define VM_WAIT() asm volatile("s_waitcnt vmcnt(0)" ::: "memory")
__device__ __forceinline__ unsigned f2bf(float f) { unsigned u = __builtin_bit_cast(unsigned, f); return (u + 0x7fffu + ((u >> 16) & 1u)) >> 16; }
__device__ __forceinline__ unsigned pk2(float lo, float hi) { unsigned r; asm volatile("v_cvt_pk_bf16_f32 %0, %1, %2" : "=v"(r) : "v"(lo), "v"(hi)); return r; }
__device__ __forceinline__ float bflo(unsigned w) { return __builtin_bit_cast(float, w << 16); }
__device__ __forceinline__ float bfhi(unsigned w) { return __builtin_bit_cast(float, w & 0xffff0000u); }
__device__ __forceinline__ float wave_sum(float v) {
#pragma unroll
    for (int o = 1; o < 64; o <<= 1) v += __shfl_xor(v, o);
    return v;
}
constexpr float SC_X = 4.0f, SC_WGU = 32.0f, SC_ACT = 16.0f, SC_WD = 16.0f, SC_Y = 64.0f;
__device__ __forceinline__ float clamp8(float v) { return __builtin_amdgcn_fmed3f(v, -448.0f, 448.0f); }
__device__ __forceinline__ unsigned pk4_fp8(float a, float b, float c, float d) { unsigned w = 0u; w = (unsigned)__builtin_amdgcn_cvt_pk_fp8_f32(clamp8(a), clamp8(b), (int)w, false); w = (unsigned)__builtin_amdgcn_cvt_pk_fp8_f32(clamp8(c), clamp8(d), (int)w, true); return w; }
__device__ __forceinline__ float fast_exp(float x) { return __builtin_amdgcn_exp2f(x * 1.44269504089f); }
__device__ __forceinline__ float sigmoidf_(float x) { return __builtin_amdgcn_rcpf(1.0f + fast_exp(-x)); }
__device__ __forceinline__ float gelu_tanh(float x) { const float z = 1.5957691216f * (x + 0.044715f * x * x * x); return x * sigmoidf_(z); }

#define XB_TMO      128
#define XB_XCNT(j)  (256  + 64 * (j))
#define XB_XSUB(j)  (1280 + 64 * (j))
#define XB_XGEN(j)  (2304 + 64 * (j))
#define XB_TOP      3328
#define XB_TOPGEN   3392
#define XCD_BAR_WORDS 3456
#define XB_SPIN_CAP (1u << 18)
__device__ __forceinline__ unsigned xb_ld(unsigned* p)              { return __hip_atomic_load(p, __ATOMIC_RELAXED, __HIP_MEMORY_SCOPE_AGENT); }
__device__ __forceinline__ unsigned xb_add(unsigned* p, unsigned v) { return __hip_atomic_fetch_add(p, v, __ATOMIC_RELAXED, __HIP_MEMORY_SCOPE_AGENT); }
__device__ __forceinline__ unsigned xb_xcc_id() { return (unsigned)__builtin_amdgcn_s_getreg((3 << 11) | 20) & 0xFu; }
#define XB_SPIN(cond, bar) do { unsigned _sp = 0; while (cond) { __builtin_amdgcn_s_sleep(1); \
    if ((++_sp & 255u) == 0u) { if (xb_ld(&(bar)[XB_TMO])) break; if (_sp > XB_SPIN_CAP) { atomicAdd(&(bar)[XB_TMO], 1u); break; } } } } while (0)
struct XcdBarrier { unsigned* bar; unsigned x; volatile LAS unsigned* st; };
__device__ __forceinline__ XcdBarrier xcd_barrier_post(unsigned* bar, volatile LAS unsigned* st) {
    XcdBarrier b; b.bar = bar; b.x = xb_xcc_id(); b.st = st;
    if (threadIdx.x == 0) (void)xb_add(&bar[XB_XCNT(b.x)], 1u);
    return b;
}
__device__ __forceinline__ void xcd_barrier_complete(unsigned* bar, unsigned x, unsigned& nloc, unsigned& nx) {
    const unsigned G = gridDim.x * gridDim.y * gridDim.z;
    unsigned sum, cnt, mine, sp = 0u;
    for (;;) {
        sum = 0u; cnt = 0u; mine = 0u;
#pragma unroll
        for (unsigned j = 0; j < 16; ++j) { const unsigned c = xb_ld(&bar[XB_XCNT(j)]); sum += c; cnt += (c > 0u) ? 1u : 0u; mine = (j == x) ? c : mine; }
        if (sum == G) break;
        __builtin_amdgcn_s_sleep(1);
        if ((++sp & 255u) == 0u) { if (xb_ld(&bar[XB_TMO])) break; if (sp > XB_SPIN_CAP) { atomicAdd(&bar[XB_TMO], 1u); break; } }
    }
    nloc = mine > 0u ? mine : 1u; nx = cnt > 0u ? cnt : 1u;
}
__device__ __forceinline__ void xcd_barrier(const XcdBarrier& b) {
    asm volatile("s_waitcnt vmcnt(0)" ::: "memory");
    __syncthreads();
    if (threadIdx.x == 0) {
        unsigned* bar = b.bar;
        __builtin_amdgcn_s_waitcnt(0);
        unsigned nloc = b.st[0], nx = b.st[1];
        if (nloc == 0u) { xcd_barrier_complete(bar, b.x, nloc, nx); b.st[0] = nloc; b.st[1] = nx; }
        const unsigned old = xb_add(&bar[XB_XSUB(b.x)], 1u);
        const unsigned gen = old / nloc;
        if (old + 1u == (gen + 1u) * nloc) {
            __builtin_amdgcn_fence(__ATOMIC_RELEASE, "agent");
            asm volatile("s_waitcnt vmcnt(0)" ::: "memory");
            const unsigned og = xb_add(&bar[XB_TOP], 1u);
            const unsigned tg = og / nx;
            if (og + 1u == (tg + 1u) * nx) xb_add(&bar[XB_TOPGEN], 1u);
            else XB_SPIN(xb_ld(&bar[XB_TOPGEN]) == tg, bar);
            __builtin_amdgcn_fence(__ATOMIC_ACQUIRE, "agent");
            xb_add(&bar[XB_XGEN(b.x)], 1u);
            asm volatile("s_waitcnt vmcnt(0)" ::: "memory");
        } else {
            XB_SPIN(xb_ld(&bar[XB_XGEN(b.x)]) == gen, bar);
            __builtin_amdgcn_fence(__ATOMIC_ACQUIRE, "agent");
            asm volatile("s_waitcnt vmcnt(0)" ::: "memory");
        }
    }
    __syncthreads();
}

__device__ __forceinline__ int lane_now() { int l = (int)__builtin_amdgcn_mbcnt_hi(~0u, __builtin_amdgcn_mbcnt_lo(~0u, 0u)); asm volatile("" : "+v"(l)); return l; }
namespace pg8 {
constexpr int BM = 256, BK = 64, HALF = 128, HTB = HALF * BK * 2, STAGE_BYTES = 8 * HTB, NXCD = 8, WGM = 8;
__host__ __device__ __forceinline__ int lds_byte(int r, int c) { const int st = (r >> 4) * 2 + (c >> 5), rr = r & 15, cc = c & 31, ob = rr * 64 + cc * 2; return st * 1024 + (ob ^ (((ob >> 9) & 1) << 5)); }
__host__ __device__ __forceinline__ void stage_rc(int b, int& R, int& C) { const int st = b / 1024, sb = b % 1024, swz = sb ^ (((sb >> 9) & 1) << 5); R = (st >> 1) * 16 + swz / 64; C = (st & 1) * 32 + (swz % 64) / 2; }
__host__ __device__ __forceinline__ int perm32(int rho) { const int n = rho >> 4, i = rho & 15; return 8 * (i >> 2) + 4 * n + (i & 3); }

struct Unit { const char* a; const char* b; int r0, c0, aux, r1; };
struct Gemm { int lda, ldb, K; };

struct DenseOrder {
    const char* A; const char* Bt; int lda, ldb, nM, nN, nwg, G, c;
    __device__ void init(const void* A_, const void* Bt_, int lda_, int ldb_, int M, int N, int G_, int c_) { A = (const char*)A_; Bt = (const char*)Bt_; lda = lda_; ldb = ldb_; nM = M / BM; nN = N / BM; nwg = nM * nN; G = G_; c = c_; }
    __device__ bool next(int i, Unit& u) const {
        const long L = (long)i * G + c; if (L >= nwg) return false;
        int wgid = (int)L; { const int q = nwg / NXCD, r = nwg % NXCD, xcd = wgid % NXCD, off = wgid / NXCD; wgid = (xcd < r ? xcd * (q + 1) : r * (q + 1) + (xcd - r) * q) + off; }
        const int nig = WGM * nN, gid = wgid / nig, fm = gid * WGM, gsz = (nM - fm) < WGM ? (nM - fm) : WGM;
        const int pm = fm + ((wgid % nig) % gsz), pn = (wgid % nig) / gsz;
        u.a = A + (size_t)pm * BM * lda * 2; u.b = Bt + (size_t)pn * BM * ldb * 2; u.r0 = pm * BM; u.c0 = pn * BM; u.aux = 0; u.r1 = 0; return true;
    }
    __device__ __forceinline__ unsigned arow(const Unit&, int) const { return 0u; }
};
struct GroupOrder {
    const char* A; const char* Bt; int lda, ldb, nN, ngrp, G, c;
    __device__ bool next(int i, Unit& u) const {
        const int L = i * G + c; if (L >= ngrp * 2 * nN) return false;
        const int g = L / (2 * nN), q = L % (2 * nN), pn = q >> 1, pm = q & 1;
        u.a = A + ((size_t)g * 512 + pm * BM) * lda * 2; u.b = Bt + ((size_t)g * nN + pn) * BM * ldb * 2; u.r0 = pm * BM; u.c0 = pn * BM; u.aux = g; u.r1 = 0; return true;
    }
    __device__ __forceinline__ unsigned arow(const Unit&, int) const { return 0u; }
};
struct StateOrder {
    const char* A; const char* Bt; int G, c;
    __device__ bool next(int i, Unit& u) const {
        const int L = i * G + c; if (L >= 128) return false;
        const int g = L >> 2, pm = (L >> 1) & 1, ks = L & 1;
        u.a = A + (((size_t)g * 512 + pm * BM) * S5K + ks * 256) * 2; u.b = Bt + ((size_t)g * 256 * 512 + ks * 256) * 2; u.r0 = pm * BM; u.c0 = 0; u.aux = g * 2 + ks; u.r1 = 0; return true;
    }
    __device__ __forceinline__ unsigned arow(const Unit&, int) const { return 0u; }
};
struct MoeOrder {
    const char* A; const char* Bt; const LAS int* cnt; const LAS int* ts; const int* list; int lda, ldb, nct, brows, G, c; bool gather;
    __device__ bool next(int i, Unit& u) const {
        const int L = i * G + c; const int lane = lane_now();
        int i64 = 64; asm volatile("" : "+v"(i64));
        if (L >= __builtin_amdgcn_readfirstlane(ts[i64]) * nct) return false;
        const int lo = ts[lane] * nct, hi = ts[lane + 1] * nct;
        const unsigned long long m = __ballot(lo <= L && L < hi);
        const int e = __builtin_amdgcn_readfirstlane((int)__builtin_ctzll(m));
        const int tse = ts[e], ne = ts[e + 1] - tse, q = L - tse * nct, ct = q / ne, rt = q % ne;
        u.a = gather ? A : A + (size_t)(tse + rt) * BM * lda * 2; u.b = Bt + ((size_t)e * brows + (size_t)ct * BM) * ldb * 2;
        u.r0 = (tse + rt) * BM; u.r1 = rt * BM; u.c0 = ct; u.aux = e; return true;
    }
    __device__ __forceinline__ unsigned arow(const Unit& u, int r) const {
        const int n = cnt[u.aux]; int rr = u.r1 + r; rr = rr < n ? rr : n - 1;
        return (unsigned)(list[(size_t)u.aux * LCAP + rr] >> 1) * (unsigned)(lda * 2);
    }
};

#define EPI_ROWS_COLS() const int rowb = wr * 64 + fr; (void)rowb;

template <class Epi, class Sched, bool GATHER = false, bool FP8 = false, bool KSEG = false>
__device__ __forceinline__ void gemm_phase(LAS unsigned char* lds, const Gemm g, const Sched& S, const Epi& E, const int wave_id, const float* ssq = nullptr) {
    int lane = (int)__builtin_amdgcn_mbcnt_hi(~0u, __builtin_amdgcn_mbcnt_lo(~0u, 0u)); asm volatile("" : "+v"(lane));
    const int wid = wave_id, tid = wid * 64 + lane, wr = wid >> 2, wc = wid & 3, fr = lane & 15, fq = lane >> 4;
    const int K = g.K; int nt = K / BK; asm volatile("" : "+s"(nt));
    unsigned voffB;
    { int R, C; stage_rc(tid * 16, R, C); const int Rb = Epi::PERM ? ((R & ~31) + perm32(R & 31)) : R; voffB = (unsigned)(Rb * g.ldb + C) * 2u; }
    const int soffB = 64 * g.ldb * 2, soffA = 64 * g.lda * 2;
#define PG8_RC(i, R, C) int R, C; { int _t = tid; asm volatile("" : "+v"(_t)); stage_rc(_t * 16 + (i) * 8192, R, C); }
#define nxoff ((LAS v4u*)(lds + 131072) + (wid * 64 + lane_now()))
    const size_t kstep = (size_t)(BK * 2);
    const size_t hstepB = (size_t)HALF * g.ldb * 2;
    const unsigned ldsw = (unsigned)wid * 1024u;
    const int aoff = lds_byte(wr * 64 + fr, fq * 8), boff = lds_byte(wc * 32 + fr, fq * 8);
#define PG8_SA(b, h) (((b) * 2 + (h)) * HTB)
#define PG8_SB(b, h) ((4 + (b) * 2 + (h)) * HTB)
#define PG8_RSRC(p) __builtin_amdgcn_make_buffer_rsrc((void*)(p), 0, 0xffffffff, 0x00020000)
#define PG8_DMA(gbase, vo, so, ldsp) do { if constexpr (FP8) { __builtin_amdgcn_raw_ptr_buffer_load_lds(PG8_RSRC(gbase), (LAS void*)(ldsp), 16, (int)(vo), (so), 0, 0); } \
        else { __builtin_amdgcn_global_load_lds((const unsigned*)((const char*)(gbase) + (so) + (vo)), (LAS unsigned*)(ldsp), 16, 0, 0); } } while (0)
#define PG8_STAGE(bufoff, gbase, voff) do { PG8_DMA(gbase, voff, 0, lds + (bufoff) + ldsw); PG8_DMA(gbase, voff, soffB, lds + (bufoff) + ldsw + 8192); } while (0)
#define PG8_STAGEA(bufoff, gbase, o0, o1, h) do { \
        if constexpr (GATHER) { PG8_DMA(gbase, o0, 0, lds + (bufoff) + ldsw); PG8_DMA(gbase, o1, 0, lds + (bufoff) + ldsw + 8192); } \
        else { PG8_DMA(gbase, c00, (h) * 2 * soffA, lds + (bufoff) + ldsw); PG8_DMA(gbase, c00, (h) * 2 * soffA + soffA, lds + (bufoff) + ldsw + 8192); } } while (0)
#define PG8_LDA(dst, b, h) do { _Pragma("unroll") for (int m = 0; m < 4; ++m) { \
        if constexpr (FP8) { dst##8[m].lo = *(const LAS v4i_*)(lds + PG8_SA(b, h) + aoff + m * 2048); dst##8[m].hi = *(const LAS v4i_*)(lds + PG8_SA(b, h) + aoff + m * 2048 + 1024); } \
        else { _Pragma("unroll") for (int k = 0; k < 2; ++k) dst[m][k] = *(const LAS bf16x8*)(lds + PG8_SA(b, h) + aoff + m * 2048 + k * 1024); } } } while (0)
#define PG8_LDB(dst, b, h) do { _Pragma("unroll") for (int n = 0; n < 2; ++n) { \
        if constexpr (FP8) { dst##8[n].lo = *(const LAS v4i_*)(lds + PG8_SB(b, h) + boff + n * 2048); dst##8[n].hi = *(const LAS v4i_*)(lds + PG8_SB(b, h) + boff + n * 2048 + 1024); } \
        else { _Pragma("unroll") for (int k = 0; k < 2; ++k) dst[n][k] = *(const LAS bf16x8*)(lds + PG8_SB(b, h) + boff + n * 2048 + k * 1024); } } } while (0)
#define PG8_MMA(ai, bj, At, Bt) do { __builtin_amdgcn_s_setprio(1); _Pragma("unroll") for (int m = 0; m < 4; ++m) _Pragma("unroll") for (int n = 0; n < 2; ++n) { \
        if constexpr (FP8) { acc[ai][bj][m][n] = __builtin_amdgcn_mfma_scale_f32_16x16x128_f8f6f4(Bt##8[n], At##8[m], acc[ai][bj][m][n], 0, 0, 0, 0x7f7f7f7f, 0, 0x7f7f7f7f); } \
        else { _Pragma("unroll") for (int k = 0; k < 2; ++k) acc[ai][bj][m][n] = __builtin_amdgcn_mfma_f32_16x16x32_bf16(Bt[n][k], At[m][k], acc[ai][bj][m][n], 0, 0, 0); } } \
        __builtin_amdgcn_s_setprio(0); } while (0)
#define PG8_WAIT_V(n) asm volatile("s_waitcnt vmcnt(" #n ")" ::: "memory")
#define PG8_WAIT_L(n) asm volatile("s_waitcnt lgkmcnt(" #n ")" ::: "memory")
#define PG8_BAR __builtin_amdgcn_s_barrier()
#define PG8_SCHED __builtin_amdgcn_sched_barrier(0)
    LAS f32x4* scl = (LAS f32x4*)(lds + 131072);
#define PG8_FILL_SCL(u) do { if constexpr (KSEG) { if (tid < 256) { const f32x4* sp = (const f32x4*)(ssq + (size_t)((u).r0 + tid) * 32); \
        const f32x4 p0 = sp[0], p1 = sp[1], p2 = sp[2], p3 = sp[3], p4 = sp[4], p5 = sp[5], p6 = sp[6]; \
        const float sa = (((p0[0] + p0[1]) + (p0[2] + p0[3])) + ((p1[0] + p1[1]) + (p1[2] + p1[3]))) + (((p2[0] + p2[1]) + (p2[2] + p2[3])) + ((p3[0] + p3[1]) + (p3[2] + p3[3]))); \
        const float sb = ((p4[0] + p4[1]) + (p4[2] + p4[3])) + ((p5[0] + p5[1]) + (p5[2] + p5[3])), sc = (p6[0] + p6[1]) + (p6[2] + p6[3]); \
        const float ra = 1.0f / sqrtf(sa * (1.f / 1024.f) + EPS), rb = 1.0f / sqrtf(sb * (1.f / 512.f) + EPS), rc = 1.0f / sqrtf(sc * (1.f / 512.f) + EPS); \
        scl[(ui & 1) * 256 + tid] = (f32x4){ra / rb, rb / rc, rc, 0.f}; } } } while (0)
#define PG8_SCALE(k) do { _Pragma("unroll") for (int _ai = 0; _ai < 2; ++_ai) _Pragma("unroll") for (int _m = 0; _m < 4; ++_m) { const float _f = ((const LAS float*)scl)[((ui & 1) * 256 + _ai * HALF + wr * 64 + _m * 16 + fr) * 4 + (k)]; \
        _Pragma("unroll") for (int _bj = 0; _bj < 2; ++_bj) _Pragma("unroll") for (int _n = 0; _n < 2; ++_n) acc[_ai][_bj][_m][_n] = acc[_ai][_bj][_m][_n] * _f; } } while (0)
    Unit cur, nxt; int ui = 0;
    if (!S.next(0, cur)) return;
    PG8_FILL_SCL(cur);
    f32x4 acc[2][2][4][2];
#pragma unroll
    for (int a = 0; a < 2; ++a)
#pragma unroll
        for (int b = 0; b < 2; ++b)
#pragma unroll
            for (int m = 0; m < 4; ++m)
#pragma unroll
                for (int n = 0; n < 2; ++n) acc[a][b][m][n] = (f32x4){0.f, 0.f, 0.f, 0.f};
    bf16x8 At[4][2], B0[2][2], B1[2][2]; v8i At8[4], B08[2], B18[2];
    const char* cA = cur.a; const char* cB = cur.b;
    unsigned c00, c01, c10, c11;
    { PG8_RC(0, R0, C0); PG8_RC(1, R1, C1);
      if constexpr (GATHER) {
        c00 = S.arow(cur, R0) + C0 * 2u; c01 = S.arow(cur, R1) + C1 * 2u; c10 = S.arow(cur, HALF + R0) + C0 * 2u; c11 = S.arow(cur, HALF + R1) + C1 * 2u;
        asm volatile("s_waitcnt vmcnt(0)" : "+v"(c00), "+v"(c01), "+v"(c10), "+v"(c11) :: "memory");
      } else {
        c00 = (unsigned)(R0 * g.lda + C0) * 2u; c01 = c00; c10 = c00; c11 = c00; (void)R1; (void)C1;
      } }
    PG8_STAGE(PG8_SB(0, 0), cB, voffB); PG8_STAGE(PG8_SB(0, 1), cB + hstepB, voffB); PG8_STAGEA(PG8_SA(0, 0), cA, c00, c01, 0); PG8_STAGEA(PG8_SA(0, 1), cA, c10, c11, 1);
    if (wr == 1) PG8_BAR;
    PG8_WAIT_V(2); PG8_BAR;
    PG8_STAGE(PG8_SB(1, 0), cB + kstep, voffB); PG8_STAGEA(PG8_SA(1, 0), cA + kstep, c00, c01, 0); PG8_STAGE(PG8_SB(1, 1), cB + hstepB + kstep, voffB);
    PG8_WAIT_V(6); PG8_BAR;
#define PG8_KITER(t) do { \
            const bool last = (t == nt - 2); \
            const char* a1 = cA + (size_t)(t + 1) * kstep; \
            const char* a2 = last ? nA : cA + (size_t)(t + 2) * kstep; const char* b2 = last ? nB : cB + (size_t)(t + 2) * kstep; \
            const char* a3 = a2 + kstep; const char* b3 = b2 + kstep; \
            unsigned x00 = c00, x01 = c01, x10 = c10, x11 = c11; \
            if constexpr (GATHER) { if (last) { const v4u nv = *nxoff; x00 = nv.x; x01 = nv.y; x10 = nv.z; x11 = nv.w; } } \
 \
            PG8_LDB(B0, 0, 0); PG8_LDB(B1, 0, 1); PG8_SCHED; PG8_LDA(At, 0, 0); PG8_STAGEA(PG8_SA(1, 1), a1, c10, c11, 1); \
            PG8_WAIT_V(8); PG8_WAIT_L(0); PG8_BAR; PG8_MMA(0, 0, At, B0); PG8_MMA(0, 1, At, B1); PG8_BAR; PG8_SCHED; \
 \
            PG8_LDA(At, 0, 1); PG8_STAGE(PG8_SB(0, 0), b2, voffB); PG8_STAGE(PG8_SB(0, 1), b2 + hstepB, voffB); PG8_STAGEA(PG8_SA(0, 0), a2, x00, x01, 0); \
            PG8_WAIT_V(8); PG8_WAIT_L(0); PG8_BAR; PG8_MMA(1, 0, At, B0); PG8_MMA(1, 1, At, B1); PG8_BAR; PG8_SCHED; \
 \
            PG8_LDB(B0, 1, 0); PG8_LDB(B1, 1, 1); PG8_SCHED; PG8_LDA(At, 1, 0); PG8_STAGEA(PG8_SA(0, 1), a2, x10, x11, 1); \
            PG8_WAIT_V(8); PG8_WAIT_L(0); PG8_BAR; PG8_MMA(0, 0, At, B0); PG8_MMA(0, 1, At, B1); PG8_BAR; PG8_SCHED; \
 \
            PG8_LDA(At, 1, 1); PG8_STAGE(PG8_SB(1, 0), b3, voffB); PG8_STAGE(PG8_SB(1, 1), b3 + hstepB, voffB); PG8_STAGEA(PG8_SA(1, 0), a3, x00, x01, 0); \
            PG8_WAIT_V(8); PG8_WAIT_L(0); PG8_BAR; PG8_MMA(1, 0, At, B0); PG8_MMA(1, 1, At, B1); PG8_BAR; PG8_SCHED; \
        } while (0)
    for (;;) {
        const bool has_next = S.next(ui + 1, nxt);
        const char* nA = has_next ? nxt.a : cA; const char* nB = has_next ? nxt.b : cB;
        if constexpr (GATHER) {
            unsigned n00 = c00, n01 = c01, n10 = c10, n11 = c11;
            if (has_next) { PG8_RC(0, R0, C0); PG8_RC(1, R1, C1); n00 = S.arow(nxt, R0) + C0 * 2u; n01 = S.arow(nxt, R1) + C1 * 2u; n10 = S.arow(nxt, HALF + R0) + C0 * 2u; n11 = S.arow(nxt, HALF + R1) + C1 * 2u; }
            asm volatile("s_waitcnt vmcnt(0)" : "+v"(n00), "+v"(n01), "+v"(n10), "+v"(n11) :: "memory");
            v4u nv; nv.x = n00; nv.y = n01; nv.z = n10; nv.w = n11; *nxoff = nv;
        }
        if constexpr (KSEG) {
#pragma unroll 1
            for (int t = 0; t < 16; t += 2) PG8_KITER(t);
            PG8_SCALE(0);
#pragma unroll 1
            for (int t = 16; t < 24; t += 2) PG8_KITER(t);
            PG8_SCALE(1);
#pragma unroll 1
            for (int t = 24; t < nt; t += 2) PG8_KITER(t);
        } else {
#pragma unroll 1
            for (int t = 0; t < nt; t += 2) PG8_KITER(t);
        }
        if (wr == 0) PG8_BAR;
        if constexpr (KSEG) PG8_SCALE(2);
        { const int le = lane_now(); E(acc, cur, wr, wc, le & 15, le >> 4); }
        if (!has_next) break;
#pragma unroll
        for (int a = 0; a < 2; ++a)
#pragma unroll
            for (int b = 0; b < 2; ++b)
#pragma unroll
                for (int m = 0; m < 4; ++m)
#pragma unroll
                    for (int n = 0; n < 2; ++n) acc[a][b][m][n] = (f32x4){0.f, 0.f, 0.f, 0.f};
        cur = nxt; cA = nA; cB = nB; ++ui;
        if constexpr (KSEG) { PG8_WAIT_L(0); PG8_FILL_SCL(cur); }
        if constexpr (GATHER) { const v4u nv = *nxoff; c00 = nv.x; c01 = nv.y; c10 = nv.z; c11 = nv.w; }
        if (wr == 1) PG8_BAR;
    }
    PG8_WAIT_V(0);
    PG8_BAR;
#undef PG8_RC
#undef PG8_KITER
#undef PG8_FILL_SCL
#undef PG8_SCALE
#undef nxoff
#undef PG8_SA
#undef PG8_SB
#undef PG8_STAGE
#undef PG8_STAGEA
#undef PG8_DMA
#undef PG8_RSRC
#undef PG8_LDA
#undef PG8_LDB
#undef PG8_MMA
#undef PG8_WAIT_V
#undef PG8_WAIT_L
#undef PG8_BAR
#undef PG8_SCHED
}

typedef const f32x4 (&AccRef)[2][2][4][2];
__device__ __forceinline__ v4u pack8(const f32x4 a, const f32x4 b) { v4u w; w.x = pk2(a[0], a[1]); w.y = pk2(a[2], a[3]); w.z = pk2(b[0], b[1]); w.w = pk2(b[2], b[3]); return w; }

struct EpiProj {
    static constexpr bool PERM = true;
    bf16* PROJ; bf16* UA;
    __device__ __forceinline__ void operator()(AccRef acc, const Unit& u, int wr, int wc, int fr, int fq) const {
        const int row0 = u.r0 + wr * 64 + fr, colb = u.c0 + wc * 32 + 8 * fq;
        const bool isu = (u.c0 == 1280 || u.c0 == 1536);
#pragma unroll
        for (int ai = 0; ai < 2; ++ai)
#pragma unroll
            for (int m = 0; m < 4; ++m) { const int row = row0 + ai * HALF + m * 16;
#pragma unroll
                for (int bj = 0; bj < 2; ++bj) { const int col = colb + bj * HALF; const v4u w = pack8(acc[ai][bj][m][0], acc[ai][bj][m][1]);
                    if (!isu) *(v4u*)(PROJ + (size_t)row * INC + col) = w;
                    else { const int cc = col - 1280, g = cc >> 4, c0 = cc & 15; *(v4u*)(UA + ((size_t)(g * 512 + (row >> 5)) * S5K + (row & 31) * 16 + c0)) = w; } } }
    }
};
struct EpiBf16 {
    static constexpr bool PERM = true;
    bf16* O; int ldc;
    __device__ __forceinline__ void operator()(AccRef acc, const Unit& u, int wr, int wc, int fr, int fq) const {
        const int row0 = u.r0 + wr * 64 + fr, colb = u.c0 + wc * 32 + 8 * fq;
#pragma unroll
        for (int ai = 0; ai < 2; ++ai)
#pragma unroll
            for (int m = 0; m < 4; ++m) { bf16* rowp = O + (size_t)(row0 + ai * HALF + m * 16) * ldc + colb;
#pragma unroll
                for (int bj = 0; bj < 2; ++bj) *(v4u*)(rowp + bj * HALF) = pack8(acc[ai][bj][m][0], acc[ai][bj][m][1]); }
    }
};
struct EpiF32 {
    static constexpr bool PERM = false;
    float* C; int ldc; size_t gstride;
    __device__ __forceinline__ void operator()(AccRef acc, const Unit& u, int wr, int wc, int fr, int fq) const {
        const int row0 = u.r0 + wr * 64 + fr, col0 = u.c0 + wc * 32 + 4 * fq; float* base = C + (size_t)u.aux * gstride;
#pragma unroll
        for (int ai = 0; ai < 2; ++ai)
#pragma unroll
            for (int m = 0; m < 4; ++m) { float* rowp = base + (size_t)(row0 + ai * HALF + m * 16) * ldc + col0;
#pragma unroll
                for (int bj = 0; bj < 2; ++bj)
#pragma unroll
                    for (int n = 0; n < 2; ++n) *(f32x4*)(rowp + bj * HALF + n * 16) = acc[ai][bj][m][n]; }
    }
};
struct EpiS5Y {
    static constexpr bool PERM = true;
    const bf16* UA; const float* dsk; bf16* Gm;
    __device__ __forceinline__ void operator()(AccRef acc, const Unit& u, int wr, int wc, int fr, int fq) const {
        const int row0 = u.r0 + wr * 64 + fr, colb = u.c0 + wc * 32 + 8 * fq, g = u.aux;
#pragma unroll
        for (int ai = 0; ai < 2; ++ai)
#pragma unroll
            for (int m = 0; m < 4; ++m) { const int row = row0 + ai * HALF + m * 16;
#pragma unroll
                for (int bj = 0; bj < 2; ++bj) { const int col = colb + bj * HALF, i = col >> 4, c0 = col & 15;
                    const v4u uw = *(const v4u*)(UA + ((size_t)(g * 512 + row) * S5K + col));
                    const f32x4 d0 = *(const f32x4*)(dsk + g * 16 + c0), d1 = *(const f32x4*)(dsk + g * 16 + c0 + 4);
                    const f32x4 a0 = acc[ai][bj][m][0], a1 = acc[ai][bj][m][1];
                    f32x4 y0, y1;
                    y0[0] = gelu_tanh(a0[0] + d0[0] * bflo(uw.x)); y0[1] = gelu_tanh(a0[1] + d0[1] * bfhi(uw.x)); y0[2] = gelu_tanh(a0[2] + d0[2] * bflo(uw.y)); y0[3] = gelu_tanh(a0[3] + d0[3] * bfhi(uw.y));
                    y1[0] = gelu_tanh(a1[0] + d1[0] * bflo(uw.z)); y1[1] = gelu_tanh(a1[1] + d1[1] * bfhi(uw.z)); y1[2] = gelu_tanh(a1[2] + d1[2] * bflo(uw.w)); y1[3] = gelu_tanh(a1[3] + d1[3] * bfhi(uw.w));
                    *(v4u*)(Gm + ((size_t)row * 32 + i) * 512 + g * 16 + c0) = pack8(y0, y1); } }
    }
};
struct EpiGlu {
    static constexpr bool PERM = true;
    const bf16* Gm; bf16* MIX; float* SS;
    __device__ __forceinline__ void operator()(AccRef acc, const Unit& u, int wr, int wc, int fr, int fq) const {
        const int row0 = u.r0 + wr * 64 + fr, colb = u.c0 + wc * 32 + 8 * fq;
#pragma unroll
        for (int ai = 0; ai < 2; ++ai)
#pragma unroll
            for (int m = 0; m < 4; ++m) { const int row = row0 + ai * HALF + m * 16; float ss = 0.f;
#pragma unroll
                for (int bj = 0; bj < 2; ++bj) { const int col = colb + bj * HALF;
                    const v4u gw = *(const v4u*)(Gm + (size_t)row * 512 + col);
                    const f32x4 a0 = acc[ai][bj][m][0], a1 = acc[ai][bj][m][1];
                    f32x4 y0, y1;
                    y0[0] = bflo(gw.x) * sigmoidf_(a0[0]); y0[1] = bfhi(gw.x) * sigmoidf_(a0[1]); y0[2] = bflo(gw.y) * sigmoidf_(a0[2]); y0[3] = bfhi(gw.y) * sigmoidf_(a0[3]);
                    y1[0] = bflo(gw.z) * sigmoidf_(a1[0]); y1[1] = bfhi(gw.z) * sigmoidf_(a1[1]); y1[2] = bflo(gw.w) * sigmoidf_(a1[2]); y1[3] = bfhi(gw.w) * sigmoidf_(a1[3]);
                    ss += ((y0[0] * y0[0] + y0[1] * y0[1]) + (y0[2] * y0[2] + y0[3] * y0[3])) + ((y1[0] * y1[0] + y1[1] * y1[1]) + (y1[2] * y1[2] + y1[3] * y1[3]));
                    *(v4u*)(MIX + (size_t)row * D + 1024 + col) = pack8(y0, y1); }
                ss += __shfl_xor(ss, 16); ss += __shfl_xor(ss, 32);
                if (fq == 0) SS[(size_t)row * 32 + 16 + (u.c0 >> 8) * 4 + wc] = ss; }
    }
};
struct EpiWo {
    static constexpr bool PERM = true;
    const float* rinv; bf16* X1B; unsigned char* X18; float* part;
    __device__ __forceinline__ void operator()(AccRef acc, const Unit& u, int wr, int wc, int fr, int fq) const {
        const int row0 = u.r0 + wr * 64 + fr, col0 = u.c0 + wc * 32 + 8 * fq;
#pragma unroll
        for (int ai = 0; ai < 2; ++ai) {
            v4u xw[4][2]; float ri[4];
#pragma unroll
            for (int m = 0; m < 4; ++m) { const int row = row0 + ai * HALF + m * 16; ri[m] = rinv[row];
#pragma unroll
                for (int bj = 0; bj < 2; ++bj) xw[m][bj] = *(const v4u*)(X1B + (size_t)row * D + col0 + bj * HALF); }
#pragma unroll
            for (int m = 0; m < 4; ++m) { const int row = row0 + ai * HALF + m * 16; const size_t off = (size_t)row * D + col0; float ss = 0.f;
#pragma unroll
                for (int bj = 0; bj < 2; ++bj) { const v4u x = xw[m][bj]; const float r = ri[m];
                    f32x4 v0, v1;
                    v0[0] = bflo(x.x) * r + acc[ai][bj][m][0][0]; v0[1] = bfhi(x.x) * r + acc[ai][bj][m][0][1]; v0[2] = bflo(x.y) * r + acc[ai][bj][m][0][2]; v0[3] = bfhi(x.y) * r + acc[ai][bj][m][0][3];
                    v1[0] = bflo(x.z) * r + acc[ai][bj][m][1][0]; v1[1] = bfhi(x.z) * r + acc[ai][bj][m][1][1]; v1[2] = bflo(x.w) * r + acc[ai][bj][m][1][2]; v1[3] = bfhi(x.w) * r + acc[ai][bj][m][1][3];
                    ss += ((v0[0] * v0[0] + v0[1] * v0[1]) + (v0[2] * v0[2] + v0[3] * v0[3])) + ((v1[0] * v1[0] + v1[1] * v1[1]) + (v1[2] * v1[2] + v1[3] * v1[3]));
                    *(v4u*)(X1B + off + bj * HALF) = pack8(v0, v1);
                    v2u w8; w8.x = pk4_fp8(v0[0] * SC_X, v0[1] * SC_X, v0[2] * SC_X, v0[3] * SC_X); w8.y = pk4_fp8(v1[0] * SC_X, v1[1] * SC_X, v1[2] * SC_X, v1[3] * SC_X);
                    *(v2u*)(X18 + off + bj * HALF) = w8; }
                ss += __shfl_xor(ss, 16); ss += __shfl_xor(ss, 32);
                if (fq == 0) part[(size_t)row * 32 + (u.c0 >> 8) * 4 + wc] = ss; }
            asm volatile("" ::: "memory");
        }
    }
};
struct EpiLogit {
    static constexpr bool PERM = false;
    float* LP;
    __device__ __forceinline__ void operator()(AccRef acc, const Unit& u, int wr, int wc, int fr, int fq) const {
        const int row0 = u.r0 + wr * 64 + fr, col0 = wc * 32 + 4 * fq; float* base = LP + (size_t)u.aux * T * 80;
#pragma unroll
        for (int ai = 0; ai < 2; ++ai)
#pragma unroll
            for (int m = 0; m < 4; ++m) { float* rowp = base + (size_t)(row0 + ai * HALF + m * 16) * 80 + col0;
#pragma unroll
                for (int n = 0; n < 2; ++n) if (col0 + n * 16 < 80) *(f32x4*)(rowp + n * 16) = acc[ai][0][m][n]; }
    }
};
struct EpiGU {
    static constexpr bool PERM = true;
    const int* list; const float* rstd; const LAS int* cnt; unsigned char* ACT;
    __device__ __forceinline__ void operator()(AccRef acc, const Unit& u, int wr, int wc, int fr, int fq) const {
        const int e = u.aux, nreal = cnt[e], rb = wr * 64 + fr, colb = u.c0 * 128 + wc * 32 + 8 * fq;
#pragma unroll
        for (int ai = 0; ai < 2; ++ai)
#pragma unroll
            for (int m = 0; m < 4; ++m) { const int r = rb + ai * HALF + m * 16; int rr = u.r1 + r; rr = rr < nreal ? rr : nreal - 1;
                const float rs = rstd[(size_t)e * LCAP + rr] * (1.0f / (SC_X * SC_WGU));
                f32x4 y0, y1;
#pragma unroll
                for (int j = 0; j < 4; ++j) { const float g0 = acc[ai][0][m][0][j] * rs, g1 = acc[ai][0][m][1][j] * rs;
                    y0[j] = g0 * sigmoidf_(g0) * (acc[ai][1][m][0][j] * rs) * SC_ACT; y1[j] = g1 * sigmoidf_(g1) * (acc[ai][1][m][1][j] * rs) * SC_ACT; }
                v2u w8; w8.x = pk4_fp8(y0[0], y0[1], y0[2], y0[3]); w8.y = pk4_fp8(y1[0], y1[1], y1[2], y1[3]);
                *(v2u*)(ACT + (size_t)(u.r0 + r) * DEXP + colb) = w8; }
    }
};
struct EpiDown {
    static constexpr bool PERM = true;
    const int* list; const float* wts; const LAS int* cnt; unsigned char* Y2;
    __device__ __forceinline__ void operator()(AccRef acc, const Unit& u, int wr, int wc, int fr, int fq) const {
        const int e = u.aux, n = cnt[e], row0 = u.r1 + wr * 64 + fr, colb = u.c0 * 256 + wc * 32 + 8 * fq;
#pragma unroll
        for (int ai = 0; ai < 2; ++ai)
#pragma unroll
            for (int m = 0; m < 4; ++m) { const int r = row0 + ai * HALF + m * 16;
                if (r < n) { const int ent = list[(size_t)e * LCAP + r]; const float w = wts[(size_t)e * LCAP + r] * (SC_Y / (SC_ACT * SC_WD));   unsigned char* rowp = Y2 + (size_t)ent * D + colb;
#pragma unroll
                    for (int bj = 0; bj < 2; ++bj) { const f32x4 a0 = acc[ai][bj][m][0] * w, a1 = acc[ai][bj][m][1] * w; v2u w8; w8.x = pk4_fp8(a0[0], a0[1], a0[2], a0[3]); w8.y = pk4_fp8(a1[0], a1[1], a1[2], a1[3]);
                        *(v2u*)(rowp + bj * HALF) = w8; } } }
    }
};
struct KSplitOrder {
    const char* A; const char* Bt; int lda, ldb, K, nM, nks, G, c;
    __device__ bool next(int i, Unit& u) const {
        const int L = i * G + c; if (L >= nM * nks) return false;
        const int pm = L / nks, ks = L % nks;
        u.a = A + ((size_t)pm * BM * lda + (size_t)ks * K) * 2; u.b = Bt + (size_t)ks * BM * ldb * 2; u.r0 = pm * BM; u.c0 = 0; u.aux = ks; u.r1 = 0; return true;
    }
    __device__ __forceinline__ unsigned arow(const Unit&, int) const { return 0u; }
};
}

struct Frame {
    LAS unsigned char* lds;
    unsigned* ctl;
    int tid, lane, wave, vcu, G;
    const float* const __attribute__((address_space(4)))* in;
    float* out; unsigned char* ws;
};
enum { I_X = 0, I_MEM, I_NORM_MIX, I_W_IN, I_Q_NORM, I_K_NORM, I_SINKS, I_REL_BIAS, I_LAM_RE, I_LAM_IM, I_LOG_DT, I_B_RE, I_B_IM, I_C_RE, I_C_IM, I_SSM_D, I_W_GLU,
       I_MEM_NORM, I_W_MEM_KV, I_XQ_NORM, I_XK_NORM, I_ON_ATTN, I_ON_SSM, I_ON_X, I_W_O, I_NORM_FFN, I_WR_G, I_WR_E, I_W_GATE, I_W_UP, I_W_DOWN };

struct TrItem { const float* W; bf16* WT; const float* ks; int ldw, ldt, k0, n0, drow0; };
__device__ __forceinline__ void tr_load(const TrItem& it, f32x4 (&v)[8], int lane) {
    const int kc = lane & 7, nq = lane >> 3; const float* src = it.W + (size_t)(it.k0 + kc * 8) * it.ldw + it.n0 + nq * 4;
#pragma unroll
    for (int j = 0; j < 8; ++j) v[j] = __builtin_nontemporal_load((const f32x4*)(src + (size_t)j * it.ldw));
}
__device__ __forceinline__ void tr_store(const TrItem& it, f32x4 (&v)[8], int lane) {
    const int kc = lane & 7, nq = lane >> 3;
    if (it.ks) { const f32x4 s0 = *(const f32x4*)(it.ks + it.k0 + kc * 8), s1 = *(const f32x4*)(it.ks + it.k0 + kc * 8 + 4);
#pragma unroll
        for (int j = 0; j < 4; ++j) { v[j] = v[j] * s0[j]; v[4 + j] = v[4 + j] * s1[j]; } }
#pragma unroll
    for (int i = 0; i < 4; ++i) { v4u o; o.x = pk2(v[0][i], v[1][i]); o.y = pk2(v[2][i], v[3][i]); o.z = pk2(v[4][i], v[5][i]); o.w = pk2(v[6][i], v[7][i]);
        *(v4u*)(it.WT + (size_t)(it.drow0 + nq * 4 + i) * it.ldt + it.k0 + kc * 8) = o; }
}
__device__ __forceinline__ void rms_row_to_bf16(const float* xrow, const float* gain, bf16* orow, int lane, float* rinv = nullptr) {
    const f32x4* xr = (const f32x4*)xrow + lane; const f32x4* gr = (const f32x4*)gain + lane;
    f32x4 v[8]; float s = 0.f;
#pragma unroll
    for (int j = 0; j < 8; ++j) { v[j] = xr[64 * j]; s += (v[j].x * v[j].x + v[j].y * v[j].y) + (v[j].z * v[j].z + v[j].w * v[j].w); }
    const float ms = wave_sum(s) * (1.f / 2048.f) + EPS; const float rstd = 1.0f / sqrtf(ms);
    if (rinv && lane == 0) *rinv = sqrtf(ms);
    v2u* o8 = (v2u*)orow + lane;
#pragma unroll
    for (int j = 0; j < 8; ++j) { const f32x4 g = gain ? gr[64 * j] : (f32x4){1.f, 1.f, 1.f, 1.f}; v2u w; w.x = pk2(v[j].x * rstd * g.x, v[j].y * rstd * g.y); w.y = pk2(v[j].z * rstd * g.z, v[j].w * rstd * g.w); o8[64 * j] = w; }
}

__device__ __forceinline__ void s5_tables(Frame& F, int g) {
    LAS float* ap = (LAS float*)F.lds;
    LAS float* Bb = ap + 33 * 64 * 2;
    LAS float* Cc = Bb + 64 * 16 * 2;
    LAS float* Km = Cc + 16 * 64 * 2;
    const float dt = expf(F.in[I_LOG_DT][g]);
    const float* lre = F.in[I_LAM_RE] + g * 64; const float* lim = F.in[I_LAM_IM] + g * 64;
    for (int idx = F.tid; idx < 33 * 64; idx += 512) { const int tau = idx >> 6, n = idx & 63; const float lr = lre[n], li = lim[n];
        const float mag = expf((float)tau * (lr * dt)), ang = (float)tau * (li * dt); ap[idx * 2] = mag * cosf(ang); ap[idx * 2 + 1] = mag * sinf(ang); }
    __syncthreads();
    for (int idx = F.tid; idx < 64 * 16; idx += 512) { const int n = idx >> 4; const float lr = lre[n], li = lim[n];
        const float nr = ap[(64 + n) * 2] - 1.0f, ni = ap[(64 + n) * 2 + 1], den = lr * lr + li * li;
        const float cr = (nr * lr + ni * li) / den, ci = (ni * lr - nr * li) / den;
        const float br = F.in[I_B_RE][(size_t)g * 1024 + idx], bi = F.in[I_B_IM][(size_t)g * 1024 + idx];
        Bb[idx * 2] = cr * br - ci * bi; Bb[idx * 2 + 1] = cr * bi + ci * br; }
    for (int idx = F.tid; idx < 16 * 64; idx += 512) { Cc[idx * 2] = F.in[I_C_RE][(size_t)g * 1024 + idx]; Cc[idx * 2 + 1] = F.in[I_C_IM][(size_t)g * 1024 + idx]; }
    __syncthreads();
    for (int idx = F.tid; idx < 32 * 256; idx += 512) { const int tau = idx >> 8, c = (idx >> 4) & 15, c2 = idx & 15; float s = 0.f;
        for (int n = 0; n < 64; ++n) { const float ar = ap[(tau * 64 + n) * 2], ai = ap[(tau * 64 + n) * 2 + 1], cr = Cc[(c * 64 + n) * 2], ci = Cc[(c * 64 + n) * 2 + 1];
            const float er = cr * ar - ci * ai, ei = cr * ai + ci * ar; s += er * Bb[(n * 16 + c2) * 2] - ei * Bb[(n * 16 + c2) * 2 + 1]; }
        Km[idx] = s; }
    __syncthreads();
    bf16* MQ = (bf16*)(F.ws + WS_MQ) + (size_t)g * 512 * S5K;
    for (int idx = F.tid; idx < 512 * 80; idx += 512) { const int row = idx / 80, ch = idx % 80, i = row >> 4, c = row & 15, k0 = ch * 8; float v[8];
        if (k0 < 512) { const int s = k0 >> 4, c20 = k0 & 15, tau = i - s;
#pragma unroll
            for (int j = 0; j < 8; ++j) v[j] = tau >= 0 ? Km[(tau * 16 + c) * 16 + c20 + j] : 0.f;
        } else { const int kk = k0 - 512, ri = kk >> 6, n0 = kk & 63;
#pragma unroll
            for (int j = 0; j < 8; ++j) { const int n = n0 + j; const float ar = ap[((i + 1) * 64 + n) * 2], ai = ap[((i + 1) * 64 + n) * 2 + 1], cr = Cc[(c * 64 + n) * 2], ci = Cc[(c * 64 + n) * 2 + 1];
                v[j] = ri == 0 ? (cr * ar - ci * ai) : -(cr * ai + ci * ar); } }
        v4u o; o.x = pk2(v[0], v[1]); o.y = pk2(v[2], v[3]); o.z = pk2(v[4], v[5]); o.w = pk2(v[6], v[7]);
        *(v4u*)(MQ + (size_t)row * S5K + k0) = o; }
    bf16* SP = (bf16*)(F.ws + WS_SP) + (size_t)g * 256 * 512;
    for (int idx = F.tid; idx < 256 * 64; idx += 512) { const int row = idx >> 6, k0 = (idx & 63) * 8; float v[8];
        if (row < 128) { const int ri = row >> 6, n = row & 63, s = k0 >> 4, c20 = k0 & 15; const float ar = ap[((31 - s) * 64 + n) * 2], ai = ap[((31 - s) * 64 + n) * 2 + 1];
#pragma unroll
            for (int j = 0; j < 8; ++j) { const float br = Bb[(n * 16 + c20 + j) * 2], bi = Bb[(n * 16 + c20 + j) * 2 + 1]; v[j] = ri == 0 ? (ar * br - ai * bi) : (ar * bi + ai * br); }
        } else {
#pragma unroll
            for (int j = 0; j < 8; ++j) v[j] = 0.f; }
        v4u o; o.x = pk2(v[0], v[1]); o.y = pk2(v[2], v[3]); o.z = pk2(v[4], v[5]); o.w = pk2(v[6], v[7]);
        *(v4u*)(SP + (size_t)row * 512 + k0) = o; }
    float* AL = (float*)(F.ws + WS_AL) + g * 128;
    if (F.tid < 64) { AL[F.tid * 2] = ap[(32 * 64 + F.tid) * 2]; AL[F.tid * 2 + 1] = ap[(32 * 64 + F.tid) * 2 + 1]; }
    __syncthreads();
}

struct BigTile { const float* src; unsigned char* dst; const float* ks; float sc; int ldw, ldt; };
constexpr int BT_GU = 64 * 2 * 64, BT_D = 64 * 64, BT_N = BT_GU + BT_D, BT_PITCH = 136;
__device__ __forceinline__ BigTile bt_decode(const Frame& F, unsigned char* Wgu8, unsigned char* Wd8, const float* nf, int ti) {
    BigTile t;
    const unsigned long long pg = (unsigned long long)F.in[I_W_GATE], pu = (unsigned long long)F.in[I_W_UP], pd = (unsigned long long)F.in[I_W_DOWN];
    if (ti < BT_GU) { const int e = ti >> 7, r = ti & 127, which = r >> 6, kb = (r >> 2) & 15, nb = r & 3;
        const unsigned long long p = pg + ((pu - pg) & (0ull - (unsigned long long)which));
        t.src = (const float*)p + (size_t)e * D * DEXP + (size_t)kb * 128 * DEXP + nb * 128; t.dst = Wgu8 + ((size_t)e * 1024 + nb * 256 + which * 128) * D + kb * 128; t.ks = nf + kb * 128; t.sc = SC_WGU; t.ldw = DEXP; t.ldt = D; }
    else { const int t2 = ti - BT_GU, e = t2 >> 6, r = t2 & 63, kb = r >> 4, nb = r & 15;
        t.src = (const float*)pd + (size_t)e * DEXP * D + (size_t)kb * 128 * D + nb * 128; t.dst = Wd8 + ((size_t)e * D + nb * 128) * DEXP + kb * 128; t.ks = nullptr; t.sc = SC_WD; t.ldw = D; t.ldt = DEXP; }
    return t;
}
#define BT_LOAD(t, v, kv) do { const unsigned _lo = (unsigned)(rl * 8 * (t).ldw + cq * 4); \
    _Pragma("unroll") for (int _p = 0; _p < 8; ++_p) kv[_p] = (t).ks ? (t).ks[rl * 8 + _p] * (t).sc : (t).sc; \
    _Pragma("unroll") for (int _p = 0; _p < 8; ++_p) v[_p] = __builtin_nontemporal_load((const f32x4*)((t).src + (size_t)_p * (t).ldw + _lo)); } while (0)
#define BT_STORE(t, v, kv) do { \
    _Pragma("unroll") for (int _i = 0; _i < 4; ++_i) { v2u _w; _w.x = pk4_fp8(v[0][_i] * kv[0], v[1][_i] * kv[1], v[2][_i] * kv[2], v[3][_i] * kv[3]); _w.y = pk4_fp8(v[4][_i] * kv[4], v[5][_i] * kv[5], v[6][_i] * kv[6], v[7][_i] * kv[7]); \
        *(LAS v2u*)(img + (cq * 4 + _i) * BT_PITCH + rl * 8) = _w; } \
    __syncthreads(); \
    _Pragma("unroll") for (int _j = 0; _j < 2; ++_j) { const int _idx = tid_ + _j * 512, _n = _idx >> 3, _ch = _idx & 7; \
        const v2u _a = *(const LAS v2u*)(img + _n * BT_PITCH + _ch * 16), _b = *(const LAS v2u*)(img + _n * BT_PITCH + _ch * 16 + 8); v4u _o; _o.x = _a.x; _o.y = _a.y; _o.z = _b.x; _o.w = _b.y; \
        *(v4u*)((t).dst + (size_t)_n * (t).ldt + _ch * 16) = _o; } \
    __syncthreads(); } while (0)
__device__ __forceinline__ void bg_convert(Frame& F, int qword, int base, int ntiles, int budget) {
    if (budget <= 0) return;
    int lane_ = (int)__builtin_amdgcn_mbcnt_hi(~0u, __builtin_amdgcn_mbcnt_lo(~0u, 0u)); asm volatile("" : "+v"(lane_)); const int tid_ = F.wave * 64 + lane_;
    unsigned char* WguT = F.ws + WS_WGU; unsigned char* WdT = F.ws + WS_WD; const float* nf = F.in[I_NORM_FFN];
    const int rl = tid_ >> 5, cq = tid_ & 31; LAS unsigned char* img = F.lds; LAS int* qn = (LAS int*)(F.lds + TAB_OFF + 1024);
    f32x4 va[8], vb[8]; float ka[8], kb[8];
    int nfetch = 0;
#define BG_FETCH(slot) do { if (nfetch < budget) { if (tid_ == 0) qn[slot] = (int)atomicAdd(F.ctl + qword, 1u); } else if (tid_ == 0) qn[slot] = 0x7fffffff; ++nfetch; } while (0)
    __syncthreads();
    BG_FETCH(0); BG_FETCH(1);
    __syncthreads();
    int i0 = __builtin_amdgcn_readfirstlane(qn[0]), i1 = __builtin_amdgcn_readfirstlane(qn[1]);
    __syncthreads();
    if (i0 < ntiles) { const BigTile t0 = bt_decode(F, WguT, WdT, nf, base + i0); BT_LOAD(t0, va, ka); }
    while (i0 < ntiles) {
        const BigTile ta = bt_decode(F, WguT, WdT, nf, base + i0);
        const BigTile tb = bt_decode(F, WguT, WdT, nf, base + (i1 < ntiles ? i1 : i0));
        BT_LOAD(tb, vb, kb);
        if (i1 >= ntiles) budget = 0;
        BG_FETCH(0);
        BT_STORE(ta, va, ka);
        const int i2 = __builtin_amdgcn_readfirstlane(qn[0]);
        if (i1 >= ntiles) break;
        const BigTile tc = bt_decode(F, WguT, WdT, nf, base + (i2 < ntiles ? i2 : i1));
        BT_LOAD(tc, va, ka);
        if (i2 >= ntiles) budget = 0;
        BG_FETCH(1);
        BT_STORE(tb, vb, kb);
        const int i3 = __builtin_amdgcn_readfirstlane(qn[1]);
        i0 = i2; i1 = i3;
    }
    __syncthreads();
#undef BG_FETCH
}
__device__ __forceinline__ void p0_prologue(Frame& F) {
    if (F.vcu < 32) s5_tables(F, F.vcu);
    const int gw = F.vcu * 8 + F.wave, NGW = F.G * 8;
    bf16* WinT = (bf16*)(F.ws + WS_WIN); bf16* WoT = (bf16*)(F.ws + WS_WO); bf16* WmkvT = (bf16*)(F.ws + WS_WMKV); bf16* WgluT = (bf16*)(F.ws + WS_WGLU);
    const float* nf = F.in[I_NORM_FFN];
    constexpr int I_IN = 32 * 72, I_O = 32 * 64, I_MKV = 32 * 32, I_GLU = 8 * 16;
    constexpr int NITEMS = I_IN + I_O + I_MKV + I_GLU;
    auto decode = [&](int it) -> TrItem {
        int r = it;
        if (r < I_IN) { const int kb = r / 72, nb = r % 72; return TrItem{F.in[I_W_IN], WinT, F.in[I_NORM_MIX]  , INC, D, kb * 64, nb * 32, nb * 32}; } r -= I_IN;
        if (r < I_O) { const int kb = r / 64, nb = r % 64, k0 = kb * 64;
            const unsigned long long pa = (unsigned long long)F.in[I_ON_ATTN], ps = (unsigned long long)(F.in[I_ON_SSM] - 1024), px = (unsigned long long)(F.in[I_ON_X] - 1536);
            const unsigned long long m1 = 0ull - (unsigned long long)(k0 >= 1024), m2 = 0ull - (unsigned long long)(k0 >= 1536);
            const unsigned long long pk = pa + ((ps - pa) & m1) + ((px - ps) & m2);
            return TrItem{F.in[I_W_O], WoT, (const float*)pk, D, D, k0, nb * 32, nb * 32}; } r -= I_O;
        if (r < I_MKV) { const int kb = r / 32, nb = r % 32; return TrItem{F.in[I_W_MEM_KV], WmkvT, nullptr, 1024, D, kb * 64, nb * 32, nb * 32}; } r -= I_MKV;
        const int kb = r / 16, nb = r % 16; return TrItem{F.in[I_W_GLU], WgluT, nullptr, 512, 512, kb * 64, nb * 32, nb * 32};
    };
    {
        f32x4 va[8], vb[8]; int it = gw; TrItem ia, ib;
        if (it < NITEMS) { ia = decode(it); tr_load(ia, va, F.lane); }
        while (it < NITEMS) {
            const int it2 = it + NGW; if (it2 < NITEMS) { ib = decode(it2); tr_load(ib, vb, F.lane); }
            tr_store(ia, va, F.lane);
            if (it2 >= NITEMS) break;
            const int it3 = it2 + NGW; if (it3 < NITEMS) { ia = decode(it3); tr_load(ia, va, F.lane); }
            tr_store(ib, vb, F.lane);
            it = it3;
        }
    }
    { bf16* WrT = (bf16*)(F.ws + WS_WR); const int gt = F.vcu * 512 + F.tid, NT = F.G * 512;
      for (int idx = gt; idx < 4 * 256 * 512; idx += NT) { const int ks = idx >> 17, n = (idx >> 9) & 255, k = ks * 512 + (idx & 511); float v = 0.f;
          if (n < 8) v = F.in[I_WR_G][k * 8 + n] * nf[k]; else if (n < 72) v = F.in[I_WR_E][k * 64 + (n - 8)] * nf[k];
          WrT[idx] = (bf16)f2bf(v); } }
    bf16* XN = (bf16*)(F.ws + WS_XN); bf16* MEMN = (bf16*)(F.ws + WS_MEMN);
    for (int m = gw; m < T; m += NGW) rms_row_to_bf16(F.in[I_X] + (size_t)m * D, nullptr, XN + (size_t)m * D, F.lane, (float*)(F.ws + WS_RINV) + m);
    for (int m = gw; m < NB * MEML; m += NGW) rms_row_to_bf16(F.in[I_MEM] + (size_t)m * D, F.in[I_MEM_NORM], MEMN + (size_t)m * D, F.lane);
    bg_convert(F, CW_QGU, 0, BT_GU, F.vcu < 32 ? PB0_S5 : PB0);
    bg_convert(F, CW_QD, BT_GU, BT_D, PB0_D);
}

constexpr int SWA_KS = 72, SWA_VS = 264;
constexpr int SWA_KOFF = 0, SWA_VOFF = 256 * SWA_KS * 2, SWA_BOFF = SWA_VOFF + 64 * SWA_VS * 2;
__device__ __forceinline__ int t5_bucket(int n) { if (n < 16) return n; const int v = 16 + (int)(logf((float)n * (1.0f / 16.0f)) / logf(8.0f) * 16.0f); return v < 31 ? v : 31; }
__device__ __forceinline__ void swa_unit(Frame& F, int unit) {
    const int b = unit >> 5, kvh = (unit >> 4) & 1, nb = unit & 15;
    const bf16* PROJ = (const bf16*)(F.ws + WS_PROJ); bf16* MIX = (bf16*)(F.ws + WS_MIX);
    LAS bf16* Ks = (LAS bf16*)(F.lds + SWA_KOFF); LAS bf16* Vt = (LAS bf16*)(F.lds + SWA_VOFF); LAS float* bt = (LAS float*)(F.lds + SWA_BOFF);
    const int w = F.wave, h = kvh * 8 + w, ql = F.lane & 31, hh = F.lane >> 5;
    v4u qnx[4];
    { const bf16* qp = PROJ + ((size_t)b * SEQ + nb * 128 + ql) * INC + h * 64 + 8 * hh;
#pragma unroll
      for (int ks = 0; ks < 4; ++ks) qnx[ks] = *(const v4u*)(qp + ks * 16); }
    __syncthreads();
    {
        const int key = F.tid >> 1, half = F.tid & 1, s = (nb - 1) * 128 + key;
        v4u kw[4], vw[4];
        if (s >= 0) { const bf16* rp = PROJ + (size_t)(b * SEQ + s) * INC + 1024 + kvh * 64 + half * 32;
#pragma unroll
            for (int j = 0; j < 4; ++j) { kw[j] = *(const v4u*)(rp + j * 8); vw[j] = *(const v4u*)(rp + 128 + j * 8); }
        } else {
#pragma unroll
            for (int j = 0; j < 4; ++j) { kw[j] = (v4u){0u, 0u, 0u, 0u}; vw[j] = (v4u){0u, 0u, 0u, 0u}; } }
        float kf[32]; float ss = 0.f;
#pragma unroll
        for (int j = 0; j < 4; ++j) { kf[j * 8 + 0] = bflo(kw[j].x); kf[j * 8 + 1] = bfhi(kw[j].x); kf[j * 8 + 2] = bflo(kw[j].y); kf[j * 8 + 3] = bfhi(kw[j].y);
            kf[j * 8 + 4] = bflo(kw[j].z); kf[j * 8 + 5] = bfhi(kw[j].z); kf[j * 8 + 6] = bflo(kw[j].w); kf[j * 8 + 7] = bfhi(kw[j].w); }
#pragma unroll
        for (int j = 0; j < 32; ++j) ss += kf[j] * kf[j];
        ss += __shfl_xor(ss, 1);
        const float rstd = 1.0f / sqrtf(ss * (1.f / 64.f) + EPS);
        const float* kn = F.in[I_K_NORM] + half * 32;
#pragma unroll
        for (int j = 0; j < 4; ++j) { v4u o; o.x = pk2(kf[j * 8 + 0] * rstd * kn[j * 8 + 0], kf[j * 8 + 1] * rstd * kn[j * 8 + 1]); o.y = pk2(kf[j * 8 + 2] * rstd * kn[j * 8 + 2], kf[j * 8 + 3] * rstd * kn[j * 8 + 3]);
            o.z = pk2(kf[j * 8 + 4] * rstd * kn[j * 8 + 4], kf[j * 8 + 5] * rstd * kn[j * 8 + 5]); o.w = pk2(kf[j * 8 + 6] * rstd * kn[j * 8 + 6], kf[j * 8 + 7] * rstd * kn[j * 8 + 7]);
            *(LAS v4u*)(Ks + key * SWA_KS + half * 32 + j * 8) = o; }
#pragma unroll
        for (int j = 0; j < 4; ++j) { const unsigned w4[4] = {vw[j].x, vw[j].y, vw[j].z, vw[j].w};
#pragma unroll
            for (int q = 0; q < 4; ++q) { const int d = half * 32 + j * 8 + q * 2; Vt[d * SWA_VS + key] = (bf16)(w4[q] & 0xffffu); Vt[(d + 1) * SWA_VS + key] = (bf16)(w4[q] >> 16); } }
        for (int idx = F.tid; idx < 8 * 128; idx += 512) { const int w = idx >> 7, dl = idx & 127; bt[idx] = F.in[I_REL_BIAS][t5_bucket(dl) * 16 + kvh * 8 + w]; }
    }
    __syncthreads();
    const float sink = F.in[I_SINKS][h];
    const float* qn = F.in[I_Q_NORM];
    for (int r = 0; r < 4; ++r) {
        const int qi = 32 * r + ql; const size_t t = (size_t)b * SEQ + nb * 128 + qi;
        bf16x8 qf[4];
        {   v4u qw[4]; float qv[32]; float ss = 0.f;
#pragma unroll
            for (int ks = 0; ks < 4; ++ks) qw[ks] = qnx[ks];
            if (r < 3) { const bf16* qp = PROJ + (t + 32) * INC + h * 64 + 8 * hh;
#pragma unroll
                for (int ks = 0; ks < 4; ++ks) qnx[ks] = *(const v4u*)(qp + ks * 16); }
#pragma unroll
            for (int ks = 0; ks < 4; ++ks) { qv[ks * 8 + 0] = bflo(qw[ks].x); qv[ks * 8 + 1] = bfhi(qw[ks].x); qv[ks * 8 + 2] = bflo(qw[ks].y); qv[ks * 8 + 3] = bfhi(qw[ks].y);
                qv[ks * 8 + 4] = bflo(qw[ks].z); qv[ks * 8 + 5] = bfhi(qw[ks].z); qv[ks * 8 + 6] = bflo(qw[ks].w); qv[ks * 8 + 7] = bfhi(qw[ks].w); }
#pragma unroll
            for (int j = 0; j < 32; ++j) ss += qv[j] * qv[j];
            ss += __shfl_xor(ss, 32);
            const float sc = 0.125f / sqrtf(ss * (1.f / 64.f) + EPS);
#pragma unroll
            for (int ks = 0; ks < 4; ++ks) { const float* g = qn + ks * 16 + 8 * hh; v4u o;
                o.x = pk2(qv[ks * 8 + 0] * sc * g[0], qv[ks * 8 + 1] * sc * g[1]); o.y = pk2(qv[ks * 8 + 2] * sc * g[2], qv[ks * 8 + 3] * sc * g[3]);
                o.z = pk2(qv[ks * 8 + 4] * sc * g[4], qv[ks * 8 + 5] * sc * g[5]); o.w = pk2(qv[ks * 8 + 6] * sc * g[6], qv[ks * 8 + 7] * sc * g[7]);
                qf[ks] = __builtin_bit_cast(bf16x8, o); } }
        f32x16 s[5];
        const int qh = ql - 4 * hh; const LAS float* pb = bt + w * 128 + qh;
        float mx = sink;
#pragma unroll
        for (int kt = 0; kt < 5; ++kt) {
            const bool live = (nb > 0) || (r + kt >= 4);
            f32x16 a = {0.f, 0.f, 0.f, 0.f, 0.f, 0.f, 0.f, 0.f, 0.f, 0.f, 0.f, 0.f, 0.f, 0.f, 0.f, 0.f};
            if (live) {
#pragma unroll
                for (int ks = 0; ks < 4; ++ks) { const bf16x8 kfrag = *(const LAS bf16x8*)(Ks + (32 * (r + kt) + ql) * SWA_KS + ks * 16 + 8 * hh);
                    a = __builtin_amdgcn_mfma_f32_32x32x16_bf16(kfrag, qf[ks], a, 0, 0, 0); }
#pragma unroll
                for (int rg = 0; rg < 16; ++rg) { const int rowc = (rg & 3) + 8 * (rg >> 2);
                    float v = a[rg] + pb[128 - 32 * kt - rowc];
                    if (kt == 0) v = (rowc > qh) ? v : -1e30f;
                    if (kt == 4) v = (rowc <= qh) ? v : -1e30f;
                    a[rg] = v; mx = fmaxf(mx, v); }
            } else {
#pragma unroll
                for (int rg = 0; rg < 16; ++rg) a[rg] = -1e30f;
            }
            s[kt] = a; }
        mx = fmaxf(mx, __shfl_xor(mx, 32));
        float l = 0.f;
#pragma unroll
        for (int kt = 0; kt < 5; ++kt)
#pragma unroll
            for (int rg = 0; rg < 16; ++rg) { const float p = fast_exp(s[kt][rg] - mx); s[kt][rg] = p; l += p; }
        l += __shfl_xor(l, 32);
        l += fast_exp(sink - mx);
        f32x16 o[2];
#pragma unroll
        for (int dt = 0; dt < 2; ++dt) o[dt] = (f32x16){0.f, 0.f, 0.f, 0.f, 0.f, 0.f, 0.f, 0.f, 0.f, 0.f, 0.f, 0.f, 0.f, 0.f, 0.f, 0.f};
#pragma unroll
        for (int kt = 0; kt < 5; ++kt)
#pragma unroll
            for (int st = 0; st < 2; ++st) { v4u pw; pw.x = pk2(s[kt][8 * st + 0], s[kt][8 * st + 1]); pw.y = pk2(s[kt][8 * st + 2], s[kt][8 * st + 3]); pw.z = pk2(s[kt][8 * st + 4], s[kt][8 * st + 5]); pw.w = pk2(s[kt][8 * st + 6], s[kt][8 * st + 7]);
                const bf16x8 pf = __builtin_bit_cast(bf16x8, pw);
#pragma unroll
                for (int dt = 0; dt < 2; ++dt) { const LAS bf16* vp = Vt + (dt * 32 + ql) * SWA_VS + 32 * (r + kt) + 16 * st + 4 * hh;
                    const v2u lo = *(const LAS v2u*)vp, hi = *(const LAS v2u*)(vp + 8); v4u vv; vv.x = lo.x; vv.y = lo.y; vv.z = hi.x; vv.w = hi.y;
                    o[dt] = __builtin_amdgcn_mfma_f32_32x32x16_bf16(__builtin_bit_cast(bf16x8, vv), pf, o[dt], 0, 0, 0); } }
        const float inv = 1.0f / l;
        { float ssq = 0.f;
#pragma unroll
          for (int dt = 0; dt < 2; ++dt)
#pragma unroll
              for (int rg = 0; rg < 16; ++rg) { const float v = o[dt][rg] * inv; ssq += v * v; }
          ssq += __shfl_xor(ssq, 32);
          if (hh == 0) ((float*)(F.ws + WS_SS))[t * 32 + h] = ssq; }
        bf16* op = MIX + t * D + h * 64 + 4 * hh;
#pragma unroll
        for (int dt = 0; dt < 2; ++dt)
#pragma unroll
            for (int q4 = 0; q4 < 4; ++q4) { v2u ow; ow.x = pk2(o[dt][q4 * 4 + 0] * inv, o[dt][q4 * 4 + 1] * inv); ow.y = pk2(o[dt][q4 * 4 + 2] * inv, o[dt][q4 * 4 + 3] * inv);
                *(v2u*)(op + dt * 32 + q4 * 8) = ow; }
    }
}

constexpr int XA_KS = 136, XA_VS = 264;
constexpr int XA_KOFF = 0, XA_VOFF = 256 * XA_KS * 2;
__device__ __forceinline__ void xattn_unit(Frame& F, int unit) {
    const int b = unit >> 5, hx = (unit >> 3) & 3, qb = unit & 7;
    const bf16* PROJ = (const bf16*)(F.ws + WS_PROJ); const bf16* MKV = (const bf16*)(F.ws + WS_MEMKV); bf16* MIX = (bf16*)(F.ws + WS_MIX);
    LAS bf16* Ks = (LAS bf16*)(F.lds + XA_KOFF); LAS bf16* Vt = (LAS bf16*)(F.lds + XA_VOFF);
    __syncthreads();
    {   const int key = F.tid >> 1, half = F.tid & 1; const bf16* rp = MKV + (size_t)(b * MEML + key) * 1024 + hx * 128 + half * 64;
        float ss = 0.f; v4u kw[8];
#pragma unroll
        for (int j = 0; j < 8; ++j) { kw[j] = *(const v4u*)(rp + j * 8);
            const float a0 = bflo(kw[j].x), a1 = bfhi(kw[j].x), a2 = bflo(kw[j].y), a3 = bfhi(kw[j].y), a4 = bflo(kw[j].z), a5 = bfhi(kw[j].z), a6 = bflo(kw[j].w), a7 = bfhi(kw[j].w);
            ss += (a0 * a0 + a1 * a1) + (a2 * a2 + a3 * a3) + (a4 * a4 + a5 * a5) + (a6 * a6 + a7 * a7); }
        ss += __shfl_xor(ss, 1);
        const float rstd = 1.0f / sqrtf(ss * (1.f / 128.f) + EPS);
        const float* kn = F.in[I_XK_NORM] + half * 64;
#pragma unroll
        for (int j = 0; j < 8; ++j) { v4u o; const float* g = kn + j * 8;
            o.x = pk2(bflo(kw[j].x) * rstd * g[0], bfhi(kw[j].x) * rstd * g[1]); o.y = pk2(bflo(kw[j].y) * rstd * g[2], bfhi(kw[j].y) * rstd * g[3]);
            o.z = pk2(bflo(kw[j].z) * rstd * g[4], bfhi(kw[j].z) * rstd * g[5]); o.w = pk2(bflo(kw[j].w) * rstd * g[6], bfhi(kw[j].w) * rstd * g[7]);
            *(LAS v4u*)(Ks + key * XA_KS + half * 64 + j * 8) = o; }
#pragma unroll
        for (int j = 0; j < 8; ++j) { const v4u vw = *(const v4u*)(rp + 512 + j * 8); const unsigned w4[4] = {vw.x, vw.y, vw.z, vw.w};
#pragma unroll
            for (int q = 0; q < 4; ++q) { const int d = half * 64 + j * 8 + q * 2; Vt[d * XA_VS + key] = (bf16)(w4[q] & 0xffffu); Vt[(d + 1) * XA_VS + key] = (bf16)(w4[q] >> 16); } }
    }
    __syncthreads();
    const int ql = F.lane & 31, hh = F.lane >> 5;
    const size_t t = (size_t)b * SEQ + qb * 256 + F.wave * 32 + ql;
    bf16x8 qf[8];
    {   const bf16* qp = PROJ + t * INC + 1792 + hx * 128 + 8 * hh; v4u qw[8]; float ss = 0.f;
#pragma unroll
        for (int ks = 0; ks < 8; ++ks) { qw[ks] = *(const v4u*)(qp + ks * 16);
            const float a0 = bflo(qw[ks].x), a1 = bfhi(qw[ks].x), a2 = bflo(qw[ks].y), a3 = bfhi(qw[ks].y), a4 = bflo(qw[ks].z), a5 = bfhi(qw[ks].z), a6 = bflo(qw[ks].w), a7 = bfhi(qw[ks].w);
            ss += (a0 * a0 + a1 * a1) + (a2 * a2 + a3 * a3) + (a4 * a4 + a5 * a5) + (a6 * a6 + a7 * a7); }
        ss += __shfl_xor(ss, 32);
        const float sc = 0.08838834764831845f / sqrtf(ss * (1.f / 128.f) + EPS);
        const float* qn = F.in[I_XQ_NORM] + 8 * hh;
#pragma unroll
        for (int ks = 0; ks < 8; ++ks) { const float* g = qn + ks * 16; v4u o;
            o.x = pk2(bflo(qw[ks].x) * sc * g[0], bfhi(qw[ks].x) * sc * g[1]); o.y = pk2(bflo(qw[ks].y) * sc * g[2], bfhi(qw[ks].y) * sc * g[3]);
            o.z = pk2(bflo(qw[ks].z) * sc * g[4], bfhi(qw[ks].z) * sc * g[5]); o.w = pk2(bflo(qw[ks].w) * sc * g[6], bfhi(qw[ks].w) * sc * g[7]);
            qf[ks] = __builtin_bit_cast(bf16x8, o); } }
    f32x16 o[4];
#pragma unroll
    for (int dt = 0; dt < 4; ++dt) o[dt] = (f32x16){0.f, 0.f, 0.f, 0.f, 0.f, 0.f, 0.f, 0.f, 0.f, 0.f, 0.f, 0.f, 0.f, 0.f, 0.f, 0.f};
    float mrun = -1e30f, lrun = 0.f;
    for (int kb = 0; kb < 4; ++kb) {
        f32x16 s[2];
#pragma unroll
        for (int kt = 0; kt < 2; ++kt) { f32x16 a = {0.f, 0.f, 0.f, 0.f, 0.f, 0.f, 0.f, 0.f, 0.f, 0.f, 0.f, 0.f, 0.f, 0.f, 0.f, 0.f};
#pragma unroll
            for (int ks = 0; ks < 8; ++ks) { const bf16x8 kfrag = *(const LAS bf16x8*)(Ks + (64 * kb + 32 * kt + ql) * XA_KS + ks * 16 + 8 * hh);
                a = __builtin_amdgcn_mfma_f32_32x32x16_bf16(kfrag, qf[ks], a, 0, 0, 0); }
            s[kt] = a; }
        float mx = mrun;
#pragma unroll
        for (int kt = 0; kt < 2; ++kt)
#pragma unroll
            for (int rg = 0; rg < 16; ++rg) mx = fmaxf(mx, s[kt][rg]);
        mx = fmaxf(mx, __shfl_xor(mx, 32));
        const float alpha = fast_exp(mrun - mx); mrun = mx;
        float ls = 0.f;
#pragma unroll
        for (int kt = 0; kt < 2; ++kt)
#pragma unroll
            for (int rg = 0; rg < 16; ++rg) { const float p = fast_exp(s[kt][rg] - mx); s[kt][rg] = p; ls += p; }
        lrun = lrun * alpha + ls;
#pragma unroll
        for (int dt = 0; dt < 4; ++dt)
#pragma unroll
            for (int rg = 0; rg < 16; ++rg) o[dt][rg] *= alpha;
#pragma unroll
        for (int kt = 0; kt < 2; ++kt)
#pragma unroll
            for (int st = 0; st < 2; ++st) { v4u pw; pw.x = pk2(s[kt][8 * st + 0], s[kt][8 * st + 1]); pw.y = pk2(s[kt][8 * st + 2], s[kt][8 * st + 3]); pw.z = pk2(s[kt][8 * st + 4], s[kt][8 * st + 5]); pw.w = pk2(s[kt][8 * st + 6], s[kt][8 * st + 7]);
                const bf16x8 pf = __builtin_bit_cast(bf16x8, pw);
#pragma unroll
                for (int dt = 0; dt < 4; ++dt) { const LAS bf16* vp = Vt + (dt * 32 + ql) * XA_VS + 64 * kb + 32 * kt + 16 * st + 4 * hh;
                    const v2u lo = *(const LAS v2u*)vp, hi = *(const LAS v2u*)(vp + 8); v4u vv; vv.x = lo.x; vv.y = lo.y; vv.z = hi.x; vv.w = hi.y;
                    o[dt] = __builtin_amdgcn_mfma_f32_32x32x16_bf16(__builtin_bit_cast(bf16x8, vv), pf, o[dt], 0, 0, 0); } }
    }
    lrun += __shfl_xor(lrun, 32);
    const float inv = 1.0f / lrun;
    { float ssq = 0.f;
#pragma unroll
      for (int dt = 0; dt < 4; ++dt)
#pragma unroll
          for (int rg = 0; rg < 16; ++rg) { const float v = o[dt][rg] * inv; ssq += v * v; }
      ssq += __shfl_xor(ssq, 32);
      if (hh == 0) ((float*)(F.ws + WS_SS))[t * 32 + 24 + hx] = ssq; }
    bf16* op = MIX + t * D + 1536 + hx * 128 + 4 * hh;
#pragma unroll
    for (int dt = 0; dt < 4; ++dt)
#pragma unroll
        for (int q4 = 0; q4 < 4; ++q4) { v2u ow; ow.x = pk2(o[dt][q4 * 4 + 0] * inv, o[dt][q4 * 4 + 1] * inv); ow.y = pk2(o[dt][q4 * 4 + 2] * inv, o[dt][q4 * 4 + 3] * inv);
            *(v2u*)(op + dt * 32 + q4 * 8) = ow; }
}

__device__ __forceinline__ void moe_tables(Frame& F) {
    LAS int* cnt = (LAS int*)(F.lds + TAB_OFF); LAS int* ts = cnt + 64;
    __syncthreads();
    if (F.tid < 64) { const int c = (int)__hip_atomic_load(F.ctl + CW_CNT + F.tid, __ATOMIC_RELAXED, __HIP_MEMORY_SCOPE_AGENT); const int nt = (c + 255) >> 8; int inc = nt;
#pragma unroll
        for (int o = 1; o < 64; o <<= 1) { const int v = __shfl_up(inc, o); if (F.tid >= o) inc += v; }
        cnt[F.tid] = c; ts[F.tid + 1] = inc; if (F.tid == 0) ts[0] = 0; }
    __syncthreads();
}

struct Args { const float* in[31]; float* out; unsigned char* ws; int ph_lo, ph_hi; };
__global__ void __launch_bounds__(512, 2) hymba_fwd(Args args) {
    extern __shared__ __attribute__((aligned(16))) unsigned char lds_raw[];
    Frame F;
    F.lds = (LAS unsigned char*)lds_raw;
    F.tid = threadIdx.x; F.lane = F.tid & 63; F.wave = __builtin_amdgcn_readfirstlane(F.tid >> 6);
    F.G = gridDim.x; { const int bx = blockIdx.x; F.vcu = (F.G % 8 == 0) ? (bx % 8) * (F.G / 8) + bx / 8 : bx; }
    F.in = (const float* const __attribute__((address_space(4)))*)__builtin_amdgcn_kernarg_segment_ptr();
    F.out = args.out; F.ws = args.ws; F.ctl = (unsigned*)(args.ws + WS_CTL);
    const int lo = args.ph_lo, hi = args.ph_hi;
#if !MK_PER_PHASE
    if (F.tid < 4) ((LAS unsigned*)(F.lds + XBW_OFF))[F.tid] = 0u;
    __syncthreads();
    XcdBarrier bar = xcd_barrier_post(F.ctl + CW_BAR, (volatile LAS unsigned*)(F.lds + XBW_OFF));
#define GRID_BAR() xcd_barrier(bar)
#else
#define GRID_BAR() do {} while (0)
#endif
#define PHASE_REGS() do { int _l = (int)__builtin_amdgcn_mbcnt_hi(~0u, __builtin_amdgcn_mbcnt_lo(~0u, 0u)); asm volatile("" : "+v"(_l)); F.lane = _l; F.tid = F.wave * 64 + _l; } while (0)
#define IN(k) (lo <= (k) && (k) < hi)
#define SEAM(k) do { if (IN(k) && IN((k) + 1)) GRID_BAR(); } while (0)
    const int gw = F.vcu * 8 + F.wave, NGW = F.G * 8;
    bf16* const XN = (bf16*)(F.ws + WS_XN); bf16* const PROJ = (bf16*)(F.ws + WS_PROJ); bf16* const MIX = (bf16*)(F.ws + WS_MIX);
    bf16* const UA = (bf16*)(F.ws + WS_UA); bf16* const Gm = (bf16*)(F.ws + WS_G);

    if (IN(0)) { PHASE_REGS(); p0_prologue(F); }
    SEAM(0);
    if (IN(1)) { PHASE_REGS();
        { pg8::Gemm g{D, D, D}; pg8::DenseOrder S; S.init(XN, F.ws + WS_WIN, D, D, T, INC, F.G, (int)blockIdx.x);
          pg8::EpiProj E{PROJ, UA}; pg8::gemm_phase<pg8::EpiProj, pg8::DenseOrder>(F.lds, g, S, E, F.wave); }
        { pg8::Gemm g{D, D, D}; pg8::DenseOrder S; S.init(F.ws + WS_MEMN, F.ws + WS_WMKV, D, D, NB * MEML, 1024, F.G, F.G - 1 - (int)blockIdx.x);
          pg8::EpiBf16 E{(bf16*)(F.ws + WS_MEMKV), 1024}; pg8::gemm_phase<pg8::EpiBf16, pg8::DenseOrder>(F.lds, g, S, E, F.wave); }
        { const int c = (int)blockIdx.x; const bool has3 = 2 * F.G + c < (T / 256) * (INC / 256), haskv = (F.G - 1 - c) < (NB * MEML / 256) * 4;
          bg_convert(F, CW_QD, BT_GU, BT_D, (!has3 && !haskv) ? PB1 : 0); }
    }
    SEAM(1);
    if (IN(2)) { PHASE_REGS();
        for (int u = F.vcu; u < 256; u += F.G) swa_unit(F, u);
        __syncthreads();
        { pg8::Gemm g{S5K, 512, 256}; pg8::StateOrder S{(const char*)UA, (const char*)(F.ws + WS_SP), F.G, F.G - 1 - F.vcu};
          pg8::EpiF32 E{(float*)(F.ws + WS_SL), 256, (size_t)512 * 256}; pg8::gemm_phase<pg8::EpiF32, pg8::StateOrder>(F.lds, g, S, E, F.wave); }
        bg_convert(F, CW_QD, BT_GU, BT_D, (F.G - 1 - F.vcu) >= 128 ? PB2 : 0);
    }
    SEAM(2);
    if (IN(3)) { PHASE_REGS();
        if (F.wave < 4) { const float* SL = (const float*)(F.ws + WS_SL); const float* AL = (const float*)(F.ws + WS_AL);
            for (int L = F.vcu; L < 128; L += F.G) { const int g = L >> 2, pm = L & 1, b = 4 * pm + F.wave, n = F.lane;
                const float ar = AL[(g * 64 + n) * 2], ai = AL[(g * 64 + n) * 2 + 1]; float xr = 0.f, xi = 0.f;
                for (int j0 = 0; j0 < 64; j0 += 8) { float sr[8], si[8];
#pragma unroll
                    for (int j = 0; j < 8; ++j) { const float* sp = SL + ((size_t)(g * 1024 + b * 64 + j0 + j)) * 256; const float* sq = sp + (size_t)512 * 256; sr[j] = sp[n] + sq[n]; si[j] = sp[64 + n] + sq[64 + n]; }
#pragma unroll
                    for (int j = 0; j < 8; ++j) { bf16* up = UA + ((size_t)(g * 512 + b * 64 + j0 + j)) * S5K + 512; up[n] = (bf16)f2bf(xr); up[64 + n] = (bf16)f2bf(xi);
                        const float nr = ar * xr - ai * xi + sr[j], ni = ar * xi + ai * xr + si[j]; xr = nr; xi = ni; } } } }
        asm volatile("s_waitcnt vmcnt(0)" ::: "memory");
        __syncthreads();
        pg8::Gemm g{S5K, S5K, S5K}; pg8::GroupOrder S{(const char*)UA, (const char*)(F.ws + WS_MQ), S5K, S5K, 2, 32, F.G, F.vcu};
        pg8::EpiS5Y E{UA, F.in[I_SSM_D], Gm}; pg8::gemm_phase<pg8::EpiS5Y, pg8::GroupOrder>(F.lds, g, S, E, F.wave);
        if (F.G >= 256 && F.vcu >= 128) { for (int u = F.vcu - 128; u < 128; u += F.G - 128) xattn_unit(F, u); __syncthreads(); }
        if (F.G < 256) { for (int u = F.vcu; u < 256; u += F.G) xattn_unit(F, u); __syncthreads(); }
        bg_convert(F, CW_QD, BT_GU, BT_D, (F.G >= 256 && F.vcu >= 128) ? PB4 : 0);
    }
    SEAM(3);
    if (IN(4)) { PHASE_REGS();
        pg8::Gemm g{512, 512, 512}; pg8::DenseOrder S; S.init(Gm, F.ws + WS_WGLU, 512, 512, T, 512, F.G, (int)blockIdx.x);
        pg8::EpiGlu E{Gm, MIX, (float*)(F.ws + WS_SS)}; pg8::gemm_phase<pg8::EpiGlu, pg8::DenseOrder>(F.lds, g, S, E, F.wave);
        if (F.G >= 256 && (int)blockIdx.x >= 128) { for (int u = 128 + (int)blockIdx.x - 128; u < 256; u += F.G - 128) xattn_unit(F, u); __syncthreads(); }
    }
    SEAM(4);
    if (IN(5)) { PHASE_REGS();
        pg8::Gemm g{D, D, D}; pg8::DenseOrder S; S.init(MIX, F.ws + WS_WO, D, D, T, D, F.G, (int)blockIdx.x);
        pg8::EpiWo E{(const float*)(F.ws + WS_RINV), XN, (unsigned char*)(F.ws + WS_X18), (float*)(F.ws + WS_PART)}; pg8::gemm_phase<pg8::EpiWo, pg8::DenseOrder, false, false, true>(F.lds, g, S, E, F.wave, (const float*)(F.ws + WS_SS));
    }
    SEAM(5);
    if (IN(6)) { PHASE_REGS();
        pg8::Gemm g{D, 512, 512}; pg8::KSplitOrder S{(const char*)XN, (const char*)(F.ws + WS_WR), D, 512, 512, T / 256, 4, F.G, F.vcu};
        pg8::EpiLogit E{(float*)(F.ws + WS_LP)}; pg8::gemm_phase<pg8::EpiLogit, pg8::KSplitOrder>(F.lds, g, S, E, F.wave);
    }
    SEAM(6);
    const int rt_per = (T + F.G - 1) / F.G, rt_beg = F.vcu * rt_per, rt_end = (rt_beg + rt_per) < T ? (rt_beg + rt_per) : T;
    if (IN(7)) { PHASE_REGS();
        LAS int* hist = (LAS int*)F.lds;
        const float* LP = (const float*)(F.ws + WS_LP); const float* part = (const float*)(F.ws + WS_PART); float* rstdv = (float*)(F.ws + WS_RSTD);
        int* toke = (int*)(F.ws + WS_TOKE); float* wts = (float*)(F.ws + WS_WTS); int* HIST = (int*)(F.ws + WS_HIST);
        __syncthreads();
        if (F.tid < 64) hist[F.tid] = 0;
        __syncthreads();
        for (int t = rt_beg + F.tid; t < rt_end; t += 512) {
            const f32x4* pp = (const f32x4*)(part + (size_t)t * 32); float ss = 0.f;
#pragma unroll
            for (int j = 0; j < 8; ++j) { const f32x4 v = pp[j]; ss += (v[0] + v[1]) + (v[2] + v[3]); }
            const float rs = 1.0f / sqrtf(ss * (1.f / 2048.f) + EPS); rstdv[t] = rs;
            const float* l0 = LP + (size_t)t * 80; const float* l1 = l0 + (size_t)T * 80; const float* l2 = l1 + (size_t)T * 80; const float* l3 = l2 + (size_t)T * 80;
            float gl[8];
#pragma unroll
            for (int j = 0; j < 8; j += 4) { const f32x4 a = *(const f32x4*)(l0 + j), b = *(const f32x4*)(l1 + j), c = *(const f32x4*)(l2 + j), d = *(const f32x4*)(l3 + j);
#pragma unroll
                for (int q = 0; q < 4; ++q) gl[j + q] = rs * (((a[q] + b[q]) + c[q]) + d[q]); }
            int gi = 0; float gm = gl[0];
#pragma unroll
            for (int j = 1; j < 8; ++j) if (gl[j] > gm) { gm = gl[j]; gi = j; }
            float gs = 0.f;
#pragma unroll
            for (int j = 0; j < 8; ++j) gs += expf(gl[j] - gm);
            const float gate = 1.0f / gs;
            float el[8];
#pragma unroll
            for (int j = 0; j < 8; j += 4) { const int o = 8 + gi * 8 + j; const f32x4 a = *(const f32x4*)(l0 + o), b = *(const f32x4*)(l1 + o), c = *(const f32x4*)(l2 + o), d = *(const f32x4*)(l3 + o);
#pragma unroll
                for (int q = 0; q < 4; ++q) el[j + q] = rs * (((a[q] + b[q]) + c[q]) + d[q]); }
            int i1 = 0; float v1 = el[0];
#pragma unroll
            for (int j = 1; j < 8; ++j) if (el[j] > v1) { v1 = el[j]; i1 = j; }
            int i2 = -1; float v2 = -3.0e38f;
#pragma unroll
            for (int j = 0; j < 8; ++j) if (j != i1 && el[j] > v2) { v2 = el[j]; i2 = j; }
            const float ex = expf(v2 - v1);
            const int ea = gi * 8 + i1, eb = gi * 8 + i2;
            const int la = __hip_atomic_fetch_add(hist + ea, 1, __ATOMIC_RELAXED, __HIP_MEMORY_SCOPE_WORKGROUP), lb = __hip_atomic_fetch_add(hist + eb, 1, __ATOMIC_RELAXED, __HIP_MEMORY_SCOPE_WORKGROUP);
            toke[t * 2] = (ea << 16) | la; toke[t * 2 + 1] = (eb << 16) | lb; wts[t * 2] = gate / (1.0f + ex); wts[t * 2 + 1] = gate * ex / (1.0f + ex);
        }
        __syncthreads();
        if (F.tid < 64) HIST[F.vcu * 64 + F.tid] = hist[F.tid];
        __syncthreads();
    }
    SEAM(7);
    if (IN(8)) { PHASE_REGS();
        LAS int* pb = (LAS int*)F.lds; LAS int* pt = pb + 512; LAS int* base = pt + 512;
        const int* HIST = (const int*)(F.ws + WS_HIST); const int* toke = (const int*)(F.ws + WS_TOKE); int* list = (int*)(F.ws + WS_LIST);
        __syncthreads();
        { const int e = F.tid & 63, p8 = F.tid >> 6; int sb = 0, st = 0;
          for (int w = p8; w < F.G; w += 8) { const int h = HIST[w * 64 + e]; st += h; sb += (w < F.vcu) ? h : 0; }
          pb[F.tid] = sb; pt[F.tid] = st; }
        __syncthreads();
        if (F.tid < 64) { int sb = 0, st = 0;
#pragma unroll
            for (int j = 0; j < 8; ++j) { sb += pb[j * 64 + F.tid]; st += pt[j * 64 + F.tid]; }
            base[F.tid] = sb; F.ctl[CW_CNT + F.tid] = (unsigned)st; }
        __syncthreads();
        for (int t = rt_beg + F.tid; t < rt_end; t += 512) {
#pragma unroll
            for (int k = 0; k < 2; ++k) { const int v = toke[t * 2 + k], e = v >> 16, sl = v & 0xffff; const size_t pos = (size_t)e * LCAP + base[e] + sl;
                list[pos] = t * 2 + k; ((float*)(F.ws + WS_LRS))[pos] = ((const float*)(F.ws + WS_RSTD))[t]; ((float*)(F.ws + WS_LWT))[pos] = ((const float*)(F.ws + WS_WTS))[t * 2 + k]; } }
        __syncthreads();
        bg_convert(F, CW_QGU, 0, BT_GU, 0x7fffffff);
    }
    SEAM(8);
    if (IN(9)) { PHASE_REGS();
        moe_tables(F);
        const LAS int* cnt = (const LAS int*)(F.lds + TAB_OFF); const int* list = (const int*)(F.ws + WS_LIST);
        pg8::Gemm g{D / 2, D / 2, D / 2}; pg8::MoeOrder S{(const char*)(F.ws + WS_X18), (const char*)(F.ws + WS_WGU), cnt, cnt + 64, list, D / 2, D / 2, 4, 1024, F.G, F.vcu, true};
        pg8::EpiGU E{list, (const float*)(F.ws + WS_LRS), cnt, F.ws + WS_ACT}; pg8::gemm_phase<pg8::EpiGU, pg8::MoeOrder, true, true>(F.lds, g, S, E, F.wave);
        PHASE_REGS();
        bg_convert(F, CW_QD, BT_GU, BT_D, 0x7fffffff);
    }
    SEAM(9);
    if (IN(10)) { PHASE_REGS();
        moe_tables(F);
        const LAS int* cnt = (const LAS int*)(F.lds + TAB_OFF); const int* list = (const int*)(F.ws + WS_LIST);
        pg8::Gemm g{DEXP / 2, DEXP / 2, DEXP / 2}; pg8::MoeOrder S{(const char*)(F.ws + WS_ACT), (const char*)(F.ws + WS_WD), cnt, cnt + 64, list, DEXP / 2, DEXP / 2, 8, 2048, F.G, F.vcu, false};
        pg8::EpiDown E{list, (const float*)(F.ws + WS_LWT), cnt, F.ws + WS_Y2};
        pg8::gemm_phase<pg8::EpiDown, pg8::MoeOrder, false, true>(F.lds, g, S, E, F.wave);
    }
    SEAM(10);
    if (IN(11)) { PHASE_REGS();
        const unsigned char* Y2 = F.ws + WS_Y2; typedef float f32x2_ __attribute__((ext_vector_type(2)));
        for (int m = gw; m < T; m += NGW) { f32x4* op = (f32x4*)(F.out + (size_t)m * D) + F.lane * 2; const v4u* xb = (const v4u*)(XN + (size_t)m * D) + F.lane;
            const v2u* ya = (const v2u*)(Y2 + (size_t)m * 2 * D) + F.lane; const v2u* yb = ya + 256;
            v4u xw[4]; v2u aw[4], cw[4];
#pragma unroll
            for (int j = 0; j < 4; ++j) { xw[j] = __builtin_nontemporal_load(xb + 64 * j); aw[j] = __builtin_nontemporal_load(ya + 64 * j); cw[j] = __builtin_nontemporal_load(yb + 64 * j); }
#pragma unroll
            for (int j = 0; j < 4; ++j) { const v4u x = xw[j]; const v2u a = aw[j], c = cw[j]; f32x4 x0, x1; const float is = 1.0f / SC_Y;
                const f32x2_ a0 = __builtin_amdgcn_cvt_pk_f32_fp8((int)a.x, false), a1 = __builtin_amdgcn_cvt_pk_f32_fp8((int)a.x, true), a2 = __builtin_amdgcn_cvt_pk_f32_fp8((int)a.y, false), a3 = __builtin_amdgcn_cvt_pk_f32_fp8((int)a.y, true);
                const f32x2_ c0 = __builtin_amdgcn_cvt_pk_f32_fp8((int)c.x, false), c1 = __builtin_amdgcn_cvt_pk_f32_fp8((int)c.x, true), c2 = __builtin_amdgcn_cvt_pk_f32_fp8((int)c.y, false), c3 = __builtin_amdgcn_cvt_pk_f32_fp8((int)c.y, true);
                x0[0] = bflo(x.x) + (a0[0] + c0[0]) * is; x0[1] = bfhi(x.x) + (a0[1] + c0[1]) * is; x0[2] = bflo(x.y) + (a1[0] + c1[0]) * is; x0[3] = bfhi(x.y) + (a1[1] + c1[1]) * is;
                x1[0] = bflo(x.z) + (a2[0] + c2[0]) * is; x1[1] = bfhi(x.z) + (a2[1] + c2[1]) * is; x1[2] = bflo(x.w) + (a3[0] + c3[0]) * is; x1[3] = bfhi(x.w) + (a3[1] + c3[1]) * is;
                __builtin_nontemporal_store(x0, op + 128 * j); __builtin_nontemporal_store(x1, op + 128 * j + 1); } }
    }
#undef IN
#undef SEAM
}

extern "C" void kernel_launch(void* const* d_in, const int* in_sizes, int n_in, void* d_out, int out_size, void* d_ws, size_t ws_size, hipStream_t stream) {
    static int grid = 0;
    if (grid == 0) {
        if (n_in != 31 || out_size != T * D || ws_size < WS_END) { fprintf(stderr, "kernel_launch: unexpected shapes (n_in %d out %d ws %zu)\n", n_in, out_size, ws_size); grid = -1; return; }
        int dev = 0, cus = 0, per_cu = 0;
        if (hipGetDevice(&dev) != hipSuccess || hipDeviceGetAttribute(&cus, hipDeviceAttributeMultiprocessorCount, dev) != hipSuccess) { grid = -1; return; }
        if (hipFuncSetAttribute((const void*)hymba_fwd, hipFuncAttributeMaxDynamicSharedMemorySize, LDS_BYTES) != hipSuccess) { fprintf(stderr, "kernel_launch: hipFuncSetAttribute failed\n"); grid = -1; return; }
        if (hipOccupancyMaxActiveBlocksPerMultiprocessor(&per_cu, (const void*)hymba_fwd, 512, LDS_BYTES) != hipSuccess || per_cu < 1) fprintf(stderr, "kernel_launch: occupancy query reports %d\n", per_cu);
        (void)hipGetLastError();
        grid = cus;
    }
    if (grid < 0) return;
    (void)hipMemsetAsync((char*)d_ws + WS_CTL, 0, CTL_ZERO_BYTES, stream);
    Args a{};
    for (int i = 0; i < 31; ++i) a.in[i] = (const float*)d_in[i];
    a.out = (float*)d_out; a.ws = (unsigned char*)d_ws;
#if MK_PER_PHASE
    for (int p = 0; p < NPH; ++p) { const int reps = ((PROBE_REP_MASK >> p) & 1) ? 2 : 1;
        for (int q = 0; q < reps; ++q) { a.ph_lo = p; a.ph_hi = p + 1; hipLaunchKernelGGL(hymba_fwd, dim3(grid), dim3(512), LDS_BYTES, stream, a); } }
#else
    a.ph_lo = 0; a.ph_hi = NPH; hipLaunchKernelGGL(hymba_fwd, dim3(grid), dim3(512), LDS_BYTES, stream, a);
#endif
}
```

```cpp
#include <hip/hip_runtime.h>
#include <cstdio>
#include <cstdint>

#ifndef PROBE_REP_MASK
#define PROBE_REP_MASK 0
#endif
#ifndef PB0
#define PB0 40
#endif
#ifndef PB0_S5
#define PB0_S5 28
#endif
#ifndef PB0_D
#define PB0_D 0
#endif
#ifndef PB1
#define PB1 18
#endif
#ifndef PB2
#define PB2 0
#endif
#ifndef PB4
#define PB4 3
#endif
#ifndef PB5
#define PB5 0
#endif
#ifndef PB11
#define PB11 0
#endif
#ifndef MK_PER_PHASE
#define MK_PER_PHASE 0
#endif

#define GAS __attribute__((address_space(1)))
#define LAS __attribute__((address_space(3)))
typedef unsigned short bf16;
typedef unsigned v4u __attribute__((ext_vector_type(4)));
typedef unsigned v2u __attribute__((ext_vector_type(2)));
typedef float f32x4 __attribute__((ext_vector_type(4)));
typedef float f32x16 __attribute__((ext_vector_type(16)));
typedef short bf16x8 __attribute__((ext_vector_type(8)));
typedef short bf16x4 __attribute__((ext_vector_type(4)));
typedef int v8i __attribute__((ext_vector_type(8)));
typedef int v4i_ __attribute__((ext_vector_type(4)));

constexpr int T = 16384, D = 2048, SEQ = 2048, NB = 8, INC = 2304, MEML = 256;
constexpr int NPH = 12;
constexpr float EPS = 1e-6f;
constexpr int NEXP = 64, DEXP = 512, LCAP = 16384;
constexpr int S5L = 32, S5K = 640;

constexpr size_t MiB = 1u << 20;
constexpr size_t WS_CTL = 0, CTL_ZERO_BYTES = 1 * MiB;
constexpr size_t WS_WIN = 2 * MiB, WS_WO = 11 * MiB, WS_WMKV = 19 * MiB, WS_WGLU = 23 * MiB;
constexpr size_t WS_MQ = 24 * MiB, WS_SP = 44 * MiB, WS_UA = 52 * MiB, WS_SL = 468 * MiB  , WS_AL = 88 * MiB, WS_WR = 89 * MiB;
constexpr size_t WS_XN = 96 * MiB;
constexpr size_t WS_MEMN = 160 * MiB, WS_MEMKV = 168 * MiB;
constexpr size_t WS_PROJ = 176 * MiB;
constexpr size_t WS_MIX = 248 * MiB;
constexpr size_t WS_Y2 = 176 * MiB;
constexpr size_t WS_G = 312 * MiB;
constexpr size_t WS_LOG = 328 * MiB;
constexpr size_t WS_LIST = 344 * MiB;
constexpr size_t WS_WTS = 348 * MiB;
constexpr size_t WS_LP = 352 * MiB;
constexpr size_t WS_PART = 376 * MiB;
constexpr size_t WS_RSTD = 379 * MiB;
constexpr size_t WS_HIST = 380 * MiB;
constexpr size_t WS_X18 = 384 * MiB;
constexpr size_t WS_SS = 382 * MiB;
constexpr size_t WS_LRS = 452 * MiB;
constexpr size_t WS_LWT = 456 * MiB;
constexpr size_t WS_RINV = 460 * MiB;
constexpr size_t WS_TOKE = 381 * MiB;
constexpr size_t WS_ACT = 544 * MiB;
constexpr size_t WS_WGU = 592 * MiB;
constexpr size_t WS_WD = 848 * MiB;
constexpr size_t WS_END = 976 * MiB;
constexpr int CW_CNT = 1024;
constexpr int CW_BAR = 4096;
constexpr int CW_QGU = 2048, CW_QD = 2112;

constexpr int RING_BYTES = 131072;
constexpr int TAB_OFF = 139264;
constexpr int XBW_OFF = TAB_OFF + 2048;
constexpr int LDS_BYTES = 147456;

#define LDS_WAIT() asm volatile("s_waitcnt lgkmcnt(0)" ::: "memory")
#define VM_WAIT() asm volatile("s_waitcnt vmcnt(0)" ::: "memory")
__device__ __forceinline__ unsigned f2bf(float f) { unsigned u = __builtin_bit_cast(unsigned, f); return (u + 0x7fffu + ((u >> 16) & 1u)) >> 16; }
__device__ __forceinline__ unsigned pk2(float lo, float hi) { unsigned r; asm volatile("v_cvt_pk_bf16_f32 %0, %1, %2" : "=v"(r) : "v"(lo), "v"(hi)); return r; }
__device__ __forceinline__ float bflo(unsigned w) { return __builtin_bit_cast(float, w << 16); }
__device__ __forceinline__ float bfhi(unsigned w) { return __builtin_bit_cast(float, w & 0xffff0000u); }
__device__ __forceinline__ float wave_sum(float v) {
#pragma unroll
    for (int o = 1; o < 64; o <<= 1) v += __shfl_xor(v, o);
    return v;
}
constexpr float SC_X = 4.0f, SC_WGU = 32.0f, SC_ACT = 16.0f, SC_WD = 16.0f, SC_Y = 64.0f;
__device__ __forceinline__ float clamp8(float v) { return __builtin_amdgcn_fmed3f(v, -448.0f, 448.0f); }
__device__ __forceinline__ unsigned pk4_fp8(float a, float b, float c, float d) { unsigned w = 0u; w = (unsigned)__builtin_amdgcn_cvt_pk_fp8_f32(clamp8(a), clamp8(b), (int)w, false); w = (unsigned)__builtin_amdgcn_cvt_pk_fp8_f32(clamp8(c), clamp8(d), (int)w, true); return w; }
__device__ __forceinline__ float fast_exp(float x) { return __builtin_amdgcn_exp2f(x * 1.44269504089f); }
__device__ __forceinline__ float sigmoidf_(float x) { return __builtin_amdgcn_rcpf(1.0f + fast_exp(-x)); }
__device__ __forceinline__ float gelu_tanh(float x) { const float z = 1.5957691216f * (x + 0.044715f * x * x * x); return x * sigmoidf_(z); }

#define XB_TMO      128
#define XB_XCNT(j)  (256  + 64 * (j))
#define XB_XSUB(j)  (1280 + 64 * (j))
#define XB_XGEN(j)  (2304 + 64 * (j))
#define XB_TOP      3328
#define XB_TOPGEN   3392
#define XCD_BAR_WORDS 3456
#define XB_SPIN_CAP (1u << 18)
__device__ __forceinline__ unsigned xb_ld(unsigned* p)              { return __hip_atomic_load(p, __ATOMIC_RELAXED, __HIP_MEMORY_SCOPE_AGENT); }
__device__ __forceinline__ unsigned xb_add(unsigned* p, unsigned v) { return __hip_atomic_fetch_add(p, v, __ATOMIC_RELAXED, __HIP_MEMORY_SCOPE_AGENT); }
__device__ __forceinline__ unsigned xb_xcc_id() { return (unsigned)__builtin_amdgcn_s_getreg((3 << 11) | 20) & 0xFu; }
#define XB_SPIN(cond, bar) do { unsigned _sp = 0; while (cond) { __builtin_amdgcn_s_sleep(1); \
    if ((++_sp & 255u) == 0u) { if (xb_ld(&(bar)[XB_TMO])) break; if (_sp > XB_SPIN_CAP) { atomicAdd(&(bar)[XB_TMO], 1u); break; } } } } while (0)
struct XcdBarrier { unsigned* bar; unsigned x; volatile LAS unsigned* st; };
__device__ __forceinline__ XcdBarrier xcd_barrier_post(unsigned* bar, volatile LAS unsigned* st) {
    XcdBarrier b; b.bar = bar; b.x = xb_xcc_id(); b.st = st;
    if (threadIdx.x == 0) (void)xb_add(&bar[XB_XCNT(b.x)], 1u);
    return b;
}
__device__ __forceinline__ void xcd_barrier_complete(unsigned* bar, unsigned x, unsigned& nloc, unsigned& nx) {
    const unsigned G = gridDim.x * gridDim.y * gridDim.z;
    unsigned sum, cnt, mine, sp = 0u;
    for (;;) {
        sum = 0u; cnt = 0u; mine = 0u;
#pragma unroll
        for (unsigned j = 0; j < 16; ++j) { const unsigned c = xb_ld(&bar[XB_XCNT(j)]); sum += c; cnt += (c > 0u) ? 1u : 0u; mine = (j == x) ? c : mine; }
        if (sum == G) break;
        __builtin_amdgcn_s_sleep(1);
        if ((++sp & 255u) == 0u) { if (xb_ld(&bar[XB_TMO])) break; if (sp > XB_SPIN_CAP) { atomicAdd(&bar[XB_TMO], 1u); break; } }
    }
    nloc = mine > 0u ? mine : 1u; nx = cnt > 0u ? cnt : 1u;
}
__device__ __forceinline__ void xcd_barrier(const XcdBarrier& b) {
    asm volatile("s_waitcnt vmcnt(0)" ::: "memory");
    __syncthreads();
    if (threadIdx.x == 0) {
        unsigned* bar = b.bar;
        __builtin_amdgcn_s_waitcnt(0);
        unsigned nloc = b.st[0], nx = b.st[1];
        if (nloc == 0u) { xcd_barrier_complete(bar, b.x, nloc, nx); b.st[0] = nloc; b.st[1] = nx; }
        const unsigned old = xb_add(&bar[XB_XSUB(b.x)], 1u);
        const unsigned gen = old / nloc;
        if (old + 1u == (gen + 1u) * nloc) {
            __builtin_amdgcn_fence(__ATOMIC_RELEASE, "agent");
            asm volatile("s_waitcnt vmcnt(0)" ::: "memory");
            const unsigned og = xb_add(&bar[XB_TOP], 1u);
            const unsigned tg = og / nx;
            if (og + 1u == (tg + 1u) * nx) xb_add(&bar[XB_TOPGEN], 1u);
            else XB_SPIN(xb_ld(&bar[XB_TOPGEN]) == tg, bar);
            __builtin_amdgcn_fence(__ATOMIC_ACQUIRE, "agent");
            xb_add(&bar[XB_XGEN(b.x)], 1u);
            asm volatile("s_waitcnt vmcnt(0)" ::: "memory");
        } else {
            XB_SPIN(xb_ld(&bar[XB_XGEN(b.x)]) == gen, bar);
            __builtin_amdgcn_fence(__ATOMIC_ACQUIRE, "agent");
            asm volatile("s_waitcnt vmcnt(0)" ::: "memory");
        }
    }
    __syncthreads();
}

__device__ __forceinline__ int lane_now() { int l = (int)__builtin_amdgcn_mbcnt_hi(~0u, __builtin_amdgcn_mbcnt_lo(~0u, 0u)); asm volatile("" : "+v"(l)); return l; }
namespace pg8 {
constexpr int BM = 256, BK = 64, HALF = 128, HTB = HALF * BK * 2, STAGE_BYTES = 8 * HTB, NXCD = 8, WGM = 8;
__host__ __device__ __forceinline__ int lds_byte(int r, int c) { const int st = (r >> 4) * 2 + (c >> 5), rr = r & 15, cc = c & 31, ob = rr * 64 + cc * 2; return st * 1024 + (ob ^ (((ob >> 9) & 1) << 5)); }
__host__ __device__ __forceinline__ void stage_rc(int b, int& R, int& C) { const int st = b / 1024, sb = b % 1024, swz = sb ^ (((sb >> 9) & 1) << 5); R = (st >> 1) * 16 + swz / 64; C = (st & 1) * 32 + (swz % 64) / 2; }
__host__ __device__ __forceinline__ int perm32(int rho) { const int n = rho >> 4, i = rho & 15; return 8 * (i >> 2) + 4 * n + (i & 3); }

struct Unit { const char* a; const char* b; int r0, c0, aux, r1; };
struct Gemm { int lda, ldb, K; };

struct DenseOrder {
    const char* A; const char* Bt; int lda, ldb, nM, nN, nwg, G, c;
    __device__ void init(const void* A_, const void* Bt_, int lda_, int ldb_, int M, int N, int G_, int c_) { A = (const char*)A_; Bt = (const char*)Bt_; lda = lda_; ldb = ldb_; nM = M / BM; nN = N / BM; nwg = nM * nN; G = G_; c = c_; }
    __device__ bool next(int i, Unit& u) const {
        const long L = (long)i * G + c; if (L >= nwg) return false;
        int wgid = (int)L; { const int q = nwg / NXCD, r = nwg % NXCD, xcd = wgid % NXCD, off = wgid / NXCD; wgid = (xcd < r ? xcd * (q + 1) : r * (q + 1) + (xcd - r) * q) + off; }
        const int nig = WGM * nN, gid = wgid / nig, fm = gid * WGM, gsz = (nM - fm) < WGM ? (nM - fm) : WGM;
        const int pm = fm + ((wgid % nig) % gsz), pn = (wgid % nig) / gsz;
        u.a = A + (size_t)pm * BM * lda * 2; u.b = Bt + (size_t)pn * BM * ldb * 2; u.r0 = pm * BM; u.c0 = pn * BM; u.aux = 0; u.r1 = 0; return true;
    }
    __device__ __forceinline__ unsigned arow(const Unit&, int) const { return 0u; }
};
struct GroupOrder {
    const char* A; const char* Bt; int lda, ldb, nN, ngrp, G, c;
    __device__ bool next(int i, Unit& u) const {
        const int L = i * G + c; if (L >= ngrp * 2 * nN) return false;
        const int g = L / (2 * nN), q = L % (2 * nN), pn = q >> 1, pm = q & 1;
        u.a = A + ((size_t)g * 512 + pm * BM) * lda * 2; u.b = Bt + ((size_t)g * nN + pn) * BM * ldb * 2; u.r0 = pm * BM; u.c0 = pn * BM; u.aux = g; u.r1 = 0; return true;
    }
    __device__ __forceinline__ unsigned arow(const Unit&, int) const { return 0u; }
};
struct StateOrder {
    const char* A; const char* Bt; int G, c;
    __device__ bool next(int i, Unit& u) const {
        const int L = i * G + c; if (L >= 128) return false;
        const int g = L >> 2, pm = (L >> 1) & 1, ks = L & 1;
        u.a = A + (((size_t)g * 512 + pm * BM) * S5K + ks * 256) * 2; u.b = Bt + ((size_t)g * 256 * 512 + ks * 256) * 2; u.r0 = pm * BM; u.c0 = 0; u.aux = g * 2 + ks; u.r1 = 0; return true;
    }
    __device__ __forceinline__ unsigned arow(const Unit&, int) const { return 0u; }
};
struct MoeOrder {
    const char* A; const char* Bt; const LAS int* cnt; const LAS int* ts; const int* list; int lda, ldb, nct, brows, G, c; bool gather;
    __device__ bool next(int i, Unit& u) const {
        const int L = i * G + c; const int lane = lane_now();
        int i64 = 64; asm volatile("" : "+v"(i64));
        if (L >= __builtin_amdgcn_readfirstlane(ts[i64]) * nct) return false;
        const int lo = ts[lane] * nct, hi = ts[lane + 1] * nct;
        const unsigned long long m = __ballot(lo <= L && L < hi);
        const int e = __builtin_amdgcn_readfirstlane((int)__builtin_ctzll(m));
        const int tse = ts[e], ne = ts[e + 1] - tse, q = L - tse * nct, ct = q / ne, rt = q % ne;
        u.a = gather ? A : A + (size_t)(tse + rt) * BM * lda * 2; u.b = Bt + ((size_t)e * brows + (size_t)ct * BM) * ldb * 2;
        u.r0 = (tse + rt) * BM; u.r1 = rt * BM; u.c0 = ct; u.aux = e; return true;
    }
    __device__ __forceinline__ unsigned arow(const Unit& u, int r) const {
        const int n = cnt[u.aux]; int rr = u.r1 + r; rr = rr < n ? rr : n - 1;
        return (unsigned)(list[(size_t)u.aux * LCAP + rr] >> 1) * (unsigned)(lda * 2);
    }
};

#define EPI_ROWS_COLS() const int rowb = wr * 64 + fr; (void)rowb;

template <class Epi, class Sched, bool GATHER = false, bool FP8 = false, bool KSEG = false>
__device__ __forceinline__ void gemm_phase(LAS unsigned char* lds, const Gemm g, const Sched& S, const Epi& E, const int wave_id, const float* ssq = nullptr) {
    int lane = (int)__builtin_amdgcn_mbcnt_hi(~0u, __builtin_amdgcn_mbcnt_lo(~0u, 0u)); asm volatile("" : "+v"(lane));
    const int wid = wave_id, tid = wid * 64 + lane, wr = wid >> 2, wc = wid & 3, fr = lane & 15, fq = lane >> 4;
    const int K = g.K; int nt = K / BK; asm volatile("" : "+s"(nt));
    unsigned voffB;
    { int R, C; stage_rc(tid * 16, R, C); const int Rb = Epi::PERM ? ((R & ~31) + perm32(R & 31)) : R; voffB = (unsigned)(Rb * g.ldb + C) * 2u; }
    const int soffB = 64 * g.ldb * 2, soffA = 64 * g.lda * 2;
#define PG8_RC(i, R, C) int R, C; { int _t = tid; asm volatile("" : "+v"(_t)); stage_rc(_t * 16 + (i) * 8192, R, C); }
#define nxoff ((LAS v4u*)(lds + 131072) + (wid * 64 + lane_now()))
    const size_t kstep = (size_t)(BK * 2);
    const size_t hstepB = (size_t)HALF * g.ldb * 2;
    const unsigned ldsw = (unsigned)wid * 1024u;
    const int aoff = lds_byte(wr * 64 + fr, fq * 8), boff = lds_byte(wc * 32 + fr, fq * 8);
#define PG8_SA(b, h) (((b) * 2 + (h)) * HTB)
#define PG8_SB(b, h) ((4 + (b) * 2 + (h)) * HTB)
#define PG8_RSRC(p) __builtin_amdgcn_make_buffer_rsrc((void*)(p), 0, 0xffffffff, 0x00020000)
#define PG8_DMA(gbase, vo, so, ldsp) do { if constexpr (FP8) { __builtin_amdgcn_raw_ptr_buffer_load_lds(PG8_RSRC(gbase), (LAS void*)(ldsp), 16, (int)(vo), (so), 0, 0); } \
        else { __builtin_amdgcn_global_load_lds((const unsigned*)((const char*)(gbase) + (so) + (vo)), (LAS unsigned*)(ldsp), 16, 0, 0); } } while (0)
#define PG8_STAGE(bufoff, gbase, voff) do { PG8_DMA(gbase, voff, 0, lds + (bufoff) + ldsw); PG8_DMA(gbase, voff, soffB, lds + (bufoff) + ldsw + 8192); } while (0)
#define PG8_STAGEA(bufoff, gbase, o0, o1, h) do { \
        if constexpr (GATHER) { PG8_DMA(gbase, o0, 0, lds + (bufoff) + ldsw); PG8_DMA(gbase, o1, 0, lds + (bufoff) + ldsw + 8192); } \
        else { PG8_DMA(gbase, c00, (h) * 2 * soffA, lds + (bufoff) + ldsw); PG8_DMA(gbase, c00, (h) * 2 * soffA + soffA, lds + (bufoff) + ldsw + 8192); } } while (0)
#define PG8_LDA(dst, b, h) do { _Pragma("unroll") for (int m = 0; m < 4; ++m) { \
        if constexpr (FP8) { dst##8[m].lo = *(const LAS v4i_*)(lds + PG8_SA(b, h) + aoff + m * 2048); dst##8[m].hi = *(const LAS v4i_*)(lds + PG8_SA(b, h) + aoff + m * 2048 + 1024); } \
        else { _Pragma("unroll") for (int k = 0; k < 2; ++k) dst[m][k] = *(const LAS bf16x8*)(lds + PG8_SA(b, h) + aoff + m * 2048 + k * 1024); } } } while (0)
#define PG8_LDB(dst, b, h) do { _Pragma("unroll") for (int n = 0; n < 2; ++n) { \
        if constexpr (FP8) { dst##8[n].lo = *(const LAS v4i_*)(lds + PG8_SB(b, h) + boff + n * 2048); dst##8[n].hi = *(const LAS v4i_*)(lds + PG8_SB(b, h) + boff + n * 2048 + 1024); } \
        else { _Pragma("unroll") for (int k = 0; k < 2; ++k) dst[n][k] = *(const LAS bf16x8*)(lds + PG8_SB(b, h) + boff + n * 2048 + k * 1024); } } } while (0)
#define PG8_MMA(ai, bj, At, Bt) do { __builtin_amdgcn_s_setprio(1); _Pragma("unroll") for (int m = 0; m < 4; ++m) _Pragma("unroll") for (int n = 0; n < 2; ++n) { \
        if constexpr (FP8) { acc[ai][bj][m][n] = __builtin_amdgcn_mfma_scale_f32_16x16x128_f8f6f4(Bt##8[n], At##8[m], acc[ai][bj][m][n], 0, 0, 0, 0x7f7f7f7f, 0, 0x7f7f7f7f); } \
        else { _Pragma("unroll") for (int k = 0; k < 2; ++k) acc[ai][bj][m][n] = __builtin_amdgcn_mfma_f32_16x16x32_bf16(Bt[n][k], At[m][k], acc[ai][bj][m][n], 0, 0, 0); } } \
        __builtin_amdgcn_s_setprio(0); } while (0)
#define PG8_WAIT_V(n) asm volatile("s_waitcnt vmcnt(" #n ")" ::: "memory")
#define PG8_WAIT_L(n) asm volatile("s_waitcnt lgkmcnt(" #n ")" ::: "memory")
#define PG8_BAR __builtin_amdgcn_s_barrier()
#define PG8_SCHED __builtin_amdgcn_sched_barrier(0)
    LAS f32x4* scl = (LAS f32x4*)(lds + 131072);
#define PG8_FILL_SCL(u) do { if constexpr (KSEG) { if (tid < 256) { const f32x4* sp = (const f32x4*)(ssq + (size_t)((u).r0 + tid) * 32); \
        const f32x4 p0 = sp[0], p1 = sp[1], p2 = sp[2], p3 = sp[3], p4 = sp[4], p5 = sp[5], p6 = sp[6]; \
        const float sa = (((p0[0] + p0[1]) + (p0[2] + p0[3])) + ((p1[0] + p1[1]) + (p1[2] + p1[3]))) + (((p2[0] + p2[1]) + (p2[2] + p2[3])) + ((p3[0] + p3[1]) + (p3[2] + p3[3]))); \
        const float sb = ((p4[0] + p4[1]) + (p4[2] + p4[3])) + ((p5[0] + p5[1]) + (p5[2] + p5[3])), sc = (p6[0] + p6[1]) + (p6[2] + p6[3]); \
        const float ra = 1.0f / sqrtf(sa * (1.f / 1024.f) + EPS), rb = 1.0f / sqrtf(sb * (1.f / 512.f) + EPS), rc = 1.0f / sqrtf(sc * (1.f / 512.f) + EPS); \
        scl[(ui & 1) * 256 + tid] = (f32x4){ra / rb, rb / rc, rc, 0.f}; } } } while (0)
#define PG8_SCALE(k) do { _Pragma("unroll") for (int _ai = 0; _ai < 2; ++_ai) _Pragma("unroll") for (int _m = 0; _m < 4; ++_m) { const float _f = ((const LAS float*)scl)[((ui & 1) * 256 + _ai * HALF + wr * 64 + _m * 16 + fr) * 4 + (k)]; \
        _Pragma("unroll") for (int _bj = 0; _bj < 2; ++_bj) _Pragma("unroll") for (int _n = 0; _n < 2; ++_n) acc[_ai][_bj][_m][_n] = acc[_ai][_bj][_m][_n] * _f; } } while (0)
    Unit cur, nxt; int ui = 0;
    if (!S.next(0, cur)) return;
    PG8_FILL_SCL(cur);
    if constexpr (Epi::PRE) E.pre(cur, lds + 143360 + (ui & 1) * 2048, tid);
    f32x4 acc[2][2][4][2];
#pragma unroll
    for (int a = 0; a < 2; ++a)
#pragma unroll
        for (int b = 0; b < 2; ++b)
#pragma unroll
            for (int m = 0; m < 4; ++m)
#pragma unroll
                for (int n = 0; n < 2; ++n) acc[a][b][m][n] = (f32x4){0.f, 0.f, 0.f, 0.f};
    bf16x8 At[4][2], B0[2][2], B1[2][2]; v8i At8[4], B08[2], B18[2];
    const char* cA = cur.a; const char* cB = cur.b;
    unsigned c00, c01, c10, c11;
    { PG8_RC(0, R0, C0); PG8_RC(1, R1, C1);
      if constexpr (GATHER) {
        c00 = S.arow(cur, R0) + C0 * 2u; c01 = S.arow(cur, R1) + C1 * 2u; c10 = S.arow(cur, HALF + R0) + C0 * 2u; c11 = S.arow(cur, HALF + R1) + C1 * 2u;
        asm volatile("s_waitcnt vmcnt(0)" : "+v"(c00), "+v"(c01), "+v"(c10), "+v"(c11) :: "memory");
      } else {
        c00 = (unsigned)(R0 * g.lda + C0) * 2u; c01 = c00; c10 = c00; c11 = c00; (void)R1; (void)C1;
      } }
    PG8_STAGE(PG8_SB(0, 0), cB, voffB); PG8_STAGE(PG8_SB(0, 1), cB + hstepB, voffB); PG8_STAGEA(PG8_SA(0, 0), cA, c00, c01, 0); PG8_STAGEA(PG8_SA(0, 1), cA, c10, c11, 1);
    if (wr == 1) PG8_BAR;
    PG8_WAIT_V(2); PG8_BAR;
    PG8_STAGE(PG8_SB(1, 0), cB + kstep, voffB); PG8_STAGEA(PG8_SA(1, 0), cA + kstep, c00, c01, 0); PG8_STAGE(PG8_SB(1, 1), cB + hstepB + kstep, voffB);
    PG8_WAIT_V(6); PG8_BAR;
#define PG8_KITER(t) do { \
            const bool last = (t == nt - 2); \
            const char* a1 = cA + (size_t)(t + 1) * kstep; \
            const char* a2 = last ? nA : cA + (size_t)(t + 2) * kstep; const char* b2 = last ? nB : cB + (size_t)(t + 2) * kstep; \
            const char* a3 = a2 + kstep; const char* b3 = b2 + kstep; \
            unsigned x00 = c00, x01 = c01, x10 = c10, x11 = c11; \
            if constexpr (GATHER) { if (last) { const v4u nv = *nxoff; x00 = nv.x; x01 = nv.y; x10 = nv.z; x11 = nv.w; } } \
 \
            PG8_LDB(B0, 0, 0); PG8_LDB(B1, 0, 1); PG8_SCHED; PG8_LDA(At, 0, 0); PG8_STAGEA(PG8_SA(1, 1), a1, c10, c11, 1); \
            PG8_WAIT_V(8); PG8_WAIT_L(0); PG8_BAR; PG8_MMA(0, 0, At, B0); PG8_MMA(0, 1, At, B1); PG8_BAR; PG8_SCHED; \
 \
            PG8_LDA(At, 0, 1); PG8_STAGE(PG8_SB(0, 0), b2, voffB); PG8_STAGE(PG8_SB(0, 1), b2 + hstepB, voffB); PG8_STAGEA(PG8_SA(0, 0), a2, x00, x01, 0); \
            PG8_WAIT_V(8); PG8_WAIT_L(0); PG8_BAR; PG8_MMA(1, 0, At, B0); PG8_MMA(1, 1, At, B1); PG8_BAR; PG8_SCHED; \
 \
            PG8_LDB(B0, 1, 0); PG8_LDB(B1, 1, 1); PG8_SCHED; PG8_LDA(At, 1, 0); PG8_STAGEA(PG8_SA(0, 1), a2, x10, x11, 1); \
            PG8_WAIT_V(8); PG8_WAIT_L(0); PG8_BAR; PG8_MMA(0, 0, At, B0); PG8_MMA(0, 1, At, B1); PG8_BAR; PG8_SCHED; \
 \
            PG8_LDA(At, 1, 1); PG8_STAGE(PG8_SB(1, 0), b3, voffB); PG8_STAGE(PG8_SB(1, 1), b3 + hstepB, voffB); PG8_STAGEA(PG8_SA(1, 0), a3, x00, x01, 0); \
            PG8_WAIT_V(8); PG8_WAIT_L(0); PG8_BAR; PG8_MMA(1, 0, At, B0); PG8_MMA(1, 1, At, B1); PG8_BAR; PG8_SCHED; \
        } while (0)
    for (;;) {
        const bool has_next = S.next(ui + 1, nxt);
        const char* nA = has_next ? nxt.a : cA; const char* nB = has_next ? nxt.b : cB;
        if constexpr (GATHER) {
            unsigned n00 = c00, n01 = c01, n10 = c10, n11 = c11;
            if (has_next) { PG8_RC(0, R0, C0); PG8_RC(1, R1, C1); n00 = S.arow(nxt, R0) + C0 * 2u; n01 = S.arow(nxt, R1) + C1 * 2u; n10 = S.arow(nxt, HALF + R0) + C0 * 2u; n11 = S.arow(nxt, HALF + R1) + C1 * 2u; }
            asm volatile("s_waitcnt vmcnt(0)" : "+v"(n00), "+v"(n01), "+v"(n10), "+v"(n11) :: "memory");
            v4u nv; nv.x = n00; nv.y = n01; nv.z = n10; nv.w = n11; *nxoff = nv;
        }
        if constexpr (KSEG) {
#pragma unroll 1
            for (int t = 0; t < 16; t += 2) PG8_KITER(t);
            PG8_SCALE(0);
#pragma unroll 1
            for (int t = 16; t < 24; t += 2) PG8_KITER(t);
            PG8_SCALE(1);
#pragma unroll 1
            for (int t = 24; t < nt; t += 2) PG8_KITER(t);
        } else {
#pragma unroll 1
            for (int t = 0; t < nt; t += 2) PG8_KITER(t);
        }
        if (wr == 0) PG8_BAR;
        if constexpr (KSEG) PG8_SCALE(2);
        { const int le = lane_now(); if constexpr (Epi::PRE) E(acc, cur, wr, wc, le & 15, le >> 4, lds + 143360 + (ui & 1) * 2048); else E(acc, cur, wr, wc, le & 15, le >> 4); }
        if (!has_next) break;
#pragma unroll
        for (int a = 0; a < 2; ++a)
#pragma unroll
            for (int b = 0; b < 2; ++b)
#pragma unroll
                for (int m = 0; m < 4; ++m)
#pragma unroll
                    for (int n = 0; n < 2; ++n) acc[a][b][m][n] = (f32x4){0.f, 0.f, 0.f, 0.f};
        cur = nxt; cA = nA; cB = nB; ++ui;
        if constexpr (KSEG) { PG8_WAIT_L(0); PG8_FILL_SCL(cur); }
        if constexpr (Epi::PRE) E.pre(cur, lds + 143360 + (ui & 1) * 2048, tid);
        if constexpr (GATHER) { const v4u nv = *nxoff; c00 = nv.x; c01 = nv.y; c10 = nv.z; c11 = nv.w; }
        if (wr == 1) PG8_BAR;
    }
    PG8_WAIT_V(0);
    PG8_BAR;
#undef PG8_RC
#undef PG8_KITER
#undef PG8_FILL_SCL
#undef PG8_SCALE
#undef nxoff
#undef PG8_SA
#undef PG8_SB
#undef PG8_STAGE
#undef PG8_STAGEA
#undef PG8_DMA
#undef PG8_RSRC
#undef PG8_LDA
#undef PG8_LDB
#undef PG8_MMA
#undef PG8_WAIT_V
#undef PG8_WAIT_L
#undef PG8_BAR
#undef PG8_SCHED
}

typedef const f32x4 (&AccRef)[2][2][4][2];
__device__ __forceinline__ v4u pack8(const f32x4 a, const f32x4 b) { v4u w; w.x = pk2(a[0], a[1]); w.y = pk2(a[2], a[3]); w.z = pk2(b[0], b[1]); w.w = pk2(b[2], b[3]); return w; }

struct EpiProj {
    static constexpr bool PERM = true, PRE = false;
    bf16* PROJ; bf16* UA;
    __device__ __forceinline__ void operator()(AccRef acc, const Unit& u, int wr, int wc, int fr, int fq) const {
        const int row0 = u.r0 + wr * 64 + fr, colb = u.c0 + wc * 32 + 8 * fq;
        const bool isu = (u.c0 == 1280 || u.c0 == 1536);
#pragma unroll
        for (int ai = 0; ai < 2; ++ai)
#pragma unroll
            for (int m = 0; m < 4; ++m) { const int row = row0 + ai * HALF + m * 16;
#pragma unroll
                for (int bj = 0; bj < 2; ++bj) { const int col = colb + bj * HALF; const v4u w = pack8(acc[ai][bj][m][0], acc[ai][bj][m][1]);
                    if (!isu) *(v4u*)(PROJ + (size_t)row * INC + col) = w;
                    else { const int cc = col - 1280, g = cc >> 4, c0 = cc & 15; *(v4u*)(UA + ((size_t)(g * 512 + (row >> 5)) * S5K + (row & 31) * 16 + c0)) = w; } } }
    }
};
struct EpiBf16 {
    static constexpr bool PERM = true, PRE = false;
    bf16* O; int ldc;
    __device__ __forceinline__ void operator()(AccRef acc, const Unit& u, int wr, int wc, int fr, int fq) const {
        const int row0 = u.r0 + wr * 64 + fr, colb = u.c0 + wc * 32 + 8 * fq;
#pragma unroll
        for (int ai = 0; ai < 2; ++ai)
#pragma unroll
            for (int m = 0; m < 4; ++m) { bf16* rowp = O + (size_t)(row0 + ai * HALF + m * 16) * ldc + colb;
#pragma unroll
                for (int bj = 0; bj < 2; ++bj) *(v4u*)(rowp + bj * HALF) = pack8(acc[ai][bj][m][0], acc[ai][bj][m][1]); }
    }
};
struct EpiF32 {
    static constexpr bool PERM = false, PRE = false;
    float* C; int ldc; size_t gstride;
    __device__ __forceinline__ void operator()(AccRef acc, const Unit& u, int wr, int wc, int fr, int fq) const {
        const int row0 = u.r0 + wr * 64 + fr, col0 = u.c0 + wc * 32 + 4 * fq; float* base = C + (size_t)u.aux * gstride;
#pragma unroll
        for (int ai = 0; ai < 2; ++ai)
#pragma unroll
            for (int m = 0; m < 4; ++m) { float* rowp = base + (size_t)(row0 + ai * HALF + m * 16) * ldc + col0;
#pragma unroll
                for (int bj = 0; bj < 2; ++bj)
#pragma unroll
                    for (int n = 0; n < 2; ++n) *(f32x4*)(rowp + bj * HALF + n * 16) = acc[ai][bj][m][n]; }
    }
};
struct EpiS5Y {
    static constexpr bool PERM = true, PRE = false;
    const bf16* UA; const float* dsk; bf16* Gm;
    __device__ __forceinline__ void operator()(AccRef acc, const Unit& u, int wr, int wc, int fr, int fq) const {
        const int row0 = u.r0 + wr * 64 + fr, colb = u.c0 + wc * 32 + 8 * fq, g = u.aux;
#pragma unroll
        for (int ai = 0; ai < 2; ++ai)
#pragma unroll
            for (int m = 0; m < 4; ++m) { const int row = row0 + ai * HALF + m * 16;
#pragma unroll
                for (int bj = 0; bj < 2; ++bj) { const int col = colb + bj * HALF, i = col >> 4, c0 = col & 15;
                    const v4u uw = *(const v4u*)(UA + ((size_t)(g * 512 + row) * S5K + col));
                    const f32x4 d0 = *(const f32x4*)(dsk + g * 16 + c0), d1 = *(const f32x4*)(dsk + g * 16 + c0 + 4);
                    const f32x4 a0 = acc[ai][bj][m][0], a1 = acc[ai][bj][m][1];
                    f32x4 y0, y1;
                    y0[0] = gelu_tanh(a0[0] + d0[0] * bflo(uw.x)); y0[1] = gelu_tanh(a0[1] + d0[1] * bfhi(uw.x)); y0[2] = gelu_tanh(a0[2] + d0[2] * bflo(uw.y)); y0[3] = gelu_tanh(a0[3] + d0[3] * bfhi(uw.y));
                    y1[0] = gelu_tanh(a1[0] + d1[0] * bflo(uw.z)); y1[1] = gelu_tanh(a1[1] + d1[1] * bfhi(uw.z)); y1[2] = gelu_tanh(a1[2] + d1[2] * bflo(uw.w)); y1[3] = gelu_tanh(a1[3] + d1[3] * bfhi(uw.w));
                    *(v4u*)(Gm + ((size_t)row * 32 + i) * 512 + g * 16 + c0) = pack8(y0, y1); } }
    }
};
struct EpiGlu {
    static constexpr bool PERM = true, PRE = false;
    const bf16* Gm; bf16* MIX; float* SS;
    __device__ __forceinline__ void operator()(AccRef acc, const Unit& u, int wr, int wc, int fr, int fq) const {
        const int row0 = u.r0 + wr * 64 + fr, colb = u.c0 + wc * 32 + 8 * fq;
#pragma unroll
        for (int ai = 0; ai < 2; ++ai)
#pragma unroll
            for (int m = 0; m < 4; ++m) { const int row = row0 + ai * HALF + m * 16; float ss = 0.f;
#pragma unroll
                for (int bj = 0; bj < 2; ++bj) { const int col = colb + bj * HALF;
                    const v4u gw = *(const v4u*)(Gm + (size_t)row * 512 + col);
                    const f32x4 a0 = acc[ai][bj][m][0], a1 = acc[ai][bj][m][1];
                    f32x4 y0, y1;
                    y0[0] = bflo(gw.x) * sigmoidf_(a0[0]); y0[1] = bfhi(gw.x) * sigmoidf_(a0[1]); y0[2] = bflo(gw.y) * sigmoidf_(a0[2]); y0[3] = bfhi(gw.y) * sigmoidf_(a0[3]);
                    y1[0] = bflo(gw.z) * sigmoidf_(a1[0]); y1[1] = bfhi(gw.z) * sigmoidf_(a1[1]); y1[2] = bflo(gw.w) * sigmoidf_(a1[2]); y1[3] = bfhi(gw.w) * sigmoidf_(a1[3]);
                    ss += ((y0[0] * y0[0] + y0[1] * y0[1]) + (y0[2] * y0[2] + y0[3] * y0[3])) + ((y1[0] * y1[0] + y1[1] * y1[1]) + (y1[2] * y1[2] + y1[3] * y1[3]));
                    *(v4u*)(MIX + (size_t)row * D + 1024 + col) = pack8(y0, y1); }
                ss += __shfl_xor(ss, 16); ss += __shfl_xor(ss, 32);
                if (fq == 0) SS[(size_t)row * 32 + 16 + (u.c0 >> 8) * 4 + wc] = ss; }
    }
};
struct EpiWo {
    static constexpr bool PERM = true, PRE = false;
    const float* rinv; bf16* X1B; unsigned char* X18; float* part;
    __device__ __forceinline__ void operator()(AccRef acc, const Unit& u, int wr, int wc, int fr, int fq) const {
        const int row0 = u.r0 + wr * 64 + fr, col0 = u.c0 + wc * 32 + 8 * fq;
#pragma unroll
        for (int ai = 0; ai < 2; ++ai) {
            v4u xw[4][2]; float ri[4];
#pragma unroll
            for (int m = 0; m < 4; ++m) { const int row = row0 + ai * HALF + m * 16; ri[m] = rinv[row];
#pragma unroll
                for (int bj = 0; bj < 2; ++bj) xw[m][bj] = *(const v4u*)(X1B + (size_t)row * D + col0 + bj * HALF); }
#pragma unroll
            for (int m = 0; m < 4; ++m) { const int row = row0 + ai * HALF + m * 16; const size_t off = (size_t)row * D + col0; float ss = 0.f;
#pragma unroll
                for (int bj = 0; bj < 2; ++bj) { const v4u x = xw[m][bj]; const float r = ri[m];
                    f32x4 v0, v1;
                    v0[0] = bflo(x.x) * r + acc[ai][bj][m][0][0]; v0[1] = bfhi(x.x) * r + acc[ai][bj][m][0][1]; v0[2] = bflo(x.y) * r + acc[ai][bj][m][0][2]; v0[3] = bfhi(x.y) * r + acc[ai][bj][m][0][3];
                    v1[0] = bflo(x.z) * r + acc[ai][bj][m][1][0]; v1[1] = bfhi(x.z) * r + acc[ai][bj][m][1][1]; v1[2] = bflo(x.w) * r + acc[ai][bj][m][1][2]; v1[3] = bfhi(x.w) * r + acc[ai][bj][m][1][3];
                    ss += ((v0[0] * v0[0] + v0[1] * v0[1]) + (v0[2] * v0[2] + v0[3] * v0[3])) + ((v1[0] * v1[0] + v1[1] * v1[1]) + (v1[2] * v1[2] + v1[3] * v1[3]));
                    *(v4u*)(X1B + off + bj * HALF) = pack8(v0, v1);
                    v2u w8; w8.x = pk4_fp8(v0[0] * SC_X, v0[1] * SC_X, v0[2] * SC_X, v0[3] * SC_X); w8.y = pk4_fp8(v1[0] * SC_X, v1[1] * SC_X, v1[2] * SC_X, v1[3] * SC_X);
                    *(v2u*)(X18 + off + bj * HALF) = w8; }
                ss += __shfl_xor(ss, 16); ss += __shfl_xor(ss, 32);
                if (fq == 0) part[(size_t)row * 32 + (u.c0 >> 8) * 4 + wc] = ss; }
            asm volatile("" ::: "memory");
        }
    }
};
struct EpiLogit {
    static constexpr bool PERM = false, PRE = false;
    float* LP;
    __device__ __forceinline__ void operator()(AccRef acc, const Unit& u, int wr, int wc, int fr, int fq) const {
        const int row0 = u.r0 + wr * 64 + fr, col0 = wc * 32 + 4 * fq; float* base = LP + (size_t)u.aux * T * 80;
#pragma unroll
        for (int ai = 0; ai < 2; ++ai)
#pragma unroll
            for (int m = 0; m < 4; ++m) { float* rowp = base + (size_t)(row0 + ai * HALF + m * 16) * 80 + col0;
#pragma unroll
                for (int n = 0; n < 2; ++n) if (col0 + n * 16 < 80) *(f32x4*)(rowp + n * 16) = acc[ai][0][m][n]; }
    }
};
struct EpiGU {
    static constexpr bool PERM = true, PRE = true;
    const float* lrs; const LAS int* cnt; unsigned char* ACT;
    __device__ __forceinline__ void pre(const Unit& u, LAS unsigned char* tab, int tid) const {
        if (tid < 256) { const int e = u.aux, n = cnt[e]; int rr = u.r1 + tid; rr = rr < n ? rr : n - 1; ((LAS float*)tab)[tid] = lrs[(size_t)e * LCAP + rr] * (1.0f / (SC_X * SC_WGU)); }
    }
    __device__ __forceinline__ void operator()(AccRef acc, const Unit& u, int wr, int wc, int fr, int fq, const LAS unsigned char* tab) const {
        const int rb = wr * 64 + fr, colb = u.c0 * 128 + wc * 32 + 8 * fq;
#pragma unroll
        for (int ai = 0; ai < 2; ++ai)
#pragma unroll
            for (int m = 0; m < 4; ++m) { const int r = rb + ai * HALF + m * 16;
                const float rs = ((const LAS float*)tab)[r];
                f32x4 y0, y1;
#pragma unroll
                for (int j = 0; j < 4; ++j) { const float g0 = acc[ai][0][m][0][j] * rs, g1 = acc[ai][0][m][1][j] * rs;
                    y0[j] = g0 * sigmoidf_(g0) * (acc[ai][1][m][0][j] * rs) * SC_ACT; y1[j] = g1 * sigmoidf_(g1) * (acc[ai][1][m][1][j] * rs) * SC_ACT; }
                v2u w8; w8.x = pk4_fp8(y0[0], y0[1], y0[2], y0[3]); w8.y = pk4_fp8(y1[0], y1[1], y1[2], y1[3]);
                *(v2u*)(ACT + (size_t)(u.r0 + r) * DEXP + colb) = w8; }
    }
};
struct EpiDown {
    static constexpr bool PERM = true, PRE = true;
    const int* list; const float* lwt; const LAS int* cnt; unsigned char* Y2;
    __device__ __forceinline__ void pre(const Unit& u, LAS unsigned char* tab, int tid) const {
        if (tid < 256) { const int e = u.aux, n = cnt[e], r = u.r1 + tid; int ent = -1; float w = 0.f;
            if (r < n) { ent = list[(size_t)e * LCAP + r]; w = lwt[(size_t)e * LCAP + r] * (SC_Y / (SC_ACT * SC_WD)); }
            ((LAS int*)tab)[tid] = ent; ((LAS float*)tab)[256 + tid] = w; }
    }
    __device__ __forceinline__ void operator()(AccRef acc, const Unit& u, int wr, int wc, int fr, int fq, const LAS unsigned char* tab) const {
        const int rb = wr * 64 + fr, colb = u.c0 * 256 + wc * 32 + 8 * fq;
#pragma unroll
        for (int ai = 0; ai < 2; ++ai)
#pragma unroll
            for (int m = 0; m < 4; ++m) { const int r = rb + ai * HALF + m * 16; const int ent = ((const LAS int*)tab)[r]; const float w = ((const LAS float*)tab)[256 + r];
                if (ent >= 0) { unsigned char* rowp = Y2 + (size_t)ent * D + colb;
#pragma unroll
                    for (int bj = 0; bj < 2; ++bj) { const f32x4 a0 = acc[ai][bj][m][0] * w, a1 = acc[ai][bj][m][1] * w; v2u w8; w8.x = pk4_fp8(a0[0], a0[1], a0[2], a0[3]); w8.y = pk4_fp8(a1[0], a1[1], a1[2], a1[3]);
                        *(v2u*)(rowp + bj * HALF) = w8; } } }
    }
};
struct KSplitOrder {
    const char* A; const char* Bt; int lda, ldb, K, nM, nks, G, c;
    __device__ bool next(int i, Unit& u) const {
        const int L = i * G + c; if (L >= nM * nks) return false;
        const int pm = L / nks, ks = L % nks;
        u.a = A + ((size_t)pm * BM * lda + (size_t)ks * K) * 2; u.b = Bt + (size_t)ks * BM * ldb * 2; u.r0 = pm * BM; u.c0 = 0; u.aux = ks; u.r1 = 0; return true;
    }
    __device__ __forceinline__ unsigned arow(const Unit&, int) const { return 0u; }
};
}

struct Frame {
    LAS unsigned char* lds;
    unsigned* ctl;
    int tid, lane, wave, vcu, G;
    const float* const __attribute__((address_space(4)))* in;
    float* out; unsigned char* ws;
};
enum { I_X = 0, I_MEM, I_NORM_MIX, I_W_IN, I_Q_NORM, I_K_NORM, I_SINKS, I_REL_BIAS, I_LAM_RE, I_LAM_IM, I_LOG_DT, I_B_RE, I_B_IM, I_C_RE, I_C_IM, I_SSM_D, I_W_GLU,
       I_MEM_NORM, I_W_MEM_KV, I_XQ_NORM, I_XK_NORM, I_ON_ATTN, I_ON_SSM, I_ON_X, I_W_O, I_NORM_FFN, I_WR_G, I_WR_E, I_W_GATE, I_W_UP, I_W_DOWN };

struct TrItem { const float* W; bf16* WT; const float* ks; int ldw, ldt, k0, n0, drow0; };
__device__ __forceinline__ void tr_load(const TrItem& it, f32x4 (&v)[8], int lane) {
    const int kc = lane & 7, nq = lane >> 3; const float* src = it.W + (size_t)(it.k0 + kc * 8) * it.ldw + it.n0 + nq * 4;
#pragma unroll
    for (int j = 0; j < 8; ++j) v[j] = __builtin_nontemporal_load((const f32x4*)(src + (size_t)j * it.ldw));
}
__device__ __forceinline__ void tr_store(const TrItem& it, f32x4 (&v)[8], int lane) {
    const int kc = lane & 7, nq = lane >> 3;
    if (it.ks) { const f32x4 s0 = *(const f32x4*)(it.ks + it.k0 + kc * 8), s1 = *(const f32x4*)(it.ks + it.k0 + kc * 8 + 4);
#pragma unroll
        for (int j = 0; j < 4; ++j) { v[j] = v[j] * s0[j]; v[4 + j] = v[4 + j] * s1[j]; } }
#pragma unroll
    for (int i = 0; i < 4; ++i) { v4u o; o.x = pk2(v[0][i], v[1][i]); o.y = pk2(v[2][i], v[3][i]); o.z = pk2(v[4][i], v[5][i]); o.w = pk2(v[6][i], v[7][i]);
        *(v4u*)(it.WT + (size_t)(it.drow0 + nq * 4 + i) * it.ldt + it.k0 + kc * 8) = o; }
}
__device__ __forceinline__ void rms_row_to_bf16(const float* xrow, const float* gain, bf16* orow, int lane, float* rinv = nullptr) {
    const f32x4* xr = (const f32x4*)xrow + lane; const f32x4* gr = (const f32x4*)gain + lane;
    f32x4 v[8]; float s = 0.f;
#pragma unroll
    for (int j = 0; j < 8; ++j) { v[j] = xr[64 * j]; s += (v[j].x * v[j].x + v[j].y * v[j].y) + (v[j].z * v[j].z + v[j].w * v[j].w); }
    const float ms = wave_sum(s) * (1.f / 2048.f) + EPS; const float rstd = 1.0f / sqrtf(ms);
    if (rinv && lane == 0) *rinv = sqrtf(ms);
    v2u* o8 = (v2u*)orow + lane;
#pragma unroll
    for (int j = 0; j < 8; ++j) { const f32x4 g = gain ? gr[64 * j] : (f32x4){1.f, 1.f, 1.f, 1.f}; v2u w; w.x = pk2(v[j].x * rstd * g.x, v[j].y * rstd * g.y); w.y = pk2(v[j].z * rstd * g.z, v[j].w * rstd * g.w); o8[64 * j] = w; }
}

__device__ __forceinline__ void s5_tables(Frame& F, int g) {
    LAS float* ap = (LAS float*)F.lds;
    LAS float* Bb = ap + 33 * 64 * 2;
    LAS float* Cc = Bb + 64 * 16 * 2;
    LAS float* Km = Cc + 16 * 64 * 2;
    const float dt = expf(F.in[I_LOG_DT][g]);
    const float* lre = F.in[I_LAM_RE] + g * 64; const float* lim = F.in[I_LAM_IM] + g * 64;
    for (int idx = F.tid; idx < 33 * 64; idx += 512) { const int tau = idx >> 6, n = idx & 63; const float lr = lre[n], li = lim[n];
        const float mag = expf((float)tau * (lr * dt)), ang = (float)tau * (li * dt); ap[idx * 2] = mag * cosf(ang); ap[idx * 2 + 1] = mag * sinf(ang); }
    __syncthreads();
    for (int idx = F.tid; idx < 64 * 16; idx += 512) { const int n = idx >> 4; const float lr = lre[n], li = lim[n];
        const float nr = ap[(64 + n) * 2] - 1.0f, ni = ap[(64 + n) * 2 + 1], den = lr * lr + li * li;
        const float cr = (nr * lr + ni * li) / den, ci = (ni * lr - nr * li) / den;
        const float br = F.in[I_B_RE][(size_t)g * 1024 + idx], bi = F.in[I_B_IM][(size_t)g * 1024 + idx];
        Bb[idx * 2] = cr * br - ci * bi; Bb[idx * 2 + 1] = cr * bi + ci * br; }
    for (int idx = F.tid; idx < 16 * 64; idx += 512) { Cc[idx * 2] = F.in[I_C_RE][(size_t)g * 1024 + idx]; Cc[idx * 2 + 1] = F.in[I_C_IM][(size_t)g * 1024 + idx]; }
    __syncthreads();
    for (int idx = F.tid; idx < 32 * 256; idx += 512) { const int tau = idx >> 8, c = (idx >> 4) & 15, c2 = idx & 15; float s = 0.f;
        for (int n = 0; n < 64; ++n) { const float ar = ap[(tau * 64 + n) * 2], ai = ap[(tau * 64 + n) * 2 + 1], cr = Cc[(c * 64 + n) * 2], ci = Cc[(c * 64 + n) * 2 + 1];
            const float er = cr * ar - ci * ai, ei = cr * ai + ci * ar; s += er * Bb[(n * 16 + c2) * 2] - ei * Bb[(n * 16 + c2) * 2 + 1]; }
        Km[idx] = s; }
    __syncthreads();
    bf16* MQ = (bf16*)(F.ws + WS_MQ) + (size_t)g * 512 * S5K;
    for (int idx = F.tid; idx < 512 * 80; idx += 512) { const int row = idx / 80, ch = idx % 80, i = row >> 4, c = row & 15, k0 = ch * 8; float v[8];
        if (k0 < 512) { const int s = k0 >> 4, c20 = k0 & 15, tau = i - s;
#pragma unroll
            for (int j = 0; j < 8; ++j) v[j] = tau >= 0 ? Km[(tau * 16 + c) * 16 + c20 + j] : 0.f;
        } else { const int kk = k0 - 512, ri = kk >> 6, n0 = kk & 63;
#pragma unroll
            for (int j = 0; j < 8; ++j) { const int n = n0 + j; const float ar = ap[((i + 1) * 64 + n) * 2], ai = ap[((i + 1) * 64 + n) * 2 + 1], cr = Cc[(c * 64 + n) * 2], ci = Cc[(c * 64 + n) * 2 + 1];
                v[j] = ri == 0 ? (cr * ar - ci * ai) : -(cr * ai + ci * ar); } }
        v4u o; o.x = pk2(v[0], v[1]); o.y = pk2(v[2], v[3]); o.z = pk2(v[4], v[5]); o.w = pk2(v[6], v[7]);
        *(v4u*)(MQ + (size_t)row * S5K + k0) = o; }
    bf16* SP = (bf16*)(F.ws + WS_SP) + (size_t)g * 256 * 512;
    for (int idx = F.tid; idx < 256 * 64; idx += 512) { const int row = idx >> 6, k0 = (idx & 63) * 8; float v[8];
        if (row < 128) { const int ri = row >> 6, n = row & 63, s = k0 >> 4, c20 = k0 & 15; const float ar = ap[((31 - s) * 64 + n) * 2], ai = ap[((31 - s) * 64 + n) * 2 + 1];
#pragma unroll
            for (int j = 0; j < 8; ++j) { const float br = Bb[(n * 16 + c20 + j) * 2], bi = Bb[(n * 16 + c20 + j) * 2 + 1]; v[j] = ri == 0 ? (ar * br - ai * bi) : (ar * bi + ai * br); }
        } else {
#pragma unroll
            for (int j = 0; j < 8; ++j) v[j] = 0.f; }
        v4u o; o.x = pk2(v[0], v[1]); o.y = pk2(v[2], v[3]); o.z = pk2(v[4], v[5]); o.w = pk2(v[6], v[7]);
        *(v4u*)(SP + (size_t)row * 512 + k0) = o; }
    float* AL = (float*)(F.ws + WS_AL) + g * 128;
    if (F.tid < 64) { AL[F.tid * 2] = ap[(32 * 64 + F.tid) * 2]; AL[F.tid * 2 + 1] = ap[(32 * 64 + F.tid) * 2 + 1]; }
    __syncthreads();
}

struct BigTile { const float* src; unsigned char* dst; const float* ks; float sc; int ldw, ldt; };
constexpr int BT_GU = 64 * 2 * 64, BT_D = 64 * 64, BT_N = BT_GU + BT_D, BT_PITCH = 136;
__device__ __forceinline__ BigTile bt_decode(const Frame& F, unsigned char* Wgu8, unsigned char* Wd8, const float* nf, int ti) {
    BigTile t;
    const unsigned long long pg = (unsigned long long)F.in[I_W_GATE], pu = (unsigned long long)F.in[I_W_UP], pd = (unsigned long long)F.in[I_W_DOWN];
    if (ti < BT_GU) { const int e = ti >> 7, r = ti & 127, which = r >> 6, kb = (r >> 2) & 15, nb = r & 3;
        const unsigned long long p = pg + ((pu - pg) & (0ull - (unsigned long long)which));
        t.src = (const float*)p + (size_t)e * D * DEXP + (size_t)kb * 128 * DEXP + nb * 128; t.dst = Wgu8 + ((size_t)e * 1024 + nb * 256 + which * 128) * D + kb * 128; t.ks = nf + kb * 128; t.sc = SC_WGU; t.ldw = DEXP; t.ldt = D; }
    else { const int t2 = ti - BT_GU, e = t2 >> 6, r = t2 & 63, kb = r >> 4, nb = r & 15;
        t.src = (const float*)pd + (size_t)e * DEXP * D + (size_t)kb * 128 * D + nb * 128; t.dst = Wd8 + ((size_t)e * D + nb * 128) * DEXP + kb * 128; t.ks = nullptr; t.sc = SC_WD; t.ldw = D; t.ldt = DEXP; }
    return t;
}
#define BT_LOAD(t, v, kv) do { const unsigned _lo = (unsigned)(rl * 8 * (t).ldw + cq * 4); \
    _Pragma("unroll") for (int _p = 0; _p < 8; ++_p) kv[_p] = (t).ks ? (t).ks[rl * 8 + _p] * (t).sc : (t).sc; \
    _Pragma("unroll") for (int _p = 0; _p < 8; ++_p) v[_p] = __builtin_nontemporal_load((const f32x4*)((t).src + (size_t)_p * (t).ldw + _lo)); } while (0)
#define BT_STORE(t, v, kv) do { \
    _Pragma("unroll") for (int _i = 0; _i < 4; ++_i) { v2u _w; _w.x = pk4_fp8(v[0][_i] * kv[0], v[1][_i] * kv[1], v[2][_i] * kv[2], v[3][_i] * kv[3]); _w.y = pk4_fp8(v[4][_i] * kv[4], v[5][_i] * kv[5], v[6][_i] * kv[6], v[7][_i] * kv[7]); \
        *(LAS v2u*)(img + (cq * 4 + _i) * BT_PITCH + rl * 8) = _w; } \
    __syncthreads(); \
    _Pragma("unroll") for (int _j = 0; _j < 2; ++_j) { const int _idx = tid_ + _j * 512, _n = _idx >> 3, _ch = _idx & 7; \
        const v2u _a = *(const LAS v2u*)(img + _n * BT_PITCH + _ch * 16), _b = *(const LAS v2u*)(img + _n * BT_PITCH + _ch * 16 + 8); v4u _o; _o.x = _a.x; _o.y = _a.y; _o.z = _b.x; _o.w = _b.y; \
        *(v4u*)((t).dst + (size_t)_n * (t).ldt + _ch * 16) = _o; } \
    __syncthreads(); } while (0)
__device__ __forceinline__ void bg_convert(Frame& F, int qword, int base, int ntiles, int budget) {
    if (budget <= 0) return;
    int lane_ = (int)__builtin_amdgcn_mbcnt_hi(~0u, __builtin_amdgcn_mbcnt_lo(~0u, 0u)); asm volatile("" : "+v"(lane_)); const int tid_ = F.wave * 64 + lane_;
    unsigned char* WguT = F.ws + WS_WGU; unsigned char* WdT = F.ws + WS_WD; const float* nf = F.in[I_NORM_FFN];
    const int rl = tid_ >> 5, cq = tid_ & 31; LAS unsigned char* img = F.lds; LAS int* qn = (LAS int*)(F.lds + TAB_OFF + 1024);
    f32x4 va[8], vb[8]; float ka[8], kb[8];
    int nfetch = 0;
#define BG_FETCH(slot) do { if (nfetch < budget) { if (tid_ == 0) qn[slot] = (int)atomicAdd(F.ctl + qword, 1u); } else if (tid_ == 0) qn[slot] = 0x7fffffff; ++nfetch; } while (0)
    __syncthreads();
    BG_FETCH(0); BG_FETCH(1);
    __syncthreads();
    int i0 = __builtin_amdgcn_readfirstlane(qn[0]), i1 = __builtin_amdgcn_readfirstlane(qn[1]);
    __syncthreads();
    if (i0 < ntiles) { const BigTile t0 = bt_decode(F, WguT, WdT, nf, base + i0); BT_LOAD(t0, va, ka); }
    while (i0 < ntiles) {
        const BigTile ta = bt_decode(F, WguT, WdT, nf, base + i0);
        const BigTile tb = bt_decode(F, WguT, WdT, nf, base + (i1 < ntiles ? i1 : i0));
        BT_LOAD(tb, vb, kb);
        if (i1 >= ntiles) budget = 0;
        BG_FETCH(0);
        BT_STORE(ta, va, ka);
        const int i2 = __builtin_amdgcn_readfirstlane(qn[0]);
        if (i1 >= ntiles) break;
        const BigTile tc = bt_decode(F, WguT, WdT, nf, base + (i2 < ntiles ? i2 : i1));
        BT_LOAD(tc, va, ka);
        if (i2 >= ntiles) budget = 0;
        BG_FETCH(1);
        BT_STORE(tb, vb, kb);
        const int i3 = __builtin_amdgcn_readfirstlane(qn[1]);
        i0 = i2; i1 = i3;
    }
    __syncthreads();
#undef BG_FETCH
}
__device__ __forceinline__ void p0_prologue(Frame& F) {
    if (F.vcu < 32) s5_tables(F, F.vcu);
    const int gw = F.vcu * 8 + F.wave, NGW = F.G * 8;
    bf16* WinT = (bf16*)(F.ws + WS_WIN); bf16* WoT = (bf16*)(F.ws + WS_WO); bf16* WmkvT = (bf16*)(F.ws + WS_WMKV); bf16* WgluT = (bf16*)(F.ws + WS_WGLU);
    const float* nf = F.in[I_NORM_FFN];
    constexpr int I_IN = 32 * 72, I_O = 32 * 64, I_MKV = 32 * 32, I_GLU = 8 * 16;
    constexpr int NITEMS = I_IN + I_O + I_MKV + I_GLU;
    auto decode = [&](int it) -> TrItem {
        int r = it;
        if (r < I_IN) { const int kb = r / 72, nb = r % 72; return TrItem{F.in[I_W_IN], WinT, F.in[I_NORM_MIX]  , INC, D, kb * 64, nb * 32, nb * 32}; } r -= I_IN;
        if (r < I_O) { const int kb = r / 64, nb = r % 64, k0 = kb * 64;
            const unsigned long long pa = (unsigned long long)F.in[I_ON_ATTN], ps = (unsigned long long)(F.in[I_ON_SSM] - 1024), px = (unsigned long long)(F.in[I_ON_X] - 1536);
            const unsigned long long m1 = 0ull - (unsigned long long)(k0 >= 1024), m2 = 0ull - (unsigned long long)(k0 >= 1536);
            const unsigned long long pk = pa + ((ps - pa) & m1) + ((px - ps) & m2);
            return TrItem{F.in[I_W_O], WoT, (const float*)pk, D, D, k0, nb * 32, nb * 32}; } r -= I_O;
        if (r < I_MKV) { const int kb = r / 32, nb = r % 32; return TrItem{F.in[I_W_MEM_KV], WmkvT, nullptr, 1024, D, kb * 64, nb * 32, nb * 32}; } r -= I_MKV;
        const int kb = r / 16, nb = r % 16; return TrItem{F.in[I_W_GLU], WgluT, nullptr, 512, 512, kb * 64, nb * 32, nb * 32};
    };
    {
        f32x4 va[8], vb[8]; int it = gw; TrItem ia, ib;
        if (it < NITEMS) { ia = decode(it); tr_load(ia, va, F.lane); }
        while (it < NITEMS) {
            const int it2 = it + NGW; if (it2 < NITEMS) { ib = decode(it2); tr_load(ib, vb, F.lane); }
            tr_store(ia, va, F.lane);
            if (it2 >= NITEMS) break;
            const int it3 = it2 + NGW; if (it3 < NITEMS) { ia = decode(it3); tr_load(ia, va, F.lane); }
            tr_store(ib, vb, F.lane);
            it = it3;
        }
    }
    { bf16* WrT = (bf16*)(F.ws + WS_WR); const int gt = F.vcu * 512 + F.tid, NT = F.G * 512;
      for (int idx = gt; idx < 4 * 256 * 512; idx += NT) { const int ks = idx >> 17, n = (idx >> 9) & 255, k = ks * 512 + (idx & 511); float v = 0.f;
          if (n < 8) v = F.in[I_WR_G][k * 8 + n] * nf[k]; else if (n < 72) v = F.in[I_WR_E][k * 64 + (n - 8)] * nf[k];
          WrT[idx] = (bf16)f2bf(v); } }
    bf16* XN = (bf16*)(F.ws + WS_XN); bf16* MEMN = (bf16*)(F.ws + WS_MEMN);
    for (int m = gw; m < T; m += NGW) rms_row_to_bf16(F.in[I_X] + (size_t)m * D, nullptr, XN + (size_t)m * D, F.lane, (float*)(F.ws + WS_RINV) + m);
    for (int m = gw; m < NB * MEML; m += NGW) rms_row_to_bf16(F.in[I_MEM] + (size_t)m * D, F.in[I_MEM_NORM], MEMN + (size_t)m * D, F.lane);
    bg_convert(F, CW_QGU, 0, BT_GU, F.vcu < 32 ? PB0_S5 : PB0);
    bg_convert(F, CW_QD, BT_GU, BT_D, PB0_D);
}

constexpr int SWA_KS = 72, SWA_VS = 264;
constexpr int SWA_KOFF = 0, SWA_VOFF = 256 * SWA_KS * 2, SWA_BOFF = SWA_VOFF + 64 * SWA_VS * 2;
__device__ __forceinline__ int t5_bucket(int n) { if (n < 16) return n; const int v = 16 + (int)(logf((float)n * (1.0f / 16.0f)) / logf(8.0f) * 16.0f); return v < 31 ? v : 31; }
__device__ __forceinline__ void swa_unit(Frame& F, int unit) {
    const int b = unit >> 5, kvh = (unit >> 4) & 1, nb = unit & 15;
    const bf16* PROJ = (const bf16*)(F.ws + WS_PROJ); bf16* MIX = (bf16*)(F.ws + WS_MIX);
    LAS bf16* Ks = (LAS bf16*)(F.lds + SWA_KOFF); LAS bf16* Vt = (LAS bf16*)(F.lds + SWA_VOFF); LAS float* bt = (LAS float*)(F.lds + SWA_BOFF);
    const int w = F.wave, h = kvh * 8 + w, ql = F.lane & 31, hh = F.lane >> 5;
    v4u qnx[4];
    { const bf16* qp = PROJ + ((size_t)b * SEQ + nb * 128 + ql) * INC + h * 64 + 8 * hh;
#pragma unroll
      for (int ks = 0; ks < 4; ++ks) qnx[ks] = *(const v4u*)(qp + ks * 16); }
    __syncthreads();
    {
        const int key = F.tid >> 1, half = F.tid & 1, s = (nb - 1) * 128 + key;
        v4u kw[4], vw[4];
        if (s >= 0) { const bf16* rp = PROJ + (size_t)(b * SEQ + s) * INC + 1024 + kvh * 64 + half * 32;
#pragma unroll
            for (int j = 0; j < 4; ++j) { kw[j] = *(const v4u*)(rp + j * 8); vw[j] = *(const v4u*)(rp + 128 + j * 8); }
        } else {
#pragma unroll
            for (int j = 0; j < 4; ++j) { kw[j] = (v4u){0u, 0u, 0u, 0u}; vw[j] = (v4u){0u, 0u, 0u, 0u}; } }
        float kf[32]; float ss = 0.f;
#pragma unroll
        for (int j = 0; j < 4; ++j) { kf[j * 8 + 0] = bflo(kw[j].x); kf[j * 8 + 1] = bfhi(kw[j].x); kf[j * 8 + 2] = bflo(kw[j].y); kf[j * 8 + 3] = bfhi(kw[j].y);
            kf[j * 8 + 4] = bflo(kw[j].z); kf[j * 8 + 5] = bfhi(kw[j].z); kf[j * 8 + 6] = bflo(kw[j].w); kf[j * 8 + 7] = bfhi(kw[j].w); }
#pragma unroll
        for (int j = 0; j < 32; ++j) ss += kf[j] * kf[j];
        ss += __shfl_xor(ss, 1);
        const float rstd = 1.0f / sqrtf(ss * (1.f / 64.f) + EPS);
        const float* kn = F.in[I_K_NORM] + half * 32;
#pragma unroll
        for (int j = 0; j < 4; ++j) { v4u o; o.x = pk2(kf[j * 8 + 0] * rstd * kn[j * 8 + 0], kf[j * 8 + 1] * rstd * kn[j * 8 + 1]); o.y = pk2(kf[j * 8 + 2] * rstd * kn[j * 8 + 2], kf[j * 8 + 3] * rstd * kn[j * 8 + 3]);
            o.z = pk2(kf[j * 8 + 4] * rstd * kn[j * 8 + 4], kf[j * 8 + 5] * rstd * kn[j * 8 + 5]); o.w = pk2(kf[j * 8 + 6] * rstd * kn[j * 8 + 6], kf[j * 8 + 7] * rstd * kn[j * 8 + 7]);
            *(LAS v4u*)(Ks + key * SWA_KS + half * 32 + j * 8) = o; }
#pragma unroll
        for (int j = 0; j < 4; ++j) { const unsigned w4[4] = {vw[j].x, vw[j].y, vw[j].z, vw[j].w};
#pragma unroll
            for (int q = 0; q < 4; ++q) { const int d = half * 32 + j * 8 + q * 2; Vt[d * SWA_VS + key] = (bf16)(w4[q] & 0xffffu); Vt[(d + 1) * SWA_VS + key] = (bf16)(w4[q] >> 16); } }
        for (int idx = F.tid; idx < 8 * 128; idx += 512) { const int w = idx >> 7, dl = idx & 127; bt[idx] = F.in[I_REL_BIAS][t5_bucket(dl) * 16 + kvh * 8 + w]; }
    }
    __syncthreads();
    const float sink = F.in[I_SINKS][h];
    const float* qn = F.in[I_Q_NORM];
    for (int r = 0; r < 4; ++r) {
        const int qi = 32 * r + ql; const size_t t = (size_t)b * SEQ + nb * 128 + qi;
        bf16x8 qf[4];
        {   v4u qw[4]; float qv[32]; float ss = 0.f;
#pragma unroll
            for (int ks = 0; ks < 4; ++ks) qw[ks] = qnx[ks];
            if (r < 3) { const bf16* qp = PROJ + (t + 32) * INC + h * 64 + 8 * hh;
#pragma unroll
                for (int ks = 0; ks < 4; ++ks) qnx[ks] = *(const v4u*)(qp + ks * 16); }
#pragma unroll
            for (int ks = 0; ks < 4; ++ks) { qv[ks * 8 + 0] = bflo(qw[ks].x); qv[ks * 8 + 1] = bfhi(qw[ks].x); qv[ks * 8 + 2] = bflo(qw[ks].y); qv[ks * 8 + 3] = bfhi(qw[ks].y);
                qv[ks * 8 + 4] = bflo(qw[ks].z); qv[ks * 8 + 5] = bfhi(qw[ks].z); qv[ks * 8 + 6] = bflo(qw[ks].w); qv[ks * 8 + 7] = bfhi(qw[ks].w); }
#pragma unroll
            for (int j = 0; j < 32; ++j) ss += qv[j] * qv[j];
            ss += __shfl_xor(ss, 32);
            const float sc = 0.125f / sqrtf(ss * (1.f / 64.f) + EPS);
#pragma unroll
            for (int ks = 0; ks < 4; ++ks) { const float* g = qn + ks * 16 + 8 * hh; v4u o;
                o.x = pk2(qv[ks * 8 + 0] * sc * g[0], qv[ks * 8 + 1] * sc * g[1]); o.y = pk2(qv[ks * 8 + 2] * sc * g[2], qv[ks * 8 + 3] * sc * g[3]);
                o.z = pk2(qv[ks * 8 + 4] * sc * g[4], qv[ks * 8 + 5] * sc * g[5]); o.w = pk2(qv[ks * 8 + 6] * sc * g[6], qv[ks * 8 + 7] * sc * g[7]);
                qf[ks] = __builtin_bit_cast(bf16x8, o); } }
        f32x16 s[5];
        const int qh = ql - 4 * hh; const LAS float* pb = bt + w * 128 + qh;
        float mx = sink;
#pragma unroll
        for (int kt = 0; kt < 5; ++kt) {
            const bool live = (nb > 0) || (r + kt >= 4);
            f32x16 a = {0.f, 0.f, 0.f, 0.f, 0.f, 0.f, 0.f, 0.f, 0.f, 0.f, 0.f, 0.f, 0.f, 0.f, 0.f, 0.f};
            if (live) {
#pragma unroll
                for (int ks = 0; ks < 4; ++ks) { const bf16x8 kfrag = *(const LAS bf16x8*)(Ks + (32 * (r + kt) + ql) * SWA_KS + ks * 16 + 8 * hh);
                    a = __builtin_amdgcn_mfma_f32_32x32x16_bf16(kfrag, qf[ks], a, 0, 0, 0); }
#pragma unroll
                for (int rg = 0; rg < 16; ++rg) { const int rowc = (rg & 3) + 8 * (rg >> 2);
                    float v = a[rg] + pb[128 - 32 * kt - rowc];
                    if (kt == 0) v = (rowc > qh) ? v : -1e30f;
                    if (kt == 4) v = (rowc <= qh) ? v : -1e30f;
                    a[rg] = v; mx = fmaxf(mx, v); }
            } else {
#pragma unroll
                for (int rg = 0; rg < 16; ++rg) a[rg] = -1e30f;
            }
            s[kt] = a; }
        mx = fmaxf(mx, __shfl_xor(mx, 32));
        float l = 0.f;
#pragma unroll
        for (int kt = 0; kt < 5; ++kt)
#pragma unroll
            for (int rg = 0; rg < 16; ++rg) { const float p = fast_exp(s[kt][rg] - mx); s[kt][rg] = p; l += p; }
        l += __shfl_xor(l, 32);
        l += fast_exp(sink - mx);
        f32x16 o[2];
#pragma unroll
        for (int dt = 0; dt < 2; ++dt) o[dt] = (f32x16){0.f, 0.f, 0.f, 0.f, 0.f, 0.f, 0.f, 0.f, 0.f, 0.f, 0.f, 0.f, 0.f, 0.f, 0.f, 0.f};
#pragma unroll
        for (int kt = 0; kt < 5; ++kt)
#pragma unroll
            for (int st = 0; st < 2; ++st) { v4u pw; pw.x = pk2(s[kt][8 * st + 0], s[kt][8 * st + 1]); pw.y = pk2(s[kt][8 * st + 2], s[kt][8 * st + 3]); pw.z = pk2(s[kt][8 * st + 4], s[kt][8 * st + 5]); pw.w = pk2(s[kt][8 * st + 6], s[kt][8 * st + 7]);
                const bf16x8 pf = __builtin_bit_cast(bf16x8, pw);
#pragma unroll
                for (int dt = 0; dt < 2; ++dt) { const LAS bf16* vp = Vt + (dt * 32 + ql) * SWA_VS + 32 * (r + kt) + 16 * st + 4 * hh;
                    const v2u lo = *(const LAS v2u*)vp, hi = *(const LAS v2u*)(vp + 8); v4u vv; vv.x = lo.x; vv.y = lo.y; vv.z = hi.x; vv.w = hi.y;
                    o[dt] = __builtin_amdgcn_mfma_f32_32x32x16_bf16(__builtin_bit_cast(bf16x8, vv), pf, o[dt], 0, 0, 0); } }
        const float inv = 1.0f / l;
        { float ssq = 0.f;
#pragma unroll
          for (int dt = 0; dt < 2; ++dt)
#pragma unroll
              for (int rg = 0; rg < 16; ++rg) { const float v = o[dt][rg] * inv; ssq += v * v; }
          ssq += __shfl_xor(ssq, 32);
          if (hh == 0) ((float*)(F.ws + WS_SS))[t * 32 + h] = ssq; }
        bf16* op = MIX + t * D + h * 64 + 4 * hh;
#pragma unroll
        for (int dt = 0; dt < 2; ++dt)
#pragma unroll
            for (int q4 = 0; q4 < 4; ++q4) { v2u ow; ow.x = pk2(o[dt][q4 * 4 + 0] * inv, o[dt][q4 * 4 + 1] * inv); ow.y = pk2(o[dt][q4 * 4 + 2] * inv, o[dt][q4 * 4 + 3] * inv);
                *(v2u*)(op + dt * 32 + q4 * 8) = ow; }
    }
}

constexpr int XA_KS = 136, XA_VS = 264;
constexpr int XA_KOFF = 0, XA_VOFF = 256 * XA_KS * 2;
__device__ __forceinline__ void xattn_unit(Frame& F, int unit) {
    const int b = unit >> 5, hx = (unit >> 3) & 3, qb = unit & 7;
    const bf16* PROJ = (const bf16*)(F.ws + WS_PROJ); const bf16* MKV = (const bf16*)(F.ws + WS_MEMKV); bf16* MIX = (bf16*)(F.ws + WS_MIX);
    LAS bf16* Ks = (LAS bf16*)(F.lds + XA_KOFF); LAS bf16* Vt = (LAS bf16*)(F.lds + XA_VOFF);
    __syncthreads();
    {   const int key = F.tid >> 1, half = F.tid & 1; const bf16* rp = MKV + (size_t)(b * MEML + key) * 1024 + hx * 128 + half * 64;
        float ss = 0.f; v4u kw[8];
#pragma unroll
        for (int j = 0; j < 8; ++j) { kw[j] = *(const v4u*)(rp + j * 8);
            const float a0 = bflo(kw[j].x), a1 = bfhi(kw[j].x), a2 = bflo(kw[j].y), a3 = bfhi(kw[j].y), a4 = bflo(kw[j].z), a5 = bfhi(kw[j].z), a6 = bflo(kw[j].w), a7 = bfhi(kw[j].w);
            ss += (a0 * a0 + a1 * a1) + (a2 * a2 + a3 * a3) + (a4 * a4 + a5 * a5) + (a6 * a6 + a7 * a7); }
        ss += __shfl_xor(ss, 1);
        const float rstd = 1.0f / sqrtf(ss * (1.f / 128.f) + EPS);
        const float* kn = F.in[I_XK_NORM] + half * 64;
#pragma unroll
        for (int j = 0; j < 8; ++j) { v4u o; const float* g = kn + j * 8;
            o.x = pk2(bflo(kw[j].x) * rstd * g[0], bfhi(kw[j].x) * rstd * g[1]); o.y = pk2(bflo(kw[j].y) * rstd * g[2], bfhi(kw[j].y) * rstd * g[3]);
            o.z = pk2(bflo(kw[j].z) * rstd * g[4], bfhi(kw[j].z) * rstd * g[5]); o.w = pk2(bflo(kw[j].w) * rstd * g[6], bfhi(kw[j].w) * rstd * g[7]);
            *(LAS v4u*)(Ks + key * XA_KS + half * 64 + j * 8) = o; }
#pragma unroll
        for (int j = 0; j < 8; ++j) { const v4u vw = *(const v4u*)(rp + 512 + j * 8); const unsigned w4[4] = {vw.x, vw.y, vw.z, vw.w};
#pragma unroll
            for (int q = 0; q < 4; ++q) { const int d = half * 64 + j * 8 + q * 2; Vt[d * XA_VS + key] = (bf16)(w4[q] & 0xffffu); Vt[(d + 1) * XA_VS + key] = (bf16)(w4[q] >> 16); } }
    }
    __syncthreads();
    const int ql = F.lane & 31, hh = F.lane >> 5;
    const size_t t = (size_t)b * SEQ + qb * 256 + F.wave * 32 + ql;
    bf16x8 qf[8];
    {   const bf16* qp = PROJ + t * INC + 1792 + hx * 128 + 8 * hh; v4u qw[8]; float ss = 0.f;
#pragma unroll
        for (int ks = 0; ks < 8; ++ks) { qw[ks] = *(const v4u*)(qp + ks * 16);
            const float a0 = bflo(qw[ks].x), a1 = bfhi(qw[ks].x), a2 = bflo(qw[ks].y), a3 = bfhi(qw[ks].y), a4 = bflo(qw[ks].z), a5 = bfhi(qw[ks].z), a6 = bflo(qw[ks].w), a7 = bfhi(qw[ks].w);
            ss += (a0 * a0 + a1 * a1) + (a2 * a2 + a3 * a3) + (a4 * a4 + a5 * a5) + (a6 * a6 + a7 * a7); }
        ss += __shfl_xor(ss, 32);
        const float sc = 0.08838834764831845f / sqrtf(ss * (1.f / 128.f) + EPS);
        const float* qn = F.in[I_XQ_NORM] + 8 * hh;
#pragma unroll
        for (int ks = 0; ks < 8; ++ks) { const float* g = qn + ks * 16; v4u o;
            o.x = pk2(bflo(qw[ks].x) * sc * g[0], bfhi(qw[ks].x) * sc * g[1]); o.y = pk2(bflo(qw[ks].y) * sc * g[2], bfhi(qw[ks].y) * sc * g[3]);
            o.z = pk2(bflo(qw[ks].z) * sc * g[4], bfhi(qw[ks].z) * sc * g[5]); o.w = pk2(bflo(qw[ks].w) * sc * g[6], bfhi(qw[ks].w) * sc * g[7]);
            qf[ks] = __builtin_bit_cast(bf16x8, o); } }
    f32x16 o[4];
#pragma unroll
    for (int dt = 0; dt < 4; ++dt) o[dt] = (f32x16){0.f, 0.f, 0.f, 0.f, 0.f, 0.f, 0.f, 0.f, 0.f, 0.f, 0.f, 0.f, 0.f, 0.f, 0.f, 0.f};
    float mrun = -1e30f, lrun = 0.f;
    for (int kb = 0; kb < 4; ++kb) {
        f32x16 s[2];
#pragma unroll
        for (int kt = 0; kt < 2; ++kt) { f32x16 a = {0.f, 0.f, 0.f, 0.f, 0.f, 0.f, 0.f, 0.f, 0.f, 0.f, 0.f, 0.f, 0.f, 0.f, 0.f, 0.f};
#pragma unroll
            for (int ks = 0; ks < 8; ++ks) { const bf16x8 kfrag = *(const LAS bf16x8*)(Ks + (64 * kb + 32 * kt + ql) * XA_KS + ks * 16 + 8 * hh);
                a = __builtin_amdgcn_mfma_f32_32x32x16_bf16(kfrag, qf[ks], a, 0, 0, 0); }
            s[kt] = a; }
        float mx = mrun;
#pragma unroll
        for (int kt = 0; kt < 2; ++kt)
#pragma unroll
            for (int rg = 0; rg < 16; ++rg) mx = fmaxf(mx, s[kt][rg]);
        mx = fmaxf(mx, __shfl_xor(mx, 32));
        const float alpha = fast_exp(mrun - mx); mrun = mx;
        float ls = 0.f;
#pragma unroll
        for (int kt = 0; kt < 2; ++kt)
#pragma unroll
            for (int rg = 0; rg < 16; ++rg) { const float p = fast_exp(s[kt][rg] - mx); s[kt][rg] = p; ls += p; }
        lrun = lrun * alpha + ls;
#pragma unroll
        for (int dt = 0; dt < 4; ++dt)
#pragma unroll
            for (int rg = 0; rg < 16; ++rg) o[dt][rg] *= alpha;
#pragma unroll
        for (int kt = 0; kt < 2; ++kt)
#pragma unroll
            for (int st = 0; st < 2; ++st) { v4u pw; pw.x = pk2(s[kt][8 * st + 0], s[kt][8 * st + 1]); pw.y = pk2(s[kt][8 * st + 2], s[kt][8 * st + 3]); pw.z = pk2(s[kt][8 * st + 4], s[kt][8 * st + 5]); pw.w = pk2(s[kt][8 * st + 6], s[kt][8 * st + 7]);
                const bf16x8 pf = __builtin_bit_cast(bf16x8, pw);
#pragma unroll
                for (int dt = 0; dt < 4; ++dt) { const LAS bf16* vp = Vt + (dt * 32 + ql) * XA_VS + 64 * kb + 32 * kt + 16 * st + 4 * hh;
                    const v2u lo = *(const LAS v2u*)vp, hi = *(const LAS v2u*)(vp + 8); v4u vv; vv.x = lo.x; vv.y = lo.y; vv.z = hi.x; vv.w = hi.y;
                    o[dt] = __builtin_amdgcn_mfma_f32_32x32x16_bf16(__builtin_bit_cast(bf16x8, vv), pf, o[dt], 0, 0, 0); } }
    }
    lrun += __shfl_xor(lrun, 32);
    const float inv = 1.0f / lrun;
    { float ssq = 0.f;
#pragma unroll
      for (int dt = 0; dt < 4; ++dt)
#pragma unroll
          for (int rg = 0; rg < 16; ++rg) { const float v = o[dt][rg] * inv; ssq += v * v; }
      ssq += __shfl_xor(ssq, 32);
      if (hh == 0) ((float*)(F.ws + WS_SS))[t * 32 + 24 + hx] = ssq; }
    bf16* op = MIX + t * D + 1536 + hx * 128 + 4 * hh;
#pragma unroll
    for (int dt = 0; dt < 4; ++dt)
#pragma unroll
        for (int q4 = 0; q4 < 4; ++q4) { v2u ow; ow.x = pk2(o[dt][q4 * 4 + 0] * inv, o[dt][q4 * 4 + 1] * inv); ow.y = pk2(o[dt][q4 * 4 + 2] * inv, o[dt][q4 * 4 + 3] * inv);
            *(v2u*)(op + dt * 32 + q4 * 8) = ow; }
}

__device__ __forceinline__ void moe_tables(Frame& F) {
    LAS int* cnt = (LAS int*)(F.lds + TAB_OFF); LAS int* ts = cnt + 64;
    __syncthreads();
    if (F.tid < 64) { const int c = (int)__hip_atomic_load(F.ctl + CW_CNT + F.tid, __ATOMIC_RELAXED, __HIP_MEMORY_SCOPE_AGENT); const int nt = (c + 255) >> 8; int inc = nt;
#pragma unroll
        for (int o = 1; o < 64; o <<= 1) { const int v = __shfl_up(inc, o); if (F.tid >= o) inc += v; }
        cnt[F.tid] = c; ts[F.tid + 1] = inc; if (F.tid == 0) ts[0] = 0; }
    __syncthreads();
}

struct Args { const float* in[31]; float* out; unsigned char* ws; int ph_lo, ph_hi; };
__global__ void __launch_bounds__(512, 2) hymba_fwd(Args args) {
    extern __shared__ __attribute__((aligned(16))) unsigned char lds_raw[];
    Frame F;
    F.lds = (LAS unsigned char*)lds_raw;
    F.tid = threadIdx.x; F.lane = F.tid & 63; F.wave = __builtin_amdgcn_readfirstlane(F.tid >> 6);
    F.G = gridDim.x; { const int bx = blockIdx.x; F.vcu = (F.G % 8 == 0) ? (bx % 8) * (F.G / 8) + bx / 8 : bx; }
    F.in = (const float* const __attribute__((address_space(4)))*)__builtin_amdgcn_kernarg_segment_ptr();
    F.out = args.out; F.ws = args.ws; F.ctl = (unsigned*)(args.ws + WS_CTL);
    const int lo = args.ph_lo, hi = args.ph_hi;
#if !MK_PER_PHASE
    if (F.tid < 4) ((LAS unsigned*)(F.lds + XBW_OFF))[F.tid] = 0u;
    __syncthreads();
    XcdBarrier bar = xcd_barrier_post(F.ctl + CW_BAR, (volatile LAS unsigned*)(F.lds + XBW_OFF));
#define GRID_BAR() xcd_barrier(bar)
#else
#define GRID_BAR() do {} while (0)
#endif
#define PHASE_REGS() do { int _l = (int)__builtin_amdgcn_mbcnt_hi(~0u, __builtin_amdgcn_mbcnt_lo(~0u, 0u)); asm volatile("" : "+v"(_l)); F.lane = _l; F.tid = F.wave * 64 + _l; } while (0)
#define IN(k) (lo <= (k) && (k) < hi)
#define SEAM(k) do { if (IN(k) && IN((k) + 1)) GRID_BAR(); } while (0)
    const int gw = F.vcu * 8 + F.wave, NGW = F.G * 8;
    bf16* const XN = (bf16*)(F.ws + WS_XN); bf16* const PROJ = (bf16*)(F.ws + WS_PROJ); bf16* const MIX = (bf16*)(F.ws + WS_MIX);
    bf16* const UA = (bf16*)(F.ws + WS_UA); bf16* const Gm = (bf16*)(F.ws + WS_G);

    if (IN(0)) { PHASE_REGS(); p0_prologue(F); }
    SEAM(0);
    if (IN(1)) { PHASE_REGS();
        { pg8::Gemm g{D, D, D}; pg8::DenseOrder S; S.init(XN, F.ws + WS_WIN, D, D, T, INC, F.G, (int)blockIdx.x);
          pg8::EpiProj E{PROJ, UA}; pg8::gemm_phase<pg8::EpiProj, pg8::DenseOrder>(F.lds, g, S, E, F.wave); }
        { pg8::Gemm g{D, D, D}; pg8::DenseOrder S; S.init(F.ws + WS_MEMN, F.ws + WS_WMKV, D, D, NB * MEML, 1024, F.G, F.G - 1 - (int)blockIdx.x);
          pg8::EpiBf16 E{(bf16*)(F.ws + WS_MEMKV), 1024}; pg8::gemm_phase<pg8::EpiBf16, pg8::DenseOrder>(F.lds, g, S, E, F.wave); }
        { const int c = (int)blockIdx.x; const bool has3 = 2 * F.G + c < (T / 256) * (INC / 256), haskv = (F.G - 1 - c) < (NB * MEML / 256) * 4;
          bg_convert(F, CW_QD, BT_GU, BT_D, (!has3 && !haskv) ? PB1 : 0); }
    }
    SEAM(1);
    if (IN(2)) { PHASE_REGS();
        for (int u = F.vcu; u < 256; u += F.G) swa_unit(F, u);
        __syncthreads();
        { pg8::Gemm g{S5K, 512, 256}; pg8::StateOrder S{(const char*)UA, (const char*)(F.ws + WS_SP), F.G, F.G - 1 - F.vcu};
          pg8::EpiF32 E{(float*)(F.ws + WS_SL), 256, (size_t)512 * 256}; pg8::gemm_phase<pg8::EpiF32, pg8::StateOrder>(F.lds, g, S, E, F.wave); }
        bg_convert(F, CW_QD, BT_GU, BT_D, (F.G - 1 - F.vcu) >= 128 ? PB2 : 0);
    }
    SEAM(2);
    if (IN(3)) { PHASE_REGS();
        if (F.wave < 4) { const float* SL = (const float*)(F.ws + WS_SL); const float* AL = (const float*)(F.ws + WS_AL);
            for (int L = F.vcu; L < 128; L += F.G) { const int g = L >> 2, pm = L & 1, b = 4 * pm + F.wave, n = F.lane;
                const float ar = AL[(g * 64 + n) * 2], ai = AL[(g * 64 + n) * 2 + 1]; float xr = 0.f, xi = 0.f;
                for (int j0 = 0; j0 < 64; j0 += 8) { float sr[8], si[8];
#pragma unroll
                    for (int j = 0; j < 8; ++j) { const float* sp = SL + ((size_t)(g * 1024 + b * 64 + j0 + j)) * 256; const float* sq = sp + (size_t)512 * 256; sr[j] = sp[n] + sq[n]; si[j] = sp[64 + n] + sq[64 + n]; }
#pragma unroll
                    for (int j = 0; j < 8; ++j) { bf16* up = UA + ((size_t)(g * 512 + b * 64 + j0 + j)) * S5K + 512; up[n] = (bf16)f2bf(xr); up[64 + n] = (bf16)f2bf(xi);
                        const float nr = ar * xr - ai * xi + sr[j], ni = ar * xi + ai * xr + si[j]; xr = nr; xi = ni; } } } }
        asm volatile("s_waitcnt vmcnt(0)" ::: "memory");
        __syncthreads();
        pg8::Gemm g{S5K, S5K, S5K}; pg8::GroupOrder S{(const char*)UA, (const char*)(F.ws + WS_MQ), S5K, S5K, 2, 32, F.G, F.vcu};
        pg8::EpiS5Y E{UA, F.in[I_SSM_D], Gm}; pg8::gemm_phase<pg8::EpiS5Y, pg8::GroupOrder>(F.lds, g, S, E, F.wave);
        if (F.G >= 256 && F.vcu >= 128) { for (int u = F.vcu - 128; u < 128; u += F.G - 128) xattn_unit(F, u); __syncthreads(); }
        if (F.G < 256) { for (int u = F.vcu; u < 256; u += F.G) xattn_unit(F, u); __syncthreads(); }
        bg_convert(F, CW_QD, BT_GU, BT_D, (F.G >= 256 && F.vcu >= 128) ? PB4 : 0);
    }
    SEAM(3);
    if (IN(4)) { PHASE_REGS();
        pg8::Gemm g{512, 512, 512}; pg8::DenseOrder S; S.init(Gm, F.ws + WS_WGLU, 512, 512, T, 512, F.G, (int)blockIdx.x);
        pg8::EpiGlu E{Gm, MIX, (float*)(F.ws + WS_SS)}; pg8::gemm_phase<pg8::EpiGlu, pg8::DenseOrder>(F.lds, g, S, E, F.wave);
        if (F.G >= 256 && (int)blockIdx.x >= 128) { for (int u = 128 + (int)blockIdx.x - 128; u < 256; u += F.G - 128) xattn_unit(F, u); __syncthreads(); }
    }
    SEAM(4);
    if (IN(5)) { PHASE_REGS();
        pg8::Gemm g{D, D, D}; pg8::DenseOrder S; S.init(MIX, F.ws + WS_WO, D, D, T, D, F.G, (int)blockIdx.x);
        pg8::EpiWo E{(const float*)(F.ws + WS_RINV), XN, (unsigned char*)(F.ws + WS_X18), (float*)(F.ws + WS_PART)}; pg8::gemm_phase<pg8::EpiWo, pg8::DenseOrder, false, false, true>(F.lds, g, S, E, F.wave, (const float*)(F.ws + WS_SS));
    }
    SEAM(5);
    if (IN(6)) { PHASE_REGS();
        pg8::Gemm g{D, 512, 512}; pg8::KSplitOrder S{(const char*)XN, (const char*)(F.ws + WS_WR), D, 512, 512, T / 256, 4, F.G, F.vcu};
        pg8::EpiLogit E{(float*)(F.ws + WS_LP)}; pg8::gemm_phase<pg8::EpiLogit, pg8::KSplitOrder>(F.lds, g, S, E, F.wave);
    }
    SEAM(6);
    const int rt_per = (T + F.G - 1) / F.G, rt_beg = F.vcu * rt_per, rt_end = (rt_beg + rt_per) < T ? (rt_beg + rt_per) : T;
    if (IN(7)) { PHASE_REGS();
        LAS int* hist = (LAS int*)F.lds;
        const float* LP = (const float*)(F.ws + WS_LP); const float* part = (const float*)(F.ws + WS_PART); float* rstdv = (float*)(F.ws + WS_RSTD);
        int* toke = (int*)(F.ws + WS_TOKE); float* wts = (float*)(F.ws + WS_WTS); int* HIST = (int*)(F.ws + WS_HIST);
        __syncthreads();
        if (F.tid < 64) hist[F.tid] = 0;
        __syncthreads();
        for (int t = rt_beg + F.tid; t < rt_end; t += 512) {
            const f32x4* pp = (const f32x4*)(part + (size_t)t * 32); float ss = 0.f;
#pragma unroll
            for (int j = 0; j < 8; ++j) { const f32x4 v = pp[j]; ss += (v[0] + v[1]) + (v[2] + v[3]); }
            const float rs = 1.0f / sqrtf(ss * (1.f / 2048.f) + EPS); rstdv[t] = rs;
            const float* l0 = LP + (size_t)t * 80; const float* l1 = l0 + (size_t)T * 80; const float* l2 = l1 + (size_t)T * 80; const float* l3 = l2 + (size_t)T * 80;
            float gl[8];
#pragma unroll
            for (int j = 0; j < 8; j += 4) { const f32x4 a = *(const f32x4*)(l0 + j), b = *(const f32x4*)(l1 + j), c = *(const f32x4*)(l2 + j), d = *(const f32x4*)(l3 + j);
#pragma unroll
                for (int q = 0; q < 4; ++q) gl[j + q] = rs * (((a[q] + b[q]) + c[q]) + d[q]); }
            int gi = 0; float gm = gl[0];
#pragma unroll
            for (int j = 1; j < 8; ++j) if (gl[j] > gm) { gm = gl[j]; gi = j; }
            float gs = 0.f;
#pragma unroll
            for (int j = 0; j < 8; ++j) gs += expf(gl[j] - gm);
            const float gate = 1.0f / gs;
            float el[8];
#pragma unroll
            for (int j = 0; j < 8; j += 4) { const int o = 8 + gi * 8 + j; const f32x4 a = *(const f32x4*)(l0 + o), b = *(const f32x4*)(l1 + o), c = *(const f32x4*)(l2 + o), d = *(const f32x4*)(l3 + o);
#pragma unroll
                for (int q = 0; q < 4; ++q) el[j + q] = rs * (((a[q] + b[q]) + c[q]) + d[q]); }
            int i1 = 0; float v1 = el[0];
#pragma unroll
            for (int j = 1; j < 8; ++j) if (el[j] > v1) { v1 = el[j]; i1 = j; }
            int i2 = -1; float v2 = -3.0e38f;
#pragma unroll
            for (int j = 0; j < 8; ++j) if (j != i1 && el[j] > v2) { v2 = el[j]; i2 = j; }
            const float ex = expf(v2 - v1);
            const int ea = gi * 8 + i1, eb = gi * 8 + i2;
            const int la = __hip_atomic_fetch_add(hist + ea, 1, __ATOMIC_RELAXED, __HIP_MEMORY_SCOPE_WORKGROUP), lb = __hip_atomic_fetch_add(hist + eb, 1, __ATOMIC_RELAXED, __HIP_MEMORY_SCOPE_WORKGROUP);
            toke[t * 2] = (ea << 16) | la; toke[t * 2 + 1] = (eb << 16) | lb; wts[t * 2] = gate / (1.0f + ex); wts[t * 2 + 1] = gate * ex / (1.0f + ex);
        }
        __syncthreads();
        if (F.tid < 64) HIST[F.vcu * 64 + F.tid] = hist[F.tid];
        __syncthreads();
    }
    SEAM(7);
    if (IN(8)) { PHASE_REGS();
        LAS int* pb = (LAS int*)F.lds; LAS int* pt = pb + 512; LAS int* base = pt + 512;
        const int* HIST = (const int*)(F.ws + WS_HIST); const int* toke = (const int*)(F.ws + WS_TOKE); int* list = (int*)(F.ws + WS_LIST);
        __syncthreads();
        { const int e = F.tid & 63, p8 = F.tid >> 6; int sb = 0, st = 0;
          for (int w = p8; w < F.G; w += 8) { const int h = HIST[w * 64 + e]; st += h; sb += (w < F.vcu) ? h : 0; }
          pb[F.tid] = sb; pt[F.tid] = st; }
        __syncthreads();
        if (F.tid < 64) { int sb = 0, st = 0;
#pragma unroll
            for (int j = 0; j < 8; ++j) { sb += pb[j * 64 + F.tid]; st += pt[j * 64 + F.tid]; }
            base[F.tid] = sb; F.ctl[CW_CNT + F.tid] = (unsigned)st; }
        __syncthreads();
        for (int t = rt_beg + F.tid; t < rt_end; t += 512) {
#pragma unroll
            for (int k = 0; k < 2; ++k) { const int v = toke[t * 2 + k], e = v >> 16, sl = v & 0xffff; const size_t pos = (size_t)e * LCAP + base[e] + sl;
                list[pos] = t * 2 + k; ((float*)(F.ws + WS_LRS))[pos] = ((const float*)(F.ws + WS_RSTD))[t]; ((float*)(F.ws + WS_LWT))[pos] = ((const float*)(F.ws + WS_WTS))[t * 2 + k]; } }
        __syncthreads();
        bg_convert(F, CW_QGU, 0, BT_GU, 0x7fffffff);
    }
    SEAM(8);
    if (IN(9)) { PHASE_REGS();
        moe_tables(F);
        const LAS int* cnt = (const LAS int*)(F.lds + TAB_OFF); const int* list = (const int*)(F.ws + WS_LIST);
        pg8::Gemm g{D / 2, D / 2, D / 2}; pg8::MoeOrder S{(const char*)(F.ws + WS_X18), (const char*)(F.ws + WS_WGU), cnt, cnt + 64, list, D / 2, D / 2, 4, 1024, F.G, F.vcu, true};
        pg8::EpiGU E{(const float*)(F.ws + WS_LRS), cnt, F.ws + WS_ACT}; pg8::gemm_phase<pg8::EpiGU, pg8::MoeOrder, true, true>(F.lds, g, S, E, F.wave);
        PHASE_REGS();
        bg_convert(F, CW_QD, BT_GU, BT_D, 0x7fffffff);
    }
    SEAM(9);
    if (IN(10)) { PHASE_REGS();
        moe_tables(F);
        const LAS int* cnt = (const LAS int*)(F.lds + TAB_OFF); const int* list = (const int*)(F.ws + WS_LIST);
        pg8::Gemm g{DEXP / 2, DEXP / 2, DEXP / 2}; pg8::MoeOrder S{(const char*)(F.ws + WS_ACT), (const char*)(F.ws + WS_WD), cnt, cnt + 64, list, DEXP / 2, DEXP / 2, 8, 2048, F.G, F.vcu, false};
        pg8::EpiDown E{list, (const float*)(F.ws + WS_LWT), cnt, F.ws + WS_Y2};
        pg8::gemm_phase<pg8::EpiDown, pg8::MoeOrder, false, true>(F.lds, g, S, E, F.wave);
    }
    SEAM(10);
    if (IN(11)) { PHASE_REGS();
        const unsigned char* Y2 = F.ws + WS_Y2; typedef float f32x2_ __attribute__((ext_vector_type(2)));
        for (int m = gw; m < T; m += NGW) { f32x4* op = (f32x4*)(F.out + (size_t)m * D) + F.lane * 2; const v4u* xb = (const v4u*)(XN + (size_t)m * D) + F.lane;
            const v2u* ya = (const v2u*)(Y2 + (size_t)m * 2 * D) + F.lane; const v2u* yb = ya + 256;
            v4u xw[4]; v2u aw[4], cw[4];
#pragma unroll
            for (int j = 0; j < 4; ++j) { xw[j] = __builtin_nontemporal_load(xb + 64 * j); aw[j] = __builtin_nontemporal_load(ya + 64 * j); cw[j] = __builtin_nontemporal_load(yb + 64 * j); }
#pragma unroll
            for (int j = 0; j < 4; ++j) { const v4u x = xw[j]; const v2u a = aw[j], c = cw[j]; f32x4 x0, x1; const float is = 1.0f / SC_Y;
                const f32x2_ a0 = __builtin_amdgcn_cvt_pk_f32_fp8((int)a.x, false), a1 = __builtin_amdgcn_cvt_pk_f32_fp8((int)a.x, true), a2 = __builtin_amdgcn_cvt_pk_f32_fp8((int)a.y, false), a3 = __builtin_amdgcn_cvt_pk_f32_fp8((int)a.y, true);
                const f32x2_ c0 = __builtin_amdgcn_cvt_pk_f32_fp8((int)c.x, false), c1 = __builtin_amdgcn_cvt_pk_f32_fp8((int)c.x, true), c2 = __builtin_amdgcn_cvt_pk_f32_fp8((int)c.y, false), c3 = __builtin_amdgcn_cvt_pk_f32_fp8((int)c.y, true);
                x0[0] = bflo(x.x) + (a0[0] + c0[0]) * is; x0[1] = bfhi(x.x) + (a0[1] + c0[1]) * is; x0[2] = bflo(x.y) + (a1[0] + c1[0]) * is; x0[3] = bfhi(x.y) + (a1[1] + c1[1]) * is;
                x1[0] = bflo(x.z) + (a2[0] + c2[0]) * is; x1[1] = bfhi(x.z) + (a2[1] + c2[1]) * is; x1[2] = bflo(x.w) + (a3[0] + c3[0]) * is; x1[3] = bfhi(x.w) + (a3[1] + c3[1]) * is;
                __builtin_nontemporal_store(x0, op + 128 * j); __builtin_nontemporal_store(x1, op + 128 * j + 1); } }
    }
#undef IN
#undef SEAM
}

extern "C" void kernel_launch(void* const* d_in, const int* in_sizes, int n_in, void* d_out, int out_size, void* d_ws, size_t ws_size, hipStream_t stream) {
    static int grid = 0;
    if (grid == 0) {
        if (n_in != 31 || out_size != T * D || ws_size < WS_END) { fprintf(stderr, "kernel_launch: unexpected shapes (n_in %d out %d ws %zu)\n", n_in, out_size, ws_size); grid = -1; return; }
        int dev = 0, cus = 0, per_cu = 0;
        if (hipGetDevice(&dev) != hipSuccess || hipDeviceGetAttribute(&cus, hipDeviceAttributeMultiprocessorCount, dev) != hipSuccess) { grid = -1; return; }
        if (hipFuncSetAttribute((const void*)hymba_fwd, hipFuncAttributeMaxDynamicSharedMemorySize, LDS_BYTES) != hipSuccess) { fprintf(stderr, "kernel_launch: hipFuncSetAttribute failed\n"); grid = -1; return; }
        if (hipOccupancyMaxActiveBlocksPerMultiprocessor(&per_cu, (const void*)hymba_fwd, 512, LDS_BYTES) != hipSuccess || per_cu < 1) fprintf(stderr, "kernel_launch: occupancy query reports %d\n", per_cu);
        (void)hipGetLastError();
        grid = cus;
    }
    if (grid < 0) return;
    (void)hipMemsetAsync((char*)d_ws + WS_CTL, 0, CTL_ZERO_BYTES, stream);
    Args a{};
    for (int i = 0; i < 31; ++i) a.in[i] = (const float*)d_in[i];
    a.out = (float*)d_out; a.ws = (unsigned char*)d_ws;
#if MK_PER_PHASE
    for (int p = 0; p < NPH; ++p) { const int reps = ((PROBE_REP_MASK >> p) & 1) ? 2 : 1;
        for (int q = 0; q < reps; ++q) { a.ph_lo = p; a.ph_hi = p + 1; hipLaunchKernelGGL(hymba_fwd, dim3(grid), dim3(512), LDS_BYTES, stream, a); } }
#else
    a.ph_lo = 0; a.ph_hi = NPH; hipLaunchKernelGGL(hymba_fwd, dim3(grid), dim3(512), LDS_BYTES, stream, a);
#endif
}
```

```cpp
#include <hip/hip_runtime.h>
#include <cstdio>
#include <cstdint>

#ifndef PROBE_REP_MASK
#define PROBE_REP_MASK 0
#endif
#ifndef PB0
#define PB0 40
#endif
#ifndef PB0_S5
#define PB0_S5 28
#endif
#ifndef PB0_D
#define PB0_D 0
#endif
#ifndef PB1
#define PB1 18
#endif
#ifndef PB2
#define PB2 0
#endif
#ifndef PB4
#define PB4 3
#endif
#ifndef PB5
#define PB5 0
#endif
#ifndef PB11
#define PB11 0
#endif
#ifndef MK_PER_PHASE
#define MK_PER_PHASE 0
#endif

#define GAS __attribute__((address_space(1)))
#define LAS __attribute__((address_space(3)))
typedef unsigned short bf16;
typedef unsigned v4u __attribute__((ext_vector_type(4)));
typedef unsigned v2u __attribute__((ext_vector_type(2)));
typedef float f32x4 __attribute__((ext_vector_type(4)));
typedef float f32x16 __attribute__((ext_vector_type(16)));
typedef short bf16x8 __attribute__((ext_vector_type(8)));
typedef short bf16x4 __attribute__((ext_vector_type(4)));
typedef int v8i __attribute__((ext_vector_type(8)));
typedef int v4i_ __attribute__((ext_vector_type(4)));

constexpr int T = 16384, D = 2048, SEQ = 2048, NB = 8, INC = 2304, MEML = 256;
constexpr int NPH = 12;
constexpr float EPS = 1e-6f;
constexpr int NEXP = 64, DEXP = 512, LCAP = 16384;
constexpr int S5L = 32, S5K = 640;

constexpr size_t MiB = 1u << 20;
constexpr size_t WS_CTL = 0, CTL_ZERO_BYTES = 32768;
constexpr size_t WS_WIN = 2 * MiB, WS_WO = 11 * MiB, WS_WMKV = 19 * MiB, WS_WGLU = 23 * MiB;
constexpr size_t WS_MQ = 24 * MiB, WS_SP = 44 * MiB, WS_UA = 52 * MiB, WS_SL = 468 * MiB  , WS_AL = 88 * MiB, WS_WR = 89 * MiB;
constexpr size_t WS_XN = 96 * MiB;
constexpr size_t WS_MEMN = 160 * MiB, WS_MEMKV = 168 * MiB;
constexpr size_t WS_PROJ = 176 * MiB;
constexpr size_t WS_MIX = 248 * MiB;
constexpr size_t WS_Y2 = 176 * MiB;
constexpr size_t WS_G = 312 * MiB;
constexpr size_t WS_LOG = 328 * MiB;
constexpr size_t WS_LIST = 344 * MiB;
constexpr size_t WS_WTS = 348 * MiB;
constexpr size_t WS_LP = 352 * MiB;
constexpr size_t WS_PART = 376 * MiB;
constexpr size_t WS_RSTD = 379 * MiB;
constexpr size_t WS_HIST = 380 * MiB;
constexpr size_t WS_X18 = 384 * MiB;
constexpr size_t WS_SS = 382 * MiB;
constexpr size_t WS_LRS = 452 * MiB;
constexpr size_t WS_LWT = 456 * MiB;
constexpr size_t WS_RINV = 460 * MiB;
constexpr size_t WS_TOKE = 381 * MiB;
constexpr size_t WS_ACT = 544 * MiB;
constexpr size_t WS_WGU = 592 * MiB;
constexpr size_t WS_WD = 848 * MiB;
constexpr size_t WS_END = 976 * MiB;
constexpr int CW_CNT = 1024;
constexpr int CW_BAR = 4096;
constexpr int CW_QGU = 2048, CW_QD = 2112;

constexpr int RING_BYTES = 131072;
constexpr int TAB_OFF = 139264;
constexpr int XBW_OFF = TAB_OFF + 2048;
constexpr int LDS_BYTES = 147456;

#define LDS_WAIT() asm volatile("s_waitcnt lgkmcnt(0)" ::: "memory")
#define VM_WAIT() asm volatile("s_waitcnt vmcnt(0)" ::: "memory")
__device__ __forceinline__ unsigned f2bf(float f) { unsigned u = __builtin_bit_cast(unsigned, f); return (u + 0x7fffu + ((u >> 16) & 1u)) >> 16; }
__device__ __forceinline__ unsigned pk2(float lo, float hi) { unsigned r; asm volatile("v_cvt_pk_bf16_f32 %0, %1, %2" : "=v"(r) : "v"(lo), "v"(hi)); return r; }
__device__ __forceinline__ float bflo(unsigned w) { return __builtin_bit_cast(float, w << 16); }
__device__ __forceinline__ float bfhi(unsigned w) { return __builtin_bit_cast(float, w & 0xffff0000u); }
__device__ __forceinline__ float wave_sum(float v) {
#pragma unroll
    for (int o = 1; o < 64; o <<= 1) v += __shfl_xor(v, o);
    return v;
}
constexpr float SC_X = 4.0f, SC_WGU = 32.0f, SC_ACT = 16.0f, SC_WD = 16.0f, SC_Y = 64.0f;
__device__ __forceinline__ float clamp8(float v) { return __builtin_amdgcn_fmed3f(v, -448.0f, 448.0f); }
__device__ __forceinline__ unsigned pk4_fp8(float a, float b, float c, float d) { unsigned w = 0u; w = (unsigned)__builtin_amdgcn_cvt_pk_fp8_f32(clamp8(a), clamp8(b), (int)w, false); w = (unsigned)__builtin_amdgcn_cvt_pk_fp8_f32(clamp8(c), clamp8(d), (int)w, true); return w; }
__device__ __forceinline__ float fast_exp(float x) { return __builtin_amdgcn_exp2f(x * 1.44269504089f); }
__device__ __forceinline__ float sigmoidf_(float x) { return __builtin_amdgcn_rcpf(1.0f + fast_exp(-x)); }
__device__ __forceinline__ float gelu_tanh(float x) { const float z = 1.5957691216f * (x + 0.044715f * x * x * x); return x * sigmoidf_(z); }

#define XB_TMO      128
#define XB_XCNT(j)  (256  + 64 * (j))
#define XB_XSUB(j)  (1280 + 64 * (j))
#define XB_XGEN(j)  (2304 + 64 * (j))
#define XB_TOP      3328
#define XB_TOPGEN   3392
#define XCD_BAR_WORDS 3456
#define XB_SPIN_CAP (1u << 18)
__device__ __forceinline__ unsigned xb_ld(unsigned* p)              { return __hip_atomic_load(p, __ATOMIC_RELAXED, __HIP_MEMORY_SCOPE_AGENT); }
__device__ __forceinline__ unsigned xb_add(unsigned* p, unsigned v) { return __hip_atomic_fetch_add(p, v, __ATOMIC_RELAXED, __HIP_MEMORY_SCOPE_AGENT); }
__device__ __forceinline__ unsigned xb_xcc_id() { return (unsigned)__builtin_amdgcn_s_getreg((3 << 11) | 20) & 0xFu; }
#define XB_SPIN(cond, bar) do { unsigned _sp = 0; while (cond) { __builtin_amdgcn_s_sleep(1); \
    if ((++_sp & 255u) == 0u) { if (xb_ld(&(bar)[XB_TMO])) break; if (_sp > XB_SPIN_CAP) { atomicAdd(&(bar)[XB_TMO], 1u); break; } } } } while (0)
struct XcdBarrier { unsigned* bar; unsigned x; volatile LAS unsigned* st; };
__device__ __forceinline__ XcdBarrier xcd_barrier_post(unsigned* bar, volatile LAS unsigned* st) {
    XcdBarrier b; b.bar = bar; b.x = xb_xcc_id(); b.st = st;
    if (threadIdx.x == 0) (void)xb_add(&bar[XB_XCNT(b.x)], 1u);
    return b;
}
__device__ __forceinline__ void xcd_barrier_complete(unsigned* bar, unsigned x, unsigned& nloc, unsigned& nx) {
    const unsigned G = gridDim.x * gridDim.y * gridDim.z;
    unsigned sum, cnt, mine, sp = 0u;
    for (;;) {
        sum = 0u; cnt = 0u; mine = 0u;
#pragma unroll
        for (unsigned j = 0; j < 16; ++j) { const unsigned c = xb_ld(&bar[XB_XCNT(j)]); sum += c; cnt += (c > 0u) ? 1u : 0u; mine = (j == x) ? c : mine; }
        if (sum == G) break;
        __builtin_amdgcn_s_sleep(1);
        if ((++sp & 255u) == 0u) { if (xb_ld(&bar[XB_TMO])) break; if (sp > XB_SPIN_CAP) { atomicAdd(&bar[XB_TMO], 1u); break; } }
    }
    nloc = mine > 0u ? mine : 1u; nx = cnt > 0u ? cnt : 1u;
}
__device__ __forceinline__ void xcd_barrier(const XcdBarrier& b) {
    asm volatile("s_waitcnt vmcnt(0)" ::: "memory");
    __syncthreads();
    if (threadIdx.x == 0) {
        unsigned* bar = b.bar;
        __builtin_amdgcn_s_waitcnt(0);
        unsigned nloc = b.st[0], nx = b.st[1];
        if (nloc == 0u) { xcd_barrier_complete(bar, b.x, nloc, nx); b.st[0] = nloc; b.st[1] = nx; }
        const unsigned old = xb_add(&bar[XB_XSUB(b.x)], 1u);
        const unsigned gen = old / nloc;
        if (old + 1u == (gen + 1u) * nloc) {
            __builtin_amdgcn_fence(__ATOMIC_RELEASE, "agent");
            asm volatile("s_waitcnt vmcnt(0)" ::: "memory");
            const unsigned og = xb_add(&bar[XB_TOP], 1u);
            const unsigned tg = og / nx;
            if (og + 1u == (tg + 1u) * nx) xb_add(&bar[XB_TOPGEN], 1u);
            else XB_SPIN(xb_ld(&bar[XB_TOPGEN]) == tg, bar);
            __builtin_amdgcn_fence(__ATOMIC_ACQUIRE, "agent");
            xb_add(&bar[XB_XGEN(b.x)], 1u);
            asm volatile("s_waitcnt vmcnt(0)" ::: "memory");
        } else {
            XB_SPIN(xb_ld(&bar[XB_XGEN(b.x)]) == gen, bar);
            __builtin_amdgcn_fence(__ATOMIC_ACQUIRE, "agent");
            asm volatile("s_waitcnt vmcnt(0)" ::: "memory");
        }
    }
    __syncthreads();
}

__device__ __forceinline__ int lane_now() { int l = (int)__builtin_amdgcn_mbcnt_hi(~0u, __builtin_amdgcn_mbcnt_lo(~0u, 0u)); asm volatile("" : "+v"(l)); return l; }
namespace pg8 {
constexpr int BM = 256, BK = 64, HALF = 128, HTB = HALF * BK * 2, STAGE_BYTES = 8 * HTB, NXCD = 8, WGM = 8;
__host__ __device__ __forceinline__ int lds_byte(int r, int c) { const int st = (r >> 4) * 2 + (c >> 5), rr = r & 15, cc = c & 31, ob = rr * 64 + cc * 2; return st * 1024 + (ob ^ (((ob >> 9) & 1) << 5)); }
__host__ __device__ __forceinline__ void stage_rc(int b, int& R, int& C) { const int st = b / 1024, sb = b % 1024, swz = sb ^ (((sb >> 9) & 1) << 5); R = (st >> 1) * 16 + swz / 64; C = (st & 1) * 32 + (swz % 64) / 2; }
__host__ __device__ __forceinline__ int perm32(int rho) { const int n = rho >> 4, i = rho & 15; return 8 * (i >> 2) + 4 * n + (i & 3); }

struct Unit { const char* a; const char* b; int r0, c0, aux, r1; };
struct Gemm { int lda, ldb, K; };

struct DenseOrder {
    const char* A; const char* Bt; int lda, ldb, nM, nN, nwg, G, c;
    __device__ void init(const void* A_, const void* Bt_, int lda_, int ldb_, int M, int N, int G_, int c_) { A = (const char*)A_; Bt = (const char*)Bt_; lda = lda_; ldb = ldb_; nM = M / BM; nN = N / BM; nwg = nM * nN; G = G_; c = c_; }
    __device__ bool next(int i, Unit& u) const {
        const long L = (long)i * G + c; if (L >= nwg) return false;
        int wgid = (int)L; { const int q = nwg / NXCD, r = nwg % NXCD, xcd = wgid % NXCD, off = wgid / NXCD; wgid = (xcd < r ? xcd * (q + 1) : r * (q + 1) + (xcd - r) * q) + off; }
        const int nig = WGM * nN, gid = wgid / nig, fm = gid * WGM, gsz = (nM - fm) < WGM ? (nM - fm) : WGM;
        const int pm = fm + ((wgid % nig) % gsz), pn = (wgid % nig) / gsz;
        u.a = A + (size_t)pm * BM * lda * 2; u.b = Bt + (size_t)pn * BM * ldb * 2; u.r0 = pm * BM; u.c0 = pn * BM; u.aux = 0; u.r1 = 0; return true;
    }
    __device__ __forceinline__ unsigned arow(const Unit&, int) const { return 0u; }
};
struct GroupOrder {
    const char* A; const char* Bt; int lda, ldb, nN, ngrp, G, c;
    __device__ bool next(int i, Unit& u) const {
        const int L = i * G + c; if (L >= ngrp * 2 * nN) return false;
        const int g = L / (2 * nN), q = L % (2 * nN), pn = q >> 1, pm = q & 1;
        u.a = A + ((size_t)g * 512 + pm * BM) * lda * 2; u.b = Bt + ((size_t)g * nN + pn) * BM * ldb * 2; u.r0 = pm * BM; u.c0 = pn * BM; u.aux = g; u.r1 = 0; return true;
    }
    __device__ __forceinline__ unsigned arow(const Unit&, int) const { return 0u; }
};
struct StateOrder {
    const char* A; const char* Bt; int G, c;
    __device__ bool next(int i, Unit& u) const {
        const int L = i * G + c; if (L >= 128) return false;
        const int g = L >> 2, pm = (L >> 1) & 1, ks = L & 1;
        u.a = A + (((size_t)g * 512 + pm * BM) * S5K + ks * 256) * 2; u.b = Bt + ((size_t)g * 256 * 512 + ks * 256) * 2; u.r0 = pm * BM; u.c0 = 0; u.aux = g * 2 + ks; u.r1 = 0; return true;
    }
    __device__ __forceinline__ unsigned arow(const Unit&, int) const { return 0u; }
};
struct MoeOrder {
    const char* A; const char* Bt; const LAS int* cnt; const LAS int* ts; const int* list; int lda, ldb, nct, brows, G, c; bool gather;
    __device__ bool next(int i, Unit& u) const {
        const int L = i * G + c; const int lane = lane_now();
        int i64 = 64; asm volatile("" : "+v"(i64));
        if (L >= __builtin_amdgcn_readfirstlane(ts[i64]) * nct) return false;
        const int lo = ts[lane] * nct, hi = ts[lane + 1] * nct;
        const unsigned long long m = __ballot(lo <= L && L < hi);
        const int e = __builtin_amdgcn_readfirstlane((int)__builtin_ctzll(m));
        const int tse = ts[e], ne = ts[e + 1] - tse, q = L - tse * nct, ct = q / ne, rt = q % ne;
        u.a = gather ? A : A + (size_t)(tse + rt) * BM * lda * 2; u.b = Bt + ((size_t)e * brows + (size_t)ct * BM) * ldb * 2;
        u.r0 = (tse + rt) * BM; u.r1 = rt * BM; u.c0 = ct; u.aux = e; return true;
    }
    __device__ __forceinline__ unsigned arow(const Unit& u, int r) const {
        const int n = cnt[u.aux]; int rr = u.r1 + r; rr = rr < n ? rr : n - 1;
        return (unsigned)(list[(size_t)u.aux * LCAP + rr] >> 1) * (unsigned)(lda * 2);
    }
};

#define EPI_ROWS_COLS() const int rowb = wr * 64 + fr; (void)rowb;

template <class Epi, class Sched, bool GATHER = false, bool FP8 = false, bool KSEG = false>
__device__ __forceinline__ void gemm_phase(LAS unsigned char* lds, const Gemm g, const Sched& S, const Epi& E, const int wave_id, const float* ssq = nullptr) {
    int lane = (int)__builtin_amdgcn_mbcnt_hi(~0u, __builtin_amdgcn_mbcnt_lo(~0u, 0u)); asm volatile("" : "+v"(lane));
    const int wid = wave_id, tid = wid * 64 + lane, wr = wid >> 2, wc = wid & 3, fr = lane & 15, fq = lane >> 4;
    const int K = g.K; int nt = K / BK; asm volatile("" : "+s"(nt));
    unsigned voffB;
    { int R, C; stage_rc(tid * 16, R, C); const int Rb = Epi::PERM ? ((R & ~31) + perm32(R & 31)) : R; voffB = (unsigned)(Rb * g.ldb + C) * 2u; }
    const int soffB = 64 * g.ldb * 2, soffA = 64 * g.lda * 2;
#define PG8_RC(i, R, C) int R, C; { int _t = tid; asm volatile("" : "+v"(_t)); stage_rc(_t * 16 + (i) * 8192, R, C); }
#define nxoff ((LAS v4u*)(lds + 131072) + (wid * 64 + lane_now()))
    const size_t kstep = (size_t)(BK * 2);
    const size_t hstepB = (size_t)HALF * g.ldb * 2;
    const unsigned ldsw = (unsigned)wid * 1024u;
    const int aoff = lds_byte(wr * 64 + fr, fq * 8), boff = lds_byte(wc * 32 + fr, fq * 8);
#define PG8_SA(b, h) (((b) * 2 + (h)) * HTB)
#define PG8_SB(b, h) ((4 + (b) * 2 + (h)) * HTB)
#define PG8_RSRC(p) __builtin_amdgcn_make_buffer_rsrc((void*)(p), 0, 0xffffffff, 0x00020000)
#define PG8_DMA(gbase, vo, so, ldsp) do { if constexpr (FP8) { __builtin_amdgcn_raw_ptr_buffer_load_lds(PG8_RSRC(gbase), (LAS void*)(ldsp), 16, (int)(vo), (so), 0, 0); } \
        else { __builtin_amdgcn_global_load_lds((const unsigned*)((const char*)(gbase) + (so) + (vo)), (LAS unsigned*)(ldsp), 16, 0, 0); } } while (0)
#define PG8_STAGE(bufoff, gbase, voff) do { PG8_DMA(gbase, voff, 0, lds + (bufoff) + ldsw); PG8_DMA(gbase, voff, soffB, lds + (bufoff) + ldsw + 8192); } while (0)
#define PG8_STAGEA(bufoff, gbase, o0, o1, h) do { \
        if constexpr (GATHER) { PG8_DMA(gbase, o0, 0, lds + (bufoff) + ldsw); PG8_DMA(gbase, o1, 0, lds + (bufoff) + ldsw + 8192); } \
        else { PG8_DMA(gbase, c00, (h) * 2 * soffA, lds + (bufoff) + ldsw); PG8_DMA(gbase, c00, (h) * 2 * soffA + soffA, lds + (bufoff) + ldsw + 8192); } } while (0)
#define PG8_LDA(dst, b, h) do { _Pragma("unroll") for (int m = 0; m < 4; ++m) { \
        if constexpr (FP8) { dst##8[m].lo = *(const LAS v4i_*)(lds + PG8_SA(b, h) + aoff + m * 2048); dst##8[m].hi = *(const LAS v4i_*)(lds + PG8_SA(b, h) + aoff + m * 2048 + 1024); } \
        else { _Pragma("unroll") for (int k = 0; k < 2; ++k) dst[m][k] = *(const LAS bf16x8*)(lds + PG8_SA(b, h) + aoff + m * 2048 + k * 1024); } } } while (0)
#define PG8_LDB(dst, b, h) do { _Pragma("unroll") for (int n = 0; n < 2; ++n) { \
        if constexpr (FP8) { dst##8[n].lo = *(const LAS v4i_*)(lds + PG8_SB(b, h) + boff + n * 2048); dst##8[n].hi = *(const LAS v4i_*)(lds + PG8_SB(b, h) + boff + n * 2048 + 1024); } \
        else { _Pragma("unroll") for (int k = 0; k < 2; ++k) dst[n][k] = *(const LAS bf16x8*)(lds + PG8_SB(b, h) + boff + n * 2048 + k * 1024); } } } while (0)
#define PG8_MMA(ai, bj, At, Bt) do { __builtin_amdgcn_s_setprio(1); _Pragma("unroll") for (int m = 0; m < 4; ++m) _Pragma("unroll") for (int n = 0; n < 2; ++n) { \
        if constexpr (FP8) { acc[ai][bj][m][n] = __builtin_amdgcn_mfma_scale_f32_16x16x128_f8f6f4(Bt##8[n], At##8[m], acc[ai][bj][m][n], 0, 0, 0, 0x7f7f7f7f, 0, 0x7f7f7f7f); } \
        else { _Pragma("unroll") for (int k = 0; k < 2; ++k) acc[ai][bj][m][n] = __builtin_amdgcn_mfma_f32_16x16x32_bf16(Bt[n][k], At[m][k], acc[ai][bj][m][n], 0, 0, 0); } } \
        __builtin_amdgcn_s_setprio(0); } while (0)
#define PG8_WAIT_V(n) asm volatile("s_waitcnt vmcnt(" #n ")" ::: "memory")
#define PG8_WAIT_L(n) asm volatile("s_waitcnt lgkmcnt(" #n ")" ::: "memory")
#define PG8_BAR __builtin_amdgcn_s_barrier()
#define PG8_SCHED __builtin_amdgcn_sched_barrier(0)
    LAS f32x4* scl = (LAS f32x4*)(lds + 131072);
#define PG8_FILL_SCL(u) do { if constexpr (KSEG) { if (tid < 256) { const f32x4* sp = (const f32x4*)(ssq + (size_t)((u).r0 + tid) * 32); \
        const f32x4 p0 = sp[0], p1 = sp[1], p2 = sp[2], p3 = sp[3], p4 = sp[4], p5 = sp[5], p6 = sp[6]; \
        const float sa = (((p0[0] + p0[1]) + (p0[2] + p0[3])) + ((p1[0] + p1[1]) + (p1[2] + p1[3]))) + (((p2[0] + p2[1]) + (p2[2] + p2[3])) + ((p3[0] + p3[1]) + (p3[2] + p3[3]))); \
        const float sb = ((p4[0] + p4[1]) + (p4[2] + p4[3])) + ((p5[0] + p5[1]) + (p5[2] + p5[3])), sc = (p6[0] + p6[1]) + (p6[2] + p6[3]); \
        const float ra = 1.0f / sqrtf(sa * (1.f / 1024.f) + EPS), rb = 1.0f / sqrtf(sb * (1.f / 512.f) + EPS), rc = 1.0f / sqrtf(sc * (1.f / 512.f) + EPS); \
        scl[(ui & 1) * 256 + tid] = (f32x4){ra / rb, rb / rc, rc, 0.f}; } } } while (0)
#define PG8_SCALE(k) do { _Pragma("unroll") for (int _ai = 0; _ai < 2; ++_ai) _Pragma("unroll") for (int _m = 0; _m < 4; ++_m) { const float _f = ((const LAS float*)scl)[((ui & 1) * 256 + _ai * HALF + wr * 64 + _m * 16 + fr) * 4 + (k)]; \
        _Pragma("unroll") for (int _bj = 0; _bj < 2; ++_bj) _Pragma("unroll") for (int _n = 0; _n < 2; ++_n) acc[_ai][_bj][_m][_n] = acc[_ai][_bj][_m][_n] * _f; } } while (0)
    Unit cur, nxt; int ui = 0;
    if (!S.next(0, cur)) return;
    PG8_FILL_SCL(cur);
    if constexpr (Epi::PRE) E.pre(cur, lds + 143360 + (ui & 1) * 2048, tid);
    f32x4 acc[2][2][4][2];
#pragma unroll
    for (int a = 0; a < 2; ++a)
#pragma unroll
        for (int b = 0; b < 2; ++b)
#pragma unroll
            for (int m = 0; m < 4; ++m)
#pragma unroll
                for (int n = 0; n < 2; ++n) acc[a][b][m][n] = (f32x4){0.f, 0.f, 0.f, 0.f};
    bf16x8 At[4][2], B0[2][2], B1[2][2]; v8i At8[4], B08[2], B18[2];
    const char* cA = cur.a; const char* cB = cur.b;
    unsigned c00, c01, c10, c11;
    { PG8_RC(0, R0, C0); PG8_RC(1, R1, C1);
      if constexpr (GATHER) {
        c00 = S.arow(cur, R0) + C0 * 2u; c01 = S.arow(cur, R1) + C1 * 2u; c10 = S.arow(cur, HALF + R0) + C0 * 2u; c11 = S.arow(cur, HALF + R1) + C1 * 2u;
        asm volatile("s_waitcnt vmcnt(0)" : "+v"(c00), "+v"(c01), "+v"(c10), "+v"(c11) :: "memory");
      } else {
        c00 = (unsigned)(R0 * g.lda + C0) * 2u; c01 = c00; c10 = c00; c11 = c00; (void)R1; (void)C1;
      } }
    PG8_STAGE(PG8_SB(0, 0), cB, voffB); PG8_STAGE(PG8_SB(0, 1), cB + hstepB, voffB); PG8_STAGEA(PG8_SA(0, 0), cA, c00, c01, 0); PG8_STAGEA(PG8_SA(0, 1), cA, c10, c11, 1);
    if (wr == 1) PG8_BAR;
    PG8_WAIT_V(2); PG8_BAR;
    PG8_STAGE(PG8_SB(1, 0), cB + kstep, voffB); PG8_STAGEA(PG8_SA(1, 0), cA + kstep, c00, c01, 0); PG8_STAGE(PG8_SB(1, 1), cB + hstepB + kstep, voffB);
    PG8_WAIT_V(6); PG8_BAR;
#define PG8_KITER(t) do { \
            const bool last = (t == nt - 2); \
            const char* a1 = cA + (size_t)(t + 1) * kstep; \
            const char* a2 = last ? nA : cA + (size_t)(t + 2) * kstep; const char* b2 = last ? nB : cB + (size_t)(t + 2) * kstep; \
            const char* a3 = a2 + kstep; const char* b3 = b2 + kstep; \
            unsigned x00 = c00, x01 = c01, x10 = c10, x11 = c11; \
            if constexpr (GATHER) { if (last) { const v4u nv = *nxoff; x00 = nv.x; x01 = nv.y; x10 = nv.z; x11 = nv.w; } } \
 \
            PG8_LDB(B0, 0, 0); PG8_LDB(B1, 0, 1); PG8_SCHED; PG8_LDA(At, 0, 0); PG8_STAGEA(PG8_SA(1, 1), a1, c10, c11, 1); \
            PG8_WAIT_V(8); PG8_WAIT_L(0); PG8_BAR; PG8_MMA(0, 0, At, B0); PG8_MMA(0, 1, At, B1); PG8_BAR; PG8_SCHED; \
 \
            PG8_LDA(At, 0, 1); PG8_STAGE(PG8_SB(0, 0), b2, voffB); PG8_STAGE(PG8_SB(0, 1), b2 + hstepB, voffB); PG8_STAGEA(PG8_SA(0, 0), a2, x00, x01, 0); \
            PG8_WAIT_V(8); PG8_WAIT_L(0); PG8_BAR; PG8_MMA(1, 0, At, B0); PG8_MMA(1, 1, At, B1); PG8_BAR; PG8_SCHED; \
 \
            PG8_LDB(B0, 1, 0); PG8_LDB(B1, 1, 1); PG8_SCHED; PG8_LDA(At, 1, 0); PG8_STAGEA(PG8_SA(0, 1), a2, x10, x11, 1); \
            PG8_WAIT_V(8); PG8_WAIT_L(0); PG8_BAR; PG8_MMA(0, 0, At, B0); PG8_MMA(0, 1, At, B1); PG8_BAR; PG8_SCHED; \
 \
            PG8_LDA(At, 1, 1); PG8_STAGE(PG8_SB(1, 0), b3, voffB); PG8_STAGE(PG8_SB(1, 1), b3 + hstepB, voffB); PG8_STAGEA(PG8_SA(1, 0), a3, x00, x01, 0); \
            PG8_WAIT_V(8); PG8_WAIT_L(0); PG8_BAR; PG8_MMA(1, 0, At, B0); PG8_MMA(1, 1, At, B1); PG8_BAR; PG8_SCHED; \
        } while (0)
    for (;;) {
        const bool has_next = S.next(ui + 1, nxt);
        const char* nA = has_next ? nxt.a : cA; const char* nB = has_next ? nxt.b : cB;
        if constexpr (GATHER) {
            unsigned n00 = c00, n01 = c01, n10 = c10, n11 = c11;
            if (has_next) { PG8_RC(0, R0, C0); PG8_RC(1, R1, C1); n00 = S.arow(nxt, R0) + C0 * 2u; n01 = S.arow(nxt, R1) + C1 * 2u; n10 = S.arow(nxt, HALF + R0) + C0 * 2u; n11 = S.arow(nxt, HALF + R1) + C1 * 2u; }
            asm volatile("s_waitcnt vmcnt(0)" : "+v"(n00), "+v"(n01), "+v"(n10), "+v"(n11) :: "memory");
            v4u nv; nv.x = n00; nv.y = n01; nv.z = n10; nv.w = n11; *nxoff = nv;
        }
        if constexpr (KSEG) {
#pragma unroll 1
            for (int t = 0; t < 16; t += 2) PG8_KITER(t);
            PG8_SCALE(0);
#pragma unroll 1
            for (int t = 16; t < 24; t += 2) PG8_KITER(t);
            PG8_SCALE(1);
#pragma unroll 1
            for (int t = 24; t < nt; t += 2) PG8_KITER(t);
        } else {
#pragma unroll 1
            for (int t = 0; t < nt; t += 2) PG8_KITER(t);
        }
        if (wr == 0) PG8_BAR;
        if constexpr (KSEG) PG8_SCALE(2);
        { const int le = lane_now(); if constexpr (Epi::PRE) E(acc, cur, wr, wc, le & 15, le >> 4, lds + 143360 + (ui & 1) * 2048); else E(acc, cur, wr, wc, le & 15, le >> 4); }
        if (!has_next) break;
#pragma unroll
        for (int a = 0; a < 2; ++a)
#pragma unroll
            for (int b = 0; b < 2; ++b)
#pragma unroll
                for (int m = 0; m < 4; ++m)
#pragma unroll
                    for (int n = 0; n < 2; ++n) acc[a][b][m][n] = (f32x4){0.f, 0.f, 0.f, 0.f};
        cur = nxt; cA = nA; cB = nB; ++ui;
        if constexpr (KSEG) { PG8_WAIT_L(0); PG8_FILL_SCL(cur); }
        if constexpr (Epi::PRE) E.pre(cur, lds + 143360 + (ui & 1) * 2048, tid);
        if constexpr (GATHER) { const v4u nv = *nxoff; c00 = nv.x; c01 = nv.y; c10 = nv.z; c11 = nv.w; }
        if (wr == 1) PG8_BAR;
    }
    PG8_WAIT_V(0);
    PG8_BAR;
#undef PG8_RC
#undef PG8_KITER
#undef PG8_FILL_SCL
#undef PG8_SCALE
#undef nxoff
#undef PG8_SA
#undef PG8_SB
#undef PG8_STAGE
#undef PG8_STAGEA
#undef PG8_DMA
#undef PG8_RSRC
#undef PG8_LDA
#undef PG8_LDB
#undef PG8_MMA
#undef PG8_WAIT_V
#undef PG8_WAIT_L
#undef PG8_BAR
#undef PG8_SCHED
}

typedef const f32x4 (&AccRef)[2][2][4][2];
__device__ __forceinline__ v4u pack8(const f32x4 a, const f32x4 b) { v4u w; w.x = pk2(a[0], a[1]); w.y = pk2(a[2], a[3]); w.z = pk2(b[0], b[1]); w.w = pk2(b[2], b[3]); return w; }

struct EpiProj {
    static constexpr bool PERM = true, PRE = false;
    bf16* PROJ; bf16* UA;
    __device__ __forceinline__ void operator()(AccRef acc, const Unit& u, int wr, int wc, int fr, int fq) const {
        const int row0 = u.r0 + wr * 64 + fr, colb = u.c0 + wc * 32 + 8 * fq;
        const bool isu = (u.c0 == 1280 || u.c0 == 1536);
#pragma unroll
        for (int ai = 0; ai < 2; ++ai)
#pragma unroll
            for (int m = 0; m < 4; ++m) { const int row = row0 + ai * HALF + m * 16;
#pragma unroll
                for (int bj = 0; bj < 2; ++bj) { const int col = colb + bj * HALF; const v4u w = pack8(acc[ai][bj][m][0], acc[ai][bj][m][1]);
                    if (!isu) *(v4u*)(PROJ + (size_t)row * INC + col) = w;
                    else { const int cc = col - 1280, g = cc >> 4, c0 = cc & 15; *(v4u*)(UA + ((size_t)(g * 512 + (row >> 5)) * S5K + (row & 31) * 16 + c0)) = w; } } }
    }
};
struct EpiBf16 {
    static constexpr bool PERM = true, PRE = false;
    bf16* O; int ldc;
    __device__ __forceinline__ void operator()(AccRef acc, const Unit& u, int wr, int wc, int fr, int fq) const {
        const int row0 = u.r0 + wr * 64 + fr, colb = u.c0 + wc * 32 + 8 * fq;
#pragma unroll
        for (int ai = 0; ai < 2; ++ai)
#pragma unroll
            for (int m = 0; m < 4; ++m) { bf16* rowp = O + (size_t)(row0 + ai * HALF + m * 16) * ldc + colb;
#pragma unroll
                for (int bj = 0; bj < 2; ++bj) *(v4u*)(rowp + bj * HALF) = pack8(acc[ai][bj][m][0], acc[ai][bj][m][1]); }
    }
};
struct EpiF32 {
    static constexpr bool PERM = false, PRE = false;
    float* C; int ldc; size_t gstride;
    __device__ __forceinline__ void operator()(AccRef acc, const Unit& u, int wr, int wc, int fr, int fq) const {
        const int row0 = u.r0 + wr * 64 + fr, col0 = u.c0 + wc * 32 + 4 * fq; float* base = C + (size_t)u.aux * gstride;
#pragma unroll
        for (int ai = 0; ai < 2; ++ai)
#pragma unroll
            for (int m = 0; m < 4; ++m) { float* rowp = base + (size_t)(row0 + ai * HALF + m * 16) * ldc + col0;
#pragma unroll
                for (int bj = 0; bj < 2; ++bj)
#pragma unroll
                    for (int n = 0; n < 2; ++n) *(f32x4*)(rowp + bj * HALF + n * 16) = acc[ai][bj][m][n]; }
    }
};
struct EpiS5Y {
    static constexpr bool PERM = true, PRE = false;
    const bf16* UA; const float* dsk; bf16* Gm;
    __device__ __forceinline__ void operator()(AccRef acc, const Unit& u, int wr, int wc, int fr, int fq) const {
        const int row0 = u.r0 + wr * 64 + fr, colb = u.c0 + wc * 32 + 8 * fq, g = u.aux;
#pragma unroll
        for (int ai = 0; ai < 2; ++ai)
#pragma unroll
            for (int m = 0; m < 4; ++m) { const int row = row0 + ai * HALF + m * 16;
#pragma unroll
                for (int bj = 0; bj < 2; ++bj) { const int col = colb + bj * HALF, i = col >> 4, c0 = col & 15;
                    const v4u uw = *(const v4u*)(UA + ((size_t)(g * 512 + row) * S5K + col));
                    const f32x4 d0 = *(const f32x4*)(dsk + g * 16 + c0), d1 = *(const f32x4*)(dsk + g * 16 + c0 + 4);
                    const f32x4 a0 = acc[ai][bj][m][0], a1 = acc[ai][bj][m][1];
                    f32x4 y0, y1;
                    y0[0] = gelu_tanh(a0[0] + d0[0] * bflo(uw.x)); y0[1] = gelu_tanh(a0[1] + d0[1] * bfhi(uw.x)); y0[2] = gelu_tanh(a0[2] + d0[2] * bflo(uw.y)); y0[3] = gelu_tanh(a0[3] + d0[3] * bfhi(uw.y));
                    y1[0] = gelu_tanh(a1[0] + d1[0] * bflo(uw.z)); y1[1] = gelu_tanh(a1[1] + d1[1] * bfhi(uw.z)); y1[2] = gelu_tanh(a1[2] + d1[2] * bflo(uw.w)); y1[3] = gelu_tanh(a1[3] + d1[3] * bfhi(uw.w));
                    *(v4u*)(Gm + ((size_t)row * 32 + i) * 512 + g * 16 + c0) = pack8(y0, y1); } }
    }
};
struct EpiGlu {
    static constexpr bool PERM = true, PRE = false;
    const bf16* Gm; bf16* MIX; float* SS;
    __device__ __forceinline__ void operator()(AccRef acc, const Unit& u, int wr, int wc, int fr, int fq) const {
        const int row0 = u.r0 + wr * 64 + fr, colb = u.c0 + wc * 32 + 8 * fq;
#pragma unroll
        for (int ai = 0; ai < 2; ++ai)
#pragma unroll
            for (int m = 0; m < 4; ++m) { const int row = row0 + ai * HALF + m * 16; float ss = 0.f;
#pragma unroll
                for (int bj = 0; bj < 2; ++bj) { const int col = colb + bj * HALF;
                    const v4u gw = *(const v4u*)(Gm + (size_t)row * 512 + col);
                    const f32x4 a0 = acc[ai][bj][m][0], a1 = acc[ai][bj][m][1];
                    f32x4 y0, y1;
                    y0[0] = bflo(gw.x) * sigmoidf_(a0[0]); y0[1] = bfhi(gw.x) * sigmoidf_(a0[1]); y0[2] = bflo(gw.y) * sigmoidf_(a0[2]); y0[3] = bfhi(gw.y) * sigmoidf_(a0[3]);
                    y1[0] = bflo(gw.z) * sigmoidf_(a1[0]); y1[1] = bfhi(gw.z) * sigmoidf_(a1[1]); y1[2] = bflo(gw.w) * sigmoidf_(a1[2]); y1[3] = bfhi(gw.w) * sigmoidf_(a1[3]);
                    ss += ((y0[0] * y0[0] + y0[1] * y0[1]) + (y0[2] * y0[2] + y0[3] * y0[3])) + ((y1[0] * y1[0] + y1[1] * y1[1]) + (y1[2] * y1[2] + y1[3] * y1[3]));
                    *(v4u*)(MIX + (size_t)row * D + 1024 + col) = pack8(y0, y1); }
                ss += __shfl_xor(ss, 16); ss += __shfl_xor(ss, 32);
                if (fq == 0) SS[(size_t)row * 32 + 16 + (u.c0 >> 8) * 4 + wc] = ss; }
    }
};
struct EpiWo {
    static constexpr bool PERM = true, PRE = false;
    const float* rinv; bf16* X1B; unsigned char* X18; float* part;
    __device__ __forceinline__ void operator()(AccRef acc, const Unit& u, int wr, int wc, int fr, int fq) const {
        const int row0 = u.r0 + wr * 64 + fr, col0 = u.c0 + wc * 32 + 8 * fq;
#pragma unroll
        for (int ai = 0; ai < 2; ++ai) {
            v4u xw[4][2]; float ri[4];
#pragma unroll
            for (int m = 0; m < 4; ++m) { const int row = row0 + ai * HALF + m * 16; ri[m] = rinv[row];
#pragma unroll
                for (int bj = 0; bj < 2; ++bj) xw[m][bj] = *(const v4u*)(X1B + (size_t)row * D + col0 + bj * HALF); }
#pragma unroll
            for (int m = 0; m < 4; ++m) { const int row = row0 + ai * HALF + m * 16; const size_t off = (size_t)row * D + col0; float ss = 0.f;
#pragma unroll
                for (int bj = 0; bj < 2; ++bj) { const v4u x = xw[m][bj]; const float r = ri[m];
                    f32x4 v0, v1;
                    v0[0] = bflo(x.x) * r + acc[ai][bj][m][0][0]; v0[1] = bfhi(x.x) * r + acc[ai][bj][m][0][1]; v0[2] = bflo(x.y) * r + acc[ai][bj][m][0][2]; v0[3] = bfhi(x.y) * r + acc[ai][bj][m][0][3];
                    v1[0] = bflo(x.z) * r + acc[ai][bj][m][1][0]; v1[1] = bfhi(x.z) * r + acc[ai][bj][m][1][1]; v1[2] = bflo(x.w) * r + acc[ai][bj][m][1][2]; v1[3] = bfhi(x.w) * r + acc[ai][bj][m][1][3];
                    ss += ((v0[0] * v0[0] + v0[1] * v0[1]) + (v0[2] * v0[2] + v0[3] * v0[3])) + ((v1[0] * v1[0] + v1[1] * v1[1]) + (v1[2] * v1[2] + v1[3] * v1[3]));
                    *(v4u*)(X1B + off + bj * HALF) = pack8(v0, v1);
                    v2u w8; w8.x = pk4_fp8(v0[0] * SC_X, v0[1] * SC_X, v0[2] * SC_X, v0[3] * SC_X); w8.y = pk4_fp8(v1[0] * SC_X, v1[1] * SC_X, v1[2] * SC_X, v1[3] * SC_X);
                    *(v2u*)(X18 + off + bj * HALF) = w8; }
                ss += __shfl_xor(ss, 16); ss += __shfl_xor(ss, 32);
                if (fq == 0) part[(size_t)row * 32 + (u.c0 >> 8) * 4 + wc] = ss; }
            asm volatile("" ::: "memory");
        }
    }
};
struct EpiLogit {
    static constexpr bool PERM = false, PRE = false;
    float* LP;
    __device__ __forceinline__ void operator()(AccRef acc, const Unit& u, int wr, int wc, int fr, int fq) const {
        const int row0 = u.r0 + wr * 64 + fr, col0 = wc * 32 + 4 * fq; float* base = LP + (size_t)u.aux * T * 80;
#pragma unroll
        for (int ai = 0; ai < 2; ++ai)
#pragma unroll
            for (int m = 0; m < 4; ++m) { float* rowp = base + (size_t)(row0 + ai * HALF + m * 16) * 80 + col0;
#pragma unroll
                for (int n = 0; n < 2; ++n) if (col0 + n * 16 < 80) *(f32x4*)(rowp + n * 16) = acc[ai][0][m][n]; }
    }
};
struct EpiGU {
    static constexpr bool PERM = true, PRE = true;
    const float* lrs; const LAS int* cnt; unsigned char* ACT;
    __device__ __forceinline__ void pre(const Unit& u, LAS unsigned char* tab, int tid) const {
        if (tid < 256) { const int e = u.aux, n = cnt[e]; int rr = u.r1 + tid; rr = rr < n ? rr : n - 1; ((LAS float*)tab)[tid] = lrs[(size_t)e * LCAP + rr] * (1.0f / (SC_X * SC_WGU)); }
    }
    __device__ __forceinline__ void operator()(AccRef acc, const Unit& u, int wr, int wc, int fr, int fq, const LAS unsigned char* tab) const {
        const int rb = wr * 64 + fr, colb = u.c0 * 128 + wc * 32 + 8 * fq;
#pragma unroll
        for (int ai = 0; ai < 2; ++ai)
#pragma unroll
            for (int m = 0; m < 4; ++m) { const int r = rb + ai * HALF + m * 16;
                const float rs = ((const LAS float*)tab)[r];
                f32x4 y0, y1;
#pragma unroll
                for (int j = 0; j < 4; ++j) { const float g0 = acc[ai][0][m][0][j] * rs, g1 = acc[ai][0][m][1][j] * rs;
                    y0[j] = g0 * sigmoidf_(g0) * (acc[ai][1][m][0][j] * rs) * SC_ACT; y1[j] = g1 * sigmoidf_(g1) * (acc[ai][1][m][1][j] * rs) * SC_ACT; }
                v2u w8; w8.x = pk4_fp8(y0[0], y0[1], y0[2], y0[3]); w8.y = pk4_fp8(y1[0], y1[1], y1[2], y1[3]);
                *(v2u*)(ACT + (size_t)(u.r0 + r) * DEXP + colb) = w8; }
    }
};
struct EpiDown {
    static constexpr bool PERM = true, PRE = true;
    const int* list; const float* lwt; const LAS int* cnt; unsigned char* Y2;
    __device__ __forceinline__ void pre(const Unit& u, LAS unsigned char* tab, int tid) const {
        if (tid < 256) { const int e = u.aux, n = cnt[e], r = u.r1 + tid; int ent = -1; float w = 0.f;
            if (r < n) { ent = list[(size_t)e * LCAP + r]; w = lwt[(size_t)e * LCAP + r] * (SC_Y / (SC_ACT * SC_WD)); }
            ((LAS int*)tab)[tid] = ent; ((LAS float*)tab)[256 + tid] = w; }
    }
    __device__ __forceinline__ void operator()(AccRef acc, const Unit& u, int wr, int wc, int fr, int fq, const LAS unsigned char* tab) const {
        const int rb = wr * 64 + fr, colb = u.c0 * 256 + wc * 32 + 8 * fq;
#pragma unroll
        for (int ai = 0; ai < 2; ++ai)
#pragma unroll
            for (int m = 0; m < 4; ++m) { const int r = rb + ai * HALF + m * 16; const int ent = ((const LAS int*)tab)[r]; const float w = ((const LAS float*)tab)[256 + r];
                if (ent >= 0) { unsigned char* rowp = Y2 + (size_t)ent * D + colb;
#pragma unroll
                    for (int bj = 0; bj < 2; ++bj) { const f32x4 a0 = acc[ai][bj][m][0] * w, a1 = acc[ai][bj][m][1] * w; v2u w8; w8.x = pk4_fp8(a0[0], a0[1], a0[2], a0[3]); w8.y = pk4_fp8(a1[0], a1[1], a1[2], a1[3]);
                        *(v2u*)(rowp + bj * HALF) = w8; } } }
    }
};
struct KSplitOrder {
    const char* A; const char* Bt; int lda, ldb, K, nM, nks, G, c;
    __device__ bool next(int i, Unit& u) const {
        const int L = i * G + c; if (L >= nM * nks) return false;
        const int pm = L / nks, ks = L % nks;
        u.a = A + ((size_t)pm * BM * lda + (size_t)ks * K) * 2; u.b = Bt + (size_t)ks * BM * ldb * 2; u.r0 = pm * BM; u.c0 = 0; u.aux = ks; u.r1 = 0; return true;
    }
    __device__ __forceinline__ unsigned arow(const Unit&, int) const { return 0u; }
};
}

struct Frame {
    LAS unsigned char* lds;
    unsigned* ctl;
    int tid, lane, wave, vcu, G;
    const float* const __attribute__((address_space(4)))* in;
    float* out; unsigned char* ws;
};
enum { I_X = 0, I_MEM, I_NORM_MIX, I_W_IN, I_Q_NORM, I_K_NORM, I_SINKS, I_REL_BIAS, I_LAM_RE, I_LAM_IM, I_LOG_DT, I_B_RE, I_B_IM, I_C_RE, I_C_IM, I_SSM_D, I_W_GLU,
       I_MEM_NORM, I_W_MEM_KV, I_XQ_NORM, I_XK_NORM, I_ON_ATTN, I_ON_SSM, I_ON_X, I_W_O, I_NORM_FFN, I_WR_G, I_WR_E, I_W_GATE, I_W_UP, I_W_DOWN };

struct TrItem { const float* W; bf16* WT; const float* ks; int ldw, ldt, k0, n0, drow0; };
__device__ __forceinline__ void tr_load(const TrItem& it, f32x4 (&v)[8], int lane) {
    const int kc = lane & 7, nq = lane >> 3; const float* src = it.W + (size_t)(it.k0 + kc * 8) * it.ldw + it.n0 + nq * 4;
#pragma unroll
    for (int j = 0; j < 8; ++j) v[j] = __builtin_nontemporal_load((const f32x4*)(src + (size_t)j * it.ldw));
}
__device__ __forceinline__ void tr_store(const TrItem& it, f32x4 (&v)[8], int lane) {
    const int kc = lane & 7, nq = lane >> 3;
    if (it.ks) { const f32x4 s0 = *(const f32x4*)(it.ks + it.k0 + kc * 8), s1 = *(const f32x4*)(it.ks + it.k0 + kc * 8 + 4);
#pragma unroll
        for (int j = 0; j < 4; ++j) { v[j] = v[j] * s0[j]; v[4 + j] = v[4 + j] * s1[j]; } }
#pragma unroll
    for (int i = 0; i < 4; ++i) { v4u o; o.x = pk2(v[0][i], v[1][i]); o.y = pk2(v[2][i], v[3][i]); o.z = pk2(v[4][i], v[5][i]); o.w = pk2(v[6][i], v[7][i]);
        *(v4u*)(it.WT + (size_t)(it.drow0 + nq * 4 + i) * it.ldt + it.k0 + kc * 8) = o; }
}
__device__ __forceinline__ void rms_row_to_bf16(const float* xrow, const float* gain, bf16* orow, int lane, float* rinv = nullptr) {
    const f32x4* xr = (const f32x4*)xrow + lane; const f32x4* gr = (const f32x4*)gain + lane;
    f32x4 v[8]; float s = 0.f;
#pragma unroll
    for (int j = 0; j < 8; ++j) { v[j] = xr[64 * j]; s += (v[j].x * v[j].x + v[j].y * v[j].y) + (v[j].z * v[j].z + v[j].w * v[j].w); }
    const float ms = wave_sum(s) * (1.f / 2048.f) + EPS; const float rstd = 1.0f / sqrtf(ms);
    if (rinv && lane == 0) *rinv = sqrtf(ms);
    v2u* o8 = (v2u*)orow + lane;
#pragma unroll
    for (int j = 0; j < 8; ++j) { const f32x4 g = gain ? gr[64 * j] : (f32x4){1.f, 1.f, 1.f, 1.f}; v2u w; w.x = pk2(v[j].x * rstd * g.x, v[j].y * rstd * g.y); w.y = pk2(v[j].z * rstd * g.z, v[j].w * rstd * g.w); o8[64 * j] = w; }
}

__device__ __forceinline__ void s5_tables(Frame& F, int g) {
    LAS float* ap = (LAS float*)F.lds;
    LAS float* Bb = ap + 33 * 64 * 2;
    LAS float* Cc = Bb + 64 * 16 * 2;
    LAS float* Km = Cc + 16 * 64 * 2;
    const float dt = expf(F.in[I_LOG_DT][g]);
    const float* lre = F.in[I_LAM_RE] + g * 64; const float* lim = F.in[I_LAM_IM] + g * 64;
    for (int idx = F.tid; idx < 33 * 64; idx += 512) { const int tau = idx >> 6, n = idx & 63; const float lr = lre[n], li = lim[n];
        const float mag = expf((float)tau * (lr * dt)), ang = (float)tau * (li * dt); ap[idx * 2] = mag * cosf(ang); ap[idx * 2 + 1] = mag * sinf(ang); }
    __syncthreads();
    for (int idx = F.tid; idx < 64 * 16; idx += 512) { const int n = idx >> 4; const float lr = lre[n], li = lim[n];
        const float nr = ap[(64 + n) * 2] - 1.0f, ni = ap[(64 + n) * 2 + 1], den = lr * lr + li * li;
        const float cr = (nr * lr + ni * li) / den, ci = (ni * lr - nr * li) / den;
        const float br = F.in[I_B_RE][(size_t)g * 1024 + idx], bi = F.in[I_B_IM][(size_t)g * 1024 + idx];
        Bb[idx * 2] = cr * br - ci * bi; Bb[idx * 2 + 1] = cr * bi + ci * br; }
    for (int idx = F.tid; idx < 16 * 64; idx += 512) { Cc[idx * 2] = F.in[I_C_RE][(size_t)g * 1024 + idx]; Cc[idx * 2 + 1] = F.in[I_C_IM][(size_t)g * 1024 + idx]; }
    __syncthreads();
    for (int idx = F.tid; idx < 32 * 256; idx += 512) { const int tau = idx >> 8, c = (idx >> 4) & 15, c2 = idx & 15; float s = 0.f;
        for (int n = 0; n < 64; ++n) { const float ar = ap[(tau * 64 + n) * 2], ai = ap[(tau * 64 + n) * 2 + 1], cr = Cc[(c * 64 + n) * 2], ci = Cc[(c * 64 + n) * 2 + 1];
            const float er = cr * ar - ci * ai, ei = cr * ai + ci * ar; s += er * Bb[(n * 16 + c2) * 2] - ei * Bb[(n * 16 + c2) * 2 + 1]; }
        Km[idx] = s; }
    __syncthreads();
    bf16* MQ = (bf16*)(F.ws + WS_MQ) + (size_t)g * 512 * S5K;
    for (int idx = F.tid; idx < 512 * 80; idx += 512) { const int row = idx / 80, ch = idx % 80, i = row >> 4, c = row & 15, k0 = ch * 8; float v[8];
        if (k0 < 512) { const int s = k0 >> 4, c20 = k0 & 15, tau = i - s;
#pragma unroll
            for (int j = 0; j < 8; ++j) v[j] = tau >= 0 ? Km[(tau * 16 + c) * 16 + c20 + j] : 0.f;
        } else { const int kk = k0 - 512, ri = kk >> 6, n0 = kk & 63;
#pragma unroll
            for (int j = 0; j < 8; ++j) { const int n = n0 + j; const float ar = ap[((i + 1) * 64 + n) * 2], ai = ap[((i + 1) * 64 + n) * 2 + 1], cr = Cc[(c * 64 + n) * 2], ci = Cc[(c * 64 + n) * 2 + 1];
                v[j] = ri == 0 ? (cr * ar - ci * ai) : -(cr * ai + ci * ar); } }
        v4u o; o.x = pk2(v[0], v[1]); o.y = pk2(v[2], v[3]); o.z = pk2(v[4], v[5]); o.w = pk2(v[6], v[7]);
        *(v4u*)(MQ + (size_t)row * S5K + k0) = o; }
    bf16* SP = (bf16*)(F.ws + WS_SP) + (size_t)g * 256 * 512;
    for (int idx = F.tid; idx < 256 * 64; idx += 512) { const int row = idx >> 6, k0 = (idx & 63) * 8; float v[8];
        if (row < 128) { const int ri = row >> 6, n = row & 63, s = k0 >> 4, c20 = k0 & 15; const float ar = ap[((31 - s) * 64 + n) * 2], ai = ap[((31 - s) * 64 + n) * 2 + 1];
#pragma unroll
            for (int j = 0; j < 8; ++j) { const float br = Bb[(n * 16 + c20 + j) * 2], bi = Bb[(n * 16 + c20 + j) * 2 + 1]; v[j] = ri == 0 ? (ar * br - ai * bi) : (ar * bi + ai * br); }
        } else {
#pragma unroll
            for (int j = 0; j < 8; ++j) v[j] = 0.f; }
        v4u o; o.x = pk2(v[0], v[1]); o.y = pk2(v[2], v[3]); o.z = pk2(v[4], v[5]); o.w = pk2(v[6], v[7]);
        *(v4u*)(SP + (size_t)row * 512 + k0) = o; }
    float* AL = (float*)(F.ws + WS_AL) + g * 128;
    if (F.tid < 64) { AL[F.tid * 2] = ap[(32 * 64 + F.tid) * 2]; AL[F.tid * 2 + 1] = ap[(32 * 64 + F.tid) * 2 + 1]; }
    __syncthreads();
}

struct BigTile { const float* src; unsigned char* dst; const float* ks; float sc; int ldw, ldt; };
constexpr int BT_GU = 64 * 2 * 64, BT_D = 64 * 64, BT_N = BT_GU + BT_D, BT_PITCH = 136;
__device__ __forceinline__ BigTile bt_decode(const Frame& F, unsigned char* Wgu8, unsigned char* Wd8, const float* nf, int ti) {
    BigTile t;
    const unsigned long long pg = (unsigned long long)F.in[I_W_GATE], pu = (unsigned long long)F.in[I_W_UP], pd = (unsigned long long)F.in[I_W_DOWN];
    if (ti < BT_GU) { const int e = ti >> 7, r = ti & 127, which = r >> 6, kb = (r >> 2) & 15, nb = r & 3;
        const unsigned long long p = pg + ((pu - pg) & (0ull - (unsigned long long)which));
        t.src = (const float*)p + (size_t)e * D * DEXP + (size_t)kb * 128 * DEXP + nb * 128; t.dst = Wgu8 + ((size_t)e * 1024 + nb * 256 + which * 128) * D + kb * 128; t.ks = nf + kb * 128; t.sc = SC_WGU; t.ldw = DEXP; t.ldt = D; }
    else { const int t2 = ti - BT_GU, e = t2 >> 6, r = t2 & 63, kb = r >> 4, nb = r & 15;
        t.src = (const float*)pd + (size_t)e * DEXP * D + (size_t)kb * 128 * D + nb * 128; t.dst = Wd8 + ((size_t)e * D + nb * 128) * DEXP + kb * 128; t.ks = nullptr; t.sc = SC_WD; t.ldw = D; t.ldt = DEXP; }
    return t;
}
#define BT_LOAD(t, v, kv) do { const unsigned _lo = (unsigned)(rl * 8 * (t).ldw + cq * 4); \
    _Pragma("unroll") for (int _p = 0; _p < 8; ++_p) kv[_p] = (t).ks ? (t).ks[rl * 8 + _p] * (t).sc : (t).sc; \
    _Pragma("unroll") for (int _p = 0; _p < 8; ++_p) v[_p] = __builtin_nontemporal_load((const f32x4*)((t).src + (size_t)_p * (t).ldw + _lo)); } while (0)
#define BT_STORE(t, v, kv) do { \
    _Pragma("unroll") for (int _i = 0; _i < 4; ++_i) { v2u _w; _w.x = pk4_fp8(v[0][_i] * kv[0], v[1][_i] * kv[1], v[2][_i] * kv[2], v[3][_i] * kv[3]); _w.y = pk4_fp8(v[4][_i] * kv[4], v[5][_i] * kv[5], v[6][_i] * kv[6], v[7][_i] * kv[7]); \
        *(LAS v2u*)(img + (cq * 4 + _i) * BT_PITCH + rl * 8) = _w; } \
    __syncthreads(); \
    _Pragma("unroll") for (int _j = 0; _j < 2; ++_j) { const int _idx = tid_ + _j * 512, _n = _idx >> 3, _ch = _idx & 7; \
        const v2u _a = *(const LAS v2u*)(img + _n * BT_PITCH + _ch * 16), _b = *(const LAS v2u*)(img + _n * BT_PITCH + _ch * 16 + 8); v4u _o; _o.x = _a.x; _o.y = _a.y; _o.z = _b.x; _o.w = _b.y; \
        *(v4u*)((t).dst + (size_t)_n * (t).ldt + _ch * 16) = _o; } \
    __syncthreads(); } while (0)
__device__ __forceinline__ void bg_convert(Frame& F, int qword, int base, int ntiles, int budget) {
    if (budget <= 0) return;
    int lane_ = (int)__builtin_amdgcn_mbcnt_hi(~0u, __builtin_amdgcn_mbcnt_lo(~0u, 0u)); asm volatile("" : "+v"(lane_)); const int tid_ = F.wave * 64 + lane_;
    unsigned char* WguT = F.ws + WS_WGU; unsigned char* WdT = F.ws + WS_WD; const float* nf = F.in[I_NORM_FFN];
    const int rl = tid_ >> 5, cq = tid_ & 31; LAS unsigned char* img = F.lds; LAS int* qn = (LAS int*)(F.lds + TAB_OFF + 1024);
    f32x4 va[8], vb[8]; float ka[8], kb[8];
    int nfetch = 0;
#define BG_FETCH(slot) do { if (nfetch < budget) { if (tid_ == 0) qn[slot] = (int)atomicAdd(F.ctl + qword, 1u); } else if (tid_ == 0) qn[slot] = 0x7fffffff; ++nfetch; } while (0)
    __syncthreads();
    BG_FETCH(0); BG_FETCH(1);
    __syncthreads();
    int i0 = __builtin_amdgcn_readfirstlane(qn[0]), i1 = __builtin_amdgcn_readfirstlane(qn[1]);
    __syncthreads();
    if (i0 < ntiles) { const BigTile t0 = bt_decode(F, WguT, WdT, nf, base + i0); BT_LOAD(t0, va, ka); }
    while (i0 < ntiles) {
        const BigTile ta = bt_decode(F, WguT, WdT, nf, base + i0);
        const BigTile tb = bt_decode(F, WguT, WdT, nf, base + (i1 < ntiles ? i1 : i0));
        BT_LOAD(tb, vb, kb);
        if (i1 >= ntiles) budget = 0;
        BG_FETCH(0);
        BT_STORE(ta, va, ka);
        const int i2 = __builtin_amdgcn_readfirstlane(qn[0]);
        if (i1 >= ntiles) break;
        const BigTile tc = bt_decode(F, WguT, WdT, nf, base + (i2 < ntiles ? i2 : i1));
        BT_LOAD(tc, va, ka);
        if (i2 >= ntiles) budget = 0;
        BG_FETCH(1);
        BT_STORE(tb, vb, kb);
        const int i3 = __builtin_amdgcn_readfirstlane(qn[1]);
        i0 = i2; i1 = i3;
    }
    __syncthreads();
#undef BG_FETCH
}
__device__ __forceinline__ void p0_prologue(Frame& F) {
    if (F.vcu < 32) s5_tables(F, F.vcu);
    const int gw = F.vcu * 8 + F.wave, NGW = F.G * 8;
    bf16* WinT = (bf16*)(F.ws + WS_WIN); bf16* WoT = (bf16*)(F.ws + WS_WO); bf16* WmkvT = (bf16*)(F.ws + WS_WMKV); bf16* WgluT = (bf16*)(F.ws + WS_WGLU);
    const float* nf = F.in[I_NORM_FFN];
    constexpr int I_IN = 32 * 72, I_O = 32 * 64, I_MKV = 32 * 32, I_GLU = 8 * 16;
    constexpr int NITEMS = I_IN + I_O + I_MKV + I_GLU;
    auto decode = [&](int it) -> TrItem {
        int r = it;
        if (r < I_IN) { const int kb = r / 72, nb = r % 72; return TrItem{F.in[I_W_IN], WinT, F.in[I_NORM_MIX]  , INC, D, kb * 64, nb * 32, nb * 32}; } r -= I_IN;
        if (r < I_O) { const int kb = r / 64, nb = r % 64, k0 = kb * 64;
            const unsigned long long pa = (unsigned long long)F.in[I_ON_ATTN], ps = (unsigned long long)(F.in[I_ON_SSM] - 1024), px = (unsigned long long)(F.in[I_ON_X] - 1536);
            const unsigned long long m1 = 0ull - (unsigned long long)(k0 >= 1024), m2 = 0ull - (unsigned long long)(k0 >= 1536);
            const unsigned long long pk = pa + ((ps - pa) & m1) + ((px - ps) & m2);
            return TrItem{F.in[I_W_O], WoT, (const float*)pk, D, D, k0, nb * 32, nb * 32}; } r -= I_O;
        if (r < I_MKV) { const int kb = r / 32, nb = r % 32; return TrItem{F.in[I_W_MEM_KV], WmkvT, nullptr, 1024, D, kb * 64, nb * 32, nb * 32}; } r -= I_MKV;
        const int kb = r / 16, nb = r % 16; return TrItem{F.in[I_W_GLU], WgluT, nullptr, 512, 512, kb * 64, nb * 32, nb * 32};
    };
    {
        f32x4 va[8], vb[8]; int it = gw; TrItem ia, ib;
        if (it < NITEMS) { ia = decode(it); tr_load(ia, va, F.lane); }
        while (it < NITEMS) {
            const int it2 = it + NGW; if (it2 < NITEMS) { ib = decode(it2); tr_load(ib, vb, F.lane); }
            tr_store(ia, va, F.lane);
            if (it2 >= NITEMS) break;
            const int it3 = it2 + NGW; if (it3 < NITEMS) { ia = decode(it3); tr_load(ia, va, F.lane); }
            tr_store(ib, vb, F.lane);
            it = it3;
        }
    }
    { bf16* WrT = (bf16*)(F.ws + WS_WR); const int gt = F.vcu * 512 + F.tid, NT = F.G * 512;
      for (int idx = gt; idx < 4 * 256 * 512; idx += NT) { const int ks = idx >> 17, n = (idx >> 9) & 255, k = ks * 512 + (idx & 511); float v = 0.f;
          if (n < 8) v = F.in[I_WR_G][k * 8 + n] * nf[k]; else if (n < 72) v = F.in[I_WR_E][k * 64 + (n - 8)] * nf[k];
          WrT[idx] = (bf16)f2bf(v); } }
    bf16* XN = (bf16*)(F.ws + WS_XN); bf16* MEMN = (bf16*)(F.ws + WS_MEMN);
    for (int m = gw; m < T; m += NGW) rms_row_to_bf16(F.in[I_X] + (size_t)m * D, nullptr, XN + (size_t)m * D, F.lane, (float*)(F.ws + WS_RINV) + m);
    for (int m = gw; m < NB * MEML; m += NGW) rms_row_to_bf16(F.in[I_MEM] + (size_t)m * D, F.in[I_MEM_NORM], MEMN + (size_t)m * D, F.lane);
    bg_convert(F, CW_QGU, 0, BT_GU, F.vcu < 32 ? PB0_S5 : PB0);
    bg_convert(F, CW_QD, BT_GU, BT_D, PB0_D);
}

constexpr int SWA_KS = 72, SWA_VS = 264;
constexpr int SWA_KOFF = 0, SWA_VOFF = 256 * SWA_KS * 2, SWA_BOFF = SWA_VOFF + 64 * SWA_VS * 2;
__device__ __forceinline__ int t5_bucket(int n) { if (n < 16) return n; const int v = 16 + (int)(logf((float)n * (1.0f / 16.0f)) / logf(8.0f) * 16.0f); return v < 31 ? v : 31; }
__device__ __forceinline__ void swa_unit(Frame& F, int unit) {
    const int b = unit >> 5, kvh = (unit >> 4) & 1, nb = unit & 15;
    const bf16* PROJ = (const bf16*)(F.ws + WS_PROJ); bf16* MIX = (bf16*)(F.ws + WS_MIX);
    LAS bf16* Ks = (LAS bf16*)(F.lds + SWA_KOFF); LAS bf16* Vt = (LAS bf16*)(F.lds + SWA_VOFF); LAS float* bt = (LAS float*)(F.lds + SWA_BOFF);
    const int w = F.wave, h = kvh * 8 + w, ql = F.lane & 31, hh = F.lane >> 5;
    v4u qnx[4];
    { const bf16* qp = PROJ + ((size_t)b * SEQ + nb * 128 + ql) * INC + h * 64 + 8 * hh;
#pragma unroll
      for (int ks = 0; ks < 4; ++ks) qnx[ks] = *(const v4u*)(qp + ks * 16); }
    __syncthreads();
    {
        const int key = F.tid >> 1, half = F.tid & 1, s = (nb - 1) * 128 + key;
        v4u kw[4], vw[4];
        if (s >= 0) { const bf16* rp = PROJ + (size_t)(b * SEQ + s) * INC + 1024 + kvh * 64 + half * 32;
#pragma unroll
            for (int j = 0; j < 4; ++j) { kw[j] = *(const v4u*)(rp + j * 8); vw[j] = *(const v4u*)(rp + 128 + j * 8); }
        } else {
#pragma unroll
            for (int j = 0; j < 4; ++j) { kw[j] = (v4u){0u, 0u, 0u, 0u}; vw[j] = (v4u){0u, 0u, 0u, 0u}; } }
        float kf[32]; float ss = 0.f;
#pragma unroll
        for (int j = 0; j < 4; ++j) { kf[j * 8 + 0] = bflo(kw[j].x); kf[j * 8 + 1] = bfhi(kw[j].x); kf[j * 8 + 2] = bflo(kw[j].y); kf[j * 8 + 3] = bfhi(kw[j].y);
            kf[j * 8 + 4] = bflo(kw[j].z); kf[j * 8 + 5] = bfhi(kw[j].z); kf[j * 8 + 6] = bflo(kw[j].w); kf[j * 8 + 7] = bfhi(kw[j].w); }
#pragma unroll
        for (int j = 0; j < 32; ++j) ss += kf[j] * kf[j];
        ss += __shfl_xor(ss, 1);
        const float rstd = 1.0f / sqrtf(ss * (1.f / 64.f) + EPS);
        const float* kn = F.in[I_K_NORM] + half * 32;
#pragma unroll
        for (int j = 0; j < 4; ++j) { v4u o; o.x = pk2(kf[j * 8 + 0] * rstd * kn[j * 8 + 0], kf[j * 8 + 1] * rstd * kn[j * 8 + 1]); o.y = pk2(kf[j * 8 + 2] * rstd * kn[j * 8 + 2], kf[j * 8 + 3] * rstd * kn[j * 8 + 3]);
            o.z = pk2(kf[j * 8 + 4] * rstd * kn[j * 8 + 4], kf[j * 8 + 5] * rstd * kn[j * 8 + 5]); o.w = pk2(kf[j * 8 + 6] * rstd * kn[j * 8 + 6], kf[j * 8 + 7] * rstd * kn[j * 8 + 7]);
            *(LAS v4u*)(Ks + key * SWA_KS + half * 32 + j * 8) = o; }
#pragma unroll
        for (int j = 0; j < 4; ++j) { const unsigned w4[4] = {vw[j].x, vw[j].y, vw[j].z, vw[j].w};
#pragma unroll
            for (int q = 0; q < 4; ++q) { const int d = half * 32 + j * 8 + q * 2; Vt[d * SWA_VS + key] = (bf16)(w4[q] & 0xffffu); Vt[(d + 1) * SWA_VS + key] = (bf16)(w4[q] >> 16); } }
        for (int idx = F.tid; idx < 8 * 128; idx += 512) { const int w = idx >> 7, dl = idx & 127; bt[idx] = F.in[I_REL_BIAS][t5_bucket(dl) * 16 + kvh * 8 + w]; }
    }
    __syncthreads();
    const float sink = F.in[I_SINKS][h];
    const float* qn = F.in[I_Q_NORM];
    for (int r = 0; r < 4; ++r) {
        const int qi = 32 * r + ql; const size_t t = (size_t)b * SEQ + nb * 128 + qi;
        bf16x8 qf[4];
        {   v4u qw[4]; float qv[32]; float ss = 0.f;
#pragma unroll
            for (int ks = 0; ks < 4; ++ks) qw[ks] = qnx[ks];
            if (r < 3) { const bf16* qp = PROJ + (t + 32) * INC + h * 64 + 8 * hh;
#pragma unroll
                for (int ks = 0; ks < 4; ++ks) qnx[ks] = *(const v4u*)(qp + ks * 16); }
#pragma unroll
            for (int ks = 0; ks < 4; ++ks) { qv[ks * 8 + 0] = bflo(qw[ks].x); qv[ks * 8 + 1] = bfhi(qw[ks].x); qv[ks * 8 + 2] = bflo(qw[ks].y); qv[ks * 8 + 3] = bfhi(qw[ks].y);
                qv[ks * 8 + 4] = bflo(qw[ks].z); qv[ks * 8 + 5] = bfhi(qw[ks].z); qv[ks * 8 + 6] = bflo(qw[ks].w); qv[ks * 8 + 7] = bfhi(qw[ks].w); }
#pragma unroll
            for (int j = 0; j < 32; ++j) ss += qv[j] * qv[j];
            ss += __shfl_xor(ss, 32);
            const float sc = 0.125f / sqrtf(ss * (1.f / 64.f) + EPS);
#pragma unroll
            for (int ks = 0; ks < 4; ++ks) { const float* g = qn + ks * 16 + 8 * hh; v4u o;
                o.x = pk2(qv[ks * 8 + 0] * sc * g[0], qv[ks * 8 + 1] * sc * g[1]); o.y = pk2(qv[ks * 8 + 2] * sc * g[2], qv[ks * 8 + 3] * sc * g[3]);
                o.z = pk2(qv[ks * 8 + 4] * sc * g[4], qv[ks * 8 + 5] * sc * g[5]); o.w = pk2(qv[ks * 8 + 6] * sc * g[6], qv[ks * 8 + 7] * sc * g[7]);
                qf[ks] = __builtin_bit_cast(bf16x8, o); } }
        f32x16 s[5];
        const int qh = ql - 4 * hh; const LAS float* pb = bt + w * 128 + qh;
        float mx = sink;
#pragma unroll
        for (int kt = 0; kt < 5; ++kt) {
            const bool live = (nb > 0) || (r + kt >= 4);
            f32x16 a = {0.f, 0.f, 0.f, 0.f, 0.f, 0.f, 0.f, 0.f, 0.f, 0.f, 0.f, 0.f, 0.f, 0.f, 0.f, 0.f};
            if (live) {
#pragma unroll
                for (int ks = 0; ks < 4; ++ks) { const bf16x8 kfrag = *(const LAS bf16x8*)(Ks + (32 * (r + kt) + ql) * SWA_KS + ks * 16 + 8 * hh);
                    a = __builtin_amdgcn_mfma_f32_32x32x16_bf16(kfrag, qf[ks], a, 0, 0, 0); }
#pragma unroll
                for (int rg = 0; rg < 16; ++rg) { const int rowc = (rg & 3) + 8 * (rg >> 2);
                    float v = a[rg] + pb[128 - 32 * kt - rowc];
                    if (kt == 0) v = (rowc > qh) ? v : -1e30f;
                    if (kt == 4) v = (rowc <= qh) ? v : -1e30f;
                    a[rg] = v; mx = fmaxf(mx, v); }
            } else {
#pragma unroll
                for (int rg = 0; rg < 16; ++rg) a[rg] = -1e30f;
            }
            s[kt] = a; }
        mx = fmaxf(mx, __shfl_xor(mx, 32));
        float l = 0.f;
#pragma unroll
        for (int kt = 0; kt < 5; ++kt)
#pragma unroll
            for (int rg = 0; rg < 16; ++rg) { const float p = fast_exp(s[kt][rg] - mx); s[kt][rg] = p; l += p; }
        l += __shfl_xor(l, 32);
        l += fast_exp(sink - mx);
        f32x16 o[2];
#pragma unroll
        for (int dt = 0; dt < 2; ++dt) o[dt] = (f32x16){0.f, 0.f, 0.f, 0.f, 0.f, 0.f, 0.f, 0.f, 0.f, 0.f, 0.f, 0.f, 0.f, 0.f, 0.f, 0.f};
#pragma unroll
        for (int kt = 0; kt < 5; ++kt)
#pragma unroll
            for (int st = 0; st < 2; ++st) { v4u pw; pw.x = pk2(s[kt][8 * st + 0], s[kt][8 * st + 1]); pw.y = pk2(s[kt][8 * st + 2], s[kt][8 * st + 3]); pw.z = pk2(s[kt][8 * st + 4], s[kt][8 * st + 5]); pw.w = pk2(s[kt][8 * st + 6], s[kt][8 * st + 7]);
                const bf16x8 pf = __builtin_bit_cast(bf16x8, pw);
#pragma unroll
                for (int dt = 0; dt < 2; ++dt) { const LAS bf16* vp = Vt + (dt * 32 + ql) * SWA_VS + 32 * (r + kt) + 16 * st + 4 * hh;
                    const v2u lo = *(const LAS v2u*)vp, hi = *(const LAS v2u*)(vp + 8); v4u vv; vv.x = lo.x; vv.y = lo.y; vv.z = hi.x; vv.w = hi.y;
                    o[dt] = __builtin_amdgcn_mfma_f32_32x32x16_bf16(__builtin_bit_cast(bf16x8, vv), pf, o[dt], 0, 0, 0); } }
        const float inv = 1.0f / l;
        { float ssq = 0.f;
#pragma unroll
          for (int dt = 0; dt < 2; ++dt)
#pragma unroll
              for (int rg = 0; rg < 16; ++rg) { const float v = o[dt][rg] * inv; ssq += v * v; }
          ssq += __shfl_xor(ssq, 32);
          if (hh == 0) ((float*)(F.ws + WS_SS))[t * 32 + h] = ssq; }
        bf16* op = MIX + t * D + h * 64 + 4 * hh;
#pragma unroll
        for (int dt = 0; dt < 2; ++dt)
#pragma unroll
            for (int q4 = 0; q4 < 4; ++q4) { v2u ow; ow.x = pk2(o[dt][q4 * 4 + 0] * inv, o[dt][q4 * 4 + 1] * inv); ow.y = pk2(o[dt][q4 * 4 + 2] * inv, o[dt][q4 * 4 + 3] * inv);
                *(v2u*)(op + dt * 32 + q4 * 8) = ow; }
    }
}

constexpr int XA_KS = 136, XA_VS = 264;
constexpr int XA_KOFF = 0, XA_VOFF = 256 * XA_KS * 2;
__device__ __forceinline__ void xattn_unit(Frame& F, int unit) {
    const int b = unit >> 5, hx = (unit >> 3) & 3, qb = unit & 7;
    const bf16* PROJ = (const bf16*)(F.ws + WS_PROJ); const bf16* MKV = (const bf16*)(F.ws + WS_MEMKV); bf16* MIX = (bf16*)(F.ws + WS_MIX);
    LAS bf16* Ks = (LAS bf16*)(F.lds + XA_KOFF); LAS bf16* Vt = (LAS bf16*)(F.lds + XA_VOFF);
    __syncthreads();
    {   const int key = F.tid >> 1, half = F.tid & 1; const bf16* rp = MKV + (size_t)(b * MEML + key) * 1024 + hx * 128 + half * 64;
        float ss = 0.f; v4u kw[8];
#pragma unroll
        for (int j = 0; j < 8; ++j) { kw[j] = *(const v4u*)(rp + j * 8);
            const float a0 = bflo(kw[j].x), a1 = bfhi(kw[j].x), a2 = bflo(kw[j].y), a3 = bfhi(kw[j].y), a4 = bflo(kw[j].z), a5 = bfhi(kw[j].z), a6 = bflo(kw[j].w), a7 = bfhi(kw[j].w);
            ss += (a0 * a0 + a1 * a1) + (a2 * a2 + a3 * a3) + (a4 * a4 + a5 * a5) + (a6 * a6 + a7 * a7); }
        ss += __shfl_xor(ss, 1);
        const float rstd = 1.0f / sqrtf(ss * (1.f / 128.f) + EPS);
        const float* kn = F.in[I_XK_NORM] + half * 64;
#pragma unroll
        for (int j = 0; j < 8; ++j) { v4u o; const float* g = kn + j * 8;
            o.x = pk2(bflo(kw[j].x) * rstd * g[0], bfhi(kw[j].x) * rstd * g[1]); o.y = pk2(bflo(kw[j].y) * rstd * g[2], bfhi(kw[j].y) * rstd * g[3]);
            o.z = pk2(bflo(kw[j].z) * rstd * g[4], bfhi(kw[j].z) * rstd * g[5]); o.w = pk2(bflo(kw[j].w) * rstd * g[6], bfhi(kw[j].w) * rstd * g[7]);
            *(LAS v4u*)(Ks + key * XA_KS + half * 64 + j * 8) = o; }
#pragma unroll
        for (int j = 0; j < 8; ++j) { const v4u vw = *(const v4u*)(rp + 512 + j * 8); const unsigned w4[4] = {vw.x, vw.y, vw.z, vw.w};
#pragma unroll
            for (int q = 0; q < 4; ++q) { const int d = half * 64 + j * 8 + q * 2; Vt[d * XA_VS + key] = (bf16)(w4[q] & 0xffffu); Vt[(d + 1) * XA_VS + key] = (bf16)(w4[q] >> 16); } }
    }
    __syncthreads();
    const int ql = F.lane & 31, hh = F.lane >> 5;
    const size_t t = (size_t)b * SEQ + qb * 256 + F.wave * 32 + ql;
    bf16x8 qf[8];
    {   const bf16* qp = PROJ + t * INC + 1792 + hx * 128 + 8 * hh; v4u qw[8]; float ss = 0.f;
#pragma unroll
        for (int ks = 0; ks < 8; ++ks) { qw[ks] = *(const v4u*)(qp + ks * 16);
            const float a0 = bflo(qw[ks].x), a1 = bfhi(qw[ks].x), a2 = bflo(qw[ks].y), a3 = bfhi(qw[ks].y), a4 = bflo(qw[ks].z), a5 = bfhi(qw[ks].z), a6 = bflo(qw[ks].w), a7 = bfhi(qw[ks].w);
            ss += (a0 * a0 + a1 * a1) + (a2 * a2 + a3 * a3) + (a4 * a4 + a5 * a5) + (a6 * a6 + a7 * a7); }
        ss += __shfl_xor(ss, 32);
        const float sc = 0.08838834764831845f / sqrtf(ss * (1.f / 128.f) + EPS);
        const float* qn = F.in[I_XQ_NORM] + 8 * hh;
#pragma unroll
        for (int ks = 0; ks < 8; ++ks) { const float* g = qn + ks * 16; v4u o;
            o.x = pk2(bflo(qw[ks].x) * sc * g[0], bfhi(qw[ks].x) * sc * g[1]); o.y = pk2(bflo(qw[ks].y) * sc * g[2], bfhi(qw[ks].y) * sc * g[3]);
            o.z = pk2(bflo(qw[ks].z) * sc * g[4], bfhi(qw[ks].z) * sc * g[5]); o.w = pk2(bflo(qw[ks].w) * sc * g[6], bfhi(qw[ks].w) * sc * g[7]);
            qf[ks] = __builtin_bit_cast(bf16x8, o); } }
    f32x16 o[4];
#pragma unroll
    for (int dt = 0; dt < 4; ++dt) o[dt] = (f32x16){0.f, 0.f, 0.f, 0.f, 0.f, 0.f, 0.f, 0.f, 0.f, 0.f, 0.f, 0.f, 0.f, 0.f, 0.f, 0.f};
    float mrun = -1e30f, lrun = 0.f;
    for (int kb = 0; kb < 4; ++kb) {
        f32x16 s[2];
#pragma unroll
        for (int kt = 0; kt < 2; ++kt) { f32x16 a = {0.f, 0.f, 0.f, 0.f, 0.f, 0.f, 0.f, 0.f, 0.f, 0.f, 0.f, 0.f, 0.f, 0.f, 0.f, 0.f};
#pragma unroll
            for (int ks = 0; ks < 8; ++ks) { const bf16x8 kfrag = *(const LAS bf16x8*)(Ks + (64 * kb + 32 * kt + ql) * XA_KS + ks * 16 + 8 * hh);
                a = __builtin_amdgcn_mfma_f32_32x32x16_bf16(kfrag, qf[ks], a, 0, 0, 0); }
            s[kt] = a; }
        float mx = mrun;
#pragma unroll
        for (int kt = 0; kt < 2; ++kt)
#pragma unroll
            for (int rg = 0; rg < 16; ++rg) mx = fmaxf(mx, s[kt][rg]);
        mx = fmaxf(mx, __shfl_xor(mx, 32));
        const float alpha = fast_exp(mrun - mx); mrun = mx;
        float ls = 0.f;
#pragma unroll
        for (int kt = 0; kt < 2; ++kt)
#pragma unroll
            for (int rg = 0; rg < 16; ++rg) { const float p = fast_exp(s[kt][rg] - mx); s[kt][rg] = p; ls += p; }
        lrun = lrun * alpha + ls;
#pragma unroll
        for (int dt = 0; dt < 4; ++dt)
#pragma unroll
            for (int rg = 0; rg < 16; ++rg) o[dt][rg] *= alpha;
#pragma unroll
        for (int kt = 0; kt < 2; ++kt)
#pragma unroll
            for (int st = 0; st < 2; ++st) { v4u pw; pw.x = pk2(s[kt][8 * st + 0], s[kt][8 * st + 1]); pw.y = pk2(s[kt][8 * st + 2], s[kt][8 * st + 3]); pw.z = pk2(s[kt][8 * st + 4], s[kt][8 * st + 5]); pw.w = pk2(s[kt][8 * st + 6], s[kt][8 * st + 7]);
                const bf16x8 pf = __builtin_bit_cast(bf16x8, pw);
#pragma unroll
                for (int dt = 0; dt < 4; ++dt) { const LAS bf16* vp = Vt + (dt * 32 + ql) * XA_VS + 64 * kb + 32 * kt + 16 * st + 4 * hh;
                    const v2u lo = *(const LAS v2u*)vp, hi = *(const LAS v2u*)(vp + 8); v4u vv; vv.x = lo.x; vv.y = lo.y; vv.z = hi.x; vv.w = hi.y;
                    o[dt] = __builtin_amdgcn_mfma_f32_32x32x16_bf16(__builtin_bit_cast(bf16x8, vv), pf, o[dt], 0, 0, 0); } }
    }
    lrun += __shfl_xor(lrun, 32);
    const float inv = 1.0f / lrun;
    { float ssq = 0.f;
#pragma unroll
      for (int dt = 0; dt < 4; ++dt)
#pragma unroll
          for (int rg = 0; rg < 16; ++rg) { const float v = o[dt][rg] * inv; ssq += v * v; }
      ssq += __shfl_xor(ssq, 32);
      if (hh == 0) ((float*)(F.ws + WS_SS))[t * 32 + 24 + hx] = ssq; }
    bf16* op = MIX + t * D + 1536 + hx * 128 + 4 * hh;
#pragma unroll
    for (int dt = 0; dt < 4; ++dt)
#pragma unroll
        for (int q4 = 0; q4 < 4; ++q4) { v2u ow; ow.x = pk2(o[dt][q4 * 4 + 0] * inv, o[dt][q4 * 4 + 1] * inv); ow.y = pk2(o[dt][q4 * 4 + 2] * inv, o[dt][q4 * 4 + 3] * inv);
            *(v2u*)(op + dt * 32 + q4 * 8) = ow; }
}

__device__ __forceinline__ void moe_tables(Frame& F) {
    LAS int* cnt = (LAS int*)(F.lds + TAB_OFF); LAS int* ts = cnt + 64;
    __syncthreads();
    if (F.tid < 64) { const int c = (int)__hip_atomic_load(F.ctl + CW_CNT + F.tid, __ATOMIC_RELAXED, __HIP_MEMORY_SCOPE_AGENT); const int nt = (c + 255) >> 8; int inc = nt;
#pragma unroll
        for (int o = 1; o < 64; o <<= 1) { const int v = __shfl_up(inc, o); if (F.tid >= o) inc += v; }
        cnt[F.tid] = c; ts[F.tid + 1] = inc; if (F.tid == 0) ts[0] = 0; }
    __syncthreads();
}

struct Args { const float* in[31]; float* out; unsigned char* ws; int ph_lo, ph_hi; };
__global__ void __launch_bounds__(512, 2) hymba_fwd(Args args) {
    extern __shared__ __attribute__((aligned(16))) unsigned char lds_raw[];
    Frame F;
    F.lds = (LAS unsigned char*)lds_raw;
    F.tid = threadIdx.x; F.lane = F.tid & 63; F.wave = __builtin_amdgcn_readfirstlane(F.tid >> 6);
    F.G = gridDim.x; { const int bx = blockIdx.x; F.vcu = (F.G % 8 == 0) ? (bx % 8) * (F.G / 8) + bx / 8 : bx; }
    F.in = (const float* const __attribute__((address_space(4)))*)__builtin_amdgcn_kernarg_segment_ptr();
    F.out = args.out; F.ws = args.ws; F.ctl = (unsigned*)(args.ws + WS_CTL);
    const int lo = args.ph_lo, hi = args.ph_hi;
#if !MK_PER_PHASE
    if (F.tid < 4) ((LAS unsigned*)(F.lds + XBW_OFF))[F.tid] = 0u;
    __syncthreads();
    XcdBarrier bar = xcd_barrier_post(F.ctl + CW_BAR, (volatile LAS unsigned*)(F.lds + XBW_OFF));
#define GRID_BAR() xcd_barrier(bar)
#else
#define GRID_BAR() do {} while (0)
#endif
#define PHASE_REGS() do { int _l = (int)__builtin_amdgcn_mbcnt_hi(~0u, __builtin_amdgcn_mbcnt_lo(~0u, 0u)); asm volatile("" : "+v"(_l)); F.lane = _l; F.tid = F.wave * 64 + _l; } while (0)
#define IN(k) (lo <= (k) && (k) < hi)
#define SEAM(k) do { if (IN(k) && IN((k) + 1)) GRID_BAR(); } while (0)
    const int gw = F.vcu * 8 + F.wave, NGW = F.G * 8;
    bf16* const XN = (bf16*)(F.ws + WS_XN); bf16* const PROJ = (bf16*)(F.ws + WS_PROJ); bf16* const MIX = (bf16*)(F.ws + WS_MIX);
    bf16* const UA = (bf16*)(F.ws + WS_UA); bf16* const Gm = (bf16*)(F.ws + WS_G);

    if (IN(0)) { PHASE_REGS(); p0_prologue(F); }
    SEAM(0);
    if (IN(1)) { PHASE_REGS();
        { pg8::Gemm g{D, D, D}; pg8::DenseOrder S; S.init(XN, F.ws + WS_WIN, D, D, T, INC, F.G, (int)blockIdx.x);
          pg8::EpiProj E{PROJ, UA}; pg8::gemm_phase<pg8::EpiProj, pg8::DenseOrder>(F.lds, g, S, E, F.wave); }
        { pg8::Gemm g{D, D, D}; pg8::DenseOrder S; S.init(F.ws + WS_MEMN, F.ws + WS_WMKV, D, D, NB * MEML, 1024, F.G, F.G - 1 - (int)blockIdx.x);
          pg8::EpiBf16 E{(bf16*)(F.ws + WS_MEMKV), 1024}; pg8::gemm_phase<pg8::EpiBf16, pg8::DenseOrder>(F.lds, g, S, E, F.wave); }
        { const int c = (int)blockIdx.x; const bool has3 = 2 * F.G + c < (T / 256) * (INC / 256), haskv = (F.G - 1 - c) < (NB * MEML / 256) * 4;
          bg_convert(F, CW_QD, BT_GU, BT_D, (!has3 && !haskv) ? PB1 : 0); }
    }
    SEAM(1);
    if (IN(2)) { PHASE_REGS();
        for (int u = F.vcu; u < 256; u += F.G) swa_unit(F, u);
        __syncthreads();
        { pg8::Gemm g{S5K, 512, 256}; pg8::StateOrder S{(const char*)UA, (const char*)(F.ws + WS_SP), F.G, F.G - 1 - F.vcu};
          pg8::EpiF32 E{(float*)(F.ws + WS_SL), 256, (size_t)512 * 256}; pg8::gemm_phase<pg8::EpiF32, pg8::StateOrder>(F.lds, g, S, E, F.wave); }
        bg_convert(F, CW_QD, BT_GU, BT_D, (F.G - 1 - F.vcu) >= 128 ? PB2 : 0);
    }
    SEAM(2);
    if (IN(3)) { PHASE_REGS();
        if (F.wave < 4) { const float* SL = (const float*)(F.ws + WS_SL); const float* AL = (const float*)(F.ws + WS_AL);
            for (int L = F.vcu; L < 128; L += F.G) { const int g = L >> 2, pm = L & 1, b = 4 * pm + F.wave, n = F.lane;
                const float ar = AL[(g * 64 + n) * 2], ai = AL[(g * 64 + n) * 2 + 1]; float xr = 0.f, xi = 0.f;
                for (int j0 = 0; j0 < 64; j0 += 8) { float sr[8], si[8];
#pragma unroll
                    for (int j = 0; j < 8; ++j) { const float* sp = SL + ((size_t)(g * 1024 + b * 64 + j0 + j)) * 256; const float* sq = sp + (size_t)512 * 256; sr[j] = sp[n] + sq[n]; si[j] = sp[64 + n] + sq[64 + n]; }
#pragma unroll
                    for (int j = 0; j < 8; ++j) { bf16* up = UA + ((size_t)(g * 512 + b * 64 + j0 + j)) * S5K + 512; up[n] = (bf16)f2bf(xr); up[64 + n] = (bf16)f2bf(xi);
                        const float nr = ar * xr - ai * xi + sr[j], ni = ar * xi + ai * xr + si[j]; xr = nr; xi = ni; } } } }
        asm volatile("s_waitcnt vmcnt(0)" ::: "memory");
        __syncthreads();
        pg8::Gemm g{S5K, S5K, S5K}; pg8::GroupOrder S{(const char*)UA, (const char*)(F.ws + WS_MQ), S5K, S5K, 2, 32, F.G, F.vcu};
        pg8::EpiS5Y E{UA, F.in[I_SSM_D], Gm}; pg8::gemm_phase<pg8::EpiS5Y, pg8::GroupOrder>(F.lds, g, S, E, F.wave);
        if (F.G >= 256 && F.vcu >= 128) { for (int u = F.vcu - 128; u < 128; u += F.G - 128) xattn_unit(F, u); __syncthreads(); }
        if (F.G < 256) { for (int u = F.vcu; u < 256; u += F.G) xattn_unit(F, u); __syncthreads(); }
        bg_convert(F, CW_QD, BT_GU, BT_D, (F.G >= 256 && F.vcu >= 128) ? PB4 : 0);
    }
    SEAM(3);
    if (IN(4)) { PHASE_REGS();
        pg8::Gemm g{512, 512, 512}; pg8::DenseOrder S; S.init(Gm, F.ws + WS_WGLU, 512, 512, T, 512, F.G, (int)blockIdx.x);
        pg8::EpiGlu E{Gm, MIX, (float*)(F.ws + WS_SS)}; pg8::gemm_phase<pg8::EpiGlu, pg8::DenseOrder>(F.lds, g, S, E, F.wave);
        if (F.G >= 256 && (int)blockIdx.x >= 128) { for (int u = 128 + (int)blockIdx.x - 128; u < 256; u += F.G - 128) xattn_unit(F, u); __syncthreads(); }
    }
    SEAM(4);
    if (IN(5)) { PHASE_REGS();
        pg8::Gemm g{D, D, D}; pg8::DenseOrder S; S.init(MIX, F.ws + WS_WO, D, D, T, D, F.G, (int)blockIdx.x);
        pg8::EpiWo E{(const float*)(F.ws + WS_RINV), XN, (unsigned char*)(F.ws + WS_X18), (float*)(F.ws + WS_PART)}; pg8::gemm_phase<pg8::EpiWo, pg8::DenseOrder, false, false, true>(F.lds, g, S, E, F.wave, (const float*)(F.ws + WS_SS));
    }
    SEAM(5);
    if (IN(6)) { PHASE_REGS();
        pg8::Gemm g{D, 512, 512}; pg8::KSplitOrder S{(const char*)XN, (const char*)(F.ws + WS_WR), D, 512, 512, T / 256, 4, F.G, F.vcu};
        pg8::EpiLogit E{(float*)(F.ws + WS_LP)}; pg8::gemm_phase<pg8::EpiLogit, pg8::KSplitOrder>(F.lds, g, S, E, F.wave);
    }
    SEAM(6);
    const int rt_per = (T + F.G - 1) / F.G, rt_beg = F.vcu * rt_per, rt_end = (rt_beg + rt_per) < T ? (rt_beg + rt_per) : T;
    if (IN(7)) { PHASE_REGS();
        LAS int* hist = (LAS int*)F.lds;
        const float* LP = (const float*)(F.ws + WS_LP); const float* part = (const float*)(F.ws + WS_PART); float* rstdv = (float*)(F.ws + WS_RSTD);
        int* toke = (int*)(F.ws + WS_TOKE); float* wts = (float*)(F.ws + WS_WTS); int* HIST = (int*)(F.ws + WS_HIST);
        __syncthreads();
        if (F.tid < 64) hist[F.tid] = 0;
        __syncthreads();
        for (int t = rt_beg + F.tid; t < rt_end; t += 512) {
            const f32x4* pp = (const f32x4*)(part + (size_t)t * 32); float ss = 0.f;
#pragma unroll
            for (int j = 0; j < 8; ++j) { const f32x4 v = pp[j]; ss += (v[0] + v[1]) + (v[2] + v[3]); }
            const float rs = 1.0f / sqrtf(ss * (1.f / 2048.f) + EPS); rstdv[t] = rs;
            const float* l0 = LP + (size_t)t * 80; const float* l1 = l0 + (size_t)T * 80; const float* l2 = l1 + (size_t)T * 80; const float* l3 = l2 + (size_t)T * 80;
            float gl[8];
#pragma unroll
            for (int j = 0; j < 8; j += 4) { const f32x4 a = *(const f32x4*)(l0 + j), b = *(const f32x4*)(l1 + j), c = *(const f32x4*)(l2 + j), d = *(const f32x4*)(l3 + j);
#pragma unroll
                for (int q = 0; q < 4; ++q) gl[j + q] = rs * (((a[q] + b[q]) + c[q]) + d[q]); }
            int gi = 0; float gm = gl[0];
#pragma unroll
            for (int j = 1; j < 8; ++j) if (gl[j] > gm) { gm = gl[j]; gi = j; }
            float gs = 0.f;
#pragma unroll
            for (int j = 0; j < 8; ++j) gs += expf(gl[j] - gm);
            const float gate = 1.0f / gs;
            float el[8];
#pragma unroll
            for (int j = 0; j < 8; j += 4) { const int o = 8 + gi * 8 + j; const f32x4 a = *(const f32x4*)(l0 + o), b = *(const f32x4*)(l1 + o), c = *(const f32x4*)(l2 + o), d = *(const f32x4*)(l3 + o);
#pragma unroll
                for (int q = 0; q < 4; ++q) el[j + q] = rs * (((a[q] + b[q]) + c[q]) + d[q]); }
            int i1 = 0; float v1 = el[0];
#pragma unroll
            for (int j = 1; j < 8; ++j) if (el[j] > v1) { v1 = el[j]; i1 = j; }
            int i2 = -1; float v2 = -3.0e38f;
#pragma unroll
            for (int j = 0; j < 8; ++j) if (j != i1 && el[j] > v2) { v2 = el[j]; i2 = j; }
            const float ex = expf(v2 - v1);
            const int ea = gi * 8 + i1, eb = gi * 8 + i2;
            const int la = __hip_atomic_fetch_add(hist + ea, 1, __ATOMIC_RELAXED, __HIP_MEMORY_SCOPE_WORKGROUP), lb = __hip_atomic_fetch_add(hist + eb, 1, __ATOMIC_RELAXED, __HIP_MEMORY_SCOPE_WORKGROUP);
            toke[t * 2] = (ea << 16) | la; toke[t * 2 + 1] = (eb << 16) | lb; wts[t * 2] = gate / (1.0f + ex); wts[t * 2 + 1] = gate * ex / (1.0f + ex);
        }
        __syncthreads();
        if (F.tid < 64) HIST[F.vcu * 64 + F.tid] = hist[F.tid];
        __syncthreads();
    }
    SEAM(7);
    if (IN(8)) { PHASE_REGS();
        LAS int* pb = (LAS int*)F.lds; LAS int* pt = pb + 512; LAS int* base = pt + 512;
        const int* HIST = (const int*)(F.ws + WS_HIST); const int* toke = (const int*)(F.ws + WS_TOKE); int* list = (int*)(F.ws + WS_LIST);
        __syncthreads();
        { const int e = F.tid & 63, p8 = F.tid >> 6; int sb = 0, st = 0;
          for (int w = p8; w < F.G; w += 8) { const int h = HIST[w * 64 + e]; st += h; sb += (w < F.vcu) ? h : 0; }
          pb[F.tid] = sb; pt[F.tid] = st; }
        __syncthreads();
        if (F.tid < 64) { int sb = 0, st = 0;
#pragma unroll
            for (int j = 0; j < 8; ++j) { sb += pb[j * 64 + F.tid]; st += pt[j * 64 + F.tid]; }
            base[F.tid] = sb; F.ctl[CW_CNT + F.tid] = (unsigned)st; }
        __syncthreads();
        for (int t = rt_beg + F.tid; t < rt_end; t += 512) {
#pragma unroll
            for (int k = 0; k < 2; ++k) { const int v = toke[t * 2 + k], e = v >> 16, sl = v & 0xffff; const size_t pos = (size_t)e * LCAP + base[e] + sl;
                list[pos] = t * 2 + k; ((float*)(F.ws + WS_LRS))[pos] = ((const float*)(F.ws + WS_RSTD))[t]; ((float*)(F.ws + WS_LWT))[pos] = ((const float*)(F.ws + WS_WTS))[t * 2 + k]; } }
        __syncthreads();
        bg_convert(F, CW_QGU, 0, BT_GU, 0x7fffffff);
    }
    SEAM(8);
    if (IN(9)) { PHASE_REGS();
        moe_tables(F);
        const LAS int* cnt = (const LAS int*)(F.lds + TAB_OFF); const int* list = (const int*)(F.ws + WS_LIST);
        pg8::Gemm g{D / 2, D / 2, D / 2}; pg8::MoeOrder S{(const char*)(F.ws + WS_X18), (const char*)(F.ws + WS_WGU), cnt, cnt + 64, list, D / 2, D / 2, 4, 1024, F.G, F.vcu, true};
        pg8::EpiGU E{(const float*)(F.ws + WS_LRS), cnt, F.ws + WS_ACT}; pg8::gemm_phase<pg8::EpiGU, pg8::MoeOrder, true, true>(F.lds, g, S, E, F.wave);
        PHASE_REGS();
        bg_convert(F, CW_QD, BT_GU, BT_D, 0x7fffffff);
    }
    SEAM(9);
    if (IN(10)) { PHASE_REGS();
        moe_tables(F);
        const LAS int* cnt = (const LAS int*)(F.lds + TAB_OFF); const int* list = (const int*)(F.ws + WS_LIST);
        pg8::Gemm g{DEXP / 2, DEXP / 2, DEXP / 2}; pg8::MoeOrder S{(const char*)(F.ws + WS_ACT), (const char*)(F.ws + WS_WD), cnt, cnt + 64, list, DEXP / 2, DEXP / 2, 8, 2048, F.G, F.vcu, false};
        pg8::EpiDown E{list, (const float*)(F.ws + WS_LWT), cnt, F.ws + WS_Y2};
        pg8::gemm_phase<pg8::EpiDown, pg8::MoeOrder, false, true>(F.lds, g, S, E, F.wave);
    }
    SEAM(10);
    if (IN(11)) { PHASE_REGS();
        const unsigned char* Y2 = F.ws + WS_Y2; typedef float f32x2_ __attribute__((ext_vector_type(2)));
        for (int m = gw; m < T; m += NGW) { f32x4* op = (f32x4*)(F.out + (size_t)m * D) + F.lane * 2; const v4u* xb = (const v4u*)(XN + (size_t)m * D) + F.lane;
            const v2u* ya = (const v2u*)(Y2 + (size_t)m * 2 * D) + F.lane; const v2u* yb = ya + 256;
            v4u xw[4]; v2u aw[4], cw[4];
#pragma unroll
            for (int j = 0; j < 4; ++j) { xw[j] = __builtin_nontemporal_load(xb + 64 * j); aw[j] = __builtin_nontemporal_load(ya + 64 * j); cw[j] = __builtin_nontemporal_load(yb + 64 * j); }
#pragma unroll
            for (int j = 0; j < 4; ++j) { const v4u x = xw[j]; const v2u a = aw[j], c = cw[j]; f32x4 x0, x1; const float is = 1.0f / SC_Y;
                const f32x2_ a0 = __builtin_amdgcn_cvt_pk_f32_fp8((int)a.x, false), a1 = __builtin_amdgcn_cvt_pk_f32_fp8((int)a.x, true), a2 = __builtin_amdgcn_cvt_pk_f32_fp8((int)a.y, false), a3 = __builtin_amdgcn_cvt_pk_f32_fp8((int)a.y, true);
                const f32x2_ c0 = __builtin_amdgcn_cvt_pk_f32_fp8((int)c.x, false), c1 = __builtin_amdgcn_cvt_pk_f32_fp8((int)c.x, true), c2 = __builtin_amdgcn_cvt_pk_f32_fp8((int)c.y, false), c3 = __builtin_amdgcn_cvt_pk_f32_fp8((int)c.y, true);
                x0[0] = bflo(x.x) + (a0[0] + c0[0]) * is; x0[1] = bfhi(x.x) + (a0[1] + c0[1]) * is; x0[2] = bflo(x.y) + (a1[0] + c1[0]) * is; x0[3] = bfhi(x.y) + (a1[1] + c1[1]) * is;
                x1[0] = bflo(x.z) + (a2[0] + c2[0]) * is; x1[1] = bfhi(x.z) + (a2[1] + c2[1]) * is; x1[2] = bflo(x.w) + (a3[0] + c3[0]) * is; x1[3] = bfhi(x.w) + (a3[1] + c3[1]) * is;
                __builtin_nontemporal_store(x0, op + 128 * j); __builtin_nontemporal_store(x1, op + 128 * j + 1); } }
    }
#undef IN
#undef SEAM
}

extern "C" void kernel_launch(void* const* d_in, const int* in_sizes, int n_in, void* d_out, int out_size, void* d_ws, size_t ws_size, hipStream_t stream) {
    static int grid = 0;
    if (grid == 0) {
        if (n_in != 31 || out_size != T * D || ws_size < WS_END) { fprintf(stderr, "kernel_launch: unexpected shapes (n_in %d out %d ws %zu)\n", n_in, out_size, ws_size); grid = -1; return; }
        int dev = 0, cus = 0, per_cu = 0;
        if (hipGetDevice(&dev) != hipSuccess || hipDeviceGetAttribute(&cus, hipDeviceAttributeMultiprocessorCount, dev) != hipSuccess) { grid = -1; return; }
        if (hipFuncSetAttribute((const void*)hymba_fwd, hipFuncAttributeMaxDynamicSharedMemorySize, LDS_BYTES) != hipSuccess) { fprintf(stderr, "kernel_launch: hipFuncSetAttribute failed\n"); grid = -1; return; }
        if (hipOccupancyMaxActiveBlocksPerMultiprocessor(&per_cu, (const void*)hymba_fwd, 512, LDS_BYTES) != hipSuccess || per_cu < 1) fprintf(stderr, "kernel_launch: occupancy query reports %d\n", per_cu);
        (void)hipGetLastError();
        grid = cus;
    }
    if (grid < 0) return;
    (void)hipMemsetAsync((char*)d_ws + WS_CTL, 0, CTL_ZERO_BYTES, stream);
    Args a{};
    for (int i = 0; i < 31; ++i) a.in[i] = (const float*)d_in[i];
    a.out = (float*)d_out; a.ws = (unsigned char*)d_ws;
#if MK_PER_PHASE
    for (int p = 0; p < NPH; ++p) { const int reps = ((PROBE_REP_MASK >> p) & 1) ? 2 : 1;
        for (int q = 0; q < reps; ++q) { a.ph_lo = p; a.ph_hi = p + 1; hipLaunchKernelGGL(hymba_fwd, dim3(grid), dim3(512), LDS_BYTES, stream, a); } }
#else
    a.ph_lo = 0; a.ph_hi = NPH; hipLaunchKernelGGL(hymba_fwd, dim3(grid), dim3(512), LDS_BYTES, stream, a);
#endif
}
```

```cpp
#include <hip/hip_runtime.h>
#include <cstdio>
#include <cstdint>

#ifndef PROBE_REP_MASK
#define PROBE_REP_MASK 0
#endif
#ifndef PB0
#define PB0 40
#endif
#ifndef PB0_S5
#define PB0_S5 28
#endif
#ifndef PB0_D
#define PB0_D 0
#endif
#ifndef PB1
#define PB1 18
#endif
#ifndef PB2
#define PB2 0
#endif
#ifndef PB4
#define PB4 3
#endif
#ifndef PB5
#define PB5 0
#endif
#ifndef PB11
#define PB11 0
#endif
#ifndef MK_PER_PHASE
#define MK_PER_PHASE 0
#endif

#define GAS __attribute__((address_space(1)))
#define LAS __attribute__((address_space(3)))
typedef unsigned short bf16;
typedef unsigned v4u __attribute__((ext_vector_type(4)));
typedef unsigned v2u __attribute__((ext_vector_type(2)));
typedef float f32x4 __attribute__((ext_vector_type(4)));
typedef float f32x16 __attribute__((ext_vector_type(16)));
typedef short bf16x8 __attribute__((ext_vector_type(8)));
typedef short bf16x4 __attribute__((ext_vector_type(4)));
typedef int v8i __attribute__((ext_vector_type(8)));
typedef int v4i_ __attribute__((ext_vector_type(4)));

constexpr int T = 16384, D = 2048, SEQ = 2048, NB = 8, INC = 2304, MEML = 256;
constexpr int NPH = 12;
constexpr float EPS = 1e-6f;
constexpr int NEXP = 64, DEXP = 512, LCAP = 16384;
constexpr int S5L = 32, S5K = 640;

constexpr size_t MiB = 1u << 20;
constexpr size_t WS_CTL = 0, CTL_ZERO_BYTES = 32768;
constexpr size_t WS_WIN = 2 * MiB, WS_WO = 11 * MiB, WS_WMKV = 19 * MiB, WS_WGLU = 23 * MiB;
constexpr size_t WS_MQ = 24 * MiB, WS_SP = 44 * MiB, WS_UA = 52 * MiB, WS_SL = 468 * MiB  , WS_AL = 88 * MiB, WS_WR = 89 * MiB;
constexpr size_t WS_XN = 96 * MiB;
constexpr size_t WS_MEMN = 160 * MiB, WS_MEMKV = 168 * MiB;
constexpr size_t WS_PROJ = 176 * MiB;
constexpr size_t WS_MIX = 248 * MiB;
constexpr size_t WS_Y2 = 176 * MiB;
constexpr size_t WS_G = 312 * MiB;
constexpr size_t WS_LOG = 328 * MiB;
constexpr size_t WS_LIST = 344 * MiB;
constexpr size_t WS_WTS = 348 * MiB;
constexpr size_t WS_LP = 352 * MiB;
constexpr size_t WS_PART = 376 * MiB;
constexpr size_t WS_RSTD = 379 * MiB;
constexpr size_t WS_HIST = 380 * MiB;
constexpr size_t WS_X18 = 384 * MiB;
constexpr size_t WS_SS = 382 * MiB;
constexpr size_t WS_LRS = 452 * MiB;
constexpr size_t WS_LWT = 456 * MiB;
constexpr size_t WS_RINV = 460 * MiB;
constexpr size_t WS_TOKE = 381 * MiB;
constexpr size_t WS_ACT = 544 * MiB;
constexpr size_t WS_WGU = 592 * MiB;
constexpr size_t WS_WD = 848 * MiB;
constexpr size_t WS_END = 976 * MiB;
constexpr int CW_CNT = 1024;
constexpr int CW_BAR = 4096;
constexpr int CW_QGU = 2048, CW_QD = 2112;

constexpr int RING_BYTES = 131072;
constexpr int TAB_OFF = 139264;
constexpr int XBW_OFF = TAB_OFF + 2048;
constexpr int LDS_BYTES = 147456;

#define LDS_WAIT() asm volatile("s_waitcnt lgkmcnt(0)" ::: "memory")
#define VM_WAIT() asm volatile("s_waitcnt vmcnt(0)" ::: "memory")
__device__ __forceinline__ unsigned f2bf(float f) { unsigned u = __builtin_bit_cast(unsigned, f); return (u + 0x7fffu + ((u >> 16) & 1u)) >> 16; }
__device__ __forceinline__ unsigned pk2(float lo, float hi) { unsigned r; asm volatile("v_cvt_pk_bf16_f32 %0, %1, %2" : "=v"(r) : "v"(lo), "v"(hi)); return r; }
__device__ __forceinline__ float bflo(unsigned w) { return __builtin_bit_cast(float, w << 16); }
__device__ __forceinline__ float bfhi(unsigned w) { return __builtin_bit_cast(float, w & 0xffff0000u); }
__device__ __forceinline__ float wave_sum(float v) {
#pragma unroll
    for (int o = 1; o < 64; o <<= 1) v += __shfl_xor(v, o);
    return v;
}
constexpr float SC_X = 4.0f, SC_WGU = 32.0f, SC_ACT = 16.0f, SC_WD = 16.0f, SC_Y = 64.0f;
__device__ __forceinline__ float clamp8(float v) { return __builtin_amdgcn_fmed3f(v, -448.0f, 448.0f); }
__device__ __forceinline__ unsigned pk4_fp8(float a, float b, float c, float d) { unsigned w = 0u; w = (unsigned)__builtin_amdgcn_cvt_pk_fp8_f32(clamp8(a), clamp8(b), (int)w, false); w = (unsigned)__builtin_amdgcn_cvt_pk_fp8_f32(clamp8(c), clamp8(d), (int)w, true); return w; }
__device__ __forceinline__ float fast_exp(float x) { return __builtin_amdgcn_exp2f(x * 1.44269504089f); }
__device__ __forceinline__ float sigmoidf_(float x) { return __builtin_amdgcn_rcpf(1.0f + fast_exp(-x)); }
__device__ __forceinline__ float gelu_tanh(float x) { const float z = 1.5957691216f * (x + 0.044715f * x * x * x); return x * sigmoidf_(z); }

#define XB_TMO      128
#define XB_XCNT(j)  (256  + 64 * (j))
#define XB_XSUB(j)  (1280 + 64 * (j))
#define XB_XGEN(j)  (2304 + 64 * (j))
#define XB_TOP      3328
#define XB_TOPGEN   3392
#define XCD_BAR_WORDS 3456
#define XB_SPIN_CAP (1u << 18)
__device__ __forceinline__ unsigned xb_ld(unsigned* p)              { return __hip_atomic_load(p, __ATOMIC_RELAXED, __HIP_MEMORY_SCOPE_AGENT); }
__device__ __forceinline__ unsigned xb_add(unsigned* p, unsigned v) { return __hip_atomic_fetch_add(p, v, __ATOMIC_RELAXED, __HIP_MEMORY_SCOPE_AGENT); }
__device__ __forceinline__ unsigned xb_xcc_id() { return (unsigned)__builtin_amdgcn_s_getreg((3 << 11) | 20) & 0xFu; }
#define XB_SPIN(cond, bar) do { unsigned _sp = 0; while (cond) { __builtin_amdgcn_s_sleep(1); \
    if ((++_sp & 255u) == 0u) { if (xb_ld(&(bar)[XB_TMO])) break; if (_sp > XB_SPIN_CAP) { atomicAdd(&(bar)[XB_TMO], 1u); break; } } } } while (0)
struct XcdBarrier { unsigned* bar; unsigned x; volatile LAS unsigned* st; };
__device__ __forceinline__ XcdBarrier xcd_barrier_post(unsigned* bar, volatile LAS unsigned* st) {
    XcdBarrier b; b.bar = bar; b.x = xb_xcc_id(); b.st = st;
    if (threadIdx.x == 0) (void)xb_add(&bar[XB_XCNT(b.x)], 1u);
    return b;
}
__device__ __forceinline__ void xcd_barrier_complete(unsigned* bar, unsigned x, unsigned& nloc, unsigned& nx) {
    const unsigned G = gridDim.x * gridDim.y * gridDim.z;
    unsigned sum, cnt, mine, sp = 0u;
    for (;;) {
        sum = 0u; cnt = 0u; mine = 0u;
#pragma unroll
        for (unsigned j = 0; j < 16; ++j) { const unsigned c = xb_ld(&bar[XB_XCNT(j)]); sum += c; cnt += (c > 0u) ? 1u : 0u; mine = (j == x) ? c : mine; }
        if (sum == G) break;
        __builtin_amdgcn_s_sleep(1);
        if ((++sp & 255u) == 0u) { if (xb_ld(&bar[XB_TMO])) break; if (sp > XB_SPIN_CAP) { atomicAdd(&bar[XB_TMO], 1u); break; } }
    }
    nloc = mine > 0u ? mine : 1u; nx = cnt > 0u ? cnt : 1u;
}
__device__ __forceinline__ void xcd_barrier(const XcdBarrier& b) {
    asm volatile("s_waitcnt vmcnt(0)" ::: "memory");
    __syncthreads();
    if (threadIdx.x == 0) {
        unsigned* bar = b.bar;
        __builtin_amdgcn_s_waitcnt(0);
        unsigned nloc = b.st[0], nx = b.st[1];
        if (nloc == 0u) { xcd_barrier_complete(bar, b.x, nloc, nx); b.st[0] = nloc; b.st[1] = nx; }
        const unsigned old = xb_add(&bar[XB_XSUB(b.x)], 1u);
        const unsigned gen = old / nloc;
        if (old + 1u == (gen + 1u) * nloc) {
            __builtin_amdgcn_fence(__ATOMIC_RELEASE, "agent");
            asm volatile("s_waitcnt vmcnt(0)" ::: "memory");
            const unsigned og = xb_add(&bar[XB_TOP], 1u);
            const unsigned tg = og / nx;
            if (og + 1u == (tg + 1u) * nx) xb_add(&bar[XB_TOPGEN], 1u);
            else XB_SPIN(xb_ld(&bar[XB_TOPGEN]) == tg, bar);
            __builtin_amdgcn_fence(__ATOMIC_ACQUIRE, "agent");
            xb_add(&bar[XB_XGEN(b.x)], 1u);
            asm volatile("s_waitcnt vmcnt(0)" ::: "memory");
        } else {
            XB_SPIN(xb_ld(&bar[XB_XGEN(b.x)]) == gen, bar);
            __builtin_amdgcn_fence(__ATOMIC_ACQUIRE, "agent");
            asm volatile("s_waitcnt vmcnt(0)" ::: "memory");
        }
    }
    __syncthreads();
}

__device__ __forceinline__ int lane_now() { int l = (int)__builtin_amdgcn_mbcnt_hi(~0u, __builtin_amdgcn_mbcnt_lo(~0u, 0u)); asm volatile("" : "+v"(l)); return l; }
namespace pg8 {
constexpr int BM = 256, BK = 64, HALF = 128, HTB = HALF * BK * 2, STAGE_BYTES = 8 * HTB, NXCD = 8, WGM = 2;
__host__ __device__ __forceinline__ int lds_byte(int r, int c) { const int st = (r >> 4) * 2 + (c >> 5), rr = r & 15, cc = c & 31, ob = rr * 64 + cc * 2; return st * 1024 + (ob ^ (((ob >> 9) & 1) << 5)); }
__host__ __device__ __forceinline__ void stage_rc(int b, int& R, int& C) { const int st = b / 1024, sb = b % 1024, swz = sb ^ (((sb >> 9) & 1) << 5); R = (st >> 1) * 16 + swz / 64; C = (st & 1) * 32 + (swz % 64) / 2; }
__host__ __device__ __forceinline__ int perm32(int rho) { const int n = rho >> 4, i = rho & 15; return 8 * (i >> 2) + 4 * n + (i & 3); }

struct Unit { const char* a; const char* b; int r0, c0, aux, r1; };
struct Gemm { int lda, ldb, K; };

struct DenseOrder {
    const char* A; const char* Bt; int lda, ldb, nM, nN, nwg, G, c;
    __device__ void init(const void* A_, const void* Bt_, int lda_, int ldb_, int M, int N, int G_, int c_) { A = (const char*)A_; Bt = (const char*)Bt_; lda = lda_; ldb = ldb_; nM = M / BM; nN = N / BM; nwg = nM * nN; G = G_; c = c_; }
    __device__ bool next(int i, Unit& u) const {
        const long L = (long)i * G + c; if (L >= nwg) return false;
        int wgid = (int)L; { const int q = nwg / NXCD, r = nwg % NXCD, xcd = wgid % NXCD, off = wgid / NXCD; wgid = (xcd < r ? xcd * (q + 1) : r * (q + 1) + (xcd - r) * q) + off; }
        const int nig = WGM * nN, gid = wgid / nig, fm = gid * WGM, gsz = (nM - fm) < WGM ? (nM - fm) : WGM;
        const int pm = fm + ((wgid % nig) % gsz), pn = (wgid % nig) / gsz;
        u.a = A + (size_t)pm * BM * lda * 2; u.b = Bt + (size_t)pn * BM * ldb * 2; u.r0 = pm * BM; u.c0 = pn * BM; u.aux = 0; u.r1 = 0; return true;
    }
    __device__ __forceinline__ unsigned arow(const Unit&, int) const { return 0u; }
};
struct GroupOrder {
    const char* A; const char* Bt; int lda, ldb, nN, ngrp, G, c;
    __device__ bool next(int i, Unit& u) const {
        const int L = i * G + c; if (L >= ngrp * 2 * nN) return false;
        const int g = L / (2 * nN), q = L % (2 * nN), pn = q >> 1, pm = q & 1;
        u.a = A + ((size_t)g * 512 + pm * BM) * lda * 2; u.b = Bt + ((size_t)g * nN + pn) * BM * ldb * 2; u.r0 = pm * BM; u.c0 = pn * BM; u.aux = g; u.r1 = 0; return true;
    }
    __device__ __forceinline__ unsigned arow(const Unit&, int) const { return 0u; }
};
struct StateOrder {
    const char* A; const char* Bt; int G, c;
    __device__ bool next(int i, Unit& u) const {
        const int L = i * G + c; if (L >= 128) return false;
        const int g = L >> 2, pm = (L >> 1) & 1, ks = L & 1;
        u.a = A + (((size_t)g * 512 + pm * BM) * S5K + ks * 256) * 2; u.b = Bt + ((size_t)g * 256 * 512 + ks * 256) * 2; u.r0 = pm * BM; u.c0 = 0; u.aux = g * 2 + ks; u.r1 = 0; return true;
    }
    __device__ __forceinline__ unsigned arow(const Unit&, int) const { return 0u; }
};
struct MoeOrder {
    const char* A; const char* Bt; const LAS int* cnt; const LAS int* ts; const int* list; int lda, ldb, nct, brows, G, c; bool gather;
    __device__ bool next(int i, Unit& u) const {
        const int L = i * G + c; const int lane = lane_now();
        int i64 = 64; asm volatile("" : "+v"(i64));
        if (L >= __builtin_amdgcn_readfirstlane(ts[i64]) * nct) return false;
        const int lo = ts[lane] * nct, hi = ts[lane + 1] * nct;
        const unsigned long long m = __ballot(lo <= L && L < hi);
        const int e = __builtin_amdgcn_readfirstlane((int)__builtin_ctzll(m));
        const int tse = ts[e], ne = ts[e + 1] - tse, q = L - tse * nct, ct = q / ne, rt = q % ne;
        u.a = gather ? A : A + (size_t)(tse + rt) * BM * lda * 2; u.b = Bt + ((size_t)e * brows + (size_t)ct * BM) * ldb * 2;
        u.r0 = (tse + rt) * BM; u.r1 = rt * BM; u.c0 = ct; u.aux = e; return true;
    }
    __device__ __forceinline__ unsigned arow(const Unit& u, int r) const {
        const int n = cnt[u.aux]; int rr = u.r1 + r; rr = rr < n ? rr : n - 1;
        return (unsigned)(list[(size_t)u.aux * LCAP + rr] >> 1) * (unsigned)(lda * 2);
    }
};

#define EPI_ROWS_COLS() const int rowb = wr * 64 + fr; (void)rowb;

template <class Epi, class Sched, bool GATHER = false, bool FP8 = false, bool KSEG = false>
__device__ __forceinline__ void gemm_phase(LAS unsigned char* lds, const Gemm g, const Sched& S, const Epi& E, const int wave_id, const float* ssq = nullptr) {
    int lane = (int)__builtin_amdgcn_mbcnt_hi(~0u, __builtin_amdgcn_mbcnt_lo(~0u, 0u)); asm volatile("" : "+v"(lane));
    const int wid = wave_id, tid = wid * 64 + lane, wr = wid >> 2, wc = wid & 3, fr = lane & 15, fq = lane >> 4;
    const int K = g.K; int nt = K / BK; asm volatile("" : "+s"(nt));
    unsigned voffB;
    { int R, C; stage_rc(tid * 16, R, C); const int Rb = Epi::PERM ? ((R & ~31) + perm32(R & 31)) : R; voffB = (unsigned)(Rb * g.ldb + C) * 2u; }
    const int soffB = 64 * g.ldb * 2, soffA = 64 * g.lda * 2;
#define PG8_RC(i, R, C) int R, C; { int _t = tid; asm volatile("" : "+v"(_t)); stage_rc(_t * 16 + (i) * 8192, R, C); }
#define nxoff ((LAS v4u*)(lds + 131072) + (wid * 64 + lane_now()))
    const size_t kstep = (size_t)(BK * 2);
    const size_t hstepB = (size_t)HALF * g.ldb * 2;
    const unsigned ldsw = (unsigned)wid * 1024u;
    const int aoff = lds_byte(wr * 64 + fr, fq * 8), boff = lds_byte(wc * 32 + fr, fq * 8);
#define PG8_SA(b, h) (((b) * 2 + (h)) * HTB)
#define PG8_SB(b, h) ((4 + (b) * 2 + (h)) * HTB)
#define PG8_RSRC(p) __builtin_amdgcn_make_buffer_rsrc((void*)(p), 0, 0xffffffff, 0x00020000)
#define PG8_DMA(gbase, vo, so, ldsp) do { if constexpr (FP8) { __builtin_amdgcn_raw_ptr_buffer_load_lds(PG8_RSRC(gbase), (LAS void*)(ldsp), 16, (int)(vo), (so), 0, 0); } \
        else { __builtin_amdgcn_global_load_lds((const unsigned*)((const char*)(gbase) + (so) + (vo)), (LAS unsigned*)(ldsp), 16, 0, 0); } } while (0)
#define PG8_STAGE(bufoff, gbase, voff) do { PG8_DMA(gbase, voff, 0, lds + (bufoff) + ldsw); PG8_DMA(gbase, voff, soffB, lds + (bufoff) + ldsw + 8192); } while (0)
#define PG8_STAGEA(bufoff, gbase, o0, o1, h) do { \
        if constexpr (GATHER) { PG8_DMA(gbase, o0, 0, lds + (bufoff) + ldsw); PG8_DMA(gbase, o1, 0, lds + (bufoff) + ldsw + 8192); } \
        else { PG8_DMA(gbase, c00, (h) * 2 * soffA, lds + (bufoff) + ldsw); PG8_DMA(gbase, c00, (h) * 2 * soffA + soffA, lds + (bufoff) + ldsw + 8192); } } while (0)
#define PG8_LDA(dst, b, h) do { _Pragma("unroll") for (int m = 0; m < 4; ++m) { \
        if constexpr (FP8) { dst##8[m].lo = *(const LAS v4i_*)(lds + PG8_SA(b, h) + aoff + m * 2048); dst##8[m].hi = *(const LAS v4i_*)(lds + PG8_SA(b, h) + aoff + m * 2048 + 1024); } \
        else { _Pragma("unroll") for (int k = 0; k < 2; ++k) dst[m][k] = *(const LAS bf16x8*)(lds + PG8_SA(b, h) + aoff + m * 2048 + k * 1024); } } } while (0)
#define PG8_LDB(dst, b, h) do { _Pragma("unroll") for (int n = 0; n < 2; ++n) { \
        if constexpr (FP8) { dst##8[n].lo = *(const LAS v4i_*)(lds + PG8_SB(b, h) + boff + n * 2048); dst##8[n].hi = *(const LAS v4i_*)(lds + PG8_SB(b, h) + boff + n * 2048 + 1024); } \
        else { _Pragma("unroll") for (int k = 0; k < 2; ++k) dst[n][k] = *(const LAS bf16x8*)(lds + PG8_SB(b, h) + boff + n * 2048 + k * 1024); } } } while (0)
#define PG8_MMA(ai, bj, At, Bt) do { __builtin_amdgcn_s_setprio(1); _Pragma("unroll") for (int m = 0; m < 4; ++m) _Pragma("unroll") for (int n = 0; n < 2; ++n) { \
        if constexpr (FP8) { acc[ai][bj][m][n] = __builtin_amdgcn_mfma_scale_f32_16x16x128_f8f6f4(Bt##8[n], At##8[m], acc[ai][bj][m][n], 0, 0, 0, 0x7f7f7f7f, 0, 0x7f7f7f7f); } \
        else { _Pragma("unroll") for (int k = 0; k < 2; ++k) acc[ai][bj][m][n] = __builtin_amdgcn_mfma_f32_16x16x32_bf16(Bt[n][k], At[m][k], acc[ai][bj][m][n], 0, 0, 0); } } \
        __builtin_amdgcn_s_setprio(0); } while (0)
#define PG8_WAIT_V(n) asm volatile("s_waitcnt vmcnt(" #n ")" ::: "memory")
#define PG8_WAIT_L(n) asm volatile("s_waitcnt lgkmcnt(" #n ")" ::: "memory")
#define PG8_BAR __builtin_amdgcn_s_barrier()
#define PG8_SCHED __builtin_amdgcn_sched_barrier(0)
    LAS f32x4* scl = (LAS f32x4*)(lds + 131072);
#define PG8_FILL_SCL(u) do { if constexpr (KSEG) { if (tid < 256) { const f32x4* sp = (const f32x4*)(ssq + (size_t)((u).r0 + tid) * 32); \
        const f32x4 p0 = sp[0], p1 = sp[1], p2 = sp[2], p3 = sp[3], p4 = sp[4], p5 = sp[5], p6 = sp[6]; \
        const float sa = (((p0[0] + p0[1]) + (p0[2] + p0[3])) + ((p1[0] + p1[1]) + (p1[2] + p1[3]))) + (((p2[0] + p2[1]) + (p2[2] + p2[3])) + ((p3[0] + p3[1]) + (p3[2] + p3[3]))); \
        const float sb = ((p4[0] + p4[1]) + (p4[2] + p4[3])) + ((p5[0] + p5[1]) + (p5[2] + p5[3])), sc = (p6[0] + p6[1]) + (p6[2] + p6[3]); \
        const float ra = 1.0f / sqrtf(sa * (1.f / 1024.f) + EPS), rb = 1.0f / sqrtf(sb * (1.f / 512.f) + EPS), rc = 1.0f / sqrtf(sc * (1.f / 512.f) + EPS); \
        scl[(ui & 1) * 256 + tid] = (f32x4){ra / rb, rb / rc, rc, 0.f}; } } } while (0)
#define PG8_SCALE(k) do { _Pragma("unroll") for (int _ai = 0; _ai < 2; ++_ai) _Pragma("unroll") for (int _m = 0; _m < 4; ++_m) { const float _f = ((const LAS float*)scl)[((ui & 1) * 256 + _ai * HALF + wr * 64 + _m * 16 + fr) * 4 + (k)]; \
        _Pragma("unroll") for (int _bj = 0; _bj < 2; ++_bj) _Pragma("unroll") for (int _n = 0; _n < 2; ++_n) acc[_ai][_bj][_m][_n] = acc[_ai][_bj][_m][_n] * _f; } } while (0)
    Unit cur, nxt; int ui = 0;
    if (!S.next(0, cur)) return;
    PG8_FILL_SCL(cur);
    if constexpr (Epi::PRE) E.pre(cur, lds + 143360 + (ui & 1) * 2048, tid);
    f32x4 acc[2][2][4][2];
#pragma unroll
    for (int a = 0; a < 2; ++a)
#pragma unroll
        for (int b = 0; b < 2; ++b)
#pragma unroll
            for (int m = 0; m < 4; ++m)
#pragma unroll
                for (int n = 0; n < 2; ++n) acc[a][b][m][n] = (f32x4){0.f, 0.f, 0.f, 0.f};
    bf16x8 At[4][2], B0[2][2], B1[2][2]; v8i At8[4], B08[2], B18[2];
    const char* cA = cur.a; const char* cB = cur.b;
    unsigned c00, c01, c10, c11;
    { PG8_RC(0, R0, C0); PG8_RC(1, R1, C1);
      if constexpr (GATHER) {
        c00 = S.arow(cur, R0) + C0 * 2u; c01 = S.arow(cur, R1) + C1 * 2u; c10 = S.arow(cur, HALF + R0) + C0 * 2u; c11 = S.arow(cur, HALF + R1) + C1 * 2u;
        asm volatile("s_waitcnt vmcnt(0)" : "+v"(c00), "+v"(c01), "+v"(c10), "+v"(c11) :: "memory");
      } else {
        c00 = (unsigned)(R0 * g.lda + C0) * 2u; c01 = c00; c10 = c00; c11 = c00; (void)R1; (void)C1;
      } }
    PG8_STAGE(PG8_SB(0, 0), cB, voffB); PG8_STAGE(PG8_SB(0, 1), cB + hstepB, voffB); PG8_STAGEA(PG8_SA(0, 0), cA, c00, c01, 0); PG8_STAGEA(PG8_SA(0, 1), cA, c10, c11, 1);
    if (wr == 1) PG8_BAR;
    PG8_WAIT_V(2); PG8_BAR;
    PG8_STAGE(PG8_SB(1, 0), cB + kstep, voffB); PG8_STAGEA(PG8_SA(1, 0), cA + kstep, c00, c01, 0); PG8_STAGE(PG8_SB(1, 1), cB + hstepB + kstep, voffB);
    PG8_WAIT_V(6); PG8_BAR;
#define PG8_KITER(t) do { \
            const bool last = (t == nt - 2); \
            const char* a1 = cA + (size_t)(t + 1) * kstep; \
            const char* a2 = last ? nA : cA + (size_t)(t + 2) * kstep; const char* b2 = last ? nB : cB + (size_t)(t + 2) * kstep; \
            const char* a3 = a2 + kstep; const char* b3 = b2 + kstep; \
            unsigned x00 = c00, x01 = c01, x10 = c10, x11 = c11; \
            if constexpr (GATHER) { if (last) { const v4u nv = *nxoff; x00 = nv.x; x01 = nv.y; x10 = nv.z; x11 = nv.w; } } \
 \
            PG8_LDB(B0, 0, 0); PG8_LDB(B1, 0, 1); PG8_SCHED; PG8_LDA(At, 0, 0); PG8_STAGEA(PG8_SA(1, 1), a1, c10, c11, 1); \
            PG8_WAIT_V(8); PG8_WAIT_L(0); PG8_BAR; PG8_MMA(0, 0, At, B0); PG8_MMA(0, 1, At, B1); PG8_BAR; PG8_SCHED; \
 \
            PG8_LDA(At, 0, 1); PG8_STAGE(PG8_SB(0, 0), b2, voffB); PG8_STAGE(PG8_SB(0, 1), b2 + hstepB, voffB); PG8_STAGEA(PG8_SA(0, 0), a2, x00, x01, 0); \
            PG8_WAIT_V(8); PG8_WAIT_L(0); PG8_BAR; PG8_MMA(1, 0, At, B0); PG8_MMA(1, 1, At, B1); PG8_BAR; PG8_SCHED; \
 \
            PG8_LDB(B0, 1, 0); PG8_LDB(B1, 1, 1); PG8_SCHED; PG8_LDA(At, 1, 0); PG8_STAGEA(PG8_SA(0, 1), a2, x10, x11, 1); \
            PG8_WAIT_V(8); PG8_WAIT_L(0); PG8_BAR; PG8_MMA(0, 0, At, B0); PG8_MMA(0, 1, At, B1); PG8_BAR; PG8_SCHED; \
 \
            PG8_LDA(At, 1, 1); PG8_STAGE(PG8_SB(1, 0), b3, voffB); PG8_STAGE(PG8_SB(1, 1), b3 + hstepB, voffB); PG8_STAGEA(PG8_SA(1, 0), a3, x00, x01, 0); \
            PG8_WAIT_V(8); PG8_WAIT_L(0); PG8_BAR; PG8_MMA(1, 0, At, B0); PG8_MMA(1, 1, At, B1); PG8_BAR; PG8_SCHED; \
        } while (0)
    for (;;) {
        const bool has_next = S.next(ui + 1, nxt);
        const char* nA = has_next ? nxt.a : cA; const char* nB = has_next ? nxt.b : cB;
        if constexpr (GATHER) {
            unsigned n00 = c00, n01 = c01, n10 = c10, n11 = c11;
            if (has_next) { PG8_RC(0, R0, C0); PG8_RC(1, R1, C1); n00 = S.arow(nxt, R0) + C0 * 2u; n01 = S.arow(nxt, R1) + C1 * 2u; n10 = S.arow(nxt, HALF + R0) + C0 * 2u; n11 = S.arow(nxt, HALF + R1) + C1 * 2u; }
            asm volatile("s_waitcnt vmcnt(0)" : "+v"(n00), "+v"(n01), "+v"(n10), "+v"(n11) :: "memory");
            v4u nv; nv.x = n00; nv.y = n01; nv.z = n10; nv.w = n11; *nxoff = nv;
        }
        if constexpr (KSEG) {
#pragma unroll 1
            for (int t = 0; t < 16; t += 2) PG8_KITER(t);
            PG8_SCALE(0);
#pragma unroll 1
            for (int t = 16; t < 24; t += 2) PG8_KITER(t);
            PG8_SCALE(1);
#pragma unroll 1
            for (int t = 24; t < nt; t += 2) PG8_KITER(t);
        } else {
#pragma unroll 1
            for (int t = 0; t < nt; t += 2) PG8_KITER(t);
        }
        if (wr == 0) PG8_BAR;
        if constexpr (KSEG) PG8_SCALE(2);
        { const int le = lane_now(); if constexpr (Epi::PRE) E(acc, cur, wr, wc, le & 15, le >> 4, lds + 143360 + (ui & 1) * 2048); else E(acc, cur, wr, wc, le & 15, le >> 4); }
        if (!has_next) break;
#pragma unroll
        for (int a = 0; a < 2; ++a)
#pragma unroll
            for (int b = 0; b < 2; ++b)
#pragma unroll
                for (int m = 0; m < 4; ++m)
#pragma unroll
                    for (int n = 0; n < 2; ++n) acc[a][b][m][n] = (f32x4){0.f, 0.f, 0.f, 0.f};
        cur = nxt; cA = nA; cB = nB; ++ui;
        if constexpr (KSEG) { PG8_WAIT_L(0); PG8_FILL_SCL(cur); }
        if constexpr (Epi::PRE) E.pre(cur, lds + 143360 + (ui & 1) * 2048, tid);
        if constexpr (GATHER) { const v4u nv = *nxoff; c00 = nv.x; c01 = nv.y; c10 = nv.z; c11 = nv.w; }
        if (wr == 1) PG8_BAR;
    }
    PG8_WAIT_V(0);
    PG8_BAR;
#undef PG8_RC
#undef PG8_KITER
#undef PG8_FILL_SCL
#undef PG8_SCALE
#undef nxoff
#undef PG8_SA
#undef PG8_SB
#undef PG8_STAGE
#undef PG8_STAGEA
#undef PG8_DMA
#undef PG8_RSRC
#undef PG8_LDA
#undef PG8_LDB
#undef PG8_MMA
#undef PG8_WAIT_V
#undef PG8_WAIT_L
#undef PG8_BAR
#undef PG8_SCHED
}

typedef const f32x4 (&AccRef)[2][2][4][2];
__device__ __forceinline__ v4u pack8(const f32x4 a, const f32x4 b) { v4u w; w.x = pk2(a[0], a[1]); w.y = pk2(a[2], a[3]); w.z = pk2(b[0], b[1]); w.w = pk2(b[2], b[3]); return w; }

struct EpiProj {
    static constexpr bool PERM = true, PRE = false;
    bf16* PROJ; bf16* UA;
    __device__ __forceinline__ void operator()(AccRef acc, const Unit& u, int wr, int wc, int fr, int fq) const {
        const int row0 = u.r0 + wr * 64 + fr, colb = u.c0 + wc * 32 + 8 * fq;
        const bool isu = (u.c0 == 1280 || u.c0 == 1536);
#pragma unroll
        for (int ai = 0; ai < 2; ++ai)
#pragma unroll
            for (int m = 0; m < 4; ++m) { const int row = row0 + ai * HALF + m * 16;
#pragma unroll
                for (int bj = 0; bj < 2; ++bj) { const int col = colb + bj * HALF; const v4u w = pack8(acc[ai][bj][m][0], acc[ai][bj][m][1]);
                    if (!isu) *(v4u*)(PROJ + (size_t)row * INC + col) = w;
                    else { const int cc = col - 1280, g = cc >> 4, c0 = cc & 15; *(v4u*)(UA + ((size_t)(g * 512 + (row >> 5)) * S5K + (row & 31) * 16 + c0)) = w; } } }
    }
};
struct EpiBf16 {
    static constexpr bool PERM = true, PRE = false;
    bf16* O; int ldc;
    __device__ __forceinline__ void operator()(AccRef acc, const Unit& u, int wr, int wc, int fr, int fq) const {
        const int row0 = u.r0 + wr * 64 + fr, colb = u.c0 + wc * 32 + 8 * fq;
#pragma unroll
        for (int ai = 0; ai < 2; ++ai)
#pragma unroll
            for (int m = 0; m < 4; ++m) { bf16* rowp = O + (size_t)(row0 + ai * HALF + m * 16) * ldc + colb;
#pragma unroll
                for (int bj = 0; bj < 2; ++bj) *(v4u*)(rowp + bj * HALF) = pack8(acc[ai][bj][m][0], acc[ai][bj][m][1]); }
    }
};
struct EpiF32 {
    static constexpr bool PERM = false, PRE = false;
    float* C; int ldc; size_t gstride;
    __device__ __forceinline__ void operator()(AccRef acc, const Unit& u, int wr, int wc, int fr, int fq) const {
        const int row0 = u.r0 + wr * 64 + fr, col0 = u.c0 + wc * 32 + 4 * fq; float* base = C + (size_t)u.aux * gstride;
#pragma unroll
        for (int ai = 0; ai < 2; ++ai)
#pragma unroll
            for (int m = 0; m < 4; ++m) { float* rowp = base + (size_t)(row0 + ai * HALF + m * 16) * ldc + col0;
#pragma unroll
                for (int bj = 0; bj < 2; ++bj)
#pragma unroll
                    for (int n = 0; n < 2; ++n) *(f32x4*)(rowp + bj * HALF + n * 16) = acc[ai][bj][m][n]; }
    }
};
struct EpiS5Y {
    static constexpr bool PERM = true, PRE = false;
    const bf16* UA; const float* dsk; bf16* Gm;
    __device__ __forceinline__ void operator()(AccRef acc, const Unit& u, int wr, int wc, int fr, int fq) const {
        const int row0 = u.r0 + wr * 64 + fr, colb = u.c0 + wc * 32 + 8 * fq, g = u.aux;
#pragma unroll
        for (int ai = 0; ai < 2; ++ai)
#pragma unroll
            for (int m = 0; m < 4; ++m) { const int row = row0 + ai * HALF + m * 16;
#pragma unroll
                for (int bj = 0; bj < 2; ++bj) { const int col = colb + bj * HALF, i = col >> 4, c0 = col & 15;
                    const v4u uw = *(const v4u*)(UA + ((size_t)(g * 512 + row) * S5K + col));
                    const f32x4 d0 = *(const f32x4*)(dsk + g * 16 + c0), d1 = *(const f32x4*)(dsk + g * 16 + c0 + 4);
                    const f32x4 a0 = acc[ai][bj][m][0], a1 = acc[ai][bj][m][1];
                    f32x4 y0, y1;
                    y0[0] = gelu_tanh(a0[0] + d0[0] * bflo(uw.x)); y0[1] = gelu_tanh(a0[1] + d0[1] * bfhi(uw.x)); y0[2] = gelu_tanh(a0[2] + d0[2] * bflo(uw.y)); y0[3] = gelu_tanh(a0[3] + d0[3] * bfhi(uw.y));
                    y1[0] = gelu_tanh(a1[0] + d1[0] * bflo(uw.z)); y1[1] = gelu_tanh(a1[1] + d1[1] * bfhi(uw.z)); y1[2] = gelu_tanh(a1[2] + d1[2] * bflo(uw.w)); y1[3] = gelu_tanh(a1[3] + d1[3] * bfhi(uw.w));
                    *(v4u*)(Gm + ((size_t)row * 32 + i) * 512 + g * 16 + c0) = pack8(y0, y1); } }
    }
};
struct EpiGlu {
    static constexpr bool PERM = true, PRE = false;
    const bf16* Gm; bf16* MIX; float* SS;
    __device__ __forceinline__ void operator()(AccRef acc, const Unit& u, int wr, int wc, int fr, int fq) const {
        const int row0 = u.r0 + wr * 64 + fr, colb = u.c0 + wc * 32 + 8 * fq;
#pragma unroll
        for (int ai = 0; ai < 2; ++ai)
#pragma unroll
            for (int m = 0; m < 4; ++m) { const int row = row0 + ai * HALF + m * 16; float ss = 0.f;
#pragma unroll
                for (int bj = 0; bj < 2; ++bj) { const int col = colb + bj * HALF;
                    const v4u gw = *(const v4u*)(Gm + (size_t)row * 512 + col);
                    const f32x4 a0 = acc[ai][bj][m][0], a1 = acc[ai][bj][m][1];
                    f32x4 y0, y1;
                    y0[0] = bflo(gw.x) * sigmoidf_(a0[0]); y0[1] = bfhi(gw.x) * sigmoidf_(a0[1]); y0[2] = bflo(gw.y) * sigmoidf_(a0[2]); y0[3] = bfhi(gw.y) * sigmoidf_(a0[3]);
                    y1[0] = bflo(gw.z) * sigmoidf_(a1[0]); y1[1] = bfhi(gw.z) * sigmoidf_(a1[1]); y1[2] = bflo(gw.w) * sigmoidf_(a1[2]); y1[3] = bfhi(gw.w) * sigmoidf_(a1[3]);
                    ss += ((y0[0] * y0[0] + y0[1] * y0[1]) + (y0[2] * y0[2] + y0[3] * y0[3])) + ((y1[0] * y1[0] + y1[1] * y1[1]) + (y1[2] * y1[2] + y1[3] * y1[3]));
                    *(v4u*)(MIX + (size_t)row * D + 1024 + col) = pack8(y0, y1); }
                ss += __shfl_xor(ss, 16); ss += __shfl_xor(ss, 32);
                if (fq == 0) SS[(size_t)row * 32 + 16 + (u.c0 >> 8) * 4 + wc] = ss; }
    }
};
struct EpiWo {
    static constexpr bool PERM = true, PRE = false;
    const float* rinv; bf16* X1B; unsigned char* X18; float* part;
    __device__ __forceinline__ void operator()(AccRef acc, const Unit& u, int wr, int wc, int fr, int fq) const {
        const int row0 = u.r0 + wr * 64 + fr, col0 = u.c0 + wc * 32 + 8 * fq;
#pragma unroll
        for (int ai = 0; ai < 2; ++ai) {
            v4u xw[4][2]; float ri[4];
#pragma unroll
            for (int m = 0; m < 4; ++m) { const int row = row0 + ai * HALF + m * 16; ri[m] = rinv[row];
#pragma unroll
                for (int bj = 0; bj < 2; ++bj) xw[m][bj] = *(const v4u*)(X1B + (size_t)row * D + col0 + bj * HALF); }
#pragma unroll
            for (int m = 0; m < 4; ++m) { const int row = row0 + ai * HALF + m * 16; const size_t off = (size_t)row * D + col0; float ss = 0.f;
#pragma unroll
                for (int bj = 0; bj < 2; ++bj) { const v4u x = xw[m][bj]; const float r = ri[m];
                    f32x4 v0, v1;
                    v0[0] = bflo(x.x) * r + acc[ai][bj][m][0][0]; v0[1] = bfhi(x.x) * r + acc[ai][bj][m][0][1]; v0[2] = bflo(x.y) * r + acc[ai][bj][m][0][2]; v0[3] = bfhi(x.y) * r + acc[ai][bj][m][0][3];
                    v1[0] = bflo(x.z) * r + acc[ai][bj][m][1][0]; v1[1] = bfhi(x.z) * r + acc[ai][bj][m][1][1]; v1[2] = bflo(x.w) * r + acc[ai][bj][m][1][2]; v1[3] = bfhi(x.w) * r + acc[ai][bj][m][1][3];
                    ss += ((v0[0] * v0[0] + v0[1] * v0[1]) + (v0[2] * v0[2] + v0[3] * v0[3])) + ((v1[0] * v1[0] + v1[1] * v1[1]) + (v1[2] * v1[2] + v1[3] * v1[3]));
                    *(v4u*)(X1B + off + bj * HALF) = pack8(v0, v1);
                    v2u w8; w8.x = pk4_fp8(v0[0] * SC_X, v0[1] * SC_X, v0[2] * SC_X, v0[3] * SC_X); w8.y = pk4_fp8(v1[0] * SC_X, v1[1] * SC_X, v1[2] * SC_X, v1[3] * SC_X);
                    *(v2u*)(X18 + off + bj * HALF) = w8; }
                ss += __shfl_xor(ss, 16); ss += __shfl_xor(ss, 32);
                if (fq == 0) part[(size_t)row * 32 + (u.c0 >> 8) * 4 + wc] = ss; }
            asm volatile("" ::: "memory");
        }
    }
};
struct EpiLogit {
    static constexpr bool PERM = false, PRE = false;
    float* LP;
    __device__ __forceinline__ void operator()(AccRef acc, const Unit& u, int wr, int wc, int fr, int fq) const {
        const int row0 = u.r0 + wr * 64 + fr, col0 = wc * 32 + 4 * fq; float* base = LP + (size_t)u.aux * T * 80;
#pragma unroll
        for (int ai = 0; ai < 2; ++ai)
#pragma unroll
            for (int m = 0; m < 4; ++m) { float* rowp = base + (size_t)(row0 + ai * HALF + m * 16) * 80 + col0;
#pragma unroll
                for (int n = 0; n < 2; ++n) if (col0 + n * 16 < 80) *(f32x4*)(rowp + n * 16) = acc[ai][0][m][n]; }
    }
};
struct EpiGU {
    static constexpr bool PERM = true, PRE = true;
    const float* lrs; const LAS int* cnt; unsigned char* ACT;
    __device__ __forceinline__ void pre(const Unit& u, LAS unsigned char* tab, int tid) const {
        if (tid < 256) { const int e = u.aux, n = cnt[e]; int rr = u.r1 + tid; rr = rr < n ? rr : n - 1; ((LAS float*)tab)[tid] = lrs[(size_t)e * LCAP + rr] * (1.0f / (SC_X * SC_WGU)); }
    }
    __device__ __forceinline__ void operator()(AccRef acc, const Unit& u, int wr, int wc, int fr, int fq, const LAS unsigned char* tab) const {
        const int rb = wr * 64 + fr, colb = u.c0 * 128 + wc * 32 + 8 * fq;
#pragma unroll
        for (int ai = 0; ai < 2; ++ai)
#pragma unroll
            for (int m = 0; m < 4; ++m) { const int r = rb + ai * HALF + m * 16;
                const float rs = ((const LAS float*)tab)[r];
                f32x4 y0, y1;
#pragma unroll
                for (int j = 0; j < 4; ++j) { const float g0 = acc[ai][0][m][0][j] * rs, g1 = acc[ai][0][m][1][j] * rs;
                    y0[j] = g0 * sigmoidf_(g0) * (acc[ai][1][m][0][j] * rs) * SC_ACT; y1[j] = g1 * sigmoidf_(g1) * (acc[ai][1][m][1][j] * rs) * SC_ACT; }
                v2u w8; w8.x = pk4_fp8(y0[0], y0[1], y0[2], y0[3]); w8.y = pk4_fp8(y1[0], y1[1], y1[2], y1[3]);
                *(v2u*)(ACT + (size_t)(u.r0 + r) * DEXP + colb) = w8; }
    }
};
struct EpiDown {
    static constexpr bool PERM = true, PRE = true;
    const int* list; const float* lwt; const LAS int* cnt; unsigned char* Y2;
    __device__ __forceinline__ void pre(const Unit& u, LAS unsigned char* tab, int tid) const {
        if (tid < 256) { const int e = u.aux, n = cnt[e], r = u.r1 + tid; int ent = -1; float w = 0.f;
            if (r < n) { ent = list[(size_t)e * LCAP + r]; w = lwt[(size_t)e * LCAP + r] * (SC_Y / (SC_ACT * SC_WD)); }
            ((LAS int*)tab)[tid] = ent; ((LAS float*)tab)[256 + tid] = w; }
    }
    __device__ __forceinline__ void operator()(AccRef acc, const Unit& u, int wr, int wc, int fr, int fq, const LAS unsigned char* tab) const {
        const int rb = wr * 64 + fr, colb = u.c0 * 256 + wc * 32 + 8 * fq;
#pragma unroll
        for (int ai = 0; ai < 2; ++ai)
#pragma unroll
            for (int m = 0; m < 4; ++m) { const int r = rb + ai * HALF + m * 16; const int ent = ((const LAS int*)tab)[r]; const float w = ((const LAS float*)tab)[256 + r];
                if (ent >= 0) { unsigned char* rowp = Y2 + (size_t)ent * D + colb;
#pragma unroll
                    for (int bj = 0; bj < 2; ++bj) { const f32x4 a0 = acc[ai][bj][m][0] * w, a1 = acc[ai][bj][m][1] * w; v2u w8; w8.x = pk4_fp8(a0[0], a0[1], a0[2], a0[3]); w8.y = pk4_fp8(a1[0], a1[1], a1[2], a1[3]);
                        *(v2u*)(rowp + bj * HALF) = w8; } } }
    }
};
struct KSplitOrder {
    const char* A; const char* Bt; int lda, ldb, K, nM, nks, G, c;
    __device__ bool next(int i, Unit& u) const {
        const int L = i * G + c; if (L >= nM * nks) return false;
        const int pm = L / nks, ks = L % nks;
        u.a = A + ((size_t)pm * BM * lda + (size_t)ks * K) * 2; u.b = Bt + (size_t)ks * BM * ldb * 2; u.r0 = pm * BM; u.c0 = 0; u.aux = ks; u.r1 = 0; return true;
    }
    __device__ __forceinline__ unsigned arow(const Unit&, int) const { return 0u; }
};
}

struct Frame {
    LAS unsigned char* lds;
    unsigned* ctl;
    int tid, lane, wave, vcu, G;
    const float* const __attribute__((address_space(4)))* in;
    float* out; unsigned char* ws;
};
enum { I_X = 0, I_MEM, I_NORM_MIX, I_W_IN, I_Q_NORM, I_K_NORM, I_SINKS, I_REL_BIAS, I_LAM_RE, I_LAM_IM, I_LOG_DT, I_B_RE, I_B_IM, I_C_RE, I_C_IM, I_SSM_D, I_W_GLU,
       I_MEM_NORM, I_W_MEM_KV, I_XQ_NORM, I_XK_NORM, I_ON_ATTN, I_ON_SSM, I_ON_X, I_W_O, I_NORM_FFN, I_WR_G, I_WR_E, I_W_GATE, I_W_UP, I_W_DOWN };

struct TrItem { const float* W; bf16* WT; const float* ks; int ldw, ldt, k0, n0, drow0; };
__device__ __forceinline__ void tr_load(const TrItem& it, f32x4 (&v)[8], int lane) {
    const int kc = lane & 7, nq = lane >> 3; const float* src = it.W + (size_t)(it.k0 + kc * 8) * it.ldw + it.n0 + nq * 4;
#pragma unroll
    for (int j = 0; j < 8; ++j) v[j] = __builtin_nontemporal_load((const f32x4*)(src + (size_t)j * it.ldw));
}
__device__ __forceinline__ void tr_store(const TrItem& it, f32x4 (&v)[8], int lane) {
    const int kc = lane & 7, nq = lane >> 3;
    if (it.ks) { const f32x4 s0 = *(const f32x4*)(it.ks + it.k0 + kc * 8), s1 = *(const f32x4*)(it.ks + it.k0 + kc * 8 + 4);
#pragma unroll
        for (int j = 0; j < 4; ++j) { v[j] = v[j] * s0[j]; v[4 + j] = v[4 + j] * s1[j]; } }
#pragma unroll
    for (int i = 0; i < 4; ++i) { v4u o; o.x = pk2(v[0][i], v[1][i]); o.y = pk2(v[2][i], v[3][i]); o.z = pk2(v[4][i], v[5][i]); o.w = pk2(v[6][i], v[7][i]);
        *(v4u*)(it.WT + (size_t)(it.drow0 + nq * 4 + i) * it.ldt + it.k0 + kc * 8) = o; }
}
__device__ __forceinline__ void rms_row_to_bf16(const float* xrow, const float* gain, bf16* orow, int lane, float* rinv = nullptr) {
    const f32x4* xr = (const f32x4*)xrow + lane; const f32x4* gr = (const f32x4*)gain + lane;
    f32x4 v[8]; float s = 0.f;
#pragma unroll
    for (int j = 0; j < 8; ++j) { v[j] = xr[64 * j]; s += (v[j].x * v[j].x + v[j].y * v[j].y) + (v[j].z * v[j].z + v[j].w * v[j].w); }
    const float ms = wave_sum(s) * (1.f / 2048.f) + EPS; const float rstd = 1.0f / sqrtf(ms);
    if (rinv && lane == 0) *rinv = sqrtf(ms);
    v2u* o8 = (v2u*)orow + lane;
#pragma unroll
    for (int j = 0; j < 8; ++j) { const f32x4 g = gain ? gr[64 * j] : (f32x4){1.f, 1.f, 1.f, 1.f}; v2u w; w.x = pk2(v[j].x * rstd * g.x, v[j].y * rstd * g.y); w.y = pk2(v[j].z * rstd * g.z, v[j].w * rstd * g.w); o8[64 * j] = w; }
}

__device__ __forceinline__ void s5_tables(Frame& F, int g) {
    LAS float* ap = (LAS float*)F.lds;
    LAS float* Bb = ap + 33 * 64 * 2;
    LAS float* Cc = Bb + 64 * 16 * 2;
    LAS float* Km = Cc + 16 * 64 * 2;
    const float dt = expf(F.in[I_LOG_DT][g]);
    const float* lre = F.in[I_LAM_RE] + g * 64; const float* lim = F.in[I_LAM_IM] + g * 64;
    for (int idx = F.tid; idx < 33 * 64; idx += 512) { const int tau = idx >> 6, n = idx & 63; const float lr = lre[n], li = lim[n];
        const float mag = expf((float)tau * (lr * dt)), ang = (float)tau * (li * dt); ap[idx * 2] = mag * cosf(ang); ap[idx * 2 + 1] = mag * sinf(ang); }
    __syncthreads();
    for (int idx = F.tid; idx < 64 * 16; idx += 512) { const int n = idx >> 4; const float lr = lre[n], li = lim[n];
        const float nr = ap[(64 + n) * 2] - 1.0f, ni = ap[(64 + n) * 2 + 1], den = lr * lr + li * li;
        const float cr = (nr * lr + ni * li) / den, ci = (ni * lr - nr * li) / den;
        const float br = F.in[I_B_RE][(size_t)g * 1024 + idx], bi = F.in[I_B_IM][(size_t)g * 1024 + idx];
        Bb[idx * 2] = cr * br - ci * bi; Bb[idx * 2 + 1] = cr * bi + ci * br; }
    for (int idx = F.tid; idx < 16 * 64; idx += 512) { Cc[idx * 2] = F.in[I_C_RE][(size_t)g * 1024 + idx]; Cc[idx * 2 + 1] = F.in[I_C_IM][(size_t)g * 1024 + idx]; }
    __syncthreads();
    for (int idx = F.tid; idx < 32 * 256; idx += 512) { const int tau = idx >> 8, c = (idx >> 4) & 15, c2 = idx & 15; float s = 0.f;
        for (int n = 0; n < 64; ++n) { const float ar = ap[(tau * 64 + n) * 2], ai = ap[(tau * 64 + n) * 2 + 1], cr = Cc[(c * 64 + n) * 2], ci = Cc[(c * 64 + n) * 2 + 1];
            const float er = cr * ar - ci * ai, ei = cr * ai + ci * ar; s += er * Bb[(n * 16 + c2) * 2] - ei * Bb[(n * 16 + c2) * 2 + 1]; }
        Km[idx] = s; }
    __syncthreads();
    bf16* MQ = (bf16*)(F.ws + WS_MQ) + (size_t)g * 512 * S5K;
    for (int idx = F.tid; idx < 512 * 80; idx += 512) { const int row = idx / 80, ch = idx % 80, i = row >> 4, c = row & 15, k0 = ch * 8; float v[8];
        if (k0 < 512) { const int s = k0 >> 4, c20 = k0 & 15, tau = i - s;
#pragma unroll
            for (int j = 0; j < 8; ++j) v[j] = tau >= 0 ? Km[(tau * 16 + c) * 16 + c20 + j] : 0.f;
        } else { const int kk = k0 - 512, ri = kk >> 6, n0 = kk & 63;
#pragma unroll
            for (int j = 0; j < 8; ++j) { const int n = n0 + j; const float ar = ap[((i + 1) * 64 + n) * 2], ai = ap[((i + 1) * 64 + n) * 2 + 1], cr = Cc[(c * 64 + n) * 2], ci = Cc[(c * 64 + n) * 2 + 1];
                v[j] = ri == 0 ? (cr * ar - ci * ai) : -(cr * ai + ci * ar); } }
        v4u o; o.x = pk2(v[0], v[1]); o.y = pk2(v[2], v[3]); o.z = pk2(v[4], v[5]); o.w = pk2(v[6], v[7]);
        *(v4u*)(MQ + (size_t)row * S5K + k0) = o; }
    bf16* SP = (bf16*)(F.ws + WS_SP) + (size_t)g * 256 * 512;
    for (int idx = F.tid; idx < 256 * 64; idx += 512) { const int row = idx >> 6, k0 = (idx & 63) * 8; float v[8];
        if (row < 128) { const int ri = row >> 6, n = row & 63, s = k0 >> 4, c20 = k0 & 15; const float ar = ap[((31 - s) * 64 + n) * 2], ai = ap[((31 - s) * 64 + n) * 2 + 1];
#pragma unroll
            for (int j = 0; j < 8; ++j) { const float br = Bb[(n * 16 + c20 + j) * 2], bi = Bb[(n * 16 + c20 + j) * 2 + 1]; v[j] = ri == 0 ? (ar * br - ai * bi) : (ar * bi + ai * br); }
        } else {
#pragma unroll
            for (int j = 0; j < 8; ++j) v[j] = 0.f; }
        v4u o; o.x = pk2(v[0], v[1]); o.y = pk2(v[2], v[3]); o.z = pk2(v[4], v[5]); o.w = pk2(v[6], v[7]);
        *(v4u*)(SP + (size_t)row * 512 + k0) = o; }
    float* AL = (float*)(F.ws + WS_AL) + g * 128;
    if (F.tid < 64) { AL[F.tid * 2] = ap[(32 * 64 + F.tid) * 2]; AL[F.tid * 2 + 1] = ap[(32 * 64 + F.tid) * 2 + 1]; }
    __syncthreads();
}

struct BigTile { const float* src; unsigned char* dst; const float* ks; float sc; int ldw, ldt; };
constexpr int BT_GU = 64 * 2 * 64, BT_D = 64 * 64, BT_N = BT_GU + BT_D, BT_PITCH = 136;
__device__ __forceinline__ BigTile bt_decode(const Frame& F, unsigned char* Wgu8, unsigned char* Wd8, const float* nf, int ti) {
    BigTile t;
    const unsigned long long pg = (unsigned long long)F.in[I_W_GATE], pu = (unsigned long long)F.in[I_W_UP], pd = (unsigned long long)F.in[I_W_DOWN];
    if (ti < BT_GU) { const int e = ti >> 7, r = ti & 127, which = r >> 6, kb = (r >> 2) & 15, nb = r & 3;
        const unsigned long long p = pg + ((pu - pg) & (0ull - (unsigned long long)which));
        t.src = (const float*)p + (size_t)e * D * DEXP + (size_t)kb * 128 * DEXP + nb * 128; t.dst = Wgu8 + ((size_t)e * 1024 + nb * 256 + which * 128) * D + kb * 128; t.ks = nf + kb * 128; t.sc = SC_WGU; t.ldw = DEXP; t.ldt = D; }
    else { const int t2 = ti - BT_GU, e = t2 >> 6, r = t2 & 63, kb = r >> 4, nb = r & 15;
        t.src = (const float*)pd + (size_t)e * DEXP * D + (size_t)kb * 128 * D + nb * 128; t.dst = Wd8 + ((size_t)e * D + nb * 128) * DEXP + kb * 128; t.ks = nullptr; t.sc = SC_WD; t.ldw = D; t.ldt = DEXP; }
    return t;
}
#define BT_LOAD(t, v, kv) do { const unsigned _lo = (unsigned)(rl * 8 * (t).ldw + cq * 4); \
    _Pragma("unroll") for (int _p = 0; _p < 8; ++_p) kv[_p] = (t).ks ? (t).ks[rl * 8 + _p] * (t).sc : (t).sc; \
    _Pragma("unroll") for (int _p = 0; _p < 8; ++_p) v[_p] = __builtin_nontemporal_load((const f32x4*)((t).src + (size_t)_p * (t).ldw + _lo)); } while (0)
#define BT_STORE(t, v, kv) do { \
    _Pragma("unroll") for (int _i = 0; _i < 4; ++_i) { v2u _w; _w.x = pk4_fp8(v[0][_i] * kv[0], v[1][_i] * kv[1], v[2][_i] * kv[2], v[3][_i] * kv[3]); _w.y = pk4_fp8(v[4][_i] * kv[4], v[5][_i] * kv[5], v[6][_i] * kv[6], v[7][_i] * kv[7]); \
        *(LAS v2u*)(img + (cq * 4 + _i) * BT_PITCH + rl * 8) = _w; } \
    __syncthreads(); \
    _Pragma("unroll") for (int _j = 0; _j < 2; ++_j) { const int _idx = tid_ + _j * 512, _n = _idx >> 3, _ch = _idx & 7; \
        const v2u _a = *(const LAS v2u*)(img + _n * BT_PITCH + _ch * 16), _b = *(const LAS v2u*)(img + _n * BT_PITCH + _ch * 16 + 8); v4u _o; _o.x = _a.x; _o.y = _a.y; _o.z = _b.x; _o.w = _b.y; \
        *(v4u*)((t).dst + (size_t)_n * (t).ldt + _ch * 16) = _o; } \
    __syncthreads(); } while (0)
__device__ __forceinline__ void bg_convert(Frame& F, int qword, int base, int ntiles, int budget) {
    if (budget <= 0) return;
    int lane_ = (int)__builtin_amdgcn_mbcnt_hi(~0u, __builtin_amdgcn_mbcnt_lo(~0u, 0u)); asm volatile("" : "+v"(lane_)); const int tid_ = F.wave * 64 + lane_;
    unsigned char* WguT = F.ws + WS_WGU; unsigned char* WdT = F.ws + WS_WD; const float* nf = F.in[I_NORM_FFN];
    const int rl = tid_ >> 5, cq = tid_ & 31; LAS unsigned char* img = F.lds; LAS int* qn = (LAS int*)(F.lds + TAB_OFF + 1024);
    f32x4 va[8], vb[8]; float ka[8], kb[8];
    int nfetch = 0;
#define BG_FETCH(slot) do { if (nfetch < budget) { if (tid_ == 0) qn[slot] = (int)atomicAdd(F.ctl + qword, 1u); } else if (tid_ == 0) qn[slot] = 0x7fffffff; ++nfetch; } while (0)
    __syncthreads();
    BG_FETCH(0); BG_FETCH(1);
    __syncthreads();
    int i0 = __builtin_amdgcn_readfirstlane(qn[0]), i1 = __builtin_amdgcn_readfirstlane(qn[1]);
    __syncthreads();
    if (i0 < ntiles) { const BigTile t0 = bt_decode(F, WguT, WdT, nf, base + i0); BT_LOAD(t0, va, ka); }
    while (i0 < ntiles) {
        const BigTile ta = bt_decode(F, WguT, WdT, nf, base + i0);
        const BigTile tb = bt_decode(F, WguT, WdT, nf, base + (i1 < ntiles ? i1 : i0));
        BT_LOAD(tb, vb, kb);
        if (i1 >= ntiles) budget = 0;
        BG_FETCH(0);
        BT_STORE(ta, va, ka);
        const int i2 = __builtin_amdgcn_readfirstlane(qn[0]);
        if (i1 >= ntiles) break;
        const BigTile tc = bt_decode(F, WguT, WdT, nf, base + (i2 < ntiles ? i2 : i1));
        BT_LOAD(tc, va, ka);
        if (i2 >= ntiles) budget = 0;
        BG_FETCH(1);
        BT_STORE(tb, vb, kb);
        const int i3 = __builtin_amdgcn_readfirstlane(qn[1]);
        i0 = i2; i1 = i3;
    }
    __syncthreads();
#undef BG_FETCH
}
__device__ __forceinline__ void p0_prologue(Frame& F) {
    if (F.vcu < 32) s5_tables(F, F.vcu);
    const int gw = F.vcu * 8 + F.wave, NGW = F.G * 8;
    bf16* WinT = (bf16*)(F.ws + WS_WIN); bf16* WoT = (bf16*)(F.ws + WS_WO); bf16* WmkvT = (bf16*)(F.ws + WS_WMKV); bf16* WgluT = (bf16*)(F.ws + WS_WGLU);
    const float* nf = F.in[I_NORM_FFN];
    constexpr int I_IN = 32 * 72, I_O = 32 * 64, I_MKV = 32 * 32, I_GLU = 8 * 16;
    constexpr int NITEMS = I_IN + I_O + I_MKV + I_GLU;
    auto decode = [&](int it) -> TrItem {
        int r = it;
        if (r < I_IN) { const int kb = r / 72, nb = r % 72; return TrItem{F.in[I_W_IN], WinT, F.in[I_NORM_MIX]  , INC, D, kb * 64, nb * 32, nb * 32}; } r -= I_IN;
        if (r < I_O) { const int kb = r / 64, nb = r % 64, k0 = kb * 64;
            const unsigned long long pa = (unsigned long long)F.in[I_ON_ATTN], ps = (unsigned long long)(F.in[I_ON_SSM] - 1024), px = (unsigned long long)(F.in[I_ON_X] - 1536);
            const unsigned long long m1 = 0ull - (unsigned long long)(k0 >= 1024), m2 = 0ull - (unsigned long long)(k0 >= 1536);
            const unsigned long long pk = pa + ((ps - pa) & m1) + ((px - ps) & m2);
            return TrItem{F.in[I_W_O], WoT, (const float*)pk, D, D, k0, nb * 32, nb * 32}; } r -= I_O;
        if (r < I_MKV) { const int kb = r / 32, nb = r % 32; return TrItem{F.in[I_W_MEM_KV], WmkvT, nullptr, 1024, D, kb * 64, nb * 32, nb * 32}; } r -= I_MKV;
        const int kb = r / 16, nb = r % 16; return TrItem{F.in[I_W_GLU], WgluT, nullptr, 512, 512, kb * 64, nb * 32, nb * 32};
    };
    {
        f32x4 va[8], vb[8]; int it = gw; TrItem ia, ib;
        if (it < NITEMS) { ia = decode(it); tr_load(ia, va, F.lane); }
        while (it < NITEMS) {
            const int it2 = it + NGW; if (it2 < NITEMS) { ib = decode(it2); tr_load(ib, vb, F.lane); }
            tr_store(ia, va, F.lane);
            if (it2 >= NITEMS) break;
            const int it3 = it2 + NGW; if (it3 < NITEMS) { ia = decode(it3); tr_load(ia, va, F.lane); }
            tr_store(ib, vb, F.lane);
            it = it3;
        }
    }
    { bf16* WrT = (bf16*)(F.ws + WS_WR); const int gt = F.vcu * 512 + F.tid, NT = F.G * 512;
      for (int idx = gt; idx < 4 * 256 * 512; idx += NT) { const int ks = idx >> 17, n = (idx >> 9) & 255, k = ks * 512 + (idx & 511); float v = 0.f;
          if (n < 8) v = F.in[I_WR_G][k * 8 + n] * nf[k]; else if (n < 72) v = F.in[I_WR_E][k * 64 + (n - 8)] * nf[k];
          WrT[idx] = (bf16)f2bf(v); } }
    bf16* XN = (bf16*)(F.ws + WS_XN); bf16* MEMN = (bf16*)(F.ws + WS_MEMN);
    for (int m = gw; m < T; m += NGW) rms_row_to_bf16(F.in[I_X] + (size_t)m * D, nullptr, XN + (size_t)m * D, F.lane, (float*)(F.ws + WS_RINV) + m);
    for (int m = gw; m < NB * MEML; m += NGW) rms_row_to_bf16(F.in[I_MEM] + (size_t)m * D, F.in[I_MEM_NORM], MEMN + (size_t)m * D, F.lane);
    bg_convert(F, CW_QGU, 0, BT_GU, F.vcu < 32 ? PB0_S5 : PB0);
    bg_convert(F, CW_QD, BT_GU, BT_D, PB0_D);
}

constexpr int SWA_KS = 72, SWA_VS = 264;
constexpr int SWA_KOFF = 0, SWA_VOFF = 256 * SWA_KS * 2, SWA_BOFF = SWA_VOFF + 64 * SWA_VS * 2;
__device__ __forceinline__ int t5_bucket(int n) { if (n < 16) return n; const int v = 16 + (int)(logf((float)n * (1.0f / 16.0f)) / logf(8.0f) * 16.0f); return v < 31 ? v : 31; }
__device__ __forceinline__ void swa_unit(Frame& F, int unit) {
    const int b = unit >> 5, kvh = (unit >> 4) & 1, nb = unit & 15;
    const bf16* PROJ = (const bf16*)(F.ws + WS_PROJ); bf16* MIX = (bf16*)(F.ws + WS_MIX);
    LAS bf16* Ks = (LAS bf16*)(F.lds + SWA_KOFF); LAS bf16* Vt = (LAS bf16*)(F.lds + SWA_VOFF); LAS float* bt = (LAS float*)(F.lds + SWA_BOFF);
    const int w = F.wave, h = kvh * 8 + w, ql = F.lane & 31, hh = F.lane >> 5;
    v4u qnx[4];
    { const bf16* qp = PROJ + ((size_t)b * SEQ + nb * 128 + ql) * INC + h * 64 + 8 * hh;
#pragma unroll
      for (int ks = 0; ks < 4; ++ks) qnx[ks] = *(const v4u*)(qp + ks * 16); }
    __syncthreads();
    {
        const int key = F.tid >> 1, half = F.tid & 1, s = (nb - 1) * 128 + key;
        v4u kw[4], vw[4];
        if (s >= 0) { const bf16* rp = PROJ + (size_t)(b * SEQ + s) * INC + 1024 + kvh * 64 + half * 32;
#pragma unroll
            for (int j = 0; j < 4; ++j) { kw[j] = *(const v4u*)(rp + j * 8); vw[j] = *(const v4u*)(rp + 128 + j * 8); }
        } else {
#pragma unroll
            for (int j = 0; j < 4; ++j) { kw[j] = (v4u){0u, 0u, 0u, 0u}; vw[j] = (v4u){0u, 0u, 0u, 0u}; } }
        float kf[32]; float ss = 0.f;
#pragma unroll
        for (int j = 0; j < 4; ++j) { kf[j * 8 + 0] = bflo(kw[j].x); kf[j * 8 + 1] = bfhi(kw[j].x); kf[j * 8 + 2] = bflo(kw[j].y); kf[j * 8 + 3] = bfhi(kw[j].y);
            kf[j * 8 + 4] = bflo(kw[j].z); kf[j * 8 + 5] = bfhi(kw[j].z); kf[j * 8 + 6] = bflo(kw[j].w); kf[j * 8 + 7] = bfhi(kw[j].w); }
#pragma unroll
        for (int j = 0; j < 32; ++j) ss += kf[j] * kf[j];
        ss += __shfl_xor(ss, 1);
        const float rstd = 1.0f / sqrtf(ss * (1.f / 64.f) + EPS);
        const float* kn = F.in[I_K_NORM] + half * 32;
#pragma unroll
        for (int j = 0; j < 4; ++j) { v4u o; o.x = pk2(kf[j * 8 + 0] * rstd * kn[j * 8 + 0], kf[j * 8 + 1] * rstd * kn[j * 8 + 1]); o.y = pk2(kf[j * 8 + 2] * rstd * kn[j * 8 + 2], kf[j * 8 + 3] * rstd * kn[j * 8 + 3]);
            o.z = pk2(kf[j * 8 + 4] * rstd * kn[j * 8 + 4], kf[j * 8 + 5] * rstd * kn[j * 8 + 5]); o.w = pk2(kf[j * 8 + 6] * rstd * kn[j * 8 + 6], kf[j * 8 + 7] * rstd * kn[j * 8 + 7]);
            *(LAS v4u*)(Ks + key * SWA_KS + half * 32 + j * 8) = o; }
#pragma unroll
        for (int j = 0; j < 4; ++j) { const unsigned w4[4] = {vw[j].x, vw[j].y, vw[j].z, vw[j].w};
#pragma unroll
            for (int q = 0; q < 4; ++q) { const int d = half * 32 + j * 8 + q * 2; Vt[d * SWA_VS + key] = (bf16)(w4[q] & 0xffffu); Vt[(d + 1) * SWA_VS + key] = (bf16)(w4[q] >> 16); } }
        for (int idx = F.tid; idx < 8 * 128; idx += 512) { const int w = idx >> 7, dl = idx & 127; bt[idx] = F.in[I_REL_BIAS][t5_bucket(dl) * 16 + kvh * 8 + w]; }
    }
    __syncthreads();
    const float sink = F.in[I_SINKS][h];
    const float* qn = F.in[I_Q_NORM];
    for (int r = 0; r < 4; ++r) {
        const int qi = 32 * r + ql; const size_t t = (size_t)b * SEQ + nb * 128 + qi;
        bf16x8 qf[4];
        {   v4u qw[4]; float qv[32]; float ss = 0.f;
#pragma unroll
            for (int ks = 0; ks < 4; ++ks) qw[ks] = qnx[ks];
            if (r < 3) { const bf16* qp = PROJ + (t + 32) * INC + h * 64 + 8 * hh;
#pragma unroll
                for (int ks = 0; ks < 4; ++ks) qnx[ks] = *(const v4u*)(qp + ks * 16); }
#pragma unroll
            for (int ks = 0; ks < 4; ++ks) { qv[ks * 8 + 0] = bflo(qw[ks].x); qv[ks * 8 + 1] = bfhi(qw[ks].x); qv[ks * 8 + 2] = bflo(qw[ks].y); qv[ks * 8 + 3] = bfhi(qw[ks].y);
                qv[ks * 8 + 4] = bflo(qw[ks].z); qv[ks * 8 + 5] = bfhi(qw[ks].z); qv[ks * 8 + 6] = bflo(qw[ks].w); qv[ks * 8 + 7] = bfhi(qw[ks].w); }
#pragma unroll
            for (int j = 0; j < 32; ++j) ss += qv[j] * qv[j];
            ss += __shfl_xor(ss, 32);
            const float sc = 0.125f / sqrtf(ss * (1.f / 64.f) + EPS);
#pragma unroll
            for (int ks = 0; ks < 4; ++ks) { const float* g = qn + ks * 16 + 8 * hh; v4u o;
                o.x = pk2(qv[ks * 8 + 0] * sc * g[0], qv[ks * 8 + 1] * sc * g[1]); o.y = pk2(qv[ks * 8 + 2] * sc * g[2], qv[ks * 8 + 3] * sc * g[3]);
                o.z = pk2(qv[ks * 8 + 4] * sc * g[4], qv[ks * 8 + 5] * sc * g[5]); o.w = pk2(qv[ks * 8 + 6] * sc * g[6], qv[ks * 8 + 7] * sc * g[7]);
                qf[ks] = __builtin_bit_cast(bf16x8, o); } }
        f32x16 s[5];
        const int qh = ql - 4 * hh; const LAS float* pb = bt + w * 128 + qh;
        float mx = sink;
#pragma unroll
        for (int kt = 0; kt < 5; ++kt) {
            const bool live = (nb > 0) || (r + kt >= 4);
            f32x16 a = {0.f, 0.f, 0.f, 0.f, 0.f, 0.f, 0.f, 0.f, 0.f, 0.f, 0.f, 0.f, 0.f, 0.f, 0.f, 0.f};
            if (live) {
#pragma unroll
                for (int ks = 0; ks < 4; ++ks) { const bf16x8 kfrag = *(const LAS bf16x8*)(Ks + (32 * (r + kt) + ql) * SWA_KS + ks * 16 + 8 * hh);
                    a = __builtin_amdgcn_mfma_f32_32x32x16_bf16(kfrag, qf[ks], a, 0, 0, 0); }
#pragma unroll
                for (int rg = 0; rg < 16; ++rg) { const int rowc = (rg & 3) + 8 * (rg >> 2);
                    float v = a[rg] + pb[128 - 32 * kt - rowc];
                    if (kt == 0) v = (rowc > qh) ? v : -1e30f;
                    if (kt == 4) v = (rowc <= qh) ? v : -1e30f;
                    a[rg] = v; mx = fmaxf(mx, v); }
            } else {
#pragma unroll
                for (int rg = 0; rg < 16; ++rg) a[rg] = -1e30f;
            }
            s[kt] = a; }
        mx = fmaxf(mx, __shfl_xor(mx, 32));
        float l = 0.f;
#pragma unroll
        for (int kt = 0; kt < 5; ++kt)
#pragma unroll
            for (int rg = 0; rg < 16; ++rg) { const float p = fast_exp(s[kt][rg] - mx); s[kt][rg] = p; l += p; }
        l += __shfl_xor(l, 32);
        l += fast_exp(sink - mx);
        f32x16 o[2];
#pragma unroll
        for (int dt = 0; dt < 2; ++dt) o[dt] = (f32x16){0.f, 0.f, 0.f, 0.f, 0.f, 0.f, 0.f, 0.f, 0.f, 0.f, 0.f, 0.f, 0.f, 0.f, 0.f, 0.f};
#pragma unroll
        for (int kt = 0; kt < 5; ++kt)
#pragma unroll
            for (int st = 0; st < 2; ++st) { v4u pw; pw.x = pk2(s[kt][8 * st + 0], s[kt][8 * st + 1]); pw.y = pk2(s[kt][8 * st + 2], s[kt][8 * st + 3]); pw.z = pk2(s[kt][8 * st + 4], s[kt][8 * st + 5]); pw.w = pk2(s[kt][8 * st + 6], s[kt][8 * st + 7]);
                const bf16x8 pf = __builtin_bit_cast(bf16x8, pw);
#pragma unroll
                for (int dt = 0; dt < 2; ++dt) { const LAS bf16* vp = Vt + (dt * 32 + ql) * SWA_VS + 32 * (r + kt) + 16 * st + 4 * hh;
                    const v2u lo = *(const LAS v2u*)vp, hi = *(const LAS v2u*)(vp + 8); v4u vv; vv.x = lo.x; vv.y = lo.y; vv.z = hi.x; vv.w = hi.y;
                    o[dt] = __builtin_amdgcn_mfma_f32_32x32x16_bf16(__builtin_bit_cast(bf16x8, vv), pf, o[dt], 0, 0, 0); } }
        const float inv = 1.0f / l;
        { float ssq = 0.f;
#pragma unroll
          for (int dt = 0; dt < 2; ++dt)
#pragma unroll
              for (int rg = 0; rg < 16; ++rg) { const float v = o[dt][rg] * inv; ssq += v * v; }
          ssq += __shfl_xor(ssq, 32);
          if (hh == 0) ((float*)(F.ws + WS_SS))[t * 32 + h] = ssq; }
        bf16* op = MIX + t * D + h * 64 + 4 * hh;
#pragma unroll
        for (int dt = 0; dt < 2; ++dt)
#pragma unroll
            for (int q4 = 0; q4 < 4; ++q4) { v2u ow; ow.x = pk2(o[dt][q4 * 4 + 0] * inv, o[dt][q4 * 4 + 1] * inv); ow.y = pk2(o[dt][q4 * 4 + 2] * inv, o[dt][q4 * 4 + 3] * inv);
                *(v2u*)(op + dt * 32 + q4 * 8) = ow; }
    }
}

constexpr int XA_KS = 136, XA_VS = 264;
constexpr int XA_KOFF = 0, XA_VOFF = 256 * XA_KS * 2;
__device__ __forceinline__ void xattn_unit(Frame& F, int unit) {
    const int b = unit >> 5, hx = (unit >> 3) & 3, qb = unit & 7;
    const bf16* PROJ = (const bf16*)(F.ws + WS_PROJ); const bf16* MKV = (const bf16*)(F.ws + WS_MEMKV); bf16* MIX = (bf16*)(F.ws + WS_MIX);
    LAS bf16* Ks = (LAS bf16*)(F.lds + XA_KOFF); LAS bf16* Vt = (LAS bf16*)(F.lds + XA_VOFF);
    __syncthreads();
    {   const int key = F.tid >> 1, half = F.tid & 1; const bf16* rp = MKV + (size_t)(b * MEML + key) * 1024 + hx * 128 + half * 64;
        float ss = 0.f; v4u kw[8];
#pragma unroll
        for (int j = 0; j < 8; ++j) { kw[j] = *(const v4u*)(rp + j * 8);
            const float a0 = bflo(kw[j].x), a1 = bfhi(kw[j].x), a2 = bflo(kw[j].y), a3 = bfhi(kw[j].y), a4 = bflo(kw[j].z), a5 = bfhi(kw[j].z), a6 = bflo(kw[j].w), a7 = bfhi(kw[j].w);
            ss += (a0 * a0 + a1 * a1) + (a2 * a2 + a3 * a3) + (a4 * a4 + a5 * a5) + (a6 * a6 + a7 * a7); }
        ss += __shfl_xor(ss, 1);
        const float rstd = 1.0f / sqrtf(ss * (1.f / 128.f) + EPS);
        const float* kn = F.in[I_XK_NORM] + half * 64;
#pragma unroll
        for (int j = 0; j < 8; ++j) { v4u o; const float* g = kn + j * 8;
            o.x = pk2(bflo(kw[j].x) * rstd * g[0], bfhi(kw[j].x) * rstd * g[1]); o.y = pk2(bflo(kw[j].y) * rstd * g[2], bfhi(kw[j].y) * rstd * g[3]);
            o.z = pk2(bflo(kw[j].z) * rstd * g[4], bfhi(kw[j].z) * rstd * g[5]); o.w = pk2(bflo(kw[j].w) * rstd * g[6], bfhi(kw[j].w) * rstd * g[7]);
            *(LAS v4u*)(Ks + key * XA_KS + half * 64 + j * 8) = o; }
#pragma unroll
        for (int j = 0; j < 8; ++j) { const v4u vw = *(const v4u*)(rp + 512 + j * 8); const unsigned w4[4] = {vw.x, vw.y, vw.z, vw.w};
#pragma unroll
            for (int q = 0; q < 4; ++q) { const int d = half * 64 + j * 8 + q * 2; Vt[d * XA_VS + key] = (bf16)(w4[q] & 0xffffu); Vt[(d + 1) * XA_VS + key] = (bf16)(w4[q] >> 16); } }
    }
    __syncthreads();
    const int ql = F.lane & 31, hh = F.lane >> 5;
    const size_t t = (size_t)b * SEQ + qb * 256 + F.wave * 32 + ql;
    bf16x8 qf[8];
    {   const bf16* qp = PROJ + t * INC + 1792 + hx * 128 + 8 * hh; v4u qw[8]; float ss = 0.f;
#pragma unroll
        for (int ks = 0; ks < 8; ++ks) { qw[ks] = *(const v4u*)(qp + ks * 16);
            const float a0 = bflo(qw[ks].x), a1 = bfhi(qw[ks].x), a2 = bflo(qw[ks].y), a3 = bfhi(qw[ks].y), a4 = bflo(qw[ks].z), a5 = bfhi(qw[ks].z), a6 = bflo(qw[ks].w), a7 = bfhi(qw[ks].w);
            ss += (a0 * a0 + a1 * a1) + (a2 * a2 + a3 * a3) + (a4 * a4 + a5 * a5) + (a6 * a6 + a7 * a7); }
        ss += __shfl_xor(ss, 32);
        const float sc = 0.08838834764831845f / sqrtf(ss * (1.f / 128.f) + EPS);
        const float* qn = F.in[I_XQ_NORM] + 8 * hh;
#pragma unroll
        for (int ks = 0; ks < 8; ++ks) { const float* g = qn + ks * 16; v4u o;
            o.x = pk2(bflo(qw[ks].x) * sc * g[0], bfhi(qw[ks].x) * sc * g[1]); o.y = pk2(bflo(qw[ks].y) * sc * g[2], bfhi(qw[ks].y) * sc * g[3]);
            o.z = pk2(bflo(qw[ks].z) * sc * g[4], bfhi(qw[ks].z) * sc * g[5]); o.w = pk2(bflo(qw[ks].w) * sc * g[6], bfhi(qw[ks].w) * sc * g[7]);
            qf[ks] = __builtin_bit_cast(bf16x8, o); } }
    f32x16 o[4];
#pragma unroll
    for (int dt = 0; dt < 4; ++dt) o[dt] = (f32x16){0.f, 0.f, 0.f, 0.f, 0.f, 0.f, 0.f, 0.f, 0.f, 0.f, 0.f, 0.f, 0.f, 0.f, 0.f, 0.f};
    float mrun = -1e30f, lrun = 0.f;
    for (int kb = 0; kb < 4; ++kb) {
        f32x16 s[2];
#pragma unroll
        for (int kt = 0; kt < 2; ++kt) { f32x16 a = {0.f, 0.f, 0.f, 0.f, 0.f, 0.f, 0.f, 0.f, 0.f, 0.f, 0.f, 0.f, 0.f, 0.f, 0.f, 0.f};
#pragma unroll
            for (int ks = 0; ks < 8; ++ks) { const bf16x8 kfrag = *(const LAS bf16x8*)(Ks + (64 * kb + 32 * kt + ql) * XA_KS + ks * 16 + 8 * hh);
                a = __builtin_amdgcn_mfma_f32_32x32x16_bf16(kfrag, qf[ks], a, 0, 0, 0); }
            s[kt] = a; }
        float mx = mrun;
#pragma unroll
        for (int kt = 0; kt < 2; ++kt)
#pragma unroll
            for (int rg = 0; rg < 16; ++rg) mx = fmaxf(mx, s[kt][rg]);
        mx = fmaxf(mx, __shfl_xor(mx, 32));
        const float alpha = fast_exp(mrun - mx); mrun = mx;
        float ls = 0.f;
#pragma unroll
        for (int kt = 0; kt < 2; ++kt)
#pragma unroll
            for (int rg = 0; rg < 16; ++rg) { const float p = fast_exp(s[kt][rg] - mx); s[kt][rg] = p; ls += p; }
        lrun = lrun * alpha + ls;
#pragma unroll
        for (int dt = 0; dt < 4; ++dt)
#pragma unroll
            for (int rg = 0; rg < 16; ++rg) o[dt][rg] *= alpha;
#pragma unroll
        for (int kt = 0; kt < 2; ++kt)
#pragma unroll
            for (int st = 0; st < 2; ++st) { v4u pw; pw.x = pk2(s[kt][8 * st + 0], s[kt][8 * st + 1]); pw.y = pk2(s[kt][8 * st + 2], s[kt][8 * st + 3]); pw.z = pk2(s[kt][8 * st + 4], s[kt][8 * st + 5]); pw.w = pk2(s[kt][8 * st + 6], s[kt][8 * st + 7]);
                const bf16x8 pf = __builtin_bit_cast(bf16x8, pw);
#pragma unroll
                for (int dt = 0; dt < 4; ++dt) { const LAS bf16* vp = Vt + (dt * 32 + ql) * XA_VS + 64 * kb + 32 * kt + 16 * st + 4 * hh;
                    const v2u lo = *(const LAS v2u*)vp, hi = *(const LAS v2u*)(vp + 8); v4u vv; vv.x = lo.x; vv.y = lo.y; vv.z = hi.x; vv.w = hi.y;
                    o[dt] = __builtin_amdgcn_mfma_f32_32x32x16_bf16(__builtin_bit_cast(bf16x8, vv), pf, o[dt], 0, 0, 0); } }
    }
    lrun += __shfl_xor(lrun, 32);
    const float inv = 1.0f / lrun;
    { float ssq = 0.f;
#pragma unroll
      for (int dt = 0; dt < 4; ++dt)
#pragma unroll
          for (int rg = 0; rg < 16; ++rg) { const float v = o[dt][rg] * inv; ssq += v * v; }
      ssq += __shfl_xor(ssq, 32);
      if (hh == 0) ((float*)(F.ws + WS_SS))[t * 32 + 24 + hx] = ssq; }
    bf16* op = MIX + t * D + 1536 + hx * 128 + 4 * hh;
#pragma unroll
    for (int dt = 0; dt < 4; ++dt)
#pragma unroll
        for (int q4 = 0; q4 < 4; ++q4) { v2u ow; ow.x = pk2(o[dt][q4 * 4 + 0] * inv, o[dt][q4 * 4 + 1] * inv); ow.y = pk2(o[dt][q4 * 4 + 2] * inv, o[dt][q4 * 4 + 3] * inv);
            *(v2u*)(op + dt * 32 + q4 * 8) = ow; }
}

__device__ __forceinline__ void moe_tables(Frame& F) {
    LAS int* cnt = (LAS int*)(F.lds + TAB_OFF); LAS int* ts = cnt + 64;
    __syncthreads();
    if (F.tid < 64) { const int c = (int)__hip_atomic_load(F.ctl + CW_CNT + F.tid, __ATOMIC_RELAXED, __HIP_MEMORY_SCOPE_AGENT); const int nt = (c + 255) >> 8; int inc = nt;
#pragma unroll
        for (int o = 1; o < 64; o <<= 1) { const int v = __shfl_up(inc, o); if (F.tid >= o) inc += v; }
        cnt[F.tid] = c; ts[F.tid + 1] = inc; if (F.tid == 0) ts[0] = 0; }
    __syncthreads();
}

struct Args { const float* in[31]; float* out; unsigned char* ws; int ph_lo, ph_hi; };
__global__ void __launch_bounds__(512, 2) hymba_fwd(Args args) {
    extern __shared__ __attribute__((aligned(16))) unsigned char lds_raw[];
    Frame F;
    F.lds = (LAS unsigned char*)lds_raw;
    F.tid = threadIdx.x; F.lane = F.tid & 63; F.wave = __builtin_amdgcn_readfirstlane(F.tid >> 6);
    F.G = gridDim.x; { const int bx = blockIdx.x; F.vcu = (F.G % 8 == 0) ? (bx % 8) * (F.G / 8) + bx / 8 : bx; }
    F.in = (const float* const __attribute__((address_space(4)))*)__builtin_amdgcn_kernarg_segment_ptr();
    F.out = args.out; F.ws = args.ws; F.ctl = (unsigned*)(args.ws + WS_CTL);
    const int lo = args.ph_lo, hi = args.ph_hi;
#if !MK_PER_PHASE
    if (F.tid < 4) ((LAS unsigned*)(F.lds + XBW_OFF))[F.tid] = 0u;
    __syncthreads();
    XcdBarrier bar = xcd_barrier_post(F.ctl + CW_BAR, (volatile LAS unsigned*)(F.lds + XBW_OFF));
#define GRID_BAR() xcd_barrier(bar)
#else
#define GRID_BAR() do {} while (0)
#endif
#define PHASE_REGS() do { int _l = (int)__builtin_amdgcn_mbcnt_hi(~0u, __builtin_amdgcn_mbcnt_lo(~0u, 0u)); asm volatile("" : "+v"(_l)); F.lane = _l; F.tid = F.wave * 64 + _l; } while (0)
#define IN(k) (lo <= (k) && (k) < hi)
#define SEAM(k) do { if (IN(k) && IN((k) + 1)) GRID_BAR(); } while (0)
    const int gw = F.vcu * 8 + F.wave, NGW = F.G * 8;
    bf16* const XN = (bf16*)(F.ws + WS_XN); bf16* const PROJ = (bf16*)(F.ws + WS_PROJ); bf16* const MIX = (bf16*)(F.ws + WS_MIX);
    bf16* const UA = (bf16*)(F.ws + WS_UA); bf16* const Gm = (bf16*)(F.ws + WS_G);

    if (IN(0)) { PHASE_REGS(); p0_prologue(F); }
    SEAM(0);
    if (IN(1)) { PHASE_REGS();
        { pg8::Gemm g{D, D, D}; pg8::DenseOrder S; S.init(XN, F.ws + WS_WIN, D, D, T, INC, F.G, (int)blockIdx.x);
          pg8::EpiProj E{PROJ, UA}; pg8::gemm_phase<pg8::EpiProj, pg8::DenseOrder>(F.lds, g, S, E, F.wave); }
        { pg8::Gemm g{D, D, D}; pg8::DenseOrder S; S.init(F.ws + WS_MEMN, F.ws + WS_WMKV, D, D, NB * MEML, 1024, F.G, F.G - 1 - (int)blockIdx.x);
          pg8::EpiBf16 E{(bf16*)(F.ws + WS_MEMKV), 1024}; pg8::gemm_phase<pg8::EpiBf16, pg8::DenseOrder>(F.lds, g, S, E, F.wave); }
        { const int c = (int)blockIdx.x; const bool has3 = 2 * F.G + c < (T / 256) * (INC / 256), haskv = (F.G - 1 - c) < (NB * MEML / 256) * 4;
          bg_convert(F, CW_QD, BT_GU, BT_D, (!has3 && !haskv) ? PB1 : 0); }
    }
    SEAM(1);
    if (IN(2)) { PHASE_REGS();
        for (int u = F.vcu; u < 256; u += F.G) swa_unit(F, u);
        __syncthreads();
        { pg8::Gemm g{S5K, 512, 256}; pg8::StateOrder S{(const char*)UA, (const char*)(F.ws + WS_SP), F.G, F.G - 1 - F.vcu};
          pg8::EpiF32 E{(float*)(F.ws + WS_SL), 256, (size_t)512 * 256}; pg8::gemm_phase<pg8::EpiF32, pg8::StateOrder>(F.lds, g, S, E, F.wave); }
        bg_convert(F, CW_QD, BT_GU, BT_D, (F.G - 1 - F.vcu) >= 128 ? PB2 : 0);
    }
    SEAM(2);
    if (IN(3)) { PHASE_REGS();
        if (F.wave < 4) { const float* SL = (const float*)(F.ws + WS_SL); const float* AL = (const float*)(F.ws + WS_AL);
            for (int L = F.vcu; L < 128; L += F.G) { const int g = L >> 2, pm = L & 1, b = 4 * pm + F.wave, n = F.lane;
                const float ar = AL[(g * 64 + n) * 2], ai = AL[(g * 64 + n) * 2 + 1]; float xr = 0.f, xi = 0.f;
                for (int j0 = 0; j0 < 64; j0 += 8) { float sr[8], si[8];
#pragma unroll
                    for (int j = 0; j < 8; ++j) { const float* sp = SL + ((size_t)(g * 1024 + b * 64 + j0 + j)) * 256; const float* sq = sp + (size_t)512 * 256; sr[j] = sp[n] + sq[n]; si[j] = sp[64 + n] + sq[64 + n]; }
#pragma unroll
                    for (int j = 0; j < 8; ++j) { bf16* up = UA + ((size_t)(g * 512 + b * 64 + j0 + j)) * S5K + 512; up[n] = (bf16)f2bf(xr); up[64 + n] = (bf16)f2bf(xi);
                        const float nr = ar * xr - ai * xi + sr[j], ni = ar * xi + ai * xr + si[j]; xr = nr; xi = ni; } } } }
        asm volatile("s_waitcnt vmcnt(0)" ::: "memory");
        __syncthreads();
        pg8::Gemm g{S5K, S5K, S5K}; pg8::GroupOrder S{(const char*)UA, (const char*)(F.ws + WS_MQ), S5K, S5K, 2, 32, F.G, F.vcu};
        pg8::EpiS5Y E{UA, F.in[I_SSM_D], Gm}; pg8::gemm_phase<pg8::EpiS5Y, pg8::GroupOrder>(F.lds, g, S, E, F.wave);
        if (F.G >= 256 && F.vcu >= 128) { for (int u = F.vcu - 128; u < 128; u += F.G - 128) xattn_unit(F, u); __syncthreads(); }
        if (F.G < 256) { for (int u = F.vcu; u < 256; u += F.G) xattn_unit(F, u); __syncthreads(); }
        bg_convert(F, CW_QD, BT_GU, BT_D, (F.G >= 256 && F.vcu >= 128) ? PB4 : 0);
    }
    SEAM(3);
    if (IN(4)) { PHASE_REGS();
        pg8::Gemm g{512, 512, 512}; pg8::DenseOrder S; S.init(Gm, F.ws + WS_WGLU, 512, 512, T, 512, F.G, (int)blockIdx.x);
        pg8::EpiGlu E{Gm, MIX, (float*)(F.ws + WS_SS)}; pg8::gemm_phase<pg8::EpiGlu, pg8::DenseOrder>(F.lds, g, S, E, F.wave);
        if (F.G >= 256 && (int)blockIdx.x >= 128) { for (int u = 128 + (int)blockIdx.x - 128; u < 256; u += F.G - 128) xattn_unit(F, u); __syncthreads(); }
    }
    SEAM(4);
    if (IN(5)) { PHASE_REGS();
        pg8::Gemm g{D, D, D}; pg8::DenseOrder S; S.init(MIX, F.ws + WS_WO, D, D, T, D, F.G, (int)blockIdx.x);
        pg8::EpiWo E{(const float*)(F.ws + WS_RINV), XN, (unsigned char*)(F.ws + WS_X18), (float*)(F.ws + WS_PART)}; pg8::gemm_phase<pg8::EpiWo, pg8::DenseOrder, false, false, true>(F.lds, g, S, E, F.wave, (const float*)(F.ws + WS_SS));
    }
    SEAM(5);
    if (IN(6)) { PHASE_REGS();
        pg8::Gemm g{D, 512, 512}; pg8::KSplitOrder S{(const char*)XN, (const char*)(F.ws + WS_WR), D, 512, 512, T / 256, 4, F.G, F.vcu};
        pg8::EpiLogit E{(float*)(F.ws + WS_LP)}; pg8::gemm_phase<pg8::EpiLogit, pg8::KSplitOrder>(F.lds, g, S, E, F.wave);
    }
    SEAM(6);
    const int rt_per = (T + F.G - 1) / F.G, rt_beg = F.vcu * rt_per, rt_end = (rt_beg + rt_per) < T ? (rt_beg + rt_per) : T;
    if (IN(7)) { PHASE_REGS();
        LAS int* hist = (LAS int*)F.lds;
        const float* LP = (const float*)(F.ws + WS_LP); const float* part = (const float*)(F.ws + WS_PART); float* rstdv = (float*)(F.ws + WS_RSTD);
        int* toke = (int*)(F.ws + WS_TOKE); float* wts = (float*)(F.ws + WS_WTS); int* HIST = (int*)(F.ws + WS_HIST);
        __syncthreads();
        if (F.tid < 64) hist[F.tid] = 0;
        __syncthreads();
        for (int t = rt_beg + F.tid; t < rt_end; t += 512) {
            const f32x4* pp = (const f32x4*)(part + (size_t)t * 32); float ss = 0.f;
#pragma unroll
            for (int j = 0; j < 8; ++j) { const f32x4 v = pp[j]; ss += (v[0] + v[1]) + (v[2] + v[3]); }
            const float rs = 1.0f / sqrtf(ss * (1.f / 2048.f) + EPS); rstdv[t] = rs;
            const float* l0 = LP + (size_t)t * 80; const float* l1 = l0 + (size_t)T * 80; const float* l2 = l1 + (size_t)T * 80; const float* l3 = l2 + (size_t)T * 80;
            float gl[8];
#pragma unroll
            for (int j = 0; j < 8; j += 4) { const f32x4 a = *(const f32x4*)(l0 + j), b = *(const f32x4*)(l1 + j), c = *(const f32x4*)(l2 + j), d = *(const f32x4*)(l3 + j);
#pragma unroll
                for (int q = 0; q < 4; ++q) gl[j + q] = rs * (((a[q] + b[q]) + c[q]) + d[q]); }
            int gi = 0; float gm = gl[0];
#pragma unroll
            for (int j = 1; j < 8; ++j) if (gl[j] > gm) { gm = gl[j]; gi = j; }
            float gs = 0.f;
#pragma unroll
            for (int j = 0; j < 8; ++j) gs += expf(gl[j] - gm);
            const float gate = 1.0f / gs;
            float el[8];
#pragma unroll
            for (int j = 0; j < 8; j += 4) { const int o = 8 + gi * 8 + j; const f32x4 a = *(const f32x4*)(l0 + o), b = *(const f32x4*)(l1 + o), c = *(const f32x4*)(l2 + o), d = *(const f32x4*)(l3 + o);
#pragma unroll
                for (int q = 0; q < 4; ++q) el[j + q] = rs * (((a[q] + b[q]) + c[q]) + d[q]); }
            int i1 = 0; float v1 = el[0];
#pragma unroll
            for (int j = 1; j < 8; ++j) if (el[j] > v1) { v1 = el[j]; i1 = j; }
            int i2 = -1; float v2 = -3.0e38f;
#pragma unroll
            for (int j = 0; j < 8; ++j) if (j != i1 && el[j] > v2) { v2 = el[j]; i2 = j; }
            const float ex = expf(v2 - v1);
            const int ea = gi * 8 + i1, eb = gi * 8 + i2;
            const int la = __hip_atomic_fetch_add(hist + ea, 1, __ATOMIC_RELAXED, __HIP_MEMORY_SCOPE_WORKGROUP), lb = __hip_atomic_fetch_add(hist + eb, 1, __ATOMIC_RELAXED, __HIP_MEMORY_SCOPE_WORKGROUP);
            toke[t * 2] = (ea << 16) | la; toke[t * 2 + 1] = (eb << 16) | lb; wts[t * 2] = gate / (1.0f + ex); wts[t * 2 + 1] = gate * ex / (1.0f + ex);
        }
        __syncthreads();
        if (F.tid < 64) HIST[F.vcu * 64 + F.tid] = hist[F.tid];
        __syncthreads();
    }
    SEAM(7);
    if (IN(8)) { PHASE_REGS();
        LAS int* pb = (LAS int*)F.lds; LAS int* pt = pb + 512; LAS int* base = pt + 512;
        const int* HIST = (const int*)(F.ws + WS_HIST); const int* toke = (const int*)(F.ws + WS_TOKE); int* list = (int*)(F.ws + WS_LIST);
        __syncthreads();
        { const int e = F.tid & 63, p8 = F.tid >> 6; int sb = 0, st = 0;
          for (int w = p8; w < F.G; w += 8) { const int h = HIST[w * 64 + e]; st += h; sb += (w < F.vcu) ? h : 0; }
          pb[F.tid] = sb; pt[F.tid] = st; }
        __syncthreads();
        if (F.tid < 64) { int sb = 0, st = 0;
#pragma unroll
            for (int j = 0; j < 8; ++j) { sb += pb[j * 64 + F.tid]; st += pt[j * 64 + F.tid]; }
            base[F.tid] = sb; F.ctl[CW_CNT + F.tid] = (unsigned)st; }
        __syncthreads();
        for (int t = rt_beg + F.tid; t < rt_end; t += 512) {
#pragma unroll
            for (int k = 0; k < 2; ++k) { const int v = toke[t * 2 + k], e = v >> 16, sl = v & 0xffff; const size_t pos = (size_t)e * LCAP + base[e] + sl;
                list[pos] = t * 2 + k; ((float*)(F.ws + WS_LRS))[pos] = ((const float*)(F.ws + WS_RSTD))[t]; ((float*)(F.ws + WS_LWT))[pos] = ((const float*)(F.ws + WS_WTS))[t * 2 + k]; } }
        __syncthreads();
        bg_convert(F, CW_QGU, 0, BT_GU, 0x7fffffff);
    }
    SEAM(8);
    if (IN(9)) { PHASE_REGS();
        moe_tables(F);
        const LAS int* cnt = (const LAS int*)(F.lds + TAB_OFF); const int* list = (const int*)(F.ws + WS_LIST);
        pg8::Gemm g{D / 2, D / 2, D / 2}; pg8::MoeOrder S{(const char*)(F.ws + WS_X18), (const char*)(F.ws + WS_WGU), cnt, cnt + 64, list, D / 2, D / 2, 4, 1024, F.G, F.vcu, true};
        pg8::EpiGU E{(const float*)(F.ws + WS_LRS), cnt, F.ws + WS_ACT}; pg8::gemm_phase<pg8::EpiGU, pg8::MoeOrder, true, true>(F.lds, g, S, E, F.wave);
        PHASE_REGS();
        bg_convert(F, CW_QD, BT_GU, BT_D, 0x7fffffff);
    }
    SEAM(9);
    if (IN(10)) { PHASE_REGS();
        moe_tables(F);
        const LAS int* cnt = (const LAS int*)(F.lds + TAB_OFF); const int* list = (const int*)(F.ws + WS_LIST);
        pg8::Gemm g{DEXP / 2, DEXP / 2, DEXP / 2}; pg8::MoeOrder S{(const char*)(F.ws + WS_ACT), (const char*)(F.ws + WS_WD), cnt, cnt + 64, list, DEXP / 2, DEXP / 2, 8, 2048, F.G, F.vcu, false};
        pg8::EpiDown E{list, (const float*)(F.ws + WS_LWT), cnt, F.ws + WS_Y2};
        pg8::gemm_phase<pg8::EpiDown, pg8::MoeOrder, false, true>(F.lds, g, S, E, F.wave);
    }
    SEAM(10);
    if (IN(11)) { PHASE_REGS();
        const unsigned char* Y2 = F.ws + WS_Y2; typedef float f32x2_ __attribute__((ext_vector_type(2)));
        for (int m = gw; m < T; m += NGW) { f32x4* op = (f32x4*)(F.out + (size_t)m * D) + F.lane * 2; const v4u* xb = (const v4u*)(XN + (size_t)m * D) + F.lane;
            const v2u* ya = (const v2u*)(Y2 + (size_t)m * 2 * D) + F.lane; const v2u* yb = ya + 256;
            v4u xw[4]; v2u aw[4], cw[4];
#pragma unroll
            for (int j = 0; j < 4; ++j) { xw[j] = __builtin_nontemporal_load(xb + 64 * j); aw[j] = __builtin_nontemporal_load(ya + 64 * j); cw[j] = __builtin_nontemporal_load(yb + 64 * j); }
#pragma unroll
            for (int j = 0; j < 4; ++j) { const v4u x = xw[j]; const v2u a = aw[j], c = cw[j]; f32x4 x0, x1; const float is = 1.0f / SC_Y;
                const f32x2_ a0 = __builtin_amdgcn_cvt_pk_f32_fp8((int)a.x, false), a1 = __builtin_amdgcn_cvt_pk_f32_fp8((int)a.x, true), a2 = __builtin_amdgcn_cvt_pk_f32_fp8((int)a.y, false), a3 = __builtin_amdgcn_cvt_pk_f32_fp8((int)a.y, true);
                const f32x2_ c0 = __builtin_amdgcn_cvt_pk_f32_fp8((int)c.x, false), c1 = __builtin_amdgcn_cvt_pk_f32_fp8((int)c.x, true), c2 = __builtin_amdgcn_cvt_pk_f32_fp8((int)c.y, false), c3 = __builtin_amdgcn_cvt_pk_f32_fp8((int)c.y, true);
                x0[0] = bflo(x.x) + (a0[0] + c0[0]) * is; x0[1] = bfhi(x.x) + (a0[1] + c0[1]) * is; x0[2] = bflo(x.y) + (a1[0] + c1[0]) * is; x0[3] = bfhi(x.y) + (a1[1] + c1[1]) * is;
                x1[0] = bflo(x.z) + (a2[0] + c2[0]) * is; x1[1] = bfhi(x.z) + (a2[1] + c2[1]) * is; x1[2] = bflo(x.w) + (a3[0] + c3[0]) * is; x1[3] = bfhi(x.w) + (a3[1] + c3[1]) * is;
                __builtin_nontemporal_store(x0, op + 128 * j); __builtin_nontemporal_store(x1, op + 128 * j + 1); } }
    }
#undef IN
#undef SEAM
}

extern "C" void kernel_launch(void* const* d_in, const int* in_sizes, int n_in, void* d_out, int out_size, void* d_ws, size_t ws_size, hipStream_t stream) {
    static int grid = 0;
    if (grid == 0) {
        if (n_in != 31 || out_size != T * D || ws_size < WS_END) { fprintf(stderr, "kernel_launch: unexpected shapes (n_in %d out %d ws %zu)\n", n_in, out_size, ws_size); grid = -1; return; }
        int dev = 0, cus = 0, per_cu = 0;
        if (hipGetDevice(&dev) != hipSuccess || hipDeviceGetAttribute(&cus, hipDeviceAttributeMultiprocessorCount, dev) != hipSuccess) { grid = -1; return; }
        if (hipFuncSetAttribute((const void*)hymba_fwd, hipFuncAttributeMaxDynamicSharedMemorySize, LDS_BYTES) != hipSuccess) { fprintf(stderr, "kernel_launch: hipFuncSetAttribute failed\n"); grid = -1; return; }
        if (hipOccupancyMaxActiveBlocksPerMultiprocessor(&per_cu, (const void*)hymba_fwd, 512, LDS_BYTES) != hipSuccess || per_cu < 1) fprintf(stderr, "kernel_launch: occupancy query reports %d\n", per_cu);
        (void)hipGetLastError();
        grid = cus;
    }
    if (grid < 0) return;
    (void)hipMemsetAsync((char*)d_ws + WS_CTL, 0, CTL_ZERO_BYTES, stream);
    Args a{};
    for (int i = 0; i < 31; ++i) a.in[i] = (const float*)d_in[i];
    a.out = (float*)d_out; a.ws = (unsigned char*)d_ws;
#if MK_PER_PHASE
    for (int p = 0; p < NPH; ++p) { const int reps = ((PROBE_REP_MASK >> p) & 1) ? 2 : 1;
        for (int q = 0; q < reps; ++q) { a.ph_lo = p; a.ph_hi = p + 1; hipLaunchKernelGGL(hymba_fwd, dim3(grid), dim3(512), LDS_BYTES, stream, a); } }
#else
    a.ph_lo = 0; a.ph_hi = NPH; hipLaunchKernelGGL(hymba_fwd, dim3(grid), dim3(512), LDS_BYTES, stream, a);
#endif
}
```
